# Optimizing an MI355X kernel written in HIP

```python
import jax, jax.numpy as jnp
from jax import lax
import numpy as np

D_MODEL = 1024
BATCH = 2
SEQ = 16384
DEPTH = 2

HGRN_HEADS = 4
HGRN_HEAD_DIM = 128
HGRN_WIDTH = HGRN_HEADS * HGRN_HEAD_DIM
GLA_HEADS = 4
GLA_KEY_DIM = 64
GLA_VAL_DIM = 128
GLA_KEY_WIDTH = GLA_HEADS * GLA_KEY_DIM
GLA_VAL_WIDTH = GLA_HEADS * GLA_VAL_DIM
GLA_GATE_RANK = 16
GLA_GATE_NORMALIZER = 16.0
LIN_CHUNK = 64
AB_SIZES = (HGRN_WIDTH, HGRN_WIDTH, HGRN_WIDTH, HGRN_WIDTH,
            GLA_KEY_WIDTH, GLA_KEY_WIDTH, GLA_VAL_WIDTH, GLA_VAL_WIDTH, GLA_GATE_RANK)
AB_WIDTH = sum(AB_SIZES)
AB_OUT_WIDTH = HGRN_WIDTH + GLA_VAL_WIDTH
MLSTM_HEADS = 4
MLSTM_QK_DIM = 128
MLSTM_V_DIM = 256
MLSTM_QK_WIDTH = MLSTM_HEADS * MLSTM_QK_DIM
MLSTM_V_WIDTH = MLSTM_HEADS * MLSTM_V_DIM
MLSTM_CONV = 4
MLSTM_CHUNK = 128
C_SIZES = (2 * MLSTM_QK_WIDTH, MLSTM_V_WIDTH, MLSTM_V_WIDTH, MLSTM_HEADS, MLSTM_HEADS)
C_WIDTH = sum(C_SIZES)
N_EXPERTS = 256
TOP_K = 8
N_GROUPS = 8
TOPK_GROUPS = 4
EXPERT_FF = 256
SHARED_FF = 256
ROUTED_SCALE = 2.5
MOE_BLOCK = 128
ALPHA = (2 * DEPTH) ** 0.25
BETA = (8 * DEPTH) ** -0.25
LN_EPS = 1e-5
RMS_EPS = 1e-6
N_EVEN = (DEPTH + 1) // 2
N_ODD = DEPTH // 2

kernel_name = "hgrn2_gla_mlstm_deepnorm_moe"


def _split(a, sizes):
    out, o = [], 0
    for s in sizes:
        out.append(a[..., o:o + s])
        o += s
    return out


def _heads(a, n):
    B, T, C = a.shape
    return a.reshape(B, T, n, C // n).transpose(0, 2, 1, 3)


def _layernorm(x, g, b):
    xf = x.astype(jnp.float32)
    mu = jnp.mean(xf, -1, keepdims=True)
    var = jnp.mean(jnp.square(xf - mu), -1, keepdims=True)
    return ((xf - mu) * lax.rsqrt(var + LN_EPS) * g.astype(jnp.float32) + b.astype(jnp.float32)).astype(x.dtype)


def _head_rmsnorm_gate(o, g, gate):
    B, H, T, dv = o.shape
    o = o * lax.rsqrt(jnp.mean(jnp.square(o), -1, keepdims=True) + RMS_EPS)
    o = o.transpose(0, 2, 1, 3).reshape(B, T, H * dv)
    return o * g.astype(jnp.float32) * jax.nn.silu(gate.astype(jnp.float32))


def _chunked_gla(q, k, v, log_a):
    B, H, T, dk = q.shape
    dv = v.shape[-1]
    L = LIN_CHUNK
    nc = T // L

    def to_chunks(a):
        return a.astype(jnp.float32).reshape(B, H, nc, L, a.shape[-1]).transpose(2, 0, 1, 3, 4)

    causal = jnp.tril(jnp.ones((L, L), dtype=bool))[:, :, None]

    def step(S, inp):
        qj, kj, vj, aj = inp
        b = jnp.cumsum(aj, axis=2)
        g = b[:, :, -1, :]
        diff = b[:, :, :, None, :] - b[:, :, None, :, :]
        decay = jnp.exp(jnp.where(causal, diff, -jnp.inf))
        scores = jnp.einsum('bhjsd,bhsd->bhjs', decay * qj[:, :, :, None, :], kj)
        o = (jnp.einsum('bhjs,bhsv->bhjv', scores, vj)
             + jnp.einsum('bhjd,bhdv->bhjv', qj * jnp.exp(b), S))
        S = (jnp.exp(g)[..., None] * S
             + jnp.einsum('bhsd,bhsv->bhdv', kj * jnp.exp(g[:, :, None, :] - b), vj))
        return S, o

    S0 = jnp.zeros((B, H, dk, dv), jnp.float32)
    _, o = lax.scan(step, S0, (to_chunks(q), to_chunks(k), to_chunks(v), to_chunks(log_a)))
    return o.transpose(1, 2, 0, 3, 4).reshape(B, H, T, dv)


def _chunked_mlstm(q, k, v, i_pre, log_f):
    B, H, T, dk = q.shape
    dv = v.shape[-1]
    L = MLSTM_CHUNK
    nc = T // L

    def to_chunks(a):
        return a.astype(jnp.float32).reshape(B, H, nc, L, a.shape[-1]).transpose(2, 0, 1, 3, 4)

    def gate_chunks(a):
        return a.astype(jnp.float32).reshape(B, H, nc, L).transpose(2, 0, 1, 3)

    causal = jnp.tril(jnp.ones((L, L), dtype=bool))

    def step(carry, inp):
        C, n, m = carry
        qj, kj, vj, ij, fj = inp
        b = jnp.cumsum(fj, axis=-1)
        g = b[..., -1]
        D = jnp.where(causal, b[..., :, None] - b[..., None, :] + ij[..., None, :], -jnp.inf)
        inter = b + m[..., None]
        m_j = jnp.maximum(inter, jnp.max(D, axis=-1))
        s = jnp.einsum('bhjd,bhsd->bhjs', qj, kj) * jnp.exp(D - m_j[..., None])
        w_inter = jnp.exp(inter - m_j)
        num = (jnp.einsum('bhjs,bhsv->bhjv', s, vj)
               + w_inter[..., None] * jnp.einsum('bhjd,bhdv->bhjv', qj, C))
        den = jnp.sum(s, -1) + w_inter * jnp.einsum('bhjd,bhd->bhj', qj, n)
        h = num / jnp.maximum(jnp.abs(den), jnp.exp(-m_j))[..., None]
        u = g[..., None] - b + ij
        m_new = jnp.maximum(g + m, jnp.max(u, -1))
        wk = kj * jnp.exp(u - m_new[..., None])[..., None]
        decay = jnp.exp(g + m - m_new)
        C = decay[..., None, None] * C + jnp.einsum('bhsd,bhsv->bhdv', wk, vj)
        n = decay[..., None] * n + jnp.sum(wk, axis=2)
        return (C, n, m_new), h

    init = (jnp.zeros((B, H, dk, dv), jnp.float32), jnp.zeros((B, H, dk), jnp.float32),
            jnp.zeros((B, H), jnp.float32))
    _, h = lax.scan(step, init, (to_chunks(q), to_chunks(k), to_chunks(v), gate_chunks(i_pre), gate_chunks(log_f)))
    return h.transpose(1, 2, 0, 3, 4).reshape(B, H, T, dv)


def _causal_conv(a, w):
    C = a.shape[-1]
    return lax.conv_general_dilated(a, w[:, None, :].astype(a.dtype), window_strides=(1,),
                                    padding=[(w.shape[0] - 1, 0)], dimension_numbers=('NWC', 'WIO', 'NWC'),
                                    feature_group_count=C)


def _hgrn2_gla_mixer(x, w_in, w_gk_up, b_gk, hgrn_g, gla_g, w_out, lb):
    proj = x @ w_in
    hq, hf, hi, hg, gq, gk, gv, gg, glr = _split(proj, AB_SIZES)
    z = hf.astype(jnp.float32)
    log_f = jnp.logaddexp(jnp.log(lb), jnp.log1p(-lb) + jax.nn.log_sigmoid(z))
    k_h = (1.0 - lb) * jax.nn.sigmoid(-z)
    o_h = _chunked_gla(_heads(jax.nn.silu(hq), HGRN_HEADS), _heads(k_h, HGRN_HEADS),
                       _heads(hi, HGRN_HEADS), _heads(log_f, HGRN_HEADS))
    log_a = jax.nn.log_sigmoid((glr @ w_gk_up + b_gk).astype(jnp.float32)) / GLA_GATE_NORMALIZER
    o_g = _chunked_gla(_heads(gq, GLA_HEADS) * (GLA_KEY_DIM ** -0.5), _heads(gk, GLA_HEADS),
                       _heads(gv, GLA_HEADS), _heads(log_a, GLA_HEADS))
    y = jnp.concatenate([_head_rmsnorm_gate(o_h, hgrn_g, hg), _head_rmsnorm_gate(o_g, gla_g, gg)], axis=-1)
    return y.astype(x.dtype) @ w_out


def _mlstm_mixer(x, w_in, conv_w, b_if, w_out):
    proj = x @ w_in
    qk, v, og, ig, fg = _split(proj, C_SIZES)
    qk = jax.nn.silu(_causal_conv(qk, conv_w))
    q, k = _split(qk, (MLSTM_QK_WIDTH, MLSTM_QK_WIDTH))
    i_pre = (ig.astype(jnp.float32) + b_if[:MLSTM_HEADS]).transpose(0, 2, 1)
    log_f = jax.nn.log_sigmoid(fg.astype(jnp.float32) + b_if[MLSTM_HEADS:]).transpose(0, 2, 1)
    h = _chunked_mlstm(_heads(q, MLSTM_HEADS), _heads(k, MLSTM_HEADS) * (MLSTM_QK_DIM ** -0.5),
                       _heads(v, MLSTM_HEADS), i_pre, log_f)
    B, H, T, dv = h.shape
    y = h.transpose(0, 2, 1, 3).reshape(B, T, H * dv) * jax.nn.sigmoid(og.astype(jnp.float32))
    return y.astype(x.dtype) @ w_out


def _moe(x2, w_router, r_bias, w_e_in, w_e_down, w_s_in, w_s_down):
    N, D = x2.shape
    E, G = N_EXPERTS, N_GROUPS
    scores = jax.nn.sigmoid((x2 @ w_router).astype(jnp.float32))
    biased = scores + r_bias.astype(jnp.float32)
    group_score = jnp.sum(lax.top_k(biased.reshape(N, G, E // G), 2)[0], -1)
    _, gidx = lax.top_k(group_score, TOPK_GROUPS)
    gsel = jnp.any(gidx[:, :, None] == jnp.arange(G)[None, None, :], axis=1)
    masked = jnp.where(jnp.repeat(gsel, E // G, axis=1), biased, -jnp.inf)
    _, eidx = lax.top_k(masked, TOP_K)
    w = jnp.take_along_axis(scores, eidx, axis=1)
    w = w / jnp.sum(w, -1, keepdims=True) * ROUTED_SCALE
    NK = N * TOP_K
    e_flat = eidx.reshape(-1)
    tok_flat = jnp.arange(NK, dtype=jnp.int32) // TOP_K
    order = jnp.argsort(e_flat)
    e_sorted, tok_sorted, w_sorted = e_flat[order], tok_flat[order], w.reshape(-1)[order]
    counts = jnp.bincount(e_flat, length=E)
    padded = (counts + MOE_BLOCK - 1) // MOE_BLOCK * MOE_BLOCK
    block_end = jnp.cumsum(padded)
    start_pad = block_end - padded
    start = jnp.cumsum(counts) - counts
    dest = start_pad[e_sorted] + jnp.arange(NK, dtype=jnp.int32) - start[e_sorted]
    n_blocks = (NK + E * (MOE_BLOCK - 1)) // MOE_BLOCK
    P = n_blocks * MOE_BLOCK
    row_tok = jnp.zeros((P,), jnp.int32).at[dest].set(tok_sorted).reshape(n_blocks, MOE_BLOCK)
    row_w = jnp.zeros((P,), jnp.float32).at[dest].set(w_sorted).reshape(n_blocks, MOE_BLOCK)
    block_expert = jnp.minimum(
        jnp.searchsorted(block_end, jnp.arange(n_blocks, dtype=jnp.int32) * MOE_BLOCK, side='right'), E - 1)

    def body(acc, inp):
        e, rows, rw = inp
        xb = x2[rows]
        gate, up = _split(xb @ w_e_in[e], (EXPERT_FF, EXPERT_FF))
        yb = (jax.nn.silu(gate) * up) @ w_e_down[e]
        return acc.at[rows].add(yb.astype(jnp.float32) * rw[:, None]), None

    routed, _ = lax.scan(body, jnp.zeros((N, D), jnp.float32), (block_expert, row_tok, row_w))
    sg, su = _split(x2 @ w_s_in, (SHARED_FF, SHARED_FF))
    shared = (jax.nn.silu(sg) * su) @ w_s_down
    return (routed + shared.astype(jnp.float32)).astype(x2.dtype)


def setup_inputs(seed: int = 0) -> dict:
    key = jax.random.key(seed)
    ks = jax.random.split(key, 24)
    f32 = jnp.float32

    def nrm(k, shape, scale):
        return jax.random.normal(k, shape, f32) * scale

    NE, NO = N_EVEN, N_ODD
    b_if_c = jnp.concatenate([
        nrm(ks[10], (NO, MLSTM_HEADS), 0.1),
        jnp.broadcast_to(jnp.linspace(3.0, 6.0, MLSTM_HEADS, dtype=f32), (NO, MLSTM_HEADS))
        + nrm(ks[11], (NO, MLSTM_HEADS), 0.1)], axis=-1)
    return {
        "x": nrm(ks[0], (BATCH, SEQ, D_MODEL), 1.0),
        "w_in_ab": nrm(ks[1], (NE, D_MODEL, AB_WIDTH), D_MODEL ** -0.5),
        "w_gla_gate_up": nrm(ks[2], (NE, GLA_GATE_RANK, GLA_KEY_WIDTH), GLA_GATE_RANK ** -0.5),
        "b_gla_gate": nrm(ks[3], (NE, GLA_KEY_WIDTH), 0.02),
        "hgrn_norm_g": 1.0 + nrm(ks[4], (NE, HGRN_WIDTH), 0.02),
        "gla_norm_g": 1.0 + nrm(ks[5], (NE, GLA_VAL_WIDTH), 0.02),
        "w_out_ab": nrm(ks[6], (NE, AB_OUT_WIDTH, D_MODEL), AB_OUT_WIDTH ** -0.5 * BETA),
        "hgrn_lb_logits": nrm(ks[7], (DEPTH + 1, HGRN_WIDTH), 0.1),
        "w_in_c": nrm(ks[8], (NO, D_MODEL, C_WIDTH), D_MODEL ** -0.5),
        "conv_c": nrm(ks[9], (NO, MLSTM_CONV, 2 * MLSTM_QK_WIDTH), MLSTM_CONV ** -0.5),
        "b_if_c": b_if_c,
        "w_out_c": nrm(ks[12], (NO, MLSTM_V_WIDTH, D_MODEL), MLSTM_V_WIDTH ** -0.5 * BETA),
        "w_router": nrm(ks[13], (DEPTH, D_MODEL, N_EXPERTS), D_MODEL ** -0.5),
        "router_bias": nrm(ks[14], (DEPTH, N_EXPERTS), 0.01),
        "w_exp_in": nrm(ks[15], (DEPTH, N_EXPERTS, D_MODEL, 2 * EXPERT_FF), D_MODEL ** -0.5),
        "w_exp_down": nrm(ks[16], (DEPTH, N_EXPERTS, EXPERT_FF, D_MODEL), EXPERT_FF ** -0.5 * BETA),
        "w_sh_in": nrm(ks[17], (DEPTH, D_MODEL, 2 * SHARED_FF), D_MODEL ** -0.5),
        "w_sh_down": nrm(ks[18], (DEPTH, SHARED_FF, D_MODEL), SHARED_FF ** -0.5 * BETA),
        "ln_mix_g": 1.0 + nrm(ks[19], (DEPTH, D_MODEL), 0.02),
        "ln_mix_b": nrm(ks[20], (DEPTH, D_MODEL), 0.02),
        "ln_ffn_g": 1.0 + nrm(ks[21], (DEPTH, D_MODEL), 0.02),
        "ln_ffn_b": nrm(ks[22], (DEPTH, D_MODEL), 0.02),
    }


def reference(x, w_in_ab, w_gla_gate_up, b_gla_gate, hgrn_norm_g, gla_norm_g, w_out_ab, hgrn_lb_logits,
              w_in_c, conv_c, b_if_c, w_out_c, w_router, router_bias, w_exp_in, w_exp_down,
              w_sh_in, w_sh_down, ln_mix_g, ln_mix_b, ln_ffn_g, ln_ffn_b):
    B, T, D = x.shape
    lower_bounds = jnp.cumsum(jax.nn.softmax(hgrn_lb_logits.astype(jnp.float32), axis=0), axis=0)
    h = x
    for l in range(DEPTH):
        j = l // 2
        if l % 2 == 0:
            mix = _hgrn2_gla_mixer(h, w_in_ab[j], w_gla_gate_up[j], b_gla_gate[j], hgrn_norm_g[j],
                                   gla_norm_g[j], w_out_ab[j], lower_bounds[l])
        else:
            mix = _mlstm_mixer(h, w_in_c[j], conv_c[j], b_if_c[j].astype(jnp.float32), w_out_c[j])
        h = _layernorm(ALPHA * h + mix, ln_mix_g[l], ln_mix_b[l])
        ffn = _moe(h.reshape(B * T, D), w_router[l], router_bias[l], w_exp_in[l], w_exp_down[l],
                   w_sh_in[l], w_sh_down[l]).reshape(B, T, D)
        h = _layernorm(ALPHA * h + ffn, ln_ffn_g[l], ln_ffn_b[l])
    return h
```

```cpp
#include <hip/hip_runtime.h>
#include <cstdio>
#include <cstdint>

#ifndef MK_ONE_LAUNCH
#define MK_ONE_LAUNCH 1
#endif

#define LAS __attribute__((address_space(3)))
typedef unsigned short bf16_t;
typedef short bf16x8 __attribute__((ext_vector_type(8)));
typedef float f32x4 __attribute__((ext_vector_type(4)));
typedef unsigned u32x4 __attribute__((ext_vector_type(4)));
typedef unsigned u32x2 __attribute__((ext_vector_type(2)));

constexpr int NTOK = 32768, SEQ = 16384, DM = 1024;
constexpr int ABW = 3840;
constexpr int CWID = 3072;
constexpr int NEXP = 256, NE1 = 257, TOPK = 8, NSLOT = 9;
constexpr float ALPHA = 1.41421356237f;
constexpr int NWG = 256;
constexpr int PRMAX = 262144 + 65536 + 32768;

constexpr size_t MiB = 1u << 20;
constexpr size_t WS_CTL = 0, CTL_BYTES = 1 * MiB;
constexpr size_t WS_MISC = 1 * MiB;
constexpr size_t WS_WAB = 2 * MiB, WS_WOAB = 10 * MiB, WS_WC = 12 * MiB, WS_WOC = 18 * MiB, WS_WR = 20 * MiB;
constexpr size_t WS_TOKE = 22 * MiB, WS_TOKP = 23 * MiB, WS_TOKW = 24 * MiB;
constexpr size_t WS_STOK = 26 * MiB, WS_POSY = 28 * MiB;
constexpr size_t WS_GATES = 32 * MiB;
constexpr size_t WS_UST = 34 * MiB, WS_GSUM = 54 * MiB;
constexpr size_t WS_LOGITS = 56 * MiB;
constexpr size_t WS_HB = 96 * MiB, WS_PROJ = 160 * MiB, WS_YMIX = 400 * MiB, WS_Z = 464 * MiB, WS_H1 = 528 * MiB, WS_H2 = 592 * MiB;
constexpr size_t WS_ACT = 656 * MiB, WS_Y = 832 * MiB, WS_W1T = 1540 * MiB, WS_W2T = 2056 * MiB, WS_END = 2320 * MiB;
constexpr int CW_BAR = 4096;
constexpr int CW_CNT = 16384;
constexpr int CW_DBG = 20480;

__device__ __forceinline__ unsigned pk2(float lo, float hi) { unsigned r; asm volatile("v_cvt_pk_bf16_f32 %0, %1, %2" : "=v"(r) : "v"(lo), "v"(hi)); return r; }
__device__ __forceinline__ float bflo(unsigned u) { return __uint_as_float(u << 16); }
__device__ __forceinline__ float bfhi(unsigned u) { return __uint_as_float(u & 0xffff0000u); }
__device__ __forceinline__ float bf2f(bf16_t b) { return __uint_as_float(((unsigned)b) << 16); }
__device__ __forceinline__ float sigm(float x) { return 1.f / (1.f + __expf(-x)); }
__device__ __forceinline__ float silu(float x) { return x / (1.f + __expf(-x)); }
__device__ __forceinline__ float logsig(float x) { return fminf(x, 0.f) - __logf(1.f + __expf(-fabsf(x))); }

#define XB_TMO      128
#define XB_XCNT(j)  (256  + 64 * (j))
#define XB_XSUB(j)  (1280 + 64 * (j))
#define XB_XGEN(j)  (2304 + 64 * (j))
#define XB_TOP      3328
#define XB_TOPGEN   3392
#define XCD_BAR_WORDS 3456
#define XB_SPIN_CAP (1u << 22)
__device__ __forceinline__ unsigned xb_ld(unsigned* p)              { return __hip_atomic_load(p, __ATOMIC_RELAXED, __HIP_MEMORY_SCOPE_AGENT); }
__device__ __forceinline__ unsigned xb_add(unsigned* p, unsigned v) { return __hip_atomic_fetch_add(p, v, __ATOMIC_RELAXED, __HIP_MEMORY_SCOPE_AGENT); }
__device__ __forceinline__ unsigned xb_xcc_id() { return (unsigned)__builtin_amdgcn_s_getreg((3 << 11) | 20) & 0xFu; }
#define XB_SPIN(cond, bar) do { unsigned _sp = 0; while (cond) { __builtin_amdgcn_s_sleep(1); \
    if ((++_sp & 255u) == 0u) { if (xb_ld(&(bar)[XB_TMO])) break; if (_sp > XB_SPIN_CAP) { atomicAdd(&(bar)[XB_TMO], 1u); break; } } } } while (0)
struct XcdBarrier { unsigned* bar; unsigned x; volatile LAS unsigned* st; };
__device__ __forceinline__ XcdBarrier xcd_barrier_post(unsigned* bar, volatile LAS unsigned* st) {
    XcdBarrier b; b.bar = bar; b.x = xb_xcc_id(); b.st = st;
    if (threadIdx.x == 0) (void)xb_add(&bar[XB_XCNT(b.x)], 1u);
    return b;
}
__device__ __forceinline__ void xcd_barrier_complete(unsigned* bar, unsigned x, unsigned& nloc, unsigned& nx) {
    const unsigned G = gridDim.x * gridDim.y * gridDim.z;
    unsigned sum, cnt, mine, sp = 0u;
    for (;;) {
        sum = 0u; cnt = 0u; mine = 0u;
#pragma unroll
        for (unsigned j = 0; j < 16; ++j) { const unsigned c = xb_ld(&bar[XB_XCNT(j)]); sum += c; cnt += (c > 0u) ? 1u : 0u; mine = (j == x) ? c : mine; }
        if (sum == G) break;
        __builtin_amdgcn_s_sleep(1);
        if ((++sp & 255u) == 0u) { if (xb_ld(&bar[XB_TMO])) break; if (sp > XB_SPIN_CAP) { atomicAdd(&bar[XB_TMO], 1u); break; } }
    }
    nloc = mine > 0u ? mine : 1u; nx = cnt > 0u ? cnt : 1u;
}
__device__ __forceinline__ void xcd_barrier(const XcdBarrier& b) {
    asm volatile("s_waitcnt vmcnt(0)" ::: "memory");
    __syncthreads();
    if (threadIdx.x == 0) {
        unsigned* bar = b.bar;
        __builtin_amdgcn_s_waitcnt(0);
        unsigned nloc = b.st[0], nx = b.st[1];
        if (nloc == 0u) { xcd_barrier_complete(bar, b.x, nloc, nx); b.st[0] = nloc; b.st[1] = nx; }
        const unsigned old = xb_add(&bar[XB_XSUB(b.x)], 1u);
        const unsigned gen = old / nloc;
        if (old + 1u == (gen + 1u) * nloc) {
            __builtin_amdgcn_fence(__ATOMIC_RELEASE, "agent");
            asm volatile("s_waitcnt vmcnt(0)" ::: "memory");
            const unsigned og = xb_add(&bar[XB_TOP], 1u);
            const unsigned tg = og / nx;
            if (og + 1u == (tg + 1u) * nx) xb_add(&bar[XB_TOPGEN], 1u);
            else XB_SPIN(xb_ld(&bar[XB_TOPGEN]) == tg, bar);
            __builtin_amdgcn_fence(__ATOMIC_ACQUIRE, "agent");
            xb_add(&bar[XB_XGEN(b.x)], 1u);
            asm volatile("s_waitcnt vmcnt(0)" ::: "memory");
        } else {
            XB_SPIN(xb_ld(&bar[XB_XGEN(b.x)]) == gen, bar);
            __builtin_amdgcn_fence(__ATOMIC_ACQUIRE, "agent");
            asm volatile("s_waitcnt vmcnt(0)" ::: "memory");
        }
    }
    __syncthreads();
}

namespace pg8 {
constexpr int BM = 256, BK = 64, HALF = 128, HTB = HALF * BK * 2, STAGE_BYTES = 8 * HTB, NXCD = 8, WGM = 8;
__device__ __forceinline__ int lds_byte(int r, int c) { const int st = (r >> 4) * 2 + (c >> 5), rr = r & 15, cc = c & 31, ob = rr * 64 + cc * 2; return st * 1024 + (ob ^ (((ob >> 9) & 1) << 5)); }
__device__ __forceinline__ void stage_rc(int b, int& R, int& C) { const int st = b / 1024, sb = b % 1024, swz = sb ^ (((sb >> 9) & 1) << 5); R = (st >> 1) * 16 + swz / 64; C = (st & 1) * 32 + (swz % 64) / 2; }
__device__ __forceinline__ int perm32(int rho) { const int n = rho >> 4, i = rho & 15; return 8 * (i >> 2) + 4 * n + (i & 3); }
struct Unit { int pm, pn; };
struct Gemm { const bf16_t* A; const bf16_t* Bt; int K; };

struct StaticOrder {
    int nM, nN, nwg, G, c;
    __device__ void init(int M, int N, int G_, int c_) { nM = M / BM; nN = N / BM; nwg = nM * nN; G = G_; c = c_; }
    __device__ bool next(int i, Unit& u) const {
        const long L = (long)i * G + c; if (L >= nwg) return false;
        int wgid = (int)L; { const int q = nwg / NXCD, r = nwg % NXCD, xcd = wgid % NXCD, off = wgid / NXCD; wgid = (xcd < r ? xcd * (q + 1) : r * (q + 1) + (xcd - r) * q) + off; }
        const int nig = WGM * nN, gid = wgid / nig, fm = gid * WGM, gsz = (nM - fm) < WGM ? (nM - fm) : WGM;
        u.pm = fm + ((wgid % nig) % gsz); u.pn = (wgid % nig) / gsz; return true;
    }
};
struct MoeOrder {
    const int* tile_exp; int nunits, sh, G, c;
    __device__ bool next(int i, Unit& u) const {
        const long L = (long)i * G + c; if (L >= nunits) return false;
        const int rt = (int)(L >> sh), j = (int)L & ((1 << sh) - 1);
        const int e = __builtin_amdgcn_readfirstlane(tile_exp[rt]);
        u.pm = rt; u.pn = (e << sh) + j; return true;
    }
};

template <class Epi, class Sched, bool GATHER>
__device__ __forceinline__ void gemm_phase(LAS unsigned char* lds, const Gemm g, const int* __restrict__ rowidx, const Sched& S, const Epi& E) {
    const int tid = threadIdx.x, wid = __builtin_amdgcn_readfirstlane(tid >> 6), lane = tid & 63, wr = wid >> 2, wc = wid & 3, fr = lane & 15, fq = lane >> 4;
    const int K = g.K, nt = K / BK;
    unsigned voffB[2], cofs[2]; int Rr[2];
#pragma unroll
    for (int i = 0; i < 2; ++i) { int R, C; stage_rc(tid * 16 + i * 8192, R, C); const int Rb = Epi::PERM ? ((R & ~31) + perm32(R & 31)) : R;
        Rr[i] = R; cofs[i] = (unsigned)C * 2u; voffB[i] = (unsigned)(Rb * K + C) * 2u; }
    const unsigned rowb = (unsigned)K * 2u;
    const size_t kstep = (size_t)(BK * 2);
    const size_t hstep = (size_t)HALF * K * 2;
    const size_t tstep = 2 * hstep;
    const unsigned ldsw = (unsigned)wid * 1024u;
    const int aoff = lds_byte(wr * 64 + fr, fq * 8), boff = lds_byte(wc * 32 + fr, fq * 8);
    const char* Abase = (const char*)g.A;
#define PG8_SA(b, h) (((b) * 2 + (h)) * HTB)
#define PG8_SB(b, h) ((4 + (b) * 2 + (h)) * HTB)
#define PG8_STAGE(bufoff, gbase, voff) do { _Pragma("unroll") for (int _i = 0; _i < 2; ++_i) \
        __builtin_amdgcn_global_load_lds((const unsigned*)((const char*)(gbase) + (voff)[_i]), (LAS unsigned*)(lds + (bufoff) + ldsw + _i * 8192), 16, 0, 0); } while (0)
#define PG8_STAGEA(bufoff, kb, offs) do { _Pragma("unroll") for (int _i = 0; _i < 2; ++_i) \
        __builtin_amdgcn_global_load_lds((const unsigned*)(Abase + (size_t)((kb) + (offs)[_i])), (LAS unsigned*)(lds + (bufoff) + ldsw + _i * 8192), 16, 0, 0); } while (0)
#define PG8_ROWOFF(u, O) do { _Pragma("unroll") for (int _h = 0; _h < 2; ++_h) _Pragma("unroll") for (int _i = 0; _i < 2; ++_i) { \
        int _row = (u).pm * BM + _h * HALF + Rr[_i]; if (GATHER) _row = rowidx[_row]; (O)[_h][_i] = (unsigned)_row * rowb + cofs[_i]; } } while (0)
#define PG8_LDA(dst, b, h) do { _Pragma("unroll") for (int m = 0; m < 4; ++m) _Pragma("unroll") for (int k = 0; k < 2; ++k) dst[m][k] = *(const LAS bf16x8*)(lds + PG8_SA(b, h) + aoff + m * 2048 + k * 1024); } while (0)
#define PG8_LDB(dst, b, h) do { _Pragma("unroll") for (int n = 0; n < 2; ++n) _Pragma("unroll") for (int k = 0; k < 2; ++k) dst[n][k] = *(const LAS bf16x8*)(lds + PG8_SB(b, h) + boff + n * 2048 + k * 1024); } while (0)
#define PG8_MMA(ai, bj, At, Bt) do { __builtin_amdgcn_s_setprio(1); _Pragma("unroll") for (int m = 0; m < 4; ++m) _Pragma("unroll") for (int n = 0; n < 2; ++n) _Pragma("unroll") for (int k = 0; k < 2; ++k) \
        acc[ai][bj][m][n] = __builtin_amdgcn_mfma_f32_16x16x32_bf16(Bt[n][k], At[m][k], acc[ai][bj][m][n], 0, 0, 0); __builtin_amdgcn_s_setprio(0); } while (0)
#define PG8_WAIT_V(n) asm volatile("s_waitcnt vmcnt(" #n ")" ::: "memory")
#define PG8_WAIT_L(n) asm volatile("s_waitcnt lgkmcnt(" #n ")" ::: "memory")
#define PG8_BAR __builtin_amdgcn_s_barrier()
#define PG8_SCHED __builtin_amdgcn_sched_barrier(0)
    Unit cur, nxt; int ui = 0;
    if (!S.next(0, cur)) return;
    f32x4 acc[2][2][4][2];
#pragma unroll
    for (int a = 0; a < 2; ++a)
#pragma unroll
        for (int b = 0; b < 2; ++b)
#pragma unroll
            for (int m = 0; m < 4; ++m)
#pragma unroll
                for (int n = 0; n < 2; ++n) acc[a][b][m][n] = (f32x4){0.f, 0.f, 0.f, 0.f};
    bf16x8 At[4][2], B0[2][2], B1[2][2];
    unsigned cO[2][2], nO[2][2];
    PG8_ROWOFF(cur, cO);
    const char* cB = (const char*)g.Bt + (size_t)cur.pn * tstep;
    PG8_STAGE(PG8_SB(0, 0), cB, voffB); PG8_STAGE(PG8_SB(0, 1), cB + hstep, voffB); PG8_STAGEA(PG8_SA(0, 0), 0u, cO[0]); PG8_STAGEA(PG8_SA(0, 1), 0u, cO[1]);
    if (wr == 1) PG8_BAR;
    PG8_WAIT_V(2); PG8_BAR;
    PG8_STAGE(PG8_SB(1, 0), cB + kstep, voffB); PG8_STAGEA(PG8_SA(1, 0), (unsigned)kstep, cO[0]); PG8_STAGE(PG8_SB(1, 1), cB + hstep + kstep, voffB);
    PG8_WAIT_V(6); PG8_BAR;
    for (;;) {
        const bool has_next = S.next(ui + 1, nxt);
        const char* nB = has_next ? (const char*)g.Bt + (size_t)nxt.pn * tstep : cB;
#pragma unroll
        for (int h = 0; h < 2; ++h)
#pragma unroll
            for (int i = 0; i < 2; ++i) nO[h][i] = cO[h][i];
#pragma unroll 1
        for (int t = 0; t < nt; t += 2) {
            const bool last = (t == nt - 2);
            if (last && has_next) PG8_ROWOFF(nxt, nO);
            const unsigned k1 = (unsigned)(t + 1) * (unsigned)kstep;
            const unsigned k2 = last ? 0u : (unsigned)(t + 2) * (unsigned)kstep, k3 = k2 + (unsigned)kstep;
            const char* b2 = last ? nB : cB + (size_t)(t + 2) * kstep; const char* b3 = b2 + kstep;
            unsigned o2[2][2];
#pragma unroll
            for (int h = 0; h < 2; ++h)
#pragma unroll
                for (int i = 0; i < 2; ++i) o2[h][i] = last ? nO[h][i] : cO[h][i];
            PG8_LDB(B0, 0, 0); PG8_LDB(B1, 0, 1); PG8_SCHED; PG8_LDA(At, 0, 0); PG8_STAGEA(PG8_SA(1, 1), k1, cO[1]);
            PG8_WAIT_V(8); PG8_WAIT_L(0); PG8_BAR; PG8_MMA(0, 0, At, B0); PG8_MMA(0, 1, At, B1); PG8_BAR; PG8_SCHED;
            PG8_LDA(At, 0, 1); PG8_STAGE(PG8_SB(0, 0), b2, voffB); PG8_STAGE(PG8_SB(0, 1), b2 + hstep, voffB); PG8_STAGEA(PG8_SA(0, 0), k2, o2[0]);
            PG8_WAIT_V(8); PG8_WAIT_L(0); PG8_BAR; PG8_MMA(1, 0, At, B0); PG8_MMA(1, 1, At, B1); PG8_BAR; PG8_SCHED;
            PG8_LDB(B0, 1, 0); PG8_LDB(B1, 1, 1); PG8_SCHED; PG8_LDA(At, 1, 0); PG8_STAGEA(PG8_SA(0, 1), k2, o2[1]);
            PG8_WAIT_V(8); PG8_WAIT_L(0); PG8_BAR; PG8_MMA(0, 0, At, B0); PG8_MMA(0, 1, At, B1); PG8_BAR; PG8_SCHED;
            PG8_LDA(At, 1, 1); PG8_STAGE(PG8_SB(1, 0), b3, voffB); PG8_STAGE(PG8_SB(1, 1), b3 + hstep, voffB); PG8_STAGEA(PG8_SA(1, 0), k3, o2[0]);
            PG8_WAIT_V(8); PG8_WAIT_L(0); PG8_BAR; PG8_MMA(1, 0, At, B0); PG8_MMA(1, 1, At, B1); PG8_BAR; PG8_SCHED;
        }
        if (wr == 0) PG8_BAR;
        E(acc, cur, wr, wc, fr, fq);
        if (!has_next) break;
#pragma unroll
        for (int a = 0; a < 2; ++a)
#pragma unroll
            for (int b = 0; b < 2; ++b)
#pragma unroll
                for (int m = 0; m < 4; ++m)
#pragma unroll
                    for (int n = 0; n < 2; ++n) acc[a][b][m][n] = (f32x4){0.f, 0.f, 0.f, 0.f};
        cur = nxt; cB = nB; ++ui;
#pragma unroll
        for (int h = 0; h < 2; ++h)
#pragma unroll
            for (int i = 0; i < 2; ++i) cO[h][i] = nO[h][i];
        if (wr == 1) PG8_BAR;
    }
    PG8_WAIT_V(0);
    PG8_BAR;
#undef PG8_SA
#undef PG8_SB
#undef PG8_STAGE
#undef PG8_STAGEA
#undef PG8_ROWOFF
#undef PG8_LDA
#undef PG8_LDB
#undef PG8_MMA
#undef PG8_WAIT_V
#undef PG8_WAIT_L
#undef PG8_BAR
#undef PG8_SCHED
}

struct EpiStoreBf16 {
    static constexpr bool PERM = true;
    bf16_t* O; int ldc;
    __device__ __forceinline__ void operator()(const f32x4 (&acc)[2][2][4][2], const Unit& u, int wr, int wc, int fr, int fq) const {
        const int row0 = u.pm * BM + wr * 64 + fr, col0 = u.pn * BM + wc * 32 + 8 * fq;
#pragma unroll
        for (int ai = 0; ai < 2; ++ai)
#pragma unroll
            for (int m = 0; m < 4; ++m) { bf16_t* rowp = O + (size_t)(row0 + ai * HALF + m * 16) * ldc + col0;
#pragma unroll
                for (int bj = 0; bj < 2; ++bj) { const f32x4 v0 = acc[ai][bj][m][0], v1 = acc[ai][bj][m][1];
                    u32x4 w; w.x = pk2(v0[0], v0[1]); w.y = pk2(v0[2], v0[3]); w.z = pk2(v1[0], v1[1]); w.w = pk2(v1[2], v1[3]);
                    *(u32x4*)(rowp + bj * HALF) = w; } }
    }
};
struct EpiResid {
    static constexpr bool PERM = true;
    bf16_t* Z; const bf16_t* H;
    __device__ __forceinline__ void operator()(const f32x4 (&acc)[2][2][4][2], const Unit& u, int wr, int wc, int fr, int fq) const {
        const int row0 = u.pm * BM + wr * 64 + fr, col0 = u.pn * BM + wc * 32 + 8 * fq;
#pragma unroll
        for (int ai = 0; ai < 2; ++ai)
#pragma unroll
            for (int m = 0; m < 4; ++m) { const size_t ro = (size_t)(row0 + ai * HALF + m * 16) * DM + col0;
#pragma unroll
                for (int bj = 0; bj < 2; ++bj) { const f32x4 v0 = acc[ai][bj][m][0], v1 = acc[ai][bj][m][1];
                    const u32x4 hh = *(const u32x4*)(H + ro + bj * HALF);
                    u32x4 w;
                    w.x = pk2(ALPHA * bflo(hh.x) + v0[0], ALPHA * bfhi(hh.x) + v0[1]); w.y = pk2(ALPHA * bflo(hh.y) + v0[2], ALPHA * bfhi(hh.y) + v0[3]);
                    w.z = pk2(ALPHA * bflo(hh.z) + v1[0], ALPHA * bfhi(hh.z) + v1[1]); w.w = pk2(ALPHA * bflo(hh.w) + v1[2], ALPHA * bfhi(hh.w) + v1[3]);
                    *(u32x4*)(Z + ro + bj * HALF) = w; } }
    }
};
struct EpiF32 {
    static constexpr bool PERM = false;
    float* C;
    __device__ __forceinline__ void operator()(const f32x4 (&acc)[2][2][4][2], const Unit& u, int wr, int wc, int fr, int fq) const {
        const int row0 = u.pm * BM + wr * 64 + fr, col0 = wc * 32 + 4 * fq;
#pragma unroll
        for (int ai = 0; ai < 2; ++ai)
#pragma unroll
            for (int m = 0; m < 4; ++m) { float* rowp = C + (size_t)(row0 + ai * HALF + m * 16) * 256 + col0;
#pragma unroll
                for (int bj = 0; bj < 2; ++bj)
#pragma unroll
                    for (int n = 0; n < 2; ++n) *(f32x4*)(rowp + bj * HALF + n * 16) = acc[ai][bj][m][n]; }
    }
};
struct EpiSwiGLU {
    static constexpr bool PERM = true;
    bf16_t* ACT;
    __device__ __forceinline__ void operator()(const f32x4 (&acc)[2][2][4][2], const Unit& u, int wr, int wc, int fr, int fq) const {
        const int row0 = u.pm * BM + wr * 64 + fr, col0 = (u.pn & 1) * 128 + wc * 32 + 8 * fq;
#pragma unroll
        for (int ai = 0; ai < 2; ++ai)
#pragma unroll
            for (int m = 0; m < 4; ++m) { bf16_t* rowp = ACT + (size_t)(row0 + ai * HALF + m * 16) * 256 + col0;
                const f32x4 g0 = acc[ai][0][m][0], g1 = acc[ai][0][m][1], u0 = acc[ai][1][m][0], u1 = acc[ai][1][m][1];
                u32x4 w; w.x = pk2(silu(g0[0]) * u0[0], silu(g0[1]) * u0[1]); w.y = pk2(silu(g0[2]) * u0[2], silu(g0[3]) * u0[3]);
                w.z = pk2(silu(g1[0]) * u1[0], silu(g1[1]) * u1[1]); w.w = pk2(silu(g1[2]) * u1[2], silu(g1[3]) * u1[3]);
                *(u32x4*)rowp = w; }
    }
};
struct EpiDown {
    static constexpr bool PERM = true;
    bf16_t* Y;
    __device__ __forceinline__ void operator()(const f32x4 (&acc)[2][2][4][2], const Unit& u, int wr, int wc, int fr, int fq) const {
        const int row0 = u.pm * BM + wr * 64 + fr, col0 = (u.pn & 3) * 256 + wc * 32 + 8 * fq;
#pragma unroll
        for (int ai = 0; ai < 2; ++ai)
#pragma unroll
            for (int m = 0; m < 4; ++m) { bf16_t* rowp = Y + (size_t)(row0 + ai * HALF + m * 16) * DM + col0;
#pragma unroll
                for (int bj = 0; bj < 2; ++bj) { const f32x4 v0 = acc[ai][bj][m][0], v1 = acc[ai][bj][m][1];
                    u32x4 w; w.x = pk2(v0[0], v0[1]); w.y = pk2(v0[2], v0[3]); w.z = pk2(v1[0], v1[1]); w.w = pk2(v1[2], v1[3]);
                    *(u32x4*)(rowp + bj * HALF) = w; } }
    }
};
}

struct Args { const float* in[22]; float* out; unsigned char* ws; int ph_lo, ph_hi; };
enum { I_X = 0, I_WINAB, I_WGKUP, I_BGK, I_HG, I_GG, I_WOAB, I_LB, I_WINC, I_CONV, I_BIF, I_WOC, I_WR, I_RB, I_WEI, I_WED, I_WSI, I_WSD, I_LMG, I_LMB, I_LFG, I_LFB };

constexpr int LDS_MISC = 147200;
constexpr int LDS_BYTES = 147456;

__device__ __forceinline__ void cvt_tile(LAS unsigned char* lds, const float* __restrict__ src, size_t ldn, int k0, int n0, bf16_t* __restrict__ dst, int K, int drow0) {
    const int t = threadIdx.x;
    { const int c4 = (t & 15) * 4, r2 = t >> 4;
      const f32x4 a = *(const f32x4*)(src + (size_t)(k0 + 2 * r2) * ldn + n0 + c4);
      const f32x4 b = *(const f32x4*)(src + (size_t)(k0 + 2 * r2 + 1) * ldn + n0 + c4);
#pragma unroll
      for (int i = 0; i < 4; ++i) *(LAS unsigned*)(lds + ((c4 + i) * 72 + 2 * r2) * 2) = pk2(a[i], b[i]); }
    __syncthreads();
    { const int kk = (t & 7) * 8, n = t >> 3;
      const u32x4 v = *(const LAS u32x4*)(lds + (n * 72 + kk) * 2);
      *(u32x4*)(dst + (size_t)(drow0 + n) * K + k0 + kk) = v; }
    __syncthreads();
}
__device__ __forceinline__ void cvt_matrix(LAS unsigned char* lds, const float* src, size_t ldn, int K, int n_lo, int ncols, bf16_t* dst, int drow_lo, int bid, int nb) {
    const int tk = K / 64, tn = ncols / 64;
    for (int j = bid; j < tk * tn; j += nb) { const int a = j / tn, b = j % tn; cvt_tile(lds, src, ldn, a * 64, n_lo + b * 64, dst, K, drow_lo + b * 64); }
}
__device__ __forceinline__ void phase_prologue(LAS unsigned char* lds, const Args& A, int bid, int nb) {
    unsigned char* ws = A.ws; const int tid = threadIdx.x;
    if (bid == 0) {
        float* lb0 = (float*)(ws + WS_MISC);
        const float* l = A.in[I_LB];
        if (tid < 512) { const float a = l[tid], b = l[512 + tid], c = l[1024 + tid]; const float m = fmaxf(a, fmaxf(b, c));
            const float ea = __expf(a - m), eb = __expf(b - m), ec = __expf(c - m); lb0[tid] = ea / (ea + eb + ec); }
    }
    if (bid == 1 % nb) {
        float* wg = (float*)(ws + WS_MISC + 4096);
        for (int i = tid; i < 8 * 1024; i += 512) { const int g = i >> 10, k = i & 1023; wg[i] = A.in[I_WINC][(size_t)k * 3080 + 3072 + g]; }
    }
    { const float* x = A.in[I_X]; bf16_t* hb = (bf16_t*)(ws + WS_HB);
      for (size_t i = ((size_t)bid * 512 + tid) * 8; i < (size_t)NTOK * DM; i += (size_t)nb * 512 * 8) {
          const f32x4 a = *(const f32x4*)(x + i), b = *(const f32x4*)(x + i + 4);
          u32x4 w; w.x = pk2(a[0], a[1]); w.y = pk2(a[2], a[3]); w.z = pk2(b[0], b[1]); w.w = pk2(b[2], b[3]);
          *(u32x4*)(hb + i) = w; } }
    { bf16_t* wab = (bf16_t*)(ws + WS_WAB); const float* win = A.in[I_WINAB]; const float* wup = A.in[I_WGKUP];
      for (int o = bid * 512 + tid; o < 256 * 128; o += nb * 512) { const int j = o >> 7, k8 = (o & 127) * 8;
          float up[16];
#pragma unroll
          for (int r = 0; r < 16; ++r) up[r] = wup[r * 256 + j];
          float res[8];
#pragma unroll
          for (int q = 0; q < 8; ++q) { const float* wr_ = win + (size_t)(k8 + q) * 3600 + 3584; float s = 0.f;
#pragma unroll
              for (int r = 0; r < 16; ++r) s += wr_[r] * up[r];
              res[q] = s; }
          u32x4 w; w.x = pk2(res[0], res[1]); w.y = pk2(res[2], res[3]); w.z = pk2(res[4], res[5]); w.w = pk2(res[6], res[7]);
          *(u32x4*)(wab + (size_t)(3584 + j) * 1024 + k8) = w; } }
    cvt_matrix(lds, A.in[I_WINAB], 3600, 1024, 0, 3584, (bf16_t*)(ws + WS_WAB), 0, bid, nb);
    cvt_matrix(lds, A.in[I_WOAB], 1024, 1024, 0, 1024, (bf16_t*)(ws + WS_WOAB), 0, bid, nb);
    cvt_matrix(lds, A.in[I_WINC], 3080, 1024, 0, 3072, (bf16_t*)(ws + WS_WC), 0, bid, nb);
    cvt_matrix(lds, A.in[I_WOC], 1024, 1024, 0, 1024, (bf16_t*)(ws + WS_WOC), 0, bid, nb);
    cvt_matrix(lds, A.in[I_WR], 256, 1024, 0, 256, (bf16_t*)(ws + WS_WR), 0, bid, nb);
    cvt_matrix(lds, A.in[I_WR] + 1024 * 256, 256, 1024, 0, 256, (bf16_t*)(ws + WS_WR) + 256 * 1024, 0, bid, nb);
    for (int j = bid; j < 2 * NE1 * 192; j += nb) {
        const int le = j / 192, t = j % 192, layer = le / NE1, e = le % NE1;
        if (t < 128) {
            const float* src = (e < NEXP) ? A.in[I_WEI] + ((size_t)(layer * NEXP + e)) * 1024 * 512 : A.in[I_WSI] + (size_t)layer * 1024 * 512;
            bf16_t* dst = (bf16_t*)(ws + WS_W1T) + ((size_t)(layer * NE1 + e)) * 512 * 1024;
            const int tk = t >> 3, tn = t & 7, n0 = tn * 64;
            const int half = n0 >> 8, nn = n0 & 255, drow = (nn >> 7) * 256 + half * 128 + (nn & 127);
            cvt_tile(lds, src, 512, tk * 64, n0, dst, 1024, drow);
        } else {
            const int t2 = t - 128;
            const float* src = (e < NEXP) ? A.in[I_WED] + ((size_t)(layer * NEXP + e)) * 256 * 1024 : A.in[I_WSD] + (size_t)layer * 256 * 1024;
            bf16_t* dst = (bf16_t*)(ws + WS_W2T) + ((size_t)(layer * NE1 + e)) * 1024 * 256;
            const int tk = t2 >> 4, tn = t2 & 15;
            cvt_tile(lds, src, 1024, tk * 64, tn * 64, dst, 256, tn * 64);
        }
    }
}

__device__ __forceinline__ void phase_ln(const bf16_t* __restrict__ Z, bf16_t* __restrict__ H, const float* __restrict__ g, const float* __restrict__ b, int bid, int nb) {
    const int lane = threadIdx.x & 63, gw = bid * 8 + (threadIdx.x >> 6), nw = nb * 8;
    float gg[16], bb[16];
#pragma unroll
    for (int i = 0; i < 8; ++i) { gg[i] = g[lane * 8 + i]; gg[8 + i] = g[512 + lane * 8 + i]; bb[i] = b[lane * 8 + i]; bb[8 + i] = b[512 + lane * 8 + i]; }
    for (int row = gw; row < NTOK; row += nw) {
        const u32x4 a = *(const u32x4*)(Z + (size_t)row * DM + lane * 8), c = *(const u32x4*)(Z + (size_t)row * DM + 512 + lane * 8);
        float v[16];
        v[0] = bflo(a.x); v[1] = bfhi(a.x); v[2] = bflo(a.y); v[3] = bfhi(a.y); v[4] = bflo(a.z); v[5] = bfhi(a.z); v[6] = bflo(a.w); v[7] = bfhi(a.w);
        v[8] = bflo(c.x); v[9] = bfhi(c.x); v[10] = bflo(c.y); v[11] = bfhi(c.y); v[12] = bflo(c.z); v[13] = bfhi(c.z); v[14] = bflo(c.w); v[15] = bfhi(c.w);
        float s = 0.f;
#pragma unroll
        for (int i = 0; i < 16; ++i) s += v[i];
#pragma unroll
        for (int o = 32; o > 0; o >>= 1) s += __shfl_xor(s, o);
        const float mu = s * (1.f / 1024.f);
        float q = 0.f;
#pragma unroll
        for (int i = 0; i < 16; ++i) { const float d = v[i] - mu; q += d * d; }
#pragma unroll
        for (int o = 32; o > 0; o >>= 1) q += __shfl_xor(q, o);
        const float rs = rsqrtf(q * (1.f / 1024.f) + 1e-5f);
        float y[16];
#pragma unroll
        for (int i = 0; i < 16; ++i) y[i] = (v[i] - mu) * rs * gg[i] + bb[i];
        u32x4 w0, w1; w0.x = pk2(y[0], y[1]); w0.y = pk2(y[2], y[3]); w0.z = pk2(y[4], y[5]); w0.w = pk2(y[6], y[7]);
        w1.x = pk2(y[8], y[9]); w1.y = pk2(y[10], y[11]); w1.z = pk2(y[12], y[13]); w1.w = pk2(y[14], y[15]);
        *(u32x4*)(H + (size_t)row * DM + lane * 8) = w0; *(u32x4*)(H + (size_t)row * DM + 512 + lane * 8) = w1;
    }
}

template <bool FINAL>
__device__ __forceinline__ void phase_combine(const bf16_t* __restrict__ Y, const int* __restrict__ posy, const float* __restrict__ tokw, const int* __restrict__ ntiles,
                                              const bf16_t* __restrict__ H1, bf16_t* __restrict__ H2, float* __restrict__ OUT, float* __restrict__ GATES,
                                              const float* __restrict__ wgate, const float* __restrict__ g, const float* __restrict__ b, int bid, int nb) {
    const int shbase = (*ntiles - NTOK / 256) * 256;
    const int lane = threadIdx.x & 63, gw = bid * 8 + (threadIdx.x >> 6), nw = nb * 8;
    for (int row = gw; row < NTOK; row += nw) {
        float v[16];
        { const u32x4 a = *(const u32x4*)(H1 + (size_t)row * DM + lane * 8), c = *(const u32x4*)(H1 + (size_t)row * DM + 512 + lane * 8);
          v[0] = bflo(a.x); v[1] = bfhi(a.x); v[2] = bflo(a.y); v[3] = bfhi(a.y); v[4] = bflo(a.z); v[5] = bfhi(a.z); v[6] = bflo(a.w); v[7] = bfhi(a.w);
          v[8] = bflo(c.x); v[9] = bfhi(c.x); v[10] = bflo(c.y); v[11] = bfhi(c.y); v[12] = bflo(c.z); v[13] = bfhi(c.z); v[14] = bflo(c.w); v[15] = bfhi(c.w); }
#pragma unroll
        for (int i = 0; i < 16; ++i) v[i] *= ALPHA;
#pragma unroll
        for (int k = 0; k < NSLOT; ++k) {
            const int pos = (k < 8) ? posy[(size_t)row * 8 + k] : shbase + row;
            const float wk = (k < 8) ? tokw[(size_t)row * 8 + k] : 1.0f;
            const bf16_t* yr = Y + (size_t)pos * DM;
            const u32x4 a = *(const u32x4*)(yr + lane * 8), c = *(const u32x4*)(yr + 512 + lane * 8);
            v[0] += wk * bflo(a.x); v[1] += wk * bfhi(a.x); v[2] += wk * bflo(a.y); v[3] += wk * bfhi(a.y); v[4] += wk * bflo(a.z); v[5] += wk * bfhi(a.z); v[6] += wk * bflo(a.w); v[7] += wk * bfhi(a.w);
            v[8] += wk * bflo(c.x); v[9] += wk * bfhi(c.x); v[10] += wk * bflo(c.y); v[11] += wk * bfhi(c.y); v[12] += wk * bflo(c.z); v[13] += wk * bfhi(c.z); v[14] += wk * bflo(c.w); v[15] += wk * bfhi(c.w);
        }
        float s = 0.f;
#pragma unroll
        for (int i = 0; i < 16; ++i) s += v[i];
#pragma unroll
        for (int o = 32; o > 0; o >>= 1) s += __shfl_xor(s, o);
        const float mu = s * (1.f / 1024.f);
        float q = 0.f;
#pragma unroll
        for (int i = 0; i < 16; ++i) { const float d = v[i] - mu; q += d * d; }
#pragma unroll
        for (int o = 32; o > 0; o >>= 1) q += __shfl_xor(q, o);
        const float rs = rsqrtf(q * (1.f / 1024.f) + 1e-5f);
        float y[16];
#pragma unroll
        for (int i = 0; i < 8; ++i) { y[i] = (v[i] - mu) * rs * g[lane * 8 + i] + b[lane * 8 + i]; y[8 + i] = (v[8 + i] - mu) * rs * g[512 + lane * 8 + i] + b[512 + lane * 8 + i]; }
        if (FINAL) {
            float* o = OUT + (size_t)row * DM;
            *(f32x4*)(o + lane * 8) = (f32x4){y[0], y[1], y[2], y[3]}; *(f32x4*)(o + lane * 8 + 4) = (f32x4){y[4], y[5], y[6], y[7]};
            *(f32x4*)(o + 512 + lane * 8) = (f32x4){y[8], y[9], y[10], y[11]}; *(f32x4*)(o + 512 + lane * 8 + 4) = (f32x4){y[12], y[13], y[14], y[15]};
        } else {
            u32x4 w0, w1; w0.x = pk2(y[0], y[1]); w0.y = pk2(y[2], y[3]); w0.z = pk2(y[4], y[5]); w0.w = pk2(y[6], y[7]);
            w1.x = pk2(y[8], y[9]); w1.y = pk2(y[10], y[11]); w1.z = pk2(y[12], y[13]); w1.w = pk2(y[14], y[15]);
            *(u32x4*)(H2 + (size_t)row * DM + lane * 8) = w0; *(u32x4*)(H2 + (size_t)row * DM + 512 + lane * 8) = w1;
            float yr[16];
            yr[0] = bflo(w0.x); yr[1] = bfhi(w0.x); yr[2] = bflo(w0.y); yr[3] = bfhi(w0.y); yr[4] = bflo(w0.z); yr[5] = bfhi(w0.z); yr[6] = bflo(w0.w); yr[7] = bfhi(w0.w);
            yr[8] = bflo(w1.x); yr[9] = bfhi(w1.x); yr[10] = bflo(w1.y); yr[11] = bfhi(w1.y); yr[12] = bflo(w1.z); yr[13] = bfhi(w1.z); yr[14] = bflo(w1.w); yr[15] = bfhi(w1.w);
            float gsum = 0.f;
#pragma unroll
            for (int gi = 0; gi < 8; ++gi) {
                const float* wp = wgate + gi * 1024; float d = 0.f;
#pragma unroll
                for (int i = 0; i < 8; ++i) d += yr[i] * wp[lane * 8 + i] + yr[8 + i] * wp[512 + lane * 8 + i];
#pragma unroll
                for (int o = 32; o > 0; o >>= 1) d += __shfl_xor(d, o);
                gsum = (lane == gi) ? d : gsum;
            }
            if (lane < 8) GATES[(size_t)row * 8 + lane] = gsum;
        }
    }
}

__device__ __forceinline__ void phase_select(LAS unsigned char* lds, const float* __restrict__ logits, const float* __restrict__ rbias, int* __restrict__ tok_e, int* __restrict__ tok_p,
                                             float* __restrict__ tok_w, unsigned* __restrict__ cnt, int bid, int nb) {
    const int tid = threadIdx.x, lane = tid & 63, wave = tid >> 6;
    LAS unsigned* hist = (LAS unsigned*)lds;
    LAS unsigned* base = hist + 256;
    LAS int* selE = (LAS int*)(base + 256);
    LAS int* selR = selE + 1024;
    const int tpw = NTOK / nb;
    const int t0 = bid * tpw;
    if (tid < 256) hist[tid] = 0u;
    __syncthreads();
    LAS float* sb = (LAS float*)(lds + 10240);
    for (int i = tid; i < tpw * 256; i += 512) { const int tk = i >> 8, e = i & 255; sb[e * tpw + tk] = sigm(logits[(size_t)(t0 + tk) * 256 + e]) + rbias[e]; }
    __syncthreads();
    if (tid < tpw) {
        const int it = tid, tok = t0 + it;
        float gs[8];
#pragma unroll
        for (int g = 0; g < 8; ++g) { float m1 = -3.0e38f, m2 = -3.0e38f;
            for (int j = 0; j < 32; ++j) { const float v = sb[(g * 32 + j) * tpw + it]; if (v > m1) { m2 = m1; m1 = v; } else if (v > m2) m2 = v; }
            gs[g] = m1 + m2; }
        unsigned selmask = 0u;
#pragma unroll
        for (int g = 0; g < 8; ++g) { int rank = 0;
#pragma unroll
            for (int q = 0; q < 8; ++q) rank += (gs[q] > gs[g] || (gs[q] == gs[g] && q < g)) ? 1 : 0;
            if (rank < 4) selmask |= 1u << g; }
        float tv[8]; int te[8];
#pragma unroll
        for (int k = 0; k < 8; ++k) { tv[k] = -3.0e38f; te[k] = 0; }
        for (int e = 0; e < 256; ++e) {
            if (!((selmask >> (e >> 5)) & 1u)) continue;
            float v = sb[e * tpw + it]; int ve = e;
            if (v > tv[7]) {
#pragma unroll
                for (int k = 0; k < 8; ++k) { if (v > tv[k]) { const float tf = tv[k]; const int ti = te[k]; tv[k] = v; te[k] = ve; v = tf; ve = ti; } }
            }
        }
        float sc8[8], tot = 0.f;
#pragma unroll
        for (int k = 0; k < 8; ++k) { sc8[k] = sigm(logits[(size_t)tok * 256 + te[k]]); tot += sc8[k]; }
        const float inv = 2.5f / tot;
#pragma unroll
        for (int k = 0; k < 8; ++k) {
            tok_e[(size_t)tok * 8 + k] = te[k]; tok_w[(size_t)tok * 8 + k] = sc8[k] * inv;
            const unsigned r = atomicAdd((unsigned*)&hist[te[k]], 1u);
            selE[it * 8 + k] = te[k]; selR[it * 8 + k] = (int)r;
        }
    }
    __syncthreads();
    if (tid < 256) { const unsigned c = hist[tid]; base[tid] = c ? __hip_atomic_fetch_add(cnt + tid, c, __ATOMIC_RELAXED, __HIP_MEMORY_SCOPE_AGENT) : 0u; }
    __syncthreads();
    for (int i = tid; i < tpw * 8; i += 512) tok_p[(size_t)t0 * 8 + i] = (int)base[selE[i]] + selR[i];
    __syncthreads();
}

__device__ __forceinline__ void phase_dispatch(LAS unsigned char* lds, const unsigned* __restrict__ cnt, const int* __restrict__ tok_e, const int* __restrict__ tok_p,
                                               int* __restrict__ s_tok, int* __restrict__ posy, int* __restrict__ tile_exp, int* __restrict__ ntiles, int bid, int nb) {
    const int tid = threadIdx.x;
    LAS int* tstart = (LAS int*)lds;
    LAS int* tcnt = tstart + 260;
    if (tid < 256) tcnt[tid] = (int)((__hip_atomic_load(cnt + tid, __ATOMIC_RELAXED, __HIP_MEMORY_SCOPE_AGENT) + 255u) >> 8);
    __syncthreads();
    if (tid == 0) { int a = 0; for (int e = 0; e < 256; ++e) { tstart[e] = a; a += tcnt[e]; } tstart[256] = a; }
    __syncthreads();
    const int TT = tstart[256];
    const int tpw = NTOK / nb, t0 = bid * tpw;
    for (int i = tid; i < tpw * 8; i += 512) {
        const size_t a = (size_t)t0 * 8 + i; const int e = tok_e[a], p = tok_p[a];
        const int pos = tstart[e] * 256 + p;
        s_tok[pos] = (int)(a >> 3); posy[a] = pos;
    }
    for (int i = tid; i < tpw; i += 512) { const int tok = t0 + i; s_tok[TT * 256 + tok] = tok; }
    for (int e = bid; e < 256; e += nb) {
        const int c = (int)__hip_atomic_load(cnt + e, __ATOMIC_RELAXED, __HIP_MEMORY_SCOPE_AGENT), ts = tstart[e], tc = tcnt[e];
        for (int i = c + tid; i < tc * 256; i += 512) s_tok[ts * 256 + i] = 0;
        for (int i = tid; i < tc; i += 512) tile_exp[ts + i] = e;
    }
    if (bid == 0) { for (int i = tid; i < NTOK / 256; i += 512) tile_exp[TT + i] = 256; if (tid == 0) *ntiles = TT + NTOK / 256; }
    __syncthreads();
}

constexpr int MX_QT = 0, MX_KT = 17408, MX_KHT = 34816, MX_VT = 53248, MX_P = 73984, MX_ST = 83200, MX_SEG = 122368, MX_GD = 126464, MX_ER = 126976, MX_RS = 127488, MX_DEN = 128000, MX_BC = 128256, MX_IP = 128512, MX_GT = 128768;
struct MixP {
    const bf16_t* proj; int ldp; int pad0; bf16_t* ymix; const float* gates;
    const float* lb0; const float* bgk; const float* hg; const float* gg; const float* conv; const float* bif;
    float* ust; float* gsum;
};
#define MFMA16(a, b, c) __builtin_amdgcn_mfma_f32_16x16x32_bf16((a), (b), (c), 0, 0, 0)

template <int MODE, bool FULL>
__device__ __forceinline__ void mixer_run(LAS unsigned char* lds, const MixP& mp, int bid) {
    constexpr int DK = (MODE == 1) ? 64 : 128, QP = DK + 8, CP = DK / 2, RG = 512 / CP, RPT = 64 / RG, KS = DK / 32;
    constexpr int NVT = (MODE == 2) ? 9 : 8;
    constexpr int NST = (DK == 128) ? NVT : 4;
    const int tid = threadIdx.x, lane = tid & 63, w = __builtin_amdgcn_readfirstlane(tid >> 6), l15 = lane & 15, l4 = lane >> 4;
    int b, h, vh = 0, seg;
    if (MODE == 0) { const int sq = bid >> 4; b = sq >> 2; h = sq & 3; seg = bid & 15; }
    else if (MODE == 1) { const int sq = (bid - 128) >> 4; b = sq >> 2; h = sq & 3; seg = bid & 15; }
    else { const int sq = bid >> 4; b = sq >> 3; h = (sq >> 1) & 3; vh = sq & 1; seg = bid & 15; }
    const int tok0 = b * SEQ + seg * 1024;
    const int ldp = mp.ldp; const bf16_t* proj = mp.proj;
    int cq, ck, cv, cg, cy;
    if (MODE == 0) { cq = h * 128; ck = 512 + h * 128; cv = 1024 + h * 128; cg = 1536 + h * 128; cy = h * 128; }
    else if (MODE == 1) { cq = 2048 + h * 64; ck = 2304 + h * 64; cv = 2560 + h * 128; cg = 3072 + h * 128; cy = 512 + h * 128; }
    else { cq = h * 128; ck = 512 + h * 128; cv = 1024 + h * 256 + vh * 128; cg = 2048 + h * 256 + vh * 128; cy = h * 256 + vh * 128; }
    const int cu = 3584 + h * 64;
    const int cp = tid % CP, rg = tid / CP, d0 = 2 * cp;
    float lbv[2] = {0.f, 0.f}, oml[2] = {0.f, 0.f}, bgk[2] = {0.f, 0.f}, cwq[4][2], cwk[4][2];
    if (MODE == 0) { lbv[0] = mp.lb0[h * 128 + d0]; lbv[1] = mp.lb0[h * 128 + d0 + 1]; oml[0] = 1.f - lbv[0]; oml[1] = 1.f - lbv[1]; }
    if (MODE == 1) { bgk[0] = mp.bgk[h * 64 + d0]; bgk[1] = mp.bgk[h * 64 + d0 + 1]; }
#pragma unroll
    for (int j = 0; j < 4; ++j) { cwq[j][0] = cwq[j][1] = cwk[j][0] = cwk[j][1] = 0.f; }
    if (MODE == 2) {
#pragma unroll
        for (int j = 0; j < 4; ++j) { cwq[j][0] = mp.conv[j * 1024 + cq + d0]; cwq[j][1] = mp.conv[j * 1024 + cq + d0 + 1]; cwk[j][0] = mp.conv[j * 1024 + ck + d0]; cwk[j][1] = mp.conv[j * 1024 + ck + d0 + 1]; }
    }
    const float bi = (MODE == 2) ? mp.bif[h] : 0.f, bfg = (MODE == 2) ? mp.bif[4 + h] : 0.f;
    const int sdt = (DK == 128) ? w : (w & 3), svt0 = (DK == 128) ? 0 : 4 * (w >> 2);
    f32x4 S[NST];
#pragma unroll
    for (int t = 0; t < NST; ++t) S[t] = (f32x4){0.f, 0.f, 0.f, 0.f};
    float gacc[2] = {0.f, 0.f};
    if (MODE == 2) {
        for (int i = tid; i < 16 * 72; i += 512) { const int r = i / 72; *(LAS bf16_t*)(lds + MX_VT + ((128 + r) * 72 + (i % 72)) * 2) = (r == 0) ? (bf16_t)0x3F80 : (bf16_t)0; }
    }
    if (FULL) {
        const int bid0 = bid & ~15;
        for (int j = 0; j < seg; ++j) {
            const float* U = mp.ust + ((size_t)(bid0 + j) * 8 + w) * (9 * 4 * 64);
            float dec[4];
            if (MODE == 2) { const float gsv = mp.gsum[(size_t)(bid0 + j) * 128]; dec[0] = dec[1] = dec[2] = dec[3] = __expf(gsv); }
            else {
#pragma unroll
                for (int r = 0; r < 4; ++r) dec[r] = __expf(mp.gsum[(size_t)(bid0 + j) * 128 + sdt * 16 + 4 * l4 + r]);
            }
#pragma unroll
            for (int t = 0; t < NST; ++t)
#pragma unroll
                for (int r = 0; r < 4; ++r) S[t][r] = dec[r] * S[t][r] + U[(t * 4 + r) * 64 + lane];
        }
    }
    __syncthreads();
    for (int c = 0; c < 16; ++c) {
        const int tokc = tok0 + c * 64;
        float la[RPT][2], qv[RPT][2], kv[RPT][2];
        if (MODE == 2) {
            if (w == 0) {
                const float* gp = mp.gates + (size_t)(tokc + lane) * 8;
                const float ip = gp[h] + bi, lf = logsig(gp[4 + h] + bfg);
                float cs = lf;
#pragma unroll
                for (int o = 1; o < 64; o <<= 1) { const float t = __shfl_up(cs, o); if (lane >= o) cs += t; }
                *(LAS float*)(lds + MX_BC + lane * 4) = cs; *(LAS float*)(lds + MX_IP + lane * 4) = ip - cs;
                if (lane == 63) *(LAS float*)(lds + MX_GT) = cs;
            }
            const int tl0 = seg * 1024 + c * 64 + rg * RPT;
            float rq[RPT + 3][2], rk[RPT + 3][2];
#pragma unroll
            for (int i = 0; i < RPT + 3; ++i) {
                const int tl = tl0 - 3 + i;
                if (tl >= 0) { const bf16_t* pr = proj + (size_t)(b * SEQ + tl) * ldp;
                    const unsigned uq = *(const unsigned*)(pr + cq + d0); rq[i][0] = bflo(uq); rq[i][1] = bfhi(uq);
                    if (true) { const unsigned uk = *(const unsigned*)(pr + ck + d0); rk[i][0] = bflo(uk); rk[i][1] = bfhi(uk); } }
                else { rq[i][0] = rq[i][1] = rk[i][0] = rk[i][1] = 0.f; }
            }
#pragma unroll
            for (int i = 0; i < RPT; ++i)
#pragma unroll
                for (int e = 0; e < 2; ++e) {
                    float aq = 0.f, ak = 0.f;
#pragma unroll
                    for (int j = 0; j < 4; ++j) { aq += cwq[j][e] * rq[i + j][e]; ak += cwk[j][e] * rk[i + j][e]; }
                    qv[i][e] = silu(aq); kv[i][e] = silu(ak) * 0.08838834764831845f; la[i][e] = 0.f;
                }
        } else {
#pragma unroll
            for (int i = 0; i < RPT; ++i) {
                const bf16_t* pr = proj + (size_t)(tokc + rg * RPT + i) * ldp;
                if (MODE == 0) {
                    const unsigned uz = *(const unsigned*)(pr + ck + d0);
                    const float z0 = bflo(uz), z1 = bfhi(uz), s0 = sigm(z0), s1 = sigm(z1);
                    la[i][0] = __logf(lbv[0] + oml[0] * s0); la[i][1] = __logf(lbv[1] + oml[1] * s1);
                    kv[i][0] = oml[0] * (1.f - s0); kv[i][1] = oml[1] * (1.f - s1);
                    if (FULL) { const unsigned uq = *(const unsigned*)(pr + cq + d0); qv[i][0] = silu(bflo(uq)); qv[i][1] = silu(bfhi(uq)); } else { qv[i][0] = qv[i][1] = 0.f; }
                } else {
                    const unsigned uu = *(const unsigned*)(pr + cu + d0), uk = *(const unsigned*)(pr + ck + d0);
                    la[i][0] = logsig(bflo(uu) + bgk[0]) * 0.0625f; la[i][1] = logsig(bfhi(uu) + bgk[1]) * 0.0625f;
                    kv[i][0] = bflo(uk); kv[i][1] = bfhi(uk);
                    if (FULL) { const unsigned uq = *(const unsigned*)(pr + cq + d0); qv[i][0] = bflo(uq) * 0.125f; qv[i][1] = bfhi(uq) * 0.125f; } else { qv[i][0] = qv[i][1] = 0.f; }
                }
            }
#pragma unroll
            for (int i = 1; i < RPT; ++i) { la[i][0] += la[i - 1][0]; la[i][1] += la[i - 1][1]; }
            *(LAS float*)(lds + MX_SEG + (rg * DK + d0) * 4) = la[RPT - 1][0]; *(LAS float*)(lds + MX_SEG + (rg * DK + d0 + 1) * 4) = la[RPT - 1][1];
        }
        {
            const int vp = tid & 63, r0 = (tid >> 6) * 8;
            unsigned pv[8];
#pragma unroll
            for (int i = 0; i < 8; ++i) pv[i] = *(const unsigned*)(proj + (size_t)(tokc + r0 + i) * ldp + cv + 2 * vp);
            u32x4 lo, hi;
            lo.x = (pv[0] & 0xffffu) | (pv[1] << 16); lo.y = (pv[2] & 0xffffu) | (pv[3] << 16); lo.z = (pv[4] & 0xffffu) | (pv[5] << 16); lo.w = (pv[6] & 0xffffu) | (pv[7] << 16);
            hi.x = (pv[0] >> 16) | (pv[1] & 0xffff0000u); hi.y = (pv[2] >> 16) | (pv[3] & 0xffff0000u); hi.z = (pv[4] >> 16) | (pv[5] & 0xffff0000u); hi.w = (pv[6] >> 16) | (pv[7] & 0xffff0000u);
            *(LAS u32x4*)(lds + MX_VT + ((2 * vp) * 72 + r0) * 2) = lo; *(LAS u32x4*)(lds + MX_VT + ((2 * vp + 1) * 72 + r0) * 2) = hi;
        }
        __syncthreads();
        {
            float pre[2], rr[2], gt[2];
            if (MODE == 2) {
                const float g = *(LAS float*)(lds + MX_GT);
                gt[0] = gt[1] = g; rr[0] = rr[1] = 0.f; pre[0] = pre[1] = 0.f;
                if (tid == 0) gacc[0] += g;
            } else {
#pragma unroll
                for (int e = 0; e < 2; ++e) { float p = 0.f, r = 0.f, g = 0.f;
#pragma unroll
                    for (int j = 0; j < RG; ++j) { const float v = *(LAS float*)(lds + MX_SEG + (j * DK + d0 + e) * 4); if (j < rg) p += v; if (j < RG / 2) r += v; g += v; }
                    pre[e] = p; rr[e] = r; gt[e] = g; }
                if (rg == 0) { gacc[0] += gt[0]; gacc[1] += gt[1];
                    *(LAS float*)(lds + MX_GD + d0 * 4) = __expf(gt[0]); *(LAS float*)(lds + MX_GD + (d0 + 1) * 4) = __expf(gt[1]);
                    *(LAS float*)(lds + MX_ER + d0 * 4) = __expf(rr[0]); *(LAS float*)(lds + MX_ER + (d0 + 1) * 4) = __expf(rr[1]); }
            }
            float kh[RPT][2];
#pragma unroll
            for (int i = 0; i < RPT; ++i) {
                const int s = rg * RPT + i;
                float qs[2], ks[2];
                if (MODE == 2) {
                    const float bc = *(LAS float*)(lds + MX_BC + s * 4), ipb = *(LAS float*)(lds + MX_IP + s * 4);
                    const float eq = __expf(bc), ek = __expf(ipb), eg = __expf(gt[0]);
                    qs[0] = qv[i][0] * eq; qs[1] = qv[i][1] * eq; ks[0] = kv[i][0] * ek; ks[1] = kv[i][1] * ek; kh[i][0] = ks[0] * eg; kh[i][1] = ks[1] * eg;
                } else {
#pragma unroll
                    for (int e = 0; e < 2; ++e) { const float bb = pre[e] + la[i][e];
                        qs[e] = qv[i][e] * __expf(bb - rr[e]); ks[e] = kv[i][e] * __expf(rr[e] - bb); kh[i][e] = kv[i][e] * __expf(gt[e] - bb); }
                }
                if (FULL) { *(LAS unsigned*)(lds + MX_QT + (s * QP + d0) * 2) = pk2(qs[0], qs[1]); *(LAS unsigned*)(lds + MX_KT + (s * QP + d0) * 2) = pk2(ks[0], ks[1]); }
            }
            if (RPT == 8) {
                u32x4 a, bq;
                a.x = pk2(kh[0][0], kh[1][0]); a.y = pk2(kh[2][0], kh[3][0]); a.z = pk2(kh[4 % RPT][0], kh[5 % RPT][0]); a.w = pk2(kh[6 % RPT][0], kh[7 % RPT][0]);
                bq.x = pk2(kh[0][1], kh[1][1]); bq.y = pk2(kh[2][1], kh[3][1]); bq.z = pk2(kh[4 % RPT][1], kh[5 % RPT][1]); bq.w = pk2(kh[6 % RPT][1], kh[7 % RPT][1]);
                *(LAS u32x4*)(lds + MX_KHT + (d0 * 72 + rg * 8) * 2) = a; *(LAS u32x4*)(lds + MX_KHT + ((d0 + 1) * 72 + rg * 8) * 2) = bq;
            } else {
                u32x2 a, bq;
                a.x = pk2(kh[0][0], kh[1][0]); a.y = pk2(kh[2][0], kh[3][0]); bq.x = pk2(kh[0][1], kh[1][1]); bq.y = pk2(kh[2][1], kh[3][1]);
                *(LAS u32x2*)(lds + MX_KHT + (d0 * 72 + rg * 4) * 2) = a; *(LAS u32x2*)(lds + MX_KHT + ((d0 + 1) * 72 + rg * 4) * 2) = bq;
            }
        }
        __syncthreads();
        if (FULL) {
#pragma unroll
            for (int tt = 0; tt < 2; ++tt) {
                const int tile = 2 * w + tt, ti = tile >> 2, tj = tile & 3;
                f32x4 acc = (f32x4){0.f, 0.f, 0.f, 0.f};
                if (ti <= tj) {
#pragma unroll
                    for (int kk = 0; kk < KS; ++kk) {
                        const bf16x8 a = *(const LAS bf16x8*)(lds + MX_KT + ((16 * ti + l15) * QP + kk * 32 + 8 * l4) * 2);
                        const bf16x8 bq = *(const LAS bf16x8*)(lds + MX_QT + ((16 * tj + l15) * QP + kk * 32 + 8 * l4) * 2);
                        acc = MFMA16(a, bq, acc);
                    }
                }
                const int s = 16 * tj + l15, sp0 = 16 * ti + 4 * l4;
                float pvv[4];
#pragma unroll
                for (int r = 0; r < 4; ++r) pvv[r] = (sp0 + r <= s) ? acc[r] : 0.f;
                u32x2 pw; pw.x = pk2(pvv[0], pvv[1]); pw.y = pk2(pvv[2], pvv[3]);
                *(LAS u32x2*)(lds + MX_P + (s * 72 + sp0) * 2) = pw;
            }
            {
                float er[4];
#pragma unroll
                for (int r = 0; r < 4; ++r) er[r] = (MODE == 2) ? 1.f : *(LAS float*)(lds + MX_ER + (sdt * 16 + 4 * l4 + r) * 4);
#pragma unroll
                for (int t = 0; t < NST; ++t) {
                    const int v = 16 * (svt0 + t) + l15;
                    u32x2 sw; sw.x = pk2(S[t][0] * er[0], S[t][1] * er[1]); sw.y = pk2(S[t][2] * er[2], S[t][3] * er[3]);
                    *(LAS u32x2*)(lds + MX_ST + (v * QP + sdt * 16 + 4 * l4) * 2) = sw;
                }
            }
            __syncthreads();
            const int sj = w & 3, ovh = w >> 2;
            constexpr int NOT = (MODE == 2) ? 5 : 4;
            f32x4 O[NOT];
#pragma unroll
            for (int t = 0; t < NOT; ++t) {
                O[t] = (f32x4){0.f, 0.f, 0.f, 0.f};
                const int vt = (t < 4) ? (4 * ovh + t) : 8;
                if (t < 4 || ovh == 0) {
#pragma unroll
                    for (int kk = 0; kk < 2; ++kk) {
                        const bf16x8 a = *(const LAS bf16x8*)(lds + MX_VT + ((16 * vt + l15) * 72 + kk * 32 + 8 * l4) * 2);
                        const bf16x8 bq = *(const LAS bf16x8*)(lds + MX_P + ((16 * sj + l15) * 72 + kk * 32 + 8 * l4) * 2);
                        O[t] = MFMA16(a, bq, O[t]);
                    }
#pragma unroll
                    for (int kk = 0; kk < KS; ++kk) {
                        const bf16x8 a = *(const LAS bf16x8*)(lds + MX_ST + ((16 * vt + l15) * QP + kk * 32 + 8 * l4) * 2);
                        const bf16x8 bq = *(const LAS bf16x8*)(lds + MX_QT + ((16 * sj + l15) * QP + kk * 32 + 8 * l4) * 2);
                        O[t] = MFMA16(a, bq, O[t]);
                    }
                }
            }
            const int srow = 16 * sj + l15, tokr = tokc + srow;
            float scale;
            if (MODE == 2) {
                if (ovh == 0 && l4 == 0) *(LAS float*)(lds + MX_DEN + srow * 4) = O[NOT - 1][0];
                __syncthreads();
                const float den = *(LAS float*)(lds + MX_DEN + srow * 4);
                scale = 1.f / fmaxf(fabsf(den), 1.f);
            } else {
                float ss = 0.f;
#pragma unroll
                for (int t = 0; t < 4; ++t)
#pragma unroll
                    for (int r = 0; r < 4; ++r) ss += O[t][r] * O[t][r];
                ss += __shfl_xor(ss, 16); ss += __shfl_xor(ss, 32);
                if (l4 == 0) *(LAS float*)(lds + MX_RS + (ovh * 64 + srow) * 4) = ss;
                __syncthreads();
                const float tot = *(LAS float*)(lds + MX_RS + srow * 4) + *(LAS float*)(lds + MX_RS + (64 + srow) * 4);
                scale = rsqrtf(tot * (1.f / 128.f) + 1e-6f);
            }
#pragma unroll
            for (int t = 0; t < 4; ++t) {
                const int v0 = 16 * (4 * ovh + t) + 4 * l4;
                const u32x2 gt = *(const u32x2*)(proj + (size_t)tokr * ldp + cg + v0);
                const float g0 = bflo(gt.x), g1 = bfhi(gt.x), g2 = bflo(gt.y), g3 = bfhi(gt.y);
                float y0, y1, y2, y3;
                if (MODE == 2) { y0 = O[t][0] * scale * sigm(g0); y1 = O[t][1] * scale * sigm(g1); y2 = O[t][2] * scale * sigm(g2); y3 = O[t][3] * scale * sigm(g3); }
                else { const float* gn = ((MODE == 0) ? mp.hg : mp.gg) + h * 128 + v0;
                    y0 = O[t][0] * scale * gn[0] * silu(g0); y1 = O[t][1] * scale * gn[1] * silu(g1); y2 = O[t][2] * scale * gn[2] * silu(g2); y3 = O[t][3] * scale * gn[3] * silu(g3); }
                u32x2 yw; yw.x = pk2(y0, y1); yw.y = pk2(y2, y3);
                *(u32x2*)(mp.ymix + (size_t)tokr * DM + cy + v0) = yw;
            }
        }
        {
            float dec[4];
            if (MODE == 2) { const float eg = __expf(*(LAS float*)(lds + MX_GT)); dec[0] = dec[1] = dec[2] = dec[3] = eg; }
            else {
#pragma unroll
                for (int r = 0; r < 4; ++r) dec[r] = *(LAS float*)(lds + MX_GD + (sdt * 16 + 4 * l4 + r) * 4);
            }
            bf16x8 ka[2];
#pragma unroll
            for (int kk = 0; kk < 2; ++kk) ka[kk] = *(const LAS bf16x8*)(lds + MX_KHT + ((16 * sdt + l15) * 72 + kk * 32 + 8 * l4) * 2);
#pragma unroll
            for (int t = 0; t < NST; ++t) {
#pragma unroll
                for (int r = 0; r < 4; ++r) S[t][r] *= dec[r];
#pragma unroll
                for (int kk = 0; kk < 2; ++kk) {
                    const bf16x8 vb = *(const LAS bf16x8*)(lds + MX_VT + ((16 * (svt0 + t) + l15) * 72 + kk * 32 + 8 * l4) * 2);
                    S[t] = MFMA16(ka[kk], vb, S[t]);
                }
            }
        }
        __syncthreads();
    }
    if (!FULL) {
        float* U = mp.ust + ((size_t)bid * 8 + w) * (9 * 4 * 64);
#pragma unroll
        for (int t = 0; t < NST; ++t)
#pragma unroll
            for (int r = 0; r < 4; ++r) U[(t * 4 + r) * 64 + lane] = S[t][r];
        if (MODE == 2) { if (tid == 0) mp.gsum[(size_t)bid * 128] = gacc[0]; }
        else if (rg == 0) { mp.gsum[(size_t)bid * 128 + d0] = gacc[0]; mp.gsum[(size_t)bid * 128 + d0 + 1] = gacc[1]; }
    }
}

#ifndef PHMASK
#define PHMASK 0xFFFFu
#endif
#ifndef MIXSEL
#define MIXSEL 7
#endif
#define EN(j) (((PHMASK) >> (j)) & 1u)
#define IN(k) (lo <= (k) && (k) < hi)
#define SEAM(k) do { if (IN((k) + 1)) xcd_barrier(bar); } while (0)

template <int layer>
__device__ __forceinline__ void run_layer(LAS unsigned char* lds, const Args& A, const XcdBarrier& bar, const int lo, const int hi) {
    const int bid = blockIdx.x, nb = gridDim.x;
    unsigned char* ws = A.ws;
    unsigned* ctl = (unsigned*)(ws + WS_CTL);
    constexpr int P = 1 + layer * 11;
    if (EN(0) && IN(P + 0)) {
        pg8::Gemm g{(const bf16_t*)(ws + (layer ? WS_H2 : WS_HB)), (const bf16_t*)(ws + (layer ? WS_WC : WS_WAB)), DM};
        pg8::StaticOrder S; S.init(NTOK, layer ? CWID : ABW, nb, bid);
        pg8::EpiStoreBf16 E{(bf16_t*)(ws + WS_PROJ), layer ? CWID : ABW};
        pg8::gemm_phase<pg8::EpiStoreBf16, pg8::StaticOrder, false>(lds, g, nullptr, S, E);
        SEAM(P + 0);
    }
    if (EN(1) && IN(P + 1)) {
        if (nb == NWG) {
            MixP mp{(const bf16_t*)(ws + WS_PROJ), layer ? CWID : ABW, 0, (bf16_t*)(ws + WS_YMIX), (const float*)(ws + WS_GATES), (const float*)(ws + WS_MISC), A.in[I_BGK], A.in[I_HG], A.in[I_GG], A.in[I_CONV], A.in[I_BIF], (float*)(ws + WS_UST), (float*)(ws + WS_GSUM)};
            if (layer == 0) { if (bid < 128) { if (MIXSEL & 1) mixer_run<0, false>(lds, mp, bid); } else { if (MIXSEL & 2) mixer_run<1, false>(lds, mp, bid); } }
            else { if (MIXSEL & 4) mixer_run<2, false>(lds, mp, bid); }
        }
        SEAM(P + 1);
    }
    if (EN(2) && IN(P + 2)) {
        if (nb == NWG) {
            MixP mp{(const bf16_t*)(ws + WS_PROJ), layer ? CWID : ABW, 0, (bf16_t*)(ws + WS_YMIX), (const float*)(ws + WS_GATES), (const float*)(ws + WS_MISC), A.in[I_BGK], A.in[I_HG], A.in[I_GG], A.in[I_CONV], A.in[I_BIF], (float*)(ws + WS_UST), (float*)(ws + WS_GSUM)};
            if (layer == 0) { if (bid < 128) { if (MIXSEL & 1) mixer_run<0, true>(lds, mp, bid); } else { if (MIXSEL & 2) mixer_run<1, true>(lds, mp, bid); } }
            else { if (MIXSEL & 4) mixer_run<2, true>(lds, mp, bid); }
        }
        SEAM(P + 2);
    }
    if (EN(3) && IN(P + 3)) {
        pg8::Gemm g{(const bf16_t*)(ws + WS_YMIX), (const bf16_t*)(ws + (layer ? WS_WOC : WS_WOAB)), DM};
        pg8::StaticOrder S; S.init(NTOK, DM, nb, bid);
        pg8::EpiResid E{(bf16_t*)(ws + WS_Z), (const bf16_t*)(ws + (layer ? WS_H2 : WS_HB))};
        pg8::gemm_phase<pg8::EpiResid, pg8::StaticOrder, false>(lds, g, nullptr, S, E);
        SEAM(P + 3);
    }
    if (EN(4) && IN(P + 4)) { phase_ln((const bf16_t*)(ws + WS_Z), (bf16_t*)(ws + WS_H1), A.in[I_LMG] + layer * DM, A.in[I_LMB] + layer * DM, bid, nb); SEAM(P + 4); }
    if (EN(5) && IN(P + 5)) {
        pg8::Gemm g{(const bf16_t*)(ws + WS_H1), (const bf16_t*)(ws + WS_WR) + (size_t)layer * 256 * 1024, DM};
        pg8::StaticOrder S; S.init(NTOK, 256, nb, bid);
        pg8::EpiF32 E{(float*)(ws + WS_LOGITS)};
        pg8::gemm_phase<pg8::EpiF32, pg8::StaticOrder, false>(lds, g, nullptr, S, E);
        SEAM(P + 5);
    }
    if (EN(6) && IN(P + 6)) { phase_select(lds, (const float*)(ws + WS_LOGITS), A.in[I_RB] + layer * NEXP, (int*)(ws + WS_TOKE), (int*)(ws + WS_TOKP), (float*)(ws + WS_TOKW), ctl + CW_CNT + layer * 256, bid, nb); SEAM(P + 6); }
    if (EN(7) && IN(P + 7)) { phase_dispatch(lds, ctl + CW_CNT + layer * 256, (const int*)(ws + WS_TOKE), (const int*)(ws + WS_TOKP), (int*)(ws + WS_STOK), (int*)(ws + WS_POSY), (int*)(ws + WS_MISC + 65536), (int*)(ws + WS_MISC + 65536 + 8192), bid, nb); SEAM(P + 7); }
    const int vcu = (nb % 8 == 0) ? (bid % 8) * (nb / 8) + bid / 8 : bid;
    if (EN(8) && IN(P + 8)) {
        const int nt = __builtin_amdgcn_readfirstlane(*(volatile int*)(ws + WS_MISC + 65536 + 8192));
        pg8::Gemm g{(const bf16_t*)(ws + WS_H1), (const bf16_t*)(ws + WS_W1T) + (size_t)layer * NE1 * 512 * 1024, DM};
        pg8::MoeOrder S{(const int*)(ws + WS_MISC + 65536), nt * 2, 1, nb, vcu};
        pg8::EpiSwiGLU E{(bf16_t*)(ws + WS_ACT)};
        pg8::gemm_phase<pg8::EpiSwiGLU, pg8::MoeOrder, true>(lds, g, (const int*)(ws + WS_STOK), S, E);
        SEAM(P + 8);
    }
    if (EN(9) && IN(P + 9)) {
        const int nt = __builtin_amdgcn_readfirstlane(*(volatile int*)(ws + WS_MISC + 65536 + 8192));
        pg8::Gemm g{(const bf16_t*)(ws + WS_ACT), (const bf16_t*)(ws + WS_W2T) + (size_t)layer * NE1 * 1024 * 256, 256};
        pg8::MoeOrder S{(const int*)(ws + WS_MISC + 65536), nt * 4, 2, nb, vcu};
        pg8::EpiDown E{(bf16_t*)(ws + WS_Y)};
        pg8::gemm_phase<pg8::EpiDown, pg8::MoeOrder, false>(lds, g, nullptr, S, E);
        SEAM(P + 9);
    }
    if (EN(10) && IN(P + 10)) {
        if (layer == 0) phase_combine<false>((const bf16_t*)(ws + WS_Y), (const int*)(ws + WS_POSY), (const float*)(ws + WS_TOKW), (const int*)(ws + WS_MISC + 65536 + 8192), (const bf16_t*)(ws + WS_H1), (bf16_t*)(ws + WS_H2), nullptr, (float*)(ws + WS_GATES), (const float*)(ws + WS_MISC + 4096), A.in[I_LFG], A.in[I_LFB], bid, nb);
        else phase_combine<true>((const bf16_t*)(ws + WS_Y), (const int*)(ws + WS_POSY), (const float*)(ws + WS_TOKW), (const int*)(ws + WS_MISC + 65536 + 8192), (const bf16_t*)(ws + WS_H1), nullptr, A.out, nullptr, nullptr, A.in[I_LFG] + DM, A.in[I_LFB] + DM, bid, nb);
        SEAM(P + 10);
    }
}

__global__ void __launch_bounds__(512, 2) fwd_kernel(Args A) {
    extern __shared__ __attribute__((aligned(16))) unsigned char lds_raw[];
    LAS unsigned char* lds = (LAS unsigned char*)lds_raw;
    const int tid = threadIdx.x;
    unsigned* ctl = (unsigned*)(A.ws + WS_CTL);
    volatile LAS unsigned* misc = (volatile LAS unsigned*)(lds + LDS_MISC);
    if (tid < 64) misc[tid] = 0u;
    __syncthreads();
    const int lo = A.ph_lo, hi = A.ph_hi;
    XcdBarrier bar; bar.bar = ctl + CW_BAR; bar.x = 0; bar.st = misc;
    if (hi - lo > 1) bar = xcd_barrier_post(ctl + CW_BAR, misc);
    if (EN(11) && IN(0)) { phase_prologue(lds, A, blockIdx.x, gridDim.x); SEAM(0); }
    run_layer<0>(lds, A, bar, lo, hi);
    run_layer<1>(lds, A, bar, lo, hi);
}
#undef IN
#undef SEAM

#ifdef DBG
__device__ __forceinline__ unsigned hash32(unsigned x) { x ^= x >> 16; x *= 0x7feb352dU; x ^= x >> 15; x *= 0x846ca68bU; x ^= x >> 16; return x; }
__device__ __forceinline__ void dbg_acc(float* w, int stage, float num, float den) { if (!(num == num) || num > 1e30f) num = 1e30f; atomicAdd(w + 2 * stage, num); atomicAdd(w + 2 * stage + 1, den); }
__device__ __forceinline__ float bfr(float x) { return bflo(pk2(x, 0.f)); }
__global__ void dbg_weights(Args A, float* w) {
    const unsigned i = blockIdx.x * 256 + threadIdx.x; unsigned char* ws = A.ws;
    float num = 0.f, den = 0.f;
    { const unsigned hsh = hash32(i * 4 + 0), col = hsh % 3584, k = (hsh >> 12) % 1024; const float r = A.in[I_WINAB][(size_t)k * 3600 + col], g = bf2f(((const bf16_t*)(ws + WS_WAB))[(size_t)col * 1024 + k]); num += (r - g) * (r - g); den += r * r; }
    { const unsigned hsh = hash32(i * 4 + 1), j = hsh % 256, k = (hsh >> 12) % 1024; float r = 0.f; for (int q = 0; q < 16; ++q) r += A.in[I_WINAB][(size_t)k * 3600 + 3584 + q] * A.in[I_WGKUP][q * 256 + j];
      const float g = bf2f(((const bf16_t*)(ws + WS_WAB))[(size_t)(3584 + j) * 1024 + k]); num += (r - g) * (r - g); den += r * r; }
    { const unsigned hsh = hash32(i * 4 + 2), le = hsh % 514, layer = le / 257, e = le % 257, n = (hsh >> 10) % 512, k = (hsh >> 20) % 1024;
      const float r = (e < 256) ? A.in[I_WEI][((size_t)(layer * 256 + e) * 1024 + k) * 512 + n] : A.in[I_WSI][((size_t)layer * 1024 + k) * 512 + n];
      const unsigned up = n >> 8, c = n & 255, drow = (c >> 7) * 256 + up * 128 + (c & 127);
      const float g = bf2f(((const bf16_t*)(ws + WS_W1T))[((size_t)(layer * 257 + e) * 512 + drow) * 1024 + k]); num += (r - g) * (r - g); den += r * r; }
    { const unsigned hsh = hash32(i * 4 + 3), le = hsh % 514, layer = le / 257, e = le % 257, n = (hsh >> 10) % 1024, k = (hsh >> 20) % 256;
      const float r = (e < 256) ? A.in[I_WED][((size_t)(layer * 256 + e) * 256 + k) * 1024 + n] : A.in[I_WSD][((size_t)layer * 256 + k) * 1024 + n];
      const float g = bf2f(((const bf16_t*)(ws + WS_W2T))[((size_t)(layer * 257 + e) * 1024 + n) * 256 + k]); num += (r - g) * (r - g); den += r * r; }
    dbg_acc(w, 1, num, den);
}
__global__ void dbg_gemm(const bf16_t* Am, int K, const bf16_t* Bt, const void* out, int ldo, int out_f32, int nrows, int ncols, float* w, int stage) {
    const unsigned i = blockIdx.x * 256 + threadIdx.x; const unsigned hsh = hash32(i + 77u * stage), row = hsh % nrows, col = (hsh >> 11) % ncols;
    float r = 0.f; for (int k = 0; k < K; ++k) r += bf2f(Am[(size_t)row * K + k]) * bf2f(Bt[(size_t)col * K + k]);
    const float g = out_f32 ? ((const float*)out)[(size_t)row * ldo + col] : bf2f(((const bf16_t*)out)[(size_t)row * ldo + col]);
    dbg_acc(w, stage, (r - g) * (r - g), r * r);
}
template <int MODE> __global__ void __launch_bounds__(256, 1) dbg_mixer(MixP mp, int b, int h, int T, float* w, int stage) {
    constexpr int DK = (MODE == 1) ? 64 : 128, DV = (MODE == 2) ? 256 : 128;
    __shared__ float sq[128], sk[128], sa[128], red[256], sh_i, sh_f;
    const int tid = threadIdx.x;
    const int ldp = mp.ldp; const bf16_t* proj = mp.proj;
    int cq, ck, cv, cg, cy, cu = 3584 + h * 64;
    if (MODE == 0) { cq = h * 128; ck = 512 + h * 128; cv = 1024 + h * 128; cg = 1536 + h * 128; cy = h * 128; }
    else if (MODE == 1) { cq = 2048 + h * 64; ck = 2304 + h * 64; cv = 2560 + h * 128; cg = 3072 + h * 128; cy = 512 + h * 128; }
    else { cq = h * 128; ck = 512 + h * 128; cv = 1024 + h * 256; cg = 2048 + h * 256; cy = h * 256; }
    float S[DK];
#pragma unroll
    for (int d = 0; d < DK; ++d) S[d] = 0.f;
    float nst = 0.f, num = 0.f, den = 0.f;
    for (int t = 0; t < T; ++t) {
        const size_t tok = (size_t)b * SEQ + t; const bf16_t* pr = proj + tok * ldp;
        if (tid < DK) {
            const int d = tid;
            if (MODE == 0) { const float z = bf2f(pr[ck + d]), sg = 1.f / (1.f + expf(-z)), lb = mp.lb0[h * 128 + d]; sa[d] = lb + (1.f - lb) * sg; sk[d] = (1.f - lb) * (1.f - sg); const float qq = bf2f(pr[cq + d]); sq[d] = qq / (1.f + expf(-qq)); }
            else if (MODE == 1) { const float u = bf2f(pr[cu + d]) + mp.bgk[h * 64 + d]; const float ls = fminf(u, 0.f) - log1pf(expf(-fabsf(u))); sa[d] = expf(ls / 16.f); sk[d] = bf2f(pr[ck + d]); sq[d] = bf2f(pr[cq + d]) * 0.125f; }
            else { float aq = 0.f, ak = 0.f; for (int j = 0; j < 4; ++j) { const int tt = t - 3 + j; if (tt >= 0) { const bf16_t* p2 = proj + ((size_t)b * SEQ + tt) * ldp; aq += mp.conv[j * 1024 + cq + d] * bf2f(p2[cq + d]); ak += mp.conv[j * 1024 + ck + d] * bf2f(p2[ck + d]); } }
                sq[d] = aq / (1.f + expf(-aq)); sk[d] = ak / (1.f + expf(-ak)) * 0.08838834764831845f; }
        }
        if (MODE == 2 && tid == 0) { const float* gp = mp.gates + tok * 8; sh_i = expf(gp[h] + mp.bif[h]); const float x = gp[4 + h] + mp.bif[4 + h]; sh_f = 1.f / (1.f + expf(-x)); }
        __syncthreads();
        const float vt = bf2f(pr[cv + tid]);
        float o = 0.f;
        if (MODE == 2) { const float f = sh_f, ii = sh_i;
#pragma unroll
            for (int d = 0; d < DK; ++d) { S[d] = f * S[d] + ii * sk[d] * vt; o += S[d] * sq[d]; }
            if (tid < 128) nst = f * nst + ii * sk[tid];
            red[tid] = (tid < 128) ? nst * sq[tid] : 0.f;
        } else {
#pragma unroll
            for (int d = 0; d < DK; ++d) { S[d] = sa[d] * S[d] + sk[d] * vt; o += S[d] * sq[d]; }
            red[tid] = o * o;
        }
        __syncthreads();
        for (int st = DV / 2; st > 0; st >>= 1) { if (tid < st) red[tid] += red[tid + st]; __syncthreads(); }
        const float tot = red[0];
        const float gt = bf2f(pr[cg + tid]);
        float y;
        if (MODE == 2) y = o / fmaxf(fabsf(tot), 1.f) * (1.f / (1.f + expf(-gt)));
        else y = o * rsqrtf(tot / 128.f + 1e-6f) * ((MODE == 0) ? mp.hg : mp.gg)[h * 128 + tid] * (gt / (1.f + expf(-gt)));
        const float g = bf2f(mp.ymix[tok * DM + cy + tid]);
        num += (y - g) * (y - g); den += y * y;
        __syncthreads();
    }
    dbg_acc(w, stage, num, den);
}
__global__ void dbg_h1(const bf16_t* HIN, const bf16_t* YM, const bf16_t* Wt, const bf16_t* H1, const float* g, const float* bb, float* w, int stage) {
    __shared__ float red[256]; __shared__ float zrow[1024];
    const int tid = threadIdx.x; const unsigned row = hash32(blockIdx.x + 1000u * stage) % NTOK;
    float z[4];
    for (int q = 0; q < 4; ++q) { const int c = tid + 256 * q; float a = 0.f; for (int k = 0; k < 1024; ++k) a += bf2f(YM[(size_t)row * 1024 + k]) * bf2f(Wt[(size_t)c * 1024 + k]); z[q] = bfr(ALPHA * bf2f(HIN[(size_t)row * 1024 + c]) + a); }
    red[tid] = z[0] + z[1] + z[2] + z[3]; __syncthreads();
    for (int st = 128; st > 0; st >>= 1) { if (tid < st) red[tid] += red[tid + st]; __syncthreads(); }
    const float mu = red[0] / 1024.f; __syncthreads();
    red[tid] = (z[0] - mu) * (z[0] - mu) + (z[1] - mu) * (z[1] - mu) + (z[2] - mu) * (z[2] - mu) + (z[3] - mu) * (z[3] - mu); __syncthreads();
    for (int st = 128; st > 0; st >>= 1) { if (tid < st) red[tid] += red[tid + st]; __syncthreads(); }
    const float rs = rsqrtf(red[0] / 1024.f + 1e-5f);
    float num = 0.f, den = 0.f;
    for (int q = 0; q < 4; ++q) { const int c = tid + 256 * q; const float y = (z[q] - mu) * rs * g[c] + bb[c], gg = bf2f(H1[(size_t)row * 1024 + c]); num += (y - gg) * (y - gg); den += y * y; }
    dbg_acc(w, stage, num, den); (void)zrow;
}
__global__ void dbg_select(const float* logits, const float* rb, const int* tok_e, const float* tok_w, float* w, int stage) {
    __shared__ float sc[256], bs[256]; __shared__ int ce[8]; __shared__ float cs[8];
    if (threadIdx.x != 0) return;
    const unsigned tok = hash32(blockIdx.x + 31u * stage) % NTOK;
    const float* lp = logits + (size_t)tok * 256;
    for (int e = 0; e < 256; ++e) { sc[e] = 1.f / (1.f + expf(-lp[e])); bs[e] = sc[e] + rb[e]; }
    float gs[8];
#pragma unroll
    for (int g = 0; g < 8; ++g) { float m1 = -1e30f, m2 = -1e30f; for (int j = 0; j < 32; ++j) { const float v = bs[g * 32 + j]; if (v > m1) { m2 = m1; m1 = v; } else if (v > m2) m2 = v; } gs[g] = m1 + m2; }
    unsigned selmask = 0;
#pragma unroll
    for (int g = 0; g < 8; ++g) { int rank = 0;
#pragma unroll
        for (int q = 0; q < 8; ++q) rank += (gs[q] > gs[g] || (gs[q] == gs[g] && q < g)) ? 1 : 0; if (rank < 4) selmask |= 1u << g; }
    float tot = 0.f;
    for (int k = 0; k < 8; ++k) { float bv = -1e30f; int be = 0; for (int e = 0; e < 256; ++e) { if (!((selmask >> (e >> 5)) & 1u)) continue; bool used = false; for (int q = 0; q < k; ++q) used |= (ce[q] == e); if (used) continue; if (bs[e] > bv) { bv = bs[e]; be = e; } } ce[k] = be; cs[k] = sc[be]; tot += sc[be]; }
    float num = 0.f, den = 0.f;
    for (int k = 0; k < 8; ++k) { const float wr_ = cs[k] / tot * 2.5f; const int ge = tok_e[(size_t)tok * 8 + k]; const float gw = tok_w[(size_t)tok * 8 + k];
        num += (ge == ce[k] ? 0.f : 1.f) + (wr_ - gw) * (wr_ - gw); den += wr_ * wr_; }
    dbg_acc(w, stage, num, den);
}
template <bool FINAL> __global__ void dbg_moe(Args A, int layer, const int* tok_e, const float* tok_w, const bf16_t* H1, const bf16_t* H2, const float* OUT, float* w, int stage) {
    __shared__ float hrow[1024], hid[256], red[256];
    const int tid = threadIdx.x; const unsigned tok = hash32(blockIdx.x + 555u * stage) % NTOK;
    for (int i = tid; i < 1024; i += 256) hrow[i] = bf2f(H1[(size_t)tok * 1024 + i]);
    float acc[4] = {0.f, 0.f, 0.f, 0.f};
    __syncthreads();
    for (int k = 0; k < 9; ++k) {
        const int e = (k < 8) ? tok_e[(size_t)tok * 8 + k] : 256; const float wk = (k < 8) ? tok_w[(size_t)tok * 8 + k] : 1.f;
        const float* W1 = (e < 256) ? A.in[I_WEI] + (size_t)(layer * 256 + e) * 1024 * 512 : A.in[I_WSI] + (size_t)layer * 1024 * 512;
        const float* W2 = (e < 256) ? A.in[I_WED] + (size_t)(layer * 256 + e) * 256 * 1024 : A.in[I_WSD] + (size_t)layer * 256 * 1024;
        float gsum = 0.f, usum = 0.f;
        for (int kk = 0; kk < 1024; ++kk) { gsum += hrow[kk] * W1[(size_t)kk * 512 + tid]; usum += hrow[kk] * W1[(size_t)kk * 512 + 256 + tid]; }
        hid[tid] = gsum / (1.f + expf(-gsum)) * usum;
        __syncthreads();
        for (int q = 0; q < 4; ++q) { const int c = tid + 256 * q; float a = 0.f; for (int j = 0; j < 256; ++j) a += hid[j] * W2[(size_t)j * 1024 + c]; acc[q] += wk * a; }
        __syncthreads();
    }
    float z[4]; for (int q = 0; q < 4; ++q) z[q] = ALPHA * hrow[tid + 256 * q] + acc[q];
    red[tid] = z[0] + z[1] + z[2] + z[3]; __syncthreads();
    for (int st = 128; st > 0; st >>= 1) { if (tid < st) red[tid] += red[tid + st]; __syncthreads(); }
    const float mu = red[0] / 1024.f; __syncthreads();
    red[tid] = (z[0] - mu) * (z[0] - mu) + (z[1] - mu) * (z[1] - mu) + (z[2] - mu) * (z[2] - mu) + (z[3] - mu) * (z[3] - mu); __syncthreads();
    for (int st = 128; st > 0; st >>= 1) { if (tid < st) red[tid] += red[tid + st]; __syncthreads(); }
    const float rs = rsqrtf(red[0] / 1024.f + 1e-5f);
    const float* g = A.in[I_LFG] + layer * DM; const float* bb = A.in[I_LFB] + layer * DM;
    float num = 0.f, den = 0.f;
    for (int q = 0; q < 4; ++q) { const int c = tid + 256 * q; const float y = (z[q] - mu) * rs * g[c] + bb[c]; const float gg = FINAL ? OUT[(size_t)tok * 1024 + c] : bf2f(H2[(size_t)tok * 1024 + c]); num += (y - gg) * (y - gg); den += y * y; }
    dbg_acc(w, stage, num, den);
}
#ifndef DBG_REPORT
#define DBG_REPORT 0
#endif
__global__ void dbg_fill(float* out, const float* w) {
    __shared__ float cval;
    if (threadIdx.x == 0) {
        float c = 0.f;
        if (DBG_REPORT == 0) { for (int st = 1; st <= 13; ++st) { const float rel = sqrtf(w[2 * st] / fmaxf(w[2 * st + 1], 1e-30f)); if (!(rel < 0.08f) || !(w[2 * st + 1] > 0.f)) { c = (float)st; break; } } }
        else { const float rel = sqrtf(w[2 * DBG_REPORT] / fmaxf(w[2 * DBG_REPORT + 1], 1e-30f)); float l = -log10f(fmaxf(rel, 1e-8f)); l = fminf(fmaxf(l, -2.f), 8.f); c = 3.f + l; }
        cval = c;
    }
    __syncthreads();
    const float c = cval;
    if (c != 0.f) for (size_t i = (size_t)blockIdx.x * 256 + threadIdx.x; i < (size_t)NTOK * DM; i += (size_t)gridDim.x * 256) out[i] = c;
}
#endif

extern "C" void kernel_launch(void* const* d_in, const int* in_sizes, int n_in, void* d_out, int out_size, void* d_ws, size_t ws_size, hipStream_t stream) {
    static int grid = 0;
    if (grid == 0) {
        if (n_in != 22 || out_size != NTOK * DM || ws_size < WS_END) { fprintf(stderr, "kernel_launch: unexpected shapes (n_in %d out %d ws %zu)\n", n_in, out_size, ws_size); grid = -1; return; }
        if (hipFuncSetAttribute((const void*)fwd_kernel, hipFuncAttributeMaxDynamicSharedMemorySize, LDS_BYTES) != hipSuccess) { fprintf(stderr, "kernel_launch: hipFuncSetAttribute failed\n"); grid = -1; return; }
        int per_cu = 0;
        if (hipOccupancyMaxActiveBlocksPerMultiprocessor(&per_cu, (const void*)fwd_kernel, 512, LDS_BYTES) != hipSuccess || per_cu < 1) fprintf(stderr, "kernel_launch: occupancy query says %d\n", per_cu);
        (void)hipGetLastError();
        grid = NWG;
    }
    if (grid < 0) return;
    (void)hipMemsetAsync((char*)d_ws + WS_CTL, 0, CTL_BYTES, stream);
    Args a{};
    for (int i = 0; i < 22; ++i) a.in[i] = (const float*)d_in[i];
    a.out = (float*)d_out; a.ws = (unsigned char*)d_ws;
#if MK_ONE_LAUNCH
    a.ph_lo = 0; a.ph_hi = 23;
    hipLaunchKernelGGL(fwd_kernel, dim3(grid), dim3(512), LDS_BYTES, stream, a);
#else
    for (int p = 0; p < 23; ++p) { a.ph_lo = p; a.ph_hi = p + 1; hipLaunchKernelGGL(fwd_kernel, dim3(grid), dim3(512), LDS_BYTES, stream, a);
#ifdef DBG
        unsigned char* ws = (unsigned char*)d_ws; float* dw = (float*)(ws + WS_CTL) + CW_DBG;
        const int layer = (p - 1) / 11, q = (p - 1) % 11;
        MixP mp{(const bf16_t*)(ws + WS_PROJ), layer ? CWID : ABW, 0, (bf16_t*)(ws + WS_YMIX), (const float*)(ws + WS_GATES), (const float*)(ws + WS_MISC), a.in[I_BGK], a.in[I_HG], a.in[I_GG], a.in[I_CONV], a.in[I_BIF], (float*)(ws + WS_UST), (float*)(ws + WS_GSUM)};
        if (p == 0) hipLaunchKernelGGL(dbg_weights, dim3(256), dim3(256), 0, stream, a, dw);
        if (p >= 1 && q == 0) hipLaunchKernelGGL(dbg_gemm, dim3(64), dim3(256), 0, stream, (const bf16_t*)(ws + (layer ? WS_H2 : WS_HB)), 1024, (const bf16_t*)(ws + (layer ? WS_WC : WS_WAB)), (const void*)(ws + WS_PROJ), layer ? CWID : ABW, 0, NTOK, layer ? CWID : ABW, dw, layer ? 9 : 2);
        if (p >= 1 && q == 2 && layer == 0) { hipLaunchKernelGGL(dbg_mixer<0>, dim3(1), dim3(128), 0, stream, mp, 0, 1, 1100, dw, 3); hipLaunchKernelGGL(dbg_mixer<1>, dim3(1), dim3(128), 0, stream, mp, 1, 2, 1100, dw, 4); }
        if (p >= 1 && q == 2 && layer == 1) hipLaunchKernelGGL(dbg_mixer<2>, dim3(1), dim3(256), 0, stream, mp, 1, 1, 1100, dw, 10);
        if (p >= 1 && q == 4) hipLaunchKernelGGL(dbg_h1, dim3(32), dim3(256), 0, stream, (const bf16_t*)(ws + (layer ? WS_H2 : WS_HB)), (const bf16_t*)(ws + WS_YMIX), (const bf16_t*)(ws + (layer ? WS_WOC : WS_WOAB)), (const bf16_t*)(ws + WS_H1), a.in[I_LMG] + layer * DM, a.in[I_LMB] + layer * DM, dw, layer ? 11 : 5);
        if (p >= 1 && q == 5 && layer == 0) hipLaunchKernelGGL(dbg_gemm, dim3(64), dim3(256), 0, stream, (const bf16_t*)(ws + WS_H1), 1024, (const bf16_t*)(ws + WS_WR), (const void*)(ws + WS_LOGITS), 256, 1, NTOK, 256, dw, 6);
        if (p >= 1 && q == 6) hipLaunchKernelGGL(dbg_select, dim3(64), dim3(64), 0, stream, (const float*)(ws + WS_LOGITS), a.in[I_RB] + layer * NEXP, (const int*)(ws + WS_TOKE), (const float*)(ws + WS_TOKW), dw, layer ? 12 : 7);
        if (p >= 1 && q == 10 && layer == 0) hipLaunchKernelGGL(dbg_moe<false>, dim3(32), dim3(256), 0, stream, a, 0, (const int*)(ws + WS_TOKE), (const float*)(ws + WS_TOKW), (const bf16_t*)(ws + WS_H1), (const bf16_t*)(ws + WS_H2), (const float*)d_out, dw, 8);
        if (p >= 1 && q == 10 && layer == 1) { hipLaunchKernelGGL(dbg_moe<true>, dim3(32), dim3(256), 0, stream, a, 1, (const int*)(ws + WS_TOKE), (const float*)(ws + WS_TOKW), (const bf16_t*)(ws + WS_H1), (const bf16_t*)(ws + WS_H2), (const float*)d_out, dw, 13);
            hipLaunchKernelGGL(dbg_fill, dim3(1024), dim3(256), 0, stream, (float*)d_out, dw); }
#endif
    }
#endif
}
```

```cpp
#include <hip/hip_runtime.h>
#include <cstdio>
#include <cstdint>

#ifndef MK_ONE_LAUNCH
#define MK_ONE_LAUNCH 1
#endif

#define LAS __attribute__((address_space(3)))
typedef unsigned short bf16_t;
typedef short bf16x8 __attribute__((ext_vector_type(8)));
typedef float f32x4 __attribute__((ext_vector_type(4)));
typedef unsigned u32x4 __attribute__((ext_vector_type(4)));
typedef unsigned u32x2 __attribute__((ext_vector_type(2)));

constexpr int NTOK = 32768, SEQ = 16384, DM = 1024;
constexpr int ABW = 3840;
constexpr int CWID = 3072;
constexpr int NEXP = 256, NE1 = 257, TOPK = 8, NSLOT = 9;
constexpr float ALPHA = 1.41421356237f;
constexpr int NWG = 256;
constexpr int PRMAX = 262144 + 65536 + 32768;

constexpr size_t MiB = 1u << 20;
constexpr size_t WS_CTL = 0, CTL_BYTES = 1 * MiB;
constexpr size_t WS_MISC = 1 * MiB;
constexpr size_t WS_WAB = 2 * MiB, WS_WOAB = 10 * MiB, WS_WC = 12 * MiB, WS_WOC = 18 * MiB, WS_WR = 20 * MiB;
constexpr size_t WS_TOKE = 22 * MiB, WS_TOKP = 23 * MiB, WS_TOKW = 24 * MiB;
constexpr size_t WS_STOK = 26 * MiB, WS_POSY = 28 * MiB;
constexpr size_t WS_GATES = 32 * MiB;
constexpr size_t WS_UST = 34 * MiB, WS_GSUM = 54 * MiB;
constexpr size_t WS_LOGITS = 56 * MiB;
constexpr size_t WS_HB = 96 * MiB, WS_PROJ = 160 * MiB, WS_YMIX = 400 * MiB, WS_Z = 464 * MiB, WS_H1 = 528 * MiB, WS_H2 = 592 * MiB;
constexpr size_t WS_ACT = 656 * MiB, WS_Y = 832 * MiB, WS_W1T = 1540 * MiB, WS_W2T = 2056 * MiB, WS_END = 2320 * MiB;
constexpr int CW_BAR = 4096;
constexpr int CW_CNT = 16384;
constexpr int CW_DBG = 20480;

__device__ __forceinline__ unsigned pk2(float lo, float hi) { unsigned r; asm volatile("v_cvt_pk_bf16_f32 %0, %1, %2" : "=v"(r) : "v"(lo), "v"(hi)); return r; }
__device__ __forceinline__ float bflo(unsigned u) { return __uint_as_float(u << 16); }
__device__ __forceinline__ float bfhi(unsigned u) { return __uint_as_float(u & 0xffff0000u); }
__device__ __forceinline__ float bf2f(bf16_t b) { return __uint_as_float(((unsigned)b) << 16); }
__device__ __forceinline__ float sigm(float x) { return __builtin_amdgcn_rcpf(1.f + __expf(-x)); }
__device__ __forceinline__ float silu(float x) { return x * __builtin_amdgcn_rcpf(1.f + __expf(-x)); }
__device__ __forceinline__ float logsig(float x) { return fminf(x, 0.f) - __logf(1.f + __expf(-fabsf(x))); }

#define XB_TMO      128
#define XB_XCNT(j)  (256  + 64 * (j))
#define XB_XSUB(j)  (1280 + 64 * (j))
#define XB_XGEN(j)  (2304 + 64 * (j))
#define XB_TOP      3328
#define XB_TOPGEN   3392
#define XCD_BAR_WORDS 3456
#define XB_SPIN_CAP (1u << 22)
__device__ __forceinline__ unsigned xb_ld(unsigned* p)              { return __hip_atomic_load(p, __ATOMIC_RELAXED, __HIP_MEMORY_SCOPE_AGENT); }
__device__ __forceinline__ unsigned xb_add(unsigned* p, unsigned v) { return __hip_atomic_fetch_add(p, v, __ATOMIC_RELAXED, __HIP_MEMORY_SCOPE_AGENT); }
__device__ __forceinline__ unsigned xb_xcc_id() { return (unsigned)__builtin_amdgcn_s_getreg((3 << 11) | 20) & 0xFu; }
#define XB_SPIN(cond, bar) do { unsigned _sp = 0; while (cond) { __builtin_amdgcn_s_sleep(1); \
    if ((++_sp & 255u) == 0u) { if (xb_ld(&(bar)[XB_TMO])) break; if (_sp > XB_SPIN_CAP) { atomicAdd(&(bar)[XB_TMO], 1u); break; } } } } while (0)
struct XcdBarrier { unsigned* bar; unsigned x; volatile LAS unsigned* st; };
__device__ __forceinline__ XcdBarrier xcd_barrier_post(unsigned* bar, volatile LAS unsigned* st) {
    XcdBarrier b; b.bar = bar; b.x = xb_xcc_id(); b.st = st;
    if (threadIdx.x == 0) (void)xb_add(&bar[XB_XCNT(b.x)], 1u);
    return b;
}
__device__ __forceinline__ void xcd_barrier_complete(unsigned* bar, unsigned x, unsigned& nloc, unsigned& nx) {
    const unsigned G = gridDim.x * gridDim.y * gridDim.z;
    unsigned sum, cnt, mine, sp = 0u;
    for (;;) {
        sum = 0u; cnt = 0u; mine = 0u;
#pragma unroll
        for (unsigned j = 0; j < 16; ++j) { const unsigned c = xb_ld(&bar[XB_XCNT(j)]); sum += c; cnt += (c > 0u) ? 1u : 0u; mine = (j == x) ? c : mine; }
        if (sum == G) break;
        __builtin_amdgcn_s_sleep(1);
        if ((++sp & 255u) == 0u) { if (xb_ld(&bar[XB_TMO])) break; if (sp > XB_SPIN_CAP) { atomicAdd(&bar[XB_TMO], 1u); break; } }
    }
    nloc = mine > 0u ? mine : 1u; nx = cnt > 0u ? cnt : 1u;
}
__device__ __forceinline__ void xcd_barrier(const XcdBarrier& b) {
    asm volatile("s_waitcnt vmcnt(0)" ::: "memory");
    __syncthreads();
    if (threadIdx.x == 0) {
        unsigned* bar = b.bar;
        __builtin_amdgcn_s_waitcnt(0);
        unsigned nloc = b.st[0], nx = b.st[1];
        if (nloc == 0u) { xcd_barrier_complete(bar, b.x, nloc, nx); b.st[0] = nloc; b.st[1] = nx; }
        const unsigned old = xb_add(&bar[XB_XSUB(b.x)], 1u);
        const unsigned gen = old / nloc;
        if (old + 1u == (gen + 1u) * nloc) {
            __builtin_amdgcn_fence(__ATOMIC_RELEASE, "agent");
            asm volatile("s_waitcnt vmcnt(0)" ::: "memory");
            const unsigned og = xb_add(&bar[XB_TOP], 1u);
            const unsigned tg = og / nx;
            if (og + 1u == (tg + 1u) * nx) xb_add(&bar[XB_TOPGEN], 1u);
            else XB_SPIN(xb_ld(&bar[XB_TOPGEN]) == tg, bar);
            __builtin_amdgcn_fence(__ATOMIC_ACQUIRE, "agent");
            xb_add(&bar[XB_XGEN(b.x)], 1u);
            asm volatile("s_waitcnt vmcnt(0)" ::: "memory");
        } else {
            XB_SPIN(xb_ld(&bar[XB_XGEN(b.x)]) == gen, bar);
            __builtin_amdgcn_fence(__ATOMIC_ACQUIRE, "agent");
            asm volatile("s_waitcnt vmcnt(0)" ::: "memory");
        }
    }
    __syncthreads();
}

namespace pg8 {
constexpr int BM = 256, BK = 64, HALF = 128, HTB = HALF * BK * 2, STAGE_BYTES = 8 * HTB, NXCD = 8, WGM = 8;
__device__ __forceinline__ int lds_byte(int r, int c) { const int st = (r >> 4) * 2 + (c >> 5), rr = r & 15, cc = c & 31, ob = rr * 64 + cc * 2; return st * 1024 + (ob ^ (((ob >> 9) & 1) << 5)); }
__device__ __forceinline__ void stage_rc(int b, int& R, int& C) { const int st = b / 1024, sb = b % 1024, swz = sb ^ (((sb >> 9) & 1) << 5); R = (st >> 1) * 16 + swz / 64; C = (st & 1) * 32 + (swz % 64) / 2; }
__device__ __forceinline__ int perm32(int rho) { const int n = rho >> 4, i = rho & 15; return 8 * (i >> 2) + 4 * n + (i & 3); }
struct Unit { int pm, pn; };
struct Gemm { const bf16_t* A; const bf16_t* Bt; int K; };

struct StaticOrder {
    int nM, nN, nwg, G, c;
    __device__ void init(int M, int N, int G_, int c_) { nM = M / BM; nN = N / BM; nwg = nM * nN; G = G_; c = c_; }
    __device__ bool next(int i, Unit& u) const {
        const long L = (long)i * G + c; if (L >= nwg) return false;
        int wgid = (int)L; { const int q = nwg / NXCD, r = nwg % NXCD, xcd = wgid % NXCD, off = wgid / NXCD; wgid = (xcd < r ? xcd * (q + 1) : r * (q + 1) + (xcd - r) * q) + off; }
        const int nig = WGM * nN, gid = wgid / nig, fm = gid * WGM, gsz = (nM - fm) < WGM ? (nM - fm) : WGM;
        u.pm = fm + ((wgid % nig) % gsz); u.pn = (wgid % nig) / gsz; return true;
    }
};
struct MoeOrder {
    const int* tile_exp; int nunits, sh, G, c;
    __device__ bool next(int i, Unit& u) const {
        const long L = (long)i * G + c; if (L >= nunits) return false;
        const int rt = (int)(L >> sh), j = (int)L & ((1 << sh) - 1);
        const int e = __builtin_amdgcn_readfirstlane(tile_exp[rt]);
        u.pm = rt; u.pn = (e << sh) + j; return true;
    }
};

template <class Epi, class Sched, bool GATHER>
__device__ __forceinline__ void gemm_phase(LAS unsigned char* lds, const Gemm g, const int* __restrict__ rowidx, const Sched& S, const Epi& E) {
    const int tid = threadIdx.x, wid = __builtin_amdgcn_readfirstlane(tid >> 6), lane = tid & 63, wr = wid >> 2, wc = wid & 3, fr = lane & 15, fq = lane >> 4;
    const int K = g.K, nt = K / BK;
    unsigned voffB[2], cofs[2]; int Rr[2];
#pragma unroll
    for (int i = 0; i < 2; ++i) { int R, C; stage_rc(tid * 16 + i * 8192, R, C); const int Rb = Epi::PERM ? ((R & ~31) + perm32(R & 31)) : R;
        Rr[i] = R; cofs[i] = (unsigned)C * 2u; voffB[i] = (unsigned)(Rb * K + C) * 2u; }
    const unsigned rowb = (unsigned)K * 2u;
    const size_t kstep = (size_t)(BK * 2);
    const size_t hstep = (size_t)HALF * K * 2;
    const size_t tstep = 2 * hstep;
    const unsigned ldsw = (unsigned)wid * 1024u;
    const int aoff = lds_byte(wr * 64 + fr, fq * 8), boff = lds_byte(wc * 32 + fr, fq * 8);
    const char* Abase = (const char*)g.A;
#define PG8_SA(b, h) (((b) * 2 + (h)) * HTB)
#define PG8_SB(b, h) ((4 + (b) * 2 + (h)) * HTB)
#define PG8_STAGE(bufoff, gbase, voff) do { _Pragma("unroll") for (int _i = 0; _i < 2; ++_i) \
        __builtin_amdgcn_global_load_lds((const unsigned*)((const char*)(gbase) + (voff)[_i]), (LAS unsigned*)(lds + (bufoff) + ldsw + _i * 8192), 16, 0, 0); } while (0)
#define PG8_STAGEA(bufoff, kb, offs) do { _Pragma("unroll") for (int _i = 0; _i < 2; ++_i) \
        __builtin_amdgcn_global_load_lds((const unsigned*)(Abase + (size_t)((kb) + (offs)[_i])), (LAS unsigned*)(lds + (bufoff) + ldsw + _i * 8192), 16, 0, 0); } while (0)
#define PG8_ROWOFF(u, O) do { _Pragma("unroll") for (int _h = 0; _h < 2; ++_h) _Pragma("unroll") for (int _i = 0; _i < 2; ++_i) { \
        int _row = (u).pm * BM + _h * HALF + Rr[_i]; if (GATHER) _row = rowidx[_row]; (O)[_h][_i] = (unsigned)_row * rowb + cofs[_i]; } } while (0)
#define PG8_LDA(dst, b, h) do { _Pragma("unroll") for (int m = 0; m < 4; ++m) _Pragma("unroll") for (int k = 0; k < 2; ++k) dst[m][k] = *(const LAS bf16x8*)(lds + PG8_SA(b, h) + aoff + m * 2048 + k * 1024); } while (0)
#define PG8_LDB(dst, b, h) do { _Pragma("unroll") for (int n = 0; n < 2; ++n) _Pragma("unroll") for (int k = 0; k < 2; ++k) dst[n][k] = *(const LAS bf16x8*)(lds + PG8_SB(b, h) + boff + n * 2048 + k * 1024); } while (0)
#define PG8_MMA(ai, bj, At, Bt) do { __builtin_amdgcn_s_setprio(1); _Pragma("unroll") for (int m = 0; m < 4; ++m) _Pragma("unroll") for (int n = 0; n < 2; ++n) _Pragma("unroll") for (int k = 0; k < 2; ++k) \
        acc[ai][bj][m][n] = __builtin_amdgcn_mfma_f32_16x16x32_bf16(Bt[n][k], At[m][k], acc[ai][bj][m][n], 0, 0, 0); __builtin_amdgcn_s_setprio(0); } while (0)
#define PG8_WAIT_V(n) asm volatile("s_waitcnt vmcnt(" #n ")" ::: "memory")
#define PG8_WAIT_L(n) asm volatile("s_waitcnt lgkmcnt(" #n ")" ::: "memory")
#define PG8_BAR __builtin_amdgcn_s_barrier()
#define PG8_SCHED __builtin_amdgcn_sched_barrier(0)
    Unit cur, nxt; int ui = 0;
    if (!S.next(0, cur)) return;
    f32x4 acc[2][2][4][2];
#pragma unroll
    for (int a = 0; a < 2; ++a)
#pragma unroll
        for (int b = 0; b < 2; ++b)
#pragma unroll
            for (int m = 0; m < 4; ++m)
#pragma unroll
                for (int n = 0; n < 2; ++n) acc[a][b][m][n] = (f32x4){0.f, 0.f, 0.f, 0.f};
    bf16x8 At[4][2], B0[2][2], B1[2][2];
    unsigned cO[2][2], nO[2][2];
    PG8_ROWOFF(cur, cO);
    const char* cB = (const char*)g.Bt + (size_t)cur.pn * tstep;
    PG8_STAGE(PG8_SB(0, 0), cB, voffB); PG8_STAGE(PG8_SB(0, 1), cB + hstep, voffB); PG8_STAGEA(PG8_SA(0, 0), 0u, cO[0]); PG8_STAGEA(PG8_SA(0, 1), 0u, cO[1]);
    if (wr == 1) PG8_BAR;
    PG8_WAIT_V(2); PG8_BAR;
    PG8_STAGE(PG8_SB(1, 0), cB + kstep, voffB); PG8_STAGEA(PG8_SA(1, 0), (unsigned)kstep, cO[0]); PG8_STAGE(PG8_SB(1, 1), cB + hstep + kstep, voffB);
    PG8_WAIT_V(6); PG8_BAR;
    for (;;) {
        const bool has_next = S.next(ui + 1, nxt);
        const char* nB = has_next ? (const char*)g.Bt + (size_t)nxt.pn * tstep : cB;
#pragma unroll
        for (int h = 0; h < 2; ++h)
#pragma unroll
            for (int i = 0; i < 2; ++i) nO[h][i] = cO[h][i];
#pragma unroll 1
        for (int t = 0; t < nt; t += 2) {
            const bool last = (t == nt - 2);
            if (last && has_next) PG8_ROWOFF(nxt, nO);
            const unsigned k1 = (unsigned)(t + 1) * (unsigned)kstep;
            const unsigned k2 = last ? 0u : (unsigned)(t + 2) * (unsigned)kstep, k3 = k2 + (unsigned)kstep;
            const char* b2 = last ? nB : cB + (size_t)(t + 2) * kstep; const char* b3 = b2 + kstep;
            unsigned o2[2][2];
#pragma unroll
            for (int h = 0; h < 2; ++h)
#pragma unroll
                for (int i = 0; i < 2; ++i) o2[h][i] = last ? nO[h][i] : cO[h][i];
            PG8_LDB(B0, 0, 0); PG8_LDB(B1, 0, 1); PG8_SCHED; PG8_LDA(At, 0, 0); PG8_STAGEA(PG8_SA(1, 1), k1, cO[1]);
            PG8_WAIT_V(8); PG8_WAIT_L(0); PG8_BAR; PG8_MMA(0, 0, At, B0); PG8_MMA(0, 1, At, B1); PG8_BAR; PG8_SCHED;
            PG8_LDA(At, 0, 1); PG8_STAGE(PG8_SB(0, 0), b2, voffB); PG8_STAGE(PG8_SB(0, 1), b2 + hstep, voffB); PG8_STAGEA(PG8_SA(0, 0), k2, o2[0]);
            PG8_WAIT_V(8); PG8_WAIT_L(0); PG8_BAR; PG8_MMA(1, 0, At, B0); PG8_MMA(1, 1, At, B1); PG8_BAR; PG8_SCHED;
            PG8_LDB(B0, 1, 0); PG8_LDB(B1, 1, 1); PG8_SCHED; PG8_LDA(At, 1, 0); PG8_STAGEA(PG8_SA(0, 1), k2, o2[1]);
            PG8_WAIT_V(8); PG8_WAIT_L(0); PG8_BAR; PG8_MMA(0, 0, At, B0); PG8_MMA(0, 1, At, B1); PG8_BAR; PG8_SCHED;
            PG8_LDA(At, 1, 1); PG8_STAGE(PG8_SB(1, 0), b3, voffB); PG8_STAGE(PG8_SB(1, 1), b3 + hstep, voffB); PG8_STAGEA(PG8_SA(1, 0), k3, o2[0]);
            PG8_WAIT_V(8); PG8_WAIT_L(0); PG8_BAR; PG8_MMA(1, 0, At, B0); PG8_MMA(1, 1, At, B1); PG8_BAR; PG8_SCHED;
        }
        if (wr == 0) PG8_BAR;
        E(acc, cur, wr, wc, fr, fq);
        if (!has_next) break;
#pragma unroll
        for (int a = 0; a < 2; ++a)
#pragma unroll
            for (int b = 0; b < 2; ++b)
#pragma unroll
                for (int m = 0; m < 4; ++m)
#pragma unroll
                    for (int n = 0; n < 2; ++n) acc[a][b][m][n] = (f32x4){0.f, 0.f, 0.f, 0.f};
        cur = nxt; cB = nB; ++ui;
#pragma unroll
        for (int h = 0; h < 2; ++h)
#pragma unroll
            for (int i = 0; i < 2; ++i) cO[h][i] = nO[h][i];
        if (wr == 1) PG8_BAR;
    }
    PG8_WAIT_V(0);
    PG8_BAR;
#undef PG8_SA
#undef PG8_SB
#undef PG8_STAGE
#undef PG8_STAGEA
#undef PG8_ROWOFF
#undef PG8_LDA
#undef PG8_LDB
#undef PG8_MMA
#undef PG8_WAIT_V
#undef PG8_WAIT_L
#undef PG8_BAR
#undef PG8_SCHED
}

struct EpiStoreBf16 {
    static constexpr bool PERM = true;
    bf16_t* O; int ldc;
    __device__ __forceinline__ void operator()(const f32x4 (&acc)[2][2][4][2], const Unit& u, int wr, int wc, int fr, int fq) const {
        const int row0 = u.pm * BM + wr * 64 + fr, col0 = u.pn * BM + wc * 32 + 8 * fq;
#pragma unroll
        for (int ai = 0; ai < 2; ++ai)
#pragma unroll
            for (int m = 0; m < 4; ++m) { bf16_t* rowp = O + (size_t)(row0 + ai * HALF + m * 16) * ldc + col0;
#pragma unroll
                for (int bj = 0; bj < 2; ++bj) { const f32x4 v0 = acc[ai][bj][m][0], v1 = acc[ai][bj][m][1];
                    u32x4 w; w.x = pk2(v0[0], v0[1]); w.y = pk2(v0[2], v0[3]); w.z = pk2(v1[0], v1[1]); w.w = pk2(v1[2], v1[3]);
                    *(u32x4*)(rowp + bj * HALF) = w; } }
    }
};
struct EpiResid {
    static constexpr bool PERM = true;
    bf16_t* Z; const bf16_t* H;
    __device__ __forceinline__ void operator()(const f32x4 (&acc)[2][2][4][2], const Unit& u, int wr, int wc, int fr, int fq) const {
        const int row0 = u.pm * BM + wr * 64 + fr, col0 = u.pn * BM + wc * 32 + 8 * fq;
#pragma unroll
        for (int ai = 0; ai < 2; ++ai)
#pragma unroll
            for (int m = 0; m < 4; ++m) { const size_t ro = (size_t)(row0 + ai * HALF + m * 16) * DM + col0;
#pragma unroll
                for (int bj = 0; bj < 2; ++bj) { const f32x4 v0 = acc[ai][bj][m][0], v1 = acc[ai][bj][m][1];
                    const u32x4 hh = *(const u32x4*)(H + ro + bj * HALF);
                    u32x4 w;
                    w.x = pk2(ALPHA * bflo(hh.x) + v0[0], ALPHA * bfhi(hh.x) + v0[1]); w.y = pk2(ALPHA * bflo(hh.y) + v0[2], ALPHA * bfhi(hh.y) + v0[3]);
                    w.z = pk2(ALPHA * bflo(hh.z) + v1[0], ALPHA * bfhi(hh.z) + v1[1]); w.w = pk2(ALPHA * bflo(hh.w) + v1[2], ALPHA * bfhi(hh.w) + v1[3]);
                    *(u32x4*)(Z + ro + bj * HALF) = w; } }
    }
};
struct EpiF32 {
    static constexpr bool PERM = false;
    float* C;
    __device__ __forceinline__ void operator()(const f32x4 (&acc)[2][2][4][2], const Unit& u, int wr, int wc, int fr, int fq) const {
        const int row0 = u.pm * BM + wr * 64 + fr, col0 = wc * 32 + 4 * fq;
#pragma unroll
        for (int ai = 0; ai < 2; ++ai)
#pragma unroll
            for (int m = 0; m < 4; ++m) { float* rowp = C + (size_t)(row0 + ai * HALF + m * 16) * 256 + col0;
#pragma unroll
                for (int bj = 0; bj < 2; ++bj)
#pragma unroll
                    for (int n = 0; n < 2; ++n) *(f32x4*)(rowp + bj * HALF + n * 16) = acc[ai][bj][m][n]; }
    }
};
struct EpiSwiGLU {
    static constexpr bool PERM = true;
    bf16_t* ACT;
    __device__ __forceinline__ void operator()(const f32x4 (&acc)[2][2][4][2], const Unit& u, int wr, int wc, int fr, int fq) const {
        const int row0 = u.pm * BM + wr * 64 + fr, col0 = (u.pn & 1) * 128 + wc * 32 + 8 * fq;
#pragma unroll
        for (int ai = 0; ai < 2; ++ai)
#pragma unroll
            for (int m = 0; m < 4; ++m) { bf16_t* rowp = ACT + (size_t)(row0 + ai * HALF + m * 16) * 256 + col0;
                const f32x4 g0 = acc[ai][0][m][0], g1 = acc[ai][0][m][1], u0 = acc[ai][1][m][0], u1 = acc[ai][1][m][1];
                u32x4 w; w.x = pk2(silu(g0[0]) * u0[0], silu(g0[1]) * u0[1]); w.y = pk2(silu(g0[2]) * u0[2], silu(g0[3]) * u0[3]);
                w.z = pk2(silu(g1[0]) * u1[0], silu(g1[1]) * u1[1]); w.w = pk2(silu(g1[2]) * u1[2], silu(g1[3]) * u1[3]);
                *(u32x4*)rowp = w; }
    }
};
struct EpiDown {
    static constexpr bool PERM = true;
    bf16_t* Y;
    __device__ __forceinline__ void operator()(const f32x4 (&acc)[2][2][4][2], const Unit& u, int wr, int wc, int fr, int fq) const {
        const int row0 = u.pm * BM + wr * 64 + fr, col0 = (u.pn & 3) * 256 + wc * 32 + 8 * fq;
#pragma unroll
        for (int ai = 0; ai < 2; ++ai)
#pragma unroll
            for (int m = 0; m < 4; ++m) { bf16_t* rowp = Y + (size_t)(row0 + ai * HALF + m * 16) * DM + col0;
#pragma unroll
                for (int bj = 0; bj < 2; ++bj) { const f32x4 v0 = acc[ai][bj][m][0], v1 = acc[ai][bj][m][1];
                    u32x4 w; w.x = pk2(v0[0], v0[1]); w.y = pk2(v0[2], v0[3]); w.z = pk2(v1[0], v1[1]); w.w = pk2(v1[2], v1[3]);
                    *(u32x4*)(rowp + bj * HALF) = w; } }
    }
};
}

struct Args { const float* in[22]; float* out; unsigned char* ws; int ph_lo, ph_hi; };
enum { I_X = 0, I_WINAB, I_WGKUP, I_BGK, I_HG, I_GG, I_WOAB, I_LB, I_WINC, I_CONV, I_BIF, I_WOC, I_WR, I_RB, I_WEI, I_WED, I_WSI, I_WSD, I_LMG, I_LMB, I_LFG, I_LFB };

constexpr int LDS_MISC = 147200;
constexpr int LDS_BYTES = 147456;

__device__ __forceinline__ void cvt_tile(LAS unsigned char* lds, const float* __restrict__ src, size_t ldn, int k0, int n0, bf16_t* __restrict__ dst, int K, int drow0) {
    const int t = threadIdx.x;
    { const int c4 = (t & 15) * 4, r2 = t >> 4;
      const f32x4 a = *(const f32x4*)(src + (size_t)(k0 + 2 * r2) * ldn + n0 + c4);
      const f32x4 b = *(const f32x4*)(src + (size_t)(k0 + 2 * r2 + 1) * ldn + n0 + c4);
#pragma unroll
      for (int i = 0; i < 4; ++i) *(LAS unsigned*)(lds + ((c4 + i) * 72 + 2 * r2) * 2) = pk2(a[i], b[i]); }
    __syncthreads();
    { const int kk = (t & 7) * 8, n = t >> 3;
      const u32x4 v = *(const LAS u32x4*)(lds + (n * 72 + kk) * 2);
      *(u32x4*)(dst + (size_t)(drow0 + n) * K + k0 + kk) = v; }
    __syncthreads();
}
template <int NT>
__device__ __forceinline__ void cvt_multi(LAS unsigned char* lds, const float* __restrict__ src, size_t ldn, int k0, int n0, bf16_t* __restrict__ dst, int K, const int (&drow)[NT]) {
    const int t = threadIdx.x;
    { const int c4 = (t & 15) * 4, r2 = t >> 4;
      f32x4 a[NT], b[NT];
#pragma unroll
      for (int q = 0; q < NT; ++q) { a[q] = *(const f32x4*)(src + (size_t)(k0 + 2 * r2) * ldn + n0 + 64 * q + c4); b[q] = *(const f32x4*)(src + (size_t)(k0 + 2 * r2 + 1) * ldn + n0 + 64 * q + c4); }
#pragma unroll
      for (int q = 0; q < NT; ++q)
#pragma unroll
          for (int i = 0; i < 4; ++i) *(LAS unsigned*)(lds + q * 9216 + ((c4 + i) * 72 + 2 * r2) * 2) = pk2(a[q][i], b[q][i]); }
    __syncthreads();
    { const int kk = (t & 7) * 8, n = t >> 3;
#pragma unroll
      for (int q = 0; q < NT; ++q) { const u32x4 v = *(const LAS u32x4*)(lds + q * 9216 + (n * 72 + kk) * 2); *(u32x4*)(dst + (size_t)(drow[q] + n) * K + k0 + kk) = v; } }
    __syncthreads();
}
template <int NT>
__device__ __forceinline__ void cvt_matrix(LAS unsigned char* lds, const float* src, size_t ldn, int K, int n_lo, int ncols, bf16_t* dst, int drow_lo, int bid, int nb) {
    const int tk = K / 64, tn = ncols / (64 * NT);
    for (int j = bid; j < tk * tn; j += nb) { const int a = j / tn, b = j % tn; int dr[NT];
#pragma unroll
        for (int q = 0; q < NT; ++q) dr[q] = drow_lo + (b * NT + q) * 64;
        cvt_multi<NT>(lds, src, ldn, a * 64, n_lo + b * 64 * NT, dst, K, dr); }
}
__device__ __forceinline__ void phase_prologue(LAS unsigned char* lds, const Args& A, int bid, int nb) {
    unsigned char* ws = A.ws; const int tid = threadIdx.x;
    if (bid == 0) {
        float* lb0 = (float*)(ws + WS_MISC);
        const float* l = A.in[I_LB];
        if (tid < 512) { const float a = l[tid], b = l[512 + tid], c = l[1024 + tid]; const float m = fmaxf(a, fmaxf(b, c));
            const float ea = __expf(a - m), eb = __expf(b - m), ec = __expf(c - m); lb0[tid] = ea / (ea + eb + ec); }
    }
    if (bid == 1 % nb) {
        float* wg = (float*)(ws + WS_MISC + 4096);
        for (int i = tid; i < 8 * 1024; i += 512) { const int g = i >> 10, k = i & 1023; wg[i] = A.in[I_WINC][(size_t)k * 3080 + 3072 + g]; }
    }
    { const float* x = A.in[I_X]; bf16_t* hb = (bf16_t*)(ws + WS_HB);
      for (size_t i = ((size_t)bid * 512 + tid) * 8; i < (size_t)NTOK * DM; i += (size_t)nb * 512 * 8) {
          const f32x4 a = *(const f32x4*)(x + i), b = *(const f32x4*)(x + i + 4);
          u32x4 w; w.x = pk2(a[0], a[1]); w.y = pk2(a[2], a[3]); w.z = pk2(b[0], b[1]); w.w = pk2(b[2], b[3]);
          *(u32x4*)(hb + i) = w; } }
    { bf16_t* wab = (bf16_t*)(ws + WS_WAB); const float* win = A.in[I_WINAB]; const float* wup = A.in[I_WGKUP];
      for (int o = bid * 512 + tid; o < 256 * 128; o += nb * 512) { const int j = o >> 7, k8 = (o & 127) * 8;
          float up[16];
#pragma unroll
          for (int r = 0; r < 16; ++r) up[r] = wup[r * 256 + j];
          float res[8];
#pragma unroll
          for (int q = 0; q < 8; ++q) { const float* wr_ = win + (size_t)(k8 + q) * 3600 + 3584; float s = 0.f;
#pragma unroll
              for (int r = 0; r < 16; ++r) s += wr_[r] * up[r];
              res[q] = s; }
          u32x4 w; w.x = pk2(res[0], res[1]); w.y = pk2(res[2], res[3]); w.z = pk2(res[4], res[5]); w.w = pk2(res[6], res[7]);
          *(u32x4*)(wab + (size_t)(3584 + j) * 1024 + k8) = w; } }
    cvt_matrix<8>(lds, A.in[I_WINAB], 3600, 1024, 0, 3584, (bf16_t*)(ws + WS_WAB), 0, bid, nb);
    cvt_matrix<8>(lds, A.in[I_WOAB], 1024, 1024, 0, 1024, (bf16_t*)(ws + WS_WOAB), 0, bid, nb);
    cvt_matrix<8>(lds, A.in[I_WINC], 3080, 1024, 0, 3072, (bf16_t*)(ws + WS_WC), 0, bid, nb);
    cvt_matrix<8>(lds, A.in[I_WOC], 1024, 1024, 0, 1024, (bf16_t*)(ws + WS_WOC), 0, bid, nb);
    cvt_matrix<4>(lds, A.in[I_WR], 256, 1024, 0, 256, (bf16_t*)(ws + WS_WR), 0, bid, nb);
    cvt_matrix<4>(lds, A.in[I_WR] + 1024 * 256, 256, 1024, 0, 256, (bf16_t*)(ws + WS_WR) + 256 * 1024, 0, bid, nb);
    for (int j = bid; j < 2 * NE1 * 24; j += nb) {
        const int le = j / 24, t = j % 24, layer = le / NE1, e = le % NE1;
        if (t < 16) {
            const float* src = (e < NEXP) ? A.in[I_WEI] + ((size_t)(layer * NEXP + e)) * 1024 * 512 : A.in[I_WSI] + (size_t)layer * 1024 * 512;
            bf16_t* dst = (bf16_t*)(ws + WS_W1T) + ((size_t)(layer * NE1 + e)) * 512 * 1024;
            int dr[8];
#pragma unroll
            for (int q = 0; q < 8; ++q) { const int n0 = q * 64, half = n0 >> 8, nn = n0 & 255; dr[q] = (nn >> 7) * 256 + half * 128 + (nn & 127); }
            cvt_multi<8>(lds, src, 512, t * 64, 0, dst, 1024, dr);
        } else {
            const int t2 = t - 16, tk = t2 >> 1, hn = t2 & 1;
            const float* src = (e < NEXP) ? A.in[I_WED] + ((size_t)(layer * NEXP + e)) * 256 * 1024 : A.in[I_WSD] + (size_t)layer * 256 * 1024;
            bf16_t* dst = (bf16_t*)(ws + WS_W2T) + ((size_t)(layer * NE1 + e)) * 1024 * 256;
            int dr[8];
#pragma unroll
            for (int q = 0; q < 8; ++q) dr[q] = hn * 512 + q * 64;
            cvt_multi<8>(lds, src, 1024, tk * 64, hn * 512, dst, 256, dr);
        }
    }
}

__device__ __forceinline__ void phase_ln(const bf16_t* __restrict__ Z, bf16_t* __restrict__ H, const float* __restrict__ g, const float* __restrict__ b, int bid, int nb) {
    const int lane = threadIdx.x & 63, gw = bid * 8 + (threadIdx.x >> 6), nw = nb * 8;
    float gg[16], bb[16];
#pragma unroll
    for (int i = 0; i < 8; ++i) { gg[i] = g[lane * 8 + i]; gg[8 + i] = g[512 + lane * 8 + i]; bb[i] = b[lane * 8 + i]; bb[8 + i] = b[512 + lane * 8 + i]; }
    for (int row = gw; row < NTOK; row += nw) {
        const u32x4 a = *(const u32x4*)(Z + (size_t)row * DM + lane * 8), c = *(const u32x4*)(Z + (size_t)row * DM + 512 + lane * 8);
        float v[16];
        v[0] = bflo(a.x); v[1] = bfhi(a.x); v[2] = bflo(a.y); v[3] = bfhi(a.y); v[4] = bflo(a.z); v[5] = bfhi(a.z); v[6] = bflo(a.w); v[7] = bfhi(a.w);
        v[8] = bflo(c.x); v[9] = bfhi(c.x); v[10] = bflo(c.y); v[11] = bfhi(c.y); v[12] = bflo(c.z); v[13] = bfhi(c.z); v[14] = bflo(c.w); v[15] = bfhi(c.w);
        float s = 0.f;
#pragma unroll
        for (int i = 0; i < 16; ++i) s += v[i];
#pragma unroll
        for (int o = 32; o > 0; o >>= 1) s += __shfl_xor(s, o);
        const float mu = s * (1.f / 1024.f);
        float q = 0.f;
#pragma unroll
        for (int i = 0; i < 16; ++i) { const float d = v[i] - mu; q += d * d; }
#pragma unroll
        for (int o = 32; o > 0; o >>= 1) q += __shfl_xor(q, o);
        const float rs = rsqrtf(q * (1.f / 1024.f) + 1e-5f);
        float y[16];
#pragma unroll
        for (int i = 0; i < 16; ++i) y[i] = (v[i] - mu) * rs * gg[i] + bb[i];
        u32x4 w0, w1; w0.x = pk2(y[0], y[1]); w0.y = pk2(y[2], y[3]); w0.z = pk2(y[4], y[5]); w0.w = pk2(y[6], y[7]);
        w1.x = pk2(y[8], y[9]); w1.y = pk2(y[10], y[11]); w1.z = pk2(y[12], y[13]); w1.w = pk2(y[14], y[15]);
        *(u32x4*)(H + (size_t)row * DM + lane * 8) = w0; *(u32x4*)(H + (size_t)row * DM + 512 + lane * 8) = w1;
    }
}

template <bool FINAL>
__device__ __forceinline__ void phase_combine(const bf16_t* __restrict__ Y, const int* __restrict__ posy, const float* __restrict__ tokw, const int* __restrict__ ntiles,
                                              const bf16_t* __restrict__ H1, bf16_t* __restrict__ H2, float* __restrict__ OUT, float* __restrict__ GATES,
                                              const float* __restrict__ wgate, const float* __restrict__ g, const float* __restrict__ b, int bid, int nb) {
    const int shbase = (*ntiles - NTOK / 256) * 256;
    const int lane = threadIdx.x & 63, gw = bid * 8 + (threadIdx.x >> 6), nw = nb * 8;
    int npos = 0; float nwk = 0.f;
    if (gw < NTOK) { npos = (lane < 8) ? posy[(size_t)gw * 8 + lane] : shbase + gw; nwk = (lane < 8) ? tokw[(size_t)gw * 8 + lane] : 1.0f; }
    for (int row = gw; row < NTOK; row += nw) {
        const int cpos = npos; const float cwk = nwk;
        { const int nr = row + nw; if (nr < NTOK) { npos = (lane < 8) ? posy[(size_t)nr * 8 + lane] : shbase + nr; nwk = (lane < 8) ? tokw[(size_t)nr * 8 + lane] : 1.0f; } }
        float v[16];
        { const u32x4 a = *(const u32x4*)(H1 + (size_t)row * DM + lane * 8), c = *(const u32x4*)(H1 + (size_t)row * DM + 512 + lane * 8);
          v[0] = bflo(a.x); v[1] = bfhi(a.x); v[2] = bflo(a.y); v[3] = bfhi(a.y); v[4] = bflo(a.z); v[5] = bfhi(a.z); v[6] = bflo(a.w); v[7] = bfhi(a.w);
          v[8] = bflo(c.x); v[9] = bfhi(c.x); v[10] = bflo(c.y); v[11] = bfhi(c.y); v[12] = bflo(c.z); v[13] = bfhi(c.z); v[14] = bflo(c.w); v[15] = bfhi(c.w); }
#pragma unroll
        for (int i = 0; i < 16; ++i) v[i] *= ALPHA;
        u32x4 ya[NSLOT], yc[NSLOT]; float wks[NSLOT];
#pragma unroll
        for (int k = 0; k < NSLOT; ++k) {
            const int pos = __builtin_amdgcn_readlane(cpos, k); wks[k] = __uint_as_float(__builtin_amdgcn_readlane(__float_as_uint(cwk), k));
            const bf16_t* yr = Y + (size_t)pos * DM;
            ya[k] = *(const u32x4*)(yr + lane * 8); yc[k] = *(const u32x4*)(yr + 512 + lane * 8);
        }
#pragma unroll
        for (int k = 0; k < NSLOT; ++k) {
            const u32x4 a = ya[k], c = yc[k]; const float wk = wks[k];
            v[0] += wk * bflo(a.x); v[1] += wk * bfhi(a.x); v[2] += wk * bflo(a.y); v[3] += wk * bfhi(a.y); v[4] += wk * bflo(a.z); v[5] += wk * bfhi(a.z); v[6] += wk * bflo(a.w); v[7] += wk * bfhi(a.w);
            v[8] += wk * bflo(c.x); v[9] += wk * bfhi(c.x); v[10] += wk * bflo(c.y); v[11] += wk * bfhi(c.y); v[12] += wk * bflo(c.z); v[13] += wk * bfhi(c.z); v[14] += wk * bflo(c.w); v[15] += wk * bfhi(c.w);
        }
        float s = 0.f;
#pragma unroll
        for (int i = 0; i < 16; ++i) s += v[i];
#pragma unroll
        for (int o = 32; o > 0; o >>= 1) s += __shfl_xor(s, o);
        const float mu = s * (1.f / 1024.f);
        float q = 0.f;
#pragma unroll
        for (int i = 0; i < 16; ++i) { const float d = v[i] - mu; q += d * d; }
#pragma unroll
        for (int o = 32; o > 0; o >>= 1) q += __shfl_xor(q, o);
        const float rs = rsqrtf(q * (1.f / 1024.f) + 1e-5f);
        float y[16];
#pragma unroll
        for (int i = 0; i < 8; ++i) { y[i] = (v[i] - mu) * rs * g[lane * 8 + i] + b[lane * 8 + i]; y[8 + i] = (v[8 + i] - mu) * rs * g[512 + lane * 8 + i] + b[512 + lane * 8 + i]; }
        if (FINAL) {
            float* o = OUT + (size_t)row * DM;
            *(f32x4*)(o + lane * 8) = (f32x4){y[0], y[1], y[2], y[3]}; *(f32x4*)(o + lane * 8 + 4) = (f32x4){y[4], y[5], y[6], y[7]};
            *(f32x4*)(o + 512 + lane * 8) = (f32x4){y[8], y[9], y[10], y[11]}; *(f32x4*)(o + 512 + lane * 8 + 4) = (f32x4){y[12], y[13], y[14], y[15]};
        } else {
            u32x4 w0, w1; w0.x = pk2(y[0], y[1]); w0.y = pk2(y[2], y[3]); w0.z = pk2(y[4], y[5]); w0.w = pk2(y[6], y[7]);
            w1.x = pk2(y[8], y[9]); w1.y = pk2(y[10], y[11]); w1.z = pk2(y[12], y[13]); w1.w = pk2(y[14], y[15]);
            *(u32x4*)(H2 + (size_t)row * DM + lane * 8) = w0; *(u32x4*)(H2 + (size_t)row * DM + 512 + lane * 8) = w1;
            float yr[16];
            yr[0] = bflo(w0.x); yr[1] = bfhi(w0.x); yr[2] = bflo(w0.y); yr[3] = bfhi(w0.y); yr[4] = bflo(w0.z); yr[5] = bfhi(w0.z); yr[6] = bflo(w0.w); yr[7] = bfhi(w0.w);
            yr[8] = bflo(w1.x); yr[9] = bfhi(w1.x); yr[10] = bflo(w1.y); yr[11] = bfhi(w1.y); yr[12] = bflo(w1.z); yr[13] = bfhi(w1.z); yr[14] = bflo(w1.w); yr[15] = bfhi(w1.w);
            float gsum = 0.f;
#pragma unroll
            for (int gi = 0; gi < 8; ++gi) {
                const float* wp = wgate + gi * 1024; float d = 0.f;
#pragma unroll
                for (int i = 0; i < 8; ++i) d += yr[i] * wp[lane * 8 + i] + yr[8 + i] * wp[512 + lane * 8 + i];
#pragma unroll
                for (int o = 32; o > 0; o >>= 1) d += __shfl_xor(d, o);
                gsum = (lane == gi) ? d : gsum;
            }
            if (lane < 8) GATES[(size_t)row * 8 + lane] = gsum;
        }
    }
}

template <bool DRY>
__device__ __forceinline__ void phase_select(LAS unsigned char* lds, const float* __restrict__ logits, const float* __restrict__ rbias, int* __restrict__ tok_e, int* __restrict__ tok_p,
                                             float* __restrict__ tok_w, unsigned* __restrict__ cnt, int bid, int nb) {
    const int tid = threadIdx.x, it = tid & 63, g8 = tid >> 6;
    LAS unsigned* hist = (LAS unsigned*)lds;
    LAS unsigned* base = hist + 256;
    LAS int* selE = (LAS int*)(base + 256);
    LAS int* selR = selE + 1024;
    LAS float* gsl = (LAS float*)(lds + 10240);
    LAS float* lv = (LAS float*)(lds + 12288);
    LAS int* le = (LAS int*)(lds + 28672);
    LAS float* sb = (LAS float*)(lds + 45056);
    const int tpw = NTOK / nb;
    const int t0 = bid * tpw;
    const float NEG = -3.0e38f;
    if (tid < 256) hist[tid] = 0u;
    __syncthreads();
    for (int half = 0; half < tpw / 64; ++half) {
        const int tb = t0 + half * 64;
        for (int i = tid; i < 64 * 256; i += 512) { const int tk = i >> 8, e = i & 255; sb[e * 65 + tk] = sigm(logits[(size_t)(tb + tk) * 256 + e]) + rbias[e]; }
        __syncthreads();
        {
            float m1 = NEG, m2 = NEG;
            for (int j = 0; j < 32; ++j) { const float v = sb[(g8 * 32 + j) * 65 + it]; if (v > m1) { m2 = m1; m1 = v; } else if (v > m2) m2 = v; }
            gsl[g8 * 64 + it] = m1 + m2;
        }
        __syncthreads();
        float G[8];
#pragma unroll
        for (int q = 0; q < 8; ++q) G[q] = gsl[q * 64 + it];
        unsigned selmask = 0u;
#pragma unroll
        for (int g = 0; g < 8; ++g) { int rank = 0;
#pragma unroll
            for (int q = 0; q < 8; ++q) rank += (G[q] > G[g] || (G[q] == G[g] && q < g)) ? 1 : 0;
            if (rank < 4) selmask |= 1u << g; }
        if ((selmask >> g8) & 1u) {
            float tv[8]; int te[8];
#pragma unroll
            for (int k = 0; k < 8; ++k) { tv[k] = NEG; te[k] = 0; }
            for (int j = 0; j < 32; ++j) {
                float v = sb[(g8 * 32 + j) * 65 + it]; int ve = g8 * 32 + j;
                if (v > tv[7]) {
#pragma unroll
                    for (int k = 0; k < 8; ++k) { if (v > tv[k]) { const float tf = tv[k]; const int ti = te[k]; tv[k] = v; te[k] = ve; v = tf; ve = ti; } }
                }
            }
#pragma unroll
            for (int k = 0; k < 8; ++k) { lv[(g8 * 8 + k) * 64 + it] = tv[k]; le[(g8 * 8 + k) * 64 + it] = te[k]; }
        }
        __syncthreads();
        if (tid < 64) {
            int gid[4]; { int n = 0;
#pragma unroll
                for (int g = 0; g < 8; ++g) if ((selmask >> g) & 1u) { if (n == 0) gid[0] = g; else if (n == 1) gid[1] = g; else if (n == 2) gid[2] = g; else gid[3] = g; ++n; } }
            float hv[4]; int hp[4];
#pragma unroll
            for (int j = 0; j < 4; ++j) { hp[j] = 0; hv[j] = lv[(gid[j] * 8) * 64 + it]; }
            float sc8[8]; int te[8]; float tot = 0.f;
#pragma unroll
            for (int k = 0; k < 8; ++k) {
                int bj = 0; float bv = hv[0];
                if (hv[1] > bv) { bv = hv[1]; bj = 1; }
                if (hv[2] > bv) { bv = hv[2]; bj = 2; }
                if (hv[3] > bv) { bv = hv[3]; bj = 3; }
                const int gsel = (bj == 0) ? gid[0] : (bj == 1) ? gid[1] : (bj == 2) ? gid[2] : gid[3];
                const int psel = (bj == 0) ? hp[0] : (bj == 1) ? hp[1] : (bj == 2) ? hp[2] : hp[3];
                const int e = le[(gsel * 8 + psel) * 64 + it];
                te[k] = e; sc8[k] = bv - rbias[e]; tot += sc8[k];
                const float nv = (psel < 7) ? lv[(gsel * 8 + psel + 1) * 64 + it] : NEG;
                if (bj == 0) { hv[0] = nv; hp[0] = psel + 1; } else if (bj == 1) { hv[1] = nv; hp[1] = psel + 1; } else if (bj == 2) { hv[2] = nv; hp[2] = psel + 1; } else { hv[3] = nv; hp[3] = psel + 1; }
            }
            const float inv = 2.5f / tot;
            const int tok = tb + it, lt = half * 64 + it;
#pragma unroll
            for (int k = 0; k < 8; ++k) {
                tok_e[(size_t)tok * 8 + k] = te[k]; tok_w[(size_t)tok * 8 + k] = sc8[k] * inv;
                const unsigned r = atomicAdd((unsigned*)&hist[te[k]], 1u);
                selE[lt * 8 + k] = te[k]; selR[lt * 8 + k] = (int)r;
            }
        }
        __syncthreads();
    }
    if (DRY) return;
    if (tid < 256) { const unsigned c = hist[tid]; base[tid] = c ? __hip_atomic_fetch_add(cnt + tid, c, __ATOMIC_RELAXED, __HIP_MEMORY_SCOPE_AGENT) : 0u; }
    __syncthreads();
    for (int i = tid; i < tpw * 8; i += 512) tok_p[(size_t)t0 * 8 + i] = (int)base[selE[i]] + selR[i];
    __syncthreads();
}

__device__ __forceinline__ void phase_dispatch(LAS unsigned char* lds, const unsigned* __restrict__ cnt, const int* __restrict__ tok_e, const int* __restrict__ tok_p,
                                               int* __restrict__ s_tok, int* __restrict__ posy, int* __restrict__ tile_exp, int* __restrict__ ntiles, int bid, int nb) {
    const int tid = threadIdx.x;
    LAS int* tstart = (LAS int*)lds;
    LAS int* tcnt = tstart + 260;
    if (tid < 256) tcnt[tid] = (int)((__hip_atomic_load(cnt + tid, __ATOMIC_RELAXED, __HIP_MEMORY_SCOPE_AGENT) + 255u) >> 8);
    __syncthreads();
    if (tid == 0) { int a = 0; for (int e = 0; e < 256; ++e) { tstart[e] = a; a += tcnt[e]; } tstart[256] = a; }
    __syncthreads();
    const int TT = tstart[256];
    const int tpw = NTOK / nb, t0 = bid * tpw;
    for (int i = tid; i < tpw * 8; i += 512) {
        const size_t a = (size_t)t0 * 8 + i; const int e = tok_e[a], p = tok_p[a];
        const int pos = tstart[e] * 256 + p;
        s_tok[pos] = (int)(a >> 3); posy[a] = pos;
    }
    for (int i = tid; i < tpw; i += 512) { const int tok = t0 + i; s_tok[TT * 256 + tok] = tok; }
    for (int e = bid; e < 256; e += nb) {
        const int c = (int)__hip_atomic_load(cnt + e, __ATOMIC_RELAXED, __HIP_MEMORY_SCOPE_AGENT), ts = tstart[e], tc = tcnt[e];
        for (int i = c + tid; i < tc * 256; i += 512) s_tok[ts * 256 + i] = 0;
        for (int i = tid; i < tc; i += 512) tile_exp[ts + i] = e;
    }
    if (bid == 0) { for (int i = tid; i < NTOK / 256; i += 512) tile_exp[TT + i] = 256; if (tid == 0) *ntiles = TT + NTOK / 256; }
    __syncthreads();
}

constexpr int MX_QT = 0, MX_KT = 17408, MX_KHT = 34816, MX_VT = 53248, MX_P = 73984, MX_ST = 83200, MX_SEG = 122368, MX_GD = 126464, MX_ER = 126976, MX_RS = 127488, MX_DEN = 128000, MX_BC = 128256, MX_IP = 128512, MX_GT = 128768;
struct MixP {
    const bf16_t* proj; int ldp; int pad0; bf16_t* ymix; const float* gates;
    const float* lb0; const float* bgk; const float* hg; const float* gg; const float* conv; const float* bif;
    float* ust; float* gsum;
};
#define MFMA16(a, b, c) __builtin_amdgcn_mfma_f32_16x16x32_bf16((a), (b), (c), 0, 0, 0)

template <int MODE, bool FULL, int VAR = 0>
__device__ __forceinline__ void mixer_run(LAS unsigned char* lds, const MixP& mp, int bid) {
    constexpr int DK = (MODE == 1) ? 64 : 128, QP = DK + 8, CP = DK / 2, RG = 512 / CP, RPT = 64 / RG, KS = DK / 32;
    constexpr int NVT = (MODE == 2) ? 9 : 8;
    constexpr int NST = (DK == 128) ? NVT : 4;
    const int tid = threadIdx.x, lane = tid & 63, w = __builtin_amdgcn_readfirstlane(tid >> 6), l15 = lane & 15, l4 = lane >> 4;
    int b, h, vh = 0, seg;
    if (MODE == 0) { const int sq = bid >> 4; b = sq >> 2; h = sq & 3; seg = bid & 15; }
    else if (MODE == 1) { const int sq = (bid - 128) >> 4; b = sq >> 2; h = sq & 3; seg = bid & 15; }
    else { const int sq = bid >> 4; b = sq >> 3; h = (sq >> 1) & 3; vh = sq & 1; seg = bid & 15; }
    const int tok0 = b * SEQ + seg * 1024;
    const int ldp = mp.ldp; const bf16_t* proj = mp.proj;
    int cq, ck, cv, cg, cy;
    if (MODE == 0) { cq = h * 128; ck = 512 + h * 128; cv = 1024 + h * 128; cg = 1536 + h * 128; cy = h * 128; }
    else if (MODE == 1) { cq = 2048 + h * 64; ck = 2304 + h * 64; cv = 2560 + h * 128; cg = 3072 + h * 128; cy = 512 + h * 128; }
    else { cq = h * 128; ck = 512 + h * 128; cv = 1024 + h * 256 + vh * 128; cg = 2048 + h * 256 + vh * 128; cy = h * 256 + vh * 128; }
    const int cu = 3584 + h * 64;
    const int cp = tid % CP, rg = tid / CP, d0 = 2 * cp;
    float lbv[2] = {0.f, 0.f}, oml[2] = {0.f, 0.f}, bgk[2] = {0.f, 0.f}, cwq[4][2], cwk[4][2];
    if (MODE == 0) { lbv[0] = mp.lb0[h * 128 + d0]; lbv[1] = mp.lb0[h * 128 + d0 + 1]; oml[0] = 1.f - lbv[0]; oml[1] = 1.f - lbv[1]; }
    if (MODE == 1) { bgk[0] = mp.bgk[h * 64 + d0]; bgk[1] = mp.bgk[h * 64 + d0 + 1]; }
#pragma unroll
    for (int j = 0; j < 4; ++j) { cwq[j][0] = cwq[j][1] = cwk[j][0] = cwk[j][1] = 0.f; }
    if (MODE == 2) {
#pragma unroll
        for (int j = 0; j < 4; ++j) { cwq[j][0] = mp.conv[j * 1024 + cq + d0]; cwq[j][1] = mp.conv[j * 1024 + cq + d0 + 1]; cwk[j][0] = mp.conv[j * 1024 + ck + d0]; cwk[j][1] = mp.conv[j * 1024 + ck + d0 + 1]; }
    }
    const float bi = (MODE == 2) ? mp.bif[h] : 0.f, bfg = (MODE == 2) ? mp.bif[4 + h] : 0.f;
    const int sdt = (DK == 128) ? w : (w & 3), svt0 = (DK == 128) ? 0 : 4 * (w >> 2);
    f32x4 S[NST];
#pragma unroll
    for (int t = 0; t < NST; ++t) S[t] = (f32x4){0.f, 0.f, 0.f, 0.f};
    float gacc[2] = {(MODE == 2) ? 0.f : 1.f, (MODE == 2) ? 0.f : 1.f};
    if (MODE == 2) {
        for (int i = tid; i < 16 * 72; i += 512) { const int r = i / 72; *(LAS bf16_t*)(lds + MX_VT + ((128 + r) * 72 + (i % 72)) * 2) = (r == 0) ? (bf16_t)0x3F80 : (bf16_t)0; }
    }
    if (FULL) {
        const int bid0 = bid & ~15;
        for (int j = 0; j < seg; ++j) {
            const float* U = mp.ust + ((size_t)(bid0 + j) * 8 + w) * (9 * 4 * 64);
            float dec[4];
            if (MODE == 2) { const float gsv = mp.gsum[(size_t)(bid0 + j) * 128]; dec[0] = dec[1] = dec[2] = dec[3] = __expf(gsv); }
            else {
#pragma unroll
                for (int r = 0; r < 4; ++r) dec[r] = mp.gsum[(size_t)(bid0 + j) * 128 + sdt * 16 + 4 * l4 + r];
            }
#pragma unroll
            for (int t = 0; t < NST; ++t)
#pragma unroll
                for (int r = 0; r < 4; ++r) S[t][r] = dec[r] * S[t][r] + U[(t * 4 + r) * 64 + lane];
        }
    }
    const int sj = w & 3, ovh = w >> 2, srow = 16 * sj + l15;
    const int vp = tid & 63, r0v = (tid >> 6) * 8;
    unsigned ra[RPT + 3], rb[RPT + 3], rc[RPT], pv[8]; u32x2 gnx[4]; float sgi = 0.f, sgf = 0.f;
#pragma unroll
    for (int i = 0; i < RPT + 3; ++i) { ra[i] = 0u; rb[i] = 0u; }
#pragma unroll
    for (int i = 0; i < RPT; ++i) rc[i] = 0u;
#pragma unroll
    for (int t = 0; t < 4; ++t) gnx[t] = (u32x2){0u, 0u};
#define MX_LOAD(cn) do { const int tokn_ = tok0 + (cn) * 64; \
        if (VAR == 1) { _Pragma("unroll") for (int i = 0; i < RPT + 3; ++i) { ra[i] = 0x3c003c00u + (unsigned)(cn); rb[i] = 0x3c003c00u; } _Pragma("unroll") for (int i = 0; i < RPT; ++i) rc[i] = 0x3c003c00u; _Pragma("unroll") for (int i = 0; i < 8; ++i) pv[i] = 0x3c003c00u; _Pragma("unroll") for (int t = 0; t < 4; ++t) gnx[t] = (u32x2){0x3c003c00u, 0x3c003c00u}; sgi = 0.1f; sgf = 3.f; } else \
        if (MODE == 2) { const int tl0_ = seg * 1024 + (cn) * 64 + rg * RPT; \
            _Pragma("unroll") for (int i = 0; i < RPT + 3; ++i) { const int tl_ = tl0_ - 3 + i; \
                if (tl_ >= 0) { const bf16_t* pr_ = proj + (size_t)(b * SEQ + tl_) * ldp; if (FULL) ra[i] = *(const unsigned*)(pr_ + cq + d0); rb[i] = *(const unsigned*)(pr_ + ck + d0); } \
                else { ra[i] = 0u; rb[i] = 0u; } } \
            if (w == 0) { const float* gp_ = mp.gates + (size_t)(tokn_ + lane) * 8; sgi = gp_[h]; sgf = gp_[4 + h]; } \
        } else { \
            _Pragma("unroll") for (int i = 0; i < RPT; ++i) { const bf16_t* pr_ = proj + (size_t)(tokn_ + rg * RPT + i) * ldp; \
                if (MODE == 0) { ra[i] = *(const unsigned*)(pr_ + ck + d0); if (FULL) rb[i] = *(const unsigned*)(pr_ + cq + d0); } \
                else { ra[i] = *(const unsigned*)(pr_ + cu + d0); rb[i] = *(const unsigned*)(pr_ + ck + d0); if (FULL) rc[i] = *(const unsigned*)(pr_ + cq + d0); } } \
        } \
        _Pragma("unroll") for (int i = 0; i < 8; ++i) pv[i] = *(const unsigned*)(proj + (size_t)(tokn_ + r0v + i) * ldp + cv + 2 * vp); \
        if (FULL) { _Pragma("unroll") for (int t = 0; t < 4; ++t) gnx[t] = *(const u32x2*)(proj + (size_t)(tokn_ + srow) * ldp + cg + 16 * (4 * ovh + t) + 4 * l4); } \
    } while (0)
    MX_LOAD(0);
    __syncthreads();
    for (int c = 0; c < 16; ++c) {
        const int tokc = tok0 + c * 64;
        float la[RPT][2], sp[RPT][2], qv[RPT][2], kv[RPT][2];
        u32x2 gcur[4];
#pragma unroll
        for (int t = 0; t < 4; ++t) gcur[t] = gnx[t];
        if (MODE == 2) {
            if (w == 0) {
                const float ip = sgi + bi, lf = logsig(sgf + bfg);
                float cs = lf;
#pragma unroll
                for (int o = 1; o < 64; o <<= 1) { const float t = __shfl_up(cs, o); if (lane >= o) cs += t; }
                *(LAS float*)(lds + MX_BC + lane * 4) = cs; *(LAS float*)(lds + MX_IP + lane * 4) = ip - cs;
                if (lane == 63) *(LAS float*)(lds + MX_GT) = cs;
            }
#pragma unroll
            for (int i = 0; i < RPT; ++i)
#pragma unroll
                for (int e = 0; e < 2; ++e) {
                    float aq = 0.f, ak = 0.f;
#pragma unroll
                    for (int j = 0; j < 4; ++j) { aq += cwq[j][e] * (e ? bfhi(ra[i + j]) : bflo(ra[i + j])); ak += cwk[j][e] * (e ? bfhi(rb[i + j]) : bflo(rb[i + j])); }
                    qv[i][e] = silu(aq); kv[i][e] = silu(ak) * 0.08838834764831845f; la[i][e] = 0.f; sp[i][e] = 0.f;
                }
        } else {
#pragma unroll
            for (int i = 0; i < RPT; ++i) {
                if (MODE == 0) {
                    const unsigned uz = ra[i];
                    const float s0 = sigm(bflo(uz)), s1 = sigm(bfhi(uz));
                    la[i][0] = lbv[0] + oml[0] * s0; la[i][1] = lbv[1] + oml[1] * s1;
                    kv[i][0] = oml[0] - oml[0] * s0; kv[i][1] = oml[1] - oml[1] * s1;
                    if (FULL) { const unsigned uq = rb[i]; qv[i][0] = silu(bflo(uq)); qv[i][1] = silu(bfhi(uq)); } else { qv[i][0] = qv[i][1] = 0.f; }
                } else {
                    const unsigned uu = ra[i], uk = rb[i];
                    la[i][0] = __expf(logsig(bflo(uu) + bgk[0]) * 0.0625f); la[i][1] = __expf(logsig(bfhi(uu) + bgk[1]) * 0.0625f);
                    kv[i][0] = bflo(uk); kv[i][1] = bfhi(uk);
                    if (FULL) { const unsigned uq = rc[i]; qv[i][0] = bflo(uq) * 0.125f; qv[i][1] = bfhi(uq) * 0.125f; } else { qv[i][0] = qv[i][1] = 0.f; }
                }
            }
#pragma unroll
            for (int e = 0; e < 2; ++e) {
                float run = 1.f;
#pragma unroll
                for (int i = RPT - 1; i >= 0; --i) { sp[i][e] = run; run *= la[i][e]; }
                run = 1.f;
#pragma unroll
                for (int i = 0; i < RPT; ++i) { run *= la[i][e]; la[i][e] = run; }
            }
            *(LAS float*)(lds + MX_SEG + (rg * DK + d0) * 4) = la[RPT - 1][0]; *(LAS float*)(lds + MX_SEG + (rg * DK + d0 + 1) * 4) = la[RPT - 1][1];
        }
        {
            u32x4 lo, hi;
            lo.x = (pv[0] & 0xffffu) | (pv[1] << 16); lo.y = (pv[2] & 0xffffu) | (pv[3] << 16); lo.z = (pv[4] & 0xffffu) | (pv[5] << 16); lo.w = (pv[6] & 0xffffu) | (pv[7] << 16);
            hi.x = (pv[0] >> 16) | (pv[1] & 0xffff0000u); hi.y = (pv[2] >> 16) | (pv[3] & 0xffff0000u); hi.z = (pv[4] >> 16) | (pv[5] & 0xffff0000u); hi.w = (pv[6] >> 16) | (pv[7] & 0xffff0000u);
            *(LAS u32x4*)(lds + MX_VT + ((2 * vp) * 72 + r0v) * 2) = lo; *(LAS u32x4*)(lds + MX_VT + ((2 * vp + 1) * 72 + r0v) * 2) = hi;
        }
        if (c + 1 < 16) MX_LOAD(c + 1);
        if (VAR == 2) { unsigned xa = 0; _Pragma("unroll") for (int i = 0; i < RPT + 3; ++i) xa ^= ra[i] ^ rb[i]; _Pragma("unroll") for (int i = 0; i < RPT; ++i) xa ^= rc[i]; _Pragma("unroll") for (int i = 0; i < 8; ++i) xa ^= pv[i];
            _Pragma("unroll") for (int t = 0; t < 4; ++t) xa ^= gnx[t].x ^ gnx[t].y; gacc[0] += (float)(xa & 1u) + sgi + sgf; continue; }
        __syncthreads();
        {
            float pre[2], h2[2], gt[2];
            if (MODE == 2) {
                const float g = *(LAS float*)(lds + MX_GT);
                gt[0] = gt[1] = g; h2[0] = h2[1] = 0.f; pre[0] = pre[1] = 0.f;
                if (tid == 0) gacc[0] += g;
            } else {
#pragma unroll
                for (int e = 0; e < 2; ++e) { float p = 1.f, a1 = 1.f, a2 = 1.f;
#pragma unroll
                    for (int j = 0; j < RG; ++j) { const float v = *(LAS float*)(lds + MX_SEG + (j * DK + d0 + e) * 4);
                        if (j < RG / 2) a1 *= v; else a2 *= v;
                        const bool inb = (rg >= RG / 2) ? (j >= RG / 2 && j < rg) : (j > rg && j < RG / 2);
                        p *= inb ? v : 1.f; }
                    pre[e] = p; h2[e] = a2; gt[e] = a1 * a2;
                    if (rg == 0) { gacc[e] *= gt[e]; *(LAS float*)(lds + MX_GD + (d0 + e) * 4) = gt[e]; *(LAS float*)(lds + MX_ER + (d0 + e) * 4) = a1; } }
            }
            float kh[RPT][2];
#pragma unroll
            for (int i = 0; i < RPT; ++i) {
                const int s = rg * RPT + i;
                float qs[2], ks[2];
                if (MODE == 2) {
                    const float bc = *(LAS float*)(lds + MX_BC + s * 4), ipb = *(LAS float*)(lds + MX_IP + s * 4);
                    const float eq = __expf(bc), ek = __expf(ipb), eg = __expf(gt[0]);
                    qs[0] = qv[i][0] * eq; qs[1] = qv[i][1] * eq; ks[0] = kv[i][0] * ek; ks[1] = kv[i][1] * ek; kh[i][0] = ks[0] * eg; kh[i][1] = ks[1] * eg;
                } else {
#pragma unroll
                    for (int e = 0; e < 2; ++e) {
                        const float cd = pre[e] * ((rg >= RG / 2) ? la[i][e] : sp[i][e]);
                        const float rc_ = __builtin_amdgcn_rcpf(cd);
                        const float qm = (rg >= RG / 2) ? cd : rc_, km = (rg >= RG / 2) ? rc_ : cd;
                        qs[e] = qv[i][e] * qm; ks[e] = kv[i][e] * km; kh[i][e] = ks[e] * h2[e]; }
                }
                if (FULL) { *(LAS unsigned*)(lds + MX_QT + (s * QP + d0) * 2) = pk2(qs[0], qs[1]); *(LAS unsigned*)(lds + MX_KT + (s * QP + d0) * 2) = pk2(ks[0], ks[1]); }
            }
            if (RPT == 8) {
                u32x4 a, bq;
                a.x = pk2(kh[0][0], kh[1][0]); a.y = pk2(kh[2][0], kh[3][0]); a.z = pk2(kh[4 % RPT][0], kh[5 % RPT][0]); a.w = pk2(kh[6 % RPT][0], kh[7 % RPT][0]);
                bq.x = pk2(kh[0][1], kh[1][1]); bq.y = pk2(kh[2][1], kh[3][1]); bq.z = pk2(kh[4 % RPT][1], kh[5 % RPT][1]); bq.w = pk2(kh[6 % RPT][1], kh[7 % RPT][1]);
                *(LAS u32x4*)(lds + MX_KHT + (d0 * 72 + rg * 8) * 2) = a; *(LAS u32x4*)(lds + MX_KHT + ((d0 + 1) * 72 + rg * 8) * 2) = bq;
            } else {
                u32x2 a, bq;
                a.x = pk2(kh[0][0], kh[1][0]); a.y = pk2(kh[2][0], kh[3][0]); bq.x = pk2(kh[0][1], kh[1][1]); bq.y = pk2(kh[2][1], kh[3][1]);
                *(LAS u32x2*)(lds + MX_KHT + (d0 * 72 + rg * 4) * 2) = a; *(LAS u32x2*)(lds + MX_KHT + ((d0 + 1) * 72 + rg * 4) * 2) = bq;
            }
        }
        __syncthreads();
        if (FULL) {
#pragma unroll
            for (int tt = 0; tt < 2; ++tt) {
                const int tile = 2 * w + tt, ti = tile >> 2, tj = tile & 3;
                f32x4 acc = (f32x4){0.f, 0.f, 0.f, 0.f};
                if (ti <= tj) {
#pragma unroll
                    for (int kk = 0; kk < KS; ++kk) {
                        const bf16x8 a = *(const LAS bf16x8*)(lds + MX_KT + ((16 * ti + l15) * QP + kk * 32 + 8 * l4) * 2);
                        const bf16x8 bq = *(const LAS bf16x8*)(lds + MX_QT + ((16 * tj + l15) * QP + kk * 32 + 8 * l4) * 2);
                        acc = MFMA16(a, bq, acc);
                    }
                }
                const int s = 16 * tj + l15, sp0 = 16 * ti + 4 * l4;
                float pvv[4];
#pragma unroll
                for (int r = 0; r < 4; ++r) pvv[r] = (sp0 + r <= s) ? acc[r] : 0.f;
                u32x2 pw; pw.x = pk2(pvv[0], pvv[1]); pw.y = pk2(pvv[2], pvv[3]);
                *(LAS u32x2*)(lds + MX_P + (s * 72 + sp0) * 2) = pw;
            }
            {
                float er[4];
#pragma unroll
                for (int r = 0; r < 4; ++r) er[r] = (MODE == 2) ? 1.f : *(LAS float*)(lds + MX_ER + (sdt * 16 + 4 * l4 + r) * 4);
#pragma unroll
                for (int t = 0; t < NST; ++t) {
                    const int v = 16 * (svt0 + t) + l15;
                    u32x2 sw; sw.x = pk2(S[t][0] * er[0], S[t][1] * er[1]); sw.y = pk2(S[t][2] * er[2], S[t][3] * er[3]);
                    *(LAS u32x2*)(lds + MX_ST + (v * QP + sdt * 16 + 4 * l4) * 2) = sw;
                }
            }
            __syncthreads();
            constexpr int NOT = (MODE == 2) ? 5 : 4;
            f32x4 O[NOT];
#pragma unroll
            for (int t = 0; t < NOT; ++t) {
                O[t] = (f32x4){0.f, 0.f, 0.f, 0.f};
                const int vt = (t < 4) ? (4 * ovh + t) : 8;
                if (t < 4 || ovh == 0) {
#pragma unroll
                    for (int kk = 0; kk < 2; ++kk) {
                        const bf16x8 a = *(const LAS bf16x8*)(lds + MX_VT + ((16 * vt + l15) * 72 + kk * 32 + 8 * l4) * 2);
                        const bf16x8 bq = *(const LAS bf16x8*)(lds + MX_P + ((16 * sj + l15) * 72 + kk * 32 + 8 * l4) * 2);
                        O[t] = MFMA16(a, bq, O[t]);
                    }
#pragma unroll
                    for (int kk = 0; kk < KS; ++kk) {
                        const bf16x8 a = *(const LAS bf16x8*)(lds + MX_ST + ((16 * vt + l15) * QP + kk * 32 + 8 * l4) * 2);
                        const bf16x8 bq = *(const LAS bf16x8*)(lds + MX_QT + ((16 * sj + l15) * QP + kk * 32 + 8 * l4) * 2);
                        O[t] = MFMA16(a, bq, O[t]);
                    }
                }
            }
            const int tokr = tokc + srow;
            float scale;
            if (MODE == 2) {
                if (ovh == 0 && l4 == 0) *(LAS float*)(lds + MX_DEN + srow * 4) = O[NOT - 1][0];
                __syncthreads();
                const float den = *(LAS float*)(lds + MX_DEN + srow * 4);
                scale = 1.f / fmaxf(fabsf(den), 1.f);
            } else {
                float ss = 0.f;
#pragma unroll
                for (int t = 0; t < 4; ++t)
#pragma unroll
                    for (int r = 0; r < 4; ++r) ss += O[t][r] * O[t][r];
                ss += __shfl_xor(ss, 16); ss += __shfl_xor(ss, 32);
                if (l4 == 0) *(LAS float*)(lds + MX_RS + (ovh * 64 + srow) * 4) = ss;
                __syncthreads();
                const float tot = *(LAS float*)(lds + MX_RS + srow * 4) + *(LAS float*)(lds + MX_RS + (64 + srow) * 4);
                scale = rsqrtf(tot * (1.f / 128.f) + 1e-6f);
            }
#pragma unroll
            for (int t = 0; t < 4; ++t) {
                const int v0 = 16 * (4 * ovh + t) + 4 * l4;
                const u32x2 gt = gcur[t];
                const float g0 = bflo(gt.x), g1 = bfhi(gt.x), g2 = bflo(gt.y), g3 = bfhi(gt.y);
                float y0, y1, y2, y3;
                if (MODE == 2) { y0 = O[t][0] * scale * sigm(g0); y1 = O[t][1] * scale * sigm(g1); y2 = O[t][2] * scale * sigm(g2); y3 = O[t][3] * scale * sigm(g3); }
                else { const float* gn = ((MODE == 0) ? mp.hg : mp.gg) + h * 128 + v0;
                    y0 = O[t][0] * scale * gn[0] * silu(g0); y1 = O[t][1] * scale * gn[1] * silu(g1); y2 = O[t][2] * scale * gn[2] * silu(g2); y3 = O[t][3] * scale * gn[3] * silu(g3); }
                u32x2 yw; yw.x = pk2(y0, y1); yw.y = pk2(y2, y3);
                *(u32x2*)(mp.ymix + (size_t)tokr * DM + cy + v0) = yw;
            }
        }
        {
            float dec[4];
            if (MODE == 2) { const float eg = __expf(*(LAS float*)(lds + MX_GT)); dec[0] = dec[1] = dec[2] = dec[3] = eg; }
            else {
#pragma unroll
                for (int r = 0; r < 4; ++r) dec[r] = *(LAS float*)(lds + MX_GD + (sdt * 16 + 4 * l4 + r) * 4);
            }
            bf16x8 ka[2];
#pragma unroll
            for (int kk = 0; kk < 2; ++kk) ka[kk] = *(const LAS bf16x8*)(lds + MX_KHT + ((16 * sdt + l15) * 72 + kk * 32 + 8 * l4) * 2);
#pragma unroll
            for (int t = 0; t < NST; ++t) {
#pragma unroll
                for (int r = 0; r < 4; ++r) S[t][r] *= dec[r];
#pragma unroll
                for (int kk = 0; kk < 2; ++kk) {
                    const bf16x8 vb = *(const LAS bf16x8*)(lds + MX_VT + ((16 * (svt0 + t) + l15) * 72 + kk * 32 + 8 * l4) * 2);
                    S[t] = MFMA16(ka[kk], vb, S[t]);
                }
            }
        }
        __syncthreads();
    }
#undef MX_LOAD
    if (VAR == 2) { mp.ust[(size_t)bid * 512 + tid] = gacc[0]; return; }
    if (!FULL) {
        float* U = mp.ust + ((size_t)bid * 8 + w) * (9 * 4 * 64);
#pragma unroll
        for (int t = 0; t < NST; ++t)
#pragma unroll
            for (int r = 0; r < 4; ++r) U[(t * 4 + r) * 64 + lane] = S[t][r];
        if (MODE == 2) { if (tid == 0) mp.gsum[(size_t)bid * 128] = gacc[0]; }
        else if (rg == 0) { mp.gsum[(size_t)bid * 128 + d0] = gacc[0]; mp.gsum[(size_t)bid * 128 + d0 + 1] = gacc[1]; }
    }
}

#ifndef PHMASK
#define PHMASK 0xFFFFu
#endif
#ifndef MIXSEL
#define MIXSEL 7
#endif
#ifndef REPMASK
#define REPMASK 0x0u
#endif
#define EN(j) (((PHMASK) >> (j)) & 1u)
#ifndef REPLAYER
#define REPLAYER 3
#endif
#define NREP(j) (1 + (int)((((REPMASK) >> (j)) & 1u) & (((REPLAYER) >> layer) & 1u)))
#define IN(k) (lo <= (k) && (k) < hi)
#define SEAM(k) do { if (IN((k) + 1)) xcd_barrier(bar); } while (0)

template <int layer> __device__ __forceinline__ void ph_proj(LAS unsigned char* lds, unsigned char* ws, int bid, int nb) {
    pg8::Gemm g{(const bf16_t*)(ws + (layer ? WS_H2 : WS_HB)), (const bf16_t*)(ws + (layer ? WS_WC : WS_WAB)), DM};
    pg8::StaticOrder S; S.init(NTOK, layer ? CWID : ABW, nb, bid);
    pg8::EpiStoreBf16 E{(bf16_t*)(ws + WS_PROJ), layer ? CWID : ABW};
    pg8::gemm_phase<pg8::EpiStoreBf16, pg8::StaticOrder, false>(lds, g, nullptr, S, E);
}
template <int layer> __device__ __forceinline__ void ph_outproj(LAS unsigned char* lds, unsigned char* ws, int bid, int nb) {
    pg8::Gemm g{(const bf16_t*)(ws + WS_YMIX), (const bf16_t*)(ws + (layer ? WS_WOC : WS_WOAB)), DM};
    pg8::StaticOrder S; S.init(NTOK, DM, nb, bid);
    pg8::EpiResid E{(bf16_t*)(ws + WS_Z), (const bf16_t*)(ws + (layer ? WS_H2 : WS_HB))};
    pg8::gemm_phase<pg8::EpiResid, pg8::StaticOrder, false>(lds, g, nullptr, S, E);
}
template <int layer> __device__ __forceinline__ void ph_router(LAS unsigned char* lds, unsigned char* ws, int bid, int nb) {
    pg8::Gemm g{(const bf16_t*)(ws + WS_H1), (const bf16_t*)(ws + WS_WR) + (size_t)layer * 256 * 1024, DM};
    pg8::StaticOrder S; S.init(NTOK, 256, nb, bid);
    pg8::EpiF32 E{(float*)(ws + WS_LOGITS)};
    pg8::gemm_phase<pg8::EpiF32, pg8::StaticOrder, false>(lds, g, nullptr, S, E);
}
template <int layer> __device__ __forceinline__ void ph_gemm1(LAS unsigned char* lds, unsigned char* ws, int bid, int nb) {
    const int vcu = (nb % 8 == 0) ? (bid % 8) * (nb / 8) + bid / 8 : bid;
    const int nt = __builtin_amdgcn_readfirstlane(*(volatile int*)(ws + WS_MISC + 65536 + 8192));
    pg8::Gemm g{(const bf16_t*)(ws + WS_H1), (const bf16_t*)(ws + WS_W1T) + (size_t)layer * NE1 * 512 * 1024, DM};
    pg8::MoeOrder S{(const int*)(ws + WS_MISC + 65536), nt * 2, 1, nb, vcu};
    pg8::EpiSwiGLU E{(bf16_t*)(ws + WS_ACT)};
    pg8::gemm_phase<pg8::EpiSwiGLU, pg8::MoeOrder, true>(lds, g, (const int*)(ws + WS_STOK), S, E);
}
template <int layer> __device__ __forceinline__ void ph_gemm2(LAS unsigned char* lds, unsigned char* ws, int bid, int nb) {
    const int vcu = (nb % 8 == 0) ? (bid % 8) * (nb / 8) + bid / 8 : bid;
    const int nt = __builtin_amdgcn_readfirstlane(*(volatile int*)(ws + WS_MISC + 65536 + 8192));
    pg8::Gemm g{(const bf16_t*)(ws + WS_ACT), (const bf16_t*)(ws + WS_W2T) + (size_t)layer * NE1 * 1024 * 256, 256};
    pg8::MoeOrder S{(const int*)(ws + WS_MISC + 65536), nt * 4, 2, nb, vcu};
    pg8::EpiDown E{(bf16_t*)(ws + WS_Y)};
    pg8::gemm_phase<pg8::EpiDown, pg8::MoeOrder, false>(lds, g, nullptr, S, E);
}
template <int layer, bool FULLP> __device__ __forceinline__ void ph_mixer(LAS unsigned char* lds, const Args& A, int bid, int nb) {
    unsigned char* ws = A.ws;
    if (nb != NWG) return;
    MixP mp{(const bf16_t*)(ws + WS_PROJ), layer ? CWID : ABW, 0, (bf16_t*)(ws + WS_YMIX), (const float*)(ws + WS_GATES), (const float*)(ws + WS_MISC), A.in[I_BGK], A.in[I_HG], A.in[I_GG], A.in[I_CONV], A.in[I_BIF], (float*)(ws + WS_UST), (float*)(ws + WS_GSUM)};
    if (layer == 0) { if (bid < 128) { if (MIXSEL & 1) mixer_run<0, FULLP>(lds, mp, bid); } else { if (MIXSEL & 2) mixer_run<1, FULLP>(lds, mp, bid); } }
    else { if (MIXSEL & 4) mixer_run<2, FULLP>(lds, mp, bid); }
}
#define REP2(j, call) do { call; if (NREP(j) == 2) { __syncthreads(); call; } } while (0)

template <int layer>
__device__ __forceinline__ void run_layer(LAS unsigned char* lds, const Args& A, const XcdBarrier& bar, const int lo, const int hi) {
    const int bid = blockIdx.x, nb = gridDim.x;
    unsigned char* ws = A.ws;
    unsigned* ctl = (unsigned*)(ws + WS_CTL);
    constexpr int P = 1 + layer * 11;
    if (EN(0) && IN(P + 0)) { REP2(0, ph_proj<layer>(lds, ws, bid, nb)); SEAM(P + 0); }
    if (EN(1) && IN(P + 1)) { REP2(1, (ph_mixer<layer, false>(lds, A, bid, nb))); SEAM(P + 1); }
    if (EN(2) && IN(P + 2)) { REP2(2, (ph_mixer<layer, true>(lds, A, bid, nb))); SEAM(P + 2); }
    if (EN(3) && IN(P + 3)) { REP2(3, ph_outproj<layer>(lds, ws, bid, nb)); SEAM(P + 3); }
    if (EN(4) && IN(P + 4)) { REP2(4, phase_ln((const bf16_t*)(ws + WS_Z), (bf16_t*)(ws + WS_H1), A.in[I_LMG] + layer * DM, A.in[I_LMB] + layer * DM, bid, nb)); SEAM(P + 4); }
    if (EN(5) && IN(P + 5)) { REP2(5, ph_router<layer>(lds, ws, bid, nb)); SEAM(P + 5); }
    if (EN(6) && IN(P + 6)) {
        phase_select<false>(lds, (const float*)(ws + WS_LOGITS), A.in[I_RB] + layer * NEXP, (int*)(ws + WS_TOKE), (int*)(ws + WS_TOKP), (float*)(ws + WS_TOKW), ctl + CW_CNT + layer * 256, bid, nb);
        if (NREP(6) == 2) phase_select<true>(lds, (const float*)(ws + WS_LOGITS), A.in[I_RB] + layer * NEXP, (int*)(ws + WS_TOKE), (int*)(ws + WS_TOKP), (float*)(ws + WS_TOKW), ctl + CW_CNT + layer * 256, bid, nb);
        SEAM(P + 6); }
    if (EN(7) && IN(P + 7)) { REP2(7, phase_dispatch(lds, ctl + CW_CNT + layer * 256, (const int*)(ws + WS_TOKE), (const int*)(ws + WS_TOKP), (int*)(ws + WS_STOK), (int*)(ws + WS_POSY), (int*)(ws + WS_MISC + 65536), (int*)(ws + WS_MISC + 65536 + 8192), bid, nb)); SEAM(P + 7); }
    if (EN(8) && IN(P + 8)) { REP2(8, ph_gemm1<layer>(lds, ws, bid, nb)); SEAM(P + 8); }
    if (EN(9) && IN(P + 9)) { REP2(9, ph_gemm2<layer>(lds, ws, bid, nb)); SEAM(P + 9); }
    if (EN(10) && IN(P + 10)) {
        if (layer == 0) REP2(10, (phase_combine<false>((const bf16_t*)(ws + WS_Y), (const int*)(ws + WS_POSY), (const float*)(ws + WS_TOKW), (const int*)(ws + WS_MISC + 65536 + 8192), (const bf16_t*)(ws + WS_H1), (bf16_t*)(ws + WS_H2), nullptr, (float*)(ws + WS_GATES), (const float*)(ws + WS_MISC + 4096), A.in[I_LFG], A.in[I_LFB], bid, nb)));
        else REP2(10, (phase_combine<true>((const bf16_t*)(ws + WS_Y), (const int*)(ws + WS_POSY), (const float*)(ws + WS_TOKW), (const int*)(ws + WS_MISC + 65536 + 8192), (const bf16_t*)(ws + WS_H1), nullptr, A.out, nullptr, nullptr, A.in[I_LFG] + DM, A.in[I_LFB] + DM, bid, nb)));
        SEAM(P + 10);
    }
}

__global__ void __launch_bounds__(512, 2) fwd_kernel(Args A) {
    extern __shared__ __attribute__((aligned(16))) unsigned char lds_raw[];
    LAS unsigned char* lds = (LAS unsigned char*)lds_raw;
    const int tid = threadIdx.x;
    unsigned* ctl = (unsigned*)(A.ws + WS_CTL);
    volatile LAS unsigned* misc = (volatile LAS unsigned*)(lds + LDS_MISC);
    if (tid < 64) misc[tid] = 0u;
    __syncthreads();
    const int lo = A.ph_lo, hi = A.ph_hi;
    XcdBarrier bar; bar.bar = ctl + CW_BAR; bar.x = 0; bar.st = misc;
    if (hi - lo > 1) bar = xcd_barrier_post(ctl + CW_BAR, misc);
    if (EN(11) && IN(0)) { for (int rep_ = 0; rep_ < 1 + (int)(((REPMASK) >> 11) & 1u); ++rep_) phase_prologue(lds, A, blockIdx.x, gridDim.x); SEAM(0); }
    run_layer<0>(lds, A, bar, lo, hi);
    run_layer<1>(lds, A, bar, lo, hi);
}
#undef IN
#undef SEAM

#ifdef DBG
__device__ __forceinline__ unsigned hash32(unsigned x) { x ^= x >> 16; x *= 0x7feb352dU; x ^= x >> 15; x *= 0x846ca68bU; x ^= x >> 16; return x; }
__device__ __forceinline__ void dbg_acc(float* w, int stage, float num, float den) { if (!(num == num) || num > 1e30f) num = 1e30f; atomicAdd(w + 2 * stage, num); atomicAdd(w + 2 * stage + 1, den); }
__device__ __forceinline__ float bfr(float x) { return bflo(pk2(x, 0.f)); }
__global__ void dbg_weights(Args A, float* w) {
    const unsigned i = blockIdx.x * 256 + threadIdx.x; unsigned char* ws = A.ws;
    float num = 0.f, den = 0.f;
    { const unsigned hsh = hash32(i * 4 + 0), col = hsh % 3584, k = (hsh >> 12) % 1024; const float r = A.in[I_WINAB][(size_t)k * 3600 + col], g = bf2f(((const bf16_t*)(ws + WS_WAB))[(size_t)col * 1024 + k]); num += (r - g) * (r - g); den += r * r; }
    { const unsigned hsh = hash32(i * 4 + 1), j = hsh % 256, k = (hsh >> 12) % 1024; float r = 0.f; for (int q = 0; q < 16; ++q) r += A.in[I_WINAB][(size_t)k * 3600 + 3584 + q] * A.in[I_WGKUP][q * 256 + j];
      const float g = bf2f(((const bf16_t*)(ws + WS_WAB))[(size_t)(3584 + j) * 1024 + k]); num += (r - g) * (r - g); den += r * r; }
    { const unsigned hsh = hash32(i * 4 + 2), le = hsh % 514, layer = le / 257, e = le % 257, n = (hsh >> 10) % 512, k = (hsh >> 20) % 1024;
      const float r = (e < 256) ? A.in[I_WEI][((size_t)(layer * 256 + e) * 1024 + k) * 512 + n] : A.in[I_WSI][((size_t)layer * 1024 + k) * 512 + n];
      const unsigned up = n >> 8, c = n & 255, drow = (c >> 7) * 256 + up * 128 + (c & 127);
      const float g = bf2f(((const bf16_t*)(ws + WS_W1T))[((size_t)(layer * 257 + e) * 512 + drow) * 1024 + k]); num += (r - g) * (r - g); den += r * r; }
    { const unsigned hsh = hash32(i * 4 + 3), le = hsh % 514, layer = le / 257, e = le % 257, n = (hsh >> 10) % 1024, k = (hsh >> 20) % 256;
      const float r = (e < 256) ? A.in[I_WED][((size_t)(layer * 256 + e) * 256 + k) * 1024 + n] : A.in[I_WSD][((size_t)layer * 256 + k) * 1024 + n];
      const float g = bf2f(((const bf16_t*)(ws + WS_W2T))[((size_t)(layer * 257 + e) * 1024 + n) * 256 + k]); num += (r - g) * (r - g); den += r * r; }
    dbg_acc(w, 1, num, den);
}
__global__ void dbg_gemm(const bf16_t* Am, int K, const bf16_t* Bt, const void* out, int ldo, int out_f32, int nrows, int ncols, float* w, int stage) {
    const unsigned i = blockIdx.x * 256 + threadIdx.x; const unsigned hsh = hash32(i + 77u * stage), row = hsh % nrows, col = (hsh >> 11) % ncols;
    float r = 0.f; for (int k = 0; k < K; ++k) r += bf2f(Am[(size_t)row * K + k]) * bf2f(Bt[(size_t)col * K + k]);
    const float g = out_f32 ? ((const float*)out)[(size_t)row * ldo + col] : bf2f(((const bf16_t*)out)[(size_t)row * ldo + col]);
    dbg_acc(w, stage, (r - g) * (r - g), r * r);
}
template <int MODE> __global__ void __launch_bounds__(256, 1) dbg_mixer(MixP mp, int b, int h, int T, float* w, int stage) {
    constexpr int DK = (MODE == 1) ? 64 : 128, DV = (MODE == 2) ? 256 : 128;
    __shared__ float sq[128], sk[128], sa[128], red[256], sh_i, sh_f;
    const int tid = threadIdx.x;
    const int ldp = mp.ldp; const bf16_t* proj = mp.proj;
    int cq, ck, cv, cg, cy, cu = 3584 + h * 64;
    if (MODE == 0) { cq = h * 128; ck = 512 + h * 128; cv = 1024 + h * 128; cg = 1536 + h * 128; cy = h * 128; }
    else if (MODE == 1) { cq = 2048 + h * 64; ck = 2304 + h * 64; cv = 2560 + h * 128; cg = 3072 + h * 128; cy = 512 + h * 128; }
    else { cq = h * 128; ck = 512 + h * 128; cv = 1024 + h * 256; cg = 2048 + h * 256; cy = h * 256; }
    float S[DK];
#pragma unroll
    for (int d = 0; d < DK; ++d) S[d] = 0.f;
    float nst = 0.f, num = 0.f, den = 0.f;
    for (int t = 0; t < T; ++t) {
        const size_t tok = (size_t)b * SEQ + t; const bf16_t* pr = proj + tok * ldp;
        if (tid < DK) {
            const int d = tid;
            if (MODE == 0) { const float z = bf2f(pr[ck + d]), sg = 1.f / (1.f + expf(-z)), lb = mp.lb0[h * 128 + d]; sa[d] = lb + (1.f - lb) * sg; sk[d] = (1.f - lb) * (1.f - sg); const float qq = bf2f(pr[cq + d]); sq[d] = qq / (1.f + expf(-qq)); }
            else if (MODE == 1) { const float u = bf2f(pr[cu + d]) + mp.bgk[h * 64 + d]; const float ls = fminf(u, 0.f) - log1pf(expf(-fabsf(u))); sa[d] = expf(ls / 16.f); sk[d] = bf2f(pr[ck + d]); sq[d] = bf2f(pr[cq + d]) * 0.125f; }
            else { float aq = 0.f, ak = 0.f; for (int j = 0; j < 4; ++j) { const int tt = t - 3 + j; if (tt >= 0) { const bf16_t* p2 = proj + ((size_t)b * SEQ + tt) * ldp; aq += mp.conv[j * 1024 + cq + d] * bf2f(p2[cq + d]); ak += mp.conv[j * 1024 + ck + d] * bf2f(p2[ck + d]); } }
                sq[d] = aq / (1.f + expf(-aq)); sk[d] = ak / (1.f + expf(-ak)) * 0.08838834764831845f; }
        }
        if (MODE == 2 && tid == 0) { const float* gp = mp.gates + tok * 8; sh_i = expf(gp[h] + mp.bif[h]); const float x = gp[4 + h] + mp.bif[4 + h]; sh_f = 1.f / (1.f + expf(-x)); }
        __syncthreads();
        const float vt = bf2f(pr[cv + tid]);
        float o = 0.f;
        if (MODE == 2) { const float f = sh_f, ii = sh_i;
#pragma unroll
            for (int d = 0; d < DK; ++d) { S[d] = f * S[d] + ii * sk[d] * vt; o += S[d] * sq[d]; }
            if (tid < 128) nst = f * nst + ii * sk[tid];
            red[tid] = (tid < 128) ? nst * sq[tid] : 0.f;
        } else {
#pragma unroll
            for (int d = 0; d < DK; ++d) { S[d] = sa[d] * S[d] + sk[d] * vt; o += S[d] * sq[d]; }
            red[tid] = o * o;
        }
        __syncthreads();
        for (int st = DV / 2; st > 0; st >>= 1) { if (tid < st) red[tid] += red[tid + st]; __syncthreads(); }
        const float tot = red[0];
        const float gt = bf2f(pr[cg + tid]);
        float y;
        if (MODE == 2) y = o / fmaxf(fabsf(tot), 1.f) * (1.f / (1.f + expf(-gt)));
        else y = o * rsqrtf(tot / 128.f + 1e-6f) * ((MODE == 0) ? mp.hg : mp.gg)[h * 128 + tid] * (gt / (1.f + expf(-gt)));
        const float g = bf2f(mp.ymix[tok * DM + cy + tid]);
        num += (y - g) * (y - g); den += y * y;
        __syncthreads();
    }
    dbg_acc(w, stage, num, den);
}
__global__ void dbg_h1(const bf16_t* HIN, const bf16_t* YM, const bf16_t* Wt, const bf16_t* H1, const float* g, const float* bb, float* w, int stage) {
    __shared__ float red[256]; __shared__ float zrow[1024];
    const int tid = threadIdx.x; const unsigned row = hash32(blockIdx.x + 1000u * stage) % NTOK;
    float z[4];
    for (int q = 0; q < 4; ++q) { const int c = tid + 256 * q; float a = 0.f; for (int k = 0; k < 1024; ++k) a += bf2f(YM[(size_t)row * 1024 + k]) * bf2f(Wt[(size_t)c * 1024 + k]); z[q] = bfr(ALPHA * bf2f(HIN[(size_t)row * 1024 + c]) + a); }
    red[tid] = z[0] + z[1] + z[2] + z[3]; __syncthreads();
    for (int st = 128; st > 0; st >>= 1) { if (tid < st) red[tid] += red[tid + st]; __syncthreads(); }
    const float mu = red[0] / 1024.f; __syncthreads();
    red[tid] = (z[0] - mu) * (z[0] - mu) + (z[1] - mu) * (z[1] - mu) + (z[2] - mu) * (z[2] - mu) + (z[3] - mu) * (z[3] - mu); __syncthreads();
    for (int st = 128; st > 0; st >>= 1) { if (tid < st) red[tid] += red[tid + st]; __syncthreads(); }
    const float rs = rsqrtf(red[0] / 1024.f + 1e-5f);
    float num = 0.f, den = 0.f;
    for (int q = 0; q < 4; ++q) { const int c = tid + 256 * q; const float y = (z[q] - mu) * rs * g[c] + bb[c], gg = bf2f(H1[(size_t)row * 1024 + c]); num += (y - gg) * (y - gg); den += y * y; }
    dbg_acc(w, stage, num, den); (void)zrow;
}
__global__ void dbg_select(const float* logits, const float* rb, const int* tok_e, const float* tok_w, float* w, int stage) {
    __shared__ float sc[256], bs[256]; __shared__ int ce[8]; __shared__ float cs[8];
    if (threadIdx.x != 0) return;
    const unsigned tok = hash32(blockIdx.x + 31u * stage) % NTOK;
    const float* lp = logits + (size_t)tok * 256;
    for (int e = 0; e < 256; ++e) { sc[e] = 1.f / (1.f + expf(-lp[e])); bs[e] = sc[e] + rb[e]; }
    float gs[8];
#pragma unroll
    for (int g = 0; g < 8; ++g) { float m1 = -1e30f, m2 = -1e30f; for (int j = 0; j < 32; ++j) { const float v = bs[g * 32 + j]; if (v > m1) { m2 = m1; m1 = v; } else if (v > m2) m2 = v; } gs[g] = m1 + m2; }
    unsigned selmask = 0;
#pragma unroll
    for (int g = 0; g < 8; ++g) { int rank = 0;
#pragma unroll
        for (int q = 0; q < 8; ++q) rank += (gs[q] > gs[g] || (gs[q] == gs[g] && q < g)) ? 1 : 0; if (rank < 4) selmask |= 1u << g; }
    float tot = 0.f;
    for (int k = 0; k < 8; ++k) { float bv = -1e30f; int be = 0; for (int e = 0; e < 256; ++e) { if (!((selmask >> (e >> 5)) & 1u)) continue; bool used = false; for (int q = 0; q < k; ++q) used |= (ce[q] == e); if (used) continue; if (bs[e] > bv) { bv = bs[e]; be = e; } } ce[k] = be; cs[k] = sc[be]; tot += sc[be]; }
    float num = 0.f, den = 0.f;
    for (int k = 0; k < 8; ++k) { const float wr_ = cs[k] / tot * 2.5f; const int ge = tok_e[(size_t)tok * 8 + k]; const float gw = tok_w[(size_t)tok * 8 + k];
        num += (ge == ce[k] ? 0.f : 1.f) + (wr_ - gw) * (wr_ - gw); den += wr_ * wr_; }
    dbg_acc(w, stage, num, den);
}
template <bool FINAL> __global__ void dbg_moe(Args A, int layer, const int* tok_e, const float* tok_w, const bf16_t* H1, const bf16_t* H2, const float* OUT, float* w, int stage) {
    __shared__ float hrow[1024], hid[256], red[256];
    const int tid = threadIdx.x; const unsigned tok = hash32(blockIdx.x + 555u * stage) % NTOK;
    for (int i = tid; i < 1024; i += 256) hrow[i] = bf2f(H1[(size_t)tok * 1024 + i]);
    float acc[4] = {0.f, 0.f, 0.f, 0.f};
    __syncthreads();
    for (int k = 0; k < 9; ++k) {
        const int e = (k < 8) ? tok_e[(size_t)tok * 8 + k] : 256; const float wk = (k < 8) ? tok_w[(size_t)tok * 8 + k] : 1.f;
        const float* W1 = (e < 256) ? A.in[I_WEI] + (size_t)(layer * 256 + e) * 1024 * 512 : A.in[I_WSI] + (size_t)layer * 1024 * 512;
        const float* W2 = (e < 256) ? A.in[I_WED] + (size_t)(layer * 256 + e) * 256 * 1024 : A.in[I_WSD] + (size_t)layer * 256 * 1024;
        float gsum = 0.f, usum = 0.f;
        for (int kk = 0; kk < 1024; ++kk) { gsum += hrow[kk] * W1[(size_t)kk * 512 + tid]; usum += hrow[kk] * W1[(size_t)kk * 512 + 256 + tid]; }
        hid[tid] = gsum / (1.f + expf(-gsum)) * usum;
        __syncthreads();
        for (int q = 0; q < 4; ++q) { const int c = tid + 256 * q; float a = 0.f; for (int j = 0; j < 256; ++j) a += hid[j] * W2[(size_t)j * 1024 + c]; acc[q] += wk * a; }
        __syncthreads();
    }
    float z[4]; for (int q = 0; q < 4; ++q) z[q] = ALPHA * hrow[tid + 256 * q] + acc[q];
    red[tid] = z[0] + z[1] + z[2] + z[3]; __syncthreads();
    for (int st = 128; st > 0; st >>= 1) { if (tid < st) red[tid] += red[tid + st]; __syncthreads(); }
    const float mu = red[0] / 1024.f; __syncthreads();
    red[tid] = (z[0] - mu) * (z[0] - mu) + (z[1] - mu) * (z[1] - mu) + (z[2] - mu) * (z[2] - mu) + (z[3] - mu) * (z[3] - mu); __syncthreads();
    for (int st = 128; st > 0; st >>= 1) { if (tid < st) red[tid] += red[tid + st]; __syncthreads(); }
    const float rs = rsqrtf(red[0] / 1024.f + 1e-5f);
    const float* g = A.in[I_LFG] + layer * DM; const float* bb = A.in[I_LFB] + layer * DM;
    float num = 0.f, den = 0.f;
    for (int q = 0; q < 4; ++q) { const int c = tid + 256 * q; const float y = (z[q] - mu) * rs * g[c] + bb[c]; const float gg = FINAL ? OUT[(size_t)tok * 1024 + c] : bf2f(H2[(size_t)tok * 1024 + c]); num += (y - gg) * (y - gg); den += y * y; }
    dbg_acc(w, stage, num, den);
}
#ifndef DBG_REPORT
#define DBG_REPORT 0
#endif
__global__ void dbg_fill(float* out, const float* w) {
    __shared__ float cval;
    if (threadIdx.x == 0) {
        float c = 0.f;
        if (DBG_REPORT == 0) { for (int st = 1; st <= 13; ++st) { const float rel = sqrtf(w[2 * st] / fmaxf(w[2 * st + 1], 1e-30f)); if (!(rel < 0.08f) || !(w[2 * st + 1] > 0.f)) { c = (float)st; break; } } }
        else { const float rel = sqrtf(w[2 * DBG_REPORT] / fmaxf(w[2 * DBG_REPORT + 1], 1e-30f)); float l = -log10f(fmaxf(rel, 1e-8f)); l = fminf(fmaxf(l, -2.f), 8.f); c = 3.f + l; }
        cval = c;
    }
    __syncthreads();
    const float c = cval;
    if (c != 0.f) for (size_t i = (size_t)blockIdx.x * 256 + threadIdx.x; i < (size_t)NTOK * DM; i += (size_t)gridDim.x * 256) out[i] = c;
}
#endif

extern "C" void kernel_launch(void* const* d_in, const int* in_sizes, int n_in, void* d_out, int out_size, void* d_ws, size_t ws_size, hipStream_t stream) {
    static int grid = 0;
    if (grid == 0) {
        if (n_in != 22 || out_size != NTOK * DM || ws_size < WS_END) { fprintf(stderr, "kernel_launch: unexpected shapes (n_in %d out %d ws %zu)\n", n_in, out_size, ws_size); grid = -1; return; }
        if (hipFuncSetAttribute((const void*)fwd_kernel, hipFuncAttributeMaxDynamicSharedMemorySize, LDS_BYTES) != hipSuccess) { fprintf(stderr, "kernel_launch: hipFuncSetAttribute failed\n"); grid = -1; return; }
        int per_cu = 0;
        if (hipOccupancyMaxActiveBlocksPerMultiprocessor(&per_cu, (const void*)fwd_kernel, 512, LDS_BYTES) != hipSuccess || per_cu < 1) fprintf(stderr, "kernel_launch: occupancy query says %d\n", per_cu);
        (void)hipGetLastError();
        grid = NWG;
    }
    if (grid < 0) return;
    (void)hipMemsetAsync((char*)d_ws + WS_CTL, 0, CTL_BYTES, stream);
    Args a{};
    for (int i = 0; i < 22; ++i) a.in[i] = (const float*)d_in[i];
    a.out = (float*)d_out; a.ws = (unsigned char*)d_ws;
#if MK_ONE_LAUNCH
    a.ph_lo = 0; a.ph_hi = 23;
    hipLaunchKernelGGL(fwd_kernel, dim3(grid), dim3(512), LDS_BYTES, stream, a);
#else
    for (int p = 0; p < 23; ++p) { a.ph_lo = p; a.ph_hi = p + 1; hipLaunchKernelGGL(fwd_kernel, dim3(grid), dim3(512), LDS_BYTES, stream, a);
#ifdef DBG
        unsigned char* ws = (unsigned char*)d_ws; float* dw = (float*)(ws + WS_CTL) + CW_DBG;
        const int layer = (p - 1) / 11, q = (p - 1) % 11;
        MixP mp{(const bf16_t*)(ws + WS_PROJ), layer ? CWID : ABW, 0, (bf16_t*)(ws + WS_YMIX), (const float*)(ws + WS_GATES), (const float*)(ws + WS_MISC), a.in[I_BGK], a.in[I_HG], a.in[I_GG], a.in[I_CONV], a.in[I_BIF], (float*)(ws + WS_UST), (float*)(ws + WS_GSUM)};
        if (p == 0) hipLaunchKernelGGL(dbg_weights, dim3(256), dim3(256), 0, stream, a, dw);
        if (p >= 1 && q == 0) hipLaunchKernelGGL(dbg_gemm, dim3(64), dim3(256), 0, stream, (const bf16_t*)(ws + (layer ? WS_H2 : WS_HB)), 1024, (const bf16_t*)(ws + (layer ? WS_WC : WS_WAB)), (const void*)(ws + WS_PROJ), layer ? CWID : ABW, 0, NTOK, layer ? CWID : ABW, dw, layer ? 9 : 2);
        if (p >= 1 && q == 2 && layer == 0) { hipLaunchKernelGGL(dbg_mixer<0>, dim3(1), dim3(128), 0, stream, mp, 0, 1, 1100, dw, 3); hipLaunchKernelGGL(dbg_mixer<1>, dim3(1), dim3(128), 0, stream, mp, 1, 2, 1100, dw, 4); }
        if (p >= 1 && q == 2 && layer == 1) hipLaunchKernelGGL(dbg_mixer<2>, dim3(1), dim3(256), 0, stream, mp, 1, 1, 1100, dw, 10);
        if (p >= 1 && q == 4) hipLaunchKernelGGL(dbg_h1, dim3(32), dim3(256), 0, stream, (const bf16_t*)(ws + (layer ? WS_H2 : WS_HB)), (const bf16_t*)(ws + WS_YMIX), (const bf16_t*)(ws + (layer ? WS_WOC : WS_WOAB)), (const bf16_t*)(ws + WS_H1), a.in[I_LMG] + layer * DM, a.in[I_LMB] + layer * DM, dw, layer ? 11 : 5);
        if (p >= 1 && q == 5 && layer == 0) hipLaunchKernelGGL(dbg_gemm, dim3(64), dim3(256), 0, stream, (const bf16_t*)(ws + WS_H1), 1024, (const bf16_t*)(ws + WS_WR), (const void*)(ws + WS_LOGITS), 256, 1, NTOK, 256, dw, 6);
        if (p >= 1 && q == 6) hipLaunchKernelGGL(dbg_select, dim3(64), dim3(64), 0, stream, (const float*)(ws + WS_LOGITS), a.in[I_RB] + layer * NEXP, (const int*)(ws + WS_TOKE), (const float*)(ws + WS_TOKW), dw, layer ? 12 : 7);
        if (p >= 1 && q == 10 && layer == 0) hipLaunchKernelGGL(dbg_moe<false>, dim3(32), dim3(256), 0, stream, a, 0, (const int*)(ws + WS_TOKE), (const float*)(ws + WS_TOKW), (const bf16_t*)(ws + WS_H1), (const bf16_t*)(ws + WS_H2), (const float*)d_out, dw, 8);
        if (p >= 1 && q == 10 && layer == 1) { hipLaunchKernelGGL(dbg_moe<true>, dim3(32), dim3(256), 0, stream, a, 1, (const int*)(ws + WS_TOKE), (const float*)(ws + WS_TOKW), (const bf16_t*)(ws + WS_H1), (const bf16_t*)(ws + WS_H2), (const float*)d_out, dw, 13);
            hipLaunchKernelGGL(dbg_fill, dim3(1024), dim3(256), 0, stream, (float*)d_out, dw); }
#endif
    }
#endif
}
```

```cpp
#include <hip/hip_runtime.h>
#include <cstdio>
#include <cstdint>

#ifndef MK_ONE_LAUNCH
#define MK_ONE_LAUNCH 1
#endif

#define LAS __attribute__((address_space(3)))
typedef unsigned short bf16_t;
typedef short bf16x8 __attribute__((ext_vector_type(8)));
typedef float f32x4 __attribute__((ext_vector_type(4)));
typedef unsigned u32x4 __attribute__((ext_vector_type(4)));
typedef unsigned u32x2 __attribute__((ext_vector_type(2)));

constexpr int NTOK = 32768, SEQ = 16384, DM = 1024;
constexpr int ABW = 3840;
constexpr int CWID = 3072;
constexpr int NEXP = 256, NE1 = 257, TOPK = 8, NSLOT = 9;
constexpr float ALPHA = 1.41421356237f;
constexpr int NWG = 256;
constexpr int PRMAX = 262144 + 65536 + 32768;

constexpr size_t MiB = 1u << 20;
constexpr size_t WS_CTL = 0, CTL_BYTES = 1 * MiB;
constexpr size_t WS_MISC = 1 * MiB;
constexpr size_t WS_WAB = 2 * MiB, WS_WOAB = 10 * MiB, WS_WC = 12 * MiB, WS_WOC = 18 * MiB, WS_WR = 20 * MiB;
constexpr size_t WS_TOKE = 22 * MiB, WS_TOKP = 23 * MiB, WS_TOKW = 24 * MiB;
constexpr size_t WS_STOK = 26 * MiB, WS_POSY = 28 * MiB;
constexpr size_t WS_GATES = 32 * MiB;
constexpr size_t WS_UST = 34 * MiB, WS_GSUM = 54 * MiB;
constexpr size_t WS_LOGITS = 56 * MiB;
constexpr size_t WS_HB = 96 * MiB, WS_PROJ = 160 * MiB, WS_YMIX = 400 * MiB, WS_Z = 464 * MiB, WS_H1 = 528 * MiB, WS_H2 = 592 * MiB;
constexpr size_t WS_ACT = 656 * MiB, WS_Y = 832 * MiB, WS_W1T = 1540 * MiB, WS_W2T = 2056 * MiB, WS_END = 2320 * MiB;
constexpr int CW_BAR = 4096;
constexpr int CW_CNT = 16384;
constexpr int CW_DBG = 20480;

__device__ __forceinline__ unsigned pk2(float lo, float hi) { unsigned r; asm volatile("v_cvt_pk_bf16_f32 %0, %1, %2" : "=v"(r) : "v"(lo), "v"(hi)); return r; }
__device__ __forceinline__ float bflo(unsigned u) { return __uint_as_float(u << 16); }
__device__ __forceinline__ float bfhi(unsigned u) { return __uint_as_float(u & 0xffff0000u); }
__device__ __forceinline__ float bf2f(bf16_t b) { return __uint_as_float(((unsigned)b) << 16); }
__device__ __forceinline__ float sigm(float x) { return __builtin_amdgcn_rcpf(1.f + __expf(-x)); }
__device__ __forceinline__ float silu(float x) { return x * __builtin_amdgcn_rcpf(1.f + __expf(-x)); }
__device__ __forceinline__ float logsig(float x) { return fminf(x, 0.f) - __logf(1.f + __expf(-fabsf(x))); }

#define XB_TMO      128
#define XB_XCNT(j)  (256  + 64 * (j))
#define XB_XSUB(j)  (1280 + 64 * (j))
#define XB_XGEN(j)  (2304 + 64 * (j))
#define XB_TOP      3328
#define XB_TOPGEN   3392
#define XCD_BAR_WORDS 3456
#define XB_SPIN_CAP (1u << 22)
__device__ __forceinline__ unsigned xb_ld(unsigned* p)              { return __hip_atomic_load(p, __ATOMIC_RELAXED, __HIP_MEMORY_SCOPE_AGENT); }
__device__ __forceinline__ unsigned xb_add(unsigned* p, unsigned v) { return __hip_atomic_fetch_add(p, v, __ATOMIC_RELAXED, __HIP_MEMORY_SCOPE_AGENT); }
__device__ __forceinline__ unsigned xb_xcc_id() { return (unsigned)__builtin_amdgcn_s_getreg((3 << 11) | 20) & 0xFu; }
#define XB_SPIN(cond, bar) do { unsigned _sp = 0; while (cond) { __builtin_amdgcn_s_sleep(1); \
    if ((++_sp & 255u) == 0u) { if (xb_ld(&(bar)[XB_TMO])) break; if (_sp > XB_SPIN_CAP) { atomicAdd(&(bar)[XB_TMO], 1u); break; } } } } while (0)
struct XcdBarrier { unsigned* bar; unsigned x; volatile LAS unsigned* st; };
__device__ __forceinline__ XcdBarrier xcd_barrier_post(unsigned* bar, volatile LAS unsigned* st) {
    XcdBarrier b; b.bar = bar; b.x = xb_xcc_id(); b.st = st;
    if (threadIdx.x == 0) (void)xb_add(&bar[XB_XCNT(b.x)], 1u);
    return b;
}
__device__ __forceinline__ void xcd_barrier_complete(unsigned* bar, unsigned x, unsigned& nloc, unsigned& nx) {
    const unsigned G = gridDim.x * gridDim.y * gridDim.z;
    unsigned sum, cnt, mine, sp = 0u;
    for (;;) {
        sum = 0u; cnt = 0u; mine = 0u;
#pragma unroll
        for (unsigned j = 0; j < 16; ++j) { const unsigned c = xb_ld(&bar[XB_XCNT(j)]); sum += c; cnt += (c > 0u) ? 1u : 0u; mine = (j == x) ? c : mine; }
        if (sum == G) break;
        __builtin_amdgcn_s_sleep(1);
        if ((++sp & 255u) == 0u) { if (xb_ld(&bar[XB_TMO])) break; if (sp > XB_SPIN_CAP) { atomicAdd(&bar[XB_TMO], 1u); break; } }
    }
    nloc = mine > 0u ? mine : 1u; nx = cnt > 0u ? cnt : 1u;
}
__device__ __forceinline__ void xcd_barrier(const XcdBarrier& b) {
    asm volatile("s_waitcnt vmcnt(0)" ::: "memory");
    __syncthreads();
    if (threadIdx.x == 0) {
        unsigned* bar = b.bar;
        __builtin_amdgcn_s_waitcnt(0);
        unsigned nloc = b.st[0], nx = b.st[1];
        if (nloc == 0u) { xcd_barrier_complete(bar, b.x, nloc, nx); b.st[0] = nloc; b.st[1] = nx; }
        const unsigned old = xb_add(&bar[XB_XSUB(b.x)], 1u);
        const unsigned gen = old / nloc;
        if (old + 1u == (gen + 1u) * nloc) {
            __builtin_amdgcn_fence(__ATOMIC_RELEASE, "agent");
            asm volatile("s_waitcnt vmcnt(0)" ::: "memory");
            const unsigned og = xb_add(&bar[XB_TOP], 1u);
            const unsigned tg = og / nx;
            if (og + 1u == (tg + 1u) * nx) xb_add(&bar[XB_TOPGEN], 1u);
            else XB_SPIN(xb_ld(&bar[XB_TOPGEN]) == tg, bar);
            __builtin_amdgcn_fence(__ATOMIC_ACQUIRE, "agent");
            xb_add(&bar[XB_XGEN(b.x)], 1u);
            asm volatile("s_waitcnt vmcnt(0)" ::: "memory");
        } else {
            XB_SPIN(xb_ld(&bar[XB_XGEN(b.x)]) == gen, bar);
            __builtin_amdgcn_fence(__ATOMIC_ACQUIRE, "agent");
            asm volatile("s_waitcnt vmcnt(0)" ::: "memory");
        }
    }
    __syncthreads();
}

namespace pg8 {
constexpr int BM = 256, BK = 64, HALF = 128, HTB = HALF * BK * 2, STAGE_BYTES = 8 * HTB, NXCD = 8, WGM = 8;
__device__ __forceinline__ int lds_byte(int r, int c) { const int st = (r >> 4) * 2 + (c >> 5), rr = r & 15, cc = c & 31, ob = rr * 64 + cc * 2; return st * 1024 + (ob ^ (((ob >> 9) & 1) << 5)); }
__device__ __forceinline__ void stage_rc(int b, int& R, int& C) { const int st = b / 1024, sb = b % 1024, swz = sb ^ (((sb >> 9) & 1) << 5); R = (st >> 1) * 16 + swz / 64; C = (st & 1) * 32 + (swz % 64) / 2; }
__device__ __forceinline__ int perm32(int rho) { const int n = rho >> 4, i = rho & 15; return 8 * (i >> 2) + 4 * n + (i & 3); }
struct Unit { int pm, pn; };
struct Gemm { const bf16_t* A; const bf16_t* Bt; int K; };

struct StaticOrder {
    int nM, nN, nwg, G, c;
    __device__ void init(int M, int N, int G_, int c_) { nM = M / BM; nN = N / BM; nwg = nM * nN; G = G_; c = c_; }
    __device__ bool next(int i, Unit& u) const {
        const long L = (long)i * G + c; if (L >= nwg) return false;
        int wgid = (int)L; { const int q = nwg / NXCD, r = nwg % NXCD, xcd = wgid % NXCD, off = wgid / NXCD; wgid = (xcd < r ? xcd * (q + 1) : r * (q + 1) + (xcd - r) * q) + off; }
        const int nig = WGM * nN, gid = wgid / nig, fm = gid * WGM, gsz = (nM - fm) < WGM ? (nM - fm) : WGM;
        u.pm = fm + ((wgid % nig) % gsz); u.pn = (wgid % nig) / gsz; return true;
    }
};
struct MoeOrder {
    const int* tile_exp; int nunits, sh, G, c;
    __device__ bool next(int i, Unit& u) const {
        const long L = (long)i * G + c; if (L >= nunits) return false;
        const int rt = (int)(L >> sh), j = (int)L & ((1 << sh) - 1);
        const int e = __builtin_amdgcn_readfirstlane(tile_exp[rt]);
        u.pm = rt; u.pn = (e << sh) + j; return true;
    }
};

template <class Epi, class Sched, bool GATHER>
__device__ __forceinline__ void gemm_phase(LAS unsigned char* lds, const Gemm g, const int* __restrict__ rowidx, const Sched& S, const Epi& E) {
    const int tid = threadIdx.x, wid = __builtin_amdgcn_readfirstlane(tid >> 6), lane = tid & 63, wr = wid >> 2, wc = wid & 3, fr = lane & 15, fq = lane >> 4;
    const int K = g.K, nt = K / BK;
    unsigned voffB[2], cofs[2]; int Rr[2];
#pragma unroll
    for (int i = 0; i < 2; ++i) { int R, C; stage_rc(tid * 16 + i * 8192, R, C); const int Rb = Epi::PERM ? ((R & ~31) + perm32(R & 31)) : R;
        Rr[i] = R; cofs[i] = (unsigned)C * 2u; voffB[i] = (unsigned)(Rb * K + C) * 2u; }
    const unsigned rowb = (unsigned)K * 2u;
    const size_t kstep = (size_t)(BK * 2);
    const size_t hstep = (size_t)HALF * K * 2;
    const size_t tstep = 2 * hstep;
    const unsigned ldsw = (unsigned)wid * 1024u;
    const int aoff = lds_byte(wr * 64 + fr, fq * 8), boff = lds_byte(wc * 32 + fr, fq * 8);
    const char* Abase = (const char*)g.A;
#define PG8_SA(b, h) (((b) * 2 + (h)) * HTB)
#define PG8_SB(b, h) ((4 + (b) * 2 + (h)) * HTB)
#define PG8_STAGE(bufoff, gbase, voff) do { _Pragma("unroll") for (int _i = 0; _i < 2; ++_i) \
        __builtin_amdgcn_global_load_lds((const unsigned*)((const char*)(gbase) + (voff)[_i]), (LAS unsigned*)(lds + (bufoff) + ldsw + _i * 8192), 16, 0, 0); } while (0)
#define PG8_STAGEA(bufoff, kb, offs) do { _Pragma("unroll") for (int _i = 0; _i < 2; ++_i) \
        __builtin_amdgcn_global_load_lds((const unsigned*)(Abase + (size_t)((kb) + (offs)[_i])), (LAS unsigned*)(lds + (bufoff) + ldsw + _i * 8192), 16, 0, 0); } while (0)
#define PG8_ROWOFF(u, O) do { _Pragma("unroll") for (int _h = 0; _h < 2; ++_h) _Pragma("unroll") for (int _i = 0; _i < 2; ++_i) { \
        int _row = (u).pm * BM + _h * HALF + Rr[_i]; if (GATHER) _row = rowidx[_row]; (O)[_h][_i] = (unsigned)_row * rowb + cofs[_i]; } } while (0)
#define PG8_LDA(dst, b, h) do { _Pragma("unroll") for (int m = 0; m < 4; ++m) _Pragma("unroll") for (int k = 0; k < 2; ++k) dst[m][k] = *(const LAS bf16x8*)(lds + PG8_SA(b, h) + aoff + m * 2048 + k * 1024); } while (0)
#define PG8_LDB(dst, b, h) do { _Pragma("unroll") for (int n = 0; n < 2; ++n) _Pragma("unroll") for (int k = 0; k < 2; ++k) dst[n][k] = *(const LAS bf16x8*)(lds + PG8_SB(b, h) + boff + n * 2048 + k * 1024); } while (0)
#define PG8_MMA(ai, bj, At, Bt) do { __builtin_amdgcn_s_setprio(1); _Pragma("unroll") for (int m = 0; m < 4; ++m) _Pragma("unroll") for (int n = 0; n < 2; ++n) _Pragma("unroll") for (int k = 0; k < 2; ++k) \
        acc[ai][bj][m][n] = __builtin_amdgcn_mfma_f32_16x16x32_bf16(Bt[n][k], At[m][k], acc[ai][bj][m][n], 0, 0, 0); __builtin_amdgcn_s_setprio(0); } while (0)
#define PG8_WAIT_V(n) asm volatile("s_waitcnt vmcnt(" #n ")" ::: "memory")
#define PG8_WAIT_L(n) asm volatile("s_waitcnt lgkmcnt(" #n ")" ::: "memory")
#define PG8_BAR __builtin_amdgcn_s_barrier()
#define PG8_SCHED __builtin_amdgcn_sched_barrier(0)
    Unit cur, nxt; int ui = 0;
    if (!S.next(0, cur)) return;
    f32x4 acc[2][2][4][2];
#pragma unroll
    for (int a = 0; a < 2; ++a)
#pragma unroll
        for (int b = 0; b < 2; ++b)
#pragma unroll
            for (int m = 0; m < 4; ++m)
#pragma unroll
                for (int n = 0; n < 2; ++n) acc[a][b][m][n] = (f32x4){0.f, 0.f, 0.f, 0.f};
    bf16x8 At[4][2], B0[2][2], B1[2][2];
    unsigned cO[2][2], nO[2][2];
    PG8_ROWOFF(cur, cO);
    const char* cB = (const char*)g.Bt + (size_t)cur.pn * tstep;
    PG8_STAGE(PG8_SB(0, 0), cB, voffB); PG8_STAGE(PG8_SB(0, 1), cB + hstep, voffB); PG8_STAGEA(PG8_SA(0, 0), 0u, cO[0]); PG8_STAGEA(PG8_SA(0, 1), 0u, cO[1]);
    if (wr == 1) PG8_BAR;
    PG8_WAIT_V(2); PG8_BAR;
    PG8_STAGE(PG8_SB(1, 0), cB + kstep, voffB); PG8_STAGEA(PG8_SA(1, 0), (unsigned)kstep, cO[0]); PG8_STAGE(PG8_SB(1, 1), cB + hstep + kstep, voffB);
    PG8_WAIT_V(6); PG8_BAR;
    for (;;) {
        const bool has_next = S.next(ui + 1, nxt);
        const char* nB = has_next ? (const char*)g.Bt + (size_t)nxt.pn * tstep : cB;
#pragma unroll
        for (int h = 0; h < 2; ++h)
#pragma unroll
            for (int i = 0; i < 2; ++i) nO[h][i] = cO[h][i];
#pragma unroll 1
        for (int t = 0; t < nt; t += 2) {
            const bool last = (t == nt - 2);
            if (last && has_next) PG8_ROWOFF(nxt, nO);
            const unsigned k1 = (unsigned)(t + 1) * (unsigned)kstep;
            const unsigned k2 = last ? 0u : (unsigned)(t + 2) * (unsigned)kstep, k3 = k2 + (unsigned)kstep;
            const char* b2 = last ? nB : cB + (size_t)(t + 2) * kstep; const char* b3 = b2 + kstep;
            unsigned o2[2][2];
#pragma unroll
            for (int h = 0; h < 2; ++h)
#pragma unroll
                for (int i = 0; i < 2; ++i) o2[h][i] = last ? nO[h][i] : cO[h][i];
            PG8_LDB(B0, 0, 0); PG8_LDB(B1, 0, 1); PG8_SCHED; PG8_LDA(At, 0, 0); PG8_STAGEA(PG8_SA(1, 1), k1, cO[1]);
            PG8_WAIT_V(8); PG8_WAIT_L(0); PG8_BAR; PG8_MMA(0, 0, At, B0); PG8_MMA(0, 1, At, B1); PG8_BAR; PG8_SCHED;
            PG8_LDA(At, 0, 1); PG8_STAGE(PG8_SB(0, 0), b2, voffB); PG8_STAGE(PG8_SB(0, 1), b2 + hstep, voffB); PG8_STAGEA(PG8_SA(0, 0), k2, o2[0]);
            PG8_WAIT_V(8); PG8_WAIT_L(0); PG8_BAR; PG8_MMA(1, 0, At, B0); PG8_MMA(1, 1, At, B1); PG8_BAR; PG8_SCHED;
            PG8_LDB(B0, 1, 0); PG8_LDB(B1, 1, 1); PG8_SCHED; PG8_LDA(At, 1, 0); PG8_STAGEA(PG8_SA(0, 1), k2, o2[1]);
            PG8_WAIT_V(8); PG8_WAIT_L(0); PG8_BAR; PG8_MMA(0, 0, At, B0); PG8_MMA(0, 1, At, B1); PG8_BAR; PG8_SCHED;
            PG8_LDA(At, 1, 1); PG8_STAGE(PG8_SB(1, 0), b3, voffB); PG8_STAGE(PG8_SB(1, 1), b3 + hstep, voffB); PG8_STAGEA(PG8_SA(1, 0), k3, o2[0]);
            PG8_WAIT_V(8); PG8_WAIT_L(0); PG8_BAR; PG8_MMA(1, 0, At, B0); PG8_MMA(1, 1, At, B1); PG8_BAR; PG8_SCHED;
        }
        if (wr == 0) PG8_BAR;
        E(acc, cur, wr, wc, fr, fq);
        if (!has_next) break;
#pragma unroll
        for (int a = 0; a < 2; ++a)
#pragma unroll
            for (int b = 0; b < 2; ++b)
#pragma unroll
                for (int m = 0; m < 4; ++m)
#pragma unroll
                    for (int n = 0; n < 2; ++n) acc[a][b][m][n] = (f32x4){0.f, 0.f, 0.f, 0.f};
        cur = nxt; cB = nB; ++ui;
#pragma unroll
        for (int h = 0; h < 2; ++h)
#pragma unroll
            for (int i = 0; i < 2; ++i) cO[h][i] = nO[h][i];
        if (wr == 1) PG8_BAR;
    }
    PG8_WAIT_V(0);
    PG8_BAR;
#undef PG8_SA
#undef PG8_SB
#undef PG8_STAGE
#undef PG8_STAGEA
#undef PG8_ROWOFF
#undef PG8_LDA
#undef PG8_LDB
#undef PG8_MMA
#undef PG8_WAIT_V
#undef PG8_WAIT_L
#undef PG8_BAR
#undef PG8_SCHED
}

struct EpiStoreBf16 {
    static constexpr bool PERM = true;
    bf16_t* O; int ldc;
    __device__ __forceinline__ void operator()(const f32x4 (&acc)[2][2][4][2], const Unit& u, int wr, int wc, int fr, int fq) const {
        const int row0 = u.pm * BM + wr * 64 + fr, col0 = u.pn * BM + wc * 32 + 8 * fq;
#pragma unroll
        for (int ai = 0; ai < 2; ++ai)
#pragma unroll
            for (int m = 0; m < 4; ++m) { bf16_t* rowp = O + (size_t)(row0 + ai * HALF + m * 16) * ldc + col0;
#pragma unroll
                for (int bj = 0; bj < 2; ++bj) { const f32x4 v0 = acc[ai][bj][m][0], v1 = acc[ai][bj][m][1];
                    u32x4 w; w.x = pk2(v0[0], v0[1]); w.y = pk2(v0[2], v0[3]); w.z = pk2(v1[0], v1[1]); w.w = pk2(v1[2], v1[3]);
                    *(u32x4*)(rowp + bj * HALF) = w; } }
    }
};
struct EpiResid {
    static constexpr bool PERM = true;
    bf16_t* Z; const bf16_t* H;
    __device__ __forceinline__ void operator()(const f32x4 (&acc)[2][2][4][2], const Unit& u, int wr, int wc, int fr, int fq) const {
        const int row0 = u.pm * BM + wr * 64 + fr, col0 = u.pn * BM + wc * 32 + 8 * fq;
#pragma unroll
        for (int ai = 0; ai < 2; ++ai)
#pragma unroll
            for (int m = 0; m < 4; ++m) { const size_t ro = (size_t)(row0 + ai * HALF + m * 16) * DM + col0;
#pragma unroll
                for (int bj = 0; bj < 2; ++bj) { const f32x4 v0 = acc[ai][bj][m][0], v1 = acc[ai][bj][m][1];
                    const u32x4 hh = *(const u32x4*)(H + ro + bj * HALF);
                    u32x4 w;
                    w.x = pk2(ALPHA * bflo(hh.x) + v0[0], ALPHA * bfhi(hh.x) + v0[1]); w.y = pk2(ALPHA * bflo(hh.y) + v0[2], ALPHA * bfhi(hh.y) + v0[3]);
                    w.z = pk2(ALPHA * bflo(hh.z) + v1[0], ALPHA * bfhi(hh.z) + v1[1]); w.w = pk2(ALPHA * bflo(hh.w) + v1[2], ALPHA * bfhi(hh.w) + v1[3]);
                    *(u32x4*)(Z + ro + bj * HALF) = w; } }
    }
};
struct EpiF32 {
    static constexpr bool PERM = false;
    float* C;
    __device__ __forceinline__ void operator()(const f32x4 (&acc)[2][2][4][2], const Unit& u, int wr, int wc, int fr, int fq) const {
        const int row0 = u.pm * BM + wr * 64 + fr, col0 = wc * 32 + 4 * fq;
#pragma unroll
        for (int ai = 0; ai < 2; ++ai)
#pragma unroll
            for (int m = 0; m < 4; ++m) { float* rowp = C + (size_t)(row0 + ai * HALF + m * 16) * 256 + col0;
#pragma unroll
                for (int bj = 0; bj < 2; ++bj)
#pragma unroll
                    for (int n = 0; n < 2; ++n) *(f32x4*)(rowp + bj * HALF + n * 16) = acc[ai][bj][m][n]; }
    }
};
struct EpiSwiGLU {
    static constexpr bool PERM = true;
    bf16_t* ACT;
    __device__ __forceinline__ void operator()(const f32x4 (&acc)[2][2][4][2], const Unit& u, int wr, int wc, int fr, int fq) const {
        const int row0 = u.pm * BM + wr * 64 + fr, col0 = (u.pn & 1) * 128 + wc * 32 + 8 * fq;
#pragma unroll
        for (int ai = 0; ai < 2; ++ai)
#pragma unroll
            for (int m = 0; m < 4; ++m) { bf16_t* rowp = ACT + (size_t)(row0 + ai * HALF + m * 16) * 256 + col0;
                const f32x4 g0 = acc[ai][0][m][0], g1 = acc[ai][0][m][1], u0 = acc[ai][1][m][0], u1 = acc[ai][1][m][1];
                u32x4 w; w.x = pk2(silu(g0[0]) * u0[0], silu(g0[1]) * u0[1]); w.y = pk2(silu(g0[2]) * u0[2], silu(g0[3]) * u0[3]);
                w.z = pk2(silu(g1[0]) * u1[0], silu(g1[1]) * u1[1]); w.w = pk2(silu(g1[2]) * u1[2], silu(g1[3]) * u1[3]);
                *(u32x4*)rowp = w; }
    }
};
struct EpiDown {
    static constexpr bool PERM = true;
    unsigned char* Y;
    __device__ __forceinline__ void operator()(const f32x4 (&acc)[2][2][4][2], const Unit& u, int wr, int wc, int fr, int fq) const {
        const int row0 = u.pm * BM + wr * 64 + fr, col0 = (u.pn & 3) * 256 + wc * 32 + 8 * fq;
#pragma unroll
        for (int ai = 0; ai < 2; ++ai)
#pragma unroll
            for (int m = 0; m < 4; ++m) { unsigned char* rowp = Y + (size_t)(row0 + ai * HALF + m * 16) * DM + col0;
#pragma unroll
                for (int bj = 0; bj < 2; ++bj) { f32x4 v0 = acc[ai][bj][m][0] * 16.f, v1 = acc[ai][bj][m][1] * 16.f;
#pragma unroll
                    for (int q = 0; q < 4; ++q) { v0[q] = fminf(fmaxf(v0[q], -224.f), 224.f); v1[q] = fminf(fmaxf(v1[q], -224.f), 224.f); }
                    int p0 = __builtin_amdgcn_cvt_pk_fp8_f32(v0[0], v0[1], 0, false); p0 = __builtin_amdgcn_cvt_pk_fp8_f32(v0[2], v0[3], p0, true);
                    int p1 = __builtin_amdgcn_cvt_pk_fp8_f32(v1[0], v1[1], 0, false); p1 = __builtin_amdgcn_cvt_pk_fp8_f32(v1[2], v1[3], p1, true);
                    u32x2 w; w.x = (unsigned)p0; w.y = (unsigned)p1;
                    *(u32x2*)(rowp + bj * HALF) = w; } }
    }
};
}

struct Args { const float* in[22]; float* out; unsigned char* ws; int ph_lo, ph_hi; };
enum { I_X = 0, I_WINAB, I_WGKUP, I_BGK, I_HG, I_GG, I_WOAB, I_LB, I_WINC, I_CONV, I_BIF, I_WOC, I_WR, I_RB, I_WEI, I_WED, I_WSI, I_WSD, I_LMG, I_LMB, I_LFG, I_LFB };

constexpr int LDS_MISC = 147200;
constexpr int LDS_BYTES = 147456;

__device__ __forceinline__ void cvt_tile(LAS unsigned char* lds, const float* __restrict__ src, size_t ldn, int k0, int n0, bf16_t* __restrict__ dst, int K, int drow0) {
    const int t = threadIdx.x;
    { const int c4 = (t & 15) * 4, r2 = t >> 4;
      const f32x4 a = *(const f32x4*)(src + (size_t)(k0 + 2 * r2) * ldn + n0 + c4);
      const f32x4 b = *(const f32x4*)(src + (size_t)(k0 + 2 * r2 + 1) * ldn + n0 + c4);
#pragma unroll
      for (int i = 0; i < 4; ++i) *(LAS unsigned*)(lds + ((c4 + i) * 72 + 2 * r2) * 2) = pk2(a[i], b[i]); }
    __syncthreads();
    { const int kk = (t & 7) * 8, n = t >> 3;
      const u32x4 v = *(const LAS u32x4*)(lds + (n * 72 + kk) * 2);
      *(u32x4*)(dst + (size_t)(drow0 + n) * K + k0 + kk) = v; }
    __syncthreads();
}
template <int NT>
__device__ __forceinline__ void cvt_multi(LAS unsigned char* lds, const float* __restrict__ src, size_t ldn, int k0, int n0, bf16_t* __restrict__ dst, int K, const int (&drow)[NT]) {
    const int t = threadIdx.x;
    { const int c4 = (t & 15) * 4, r2 = t >> 4;
      f32x4 a[NT], b[NT];
#pragma unroll
      for (int q = 0; q < NT; ++q) { a[q] = *(const f32x4*)(src + (size_t)(k0 + 2 * r2) * ldn + n0 + 64 * q + c4); b[q] = *(const f32x4*)(src + (size_t)(k0 + 2 * r2 + 1) * ldn + n0 + 64 * q + c4); }
#pragma unroll
      for (int q = 0; q < NT; ++q)
#pragma unroll
          for (int i = 0; i < 4; ++i) *(LAS unsigned*)(lds + q * 9216 + ((c4 + i) * 72 + 2 * r2) * 2) = pk2(a[q][i], b[q][i]); }
    __syncthreads();
    { const int kk = (t & 7) * 8, n = t >> 3;
#pragma unroll
      for (int q = 0; q < NT; ++q) { const u32x4 v = *(const LAS u32x4*)(lds + q * 9216 + (n * 72 + kk) * 2); *(u32x4*)(dst + (size_t)(drow[q] + n) * K + k0 + kk) = v; } }
    __syncthreads();
}
template <int NT>
__device__ __forceinline__ void cvt_matrix(LAS unsigned char* lds, const float* src, size_t ldn, int K, int n_lo, int ncols, bf16_t* dst, int drow_lo, int bid, int nb) {
    const int tk = K / 64, tn = ncols / (64 * NT);
    for (int j = bid; j < tk * tn; j += nb) { const int a = j / tn, b = j % tn; int dr[NT];
#pragma unroll
        for (int q = 0; q < NT; ++q) dr[q] = drow_lo + (b * NT + q) * 64;
        cvt_multi<NT>(lds, src, ldn, a * 64, n_lo + b * 64 * NT, dst, K, dr); }
}
__device__ __forceinline__ void phase_prologue(LAS unsigned char* lds, const Args& A, int bid, int nb) {
    unsigned char* ws = A.ws; const int tid = threadIdx.x;
    if (bid == 0) {
        float* lb0 = (float*)(ws + WS_MISC);
        const float* l = A.in[I_LB];
        if (tid < 512) { const float a = l[tid], b = l[512 + tid], c = l[1024 + tid]; const float m = fmaxf(a, fmaxf(b, c));
            const float ea = __expf(a - m), eb = __expf(b - m), ec = __expf(c - m); lb0[tid] = ea / (ea + eb + ec); }
    }
    if (bid == 1 % nb) {
        float* wg = (float*)(ws + WS_MISC + 4096);
        for (int i = tid; i < 8 * 1024; i += 512) { const int g = i >> 10, k = i & 1023; wg[i] = A.in[I_WINC][(size_t)k * 3080 + 3072 + g]; }
    }
    { const float* x = A.in[I_X]; bf16_t* hb = (bf16_t*)(ws + WS_HB);
      for (size_t i = ((size_t)bid * 512 + tid) * 8; i < (size_t)NTOK * DM; i += (size_t)nb * 512 * 8) {
          const f32x4 a = *(const f32x4*)(x + i), b = *(const f32x4*)(x + i + 4);
          u32x4 w; w.x = pk2(a[0], a[1]); w.y = pk2(a[2], a[3]); w.z = pk2(b[0], b[1]); w.w = pk2(b[2], b[3]);
          *(u32x4*)(hb + i) = w; } }
    { bf16_t* wab = (bf16_t*)(ws + WS_WAB); const float* win = A.in[I_WINAB]; const float* wup = A.in[I_WGKUP];
      for (int o = bid * 512 + tid; o < 256 * 128; o += nb * 512) { const int j = o >> 7, k8 = (o & 127) * 8;
          float up[16];
#pragma unroll
          for (int r = 0; r < 16; ++r) up[r] = wup[r * 256 + j];
          float res[8];
#pragma unroll
          for (int q = 0; q < 8; ++q) { const float* wr_ = win + (size_t)(k8 + q) * 3600 + 3584; float s = 0.f;
#pragma unroll
              for (int r = 0; r < 16; ++r) s += wr_[r] * up[r];
              res[q] = s; }
          u32x4 w; w.x = pk2(res[0], res[1]); w.y = pk2(res[2], res[3]); w.z = pk2(res[4], res[5]); w.w = pk2(res[6], res[7]);
          *(u32x4*)(wab + (size_t)(3584 + j) * 1024 + k8) = w; } }
    cvt_matrix<8>(lds, A.in[I_WINAB], 3600, 1024, 0, 3584, (bf16_t*)(ws + WS_WAB), 0, bid, nb);
    cvt_matrix<8>(lds, A.in[I_WOAB], 1024, 1024, 0, 1024, (bf16_t*)(ws + WS_WOAB), 0, bid, nb);
    cvt_matrix<8>(lds, A.in[I_WINC], 3080, 1024, 0, 3072, (bf16_t*)(ws + WS_WC), 0, bid, nb);
    cvt_matrix<8>(lds, A.in[I_WOC], 1024, 1024, 0, 1024, (bf16_t*)(ws + WS_WOC), 0, bid, nb);
    cvt_matrix<4>(lds, A.in[I_WR], 256, 1024, 0, 256, (bf16_t*)(ws + WS_WR), 0, bid, nb);
    cvt_matrix<4>(lds, A.in[I_WR] + 1024 * 256, 256, 1024, 0, 256, (bf16_t*)(ws + WS_WR) + 256 * 1024, 0, bid, nb);
    for (int j = bid; j < 2 * NE1 * 24; j += nb) {
        const int le = j / 24, t = j % 24, layer = le / NE1, e = le % NE1;
        if (t < 16) {
            const float* src = (e < NEXP) ? A.in[I_WEI] + ((size_t)(layer * NEXP + e)) * 1024 * 512 : A.in[I_WSI] + (size_t)layer * 1024 * 512;
            bf16_t* dst = (bf16_t*)(ws + WS_W1T) + ((size_t)(layer * NE1 + e)) * 512 * 1024;
            int dr[8];
#pragma unroll
            for (int q = 0; q < 8; ++q) { const int n0 = q * 64, half = n0 >> 8, nn = n0 & 255; dr[q] = (nn >> 7) * 256 + half * 128 + (nn & 127); }
            cvt_multi<8>(lds, src, 512, t * 64, 0, dst, 1024, dr);
        } else {
            const int t2 = t - 16, tk = t2 >> 1, hn = t2 & 1;
            const float* src = (e < NEXP) ? A.in[I_WED] + ((size_t)(layer * NEXP + e)) * 256 * 1024 : A.in[I_WSD] + (size_t)layer * 256 * 1024;
            bf16_t* dst = (bf16_t*)(ws + WS_W2T) + ((size_t)(layer * NE1 + e)) * 1024 * 256;
            int dr[8];
#pragma unroll
            for (int q = 0; q < 8; ++q) dr[q] = hn * 512 + q * 64;
            cvt_multi<8>(lds, src, 1024, tk * 64, hn * 512, dst, 256, dr);
        }
    }
}

__device__ __forceinline__ void phase_ln(const bf16_t* __restrict__ Z, bf16_t* __restrict__ H, const float* __restrict__ g, const float* __restrict__ b, int bid, int nb) {
    const int lane = threadIdx.x & 63, gw = bid * 8 + (threadIdx.x >> 6), nw = nb * 8;
    float gg[16], bb[16];
#pragma unroll
    for (int i = 0; i < 8; ++i) { gg[i] = g[lane * 8 + i]; gg[8 + i] = g[512 + lane * 8 + i]; bb[i] = b[lane * 8 + i]; bb[8 + i] = b[512 + lane * 8 + i]; }
    for (int row = gw; row < NTOK; row += nw) {
        const u32x4 a = *(const u32x4*)(Z + (size_t)row * DM + lane * 8), c = *(const u32x4*)(Z + (size_t)row * DM + 512 + lane * 8);
        float v[16];
        v[0] = bflo(a.x); v[1] = bfhi(a.x); v[2] = bflo(a.y); v[3] = bfhi(a.y); v[4] = bflo(a.z); v[5] = bfhi(a.z); v[6] = bflo(a.w); v[7] = bfhi(a.w);
        v[8] = bflo(c.x); v[9] = bfhi(c.x); v[10] = bflo(c.y); v[11] = bfhi(c.y); v[12] = bflo(c.z); v[13] = bfhi(c.z); v[14] = bflo(c.w); v[15] = bfhi(c.w);
        float s = 0.f;
#pragma unroll
        for (int i = 0; i < 16; ++i) s += v[i];
#pragma unroll
        for (int o = 32; o > 0; o >>= 1) s += __shfl_xor(s, o);
        const float mu = s * (1.f / 1024.f);
        float q = 0.f;
#pragma unroll
        for (int i = 0; i < 16; ++i) { const float d = v[i] - mu; q += d * d; }
#pragma unroll
        for (int o = 32; o > 0; o >>= 1) q += __shfl_xor(q, o);
        const float rs = rsqrtf(q * (1.f / 1024.f) + 1e-5f);
        float y[16];
#pragma unroll
        for (int i = 0; i < 16; ++i) y[i] = (v[i] - mu) * rs * gg[i] + bb[i];
        u32x4 w0, w1; w0.x = pk2(y[0], y[1]); w0.y = pk2(y[2], y[3]); w0.z = pk2(y[4], y[5]); w0.w = pk2(y[6], y[7]);
        w1.x = pk2(y[8], y[9]); w1.y = pk2(y[10], y[11]); w1.z = pk2(y[12], y[13]); w1.w = pk2(y[14], y[15]);
        *(u32x4*)(H + (size_t)row * DM + lane * 8) = w0; *(u32x4*)(H + (size_t)row * DM + 512 + lane * 8) = w1;
    }
}

template <bool FINAL>
__device__ __forceinline__ void phase_combine(const unsigned char* __restrict__ Y, const int* __restrict__ posy, const float* __restrict__ tokw, const int* __restrict__ ntiles,
                                              const bf16_t* __restrict__ H1, bf16_t* __restrict__ H2, float* __restrict__ OUT, float* __restrict__ GATES,
                                              const float* __restrict__ wgate, const float* __restrict__ g, const float* __restrict__ b, int bid, int nb) {
    const int shbase = (*ntiles - NTOK / 256) * 256;
    const int lane = threadIdx.x & 63, gw = bid * 8 + (threadIdx.x >> 6), nw = nb * 8;
    int npos = 0; float nwk = 0.f;
    if (gw < NTOK) { npos = (lane < 8) ? posy[(size_t)gw * 8 + lane] : shbase + gw; nwk = (lane < 8) ? tokw[(size_t)gw * 8 + lane] : 1.0f; }
    for (int row = gw; row < NTOK; row += nw) {
        const int cpos = npos; const float cwk = nwk;
        { const int nr = row + nw; if (nr < NTOK) { npos = (lane < 8) ? posy[(size_t)nr * 8 + lane] : shbase + nr; nwk = (lane < 8) ? tokw[(size_t)nr * 8 + lane] : 1.0f; } }
        float v[16];
        { const u32x4 a = *(const u32x4*)(H1 + (size_t)row * DM + lane * 8), c = *(const u32x4*)(H1 + (size_t)row * DM + 512 + lane * 8);
          v[0] = bflo(a.x); v[1] = bfhi(a.x); v[2] = bflo(a.y); v[3] = bfhi(a.y); v[4] = bflo(a.z); v[5] = bfhi(a.z); v[6] = bflo(a.w); v[7] = bfhi(a.w);
          v[8] = bflo(c.x); v[9] = bfhi(c.x); v[10] = bflo(c.y); v[11] = bfhi(c.y); v[12] = bflo(c.z); v[13] = bfhi(c.z); v[14] = bflo(c.w); v[15] = bfhi(c.w); }
#pragma unroll
        for (int i = 0; i < 16; ++i) v[i] *= ALPHA;
        u32x2 ya[NSLOT], yc[NSLOT]; float wks[NSLOT];
#pragma unroll
        for (int k = 0; k < NSLOT; ++k) {
            const int pos = __builtin_amdgcn_readlane(cpos, k); wks[k] = __uint_as_float(__builtin_amdgcn_readlane(__float_as_uint(cwk), k)) * 0.0625f;
            const unsigned char* yr = Y + (size_t)pos * DM;
            ya[k] = *(const u32x2*)(yr + lane * 8); yc[k] = *(const u32x2*)(yr + 512 + lane * 8);
        }
        typedef float f32x2_ __attribute__((ext_vector_type(2)));
#pragma unroll
        for (int k = 0; k < NSLOT; ++k) {
            const float wk = wks[k];
            const f32x2_ a0 = __builtin_amdgcn_cvt_pk_f32_fp8((int)ya[k].x, false), a1 = __builtin_amdgcn_cvt_pk_f32_fp8((int)ya[k].x, true), a2 = __builtin_amdgcn_cvt_pk_f32_fp8((int)ya[k].y, false), a3 = __builtin_amdgcn_cvt_pk_f32_fp8((int)ya[k].y, true);
            const f32x2_ c0 = __builtin_amdgcn_cvt_pk_f32_fp8((int)yc[k].x, false), c1 = __builtin_amdgcn_cvt_pk_f32_fp8((int)yc[k].x, true), c2 = __builtin_amdgcn_cvt_pk_f32_fp8((int)yc[k].y, false), c3 = __builtin_amdgcn_cvt_pk_f32_fp8((int)yc[k].y, true);
            v[0] += wk * a0.x; v[1] += wk * a0.y; v[2] += wk * a1.x; v[3] += wk * a1.y; v[4] += wk * a2.x; v[5] += wk * a2.y; v[6] += wk * a3.x; v[7] += wk * a3.y;
            v[8] += wk * c0.x; v[9] += wk * c0.y; v[10] += wk * c1.x; v[11] += wk * c1.y; v[12] += wk * c2.x; v[13] += wk * c2.y; v[14] += wk * c3.x; v[15] += wk * c3.y;
        }
        float s = 0.f;
#pragma unroll
        for (int i = 0; i < 16; ++i) s += v[i];
#pragma unroll
        for (int o = 32; o > 0; o >>= 1) s += __shfl_xor(s, o);
        const float mu = s * (1.f / 1024.f);
        float q = 0.f;
#pragma unroll
        for (int i = 0; i < 16; ++i) { const float d = v[i] - mu; q += d * d; }
#pragma unroll
        for (int o = 32; o > 0; o >>= 1) q += __shfl_xor(q, o);
        const float rs = rsqrtf(q * (1.f / 1024.f) + 1e-5f);
        float y[16];
#pragma unroll
        for (int i = 0; i < 8; ++i) { y[i] = (v[i] - mu) * rs * g[lane * 8 + i] + b[lane * 8 + i]; y[8 + i] = (v[8 + i] - mu) * rs * g[512 + lane * 8 + i] + b[512 + lane * 8 + i]; }
        if (FINAL) {
            float* o = OUT + (size_t)row * DM;
            *(f32x4*)(o + lane * 8) = (f32x4){y[0], y[1], y[2], y[3]}; *(f32x4*)(o + lane * 8 + 4) = (f32x4){y[4], y[5], y[6], y[7]};
            *(f32x4*)(o + 512 + lane * 8) = (f32x4){y[8], y[9], y[10], y[11]}; *(f32x4*)(o + 512 + lane * 8 + 4) = (f32x4){y[12], y[13], y[14], y[15]};
        } else {
            u32x4 w0, w1; w0.x = pk2(y[0], y[1]); w0.y = pk2(y[2], y[3]); w0.z = pk2(y[4], y[5]); w0.w = pk2(y[6], y[7]);
            w1.x = pk2(y[8], y[9]); w1.y = pk2(y[10], y[11]); w1.z = pk2(y[12], y[13]); w1.w = pk2(y[14], y[15]);
            *(u32x4*)(H2 + (size_t)row * DM + lane * 8) = w0; *(u32x4*)(H2 + (size_t)row * DM + 512 + lane * 8) = w1;
            float yr[16];
            yr[0] = bflo(w0.x); yr[1] = bfhi(w0.x); yr[2] = bflo(w0.y); yr[3] = bfhi(w0.y); yr[4] = bflo(w0.z); yr[5] = bfhi(w0.z); yr[6] = bflo(w0.w); yr[7] = bfhi(w0.w);
            yr[8] = bflo(w1.x); yr[9] = bfhi(w1.x); yr[10] = bflo(w1.y); yr[11] = bfhi(w1.y); yr[12] = bflo(w1.z); yr[13] = bfhi(w1.z); yr[14] = bflo(w1.w); yr[15] = bfhi(w1.w);
            float gsum = 0.f;
#pragma unroll
            for (int gi = 0; gi < 8; ++gi) {
                const float* wp = wgate + gi * 1024; float d = 0.f;
#pragma unroll
                for (int i = 0; i < 8; ++i) d += yr[i] * wp[lane * 8 + i] + yr[8 + i] * wp[512 + lane * 8 + i];
#pragma unroll
                for (int o = 32; o > 0; o >>= 1) d += __shfl_xor(d, o);
                gsum = (lane == gi) ? d : gsum;
            }
            if (lane < 8) GATES[(size_t)row * 8 + lane] = gsum;
        }
    }
}

template <bool DRY>
__device__ __forceinline__ void phase_select(LAS unsigned char* lds, const float* __restrict__ logits, const float* __restrict__ rbias, int* __restrict__ tok_e, int* __restrict__ tok_p,
                                             float* __restrict__ tok_w, unsigned* __restrict__ cnt, int bid, int nb) {
    const int tid = threadIdx.x, it = tid & 63, g8 = tid >> 6;
    LAS unsigned* hist = (LAS unsigned*)lds;
    LAS unsigned* base = hist + 256;
    LAS int* selE = (LAS int*)(base + 256);
    LAS int* selR = selE + 1024;
    LAS float* gsl = (LAS float*)(lds + 10240);
    LAS float* lv = (LAS float*)(lds + 12288);
    LAS int* le = (LAS int*)(lds + 28672);
    LAS float* sb = (LAS float*)(lds + 45056);
    const int tpw = NTOK / nb;
    const int t0 = bid * tpw;
    const float NEG = -3.0e38f;
    if (tid < 256) hist[tid] = 0u;
    __syncthreads();
    for (int half = 0; half < tpw / 64; ++half) {
        const int tb = t0 + half * 64;
        for (int i = tid; i < 64 * 256; i += 512) { const int tk = i >> 8, e = i & 255; sb[e * 65 + tk] = sigm(logits[(size_t)(tb + tk) * 256 + e]) + rbias[e]; }
        __syncthreads();
        {
            float m1 = NEG, m2 = NEG;
            for (int j = 0; j < 32; ++j) { const float v = sb[(g8 * 32 + j) * 65 + it]; if (v > m1) { m2 = m1; m1 = v; } else if (v > m2) m2 = v; }
            gsl[g8 * 64 + it] = m1 + m2;
        }
        __syncthreads();
        float G[8];
#pragma unroll
        for (int q = 0; q < 8; ++q) G[q] = gsl[q * 64 + it];
        unsigned selmask = 0u;
#pragma unroll
        for (int g = 0; g < 8; ++g) { int rank = 0;
#pragma unroll
            for (int q = 0; q < 8; ++q) rank += (G[q] > G[g] || (G[q] == G[g] && q < g)) ? 1 : 0;
            if (rank < 4) selmask |= 1u << g; }
        if ((selmask >> g8) & 1u) {
            float tv[8]; int te[8];
#pragma unroll
            for (int k = 0; k < 8; ++k) { tv[k] = NEG; te[k] = 0; }
            for (int j = 0; j < 32; ++j) {
                float v = sb[(g8 * 32 + j) * 65 + it]; int ve = g8 * 32 + j;
                if (v > tv[7]) {
#pragma unroll
                    for (int k = 0; k < 8; ++k) { if (v > tv[k]) { const float tf = tv[k]; const int ti = te[k]; tv[k] = v; te[k] = ve; v = tf; ve = ti; } }
                }
            }
#pragma unroll
            for (int k = 0; k < 8; ++k) { lv[(g8 * 8 + k) * 64 + it] = tv[k]; le[(g8 * 8 + k) * 64 + it] = te[k]; }
        }
        __syncthreads();
        if (tid < 64) {
            int gid[4]; { int n = 0;
#pragma unroll
                for (int g = 0; g < 8; ++g) if ((selmask >> g) & 1u) { if (n == 0) gid[0] = g; else if (n == 1) gid[1] = g; else if (n == 2) gid[2] = g; else gid[3] = g; ++n; } }
            float hv[4]; int hp[4];
#pragma unroll
            for (int j = 0; j < 4; ++j) { hp[j] = 0; hv[j] = lv[(gid[j] * 8) * 64 + it]; }
            float sc8[8]; int te[8]; float tot = 0.f;
#pragma unroll
            for (int k = 0; k < 8; ++k) {
                int bj = 0; float bv = hv[0];
                if (hv[1] > bv) { bv = hv[1]; bj = 1; }
                if (hv[2] > bv) { bv = hv[2]; bj = 2; }
                if (hv[3] > bv) { bv = hv[3]; bj = 3; }
                const int gsel = (bj == 0) ? gid[0] : (bj == 1) ? gid[1] : (bj == 2) ? gid[2] : gid[3];
                const int psel = (bj == 0) ? hp[0] : (bj == 1) ? hp[1] : (bj == 2) ? hp[2] : hp[3];
                const int e = le[(gsel * 8 + psel) * 64 + it];
                te[k] = e; sc8[k] = bv - rbias[e]; tot += sc8[k];
                const float nv = (psel < 7) ? lv[(gsel * 8 + psel + 1) * 64 + it] : NEG;
                if (bj == 0) { hv[0] = nv; hp[0] = psel + 1; } else if (bj == 1) { hv[1] = nv; hp[1] = psel + 1; } else if (bj == 2) { hv[2] = nv; hp[2] = psel + 1; } else { hv[3] = nv; hp[3] = psel + 1; }
            }
            const float inv = 2.5f / tot;
            const int tok = tb + it, lt = half * 64 + it;
#pragma unroll
            for (int k = 0; k < 8; ++k) {
                tok_e[(size_t)tok * 8 + k] = te[k]; tok_w[(size_t)tok * 8 + k] = sc8[k] * inv;
                const unsigned r = atomicAdd((unsigned*)&hist[te[k]], 1u);
                selE[lt * 8 + k] = te[k]; selR[lt * 8 + k] = (int)r;
            }
        }
        __syncthreads();
    }
    if (DRY) return;
    if (tid < 256) { const unsigned c = hist[tid]; base[tid] = c ? __hip_atomic_fetch_add(cnt + tid, c, __ATOMIC_RELAXED, __HIP_MEMORY_SCOPE_AGENT) : 0u; }
    __syncthreads();
    for (int i = tid; i < tpw * 8; i += 512) tok_p[(size_t)t0 * 8 + i] = (int)base[selE[i]] + selR[i];
    __syncthreads();
}

__device__ __forceinline__ void phase_dispatch(LAS unsigned char* lds, const unsigned* __restrict__ cnt, const int* __restrict__ tok_e, const int* __restrict__ tok_p,
                                               int* __restrict__ s_tok, int* __restrict__ posy, int* __restrict__ tile_exp, int* __restrict__ ntiles, int bid, int nb) {
    const int tid = threadIdx.x;
    LAS int* tstart = (LAS int*)lds;
    LAS int* tcnt = tstart + 260;
    if (tid < 256) tcnt[tid] = (int)((__hip_atomic_load(cnt + tid, __ATOMIC_RELAXED, __HIP_MEMORY_SCOPE_AGENT) + 255u) >> 8);
    __syncthreads();
    if (tid == 0) { int a = 0; for (int e = 0; e < 256; ++e) { tstart[e] = a; a += tcnt[e]; } tstart[256] = a; }
    __syncthreads();
    const int TT = tstart[256];
    const int tpw = NTOK / nb, t0 = bid * tpw;
    for (int i = tid; i < tpw * 8; i += 512) {
        const size_t a = (size_t)t0 * 8 + i; const int e = tok_e[a], p = tok_p[a];
        const int pos = tstart[e] * 256 + p;
        s_tok[pos] = (int)(a >> 3); posy[a] = pos;
    }
    for (int i = tid; i < tpw; i += 512) { const int tok = t0 + i; s_tok[TT * 256 + tok] = tok; }
    for (int e = bid; e < 256; e += nb) {
        const int c = (int)__hip_atomic_load(cnt + e, __ATOMIC_RELAXED, __HIP_MEMORY_SCOPE_AGENT), ts = tstart[e], tc = tcnt[e];
        for (int i = c + tid; i < tc * 256; i += 512) s_tok[ts * 256 + i] = 0;
        for (int i = tid; i < tc; i += 512) tile_exp[ts + i] = e;
    }
    if (bid == 0) { for (int i = tid; i < NTOK / 256; i += 512) tile_exp[TT + i] = 256; if (tid == 0) *ntiles = TT + NTOK / 256; }
    __syncthreads();
}

constexpr int MX_QT = 0, MX_KT = 17408, MX_KHT = 34816, MX_VT = 53248, MX_P = 73984, MX_ST = 83200, MX_SEG = 122368, MX_GD = 126464, MX_ER = 126976, MX_RS = 127488, MX_DEN = 128000, MX_BC = 128256, MX_IP = 128512, MX_GT = 128768;
struct MixP {
    const bf16_t* proj; int ldp; int pad0; bf16_t* ymix; const float* gates;
    const float* lb0; const float* bgk; const float* hg; const float* gg; const float* conv; const float* bif;
    float* ust; float* gsum;
};
#define MFMA16(a, b, c) __builtin_amdgcn_mfma_f32_16x16x32_bf16((a), (b), (c), 0, 0, 0)

template <int MODE, bool FULL, int VAR = 0>
__device__ __forceinline__ void mixer_run(LAS unsigned char* lds, const MixP& mp, int bid) {
    constexpr int DK = (MODE == 1) ? 64 : 128, QP = DK + 8, CP = DK / 2, RG = 512 / CP, RPT = 64 / RG, KS = DK / 32;
    constexpr int NVT = (MODE == 2) ? 9 : 8;
    constexpr int NST = (DK == 128) ? NVT : 4;
    const int tid = threadIdx.x, lane = tid & 63, w = __builtin_amdgcn_readfirstlane(tid >> 6), l15 = lane & 15, l4 = lane >> 4;
    int b, h, vh = 0, seg;
    if (MODE == 0) { const int sq = bid >> 4; b = sq >> 2; h = sq & 3; seg = bid & 15; }
    else if (MODE == 1) { const int sq = (bid - 128) >> 4; b = sq >> 2; h = sq & 3; seg = bid & 15; }
    else { const int sq = bid >> 4; b = sq >> 3; h = (sq >> 1) & 3; vh = sq & 1; seg = bid & 15; }
    const int tok0 = b * SEQ + seg * 1024;
    const int ldp = mp.ldp; const bf16_t* proj = mp.proj;
    int cq, ck, cv, cg, cy;
    if (MODE == 0) { cq = h * 128; ck = 512 + h * 128; cv = 1024 + h * 128; cg = 1536 + h * 128; cy = h * 128; }
    else if (MODE == 1) { cq = 2048 + h * 64; ck = 2304 + h * 64; cv = 2560 + h * 128; cg = 3072 + h * 128; cy = 512 + h * 128; }
    else { cq = h * 128; ck = 512 + h * 128; cv = 1024 + h * 256 + vh * 128; cg = 2048 + h * 256 + vh * 128; cy = h * 256 + vh * 128; }
    const int cu = 3584 + h * 64;
    const int cp = tid % CP, rg = tid / CP, d0 = 2 * cp;
    float lbv[2] = {0.f, 0.f}, oml[2] = {0.f, 0.f}, bgk[2] = {0.f, 0.f}, cwq[4][2], cwk[4][2];
    if (MODE == 0) { lbv[0] = mp.lb0[h * 128 + d0]; lbv[1] = mp.lb0[h * 128 + d0 + 1]; oml[0] = 1.f - lbv[0]; oml[1] = 1.f - lbv[1]; }
    if (MODE == 1) { bgk[0] = mp.bgk[h * 64 + d0]; bgk[1] = mp.bgk[h * 64 + d0 + 1]; }
#pragma unroll
    for (int j = 0; j < 4; ++j) { cwq[j][0] = cwq[j][1] = cwk[j][0] = cwk[j][1] = 0.f; }
    if (MODE == 2) {
#pragma unroll
        for (int j = 0; j < 4; ++j) { cwq[j][0] = mp.conv[j * 1024 + cq + d0]; cwq[j][1] = mp.conv[j * 1024 + cq + d0 + 1]; cwk[j][0] = mp.conv[j * 1024 + ck + d0]; cwk[j][1] = mp.conv[j * 1024 + ck + d0 + 1]; }
    }
    const float bi = (MODE == 2) ? mp.bif[h] : 0.f, bfg = (MODE == 2) ? mp.bif[4 + h] : 0.f;
    const int sdt = (DK == 128) ? w : (w & 3), svt0 = (DK == 128) ? 0 : 4 * (w >> 2);
    f32x4 S[NST];
#pragma unroll
    for (int t = 0; t < NST; ++t) S[t] = (f32x4){0.f, 0.f, 0.f, 0.f};
    float gacc[2] = {(MODE == 2) ? 0.f : 1.f, (MODE == 2) ? 0.f : 1.f};
    if (MODE == 2) {
        for (int i = tid; i < 16 * 72; i += 512) { const int r = i / 72; *(LAS bf16_t*)(lds + MX_VT + ((128 + r) * 72 + (i % 72)) * 2) = (r == 0) ? (bf16_t)0x3F80 : (bf16_t)0; }
    }
    if (FULL) {
        const int bid0 = bid & ~15;
        for (int j = 0; j < seg; ++j) {
            const float* U = mp.ust + ((size_t)(bid0 + j) * 8 + w) * (9 * 4 * 64);
            float dec[4];
            if (MODE == 2) { const float gsv = mp.gsum[(size_t)(bid0 + j) * 128]; dec[0] = dec[1] = dec[2] = dec[3] = __expf(gsv); }
            else {
#pragma unroll
                for (int r = 0; r < 4; ++r) dec[r] = mp.gsum[(size_t)(bid0 + j) * 128 + sdt * 16 + 4 * l4 + r];
            }
#pragma unroll
            for (int t = 0; t < NST; ++t)
#pragma unroll
                for (int r = 0; r < 4; ++r) S[t][r] = dec[r] * S[t][r] + U[(t * 4 + r) * 64 + lane];
        }
    }
    const int sj = w & 3, ovh = w >> 2, srow = 16 * sj + l15;
    const int vp = tid & 63, r0v = (tid >> 6) * 8;
    unsigned ra[RPT + 3], rb[RPT + 3], rc[RPT], pv[8]; u32x2 gnx[4]; float sgi = 0.f, sgf = 0.f;
#pragma unroll
    for (int i = 0; i < RPT + 3; ++i) { ra[i] = 0u; rb[i] = 0u; }
#pragma unroll
    for (int i = 0; i < RPT; ++i) rc[i] = 0u;
#pragma unroll
    for (int t = 0; t < 4; ++t) gnx[t] = (u32x2){0u, 0u};
#define MX_LOAD(cn) do { const int tokn_ = tok0 + (cn) * 64; \
        if (VAR == 1) { _Pragma("unroll") for (int i = 0; i < RPT + 3; ++i) { ra[i] = 0x3c003c00u + (unsigned)(cn); rb[i] = 0x3c003c00u; } _Pragma("unroll") for (int i = 0; i < RPT; ++i) rc[i] = 0x3c003c00u; _Pragma("unroll") for (int i = 0; i < 8; ++i) pv[i] = 0x3c003c00u; _Pragma("unroll") for (int t = 0; t < 4; ++t) gnx[t] = (u32x2){0x3c003c00u, 0x3c003c00u}; sgi = 0.1f; sgf = 3.f; } else \
        if (MODE == 2) { const int tl0_ = seg * 1024 + (cn) * 64 + rg * RPT; \
            _Pragma("unroll") for (int i = 0; i < RPT + 3; ++i) { const int tl_ = tl0_ - 3 + i; \
                if (tl_ >= 0) { const bf16_t* pr_ = proj + (size_t)(b * SEQ + tl_) * ldp; if (FULL) ra[i] = *(const unsigned*)(pr_ + cq + d0); rb[i] = *(const unsigned*)(pr_ + ck + d0); } \
                else { ra[i] = 0u; rb[i] = 0u; } } \
            if (w == 0) { const float* gp_ = mp.gates + (size_t)(tokn_ + lane) * 8; sgi = gp_[h]; sgf = gp_[4 + h]; } \
        } else { \
            _Pragma("unroll") for (int i = 0; i < RPT; ++i) { const bf16_t* pr_ = proj + (size_t)(tokn_ + rg * RPT + i) * ldp; \
                if (MODE == 0) { ra[i] = *(const unsigned*)(pr_ + ck + d0); if (FULL) rb[i] = *(const unsigned*)(pr_ + cq + d0); } \
                else { ra[i] = *(const unsigned*)(pr_ + cu + d0); rb[i] = *(const unsigned*)(pr_ + ck + d0); if (FULL) rc[i] = *(const unsigned*)(pr_ + cq + d0); } } \
        } \
        _Pragma("unroll") for (int i = 0; i < 8; ++i) pv[i] = *(const unsigned*)(proj + (size_t)(tokn_ + r0v + i) * ldp + cv + 2 * vp); \
        if (FULL) { _Pragma("unroll") for (int t = 0; t < 4; ++t) gnx[t] = *(const u32x2*)(proj + (size_t)(tokn_ + srow) * ldp + cg + 16 * (4 * ovh + t) + 4 * l4); } \
    } while (0)
    MX_LOAD(0);
    __syncthreads();
    for (int c = 0; c < 16; ++c) {
        const int tokc = tok0 + c * 64;
        float la[RPT][2], sp[RPT][2], qv[RPT][2], kv[RPT][2];
        u32x2 gcur[4];
#pragma unroll
        for (int t = 0; t < 4; ++t) gcur[t] = gnx[t];
        if (MODE == 2) {
            if (w == 0) {
                const float ip = sgi + bi, lf = logsig(sgf + bfg);
                float cs = lf;
#pragma unroll
                for (int o = 1; o < 64; o <<= 1) { const float t = __shfl_up(cs, o); if (lane >= o) cs += t; }
                *(LAS float*)(lds + MX_BC + lane * 4) = cs; *(LAS float*)(lds + MX_IP + lane * 4) = ip - cs;
                if (lane == 63) *(LAS float*)(lds + MX_GT) = cs;
            }
#pragma unroll
            for (int i = 0; i < RPT; ++i)
#pragma unroll
                for (int e = 0; e < 2; ++e) {
                    float aq = 0.f, ak = 0.f;
#pragma unroll
                    for (int j = 0; j < 4; ++j) { aq += cwq[j][e] * (e ? bfhi(ra[i + j]) : bflo(ra[i + j])); ak += cwk[j][e] * (e ? bfhi(rb[i + j]) : bflo(rb[i + j])); }
                    qv[i][e] = silu(aq); kv[i][e] = silu(ak) * 0.08838834764831845f; la[i][e] = 0.f; sp[i][e] = 0.f;
                }
        } else {
#pragma unroll
            for (int i = 0; i < RPT; ++i) {
                if (MODE == 0) {
                    const unsigned uz = ra[i];
                    const float s0 = sigm(bflo(uz)), s1 = sigm(bfhi(uz));
                    la[i][0] = lbv[0] + oml[0] * s0; la[i][1] = lbv[1] + oml[1] * s1;
                    kv[i][0] = oml[0] - oml[0] * s0; kv[i][1] = oml[1] - oml[1] * s1;
                    if (FULL) { const unsigned uq = rb[i]; qv[i][0] = silu(bflo(uq)); qv[i][1] = silu(bfhi(uq)); } else { qv[i][0] = qv[i][1] = 0.f; }
                } else {
                    const unsigned uu = ra[i], uk = rb[i];
                    la[i][0] = __expf(logsig(bflo(uu) + bgk[0]) * 0.0625f); la[i][1] = __expf(logsig(bfhi(uu) + bgk[1]) * 0.0625f);
                    kv[i][0] = bflo(uk); kv[i][1] = bfhi(uk);
                    if (FULL) { const unsigned uq = rc[i]; qv[i][0] = bflo(uq) * 0.125f; qv[i][1] = bfhi(uq) * 0.125f; } else { qv[i][0] = qv[i][1] = 0.f; }
                }
            }
#pragma unroll
            for (int e = 0; e < 2; ++e) {
                float run = 1.f;
#pragma unroll
                for (int i = RPT - 1; i >= 0; --i) { sp[i][e] = run; run *= la[i][e]; }
                run = 1.f;
#pragma unroll
                for (int i = 0; i < RPT; ++i) { run *= la[i][e]; la[i][e] = run; }
            }
            *(LAS float*)(lds + MX_SEG + (rg * DK + d0) * 4) = la[RPT - 1][0]; *(LAS float*)(lds + MX_SEG + (rg * DK + d0 + 1) * 4) = la[RPT - 1][1];
        }
        {
            u32x4 lo, hi;
            lo.x = (pv[0] & 0xffffu) | (pv[1] << 16); lo.y = (pv[2] & 0xffffu) | (pv[3] << 16); lo.z = (pv[4] & 0xffffu) | (pv[5] << 16); lo.w = (pv[6] & 0xffffu) | (pv[7] << 16);
            hi.x = (pv[0] >> 16) | (pv[1] & 0xffff0000u); hi.y = (pv[2] >> 16) | (pv[3] & 0xffff0000u); hi.z = (pv[4] >> 16) | (pv[5] & 0xffff0000u); hi.w = (pv[6] >> 16) | (pv[7] & 0xffff0000u);
            *(LAS u32x4*)(lds + MX_VT + ((2 * vp) * 72 + r0v) * 2) = lo; *(LAS u32x4*)(lds + MX_VT + ((2 * vp + 1) * 72 + r0v) * 2) = hi;
        }
        if (c + 1 < 16) MX_LOAD(c + 1);
        if (VAR == 2) { unsigned xa = 0; _Pragma("unroll") for (int i = 0; i < RPT + 3; ++i) xa ^= ra[i] ^ rb[i]; _Pragma("unroll") for (int i = 0; i < RPT; ++i) xa ^= rc[i]; _Pragma("unroll") for (int i = 0; i < 8; ++i) xa ^= pv[i];
            _Pragma("unroll") for (int t = 0; t < 4; ++t) xa ^= gnx[t].x ^ gnx[t].y; gacc[0] += (float)(xa & 1u) + sgi + sgf; continue; }
        __syncthreads();
        {
            float pre[2], h2[2], gt[2];
            if (MODE == 2) {
                const float g = *(LAS float*)(lds + MX_GT);
                gt[0] = gt[1] = g; h2[0] = h2[1] = 0.f; pre[0] = pre[1] = 0.f;
                if (tid == 0) gacc[0] += g;
            } else {
#pragma unroll
                for (int e = 0; e < 2; ++e) { float p = 1.f, a1 = 1.f, a2 = 1.f;
#pragma unroll
                    for (int j = 0; j < RG; ++j) { const float v = *(LAS float*)(lds + MX_SEG + (j * DK + d0 + e) * 4);
                        if (j < RG / 2) a1 *= v; else a2 *= v;
                        const bool inb = (rg >= RG / 2) ? (j >= RG / 2 && j < rg) : (j > rg && j < RG / 2);
                        p *= inb ? v : 1.f; }
                    pre[e] = p; h2[e] = a2; gt[e] = a1 * a2;
                    if (rg == 0) { gacc[e] *= gt[e]; *(LAS float*)(lds + MX_GD + (d0 + e) * 4) = gt[e]; *(LAS float*)(lds + MX_ER + (d0 + e) * 4) = a1; } }
            }
            float kh[RPT][2];
#pragma unroll
            for (int i = 0; i < RPT; ++i) {
                const int s = rg * RPT + i;
                float qs[2], ks[2];
                if (MODE == 2) {
                    const float bc = *(LAS float*)(lds + MX_BC + s * 4), ipb = *(LAS float*)(lds + MX_IP + s * 4);
                    const float eq = __expf(bc), ek = __expf(ipb), eg = __expf(gt[0]);
                    qs[0] = qv[i][0] * eq; qs[1] = qv[i][1] * eq; ks[0] = kv[i][0] * ek; ks[1] = kv[i][1] * ek; kh[i][0] = ks[0] * eg; kh[i][1] = ks[1] * eg;
                } else {
#pragma unroll
                    for (int e = 0; e < 2; ++e) {
                        const float cd = pre[e] * ((rg >= RG / 2) ? la[i][e] : sp[i][e]);
                        const float rc_ = __builtin_amdgcn_rcpf(cd);
                        const float qm = (rg >= RG / 2) ? cd : rc_, km = (rg >= RG / 2) ? rc_ : cd;
                        qs[e] = qv[i][e] * qm; ks[e] = kv[i][e] * km; kh[i][e] = ks[e] * h2[e]; }
                }
                if (FULL) { *(LAS unsigned*)(lds + MX_QT + (s * QP + d0) * 2) = pk2(qs[0], qs[1]); *(LAS unsigned*)(lds + MX_KT + (s * QP + d0) * 2) = pk2(ks[0], ks[1]); }
            }
            if (RPT == 8) {
                u32x4 a, bq;
                a.x = pk2(kh[0][0], kh[1][0]); a.y = pk2(kh[2][0], kh[3][0]); a.z = pk2(kh[4 % RPT][0], kh[5 % RPT][0]); a.w = pk2(kh[6 % RPT][0], kh[7 % RPT][0]);
                bq.x = pk2(kh[0][1], kh[1][1]); bq.y = pk2(kh[2][1], kh[3][1]); bq.z = pk2(kh[4 % RPT][1], kh[5 % RPT][1]); bq.w = pk2(kh[6 % RPT][1], kh[7 % RPT][1]);
                *(LAS u32x4*)(lds + MX_KHT + (d0 * 72 + rg * 8) * 2) = a; *(LAS u32x4*)(lds + MX_KHT + ((d0 + 1) * 72 + rg * 8) * 2) = bq;
            } else {
                u32x2 a, bq;
                a.x = pk2(kh[0][0], kh[1][0]); a.y = pk2(kh[2][0], kh[3][0]); bq.x = pk2(kh[0][1], kh[1][1]); bq.y = pk2(kh[2][1], kh[3][1]);
                *(LAS u32x2*)(lds + MX_KHT + (d0 * 72 + rg * 4) * 2) = a; *(LAS u32x2*)(lds + MX_KHT + ((d0 + 1) * 72 + rg * 4) * 2) = bq;
            }
        }
        __syncthreads();
        if (FULL) {
#pragma unroll
            for (int tt = 0; tt < 2; ++tt) {
                const int tile = 2 * w + tt, ti = tile >> 2, tj = tile & 3;
                f32x4 acc = (f32x4){0.f, 0.f, 0.f, 0.f};
                if (ti <= tj) {
#pragma unroll
                    for (int kk = 0; kk < KS; ++kk) {
                        const bf16x8 a = *(const LAS bf16x8*)(lds + MX_KT + ((16 * ti + l15) * QP + kk * 32 + 8 * l4) * 2);
                        const bf16x8 bq = *(const LAS bf16x8*)(lds + MX_QT + ((16 * tj + l15) * QP + kk * 32 + 8 * l4) * 2);
                        acc = MFMA16(a, bq, acc);
                    }
                }
                const int s = 16 * tj + l15, sp0 = 16 * ti + 4 * l4;
                float pvv[4];
#pragma unroll
                for (int r = 0; r < 4; ++r) pvv[r] = (sp0 + r <= s) ? acc[r] : 0.f;
                u32x2 pw; pw.x = pk2(pvv[0], pvv[1]); pw.y = pk2(pvv[2], pvv[3]);
                *(LAS u32x2*)(lds + MX_P + (s * 72 + sp0) * 2) = pw;
            }
            {
                float er[4];
#pragma unroll
                for (int r = 0; r < 4; ++r) er[r] = (MODE == 2) ? 1.f : *(LAS float*)(lds + MX_ER + (sdt * 16 + 4 * l4 + r) * 4);
#pragma unroll
                for (int t = 0; t < NST; ++t) {
                    const int v = 16 * (svt0 + t) + l15;
                    u32x2 sw; sw.x = pk2(S[t][0] * er[0], S[t][1] * er[1]); sw.y = pk2(S[t][2] * er[2], S[t][3] * er[3]);
                    *(LAS u32x2*)(lds + MX_ST + (v * QP + sdt * 16 + 4 * l4) * 2) = sw;
                }
            }
            __syncthreads();
            constexpr int NOT = (MODE == 2) ? 5 : 4;
            f32x4 O[NOT];
#pragma unroll
            for (int t = 0; t < NOT; ++t) {
                O[t] = (f32x4){0.f, 0.f, 0.f, 0.f};
                const int vt = (t < 4) ? (4 * ovh + t) : 8;
                if (t < 4 || ovh == 0) {
#pragma unroll
                    for (int kk = 0; kk < 2; ++kk) {
                        const bf16x8 a = *(const LAS bf16x8*)(lds + MX_VT + ((16 * vt + l15) * 72 + kk * 32 + 8 * l4) * 2);
                        const bf16x8 bq = *(const LAS bf16x8*)(lds + MX_P + ((16 * sj + l15) * 72 + kk * 32 + 8 * l4) * 2);
                        O[t] = MFMA16(a, bq, O[t]);
                    }
#pragma unroll
                    for (int kk = 0; kk < KS; ++kk) {
                        const bf16x8 a = *(const LAS bf16x8*)(lds + MX_ST + ((16 * vt + l15) * QP + kk * 32 + 8 * l4) * 2);
                        const bf16x8 bq = *(const LAS bf16x8*)(lds + MX_QT + ((16 * sj + l15) * QP + kk * 32 + 8 * l4) * 2);
                        O[t] = MFMA16(a, bq, O[t]);
                    }
                }
            }
            const int tokr = tokc + srow;
            float scale;
            if (MODE == 2) {
                if (ovh == 0 && l4 == 0) *(LAS float*)(lds + MX_DEN + srow * 4) = O[NOT - 1][0];
                __syncthreads();
                const float den = *(LAS float*)(lds + MX_DEN + srow * 4);
                scale = 1.f / fmaxf(fabsf(den), 1.f);
            } else {
                float ss = 0.f;
#pragma unroll
                for (int t = 0; t < 4; ++t)
#pragma unroll
                    for (int r = 0; r < 4; ++r) ss += O[t][r] * O[t][r];
                ss += __shfl_xor(ss, 16); ss += __shfl_xor(ss, 32);
                if (l4 == 0) *(LAS float*)(lds + MX_RS + (ovh * 64 + srow) * 4) = ss;
                __syncthreads();
                const float tot = *(LAS float*)(lds + MX_RS + srow * 4) + *(LAS float*)(lds + MX_RS + (64 + srow) * 4);
                scale = rsqrtf(tot * (1.f / 128.f) + 1e-6f);
            }
#pragma unroll
            for (int t = 0; t < 4; ++t) {
                const int v0 = 16 * (4 * ovh + t) + 4 * l4;
                const u32x2 gt = gcur[t];
                const float g0 = bflo(gt.x), g1 = bfhi(gt.x), g2 = bflo(gt.y), g3 = bfhi(gt.y);
                float y0, y1, y2, y3;
                if (MODE == 2) { y0 = O[t][0] * scale * sigm(g0); y1 = O[t][1] * scale * sigm(g1); y2 = O[t][2] * scale * sigm(g2); y3 = O[t][3] * scale * sigm(g3); }
                else { const float* gn = ((MODE == 0) ? mp.hg : mp.gg) + h * 128 + v0;
                    y0 = O[t][0] * scale * gn[0] * silu(g0); y1 = O[t][1] * scale * gn[1] * silu(g1); y2 = O[t][2] * scale * gn[2] * silu(g2); y3 = O[t][3] * scale * gn[3] * silu(g3); }
                u32x2 yw; yw.x = pk2(y0, y1); yw.y = pk2(y2, y3);
                *(u32x2*)(mp.ymix + (size_t)tokr * DM + cy + v0) = yw;
            }
        }
        {
            float dec[4];
            if (MODE == 2) { const float eg = __expf(*(LAS float*)(lds + MX_GT)); dec[0] = dec[1] = dec[2] = dec[3] = eg; }
            else {
#pragma unroll
                for (int r = 0; r < 4; ++r) dec[r] = *(LAS float*)(lds + MX_GD + (sdt * 16 + 4 * l4 + r) * 4);
            }
            bf16x8 ka[2];
#pragma unroll
            for (int kk = 0; kk < 2; ++kk) ka[kk] = *(const LAS bf16x8*)(lds + MX_KHT + ((16 * sdt + l15) * 72 + kk * 32 + 8 * l4) * 2);
#pragma unroll
            for (int t = 0; t < NST; ++t) {
#pragma unroll
                for (int r = 0; r < 4; ++r) S[t][r] *= dec[r];
#pragma unroll
                for (int kk = 0; kk < 2; ++kk) {
                    const bf16x8 vb = *(const LAS bf16x8*)(lds + MX_VT + ((16 * (svt0 + t) + l15) * 72 + kk * 32 + 8 * l4) * 2);
                    S[t] = MFMA16(ka[kk], vb, S[t]);
                }
            }
        }
        __syncthreads();
    }
#undef MX_LOAD
    if (VAR == 2) { mp.ust[(size_t)bid * 512 + tid] = gacc[0]; return; }
    if (!FULL) {
        float* U = mp.ust + ((size_t)bid * 8 + w) * (9 * 4 * 64);
#pragma unroll
        for (int t = 0; t < NST; ++t)
#pragma unroll
            for (int r = 0; r < 4; ++r) U[(t * 4 + r) * 64 + lane] = S[t][r];
        if (MODE == 2) { if (tid == 0) mp.gsum[(size_t)bid * 128] = gacc[0]; }
        else if (rg == 0) { mp.gsum[(size_t)bid * 128 + d0] = gacc[0]; mp.gsum[(size_t)bid * 128 + d0 + 1] = gacc[1]; }
    }
}

#ifndef PHMASK
#define PHMASK 0xFFFFu
#endif
#ifndef MIXSEL
#define MIXSEL 7
#endif
#ifndef REPMASK
#define REPMASK 0x0u
#endif
#define EN(j) (((PHMASK) >> (j)) & 1u)
#ifndef REPLAYER
#define REPLAYER 3
#endif
#define NREP(j) (1 + (int)((((REPMASK) >> (j)) & 1u) & (((REPLAYER) >> layer) & 1u)))
#define IN(k) (lo <= (k) && (k) < hi)
#define SEAM(k) do { if (IN((k) + 1)) xcd_barrier(bar); } while (0)

template <int layer> __device__ __forceinline__ void ph_proj(LAS unsigned char* lds, unsigned char* ws, int bid, int nb) {
    pg8::Gemm g{(const bf16_t*)(ws + (layer ? WS_H2 : WS_HB)), (const bf16_t*)(ws + (layer ? WS_WC : WS_WAB)), DM};
    pg8::StaticOrder S; S.init(NTOK, layer ? CWID : ABW, nb, bid);
    pg8::EpiStoreBf16 E{(bf16_t*)(ws + WS_PROJ), layer ? CWID : ABW};
    pg8::gemm_phase<pg8::EpiStoreBf16, pg8::StaticOrder, false>(lds, g, nullptr, S, E);
}
template <int layer> __device__ __forceinline__ void ph_outproj(LAS unsigned char* lds, unsigned char* ws, int bid, int nb) {
    pg8::Gemm g{(const bf16_t*)(ws + WS_YMIX), (const bf16_t*)(ws + (layer ? WS_WOC : WS_WOAB)), DM};
    pg8::StaticOrder S; S.init(NTOK, DM, nb, bid);
    pg8::EpiResid E{(bf16_t*)(ws + WS_Z), (const bf16_t*)(ws + (layer ? WS_H2 : WS_HB))};
    pg8::gemm_phase<pg8::EpiResid, pg8::StaticOrder, false>(lds, g, nullptr, S, E);
}
template <int layer> __device__ __forceinline__ void ph_router(LAS unsigned char* lds, unsigned char* ws, int bid, int nb) {
    pg8::Gemm g{(const bf16_t*)(ws + WS_H1), (const bf16_t*)(ws + WS_WR) + (size_t)layer * 256 * 1024, DM};
    pg8::StaticOrder S; S.init(NTOK, 256, nb, bid);
    pg8::EpiF32 E{(float*)(ws + WS_LOGITS)};
    pg8::gemm_phase<pg8::EpiF32, pg8::StaticOrder, false>(lds, g, nullptr, S, E);
}
template <int layer> __device__ __forceinline__ void ph_gemm1(LAS unsigned char* lds, unsigned char* ws, int bid, int nb) {
    const int vcu = (nb % 8 == 0) ? (bid % 8) * (nb / 8) + bid / 8 : bid;
    const int nt = __builtin_amdgcn_readfirstlane(*(volatile int*)(ws + WS_MISC + 65536 + 8192));
    pg8::Gemm g{(const bf16_t*)(ws + WS_H1), (const bf16_t*)(ws + WS_W1T) + (size_t)layer * NE1 * 512 * 1024, DM};
    pg8::MoeOrder S{(const int*)(ws + WS_MISC + 65536), nt * 2, 1, nb, vcu};
    pg8::EpiSwiGLU E{(bf16_t*)(ws + WS_ACT)};
    pg8::gemm_phase<pg8::EpiSwiGLU, pg8::MoeOrder, true>(lds, g, (const int*)(ws + WS_STOK), S, E);
}
template <int layer> __device__ __forceinline__ void ph_gemm2(LAS unsigned char* lds, unsigned char* ws, int bid, int nb) {
    const int vcu = (nb % 8 == 0) ? (bid % 8) * (nb / 8) + bid / 8 : bid;
    const int nt = __builtin_amdgcn_readfirstlane(*(volatile int*)(ws + WS_MISC + 65536 + 8192));
    pg8::Gemm g{(const bf16_t*)(ws + WS_ACT), (const bf16_t*)(ws + WS_W2T) + (size_t)layer * NE1 * 1024 * 256, 256};
    pg8::MoeOrder S{(const int*)(ws + WS_MISC + 65536), nt * 4, 2, nb, vcu};
    pg8::EpiDown E{(unsigned char*)(ws + WS_Y)};
    pg8::gemm_phase<pg8::EpiDown, pg8::MoeOrder, false>(lds, g, nullptr, S, E);
}
template <int layer, bool FULLP> __device__ __forceinline__ void ph_mixer(LAS unsigned char* lds, const Args& A, int bid, int nb) {
    unsigned char* ws = A.ws;
    if (nb != NWG) return;
    MixP mp{(const bf16_t*)(ws + WS_PROJ), layer ? CWID : ABW, 0, (bf16_t*)(ws + WS_YMIX), (const float*)(ws + WS_GATES), (const float*)(ws + WS_MISC), A.in[I_BGK], A.in[I_HG], A.in[I_GG], A.in[I_CONV], A.in[I_BIF], (float*)(ws + WS_UST), (float*)(ws + WS_GSUM)};
    if (layer == 0) { if (bid < 128) { if (MIXSEL & 1) mixer_run<0, FULLP>(lds, mp, bid); } else { if (MIXSEL & 2) mixer_run<1, FULLP>(lds, mp, bid); } }
    else { if (MIXSEL & 4) mixer_run<2, FULLP>(lds, mp, bid); }
}
#define REP2(j, call) do { call; if (NREP(j) == 2) { __syncthreads(); call; } } while (0)

template <int layer>
__device__ __forceinline__ void run_layer(LAS unsigned char* lds, const Args& A, const XcdBarrier& bar, const int lo, const int hi) {
    const int bid = blockIdx.x, nb = gridDim.x;
    unsigned char* ws = A.ws;
    unsigned* ctl = (unsigned*)(ws + WS_CTL);
    constexpr int P = 1 + layer * 11;
    if (EN(0) && IN(P + 0)) { REP2(0, ph_proj<layer>(lds, ws, bid, nb)); SEAM(P + 0); }
    if (EN(1) && IN(P + 1)) { REP2(1, (ph_mixer<layer, false>(lds, A, bid, nb))); SEAM(P + 1); }
    if (EN(2) && IN(P + 2)) { REP2(2, (ph_mixer<layer, true>(lds, A, bid, nb))); SEAM(P + 2); }
    if (EN(3) && IN(P + 3)) { REP2(3, ph_outproj<layer>(lds, ws, bid, nb)); SEAM(P + 3); }
    if (EN(4) && IN(P + 4)) { REP2(4, phase_ln((const bf16_t*)(ws + WS_Z), (bf16_t*)(ws + WS_H1), A.in[I_LMG] + layer * DM, A.in[I_LMB] + layer * DM, bid, nb)); SEAM(P + 4); }
    if (EN(5) && IN(P + 5)) { REP2(5, ph_router<layer>(lds, ws, bid, nb)); SEAM(P + 5); }
    if (EN(6) && IN(P + 6)) {
        phase_select<false>(lds, (const float*)(ws + WS_LOGITS), A.in[I_RB] + layer * NEXP, (int*)(ws + WS_TOKE), (int*)(ws + WS_TOKP), (float*)(ws + WS_TOKW), ctl + CW_CNT + layer * 256, bid, nb);
        if (NREP(6) == 2) phase_select<true>(lds, (const float*)(ws + WS_LOGITS), A.in[I_RB] + layer * NEXP, (int*)(ws + WS_TOKE), (int*)(ws + WS_TOKP), (float*)(ws + WS_TOKW), ctl + CW_CNT + layer * 256, bid, nb);
        SEAM(P + 6); }
    if (EN(7) && IN(P + 7)) { REP2(7, phase_dispatch(lds, ctl + CW_CNT + layer * 256, (const int*)(ws + WS_TOKE), (const int*)(ws + WS_TOKP), (int*)(ws + WS_STOK), (int*)(ws + WS_POSY), (int*)(ws + WS_MISC + 65536), (int*)(ws + WS_MISC + 65536 + 8192), bid, nb)); SEAM(P + 7); }
    if (EN(8) && IN(P + 8)) { REP2(8, ph_gemm1<layer>(lds, ws, bid, nb)); SEAM(P + 8); }
    if (EN(9) && IN(P + 9)) { REP2(9, ph_gemm2<layer>(lds, ws, bid, nb)); SEAM(P + 9); }
    if (EN(10) && IN(P + 10)) {
        if (layer == 0) REP2(10, (phase_combine<false>((const unsigned char*)(ws + WS_Y), (const int*)(ws + WS_POSY), (const float*)(ws + WS_TOKW), (const int*)(ws + WS_MISC + 65536 + 8192), (const bf16_t*)(ws + WS_H1), (bf16_t*)(ws + WS_H2), nullptr, (float*)(ws + WS_GATES), (const float*)(ws + WS_MISC + 4096), A.in[I_LFG], A.in[I_LFB], bid, nb)));
        else REP2(10, (phase_combine<true>((const unsigned char*)(ws + WS_Y), (const int*)(ws + WS_POSY), (const float*)(ws + WS_TOKW), (const int*)(ws + WS_MISC + 65536 + 8192), (const bf16_t*)(ws + WS_H1), nullptr, A.out, nullptr, nullptr, A.in[I_LFG] + DM, A.in[I_LFB] + DM, bid, nb)));
        SEAM(P + 10);
    }
}

__global__ void __launch_bounds__(512, 2) fwd_kernel(Args A) {
    extern __shared__ __attribute__((aligned(16))) unsigned char lds_raw[];
    LAS unsigned char* lds = (LAS unsigned char*)lds_raw;
    const int tid = threadIdx.x;
    unsigned* ctl = (unsigned*)(A.ws + WS_CTL);
    volatile LAS unsigned* misc = (volatile LAS unsigned*)(lds + LDS_MISC);
    if (tid < 64) misc[tid] = 0u;
    __syncthreads();
    const int lo = A.ph_lo, hi = A.ph_hi;
    XcdBarrier bar; bar.bar = ctl + CW_BAR; bar.x = 0; bar.st = misc;
    if (hi - lo > 1) bar = xcd_barrier_post(ctl + CW_BAR, misc);
    if (EN(11) && IN(0)) { for (int rep_ = 0; rep_ < 1 + (int)(((REPMASK) >> 11) & 1u); ++rep_) phase_prologue(lds, A, blockIdx.x, gridDim.x); SEAM(0); }
    run_layer<0>(lds, A, bar, lo, hi);
    run_layer<1>(lds, A, bar, lo, hi);
}
#undef IN
#undef SEAM

#ifdef DBG
__device__ __forceinline__ unsigned hash32(unsigned x) { x ^= x >> 16; x *= 0x7feb352dU; x ^= x >> 15; x *= 0x846ca68bU; x ^= x >> 16; return x; }
__device__ __forceinline__ void dbg_acc(float* w, int stage, float num, float den) { if (!(num == num) || num > 1e30f) num = 1e30f; atomicAdd(w + 2 * stage, num); atomicAdd(w + 2 * stage + 1, den); }
__device__ __forceinline__ float bfr(float x) { return bflo(pk2(x, 0.f)); }
__global__ void dbg_weights(Args A, float* w) {
    const unsigned i = blockIdx.x * 256 + threadIdx.x; unsigned char* ws = A.ws;
    float num = 0.f, den = 0.f;
    { const unsigned hsh = hash32(i * 4 + 0), col = hsh % 3584, k = (hsh >> 12) % 1024; const float r = A.in[I_WINAB][(size_t)k * 3600 + col], g = bf2f(((const bf16_t*)(ws + WS_WAB))[(size_t)col * 1024 + k]); num += (r - g) * (r - g); den += r * r; }
    { const unsigned hsh = hash32(i * 4 + 1), j = hsh % 256, k = (hsh >> 12) % 1024; float r = 0.f; for (int q = 0; q < 16; ++q) r += A.in[I_WINAB][(size_t)k * 3600 + 3584 + q] * A.in[I_WGKUP][q * 256 + j];
      const float g = bf2f(((const bf16_t*)(ws + WS_WAB))[(size_t)(3584 + j) * 1024 + k]); num += (r - g) * (r - g); den += r * r; }
    { const unsigned hsh = hash32(i * 4 + 2), le = hsh % 514, layer = le / 257, e = le % 257, n = (hsh >> 10) % 512, k = (hsh >> 20) % 1024;
      const float r = (e < 256) ? A.in[I_WEI][((size_t)(layer * 256 + e) * 1024 + k) * 512 + n] : A.in[I_WSI][((size_t)layer * 1024 + k) * 512 + n];
      const unsigned up = n >> 8, c = n & 255, drow = (c >> 7) * 256 + up * 128 + (c & 127);
      const float g = bf2f(((const bf16_t*)(ws + WS_W1T))[((size_t)(layer * 257 + e) * 512 + drow) * 1024 + k]); num += (r - g) * (r - g); den += r * r; }
    { const unsigned hsh = hash32(i * 4 + 3), le = hsh % 514, layer = le / 257, e = le % 257, n = (hsh >> 10) % 1024, k = (hsh >> 20) % 256;
      const float r = (e < 256) ? A.in[I_WED][((size_t)(layer * 256 + e) * 256 + k) * 1024 + n] : A.in[I_WSD][((size_t)layer * 256 + k) * 1024 + n];
      const float g = bf2f(((const bf16_t*)(ws + WS_W2T))[((size_t)(layer * 257 + e) * 1024 + n) * 256 + k]); num += (r - g) * (r - g); den += r * r; }
    dbg_acc(w, 1, num, den);
}
__global__ void dbg_gemm(const bf16_t* Am, int K, const bf16_t* Bt, const void* out, int ldo, int out_f32, int nrows, int ncols, float* w, int stage) {
    const unsigned i = blockIdx.x * 256 + threadIdx.x; const unsigned hsh = hash32(i + 77u * stage), row = hsh % nrows, col = (hsh >> 11) % ncols;
    float r = 0.f; for (int k = 0; k < K; ++k) r += bf2f(Am[(size_t)row * K + k]) * bf2f(Bt[(size_t)col * K + k]);
    const float g = out_f32 ? ((const float*)out)[(size_t)row * ldo + col] : bf2f(((const bf16_t*)out)[(size_t)row * ldo + col]);
    dbg_acc(w, stage, (r - g) * (r - g), r * r);
}
template <int MODE> __global__ void __launch_bounds__(256, 1) dbg_mixer(MixP mp, int b, int h, int T, float* w, int stage) {
    constexpr int DK = (MODE == 1) ? 64 : 128, DV = (MODE == 2) ? 256 : 128;
    __shared__ float sq[128], sk[128], sa[128], red[256], sh_i, sh_f;
    const int tid = threadIdx.x;
    const int ldp = mp.ldp; const bf16_t* proj = mp.proj;
    int cq, ck, cv, cg, cy, cu = 3584 + h * 64;
    if (MODE == 0) { cq = h * 128; ck = 512 + h * 128; cv = 1024 + h * 128; cg = 1536 + h * 128; cy = h * 128; }
    else if (MODE == 1) { cq = 2048 + h * 64; ck = 2304 + h * 64; cv = 2560 + h * 128; cg = 3072 + h * 128; cy = 512 + h * 128; }
    else { cq = h * 128; ck = 512 + h * 128; cv = 1024 + h * 256; cg = 2048 + h * 256; cy = h * 256; }
    float S[DK];
#pragma unroll
    for (int d = 0; d < DK; ++d) S[d] = 0.f;
    float nst = 0.f, num = 0.f, den = 0.f;
    for (int t = 0; t < T; ++t) {
        const size_t tok = (size_t)b * SEQ + t; const bf16_t* pr = proj + tok * ldp;
        if (tid < DK) {
            const int d = tid;
            if (MODE == 0) { const float z = bf2f(pr[ck + d]), sg = 1.f / (1.f + expf(-z)), lb = mp.lb0[h * 128 + d]; sa[d] = lb + (1.f - lb) * sg; sk[d] = (1.f - lb) * (1.f - sg); const float qq = bf2f(pr[cq + d]); sq[d] = qq / (1.f + expf(-qq)); }
            else if (MODE == 1) { const float u = bf2f(pr[cu + d]) + mp.bgk[h * 64 + d]; const float ls = fminf(u, 0.f) - log1pf(expf(-fabsf(u))); sa[d] = expf(ls / 16.f); sk[d] = bf2f(pr[ck + d]); sq[d] = bf2f(pr[cq + d]) * 0.125f; }
            else { float aq = 0.f, ak = 0.f; for (int j = 0; j < 4; ++j) { const int tt = t - 3 + j; if (tt >= 0) { const bf16_t* p2 = proj + ((size_t)b * SEQ + tt) * ldp; aq += mp.conv[j * 1024 + cq + d] * bf2f(p2[cq + d]); ak += mp.conv[j * 1024 + ck + d] * bf2f(p2[ck + d]); } }
                sq[d] = aq / (1.f + expf(-aq)); sk[d] = ak / (1.f + expf(-ak)) * 0.08838834764831845f; }
        }
        if (MODE == 2 && tid == 0) { const float* gp = mp.gates + tok * 8; sh_i = expf(gp[h] + mp.bif[h]); const float x = gp[4 + h] + mp.bif[4 + h]; sh_f = 1.f / (1.f + expf(-x)); }
        __syncthreads();
        const float vt = bf2f(pr[cv + tid]);
        float o = 0.f;
        if (MODE == 2) { const float f = sh_f, ii = sh_i;
#pragma unroll
            for (int d = 0; d < DK; ++d) { S[d] = f * S[d] + ii * sk[d] * vt; o += S[d] * sq[d]; }
            if (tid < 128) nst = f * nst + ii * sk[tid];
            red[tid] = (tid < 128) ? nst * sq[tid] : 0.f;
        } else {
#pragma unroll
            for (int d = 0; d < DK; ++d) { S[d] = sa[d] * S[d] + sk[d] * vt; o += S[d] * sq[d]; }
            red[tid] = o * o;
        }
        __syncthreads();
        for (int st = DV / 2; st > 0; st >>= 1) { if (tid < st) red[tid] += red[tid + st]; __syncthreads(); }
        const float tot = red[0];
        const float gt = bf2f(pr[cg + tid]);
        float y;
        if (MODE == 2) y = o / fmaxf(fabsf(tot), 1.f) * (1.f / (1.f + expf(-gt)));
        else y = o * rsqrtf(tot / 128.f + 1e-6f) * ((MODE == 0) ? mp.hg : mp.gg)[h * 128 + tid] * (gt / (1.f + expf(-gt)));
        const float g = bf2f(mp.ymix[tok * DM + cy + tid]);
        num += (y - g) * (y - g); den += y * y;
        __syncthreads();
    }
    dbg_acc(w, stage, num, den);
}
__global__ void dbg_h1(const bf16_t* HIN, const bf16_t* YM, const bf16_t* Wt, const bf16_t* H1, const float* g, const float* bb, float* w, int stage) {
    __shared__ float red[256]; __shared__ float zrow[1024];
    const int tid = threadIdx.x; const unsigned row = hash32(blockIdx.x + 1000u * stage) % NTOK;
    float z[4];
    for (int q = 0; q < 4; ++q) { const int c = tid + 256 * q; float a = 0.f; for (int k = 0; k < 1024; ++k) a += bf2f(YM[(size_t)row * 1024 + k]) * bf2f(Wt[(size_t)c * 1024 + k]); z[q] = bfr(ALPHA * bf2f(HIN[(size_t)row * 1024 + c]) + a); }
    red[tid] = z[0] + z[1] + z[2] + z[3]; __syncthreads();
    for (int st = 128; st > 0; st >>= 1) { if (tid < st) red[tid] += red[tid + st]; __syncthreads(); }
    const float mu = red[0] / 1024.f; __syncthreads();
    red[tid] = (z[0] - mu) * (z[0] - mu) + (z[1] - mu) * (z[1] - mu) + (z[2] - mu) * (z[2] - mu) + (z[3] - mu) * (z[3] - mu); __syncthreads();
    for (int st = 128; st > 0; st >>= 1) { if (tid < st) red[tid] += red[tid + st]; __syncthreads(); }
    const float rs = rsqrtf(red[0] / 1024.f + 1e-5f);
    float num = 0.f, den = 0.f;
    for (int q = 0; q < 4; ++q) { const int c = tid + 256 * q; const float y = (z[q] - mu) * rs * g[c] + bb[c], gg = bf2f(H1[(size_t)row * 1024 + c]); num += (y - gg) * (y - gg); den += y * y; }
    dbg_acc(w, stage, num, den); (void)zrow;
}
__global__ void dbg_select(const float* logits, const float* rb, const int* tok_e, const float* tok_w, float* w, int stage) {
    __shared__ float sc[256], bs[256]; __shared__ int ce[8]; __shared__ float cs[8];
    if (threadIdx.x != 0) return;
    const unsigned tok = hash32(blockIdx.x + 31u * stage) % NTOK;
    const float* lp = logits + (size_t)tok * 256;
    for (int e = 0; e < 256; ++e) { sc[e] = 1.f / (1.f + expf(-lp[e])); bs[e] = sc[e] + rb[e]; }
    float gs[8];
#pragma unroll
    for (int g = 0; g < 8; ++g) { float m1 = -1e30f, m2 = -1e30f; for (int j = 0; j < 32; ++j) { const float v = bs[g * 32 + j]; if (v > m1) { m2 = m1; m1 = v; } else if (v > m2) m2 = v; } gs[g] = m1 + m2; }
    unsigned selmask = 0;
#pragma unroll
    for (int g = 0; g < 8; ++g) { int rank = 0;
#pragma unroll
        for (int q = 0; q < 8; ++q) rank += (gs[q] > gs[g] || (gs[q] == gs[g] && q < g)) ? 1 : 0; if (rank < 4) selmask |= 1u << g; }
    float tot = 0.f;
    for (int k = 0; k < 8; ++k) { float bv = -1e30f; int be = 0; for (int e = 0; e < 256; ++e) { if (!((selmask >> (e >> 5)) & 1u)) continue; bool used = false; for (int q = 0; q < k; ++q) used |= (ce[q] == e); if (used) continue; if (bs[e] > bv) { bv = bs[e]; be = e; } } ce[k] = be; cs[k] = sc[be]; tot += sc[be]; }
    float num = 0.f, den = 0.f;
    for (int k = 0; k < 8; ++k) { const float wr_ = cs[k] / tot * 2.5f; const int ge = tok_e[(size_t)tok * 8 + k]; const float gw = tok_w[(size_t)tok * 8 + k];
        num += (ge == ce[k] ? 0.f : 1.f) + (wr_ - gw) * (wr_ - gw); den += wr_ * wr_; }
    dbg_acc(w, stage, num, den);
}
template <bool FINAL> __global__ void dbg_moe(Args A, int layer, const int* tok_e, const float* tok_w, const bf16_t* H1, const bf16_t* H2, const float* OUT, float* w, int stage) {
    __shared__ float hrow[1024], hid[256], red[256];
    const int tid = threadIdx.x; const unsigned tok = hash32(blockIdx.x + 555u * stage) % NTOK;
    for (int i = tid; i < 1024; i += 256) hrow[i] = bf2f(H1[(size_t)tok * 1024 + i]);
    float acc[4] = {0.f, 0.f, 0.f, 0.f};
    __syncthreads();
    for (int k = 0; k < 9; ++k) {
        const int e = (k < 8) ? tok_e[(size_t)tok * 8 + k] : 256; const float wk = (k < 8) ? tok_w[(size_t)tok * 8 + k] : 1.f;
        const float* W1 = (e < 256) ? A.in[I_WEI] + (size_t)(layer * 256 + e) * 1024 * 512 : A.in[I_WSI] + (size_t)layer * 1024 * 512;
        const float* W2 = (e < 256) ? A.in[I_WED] + (size_t)(layer * 256 + e) * 256 * 1024 : A.in[I_WSD] + (size_t)layer * 256 * 1024;
        float gsum = 0.f, usum = 0.f;
        for (int kk = 0; kk < 1024; ++kk) { gsum += hrow[kk] * W1[(size_t)kk * 512 + tid]; usum += hrow[kk] * W1[(size_t)kk * 512 + 256 + tid]; }
        hid[tid] = gsum / (1.f + expf(-gsum)) * usum;
        __syncthreads();
        for (int q = 0; q < 4; ++q) { const int c = tid + 256 * q; float a = 0.f; for (int j = 0; j < 256; ++j) a += hid[j] * W2[(size_t)j * 1024 + c]; acc[q] += wk * a; }
        __syncthreads();
    }
    float z[4]; for (int q = 0; q < 4; ++q) z[q] = ALPHA * hrow[tid + 256 * q] + acc[q];
    red[tid] = z[0] + z[1] + z[2] + z[3]; __syncthreads();
    for (int st = 128; st > 0; st >>= 1) { if (tid < st) red[tid] += red[tid + st]; __syncthreads(); }
    const float mu = red[0] / 1024.f; __syncthreads();
    red[tid] = (z[0] - mu) * (z[0] - mu) + (z[1] - mu) * (z[1] - mu) + (z[2] - mu) * (z[2] - mu) + (z[3] - mu) * (z[3] - mu); __syncthreads();
    for (int st = 128; st > 0; st >>= 1) { if (tid < st) red[tid] += red[tid + st]; __syncthreads(); }
    const float rs = rsqrtf(red[0] / 1024.f + 1e-5f);
    const float* g = A.in[I_LFG] + layer * DM; const float* bb = A.in[I_LFB] + layer * DM;
    float num = 0.f, den = 0.f;
    for (int q = 0; q < 4; ++q) { const int c = tid + 256 * q; const float y = (z[q] - mu) * rs * g[c] + bb[c]; const float gg = FINAL ? OUT[(size_t)tok * 1024 + c] : bf2f(H2[(size_t)tok * 1024 + c]); num += (y - gg) * (y - gg); den += y * y; }
    dbg_acc(w, stage, num, den);
}
#ifndef DBG_REPORT
#define DBG_REPORT 0
#endif
__global__ void dbg_fill(float* out, const float* w) {
    __shared__ float cval;
    if (threadIdx.x == 0) {
        float c = 0.f;
        if (DBG_REPORT == 0) { for (int st = 1; st <= 13; ++st) { const float rel = sqrtf(w[2 * st] / fmaxf(w[2 * st + 1], 1e-30f)); if (!(rel < 0.08f) || !(w[2 * st + 1] > 0.f)) { c = (float)st; break; } } }
        else { const float rel = sqrtf(w[2 * DBG_REPORT] / fmaxf(w[2 * DBG_REPORT + 1], 1e-30f)); float l = -log10f(fmaxf(rel, 1e-8f)); l = fminf(fmaxf(l, -2.f), 8.f); c = 3.f + l; }
        cval = c;
    }
    __syncthreads();
    const float c = cval;
    if (c != 0.f) for (size_t i = (size_t)blockIdx.x * 256 + threadIdx.x; i < (size_t)NTOK * DM; i += (size_t)gridDim.x * 256) out[i] = c;
}
#endif

extern "C" void kernel_launch(void* const* d_in, const int* in_sizes, int n_in, void* d_out, int out_size, void* d_ws, size_t ws_size, hipStream_t stream) {
    static int grid = 0;
    if (grid == 0) {
        if (n_in != 22 || out_size != NTOK * DM || ws_size < WS_END) { fprintf(stderr, "kernel_launch: unexpected shapes (n_in %d out %d ws %zu)\n", n_in, out_size, ws_size); grid = -1; return; }
        if (hipFuncSetAttribute((const void*)fwd_kernel, hipFuncAttributeMaxDynamicSharedMemorySize, LDS_BYTES) != hipSuccess) { fprintf(stderr, "kernel_launch: hipFuncSetAttribute failed\n"); grid = -1; return; }
        int per_cu = 0;
        if (hipOccupancyMaxActiveBlocksPerMultiprocessor(&per_cu, (const void*)fwd_kernel, 512, LDS_BYTES) != hipSuccess || per_cu < 1) fprintf(stderr, "kernel_launch: occupancy query says %d\n", per_cu);
        (void)hipGetLastError();
        grid = NWG;
    }
    if (grid < 0) return;
    (void)hipMemsetAsync((char*)d_ws + WS_CTL, 0, CTL_BYTES, stream);
    Args a{};
    for (int i = 0; i < 22; ++i) a.in[i] = (const float*)d_in[i];
    a.out = (float*)d_out; a.ws = (unsigned char*)d_ws;
#if MK_ONE_LAUNCH
    a.ph_lo = 0; a.ph_hi = 23;
    hipLaunchKernelGGL(fwd_kernel, dim3(grid), dim3(512), LDS_BYTES, stream, a);
#else
    for (int p = 0; p < 23; ++p) { a.ph_lo = p; a.ph_hi = p + 1; hipLaunchKernelGGL(fwd_kernel, dim3(grid), dim3(512), LDS_BYTES, stream, a);
#ifdef DBG
        unsigned char* ws = (unsigned char*)d_ws; float* dw = (float*)(ws + WS_CTL) + CW_DBG;
        const int layer = (p - 1) / 11, q = (p - 1) % 11;
        MixP mp{(const bf16_t*)(ws + WS_PROJ), layer ? CWID : ABW, 0, (bf16_t*)(ws + WS_YMIX), (const float*)(ws + WS_GATES), (const float*)(ws + WS_MISC), a.in[I_BGK], a.in[I_HG], a.in[I_GG], a.in[I_CONV], a.in[I_BIF], (float*)(ws + WS_UST), (float*)(ws + WS_GSUM)};
        if (p == 0) hipLaunchKernelGGL(dbg_weights, dim3(256), dim3(256), 0, stream, a, dw);
        if (p >= 1 && q == 0) hipLaunchKernelGGL(dbg_gemm, dim3(64), dim3(256), 0, stream, (const bf16_t*)(ws + (layer ? WS_H2 : WS_HB)), 1024, (const bf16_t*)(ws + (layer ? WS_WC : WS_WAB)), (const void*)(ws + WS_PROJ), layer ? CWID : ABW, 0, NTOK, layer ? CWID : ABW, dw, layer ? 9 : 2);
        if (p >= 1 && q == 2 && layer == 0) { hipLaunchKernelGGL(dbg_mixer<0>, dim3(1), dim3(128), 0, stream, mp, 0, 1, 1100, dw, 3); hipLaunchKernelGGL(dbg_mixer<1>, dim3(1), dim3(128), 0, stream, mp, 1, 2, 1100, dw, 4); }
        if (p >= 1 && q == 2 && layer == 1) hipLaunchKernelGGL(dbg_mixer<2>, dim3(1), dim3(256), 0, stream, mp, 1, 1, 1100, dw, 10);
        if (p >= 1 && q == 4) hipLaunchKernelGGL(dbg_h1, dim3(32), dim3(256), 0, stream, (const bf16_t*)(ws + (layer ? WS_H2 : WS_HB)), (const bf16_t*)(ws + WS_YMIX), (const bf16_t*)(ws + (layer ? WS_WOC : WS_WOAB)), (const bf16_t*)(ws + WS_H1), a.in[I_LMG] + layer * DM, a.in[I_LMB] + layer * DM, dw, layer ? 11 : 5);
        if (p >= 1 && q == 5 && layer == 0) hipLaunchKernelGGL(dbg_gemm, dim3(64), dim3(256), 0, stream, (const bf16_t*)(ws + WS_H1), 1024, (const bf16_t*)(ws + WS_WR), (const void*)(ws + WS_LOGITS), 256, 1, NTOK, 256, dw, 6);
        if (p >= 1 && q == 6) hipLaunchKernelGGL(dbg_select, dim3(64), dim3(64), 0, stream, (const float*)(ws + WS_LOGITS), a.in[I_RB] + layer * NEXP, (const int*)(ws + WS_TOKE), (const float*)(ws + WS_TOKW), dw, layer ? 12 : 7);
        if (p >= 1 && q == 10 && layer == 0) hipLaunchKernelGGL(dbg_moe<false>, dim3(32), dim3(256), 0, stream, a, 0, (const int*)(ws + WS_TOKE), (const float*)(ws + WS_TOKW), (const bf16_t*)(ws + WS_H1), (const bf16_t*)(ws + WS_H2), (const float*)d_out, dw, 8);
        if (p >= 1 && q == 10 && layer == 1) { hipLaunchKernelGGL(dbg_moe<true>, dim3(32), dim3(256), 0, stream, a, 1, (const int*)(ws + WS_TOKE), (const float*)(ws + WS_TOKW), (const bf16_t*)(ws + WS_H1), (const bf16_t*)(ws + WS_H2), (const float*)d_out, dw, 13);
            hipLaunchKernelGGL(dbg_fill, dim3(1024), dim3(256), 0, stream, (float*)d_out, dw); }
#endif
    }
#endif
}
```

```cpp
#include <hip/hip_runtime.h>
#include <cstdio>
#include <cstdint>

#ifndef MK_ONE_LAUNCH
#define MK_ONE_LAUNCH 1
#endif

#define LAS __attribute__((address_space(3)))
typedef unsigned short bf16_t;
typedef short bf16x8 __attribute__((ext_vector_type(8)));
typedef float f32x4 __attribute__((ext_vector_type(4)));
typedef unsigned u32x4 __attribute__((ext_vector_type(4)));
typedef unsigned u32x2 __attribute__((ext_vector_type(2)));

constexpr int NTOK = 32768, SEQ = 16384, DM = 1024;
constexpr int ABW = 3840;
constexpr int CWID = 3072;
constexpr int NEXP = 256, NE1 = 257, TOPK = 8, NSLOT = 9;
constexpr float ALPHA = 1.41421356237f;
constexpr int NWG = 256;
constexpr int PRMAX = 262144 + 65536 + 32768;

constexpr size_t MiB = 1u << 20;
constexpr size_t WS_CTL = 0, CTL_BYTES = 1 * MiB;
constexpr size_t WS_MISC = 1 * MiB;
constexpr size_t WS_WAB = 2 * MiB, WS_WOAB = 10 * MiB, WS_WC = 12 * MiB, WS_WOC = 18 * MiB, WS_WR = 20 * MiB;
constexpr size_t WS_TOKE = 22 * MiB, WS_TOKP = 23 * MiB, WS_TOKW = 24 * MiB;
constexpr size_t WS_STOK = 26 * MiB, WS_POSY = 28 * MiB;
constexpr size_t WS_GATES = 32 * MiB;
constexpr size_t WS_UST = 34 * MiB, WS_GSUM = 54 * MiB;
constexpr size_t WS_LOGITS = 56 * MiB;
constexpr size_t WS_HB = 96 * MiB, WS_PROJ = 160 * MiB, WS_YMIX = 400 * MiB, WS_Z = 464 * MiB, WS_H1 = 528 * MiB, WS_H2 = 592 * MiB;
constexpr size_t WS_ACT = 656 * MiB, WS_Y = 832 * MiB, WS_W1T = 1540 * MiB, WS_W2T = 2056 * MiB;
constexpr size_t WS_XQ = 2320 * MiB, WS_H1Q = 2352 * MiB, WS_H2Q = 2384 * MiB, WS_END = 2416 * MiB;
constexpr float Q_SA = 127.f / 5.5f, Q_SW = 127.f * 32.f / 5.5f, Q_DEQ = 1.f / (Q_SA * Q_SW);
constexpr int CW_BAR = 4096;
constexpr int CW_CNT = 16384;
constexpr int CW_DBG = 20480;

__device__ __forceinline__ unsigned pk2(float lo, float hi) { unsigned r; asm volatile("v_cvt_pk_bf16_f32 %0, %1, %2" : "=v"(r) : "v"(lo), "v"(hi)); return r; }
__device__ __forceinline__ float bflo(unsigned u) { return __uint_as_float(u << 16); }
__device__ __forceinline__ float bfhi(unsigned u) { return __uint_as_float(u & 0xffff0000u); }
__device__ __forceinline__ float bf2f(bf16_t b) { return __uint_as_float(((unsigned)b) << 16); }
__device__ __forceinline__ float sigm(float x) { return __builtin_amdgcn_rcpf(1.f + __expf(-x)); }
__device__ __forceinline__ float silu(float x) { return x * __builtin_amdgcn_rcpf(1.f + __expf(-x)); }
__device__ __forceinline__ int q8(float x, float sc) { return (int)rintf(fminf(fmaxf(x * sc, -127.f), 127.f)); }
__device__ __forceinline__ unsigned pk4(int a, int b, int c, int d) { return (unsigned)(a & 255) | ((unsigned)(b & 255) << 8) | ((unsigned)(c & 255) << 16) | ((unsigned)d << 24); }
__device__ __forceinline__ float logsig(float x) { return fminf(x, 0.f) - __logf(1.f + __expf(-fabsf(x))); }

#define XB_TMO      128
#define XB_XCNT(j)  (256  + 64 * (j))
#define XB_XSUB(j)  (1280 + 64 * (j))
#define XB_XGEN(j)  (2304 + 64 * (j))
#define XB_TOP      3328
#define XB_TOPGEN   3392
#define XCD_BAR_WORDS 3456
#define XB_SPIN_CAP (1u << 22)
__device__ __forceinline__ unsigned xb_ld(unsigned* p)              { return __hip_atomic_load(p, __ATOMIC_RELAXED, __HIP_MEMORY_SCOPE_AGENT); }
__device__ __forceinline__ unsigned xb_add(unsigned* p, unsigned v) { return __hip_atomic_fetch_add(p, v, __ATOMIC_RELAXED, __HIP_MEMORY_SCOPE_AGENT); }
__device__ __forceinline__ unsigned xb_xcc_id() { return (unsigned)__builtin_amdgcn_s_getreg((3 << 11) | 20) & 0xFu; }
#define XB_SPIN(cond, bar) do { unsigned _sp = 0; while (cond) { __builtin_amdgcn_s_sleep(1); \
    if ((++_sp & 255u) == 0u) { if (xb_ld(&(bar)[XB_TMO])) break; if (_sp > XB_SPIN_CAP) { atomicAdd(&(bar)[XB_TMO], 1u); break; } } } } while (0)
struct XcdBarrier { unsigned* bar; unsigned x; volatile LAS unsigned* st; };
__device__ __forceinline__ XcdBarrier xcd_barrier_post(unsigned* bar, volatile LAS unsigned* st) {
    XcdBarrier b; b.bar = bar; b.x = xb_xcc_id(); b.st = st;
    if (threadIdx.x == 0) (void)xb_add(&bar[XB_XCNT(b.x)], 1u);
    return b;
}
__device__ __forceinline__ void xcd_barrier_complete(unsigned* bar, unsigned x, unsigned& nloc, unsigned& nx) {
    const unsigned G = gridDim.x * gridDim.y * gridDim.z;
    unsigned sum, cnt, mine, sp = 0u;
    for (;;) {
        sum = 0u; cnt = 0u; mine = 0u;
#pragma unroll
        for (unsigned j = 0; j < 16; ++j) { const unsigned c = xb_ld(&bar[XB_XCNT(j)]); sum += c; cnt += (c > 0u) ? 1u : 0u; mine = (j == x) ? c : mine; }
        if (sum == G) break;
        __builtin_amdgcn_s_sleep(1);
        if ((++sp & 255u) == 0u) { if (xb_ld(&bar[XB_TMO])) break; if (sp > XB_SPIN_CAP) { atomicAdd(&bar[XB_TMO], 1u); break; } }
    }
    nloc = mine > 0u ? mine : 1u; nx = cnt > 0u ? cnt : 1u;
}
__device__ __forceinline__ void xcd_barrier(const XcdBarrier& b) {
    asm volatile("s_waitcnt vmcnt(0)" ::: "memory");
    __syncthreads();
    if (threadIdx.x == 0) {
        unsigned* bar = b.bar;
        __builtin_amdgcn_s_waitcnt(0);
        unsigned nloc = b.st[0], nx = b.st[1];
        if (nloc == 0u) { xcd_barrier_complete(bar, b.x, nloc, nx); b.st[0] = nloc; b.st[1] = nx; }
        const unsigned old = xb_add(&bar[XB_XSUB(b.x)], 1u);
        const unsigned gen = old / nloc;
        if (old + 1u == (gen + 1u) * nloc) {
            __builtin_amdgcn_fence(__ATOMIC_RELEASE, "agent");
            asm volatile("s_waitcnt vmcnt(0)" ::: "memory");
            const unsigned og = xb_add(&bar[XB_TOP], 1u);
            const unsigned tg = og / nx;
            if (og + 1u == (tg + 1u) * nx) xb_add(&bar[XB_TOPGEN], 1u);
            else XB_SPIN(xb_ld(&bar[XB_TOPGEN]) == tg, bar);
            __builtin_amdgcn_fence(__ATOMIC_ACQUIRE, "agent");
            xb_add(&bar[XB_XGEN(b.x)], 1u);
            asm volatile("s_waitcnt vmcnt(0)" ::: "memory");
        } else {
            XB_SPIN(xb_ld(&bar[XB_XGEN(b.x)]) == gen, bar);
            __builtin_amdgcn_fence(__ATOMIC_ACQUIRE, "agent");
            asm volatile("s_waitcnt vmcnt(0)" ::: "memory");
        }
    }
    __syncthreads();
}

namespace pg8 {
constexpr int BM = 256, BK = 64, HALF = 128, HTB = HALF * BK * 2, STAGE_BYTES = 8 * HTB, NXCD = 8, WGM = 8;
__device__ __forceinline__ int lds_byte(int r, int c) { const int st = (r >> 4) * 2 + (c >> 5), rr = r & 15, cc = c & 31, ob = rr * 64 + cc * 2; return st * 1024 + (ob ^ (((ob >> 9) & 1) << 5)); }
__device__ __forceinline__ void stage_rc(int b, int& R, int& C) { const int st = b / 1024, sb = b % 1024, swz = sb ^ (((sb >> 9) & 1) << 5); R = (st >> 1) * 16 + swz / 64; C = (st & 1) * 32 + (swz % 64) / 2; }
__device__ __forceinline__ int perm32(int rho) { const int n = rho >> 4, i = rho & 15; return 8 * (i >> 2) + 4 * n + (i & 3); }
struct Unit { int pm, pn; };
struct Gemm { const bf16_t* A; const bf16_t* Bt; int K; };

struct StaticOrder {
    int nM, nN, nwg, G, c;
    __device__ void init(int M, int N, int G_, int c_) { nM = M / BM; nN = N / BM; nwg = nM * nN; G = G_; c = c_; }
    __device__ bool next(int i, Unit& u) const {
        const long L = (long)i * G + c; if (L >= nwg) return false;
        int wgid = (int)L; { const int q = nwg / NXCD, r = nwg % NXCD, xcd = wgid % NXCD, off = wgid / NXCD; wgid = (xcd < r ? xcd * (q + 1) : r * (q + 1) + (xcd - r) * q) + off; }
        const int nig = WGM * nN, gid = wgid / nig, fm = gid * WGM, gsz = (nM - fm) < WGM ? (nM - fm) : WGM;
        u.pm = fm + ((wgid % nig) % gsz); u.pn = (wgid % nig) / gsz; return true;
    }
};
struct MoeOrder {
    const int* tile_exp; int nunits, sh, G, c;
    __device__ bool next(int i, Unit& u) const {
        const long L = (long)i * G + c; if (L >= nunits) return false;
        const int rt = (int)(L >> sh), j = (int)L & ((1 << sh) - 1);
        const int e = __builtin_amdgcn_readfirstlane(tile_exp[rt]);
        u.pm = rt; u.pn = (e << sh) + j; return true;
    }
};

typedef int i32x4 __attribute__((ext_vector_type(4)));
template <class Epi, class Sched, bool GATHER, bool I8 = false>
__device__ __forceinline__ void gemm_phase(LAS unsigned char* lds, const Gemm g, const int* __restrict__ rowidx, const Sched& S, const Epi& E) {
    const int tid = threadIdx.x, wid = __builtin_amdgcn_readfirstlane(tid >> 6), lane = tid & 63, wr = wid >> 2, wc = wid & 3, fr = lane & 15, fq = lane >> 4;
    const int K = g.K, nt = K / BK;
    unsigned voffB[2], cofs[2]; int Rr[2];
#pragma unroll
    for (int i = 0; i < 2; ++i) { int R, C; stage_rc(tid * 16 + i * 8192, R, C); const int Rb = Epi::PERM ? ((R & ~31) + perm32(R & 31)) : R;
        Rr[i] = R; cofs[i] = (unsigned)C * 2u; voffB[i] = (unsigned)(Rb * K + C) * 2u; }
    const unsigned rowb = (unsigned)K * 2u;
    const size_t kstep = (size_t)(BK * 2);
    const size_t hstep = (size_t)HALF * K * 2;
    const size_t tstep = 2 * hstep;
    const unsigned ldsw = (unsigned)wid * 1024u;
    const int aoff = lds_byte(wr * 64 + fr, fq * 8), boff = lds_byte(wc * 32 + fr, fq * 8);
    const char* Abase = (const char*)g.A;
#define PG8_SA(b, h) (((b) * 2 + (h)) * HTB)
#define PG8_SB(b, h) ((4 + (b) * 2 + (h)) * HTB)
#define PG8_STAGE(bufoff, gbase, voff) do { _Pragma("unroll") for (int _i = 0; _i < 2; ++_i) \
        __builtin_amdgcn_global_load_lds((const unsigned*)((const char*)(gbase) + (voff)[_i]), (LAS unsigned*)(lds + (bufoff) + ldsw + _i * 8192), 16, 0, 0); } while (0)
#define PG8_STAGEA(bufoff, kb, offs) do { _Pragma("unroll") for (int _i = 0; _i < 2; ++_i) \
        __builtin_amdgcn_global_load_lds((const unsigned*)(Abase + (size_t)((kb) + (offs)[_i])), (LAS unsigned*)(lds + (bufoff) + ldsw + _i * 8192), 16, 0, 0); } while (0)
#define PG8_ROWOFF(u, O) do { _Pragma("unroll") for (int _h = 0; _h < 2; ++_h) _Pragma("unroll") for (int _i = 0; _i < 2; ++_i) { \
        int _row = (u).pm * BM + _h * HALF + Rr[_i]; if (GATHER) _row = rowidx[_row]; (O)[_h][_i] = (unsigned)_row * rowb + cofs[_i]; } } while (0)
#define PG8_LDA(dst, b, h) do { _Pragma("unroll") for (int m = 0; m < 4; ++m) _Pragma("unroll") for (int k = 0; k < 2; ++k) dst[m][k] = *(const LAS bf16x8*)(lds + PG8_SA(b, h) + aoff + m * 2048 + k * 1024); } while (0)
#define PG8_LDB(dst, b, h) do { _Pragma("unroll") for (int n = 0; n < 2; ++n) _Pragma("unroll") for (int k = 0; k < 2; ++k) dst[n][k] = *(const LAS bf16x8*)(lds + PG8_SB(b, h) + boff + n * 2048 + k * 1024); } while (0)
#define PG8_MMA(ai, bj, At, Bt) do { __builtin_amdgcn_s_setprio(1); _Pragma("unroll") for (int m = 0; m < 4; ++m) _Pragma("unroll") for (int n = 0; n < 2; ++n) _Pragma("unroll") for (int k = 0; k < 2; ++k) \
        { if (I8) acc[ai][bj][m][n] = __builtin_bit_cast(f32x4, __builtin_amdgcn_mfma_i32_16x16x64_i8(__builtin_bit_cast(i32x4, Bt[n][k]), __builtin_bit_cast(i32x4, At[m][k]), __builtin_bit_cast(i32x4, acc[ai][bj][m][n]), 0, 0, 0)); \
          else acc[ai][bj][m][n] = __builtin_amdgcn_mfma_f32_16x16x32_bf16(Bt[n][k], At[m][k], acc[ai][bj][m][n], 0, 0, 0); } __builtin_amdgcn_s_setprio(0); } while (0)
#define PG8_WAIT_V(n) asm volatile("s_waitcnt vmcnt(" #n ")" ::: "memory")
#define PG8_WAIT_L(n) asm volatile("s_waitcnt lgkmcnt(" #n ")" ::: "memory")
#define PG8_BAR __builtin_amdgcn_s_barrier()
#define PG8_SCHED __builtin_amdgcn_sched_barrier(0)
    Unit cur, nxt; int ui = 0;
    if (!S.next(0, cur)) return;
    f32x4 acc[2][2][4][2];
#pragma unroll
    for (int a = 0; a < 2; ++a)
#pragma unroll
        for (int b = 0; b < 2; ++b)
#pragma unroll
            for (int m = 0; m < 4; ++m)
#pragma unroll
                for (int n = 0; n < 2; ++n) acc[a][b][m][n] = (f32x4){0.f, 0.f, 0.f, 0.f};
    bf16x8 At[4][2], B0[2][2], B1[2][2];
    unsigned cO[2][2], nO[2][2];
    PG8_ROWOFF(cur, cO);
    const char* cB = (const char*)g.Bt + (size_t)cur.pn * tstep;
    PG8_STAGE(PG8_SB(0, 0), cB, voffB); PG8_STAGE(PG8_SB(0, 1), cB + hstep, voffB); PG8_STAGEA(PG8_SA(0, 0), 0u, cO[0]); PG8_STAGEA(PG8_SA(0, 1), 0u, cO[1]);
    if (wr == 1) PG8_BAR;
    PG8_WAIT_V(2); PG8_BAR;
    PG8_STAGE(PG8_SB(1, 0), cB + kstep, voffB); PG8_STAGEA(PG8_SA(1, 0), (unsigned)kstep, cO[0]); PG8_STAGE(PG8_SB(1, 1), cB + hstep + kstep, voffB);
    PG8_WAIT_V(6); PG8_BAR;
    for (;;) {
        const bool has_next = S.next(ui + 1, nxt);
        const char* nB = has_next ? (const char*)g.Bt + (size_t)nxt.pn * tstep : cB;
#pragma unroll
        for (int h = 0; h < 2; ++h)
#pragma unroll
            for (int i = 0; i < 2; ++i) nO[h][i] = cO[h][i];
#pragma unroll 1
        for (int t = 0; t < nt; t += 2) {
            const bool last = (t == nt - 2);
            if (last && has_next) PG8_ROWOFF(nxt, nO);
            const unsigned k1 = (unsigned)(t + 1) * (unsigned)kstep;
            const unsigned k2 = last ? 0u : (unsigned)(t + 2) * (unsigned)kstep, k3 = k2 + (unsigned)kstep;
            const char* b2 = last ? nB : cB + (size_t)(t + 2) * kstep; const char* b3 = b2 + kstep;
            unsigned o2[2][2];
#pragma unroll
            for (int h = 0; h < 2; ++h)
#pragma unroll
                for (int i = 0; i < 2; ++i) o2[h][i] = last ? nO[h][i] : cO[h][i];
            PG8_LDB(B0, 0, 0); PG8_LDB(B1, 0, 1); PG8_SCHED; PG8_LDA(At, 0, 0); PG8_STAGEA(PG8_SA(1, 1), k1, cO[1]);
            PG8_WAIT_V(8); PG8_WAIT_L(0); PG8_BAR; PG8_MMA(0, 0, At, B0); PG8_MMA(0, 1, At, B1); PG8_BAR; PG8_SCHED;
            PG8_LDA(At, 0, 1); PG8_STAGE(PG8_SB(0, 0), b2, voffB); PG8_STAGE(PG8_SB(0, 1), b2 + hstep, voffB); PG8_STAGEA(PG8_SA(0, 0), k2, o2[0]);
            PG8_WAIT_V(8); PG8_WAIT_L(0); PG8_BAR; PG8_MMA(1, 0, At, B0); PG8_MMA(1, 1, At, B1); PG8_BAR; PG8_SCHED;
            PG8_LDB(B0, 1, 0); PG8_LDB(B1, 1, 1); PG8_SCHED; PG8_LDA(At, 1, 0); PG8_STAGEA(PG8_SA(0, 1), k2, o2[1]);
            PG8_WAIT_V(8); PG8_WAIT_L(0); PG8_BAR; PG8_MMA(0, 0, At, B0); PG8_MMA(0, 1, At, B1); PG8_BAR; PG8_SCHED;
            PG8_LDA(At, 1, 1); PG8_STAGE(PG8_SB(1, 0), b3, voffB); PG8_STAGE(PG8_SB(1, 1), b3 + hstep, voffB); PG8_STAGEA(PG8_SA(1, 0), k3, o2[0]);
            PG8_WAIT_V(8); PG8_WAIT_L(0); PG8_BAR; PG8_MMA(1, 0, At, B0); PG8_MMA(1, 1, At, B1); PG8_BAR; PG8_SCHED;
        }
        if (wr == 0) PG8_BAR;
        E(acc, cur, wr, wc, fr, fq);
        if (!has_next) break;
#pragma unroll
        for (int a = 0; a < 2; ++a)
#pragma unroll
            for (int b = 0; b < 2; ++b)
#pragma unroll
                for (int m = 0; m < 4; ++m)
#pragma unroll
                    for (int n = 0; n < 2; ++n) acc[a][b][m][n] = (f32x4){0.f, 0.f, 0.f, 0.f};
        cur = nxt; cB = nB; ++ui;
#pragma unroll
        for (int h = 0; h < 2; ++h)
#pragma unroll
            for (int i = 0; i < 2; ++i) cO[h][i] = nO[h][i];
        if (wr == 1) PG8_BAR;
    }
    PG8_WAIT_V(0);
    PG8_BAR;
#undef PG8_SA
#undef PG8_SB
#undef PG8_STAGE
#undef PG8_STAGEA
#undef PG8_ROWOFF
#undef PG8_LDA
#undef PG8_LDB
#undef PG8_MMA
#undef PG8_WAIT_V
#undef PG8_WAIT_L
#undef PG8_BAR
#undef PG8_SCHED
}

template <bool I8> struct EpiStoreBf16 {
    static constexpr bool PERM = true;
    bf16_t* O; int ldc;
    static __device__ __forceinline__ f32x4 dq(f32x4 v) { if (I8) { const i32x4 q = __builtin_bit_cast(i32x4, v); return (f32x4){(float)q[0] * Q_DEQ, (float)q[1] * Q_DEQ, (float)q[2] * Q_DEQ, (float)q[3] * Q_DEQ}; } return v; }
    __device__ __forceinline__ void operator()(const f32x4 (&acc)[2][2][4][2], const Unit& u, int wr, int wc, int fr, int fq) const {
        const int row0 = u.pm * BM + wr * 64 + fr, col0 = u.pn * BM + wc * 32 + 8 * fq;
#pragma unroll
        for (int ai = 0; ai < 2; ++ai)
#pragma unroll
            for (int m = 0; m < 4; ++m) { bf16_t* rowp = O + (size_t)(row0 + ai * HALF + m * 16) * ldc + col0;
#pragma unroll
                for (int bj = 0; bj < 2; ++bj) { const f32x4 v0 = dq(acc[ai][bj][m][0]), v1 = dq(acc[ai][bj][m][1]);
                    u32x4 w; w.x = pk2(v0[0], v0[1]); w.y = pk2(v0[2], v0[3]); w.z = pk2(v1[0], v1[1]); w.w = pk2(v1[2], v1[3]);
                    *(u32x4*)(rowp + bj * HALF) = w; } }
    }
};
struct EpiResid {
    static constexpr bool PERM = true;
    bf16_t* Z; const bf16_t* H;
    __device__ __forceinline__ void operator()(const f32x4 (&acc)[2][2][4][2], const Unit& u, int wr, int wc, int fr, int fq) const {
        const int row0 = u.pm * BM + wr * 64 + fr, col0 = u.pn * BM + wc * 32 + 8 * fq;
#pragma unroll
        for (int ai = 0; ai < 2; ++ai)
#pragma unroll
            for (int m = 0; m < 4; ++m) { const size_t ro = (size_t)(row0 + ai * HALF + m * 16) * DM + col0;
#pragma unroll
                for (int bj = 0; bj < 2; ++bj) { const f32x4 v0 = acc[ai][bj][m][0], v1 = acc[ai][bj][m][1];
                    const u32x4 hh = *(const u32x4*)(H + ro + bj * HALF);
                    u32x4 w;
                    w.x = pk2(ALPHA * bflo(hh.x) + v0[0], ALPHA * bfhi(hh.x) + v0[1]); w.y = pk2(ALPHA * bflo(hh.y) + v0[2], ALPHA * bfhi(hh.y) + v0[3]);
                    w.z = pk2(ALPHA * bflo(hh.z) + v1[0], ALPHA * bfhi(hh.z) + v1[1]); w.w = pk2(ALPHA * bflo(hh.w) + v1[2], ALPHA * bfhi(hh.w) + v1[3]);
                    *(u32x4*)(Z + ro + bj * HALF) = w; } }
    }
};
struct EpiF32 {
    static constexpr bool PERM = false;
    float* C;
    __device__ __forceinline__ void operator()(const f32x4 (&acc)[2][2][4][2], const Unit& u, int wr, int wc, int fr, int fq) const {
        const int row0 = u.pm * BM + wr * 64 + fr, col0 = wc * 32 + 4 * fq;
#pragma unroll
        for (int ai = 0; ai < 2; ++ai)
#pragma unroll
            for (int m = 0; m < 4; ++m) { float* rowp = C + (size_t)(row0 + ai * HALF + m * 16) * 256 + col0;
#pragma unroll
                for (int bj = 0; bj < 2; ++bj)
#pragma unroll
                    for (int n = 0; n < 2; ++n) *(f32x4*)(rowp + bj * HALF + n * 16) = acc[ai][bj][m][n]; }
    }
};
template <bool I8> struct EpiSwiGLU {
    static constexpr bool PERM = true;
    bf16_t* ACT;
    static __device__ __forceinline__ f32x4 dq(f32x4 v) { if (I8) { const i32x4 q = __builtin_bit_cast(i32x4, v); return (f32x4){(float)q[0] * Q_DEQ, (float)q[1] * Q_DEQ, (float)q[2] * Q_DEQ, (float)q[3] * Q_DEQ}; } return v; }
    __device__ __forceinline__ void operator()(const f32x4 (&acc)[2][2][4][2], const Unit& u, int wr, int wc, int fr, int fq) const {
        const int row0 = u.pm * BM + wr * 64 + fr, col0 = (u.pn & 1) * 128 + wc * 32 + 8 * fq;
#pragma unroll
        for (int ai = 0; ai < 2; ++ai)
#pragma unroll
            for (int m = 0; m < 4; ++m) { bf16_t* rowp = ACT + (size_t)(row0 + ai * HALF + m * 16) * 256 + col0;
                const f32x4 g0 = dq(acc[ai][0][m][0]), g1 = dq(acc[ai][0][m][1]), u0 = dq(acc[ai][1][m][0]), u1 = dq(acc[ai][1][m][1]);
                u32x4 w; w.x = pk2(silu(g0[0]) * u0[0], silu(g0[1]) * u0[1]); w.y = pk2(silu(g0[2]) * u0[2], silu(g0[3]) * u0[3]);
                w.z = pk2(silu(g1[0]) * u1[0], silu(g1[1]) * u1[1]); w.w = pk2(silu(g1[2]) * u1[2], silu(g1[3]) * u1[3]);
                *(u32x4*)rowp = w; }
    }
};
struct EpiDown {
    static constexpr bool PERM = true;
    unsigned char* Y;
    __device__ __forceinline__ void operator()(const f32x4 (&acc)[2][2][4][2], const Unit& u, int wr, int wc, int fr, int fq) const {
        const int row0 = u.pm * BM + wr * 64 + fr, col0 = (u.pn & 3) * 256 + wc * 32 + 8 * fq;
#pragma unroll
        for (int ai = 0; ai < 2; ++ai)
#pragma unroll
            for (int m = 0; m < 4; ++m) { unsigned char* rowp = Y + (size_t)(row0 + ai * HALF + m * 16) * DM + col0;
#pragma unroll
                for (int bj = 0; bj < 2; ++bj) { f32x4 v0 = acc[ai][bj][m][0] * 16.f, v1 = acc[ai][bj][m][1] * 16.f;
#pragma unroll
                    for (int q = 0; q < 4; ++q) { v0[q] = fminf(fmaxf(v0[q], -224.f), 224.f); v1[q] = fminf(fmaxf(v1[q], -224.f), 224.f); }
                    int p0 = __builtin_amdgcn_cvt_pk_fp8_f32(v0[0], v0[1], 0, false); p0 = __builtin_amdgcn_cvt_pk_fp8_f32(v0[2], v0[3], p0, true);
                    int p1 = __builtin_amdgcn_cvt_pk_fp8_f32(v1[0], v1[1], 0, false); p1 = __builtin_amdgcn_cvt_pk_fp8_f32(v1[2], v1[3], p1, true);
                    u32x2 w; w.x = (unsigned)p0; w.y = (unsigned)p1;
                    *(u32x2*)(rowp + bj * HALF) = w; } }
    }
};
}

struct Args { const float* in[22]; float* out; unsigned char* ws; int ph_lo, ph_hi; };
enum { I_X = 0, I_WINAB, I_WGKUP, I_BGK, I_HG, I_GG, I_WOAB, I_LB, I_WINC, I_CONV, I_BIF, I_WOC, I_WR, I_RB, I_WEI, I_WED, I_WSI, I_WSD, I_LMG, I_LMB, I_LFG, I_LFB };

constexpr int LDS_MISC = 147200;
constexpr int LDS_BYTES = 147456;

__device__ __forceinline__ void cvt_tile(LAS unsigned char* lds, const float* __restrict__ src, size_t ldn, int k0, int n0, bf16_t* __restrict__ dst, int K, int drow0) {
    const int t = threadIdx.x;
    { const int c4 = (t & 15) * 4, r2 = t >> 4;
      const f32x4 a = *(const f32x4*)(src + (size_t)(k0 + 2 * r2) * ldn + n0 + c4);
      const f32x4 b = *(const f32x4*)(src + (size_t)(k0 + 2 * r2 + 1) * ldn + n0 + c4);
#pragma unroll
      for (int i = 0; i < 4; ++i) *(LAS unsigned*)(lds + ((c4 + i) * 72 + 2 * r2) * 2) = pk2(a[i], b[i]); }
    __syncthreads();
    { const int kk = (t & 7) * 8, n = t >> 3;
      const u32x4 v = *(const LAS u32x4*)(lds + (n * 72 + kk) * 2);
      *(u32x4*)(dst + (size_t)(drow0 + n) * K + k0 + kk) = v; }
    __syncthreads();
}
template <int NT>
__device__ __forceinline__ void cvt_multi(LAS unsigned char* lds, const float* __restrict__ src, size_t ldn, int k0, int n0, bf16_t* __restrict__ dst, int K, const int (&drow)[NT]) {
    const int t = threadIdx.x;
    { const int c4 = (t & 15) * 4, r2 = t >> 4;
      f32x4 a[NT], b[NT];
#pragma unroll
      for (int q = 0; q < NT; ++q) { a[q] = *(const f32x4*)(src + (size_t)(k0 + 2 * r2) * ldn + n0 + 64 * q + c4); b[q] = *(const f32x4*)(src + (size_t)(k0 + 2 * r2 + 1) * ldn + n0 + 64 * q + c4); }
#pragma unroll
      for (int q = 0; q < NT; ++q)
#pragma unroll
          for (int i = 0; i < 4; ++i) *(LAS unsigned*)(lds + q * 9216 + ((c4 + i) * 72 + 2 * r2) * 2) = pk2(a[q][i], b[q][i]); }
    __syncthreads();
    { const int kk = (t & 7) * 8, n = t >> 3;
#pragma unroll
      for (int q = 0; q < NT; ++q) { const u32x4 v = *(const LAS u32x4*)(lds + q * 9216 + (n * 72 + kk) * 2); *(u32x4*)(dst + (size_t)(drow[q] + n) * K + k0 + kk) = v; } }
    __syncthreads();
}
template <int NT>
__device__ __forceinline__ void cvt8_multi(LAS unsigned char* lds, const float* __restrict__ src, size_t ldn, int k0, int n0, unsigned char* __restrict__ dst, int Kb, const int (&drow)[NT], float sc) {
    const int t = threadIdx.x;
    { const int c4 = (t & 15) * 4, r4 = t >> 4;
      f32x4 a[NT][4];
#pragma unroll
      for (int q = 0; q < NT; ++q)
#pragma unroll
          for (int j = 0; j < 4; ++j) a[q][j] = *(const f32x4*)(src + (size_t)(k0 + 4 * r4 + j) * ldn + n0 + 64 * q + c4);
#pragma unroll
      for (int q = 0; q < NT; ++q)
#pragma unroll
          for (int i = 0; i < 4; ++i) *(LAS unsigned*)(lds + q * 9216 + (c4 + i) * 144 + 4 * r4) = pk4(q8(a[q][0][i], sc), q8(a[q][1][i], sc), q8(a[q][2][i], sc), q8(a[q][3][i], sc)); }
    __syncthreads();
    { const int kk = (t & 7) * 16, n = t >> 3;
#pragma unroll
      for (int q = 0; q < NT; ++q) { const u32x4 v = *(const LAS u32x4*)(lds + q * 9216 + n * 144 + kk); *(u32x4*)(dst + (size_t)(drow[q] + n) * Kb + k0 + kk) = v; } }
    __syncthreads();
}
template <int NT>
__device__ __forceinline__ void cvt8_matrix(LAS unsigned char* lds, const float* src, size_t ldn, int K, int n_lo, int ncols, unsigned char* dst, int drow_lo, float sc, int bid, int nb) {
    const int tk = K / 128, tn = ncols / (64 * NT);
    for (int j = bid; j < tk * tn; j += nb) { const int a = j / tn, b = j % tn; int dr[NT];
#pragma unroll
        for (int q = 0; q < NT; ++q) dr[q] = drow_lo + (b * NT + q) * 64;
        cvt8_multi<NT>(lds, src, ldn, a * 128, n_lo + b * 64 * NT, dst, K, dr, sc); }
}
template <int NT>
__device__ __forceinline__ void cvt_matrix(LAS unsigned char* lds, const float* src, size_t ldn, int K, int n_lo, int ncols, bf16_t* dst, int drow_lo, int bid, int nb) {
    const int tk = K / 64, tn = ncols / (64 * NT);
    for (int j = bid; j < tk * tn; j += nb) { const int a = j / tn, b = j % tn; int dr[NT];
#pragma unroll
        for (int q = 0; q < NT; ++q) dr[q] = drow_lo + (b * NT + q) * 64;
        cvt_multi<NT>(lds, src, ldn, a * 64, n_lo + b * 64 * NT, dst, K, dr); }
}
__device__ __forceinline__ void phase_prologue(LAS unsigned char* lds, const Args& A, int bid, int nb) {
    unsigned char* ws = A.ws; const int tid = threadIdx.x;
    if (bid == 0) {
        float* lb0 = (float*)(ws + WS_MISC);
        const float* l = A.in[I_LB];
        if (tid < 512) { const float a = l[tid], b = l[512 + tid], c = l[1024 + tid]; const float m = fmaxf(a, fmaxf(b, c));
            const float ea = __expf(a - m), eb = __expf(b - m), ec = __expf(c - m); lb0[tid] = ea / (ea + eb + ec); }
    }
    if (bid == 1 % nb) {
        float* wg = (float*)(ws + WS_MISC + 4096);
        for (int i = tid; i < 8 * 1024; i += 512) { const int g = i >> 10, k = i & 1023; wg[i] = A.in[I_WINC][(size_t)k * 3080 + 3072 + g]; }
    }
    { const float* x = A.in[I_X]; bf16_t* hb = (bf16_t*)(ws + WS_HB); unsigned char* xq = ws + WS_XQ;
      for (size_t i = ((size_t)bid * 512 + tid) * 8; i < (size_t)NTOK * DM; i += (size_t)nb * 512 * 8) {
          const f32x4 a = *(const f32x4*)(x + i), b = *(const f32x4*)(x + i + 4);
          u32x4 w; w.x = pk2(a[0], a[1]); w.y = pk2(a[2], a[3]); w.z = pk2(b[0], b[1]); w.w = pk2(b[2], b[3]);
          *(u32x4*)(hb + i) = w;
          u32x2 qv; qv.x = pk4(q8(a[0], Q_SA), q8(a[1], Q_SA), q8(a[2], Q_SA), q8(a[3], Q_SA)); qv.y = pk4(q8(b[0], Q_SA), q8(b[1], Q_SA), q8(b[2], Q_SA), q8(b[3], Q_SA));
          *(u32x2*)(xq + i) = qv; } }
    { unsigned char* wab = ws + WS_WAB; const float* win = A.in[I_WINAB]; const float* wup = A.in[I_WGKUP];
      for (int o = bid * 512 + tid; o < 256 * 64; o += nb * 512) { const int j = o >> 6, k16 = (o & 63) * 16;
          float up[16];
#pragma unroll
          for (int r = 0; r < 16; ++r) up[r] = wup[r * 256 + j];
          int res[16];
#pragma unroll
          for (int q = 0; q < 16; ++q) { const float* wr_ = win + (size_t)(k16 + q) * 3600 + 3584; float sm = 0.f;
#pragma unroll
              for (int r = 0; r < 16; ++r) sm += wr_[r] * up[r];
              res[q] = q8(sm, Q_SW); }
          u32x4 w; w.x = pk4(res[0], res[1], res[2], res[3]); w.y = pk4(res[4], res[5], res[6], res[7]); w.z = pk4(res[8], res[9], res[10], res[11]); w.w = pk4(res[12], res[13], res[14], res[15]);
          *(u32x4*)(wab + (size_t)(3584 + j) * 1024 + k16) = w; } }
    cvt8_matrix<4>(lds, A.in[I_WINAB], 3600, 1024, 0, 3584, ws + WS_WAB, 0, Q_SW, bid, nb);
    cvt_matrix<8>(lds, A.in[I_WOAB], 1024, 1024, 0, 1024, (bf16_t*)(ws + WS_WOAB), 0, bid, nb);
    cvt8_matrix<4>(lds, A.in[I_WINC], 3080, 1024, 0, 3072, ws + WS_WC, 0, Q_SW, bid, nb);
    cvt_matrix<8>(lds, A.in[I_WOC], 1024, 1024, 0, 1024, (bf16_t*)(ws + WS_WOC), 0, bid, nb);
    cvt_matrix<4>(lds, A.in[I_WR], 256, 1024, 0, 256, (bf16_t*)(ws + WS_WR), 0, bid, nb);
    cvt_matrix<4>(lds, A.in[I_WR] + 1024 * 256, 256, 1024, 0, 256, (bf16_t*)(ws + WS_WR) + 256 * 1024, 0, bid, nb);
    for (int j = bid; j < 2 * NE1 * 24; j += nb) {
        const int le = j / 24, t = j % 24, layer = le / NE1, e = le % NE1;
        if (t < 16) {
            const float* src = (e < NEXP) ? A.in[I_WEI] + ((size_t)(layer * NEXP + e)) * 1024 * 512 : A.in[I_WSI] + (size_t)layer * 1024 * 512;
            unsigned char* dst = ws + WS_W1T + ((size_t)(layer * NE1 + e)) * 512 * 1024;
            const int tk = t >> 1, gq = t & 1;
            int dr[4];
#pragma unroll
            for (int q = 0; q < 4; ++q) { const int nn = q * 64; dr[q] = (nn >> 7) * 256 + gq * 128 + (nn & 127); }
            cvt8_multi<4>(lds, src, 512, tk * 128, gq * 256, dst, 1024, dr, Q_SW);
        } else {
            const int t2 = t - 16, tk = t2 >> 1, hn = t2 & 1;
            const float* src = (e < NEXP) ? A.in[I_WED] + ((size_t)(layer * NEXP + e)) * 256 * 1024 : A.in[I_WSD] + (size_t)layer * 256 * 1024;
            bf16_t* dst = (bf16_t*)(ws + WS_W2T) + ((size_t)(layer * NE1 + e)) * 1024 * 256;
            int dr[8];
#pragma unroll
            for (int q = 0; q < 8; ++q) dr[q] = hn * 512 + q * 64;
            cvt_multi<8>(lds, src, 1024, tk * 64, hn * 512, dst, 256, dr);
        }
    }
}

__device__ __forceinline__ void phase_ln(const bf16_t* __restrict__ Z, bf16_t* __restrict__ H, unsigned char* __restrict__ HQ, const float* __restrict__ g, const float* __restrict__ b, int bid, int nb) {
    const int lane = threadIdx.x & 63, gw = bid * 8 + (threadIdx.x >> 6), nw = nb * 8;
    float gg[16], bb[16];
#pragma unroll
    for (int i = 0; i < 8; ++i) { gg[i] = g[lane * 8 + i]; gg[8 + i] = g[512 + lane * 8 + i]; bb[i] = b[lane * 8 + i]; bb[8 + i] = b[512 + lane * 8 + i]; }
    for (int row = gw; row < NTOK; row += nw) {
        const u32x4 a = *(const u32x4*)(Z + (size_t)row * DM + lane * 8), c = *(const u32x4*)(Z + (size_t)row * DM + 512 + lane * 8);
        float v[16];
        v[0] = bflo(a.x); v[1] = bfhi(a.x); v[2] = bflo(a.y); v[3] = bfhi(a.y); v[4] = bflo(a.z); v[5] = bfhi(a.z); v[6] = bflo(a.w); v[7] = bfhi(a.w);
        v[8] = bflo(c.x); v[9] = bfhi(c.x); v[10] = bflo(c.y); v[11] = bfhi(c.y); v[12] = bflo(c.z); v[13] = bfhi(c.z); v[14] = bflo(c.w); v[15] = bfhi(c.w);
        float s = 0.f;
#pragma unroll
        for (int i = 0; i < 16; ++i) s += v[i];
#pragma unroll
        for (int o = 32; o > 0; o >>= 1) s += __shfl_xor(s, o);
        const float mu = s * (1.f / 1024.f);
        float q = 0.f;
#pragma unroll
        for (int i = 0; i < 16; ++i) { const float d = v[i] - mu; q += d * d; }
#pragma unroll
        for (int o = 32; o > 0; o >>= 1) q += __shfl_xor(q, o);
        const float rs = rsqrtf(q * (1.f / 1024.f) + 1e-5f);
        float y[16];
#pragma unroll
        for (int i = 0; i < 16; ++i) y[i] = (v[i] - mu) * rs * gg[i] + bb[i];
        u32x4 w0, w1; w0.x = pk2(y[0], y[1]); w0.y = pk2(y[2], y[3]); w0.z = pk2(y[4], y[5]); w0.w = pk2(y[6], y[7]);
        w1.x = pk2(y[8], y[9]); w1.y = pk2(y[10], y[11]); w1.z = pk2(y[12], y[13]); w1.w = pk2(y[14], y[15]);
        *(u32x4*)(H + (size_t)row * DM + lane * 8) = w0; *(u32x4*)(H + (size_t)row * DM + 512 + lane * 8) = w1;
        u32x2 q0, q1;
        q0.x = pk4(q8(y[0], Q_SA), q8(y[1], Q_SA), q8(y[2], Q_SA), q8(y[3], Q_SA)); q0.y = pk4(q8(y[4], Q_SA), q8(y[5], Q_SA), q8(y[6], Q_SA), q8(y[7], Q_SA));
        q1.x = pk4(q8(y[8], Q_SA), q8(y[9], Q_SA), q8(y[10], Q_SA), q8(y[11], Q_SA)); q1.y = pk4(q8(y[12], Q_SA), q8(y[13], Q_SA), q8(y[14], Q_SA), q8(y[15], Q_SA));
        *(u32x2*)(HQ + (size_t)row * DM + lane * 8) = q0; *(u32x2*)(HQ + (size_t)row * DM + 512 + lane * 8) = q1;
    }
}

template <bool FINAL>
__device__ __forceinline__ void phase_combine(const unsigned char* __restrict__ Y, const int* __restrict__ posy, const float* __restrict__ tokw, const int* __restrict__ ntiles,
                                              const bf16_t* __restrict__ H1, bf16_t* __restrict__ H2, unsigned char* __restrict__ H2Q, float* __restrict__ OUT, float* __restrict__ GATES,
                                              const float* __restrict__ wgate, const float* __restrict__ g, const float* __restrict__ b, int bid, int nb) {
    const int shbase = (*ntiles - NTOK / 256) * 256;
    const int lane = threadIdx.x & 63, gw = bid * 8 + (threadIdx.x >> 6), nw = nb * 8;
    int npos = 0; float nwk = 0.f;
    if (gw < NTOK) { npos = (lane < 8) ? posy[(size_t)gw * 8 + lane] : shbase + gw; nwk = (lane < 8) ? tokw[(size_t)gw * 8 + lane] : 1.0f; }
    for (int row = gw; row < NTOK; row += nw) {
        const int cpos = npos; const float cwk = nwk;
        { const int nr = row + nw; if (nr < NTOK) { npos = (lane < 8) ? posy[(size_t)nr * 8 + lane] : shbase + nr; nwk = (lane < 8) ? tokw[(size_t)nr * 8 + lane] : 1.0f; } }
        float v[16];
        { const u32x4 a = *(const u32x4*)(H1 + (size_t)row * DM + lane * 8), c = *(const u32x4*)(H1 + (size_t)row * DM + 512 + lane * 8);
          v[0] = bflo(a.x); v[1] = bfhi(a.x); v[2] = bflo(a.y); v[3] = bfhi(a.y); v[4] = bflo(a.z); v[5] = bfhi(a.z); v[6] = bflo(a.w); v[7] = bfhi(a.w);
          v[8] = bflo(c.x); v[9] = bfhi(c.x); v[10] = bflo(c.y); v[11] = bfhi(c.y); v[12] = bflo(c.z); v[13] = bfhi(c.z); v[14] = bflo(c.w); v[15] = bfhi(c.w); }
#pragma unroll
        for (int i = 0; i < 16; ++i) v[i] *= ALPHA;
        u32x2 ya[NSLOT], yc[NSLOT]; float wks[NSLOT];
#pragma unroll
        for (int k = 0; k < NSLOT; ++k) {
            const int pos = __builtin_amdgcn_readlane(cpos, k); wks[k] = __uint_as_float(__builtin_amdgcn_readlane(__float_as_uint(cwk), k)) * 0.0625f;
            const unsigned char* yr = Y + (size_t)pos * DM;
            ya[k] = *(const u32x2*)(yr + lane * 8); yc[k] = *(const u32x2*)(yr + 512 + lane * 8);
        }
        typedef float f32x2_ __attribute__((ext_vector_type(2)));
#pragma unroll
        for (int k = 0; k < NSLOT; ++k) {
            const float wk = wks[k];
            const f32x2_ a0 = __builtin_amdgcn_cvt_pk_f32_fp8((int)ya[k].x, false), a1 = __builtin_amdgcn_cvt_pk_f32_fp8((int)ya[k].x, true), a2 = __builtin_amdgcn_cvt_pk_f32_fp8((int)ya[k].y, false), a3 = __builtin_amdgcn_cvt_pk_f32_fp8((int)ya[k].y, true);
            const f32x2_ c0 = __builtin_amdgcn_cvt_pk_f32_fp8((int)yc[k].x, false), c1 = __builtin_amdgcn_cvt_pk_f32_fp8((int)yc[k].x, true), c2 = __builtin_amdgcn_cvt_pk_f32_fp8((int)yc[k].y, false), c3 = __builtin_amdgcn_cvt_pk_f32_fp8((int)yc[k].y, true);
            v[0] += wk * a0.x; v[1] += wk * a0.y; v[2] += wk * a1.x; v[3] += wk * a1.y; v[4] += wk * a2.x; v[5] += wk * a2.y; v[6] += wk * a3.x; v[7] += wk * a3.y;
            v[8] += wk * c0.x; v[9] += wk * c0.y; v[10] += wk * c1.x; v[11] += wk * c1.y; v[12] += wk * c2.x; v[13] += wk * c2.y; v[14] += wk * c3.x; v[15] += wk * c3.y;
        }
        float s = 0.f;
#pragma unroll
        for (int i = 0; i < 16; ++i) s += v[i];
#pragma unroll
        for (int o = 32; o > 0; o >>= 1) s += __shfl_xor(s, o);
        const float mu = s * (1.f / 1024.f);
        float q = 0.f;
#pragma unroll
        for (int i = 0; i < 16; ++i) { const float d = v[i] - mu; q += d * d; }
#pragma unroll
        for (int o = 32; o > 0; o >>= 1) q += __shfl_xor(q, o);
        const float rs = rsqrtf(q * (1.f / 1024.f) + 1e-5f);
        float y[16];
#pragma unroll
        for (int i = 0; i < 8; ++i) { y[i] = (v[i] - mu) * rs * g[lane * 8 + i] + b[lane * 8 + i]; y[8 + i] = (v[8 + i] - mu) * rs * g[512 + lane * 8 + i] + b[512 + lane * 8 + i]; }
        if (FINAL) {
            float* o = OUT + (size_t)row * DM;
            *(f32x4*)(o + lane * 8) = (f32x4){y[0], y[1], y[2], y[3]}; *(f32x4*)(o + lane * 8 + 4) = (f32x4){y[4], y[5], y[6], y[7]};
            *(f32x4*)(o + 512 + lane * 8) = (f32x4){y[8], y[9], y[10], y[11]}; *(f32x4*)(o + 512 + lane * 8 + 4) = (f32x4){y[12], y[13], y[14], y[15]};
        } else {
            u32x4 w0, w1; w0.x = pk2(y[0], y[1]); w0.y = pk2(y[2], y[3]); w0.z = pk2(y[4], y[5]); w0.w = pk2(y[6], y[7]);
            w1.x = pk2(y[8], y[9]); w1.y = pk2(y[10], y[11]); w1.z = pk2(y[12], y[13]); w1.w = pk2(y[14], y[15]);
            *(u32x4*)(H2 + (size_t)row * DM + lane * 8) = w0; *(u32x4*)(H2 + (size_t)row * DM + 512 + lane * 8) = w1;
            { u32x2 q0, q1;
              q0.x = pk4(q8(y[0], Q_SA), q8(y[1], Q_SA), q8(y[2], Q_SA), q8(y[3], Q_SA)); q0.y = pk4(q8(y[4], Q_SA), q8(y[5], Q_SA), q8(y[6], Q_SA), q8(y[7], Q_SA));
              q1.x = pk4(q8(y[8], Q_SA), q8(y[9], Q_SA), q8(y[10], Q_SA), q8(y[11], Q_SA)); q1.y = pk4(q8(y[12], Q_SA), q8(y[13], Q_SA), q8(y[14], Q_SA), q8(y[15], Q_SA));
              *(u32x2*)(H2Q + (size_t)row * DM + lane * 8) = q0; *(u32x2*)(H2Q + (size_t)row * DM + 512 + lane * 8) = q1; }
            float yr[16];
            yr[0] = bflo(w0.x); yr[1] = bfhi(w0.x); yr[2] = bflo(w0.y); yr[3] = bfhi(w0.y); yr[4] = bflo(w0.z); yr[5] = bfhi(w0.z); yr[6] = bflo(w0.w); yr[7] = bfhi(w0.w);
            yr[8] = bflo(w1.x); yr[9] = bfhi(w1.x); yr[10] = bflo(w1.y); yr[11] = bfhi(w1.y); yr[12] = bflo(w1.z); yr[13] = bfhi(w1.z); yr[14] = bflo(w1.w); yr[15] = bfhi(w1.w);
            float gsum = 0.f;
#pragma unroll
            for (int gi = 0; gi < 8; ++gi) {
                const float* wp = wgate + gi * 1024; float d = 0.f;
#pragma unroll
                for (int i = 0; i < 8; ++i) d += yr[i] * wp[lane * 8 + i] + yr[8 + i] * wp[512 + lane * 8 + i];
#pragma unroll
                for (int o = 32; o > 0; o >>= 1) d += __shfl_xor(d, o);
                gsum = (lane == gi) ? d : gsum;
            }
            if (lane < 8) GATES[(size_t)row * 8 + lane] = gsum;
        }
    }
}

template <bool DRY>
__device__ __forceinline__ void phase_select(LAS unsigned char* lds, const float* __restrict__ logits, const float* __restrict__ rbias, int* __restrict__ tok_e, int* __restrict__ tok_p,
                                             float* __restrict__ tok_w, unsigned* __restrict__ cnt, int bid, int nb) {
    const int tid = threadIdx.x, it = tid & 63, g8 = tid >> 6;
    LAS unsigned* hist = (LAS unsigned*)lds;
    LAS unsigned* base = hist + 256;
    LAS int* selE = (LAS int*)(base + 256);
    LAS int* selR = selE + 1024;
    LAS float* gsl = (LAS float*)(lds + 10240);
    LAS float* lv = (LAS float*)(lds + 12288);
    LAS int* le = (LAS int*)(lds + 28672);
    LAS float* sb = (LAS float*)(lds + 45056);
    const int tpw = NTOK / nb;
    const int t0 = bid * tpw;
    const float NEG = -3.0e38f;
    if (tid < 256) hist[tid] = 0u;
    __syncthreads();
    for (int half = 0; half < tpw / 64; ++half) {
        const int tb = t0 + half * 64;
        for (int i = tid; i < 64 * 256; i += 512) { const int tk = i >> 8, e = i & 255; sb[e * 65 + tk] = sigm(logits[(size_t)(tb + tk) * 256 + e]) + rbias[e]; }
        __syncthreads();
        {
            float m1 = NEG, m2 = NEG;
            for (int j = 0; j < 32; ++j) { const float v = sb[(g8 * 32 + j) * 65 + it]; if (v > m1) { m2 = m1; m1 = v; } else if (v > m2) m2 = v; }
            gsl[g8 * 64 + it] = m1 + m2;
        }
        __syncthreads();
        float G[8];
#pragma unroll
        for (int q = 0; q < 8; ++q) G[q] = gsl[q * 64 + it];
        unsigned selmask = 0u;
#pragma unroll
        for (int g = 0; g < 8; ++g) { int rank = 0;
#pragma unroll
            for (int q = 0; q < 8; ++q) rank += (G[q] > G[g] || (G[q] == G[g] && q < g)) ? 1 : 0;
            if (rank < 4) selmask |= 1u << g; }
        if ((selmask >> g8) & 1u) {
            float tv[8]; int te[8];
#pragma unroll
            for (int k = 0; k < 8; ++k) { tv[k] = NEG; te[k] = 0; }
            for (int j = 0; j < 32; ++j) {
                float v = sb[(g8 * 32 + j) * 65 + it]; int ve = g8 * 32 + j;
                if (v > tv[7]) {
#pragma unroll
                    for (int k = 0; k < 8; ++k) { if (v > tv[k]) { const float tf = tv[k]; const int ti = te[k]; tv[k] = v; te[k] = ve; v = tf; ve = ti; } }
                }
            }
#pragma unroll
            for (int k = 0; k < 8; ++k) { lv[(g8 * 8 + k) * 64 + it] = tv[k]; le[(g8 * 8 + k) * 64 + it] = te[k]; }
        }
        __syncthreads();
        if (tid < 64) {
            int gid[4]; { int n = 0;
#pragma unroll
                for (int g = 0; g < 8; ++g) if ((selmask >> g) & 1u) { if (n == 0) gid[0] = g; else if (n == 1) gid[1] = g; else if (n == 2) gid[2] = g; else gid[3] = g; ++n; } }
            float hv[4]; int hp[4];
#pragma unroll
            for (int j = 0; j < 4; ++j) { hp[j] = 0; hv[j] = lv[(gid[j] * 8) * 64 + it]; }
            float sc8[8]; int te[8]; float tot = 0.f;
#pragma unroll
            for (int k = 0; k < 8; ++k) {
                int bj = 0; float bv = hv[0];
                if (hv[1] > bv) { bv = hv[1]; bj = 1; }
                if (hv[2] > bv) { bv = hv[2]; bj = 2; }
                if (hv[3] > bv) { bv = hv[3]; bj = 3; }
                const int gsel = (bj == 0) ? gid[0] : (bj == 1) ? gid[1] : (bj == 2) ? gid[2] : gid[3];
                const int psel = (bj == 0) ? hp[0] : (bj == 1) ? hp[1] : (bj == 2) ? hp[2] : hp[3];
                const int e = le[(gsel * 8 + psel) * 64 + it];
                te[k] = e; sc8[k] = bv - rbias[e]; tot += sc8[k];
                const float nv = (psel < 7) ? lv[(gsel * 8 + psel + 1) * 64 + it] : NEG;
                if (bj == 0) { hv[0] = nv; hp[0] = psel + 1; } else if (bj == 1) { hv[1] = nv; hp[1] = psel + 1; } else if (bj == 2) { hv[2] = nv; hp[2] = psel + 1; } else { hv[3] = nv; hp[3] = psel + 1; }
            }
            const float inv = 2.5f / tot;
            const int tok = tb + it, lt = half * 64 + it;
#pragma unroll
            for (int k = 0; k < 8; ++k) {
                tok_e[(size_t)tok * 8 + k] = te[k]; tok_w[(size_t)tok * 8 + k] = sc8[k] * inv;
                const unsigned r = atomicAdd((unsigned*)&hist[te[k]], 1u);
                selE[lt * 8 + k] = te[k]; selR[lt * 8 + k] = (int)r;
            }
        }
        __syncthreads();
    }
    if (DRY) return;
    if (tid < 256) { const unsigned c = hist[tid]; base[tid] = c ? __hip_atomic_fetch_add(cnt + tid, c, __ATOMIC_RELAXED, __HIP_MEMORY_SCOPE_AGENT) : 0u; }
    __syncthreads();
    for (int i = tid; i < tpw * 8; i += 512) tok_p[(size_t)t0 * 8 + i] = (int)base[selE[i]] + selR[i];
    __syncthreads();
}

__device__ __forceinline__ void phase_dispatch(LAS unsigned char* lds, const unsigned* __restrict__ cnt, const int* __restrict__ tok_e, const int* __restrict__ tok_p,
                                               int* __restrict__ s_tok, int* __restrict__ posy, int* __restrict__ tile_exp, int* __restrict__ ntiles, int bid, int nb) {
    const int tid = threadIdx.x;
    LAS int* tstart = (LAS int*)lds;
    LAS int* tcnt = tstart + 260;
    if (tid < 256) tcnt[tid] = (int)((__hip_atomic_load(cnt + tid, __ATOMIC_RELAXED, __HIP_MEMORY_SCOPE_AGENT) + 255u) >> 8);
    __syncthreads();
    if (tid == 0) { int a = 0; for (int e = 0; e < 256; ++e) { tstart[e] = a; a += tcnt[e]; } tstart[256] = a; }
    __syncthreads();
    const int TT = tstart[256];
    const int tpw = NTOK / nb, t0 = bid * tpw;
    for (int i = tid; i < tpw * 8; i += 512) {
        const size_t a = (size_t)t0 * 8 + i; const int e = tok_e[a], p = tok_p[a];
        const int pos = tstart[e] * 256 + p;
        s_tok[pos] = (int)(a >> 3); posy[a] = pos;
    }
    for (int i = tid; i < tpw; i += 512) { const int tok = t0 + i; s_tok[TT * 256 + tok] = tok; }
    for (int e = bid; e < 256; e += nb) {
        const int c = (int)__hip_atomic_load(cnt + e, __ATOMIC_RELAXED, __HIP_MEMORY_SCOPE_AGENT), ts = tstart[e], tc = tcnt[e];
        for (int i = c + tid; i < tc * 256; i += 512) s_tok[ts * 256 + i] = 0;
        for (int i = tid; i < tc; i += 512) tile_exp[ts + i] = e;
    }
    if (bid == 0) { for (int i = tid; i < NTOK / 256; i += 512) tile_exp[TT + i] = 256; if (tid == 0) *ntiles = TT + NTOK / 256; }
    __syncthreads();
}

constexpr int MX_QT = 0, MX_KT = 17408, MX_KHT = 34816, MX_VT = 53248, MX_P = 73984, MX_ST = 83200, MX_SEG = 122368, MX_GD = 126464, MX_ER = 126976, MX_RS = 127488, MX_DEN = 128000, MX_BC = 128256, MX_IP = 128512, MX_GT = 128768;
struct MixP {
    const bf16_t* proj; int ldp; int pad0; bf16_t* ymix; const float* gates;
    const float* lb0; const float* bgk; const float* hg; const float* gg; const float* conv; const float* bif;
    float* ust; float* gsum;
};
#define MFMA16(a, b, c) __builtin_amdgcn_mfma_f32_16x16x32_bf16((a), (b), (c), 0, 0, 0)

template <int MODE, bool FULL, int VAR = 0>
__device__ __forceinline__ void mixer_run(LAS unsigned char* lds, const MixP& mp, int bid) {
    constexpr int DK = (MODE == 1) ? 64 : 128, QP = DK + 8, CP = DK / 2, RG = 512 / CP, RPT = 64 / RG, KS = DK / 32;
    constexpr int NVT = (MODE == 2) ? 9 : 8;
    constexpr int NST = (DK == 128) ? NVT : 4;
    const int tid = threadIdx.x, lane = tid & 63, w = __builtin_amdgcn_readfirstlane(tid >> 6), l15 = lane & 15, l4 = lane >> 4;
    int b, h, vh = 0, seg;
    if (MODE == 0) { const int sq = bid >> 4; b = sq >> 2; h = sq & 3; seg = bid & 15; }
    else if (MODE == 1) { const int sq = (bid - 128) >> 4; b = sq >> 2; h = sq & 3; seg = bid & 15; }
    else { const int sq = bid >> 4; b = sq >> 3; h = (sq >> 1) & 3; vh = sq & 1; seg = bid & 15; }
    const int tok0 = b * SEQ + seg * 1024;
    const int ldp = mp.ldp; const bf16_t* proj = mp.proj;
    int cq, ck, cv, cg, cy;
    if (MODE == 0) { cq = h * 128; ck = 512 + h * 128; cv = 1024 + h * 128; cg = 1536 + h * 128; cy = h * 128; }
    else if (MODE == 1) { cq = 2048 + h * 64; ck = 2304 + h * 64; cv = 2560 + h * 128; cg = 3072 + h * 128; cy = 512 + h * 128; }
    else { cq = h * 128; ck = 512 + h * 128; cv = 1024 + h * 256 + vh * 128; cg = 2048 + h * 256 + vh * 128; cy = h * 256 + vh * 128; }
    const int cu = 3584 + h * 64;
    const int cp = tid % CP, rg = tid / CP, d0 = 2 * cp;
    float lbv[2] = {0.f, 0.f}, oml[2] = {0.f, 0.f}, bgk[2] = {0.f, 0.f}, cwq[4][2], cwk[4][2];
    if (MODE == 0) { lbv[0] = mp.lb0[h * 128 + d0]; lbv[1] = mp.lb0[h * 128 + d0 + 1]; oml[0] = 1.f - lbv[0]; oml[1] = 1.f - lbv[1]; }
    if (MODE == 1) { bgk[0] = mp.bgk[h * 64 + d0]; bgk[1] = mp.bgk[h * 64 + d0 + 1]; }
#pragma unroll
    for (int j = 0; j < 4; ++j) { cwq[j][0] = cwq[j][1] = cwk[j][0] = cwk[j][1] = 0.f; }
    if (MODE == 2) {
#pragma unroll
        for (int j = 0; j < 4; ++j) { cwq[j][0] = mp.conv[j * 1024 + cq + d0]; cwq[j][1] = mp.conv[j * 1024 + cq + d0 + 1]; cwk[j][0] = mp.conv[j * 1024 + ck + d0]; cwk[j][1] = mp.conv[j * 1024 + ck + d0 + 1]; }
    }
    const float bi = (MODE == 2) ? mp.bif[h] : 0.f, bfg = (MODE == 2) ? mp.bif[4 + h] : 0.f;
    const int sdt = (DK == 128) ? w : (w & 3), svt0 = (DK == 128) ? 0 : 4 * (w >> 2);
    f32x4 S[NST];
#pragma unroll
    for (int t = 0; t < NST; ++t) S[t] = (f32x4){0.f, 0.f, 0.f, 0.f};
    float gacc[2] = {(MODE == 2) ? 0.f : 1.f, (MODE == 2) ? 0.f : 1.f};
    if (MODE == 2) {
        for (int i = tid; i < 16 * 72; i += 512) { const int r = i / 72; *(LAS bf16_t*)(lds + MX_VT + ((128 + r) * 72 + (i % 72)) * 2) = (r == 0) ? (bf16_t)0x3F80 : (bf16_t)0; }
    }
    if (FULL) {
        const int bid0 = bid & ~15;
        for (int j = 0; j < seg; ++j) {
            const float* U = mp.ust + ((size_t)(bid0 + j) * 8 + w) * (9 * 4 * 64);
            float dec[4];
            if (MODE == 2) { const float gsv = mp.gsum[(size_t)(bid0 + j) * 128]; dec[0] = dec[1] = dec[2] = dec[3] = __expf(gsv); }
            else {
#pragma unroll
                for (int r = 0; r < 4; ++r) dec[r] = mp.gsum[(size_t)(bid0 + j) * 128 + sdt * 16 + 4 * l4 + r];
            }
#pragma unroll
            for (int t = 0; t < NST; ++t)
#pragma unroll
                for (int r = 0; r < 4; ++r) S[t][r] = dec[r] * S[t][r] + U[(t * 4 + r) * 64 + lane];
        }
    }
    const int sj = w & 3, ovh = w >> 2, srow = 16 * sj + l15;
    const int vp = tid & 63, r0v = (tid >> 6) * 8;
    unsigned ra[RPT + 3], rb[RPT + 3], rc[RPT], pv[8]; u32x2 gnx[4]; float sgi = 0.f, sgf = 0.f;
#pragma unroll
    for (int i = 0; i < RPT + 3; ++i) { ra[i] = 0u; rb[i] = 0u; }
#pragma unroll
    for (int i = 0; i < RPT; ++i) rc[i] = 0u;
#pragma unroll
    for (int t = 0; t < 4; ++t) gnx[t] = (u32x2){0u, 0u};
#define MX_LOAD(cn) do { const int tokn_ = tok0 + (cn) * 64; \
        if (VAR == 1) { _Pragma("unroll") for (int i = 0; i < RPT + 3; ++i) { ra[i] = 0x3c003c00u + (unsigned)(cn); rb[i] = 0x3c003c00u; } _Pragma("unroll") for (int i = 0; i < RPT; ++i) rc[i] = 0x3c003c00u; _Pragma("unroll") for (int i = 0; i < 8; ++i) pv[i] = 0x3c003c00u; _Pragma("unroll") for (int t = 0; t < 4; ++t) gnx[t] = (u32x2){0x3c003c00u, 0x3c003c00u}; sgi = 0.1f; sgf = 3.f; } else \
        if (MODE == 2) { const int tl0_ = seg * 1024 + (cn) * 64 + rg * RPT; \
            _Pragma("unroll") for (int i = 0; i < RPT + 3; ++i) { const int tl_ = tl0_ - 3 + i; \
                if (tl_ >= 0) { const bf16_t* pr_ = proj + (size_t)(b * SEQ + tl_) * ldp; if (FULL) ra[i] = *(const unsigned*)(pr_ + cq + d0); rb[i] = *(const unsigned*)(pr_ + ck + d0); } \
                else { ra[i] = 0u; rb[i] = 0u; } } \
            if (w == 0) { const float* gp_ = mp.gates + (size_t)(tokn_ + lane) * 8; sgi = gp_[h]; sgf = gp_[4 + h]; } \
        } else { \
            _Pragma("unroll") for (int i = 0; i < RPT; ++i) { const bf16_t* pr_ = proj + (size_t)(tokn_ + rg * RPT + i) * ldp; \
                if (MODE == 0) { ra[i] = *(const unsigned*)(pr_ + ck + d0); if (FULL) rb[i] = *(const unsigned*)(pr_ + cq + d0); } \
                else { ra[i] = *(const unsigned*)(pr_ + cu + d0); rb[i] = *(const unsigned*)(pr_ + ck + d0); if (FULL) rc[i] = *(const unsigned*)(pr_ + cq + d0); } } \
        } \
        _Pragma("unroll") for (int i = 0; i < 8; ++i) pv[i] = *(const unsigned*)(proj + (size_t)(tokn_ + r0v + i) * ldp + cv + 2 * vp); \
        if (FULL) { _Pragma("unroll") for (int t = 0; t < 4; ++t) gnx[t] = *(const u32x2*)(proj + (size_t)(tokn_ + srow) * ldp + cg + 16 * (4 * ovh + t) + 4 * l4); } \
    } while (0)
    MX_LOAD(0);
    __syncthreads();
    for (int c = 0; c < 16; ++c) {
        const int tokc = tok0 + c * 64;
        float la[RPT][2], sp[RPT][2], qv[RPT][2], kv[RPT][2];
        u32x2 gcur[4];
#pragma unroll
        for (int t = 0; t < 4; ++t) gcur[t] = gnx[t];
        if (MODE == 2) {
            if (w == 0) {
                const float ip = sgi + bi, lf = logsig(sgf + bfg);
                float cs = lf;
#pragma unroll
                for (int o = 1; o < 64; o <<= 1) { const float t = __shfl_up(cs, o); if (lane >= o) cs += t; }
                *(LAS float*)(lds + MX_BC + lane * 4) = cs; *(LAS float*)(lds + MX_IP + lane * 4) = ip - cs;
                if (lane == 63) *(LAS float*)(lds + MX_GT) = cs;
            }
#pragma unroll
            for (int i = 0; i < RPT; ++i)
#pragma unroll
                for (int e = 0; e < 2; ++e) {
                    float aq = 0.f, ak = 0.f;
#pragma unroll
                    for (int j = 0; j < 4; ++j) { aq += cwq[j][e] * (e ? bfhi(ra[i + j]) : bflo(ra[i + j])); ak += cwk[j][e] * (e ? bfhi(rb[i + j]) : bflo(rb[i + j])); }
                    qv[i][e] = silu(aq); kv[i][e] = silu(ak) * 0.08838834764831845f; la[i][e] = 0.f; sp[i][e] = 0.f;
                }
        } else {
#pragma unroll
            for (int i = 0; i < RPT; ++i) {
                if (MODE == 0) {
                    const unsigned uz = ra[i];
                    const float s0 = sigm(bflo(uz)), s1 = sigm(bfhi(uz));
                    la[i][0] = lbv[0] + oml[0] * s0; la[i][1] = lbv[1] + oml[1] * s1;
                    kv[i][0] = oml[0] - oml[0] * s0; kv[i][1] = oml[1] - oml[1] * s1;
                    if (FULL) { const unsigned uq = rb[i]; qv[i][0] = silu(bflo(uq)); qv[i][1] = silu(bfhi(uq)); } else { qv[i][0] = qv[i][1] = 0.f; }
                } else {
                    const unsigned uu = ra[i], uk = rb[i];
                    la[i][0] = __expf(logsig(bflo(uu) + bgk[0]) * 0.0625f); la[i][1] = __expf(logsig(bfhi(uu) + bgk[1]) * 0.0625f);
                    kv[i][0] = bflo(uk); kv[i][1] = bfhi(uk);
                    if (FULL) { const unsigned uq = rc[i]; qv[i][0] = bflo(uq) * 0.125f; qv[i][1] = bfhi(uq) * 0.125f; } else { qv[i][0] = qv[i][1] = 0.f; }
                }
            }
#pragma unroll
            for (int e = 0; e < 2; ++e) {
                float run = 1.f;
#pragma unroll
                for (int i = RPT - 1; i >= 0; --i) { sp[i][e] = run; run *= la[i][e]; }
                run = 1.f;
#pragma unroll
                for (int i = 0; i < RPT; ++i) { run *= la[i][e]; la[i][e] = run; }
            }
            *(LAS float*)(lds + MX_SEG + (rg * DK + d0) * 4) = la[RPT - 1][0]; *(LAS float*)(lds + MX_SEG + (rg * DK + d0 + 1) * 4) = la[RPT - 1][1];
        }
        {
            u32x4 lo, hi;
            lo.x = (pv[0] & 0xffffu) | (pv[1] << 16); lo.y = (pv[2] & 0xffffu) | (pv[3] << 16); lo.z = (pv[4] & 0xffffu) | (pv[5] << 16); lo.w = (pv[6] & 0xffffu) | (pv[7] << 16);
            hi.x = (pv[0] >> 16) | (pv[1] & 0xffff0000u); hi.y = (pv[2] >> 16) | (pv[3] & 0xffff0000u); hi.z = (pv[4] >> 16) | (pv[5] & 0xffff0000u); hi.w = (pv[6] >> 16) | (pv[7] & 0xffff0000u);
            *(LAS u32x4*)(lds + MX_VT + ((2 * vp) * 72 + r0v) * 2) = lo; *(LAS u32x4*)(lds + MX_VT + ((2 * vp + 1) * 72 + r0v) * 2) = hi;
        }
        if (c + 1 < 16) MX_LOAD(c + 1);
        if (VAR == 2) { unsigned xa = 0; _Pragma("unroll") for (int i = 0; i < RPT + 3; ++i) xa ^= ra[i] ^ rb[i]; _Pragma("unroll") for (int i = 0; i < RPT; ++i) xa ^= rc[i]; _Pragma("unroll") for (int i = 0; i < 8; ++i) xa ^= pv[i];
            _Pragma("unroll") for (int t = 0; t < 4; ++t) xa ^= gnx[t].x ^ gnx[t].y; gacc[0] += (float)(xa & 1u) + sgi + sgf; continue; }
        __syncthreads();
        {
            float pre[2], h2[2], gt[2];
            if (MODE == 2) {
                const float g = *(LAS float*)(lds + MX_GT);
                gt[0] = gt[1] = g; h2[0] = h2[1] = 0.f; pre[0] = pre[1] = 0.f;
                if (tid == 0) gacc[0] += g;
            } else {
#pragma unroll
                for (int e = 0; e < 2; ++e) { float p = 1.f, a1 = 1.f, a2 = 1.f;
#pragma unroll
                    for (int j = 0; j < RG; ++j) { const float v = *(LAS float*)(lds + MX_SEG + (j * DK + d0 + e) * 4);
                        if (j < RG / 2) a1 *= v; else a2 *= v;
                        const bool inb = (rg >= RG / 2) ? (j >= RG / 2 && j < rg) : (j > rg && j < RG / 2);
                        p *= inb ? v : 1.f; }
                    pre[e] = p; h2[e] = a2; gt[e] = a1 * a2;
                    if (rg == 0) { gacc[e] *= gt[e]; *(LAS float*)(lds + MX_GD + (d0 + e) * 4) = gt[e]; *(LAS float*)(lds + MX_ER + (d0 + e) * 4) = a1; } }
            }
            float kh[RPT][2];
#pragma unroll
            for (int i = 0; i < RPT; ++i) {
                const int s = rg * RPT + i;
                float qs[2], ks[2];
                if (MODE == 2) {
                    const float bc = *(LAS float*)(lds + MX_BC + s * 4), ipb = *(LAS float*)(lds + MX_IP + s * 4);
                    const float eq = __expf(bc), ek = __expf(ipb), eg = __expf(gt[0]);
                    qs[0] = qv[i][0] * eq; qs[1] = qv[i][1] * eq; ks[0] = kv[i][0] * ek; ks[1] = kv[i][1] * ek; kh[i][0] = ks[0] * eg; kh[i][1] = ks[1] * eg;
                } else {
#pragma unroll
                    for (int e = 0; e < 2; ++e) {
                        const float cd = pre[e] * ((rg >= RG / 2) ? la[i][e] : sp[i][e]);
                        const float rc_ = __builtin_amdgcn_rcpf(cd);
                        const float qm = (rg >= RG / 2) ? cd : rc_, km = (rg >= RG / 2) ? rc_ : cd;
                        qs[e] = qv[i][e] * qm; ks[e] = kv[i][e] * km; kh[i][e] = ks[e] * h2[e]; }
                }
                if (FULL) { *(LAS unsigned*)(lds + MX_QT + (s * QP + d0) * 2) = pk2(qs[0], qs[1]); *(LAS unsigned*)(lds + MX_KT + (s * QP + d0) * 2) = pk2(ks[0], ks[1]); }
            }
            if (RPT == 8) {
                u32x4 a, bq;
                a.x = pk2(kh[0][0], kh[1][0]); a.y = pk2(kh[2][0], kh[3][0]); a.z = pk2(kh[4 % RPT][0], kh[5 % RPT][0]); a.w = pk2(kh[6 % RPT][0], kh[7 % RPT][0]);
                bq.x = pk2(kh[0][1], kh[1][1]); bq.y = pk2(kh[2][1], kh[3][1]); bq.z = pk2(kh[4 % RPT][1], kh[5 % RPT][1]); bq.w = pk2(kh[6 % RPT][1], kh[7 % RPT][1]);
                *(LAS u32x4*)(lds + MX_KHT + (d0 * 72 + rg * 8) * 2) = a; *(LAS u32x4*)(lds + MX_KHT + ((d0 + 1) * 72 + rg * 8) * 2) = bq;
            } else {
                u32x2 a, bq;
                a.x = pk2(kh[0][0], kh[1][0]); a.y = pk2(kh[2][0], kh[3][0]); bq.x = pk2(kh[0][1], kh[1][1]); bq.y = pk2(kh[2][1], kh[3][1]);
                *(LAS u32x2*)(lds + MX_KHT + (d0 * 72 + rg * 4) * 2) = a; *(LAS u32x2*)(lds + MX_KHT + ((d0 + 1) * 72 + rg * 4) * 2) = bq;
            }
        }
        __syncthreads();
        if (FULL) {
#pragma unroll
            for (int tt = 0; tt < 2; ++tt) {
                const int tile = 2 * w + tt, ti = tile >> 2, tj = tile & 3;
                f32x4 acc = (f32x4){0.f, 0.f, 0.f, 0.f};
                if (ti <= tj) {
#pragma unroll
                    for (int kk = 0; kk < KS; ++kk) {
                        const bf16x8 a = *(const LAS bf16x8*)(lds + MX_KT + ((16 * ti + l15) * QP + kk * 32 + 8 * l4) * 2);
                        const bf16x8 bq = *(const LAS bf16x8*)(lds + MX_QT + ((16 * tj + l15) * QP + kk * 32 + 8 * l4) * 2);
                        acc = MFMA16(a, bq, acc);
                    }
                }
                const int s = 16 * tj + l15, sp0 = 16 * ti + 4 * l4;
                float pvv[4];
#pragma unroll
                for (int r = 0; r < 4; ++r) pvv[r] = (sp0 + r <= s) ? acc[r] : 0.f;
                u32x2 pw; pw.x = pk2(pvv[0], pvv[1]); pw.y = pk2(pvv[2], pvv[3]);
                *(LAS u32x2*)(lds + MX_P + (s * 72 + sp0) * 2) = pw;
            }
            {
                float er[4];
#pragma unroll
                for (int r = 0; r < 4; ++r) er[r] = (MODE == 2) ? 1.f : *(LAS float*)(lds + MX_ER + (sdt * 16 + 4 * l4 + r) * 4);
#pragma unroll
                for (int t = 0; t < NST; ++t) {
                    const int v = 16 * (svt0 + t) + l15;
                    u32x2 sw; sw.x = pk2(S[t][0] * er[0], S[t][1] * er[1]); sw.y = pk2(S[t][2] * er[2], S[t][3] * er[3]);
                    *(LAS u32x2*)(lds + MX_ST + (v * QP + sdt * 16 + 4 * l4) * 2) = sw;
                }
            }
            __syncthreads();
            constexpr int NOT = (MODE == 2) ? 5 : 4;
            f32x4 O[NOT];
#pragma unroll
            for (int t = 0; t < NOT; ++t) {
                O[t] = (f32x4){0.f, 0.f, 0.f, 0.f};
                const int vt = (t < 4) ? (4 * ovh + t) : 8;
                if (t < 4 || ovh == 0) {
#pragma unroll
                    for (int kk = 0; kk < 2; ++kk) {
                        const bf16x8 a = *(const LAS bf16x8*)(lds + MX_VT + ((16 * vt + l15) * 72 + kk * 32 + 8 * l4) * 2);
                        const bf16x8 bq = *(const LAS bf16x8*)(lds + MX_P + ((16 * sj + l15) * 72 + kk * 32 + 8 * l4) * 2);
                        O[t] = MFMA16(a, bq, O[t]);
                    }
#pragma unroll
                    for (int kk = 0; kk < KS; ++kk) {
                        const bf16x8 a = *(const LAS bf16x8*)(lds + MX_ST + ((16 * vt + l15) * QP + kk * 32 + 8 * l4) * 2);
                        const bf16x8 bq = *(const LAS bf16x8*)(lds + MX_QT + ((16 * sj + l15) * QP + kk * 32 + 8 * l4) * 2);
                        O[t] = MFMA16(a, bq, O[t]);
                    }
                }
            }
            const int tokr = tokc + srow;
            float scale;
            if (MODE == 2) {
                if (ovh == 0 && l4 == 0) *(LAS float*)(lds + MX_DEN + srow * 4) = O[NOT - 1][0];
                __syncthreads();
                const float den = *(LAS float*)(lds + MX_DEN + srow * 4);
                scale = 1.f / fmaxf(fabsf(den), 1.f);
            } else {
                float ss = 0.f;
#pragma unroll
                for (int t = 0; t < 4; ++t)
#pragma unroll
                    for (int r = 0; r < 4; ++r) ss += O[t][r] * O[t][r];
                ss += __shfl_xor(ss, 16); ss += __shfl_xor(ss, 32);
                if (l4 == 0) *(LAS float*)(lds + MX_RS + (ovh * 64 + srow) * 4) = ss;
                __syncthreads();
                const float tot = *(LAS float*)(lds + MX_RS + srow * 4) + *(LAS float*)(lds + MX_RS + (64 + srow) * 4);
                scale = rsqrtf(tot * (1.f / 128.f) + 1e-6f);
            }
#pragma unroll
            for (int t = 0; t < 4; ++t) {
                const int v0 = 16 * (4 * ovh + t) + 4 * l4;
                const u32x2 gt = gcur[t];
                const float g0 = bflo(gt.x), g1 = bfhi(gt.x), g2 = bflo(gt.y), g3 = bfhi(gt.y);
                float y0, y1, y2, y3;
                if (MODE == 2) { y0 = O[t][0] * scale * sigm(g0); y1 = O[t][1] * scale * sigm(g1); y2 = O[t][2] * scale * sigm(g2); y3 = O[t][3] * scale * sigm(g3); }
                else { const float* gn = ((MODE == 0) ? mp.hg : mp.gg) + h * 128 + v0;
                    y0 = O[t][0] * scale * gn[0] * silu(g0); y1 = O[t][1] * scale * gn[1] * silu(g1); y2 = O[t][2] * scale * gn[2] * silu(g2); y3 = O[t][3] * scale * gn[3] * silu(g3); }
                u32x2 yw; yw.x = pk2(y0, y1); yw.y = pk2(y2, y3);
                *(u32x2*)(mp.ymix + (size_t)tokr * DM + cy + v0) = yw;
            }
        }
        {
            float dec[4];
            if (MODE == 2) { const float eg = __expf(*(LAS float*)(lds + MX_GT)); dec[0] = dec[1] = dec[2] = dec[3] = eg; }
            else {
#pragma unroll
                for (int r = 0; r < 4; ++r) dec[r] = *(LAS float*)(lds + MX_GD + (sdt * 16 + 4 * l4 + r) * 4);
            }
            bf16x8 ka[2];
#pragma unroll
            for (int kk = 0; kk < 2; ++kk) ka[kk] = *(const LAS bf16x8*)(lds + MX_KHT + ((16 * sdt + l15) * 72 + kk * 32 + 8 * l4) * 2);
#pragma unroll
            for (int t = 0; t < NST; ++t) {
#pragma unroll
                for (int r = 0; r < 4; ++r) S[t][r] *= dec[r];
#pragma unroll
                for (int kk = 0; kk < 2; ++kk) {
                    const bf16x8 vb = *(const LAS bf16x8*)(lds + MX_VT + ((16 * (svt0 + t) + l15) * 72 + kk * 32 + 8 * l4) * 2);
                    S[t] = MFMA16(ka[kk], vb, S[t]);
                }
            }
        }
        __syncthreads();
    }
#undef MX_LOAD
    if (VAR == 2) { mp.ust[(size_t)bid * 512 + tid] = gacc[0]; return; }
    if (!FULL) {
        float* U = mp.ust + ((size_t)bid * 8 + w) * (9 * 4 * 64);
#pragma unroll
        for (int t = 0; t < NST; ++t)
#pragma unroll
            for (int r = 0; r < 4; ++r) U[(t * 4 + r) * 64 + lane] = S[t][r];
        if (MODE == 2) { if (tid == 0) mp.gsum[(size_t)bid * 128] = gacc[0]; }
        else if (rg == 0) { mp.gsum[(size_t)bid * 128 + d0] = gacc[0]; mp.gsum[(size_t)bid * 128 + d0 + 1] = gacc[1]; }
    }
}

#ifndef PHMASK
#define PHMASK 0xFFFFu
#endif
#ifndef MIXSEL
#define MIXSEL 7
#endif
#ifndef REPMASK
#define REPMASK 0x0u
#endif
#define EN(j) (((PHMASK) >> (j)) & 1u)
#ifndef REPLAYER
#define REPLAYER 3
#endif
#define NREP(j) (1 + (int)((((REPMASK) >> (j)) & 1u) & (((REPLAYER) >> layer) & 1u)))
#define IN(k) (lo <= (k) && (k) < hi)
#define SEAM(k) do { if (IN((k) + 1)) xcd_barrier(bar); } while (0)

template <int layer> __device__ __forceinline__ void ph_proj(LAS unsigned char* lds, unsigned char* ws, int bid, int nb) {
    pg8::Gemm g{(const bf16_t*)(ws + (layer ? WS_H2Q : WS_XQ)), (const bf16_t*)(ws + (layer ? WS_WC : WS_WAB)), DM / 2};
    pg8::StaticOrder S; S.init(NTOK, layer ? CWID : ABW, nb, bid);
    pg8::EpiStoreBf16<true> E{(bf16_t*)(ws + WS_PROJ), layer ? CWID : ABW};
    pg8::gemm_phase<pg8::EpiStoreBf16<true>, pg8::StaticOrder, false, true>(lds, g, nullptr, S, E);
}
template <int layer> __device__ __forceinline__ void ph_outproj(LAS unsigned char* lds, unsigned char* ws, int bid, int nb) {
    pg8::Gemm g{(const bf16_t*)(ws + WS_YMIX), (const bf16_t*)(ws + (layer ? WS_WOC : WS_WOAB)), DM};
    pg8::StaticOrder S; S.init(NTOK, DM, nb, bid);
    pg8::EpiResid E{(bf16_t*)(ws + WS_Z), (const bf16_t*)(ws + (layer ? WS_H2 : WS_HB))};
    pg8::gemm_phase<pg8::EpiResid, pg8::StaticOrder, false>(lds, g, nullptr, S, E);
}
template <int layer> __device__ __forceinline__ void ph_router(LAS unsigned char* lds, unsigned char* ws, int bid, int nb) {
    pg8::Gemm g{(const bf16_t*)(ws + WS_H1), (const bf16_t*)(ws + WS_WR) + (size_t)layer * 256 * 1024, DM};
    pg8::StaticOrder S; S.init(NTOK, 256, nb, bid);
    pg8::EpiF32 E{(float*)(ws + WS_LOGITS)};
    pg8::gemm_phase<pg8::EpiF32, pg8::StaticOrder, false>(lds, g, nullptr, S, E);
}
template <int layer> __device__ __forceinline__ void ph_gemm1(LAS unsigned char* lds, unsigned char* ws, int bid, int nb) {
    const int vcu = (nb % 8 == 0) ? (bid % 8) * (nb / 8) + bid / 8 : bid;
    const int nt = __builtin_amdgcn_readfirstlane(*(volatile int*)(ws + WS_MISC + 65536 + 8192));
    pg8::Gemm g{(const bf16_t*)(ws + WS_H1Q), (const bf16_t*)(ws + WS_W1T + (size_t)layer * NE1 * 512 * 1024), DM / 2};
    pg8::MoeOrder S{(const int*)(ws + WS_MISC + 65536), nt * 2, 1, nb, vcu};
    pg8::EpiSwiGLU<true> E{(bf16_t*)(ws + WS_ACT)};
    pg8::gemm_phase<pg8::EpiSwiGLU<true>, pg8::MoeOrder, true, true>(lds, g, (const int*)(ws + WS_STOK), S, E);
}
template <int layer> __device__ __forceinline__ void ph_gemm2(LAS unsigned char* lds, unsigned char* ws, int bid, int nb) {
    const int vcu = (nb % 8 == 0) ? (bid % 8) * (nb / 8) + bid / 8 : bid;
    const int nt = __builtin_amdgcn_readfirstlane(*(volatile int*)(ws + WS_MISC + 65536 + 8192));
    pg8::Gemm g{(const bf16_t*)(ws + WS_ACT), (const bf16_t*)(ws + WS_W2T) + (size_t)layer * NE1 * 1024 * 256, 256};
    pg8::MoeOrder S{(const int*)(ws + WS_MISC + 65536), nt * 4, 2, nb, vcu};
    pg8::EpiDown E{(unsigned char*)(ws + WS_Y)};
    pg8::gemm_phase<pg8::EpiDown, pg8::MoeOrder, false>(lds, g, nullptr, S, E);
}
template <int layer, bool FULLP> __device__ __forceinline__ void ph_mixer(LAS unsigned char* lds, const Args& A, int bid, int nb) {
    unsigned char* ws = A.ws;
    if (nb != NWG) return;
    MixP mp{(const bf16_t*)(ws + WS_PROJ), layer ? CWID : ABW, 0, (bf16_t*)(ws + WS_YMIX), (const float*)(ws + WS_GATES), (const float*)(ws + WS_MISC), A.in[I_BGK], A.in[I_HG], A.in[I_GG], A.in[I_CONV], A.in[I_BIF], (float*)(ws + WS_UST), (float*)(ws + WS_GSUM)};
    if (layer == 0) { if (bid < 128) { if (MIXSEL & 1) mixer_run<0, FULLP>(lds, mp, bid); } else { if (MIXSEL & 2) mixer_run<1, FULLP>(lds, mp, bid); } }
    else { if (MIXSEL & 4) mixer_run<2, FULLP>(lds, mp, bid); }
}
#define REP2(j, call) do { call; if (NREP(j) == 2) { __syncthreads(); call; } } while (0)

template <int layer>
__device__ __forceinline__ void run_layer(LAS unsigned char* lds, const Args& A, const XcdBarrier& bar, const int lo, const int hi) {
    const int bid = blockIdx.x, nb = gridDim.x;
    unsigned char* ws = A.ws;
    unsigned* ctl = (unsigned*)(ws + WS_CTL);
    constexpr int P = 1 + layer * 11;
    if (EN(0) && IN(P + 0)) { REP2(0, ph_proj<layer>(lds, ws, bid, nb)); SEAM(P + 0); }
    if (EN(1) && IN(P + 1)) { REP2(1, (ph_mixer<layer, false>(lds, A, bid, nb))); SEAM(P + 1); }
    if (EN(2) && IN(P + 2)) { REP2(2, (ph_mixer<layer, true>(lds, A, bid, nb))); SEAM(P + 2); }
    if (EN(3) && IN(P + 3)) { REP2(3, ph_outproj<layer>(lds, ws, bid, nb)); SEAM(P + 3); }
    if (EN(4) && IN(P + 4)) { REP2(4, phase_ln((const bf16_t*)(ws + WS_Z), (bf16_t*)(ws + WS_H1), ws + WS_H1Q, A.in[I_LMG] + layer * DM, A.in[I_LMB] + layer * DM, bid, nb)); SEAM(P + 4); }
    if (EN(5) && IN(P + 5)) { REP2(5, ph_router<layer>(lds, ws, bid, nb)); SEAM(P + 5); }
    if (EN(6) && IN(P + 6)) {
        phase_select<false>(lds, (const float*)(ws + WS_LOGITS), A.in[I_RB] + layer * NEXP, (int*)(ws + WS_TOKE), (int*)(ws + WS_TOKP), (float*)(ws + WS_TOKW), ctl + CW_CNT + layer * 256, bid, nb);
        if (NREP(6) == 2) phase_select<true>(lds, (const float*)(ws + WS_LOGITS), A.in[I_RB] + layer * NEXP, (int*)(ws + WS_TOKE), (int*)(ws + WS_TOKP), (float*)(ws + WS_TOKW), ctl + CW_CNT + layer * 256, bid, nb);
        SEAM(P + 6); }
    if (EN(7) && IN(P + 7)) { REP2(7, phase_dispatch(lds, ctl + CW_CNT + layer * 256, (const int*)(ws + WS_TOKE), (const int*)(ws + WS_TOKP), (int*)(ws + WS_STOK), (int*)(ws + WS_POSY), (int*)(ws + WS_MISC + 65536), (int*)(ws + WS_MISC + 65536 + 8192), bid, nb)); SEAM(P + 7); }
    if (EN(8) && IN(P + 8)) { REP2(8, ph_gemm1<layer>(lds, ws, bid, nb)); SEAM(P + 8); }
    if (EN(9) && IN(P + 9)) { REP2(9, ph_gemm2<layer>(lds, ws, bid, nb)); SEAM(P + 9); }
    if (EN(10) && IN(P + 10)) {
        if (layer == 0) REP2(10, (phase_combine<false>((const unsigned char*)(ws + WS_Y), (const int*)(ws + WS_POSY), (const float*)(ws + WS_TOKW), (const int*)(ws + WS_MISC + 65536 + 8192), (const bf16_t*)(ws + WS_H1), (bf16_t*)(ws + WS_H2), ws + WS_H2Q, nullptr, (float*)(ws + WS_GATES), (const float*)(ws + WS_MISC + 4096), A.in[I_LFG], A.in[I_LFB], bid, nb)));
        else REP2(10, (phase_combine<true>((const unsigned char*)(ws + WS_Y), (const int*)(ws + WS_POSY), (const float*)(ws + WS_TOKW), (const int*)(ws + WS_MISC + 65536 + 8192), (const bf16_t*)(ws + WS_H1), nullptr, nullptr, A.out, nullptr, nullptr, A.in[I_LFG] + DM, A.in[I_LFB] + DM, bid, nb)));
        SEAM(P + 10);
    }
}

__global__ void __launch_bounds__(512, 2) fwd_kernel(Args A) {
    extern __shared__ __attribute__((aligned(16))) unsigned char lds_raw[];
    LAS unsigned char* lds = (LAS unsigned char*)lds_raw;
    const int tid = threadIdx.x;
    unsigned* ctl = (unsigned*)(A.ws + WS_CTL);
    volatile LAS unsigned* misc = (volatile LAS unsigned*)(lds + LDS_MISC);
    if (tid < 64) misc[tid] = 0u;
    __syncthreads();
    const int lo = A.ph_lo, hi = A.ph_hi;
    XcdBarrier bar; bar.bar = ctl + CW_BAR; bar.x = 0; bar.st = misc;
    if (hi - lo > 1) bar = xcd_barrier_post(ctl + CW_BAR, misc);
    if (EN(11) && IN(0)) { for (int rep_ = 0; rep_ < 1 + (int)(((REPMASK) >> 11) & 1u); ++rep_) phase_prologue(lds, A, blockIdx.x, gridDim.x); SEAM(0); }
    run_layer<0>(lds, A, bar, lo, hi);
    run_layer<1>(lds, A, bar, lo, hi);
}
#undef IN
#undef SEAM

#ifdef DBG
__device__ __forceinline__ unsigned hash32(unsigned x) { x ^= x >> 16; x *= 0x7feb352dU; x ^= x >> 15; x *= 0x846ca68bU; x ^= x >> 16; return x; }
__device__ __forceinline__ void dbg_acc(float* w, int stage, float num, float den) { if (!(num == num) || num > 1e30f) num = 1e30f; atomicAdd(w + 2 * stage, num); atomicAdd(w + 2 * stage + 1, den); }
__device__ __forceinline__ float bfr(float x) { return bflo(pk2(x, 0.f)); }
__global__ void dbg_weights(Args A, float* w) {
    const unsigned i = blockIdx.x * 256 + threadIdx.x; unsigned char* ws = A.ws;
    float num = 0.f, den = 0.f;
    { const unsigned hsh = hash32(i * 4 + 0), col = hsh % 3584, k = (hsh >> 12) % 1024; const float r = A.in[I_WINAB][(size_t)k * 3600 + col], g = bf2f(((const bf16_t*)(ws + WS_WAB))[(size_t)col * 1024 + k]); num += (r - g) * (r - g); den += r * r; }
    { const unsigned hsh = hash32(i * 4 + 1), j = hsh % 256, k = (hsh >> 12) % 1024; float r = 0.f; for (int q = 0; q < 16; ++q) r += A.in[I_WINAB][(size_t)k * 3600 + 3584 + q] * A.in[I_WGKUP][q * 256 + j];
      const float g = bf2f(((const bf16_t*)(ws + WS_WAB))[(size_t)(3584 + j) * 1024 + k]); num += (r - g) * (r - g); den += r * r; }
    { const unsigned hsh = hash32(i * 4 + 2), le = hsh % 514, layer = le / 257, e = le % 257, n = (hsh >> 10) % 512, k = (hsh >> 20) % 1024;
      const float r = (e < 256) ? A.in[I_WEI][((size_t)(layer * 256 + e) * 1024 + k) * 512 + n] : A.in[I_WSI][((size_t)layer * 1024 + k) * 512 + n];
      const unsigned up = n >> 8, c = n & 255, drow = (c >> 7) * 256 + up * 128 + (c & 127);
      const float g = bf2f(((const bf16_t*)(ws + WS_W1T))[((size_t)(layer * 257 + e) * 512 + drow) * 1024 + k]); num += (r - g) * (r - g); den += r * r; }
    { const unsigned hsh = hash32(i * 4 + 3), le = hsh % 514, layer = le / 257, e = le % 257, n = (hsh >> 10) % 1024, k = (hsh >> 20) % 256;
      const float r = (e < 256) ? A.in[I_WED][((size_t)(layer * 256 + e) * 256 + k) * 1024 + n] : A.in[I_WSD][((size_t)layer * 256 + k) * 1024 + n];
      const float g = bf2f(((const bf16_t*)(ws + WS_W2T))[((size_t)(layer * 257 + e) * 1024 + n) * 256 + k]); num += (r - g) * (r - g); den += r * r; }
    dbg_acc(w, 1, num, den);
}
__global__ void dbg_gemm(const bf16_t* Am, int K, const bf16_t* Bt, const void* out, int ldo, int out_f32, int nrows, int ncols, float* w, int stage) {
    const unsigned i = blockIdx.x * 256 + threadIdx.x; const unsigned hsh = hash32(i + 77u * stage), row = hsh % nrows, col = (hsh >> 11) % ncols;
    float r = 0.f; for (int k = 0; k < K; ++k) r += bf2f(Am[(size_t)row * K + k]) * bf2f(Bt[(size_t)col * K + k]);
    const float g = out_f32 ? ((const float*)out)[(size_t)row * ldo + col] : bf2f(((const bf16_t*)out)[(size_t)row * ldo + col]);
    dbg_acc(w, stage, (r - g) * (r - g), r * r);
}
template <int MODE> __global__ void __launch_bounds__(256, 1) dbg_mixer(MixP mp, int b, int h, int T, float* w, int stage) {
    constexpr int DK = (MODE == 1) ? 64 : 128, DV = (MODE == 2) ? 256 : 128;
    __shared__ float sq[128], sk[128], sa[128], red[256], sh_i, sh_f;
    const int tid = threadIdx.x;
    const int ldp = mp.ldp; const bf16_t* proj = mp.proj;
    int cq, ck, cv, cg, cy, cu = 3584 + h * 64;
    if (MODE == 0) { cq = h * 128; ck = 512 + h * 128; cv = 1024 + h * 128; cg = 1536 + h * 128; cy = h * 128; }
    else if (MODE == 1) { cq = 2048 + h * 64; ck = 2304 + h * 64; cv = 2560 + h * 128; cg = 3072 + h * 128; cy = 512 + h * 128; }
    else { cq = h * 128; ck = 512 + h * 128; cv = 1024 + h * 256; cg = 2048 + h * 256; cy = h * 256; }
    float S[DK];
#pragma unroll
    for (int d = 0; d < DK; ++d) S[d] = 0.f;
    float nst = 0.f, num = 0.f, den = 0.f;
    for (int t = 0; t < T; ++t) {
        const size_t tok = (size_t)b * SEQ + t; const bf16_t* pr = proj + tok * ldp;
        if (tid < DK) {
            const int d = tid;
            if (MODE == 0) { const float z = bf2f(pr[ck + d]), sg = 1.f / (1.f + expf(-z)), lb = mp.lb0[h * 128 + d]; sa[d] = lb + (1.f - lb) * sg; sk[d] = (1.f - lb) * (1.f - sg); const float qq = bf2f(pr[cq + d]); sq[d] = qq / (1.f + expf(-qq)); }
            else if (MODE == 1) { const float u = bf2f(pr[cu + d]) + mp.bgk[h * 64 + d]; const float ls = fminf(u, 0.f) - log1pf(expf(-fabsf(u))); sa[d] = expf(ls / 16.f); sk[d] = bf2f(pr[ck + d]); sq[d] = bf2f(pr[cq + d]) * 0.125f; }
            else { float aq = 0.f, ak = 0.f; for (int j = 0; j < 4; ++j) { const int tt = t - 3 + j; if (tt >= 0) { const bf16_t* p2 = proj + ((size_t)b * SEQ + tt) * ldp; aq += mp.conv[j * 1024 + cq + d] * bf2f(p2[cq + d]); ak += mp.conv[j * 1024 + ck + d] * bf2f(p2[ck + d]); } }
                sq[d] = aq / (1.f + expf(-aq)); sk[d] = ak / (1.f + expf(-ak)) * 0.08838834764831845f; }
        }
        if (MODE == 2 && tid == 0) { const float* gp = mp.gates + tok * 8; sh_i = expf(gp[h] + mp.bif[h]); const float x = gp[4 + h] + mp.bif[4 + h]; sh_f = 1.f / (1.f + expf(-x)); }
        __syncthreads();
        const float vt = bf2f(pr[cv + tid]);
        float o = 0.f;
        if (MODE == 2) { const float f = sh_f, ii = sh_i;
#pragma unroll
            for (int d = 0; d < DK; ++d) { S[d] = f * S[d] + ii * sk[d] * vt; o += S[d] * sq[d]; }
            if (tid < 128) nst = f * nst + ii * sk[tid];
            red[tid] = (tid < 128) ? nst * sq[tid] : 0.f;
        } else {
#pragma unroll
            for (int d = 0; d < DK; ++d) { S[d] = sa[d] * S[d] + sk[d] * vt; o += S[d] * sq[d]; }
            red[tid] = o * o;
        }
        __syncthreads();
        for (int st = DV / 2; st > 0; st >>= 1) { if (tid < st) red[tid] += red[tid + st]; __syncthreads(); }
        const float tot = red[0];
        const float gt = bf2f(pr[cg + tid]);
        float y;
        if (MODE == 2) y = o / fmaxf(fabsf(tot), 1.f) * (1.f / (1.f + expf(-gt)));
        else y = o * rsqrtf(tot / 128.f + 1e-6f) * ((MODE == 0) ? mp.hg : mp.gg)[h * 128 + tid] * (gt / (1.f + expf(-gt)));
        const float g = bf2f(mp.ymix[tok * DM + cy + tid]);
        num += (y - g) * (y - g); den += y * y;
        __syncthreads();
    }
    dbg_acc(w, stage, num, den);
}
__global__ void dbg_h1(const bf16_t* HIN, const bf16_t* YM, const bf16_t* Wt, const bf16_t* H1, const float* g, const float* bb, float* w, int stage) {
    __shared__ float red[256]; __shared__ float zrow[1024];
    const int tid = threadIdx.x; const unsigned row = hash32(blockIdx.x + 1000u * stage) % NTOK;
    float z[4];
    for (int q = 0; q < 4; ++q) { const int c = tid + 256 * q; float a = 0.f; for (int k = 0; k < 1024; ++k) a += bf2f(YM[(size_t)row * 1024 + k]) * bf2f(Wt[(size_t)c * 1024 + k]); z[q] = bfr(ALPHA * bf2f(HIN[(size_t)row * 1024 + c]) + a); }
    red[tid] = z[0] + z[1] + z[2] + z[3]; __syncthreads();
    for (int st = 128; st > 0; st >>= 1) { if (tid < st) red[tid] += red[tid + st]; __syncthreads(); }
    const float mu = red[0] / 1024.f; __syncthreads();
    red[tid] = (z[0] - mu) * (z[0] - mu) + (z[1] - mu) * (z[1] - mu) + (z[2] - mu) * (z[2] - mu) + (z[3] - mu) * (z[3] - mu); __syncthreads();
    for (int st = 128; st > 0; st >>= 1) { if (tid < st) red[tid] += red[tid + st]; __syncthreads(); }
    const float rs = rsqrtf(red[0] / 1024.f + 1e-5f);
    float num = 0.f, den = 0.f;
    for (int q = 0; q < 4; ++q) { const int c = tid + 256 * q; const float y = (z[q] - mu) * rs * g[c] + bb[c], gg = bf2f(H1[(size_t)row * 1024 + c]); num += (y - gg) * (y - gg); den += y * y; }
    dbg_acc(w, stage, num, den); (void)zrow;
}
__global__ void dbg_select(const float* logits, const float* rb, const int* tok_e, const float* tok_w, float* w, int stage) {
    __shared__ float sc[256], bs[256]; __shared__ int ce[8]; __shared__ float cs[8];
    if (threadIdx.x != 0) return;
    const unsigned tok = hash32(blockIdx.x + 31u * stage) % NTOK;
    const float* lp = logits + (size_t)tok * 256;
    for (int e = 0; e < 256; ++e) { sc[e] = 1.f / (1.f + expf(-lp[e])); bs[e] = sc[e] + rb[e]; }
    float gs[8];
#pragma unroll
    for (int g = 0; g < 8; ++g) { float m1 = -1e30f, m2 = -1e30f; for (int j = 0; j < 32; ++j) { const float v = bs[g * 32 + j]; if (v > m1) { m2 = m1; m1 = v; } else if (v > m2) m2 = v; } gs[g] = m1 + m2; }
    unsigned selmask = 0;
#pragma unroll
    for (int g = 0; g < 8; ++g) { int rank = 0;
#pragma unroll
        for (int q = 0; q < 8; ++q) rank += (gs[q] > gs[g] || (gs[q] == gs[g] && q < g)) ? 1 : 0; if (rank < 4) selmask |= 1u << g; }
    float tot = 0.f;
    for (int k = 0; k < 8; ++k) { float bv = -1e30f; int be = 0; for (int e = 0; e < 256; ++e) { if (!((selmask >> (e >> 5)) & 1u)) continue; bool used = false; for (int q = 0; q < k; ++q) used |= (ce[q] == e); if (used) continue; if (bs[e] > bv) { bv = bs[e]; be = e; } } ce[k] = be; cs[k] = sc[be]; tot += sc[be]; }
    float num = 0.f, den = 0.f;
    for (int k = 0; k < 8; ++k) { const float wr_ = cs[k] / tot * 2.5f; const int ge = tok_e[(size_t)tok * 8 + k]; const float gw = tok_w[(size_t)tok * 8 + k];
        num += (ge == ce[k] ? 0.f : 1.f) + (wr_ - gw) * (wr_ - gw); den += wr_ * wr_; }
    dbg_acc(w, stage, num, den);
}
template <bool FINAL> __global__ void dbg_moe(Args A, int layer, const int* tok_e, const float* tok_w, const bf16_t* H1, const bf16_t* H2, const float* OUT, float* w, int stage) {
    __shared__ float hrow[1024], hid[256], red[256];
    const int tid = threadIdx.x; const unsigned tok = hash32(blockIdx.x + 555u * stage) % NTOK;
    for (int i = tid; i < 1024; i += 256) hrow[i] = bf2f(H1[(size_t)tok * 1024 + i]);
    float acc[4] = {0.f, 0.f, 0.f, 0.f};
    __syncthreads();
    for (int k = 0; k < 9; ++k) {
        const int e = (k < 8) ? tok_e[(size_t)tok * 8 + k] : 256; const float wk = (k < 8) ? tok_w[(size_t)tok * 8 + k] : 1.f;
        const float* W1 = (e < 256) ? A.in[I_WEI] + (size_t)(layer * 256 + e) * 1024 * 512 : A.in[I_WSI] + (size_t)layer * 1024 * 512;
        const float* W2 = (e < 256) ? A.in[I_WED] + (size_t)(layer * 256 + e) * 256 * 1024 : A.in[I_WSD] + (size_t)layer * 256 * 1024;
        float gsum = 0.f, usum = 0.f;
        for (int kk = 0; kk < 1024; ++kk) { gsum += hrow[kk] * W1[(size_t)kk * 512 + tid]; usum += hrow[kk] * W1[(size_t)kk * 512 + 256 + tid]; }
        hid[tid] = gsum / (1.f + expf(-gsum)) * usum;
        __syncthreads();
        for (int q = 0; q < 4; ++q) { const int c = tid + 256 * q; float a = 0.f; for (int j = 0; j < 256; ++j) a += hid[j] * W2[(size_t)j * 1024 + c]; acc[q] += wk * a; }
        __syncthreads();
    }
    float z[4]; for (int q = 0; q < 4; ++q) z[q] = ALPHA * hrow[tid + 256 * q] + acc[q];
    red[tid] = z[0] + z[1] + z[2] + z[3]; __syncthreads();
    for (int st = 128; st > 0; st >>= 1) { if (tid < st) red[tid] += red[tid + st]; __syncthreads(); }
    const float mu = red[0] / 1024.f; __syncthreads();
    red[tid] = (z[0] - mu) * (z[0] - mu) + (z[1] - mu) * (z[1] - mu) + (z[2] - mu) * (z[2] - mu) + (z[3] - mu) * (z[3] - mu); __syncthreads();
    for (int st = 128; st > 0; st >>= 1) { if (tid < st) red[tid] += red[tid + st]; __syncthreads(); }
    const float rs = rsqrtf(red[0] / 1024.f + 1e-5f);
    const float* g = A.in[I_LFG] + layer * DM; const float* bb = A.in[I_LFB] + layer * DM;
    float num = 0.f, den = 0.f;
    for (int q = 0; q < 4; ++q) { const int c = tid + 256 * q; const float y = (z[q] - mu) * rs * g[c] + bb[c]; const float gg = FINAL ? OUT[(size_t)tok * 1024 + c] : bf2f(H2[(size_t)tok * 1024 + c]); num += (y - gg) * (y - gg); den += y * y; }
    dbg_acc(w, stage, num, den);
}
#ifndef DBG_REPORT
#define DBG_REPORT 0
#endif
__global__ void dbg_fill(float* out, const float* w) {
    __shared__ float cval;
    if (threadIdx.x == 0) {
        float c = 0.f;
        if (DBG_REPORT == 0) { for (int st = 1; st <= 13; ++st) { const float rel = sqrtf(w[2 * st] / fmaxf(w[2 * st + 1], 1e-30f)); if (!(rel < 0.08f) || !(w[2 * st + 1] > 0.f)) { c = (float)st; break; } } }
        else { const float rel = sqrtf(w[2 * DBG_REPORT] / fmaxf(w[2 * DBG_REPORT + 1], 1e-30f)); float l = -log10f(fmaxf(rel, 1e-8f)); l = fminf(fmaxf(l, -2.f), 8.f); c = 3.f + l; }
        cval = c;
    }
    __syncthreads();
    const float c = cval;
    if (c != 0.f) for (size_t i = (size_t)blockIdx.x * 256 + threadIdx.x; i < (size_t)NTOK * DM; i += (size_t)gridDim.x * 256) out[i] = c;
}
#endif

extern "C" void kernel_launch(void* const* d_in, const int* in_sizes, int n_in, void* d_out, int out_size, void* d_ws, size_t ws_size, hipStream_t stream) {
    static int grid = 0;
    if (grid == 0) {
        if (n_in != 22 || out_size != NTOK * DM || ws_size < WS_END) { fprintf(stderr, "kernel_launch: unexpected shapes (n_in %d out %d ws %zu)\n", n_in, out_size, ws_size); grid = -1; return; }
        if (hipFuncSetAttribute((const void*)fwd_kernel, hipFuncAttributeMaxDynamicSharedMemorySize, LDS_BYTES) != hipSuccess) { fprintf(stderr, "kernel_launch: hipFuncSetAttribute failed\n"); grid = -1; return; }
        int per_cu = 0;
        if (hipOccupancyMaxActiveBlocksPerMultiprocessor(&per_cu, (const void*)fwd_kernel, 512, LDS_BYTES) != hipSuccess || per_cu < 1) fprintf(stderr, "kernel_launch: occupancy query says %d\n", per_cu);
        (void)hipGetLastError();
        grid = NWG;
    }
    if (grid < 0) return;
    (void)hipMemsetAsync((char*)d_ws + WS_CTL, 0, CTL_BYTES, stream);
    Args a{};
    for (int i = 0; i < 22; ++i) a.in[i] = (const float*)d_in[i];
    a.out = (float*)d_out; a.ws = (unsigned char*)d_ws;
#if MK_ONE_LAUNCH
    a.ph_lo = 0; a.ph_hi = 23;
    hipLaunchKernelGGL(fwd_kernel, dim3(grid), dim3(512), LDS_BYTES, stream, a);
#else
    for (int p = 0; p < 23; ++p) { a.ph_lo = p; a.ph_hi = p + 1; hipLaunchKernelGGL(fwd_kernel, dim3(grid), dim3(512), LDS_BYTES, stream, a);
#ifdef DBG
        unsigned char* ws = (unsigned char*)d_ws; float* dw = (float*)(ws + WS_CTL) + CW_DBG;
        const int layer = (p - 1) / 11, q = (p - 1) % 11;
        MixP mp{(const bf16_t*)(ws + WS_PROJ), layer ? CWID : ABW, 0, (bf16_t*)(ws + WS_YMIX), (const float*)(ws + WS_GATES), (const float*)(ws + WS_MISC), a.in[I_BGK], a.in[I_HG], a.in[I_GG], a.in[I_CONV], a.in[I_BIF], (float*)(ws + WS_UST), (float*)(ws + WS_GSUM)};
        if (p == 0) hipLaunchKernelGGL(dbg_weights, dim3(256), dim3(256), 0, stream, a, dw);
        if (p >= 1 && q == 0) hipLaunchKernelGGL(dbg_gemm, dim3(64), dim3(256), 0, stream, (const bf16_t*)(ws + (layer ? WS_H2 : WS_HB)), 1024, (const bf16_t*)(ws + (layer ? WS_WC : WS_WAB)), (const void*)(ws + WS_PROJ), layer ? CWID : ABW, 0, NTOK, layer ? CWID : ABW, dw, layer ? 9 : 2);
        if (p >= 1 && q == 2 && layer == 0) { hipLaunchKernelGGL(dbg_mixer<0>, dim3(1), dim3(128), 0, stream, mp, 0, 1, 1100, dw, 3); hipLaunchKernelGGL(dbg_mixer<1>, dim3(1), dim3(128), 0, stream, mp, 1, 2, 1100, dw, 4); }
        if (p >= 1 && q == 2 && layer == 1) hipLaunchKernelGGL(dbg_mixer<2>, dim3(1), dim3(256), 0, stream, mp, 1, 1, 1100, dw, 10);
        if (p >= 1 && q == 4) hipLaunchKernelGGL(dbg_h1, dim3(32), dim3(256), 0, stream, (const bf16_t*)(ws + (layer ? WS_H2 : WS_HB)), (const bf16_t*)(ws + WS_YMIX), (const bf16_t*)(ws + (layer ? WS_WOC : WS_WOAB)), (const bf16_t*)(ws + WS_H1), a.in[I_LMG] + layer * DM, a.in[I_LMB] + layer * DM, dw, layer ? 11 : 5);
        if (p >= 1 && q == 5 && layer == 0) hipLaunchKernelGGL(dbg_gemm, dim3(64), dim3(256), 0, stream, (const bf16_t*)(ws + WS_H1), 1024, (const bf16_t*)(ws + WS_WR), (const void*)(ws + WS_LOGITS), 256, 1, NTOK, 256, dw, 6);
        if (p >= 1 && q == 6) hipLaunchKernelGGL(dbg_select, dim3(64), dim3(64), 0, stream, (const float*)(ws + WS_LOGITS), a.in[I_RB] + layer * NEXP, (const int*)(ws + WS_TOKE), (const float*)(ws + WS_TOKW), dw, layer ? 12 : 7);
        if (p >= 1 && q == 10 && layer == 0) hipLaunchKernelGGL(dbg_moe<false>, dim3(32), dim3(256), 0, stream, a, 0, (const int*)(ws + WS_TOKE), (const float*)(ws + WS_TOKW), (const bf16_t*)(ws + WS_H1), (const bf16_t*)(ws + WS_H2), (const float*)d_out, dw, 8);
        if (p >= 1 && q == 10 && layer == 1) { hipLaunchKernelGGL(dbg_moe<true>, dim3(32), dim3(256), 0, stream, a, 1, (const int*)(ws + WS_TOKE), (const float*)(ws + WS_TOKW), (const bf16_t*)(ws + WS_H1), (const bf16_t*)(ws + WS_H2), (const float*)d_out, dw, 13);
            hipLaunchKernelGGL(dbg_fill, dim3(1024), dim3(256), 0, stream, (float*)d_out, dw); }
#endif
    }
#endif
}
```

```cpp
#include <hip/hip_runtime.h>
#include <cstdio>
#include <cstdint>

#ifndef MK_ONE_LAUNCH
#define MK_ONE_LAUNCH 1
#endif

#define LAS __attribute__((address_space(3)))
typedef unsigned short bf16_t;
typedef short bf16x8 __attribute__((ext_vector_type(8)));
typedef float f32x4 __attribute__((ext_vector_type(4)));
typedef unsigned u32x4 __attribute__((ext_vector_type(4)));
typedef unsigned u32x2 __attribute__((ext_vector_type(2)));

constexpr int NTOK = 32768, SEQ = 16384, DM = 1024;
constexpr int ABW = 3840;
constexpr int CWID = 3072;
constexpr int NEXP = 256, NE1 = 257, TOPK = 8, NSLOT = 9;
constexpr float ALPHA = 1.41421356237f;
constexpr int NWG = 256;
constexpr int PRMAX = 262144 + 65536 + 32768;

constexpr size_t MiB = 1u << 20;
constexpr size_t WS_CTL = 0, CTL_BYTES = 1 * MiB;
constexpr size_t WS_MISC = 1 * MiB;
constexpr size_t WS_WAB = 2 * MiB, WS_WOAB = 10 * MiB, WS_WC = 12 * MiB, WS_WOC = 18 * MiB, WS_WR = 20 * MiB;
constexpr size_t WS_TOKE = 22 * MiB, WS_TOKP = 23 * MiB, WS_TOKW = 24 * MiB;
constexpr size_t WS_STOK = 26 * MiB, WS_POSY = 28 * MiB;
constexpr size_t WS_GATES = 32 * MiB;
constexpr size_t WS_UST = 34 * MiB, WS_GSUM = 54 * MiB;
constexpr size_t WS_LOGITS = 56 * MiB;
constexpr size_t WS_HB = 96 * MiB, WS_PROJ = 160 * MiB, WS_YMIX = 400 * MiB, WS_Z = 464 * MiB, WS_H1 = 528 * MiB, WS_H2 = 592 * MiB;
constexpr size_t WS_ACT = 656 * MiB, WS_Y = 832 * MiB, WS_W1T = 1540 * MiB, WS_W2T = 2056 * MiB;
constexpr size_t WS_XQ = 2320 * MiB, WS_H1Q = 2352 * MiB, WS_H2Q = 2384 * MiB, WS_END = 2416 * MiB;
constexpr float Q_SA = 127.f / 5.5f, Q_SW = 127.f * 32.f / 5.5f, Q_DEQ = 1.f / (Q_SA * Q_SW);
constexpr float Q_SACT = 127.f / 8.f, Q_DEQ2 = 16.f / (Q_SACT * Q_SW);
constexpr int CW_BAR = 4096;
constexpr int CW_CNT = 16384;
constexpr int CW_DBG = 20480;

__device__ __forceinline__ unsigned pk2(float lo, float hi) { unsigned r; asm volatile("v_cvt_pk_bf16_f32 %0, %1, %2" : "=v"(r) : "v"(lo), "v"(hi)); return r; }
__device__ __forceinline__ float bflo(unsigned u) { return __uint_as_float(u << 16); }
__device__ __forceinline__ float bfhi(unsigned u) { return __uint_as_float(u & 0xffff0000u); }
__device__ __forceinline__ float bf2f(bf16_t b) { return __uint_as_float(((unsigned)b) << 16); }
__device__ __forceinline__ float sigm(float x) { return __builtin_amdgcn_rcpf(1.f + __expf(-x)); }
__device__ __forceinline__ float silu(float x) { return x * __builtin_amdgcn_rcpf(1.f + __expf(-x)); }
__device__ __forceinline__ int q8(float x, float sc) { return (int)rintf(fminf(fmaxf(x * sc, -127.f), 127.f)); }
__device__ __forceinline__ unsigned pk4(int a, int b, int c, int d) { return (unsigned)(a & 255) | ((unsigned)(b & 255) << 8) | ((unsigned)(c & 255) << 16) | ((unsigned)d << 24); }
__device__ __forceinline__ float logsig(float x) { return fminf(x, 0.f) - __logf(1.f + __expf(-fabsf(x))); }

#define XB_TMO      128
#define XB_XCNT(j)  (256  + 64 * (j))
#define XB_XSUB(j)  (1280 + 64 * (j))
#define XB_XGEN(j)  (2304 + 64 * (j))
#define XB_TOP      3328
#define XB_TOPGEN   3392
#define XCD_BAR_WORDS 3456
#define XB_SPIN_CAP (1u << 22)
__device__ __forceinline__ unsigned xb_ld(unsigned* p)              { return __hip_atomic_load(p, __ATOMIC_RELAXED, __HIP_MEMORY_SCOPE_AGENT); }
__device__ __forceinline__ unsigned xb_add(unsigned* p, unsigned v) { return __hip_atomic_fetch_add(p, v, __ATOMIC_RELAXED, __HIP_MEMORY_SCOPE_AGENT); }
__device__ __forceinline__ unsigned xb_xcc_id() { return (unsigned)__builtin_amdgcn_s_getreg((3 << 11) | 20) & 0xFu; }
#define XB_SPIN(cond, bar) do { unsigned _sp = 0; while (cond) { __builtin_amdgcn_s_sleep(1); \
    if ((++_sp & 255u) == 0u) { if (xb_ld(&(bar)[XB_TMO])) break; if (_sp > XB_SPIN_CAP) { atomicAdd(&(bar)[XB_TMO], 1u); break; } } } } while (0)
struct XcdBarrier { unsigned* bar; unsigned x; volatile LAS unsigned* st; };
__device__ __forceinline__ XcdBarrier xcd_barrier_post(unsigned* bar, volatile LAS unsigned* st) {
    XcdBarrier b; b.bar = bar; b.x = xb_xcc_id(); b.st = st;
    if (threadIdx.x == 0) (void)xb_add(&bar[XB_XCNT(b.x)], 1u);
    return b;
}
__device__ __forceinline__ void xcd_barrier_complete(unsigned* bar, unsigned x, unsigned& nloc, unsigned& nx) {
    const unsigned G = gridDim.x * gridDim.y * gridDim.z;
    unsigned sum, cnt, mine, sp = 0u;
    for (;;) {
        sum = 0u; cnt = 0u; mine = 0u;
#pragma unroll
        for (unsigned j = 0; j < 16; ++j) { const unsigned c = xb_ld(&bar[XB_XCNT(j)]); sum += c; cnt += (c > 0u) ? 1u : 0u; mine = (j == x) ? c : mine; }
        if (sum == G) break;
        __builtin_amdgcn_s_sleep(1);
        if ((++sp & 255u) == 0u) { if (xb_ld(&bar[XB_TMO])) break; if (sp > XB_SPIN_CAP) { atomicAdd(&bar[XB_TMO], 1u); break; } }
    }
    nloc = mine > 0u ? mine : 1u; nx = cnt > 0u ? cnt : 1u;
}
__device__ __forceinline__ void xcd_barrier(const XcdBarrier& b) {
    asm volatile("s_waitcnt vmcnt(0)" ::: "memory");
    __syncthreads();
    if (threadIdx.x == 0) {
        unsigned* bar = b.bar;
        __builtin_amdgcn_s_waitcnt(0);
        unsigned nloc = b.st[0], nx = b.st[1];
        if (nloc == 0u) { xcd_barrier_complete(bar, b.x, nloc, nx); b.st[0] = nloc; b.st[1] = nx; }
        const unsigned old = xb_add(&bar[XB_XSUB(b.x)], 1u);
        const unsigned gen = old / nloc;
        if (old + 1u == (gen + 1u) * nloc) {
            __builtin_amdgcn_fence(__ATOMIC_RELEASE, "agent");
            asm volatile("s_waitcnt vmcnt(0)" ::: "memory");
            const unsigned og = xb_add(&bar[XB_TOP], 1u);
            const unsigned tg = og / nx;
            if (og + 1u == (tg + 1u) * nx) xb_add(&bar[XB_TOPGEN], 1u);
            else XB_SPIN(xb_ld(&bar[XB_TOPGEN]) == tg, bar);
            __builtin_amdgcn_fence(__ATOMIC_ACQUIRE, "agent");
            xb_add(&bar[XB_XGEN(b.x)], 1u);
            asm volatile("s_waitcnt vmcnt(0)" ::: "memory");
        } else {
            XB_SPIN(xb_ld(&bar[XB_XGEN(b.x)]) == gen, bar);
            __builtin_amdgcn_fence(__ATOMIC_ACQUIRE, "agent");
            asm volatile("s_waitcnt vmcnt(0)" ::: "memory");
        }
    }
    __syncthreads();
}

namespace pg8 {
constexpr int BM = 256, BK = 64, HALF = 128, HTB = HALF * BK * 2, STAGE_BYTES = 8 * HTB, NXCD = 8, WGM = 8;
__device__ __forceinline__ int lds_byte(int r, int c) { const int st = (r >> 4) * 2 + (c >> 5), rr = r & 15, cc = c & 31, ob = rr * 64 + cc * 2; return st * 1024 + (ob ^ (((ob >> 9) & 1) << 5)); }
__device__ __forceinline__ void stage_rc(int b, int& R, int& C) { const int st = b / 1024, sb = b % 1024, swz = sb ^ (((sb >> 9) & 1) << 5); R = (st >> 1) * 16 + swz / 64; C = (st & 1) * 32 + (swz % 64) / 2; }
__device__ __forceinline__ int perm32(int rho) { const int n = rho >> 4, i = rho & 15; return 8 * (i >> 2) + 4 * n + (i & 3); }
struct Unit { int pm, pn; };
struct Gemm { const bf16_t* A; const bf16_t* Bt; int K; };

struct StaticOrder {
    int nM, nN, nwg, G, c;
    __device__ void init(int M, int N, int G_, int c_) { nM = M / BM; nN = N / BM; nwg = nM * nN; G = G_; c = c_; }
    __device__ bool next(int i, Unit& u) const {
        const long L = (long)i * G + c; if (L >= nwg) return false;
        int wgid = (int)L; { const int q = nwg / NXCD, r = nwg % NXCD, xcd = wgid % NXCD, off = wgid / NXCD; wgid = (xcd < r ? xcd * (q + 1) : r * (q + 1) + (xcd - r) * q) + off; }
        const int nig = WGM * nN, gid = wgid / nig, fm = gid * WGM, gsz = (nM - fm) < WGM ? (nM - fm) : WGM;
        u.pm = fm + ((wgid % nig) % gsz); u.pn = (wgid % nig) / gsz; return true;
    }
};
struct MoeOrder {
    const LAS int* tab; int n;
    __device__ bool next(int i, Unit& u) const {
        if (i >= n) return false;
        u.pm = __builtin_amdgcn_readfirstlane(tab[2 * i]); u.pn = __builtin_amdgcn_readfirstlane(tab[2 * i + 1]); return true;
    }
};
constexpr int LDS_UT = 131072, LDS_IDX = 131072 + 512, MOE_MAXU = 15;
__device__ __forceinline__ int moe_prep(LAS unsigned char* lds, const int* __restrict__ tile_exp, int nunits, int sh, int G, int c, const int* __restrict__ rowidx) {
    const int tid = threadIdx.x;
    LAS int* tab = (LAS int*)(lds + LDS_UT);
    int n = 0; { const long rem = (long)nunits - c; n = rem > 0 ? (int)((rem + G - 1) / G) : 0; if (n > 32) n = 32; }
    if (tid < n) { const long L = (long)tid * G + c; const int rt = (int)(L >> sh), j = (int)L & ((1 << sh) - 1); tab[2 * tid] = rt; tab[2 * tid + 1] = (tile_exp[rt] << sh) + j; }
    __syncthreads();
    if (rowidx) { LAS int* idx = (LAS int*)(lds + LDS_IDX); const int nn = n < MOE_MAXU ? n : MOE_MAXU;
        for (int x = tid; x < nn * 256; x += 512) idx[x] = rowidx[tab[2 * (x >> 8)] * 256 + (x & 255)];
        __syncthreads(); }
    return n;
}

typedef int i32x4 __attribute__((ext_vector_type(4)));
template <class Epi, class Sched, bool GATHER, bool I8 = false>
__device__ __forceinline__ void gemm_phase(LAS unsigned char* lds, const Gemm g, const LAS int* rowidx, const Sched& S, const Epi& E) {
    const int tid = threadIdx.x, wid = __builtin_amdgcn_readfirstlane(tid >> 6), lane = tid & 63, wr = wid >> 2, wc = wid & 3, fr = lane & 15, fq = lane >> 4;
    const int K = g.K, nt = K / BK;
    unsigned voffB[2], cofs[2]; int Rr[2];
#pragma unroll
    for (int i = 0; i < 2; ++i) { int R, C; stage_rc(tid * 16 + i * 8192, R, C); const int Rb = Epi::PERM ? ((R & ~31) + perm32(R & 31)) : R;
        Rr[i] = R; cofs[i] = (unsigned)C * 2u; voffB[i] = (unsigned)(Rb * K + C) * 2u; }
    const unsigned rowb = (unsigned)K * 2u;
    const size_t kstep = (size_t)(BK * 2);
    const size_t hstep = (size_t)HALF * K * 2;
    const size_t tstep = 2 * hstep;
    const unsigned ldsw = (unsigned)wid * 1024u;
    const int aoff = lds_byte(wr * 64 + fr, fq * 8), boff = lds_byte(wc * 32 + fr, fq * 8);
    const char* Abase = (const char*)g.A;
#define PG8_SA(b, h) (((b) * 2 + (h)) * HTB)
#define PG8_SB(b, h) ((4 + (b) * 2 + (h)) * HTB)
#define PG8_STAGE(bufoff, gbase, voff) do { _Pragma("unroll") for (int _i = 0; _i < 2; ++_i) \
        __builtin_amdgcn_global_load_lds((const unsigned*)((const char*)(gbase) + (voff)[_i]), (LAS unsigned*)(lds + (bufoff) + ldsw + _i * 8192), 16, 0, 0); } while (0)
#define PG8_STAGEA(bufoff, kb, offs) do { _Pragma("unroll") for (int _i = 0; _i < 2; ++_i) \
        __builtin_amdgcn_global_load_lds((const unsigned*)(Abase + (size_t)((kb) + (offs)[_i])), (LAS unsigned*)(lds + (bufoff) + ldsw + _i * 8192), 16, 0, 0); } while (0)
#define PG8_ROWOFF(u, uo, O) do { _Pragma("unroll") for (int _h = 0; _h < 2; ++_h) _Pragma("unroll") for (int _i = 0; _i < 2; ++_i) { \
        int _row = (u).pm * BM + _h * HALF + Rr[_i]; if (GATHER) _row = rowidx[(uo) * 256 + _h * HALF + Rr[_i]]; (O)[_h][_i] = (unsigned)_row * rowb + cofs[_i]; } } while (0)
#define PG8_LDA(dst, b, h) do { _Pragma("unroll") for (int m = 0; m < 4; ++m) _Pragma("unroll") for (int k = 0; k < 2; ++k) dst[m][k] = *(const LAS bf16x8*)(lds + PG8_SA(b, h) + aoff + m * 2048 + k * 1024); } while (0)
#define PG8_LDB(dst, b, h) do { _Pragma("unroll") for (int n = 0; n < 2; ++n) _Pragma("unroll") for (int k = 0; k < 2; ++k) dst[n][k] = *(const LAS bf16x8*)(lds + PG8_SB(b, h) + boff + n * 2048 + k * 1024); } while (0)
#define PG8_MMA(ai, bj, At, Bt) do { __builtin_amdgcn_s_setprio(1); _Pragma("unroll") for (int m = 0; m < 4; ++m) _Pragma("unroll") for (int n = 0; n < 2; ++n) _Pragma("unroll") for (int k = 0; k < 2; ++k) \
        { if (I8) acc[ai][bj][m][n] = __builtin_bit_cast(f32x4, __builtin_amdgcn_mfma_i32_16x16x64_i8(__builtin_bit_cast(i32x4, Bt[n][k]), __builtin_bit_cast(i32x4, At[m][k]), __builtin_bit_cast(i32x4, acc[ai][bj][m][n]), 0, 0, 0)); \
          else acc[ai][bj][m][n] = __builtin_amdgcn_mfma_f32_16x16x32_bf16(Bt[n][k], At[m][k], acc[ai][bj][m][n], 0, 0, 0); } __builtin_amdgcn_s_setprio(0); } while (0)
#define PG8_WAIT_V(n) asm volatile("s_waitcnt vmcnt(" #n ")" ::: "memory")
#define PG8_WAIT_L(n) asm volatile("s_waitcnt lgkmcnt(" #n ")" ::: "memory")
#define PG8_BAR __builtin_amdgcn_s_barrier()
#define PG8_SCHED __builtin_amdgcn_sched_barrier(0)
    Unit cur, nxt; int ui = 0;
    if (!S.next(0, cur)) return;
    f32x4 acc[2][2][4][2];
#pragma unroll
    for (int a = 0; a < 2; ++a)
#pragma unroll
        for (int b = 0; b < 2; ++b)
#pragma unroll
            for (int m = 0; m < 4; ++m)
#pragma unroll
                for (int n = 0; n < 2; ++n) acc[a][b][m][n] = (f32x4){0.f, 0.f, 0.f, 0.f};
    bf16x8 At[4][2], B0[2][2], B1[2][2];
    unsigned cO[2][2], nO[2][2];
    PG8_ROWOFF(cur, 0, cO);
    const char* cB = (const char*)g.Bt + (size_t)cur.pn * tstep;
    PG8_STAGE(PG8_SB(0, 0), cB, voffB); PG8_STAGE(PG8_SB(0, 1), cB + hstep, voffB); PG8_STAGEA(PG8_SA(0, 0), 0u, cO[0]); PG8_STAGEA(PG8_SA(0, 1), 0u, cO[1]);
    if (wr == 1) PG8_BAR;
    PG8_WAIT_V(2); PG8_BAR;
    PG8_STAGE(PG8_SB(1, 0), cB + kstep, voffB); PG8_STAGEA(PG8_SA(1, 0), (unsigned)kstep, cO[0]); PG8_STAGE(PG8_SB(1, 1), cB + hstep + kstep, voffB);
    PG8_WAIT_V(6); PG8_BAR;
    for (;;) {
        const bool has_next = S.next(ui + 1, nxt);
        const char* nB = has_next ? (const char*)g.Bt + (size_t)nxt.pn * tstep : cB;
#pragma unroll
        for (int h = 0; h < 2; ++h)
#pragma unroll
            for (int i = 0; i < 2; ++i) nO[h][i] = cO[h][i];
#pragma unroll 1
        for (int t = 0; t < nt; t += 2) {
            const bool last = (t == nt - 2);
            if (last && has_next) PG8_ROWOFF(nxt, ui + 1, nO);
            const unsigned k1 = (unsigned)(t + 1) * (unsigned)kstep;
            const unsigned k2 = last ? 0u : (unsigned)(t + 2) * (unsigned)kstep, k3 = k2 + (unsigned)kstep;
            const char* b2 = last ? nB : cB + (size_t)(t + 2) * kstep; const char* b3 = b2 + kstep;
            unsigned o2[2][2];
#pragma unroll
            for (int h = 0; h < 2; ++h)
#pragma unroll
                for (int i = 0; i < 2; ++i) o2[h][i] = last ? nO[h][i] : cO[h][i];
            PG8_LDB(B0, 0, 0); PG8_LDB(B1, 0, 1); PG8_SCHED; PG8_LDA(At, 0, 0); PG8_STAGEA(PG8_SA(1, 1), k1, cO[1]);
            PG8_WAIT_V(8); PG8_WAIT_L(0); PG8_BAR; PG8_MMA(0, 0, At, B0); PG8_MMA(0, 1, At, B1); PG8_BAR; PG8_SCHED;
            PG8_LDA(At, 0, 1); PG8_STAGE(PG8_SB(0, 0), b2, voffB); PG8_STAGE(PG8_SB(0, 1), b2 + hstep, voffB); PG8_STAGEA(PG8_SA(0, 0), k2, o2[0]);
            PG8_WAIT_V(8); PG8_WAIT_L(0); PG8_BAR; PG8_MMA(1, 0, At, B0); PG8_MMA(1, 1, At, B1); PG8_BAR; PG8_SCHED;
            PG8_LDB(B0, 1, 0); PG8_LDB(B1, 1, 1); PG8_SCHED; PG8_LDA(At, 1, 0); PG8_STAGEA(PG8_SA(0, 1), k2, o2[1]);
            PG8_WAIT_V(8); PG8_WAIT_L(0); PG8_BAR; PG8_MMA(0, 0, At, B0); PG8_MMA(0, 1, At, B1); PG8_BAR; PG8_SCHED;
            PG8_LDA(At, 1, 1); PG8_STAGE(PG8_SB(1, 0), b3, voffB); PG8_STAGE(PG8_SB(1, 1), b3 + hstep, voffB); PG8_STAGEA(PG8_SA(1, 0), k3, o2[0]);
            PG8_WAIT_V(8); PG8_WAIT_L(0); PG8_BAR; PG8_MMA(1, 0, At, B0); PG8_MMA(1, 1, At, B1); PG8_BAR; PG8_SCHED;
        }
        if (wr == 0) PG8_BAR;
        E(acc, cur, wr, wc, fr, fq);
        if (!has_next) break;
#pragma unroll
        for (int a = 0; a < 2; ++a)
#pragma unroll
            for (int b = 0; b < 2; ++b)
#pragma unroll
                for (int m = 0; m < 4; ++m)
#pragma unroll
                    for (int n = 0; n < 2; ++n) acc[a][b][m][n] = (f32x4){0.f, 0.f, 0.f, 0.f};
        cur = nxt; cB = nB; ++ui;
#pragma unroll
        for (int h = 0; h < 2; ++h)
#pragma unroll
            for (int i = 0; i < 2; ++i) cO[h][i] = nO[h][i];
        if (wr == 1) PG8_BAR;
    }
    PG8_WAIT_V(0);
    PG8_BAR;
#undef PG8_SA
#undef PG8_SB
#undef PG8_STAGE
#undef PG8_STAGEA
#undef PG8_ROWOFF
#undef PG8_LDA
#undef PG8_LDB
#undef PG8_MMA
#undef PG8_WAIT_V
#undef PG8_WAIT_L
#undef PG8_BAR
#undef PG8_SCHED
}

template <bool I8> struct EpiStoreBf16 {
    static constexpr bool PERM = true;
    bf16_t* O; int ldc;
    static __device__ __forceinline__ f32x4 dq(f32x4 v) { if (I8) { const i32x4 q = __builtin_bit_cast(i32x4, v); return (f32x4){(float)q[0] * Q_DEQ, (float)q[1] * Q_DEQ, (float)q[2] * Q_DEQ, (float)q[3] * Q_DEQ}; } return v; }
    __device__ __forceinline__ void operator()(const f32x4 (&acc)[2][2][4][2], const Unit& u, int wr, int wc, int fr, int fq) const {
        const int row0 = u.pm * BM + wr * 64 + fr, col0 = u.pn * BM + wc * 32 + 8 * fq;
#pragma unroll
        for (int ai = 0; ai < 2; ++ai)
#pragma unroll
            for (int m = 0; m < 4; ++m) { bf16_t* rowp = O + (size_t)(row0 + ai * HALF + m * 16) * ldc + col0;
#pragma unroll
                for (int bj = 0; bj < 2; ++bj) { const f32x4 v0 = dq(acc[ai][bj][m][0]), v1 = dq(acc[ai][bj][m][1]);
                    u32x4 w; w.x = pk2(v0[0], v0[1]); w.y = pk2(v0[2], v0[3]); w.z = pk2(v1[0], v1[1]); w.w = pk2(v1[2], v1[3]);
                    *(u32x4*)(rowp + bj * HALF) = w; } }
    }
};
struct EpiResid {
    static constexpr bool PERM = true;
    bf16_t* Z; const bf16_t* H;
    __device__ __forceinline__ void operator()(const f32x4 (&acc)[2][2][4][2], const Unit& u, int wr, int wc, int fr, int fq) const {
        const int row0 = u.pm * BM + wr * 64 + fr, col0 = u.pn * BM + wc * 32 + 8 * fq;
#pragma unroll
        for (int ai = 0; ai < 2; ++ai)
#pragma unroll
            for (int m = 0; m < 4; ++m) { const size_t ro = (size_t)(row0 + ai * HALF + m * 16) * DM + col0;
#pragma unroll
                for (int bj = 0; bj < 2; ++bj) { const f32x4 v0 = acc[ai][bj][m][0], v1 = acc[ai][bj][m][1];
                    const u32x4 hh = *(const u32x4*)(H + ro + bj * HALF);
                    u32x4 w;
                    w.x = pk2(ALPHA * bflo(hh.x) + v0[0], ALPHA * bfhi(hh.x) + v0[1]); w.y = pk2(ALPHA * bflo(hh.y) + v0[2], ALPHA * bfhi(hh.y) + v0[3]);
                    w.z = pk2(ALPHA * bflo(hh.z) + v1[0], ALPHA * bfhi(hh.z) + v1[1]); w.w = pk2(ALPHA * bflo(hh.w) + v1[2], ALPHA * bfhi(hh.w) + v1[3]);
                    *(u32x4*)(Z + ro + bj * HALF) = w; } }
    }
};
struct EpiF32 {
    static constexpr bool PERM = false;
    float* C;
    __device__ __forceinline__ void operator()(const f32x4 (&acc)[2][2][4][2], const Unit& u, int wr, int wc, int fr, int fq) const {
        const int row0 = u.pm * BM + wr * 64 + fr, col0 = wc * 32 + 4 * fq;
#pragma unroll
        for (int ai = 0; ai < 2; ++ai)
#pragma unroll
            for (int m = 0; m < 4; ++m) { float* rowp = C + (size_t)(row0 + ai * HALF + m * 16) * 256 + col0;
#pragma unroll
                for (int bj = 0; bj < 2; ++bj)
#pragma unroll
                    for (int n = 0; n < 2; ++n) *(f32x4*)(rowp + bj * HALF + n * 16) = acc[ai][bj][m][n]; }
    }
};
template <bool I8> struct EpiSwiGLU {
    static constexpr bool PERM = true;
    unsigned char* ACT; LAS unsigned char* sbuf;
    static __device__ __forceinline__ f32x4 dq(f32x4 v) { if (I8) { const i32x4 q = __builtin_bit_cast(i32x4, v); return (f32x4){(float)q[0] * Q_DEQ, (float)q[1] * Q_DEQ, (float)q[2] * Q_DEQ, (float)q[3] * Q_DEQ}; } return v; }
    __device__ __forceinline__ void operator()(const f32x4 (&acc)[2][2][4][2], const Unit& u, int wr, int wc, int fr, int fq) const {
        const int tid = threadIdx.x, rrow = tid >> 3, rchunk = tid & 7;
        const int wrow = wr * 16 + fr;
        unsigned char* abase = ACT + (size_t)(u.pm * BM) * 256 + (u.pn & 1) * 128 + rchunk * 16;
#pragma unroll
        for (int st = 0; st < 8; ++st) {
            const int ai = st >> 2, m = st & 3;
            LAS unsigned char* buf = sbuf + (st & 1) * 4096;
            const f32x4 g0 = dq(acc[ai][0][m][0]), g1 = dq(acc[ai][0][m][1]), u0 = dq(acc[ai][1][m][0]), u1 = dq(acc[ai][1][m][1]);
            u32x2 w;
            w.x = pk4(q8(silu(g0[0]) * u0[0], Q_SACT), q8(silu(g0[1]) * u0[1], Q_SACT), q8(silu(g0[2]) * u0[2], Q_SACT), q8(silu(g0[3]) * u0[3], Q_SACT));
            w.y = pk4(q8(silu(g1[0]) * u1[0], Q_SACT), q8(silu(g1[1]) * u1[1], Q_SACT), q8(silu(g1[2]) * u1[2], Q_SACT), q8(silu(g1[3]) * u1[3], Q_SACT));
            const int c16 = wc * 2 + (fq >> 1);
            *(LAS u32x2*)(buf + wrow * 128 + ((c16 ^ (wrow & 7)) << 4) + (fq & 1) * 8) = w;
            asm volatile("s_waitcnt lgkmcnt(0)" ::: "memory"); __builtin_amdgcn_s_barrier(); asm volatile("" ::: "memory");
            if (tid < 256) {
                const u32x4 rv = *(const LAS u32x4*)(buf + rrow * 128 + ((rchunk ^ (rrow & 7)) << 4));
                const int grow = ai * HALF + (rrow >> 4) * 64 + m * 16 + (rrow & 15);
                *(u32x4*)(abase + (size_t)grow * 256) = rv;
            }
        }
        asm volatile("s_waitcnt lgkmcnt(0)" ::: "memory"); __builtin_amdgcn_s_barrier(); asm volatile("" ::: "memory");
    }
};
template <int EV = 0> struct EpiDownT {
    static constexpr bool PERM = true;
    unsigned char* Y; LAS unsigned char* sbuf;
    __device__ __forceinline__ void operator()(const f32x4 (&acc)[2][2][4][2], const Unit& u, int wr, int wc, int fr, int fq) const {
        const int tid = threadIdx.x, rrow = tid >> 4, rchunk = tid & 15;
        const int wrow = wr * 16 + fr;
        unsigned char* ybase = Y + (size_t)(u.pm * BM) * DM + (u.pn & 3) * 256 + rchunk * 16;
#pragma unroll
        for (int st = 0; st < 8; ++st) {
            const int ai = st >> 2, m = st & 3;
            LAS unsigned char* buf = sbuf + (st & 1) * 8192;
#pragma unroll
            for (int bj = 0; bj < 2; ++bj) { const i32x4 q0 = __builtin_bit_cast(i32x4, acc[ai][bj][m][0]), q1 = __builtin_bit_cast(i32x4, acc[ai][bj][m][1]);
                const f32x4 v0 = (f32x4){(float)q0[0] * Q_DEQ2, (float)q0[1] * Q_DEQ2, (float)q0[2] * Q_DEQ2, (float)q0[3] * Q_DEQ2}, v1 = (f32x4){(float)q1[0] * Q_DEQ2, (float)q1[1] * Q_DEQ2, (float)q1[2] * Q_DEQ2, (float)q1[3] * Q_DEQ2};
                int p0 = __builtin_amdgcn_cvt_pk_fp8_f32(v0[0], v0[1], 0, false); p0 = __builtin_amdgcn_cvt_pk_fp8_f32(v0[2], v0[3], p0, true);
                int p1 = __builtin_amdgcn_cvt_pk_fp8_f32(v1[0], v1[1], 0, false); p1 = __builtin_amdgcn_cvt_pk_fp8_f32(v1[2], v1[3], p1, true);
                u32x2 w; w.x = (unsigned)p0; w.y = (unsigned)p1;
                const int c16 = bj * 8 + wc * 2 + (fq >> 1);
                *(LAS u32x2*)(buf + wrow * 256 + ((c16 ^ (wrow & 15)) << 4) + (fq & 1) * 8) = w; }
            asm volatile("s_waitcnt lgkmcnt(0)" ::: "memory"); __builtin_amdgcn_s_barrier(); asm volatile("" ::: "memory");
            const u32x4 rv = *(const LAS u32x4*)(buf + rrow * 256 + ((rchunk ^ (rrow & 15)) << 4));
            const int grow = ai * HALF + (rrow >> 4) * 64 + m * 16 + (rrow & 15);
            if (EV == 1) { asm volatile("" :: "v"(rv.x), "v"(rv.y), "v"(rv.z), "v"(rv.w)); } else *(u32x4*)(ybase + (size_t)grow * DM) = rv;
        }
        asm volatile("s_waitcnt lgkmcnt(0)" ::: "memory"); __builtin_amdgcn_s_barrier(); asm volatile("" ::: "memory");
    }
};
typedef EpiDownT<0> EpiDown;
}

struct Args { const float* in[22]; float* out; unsigned char* ws; int ph_lo, ph_hi; };
enum { I_X = 0, I_WINAB, I_WGKUP, I_BGK, I_HG, I_GG, I_WOAB, I_LB, I_WINC, I_CONV, I_BIF, I_WOC, I_WR, I_RB, I_WEI, I_WED, I_WSI, I_WSD, I_LMG, I_LMB, I_LFG, I_LFB };

constexpr int LDS_MISC = 147200;
constexpr int LDS_BYTES = 147456;

__device__ __forceinline__ void cvt_tile(LAS unsigned char* lds, const float* __restrict__ src, size_t ldn, int k0, int n0, bf16_t* __restrict__ dst, int K, int drow0) {
    const int t = threadIdx.x;
    { const int c4 = (t & 15) * 4, r2 = t >> 4;
      const f32x4 a = *(const f32x4*)(src + (size_t)(k0 + 2 * r2) * ldn + n0 + c4);
      const f32x4 b = *(const f32x4*)(src + (size_t)(k0 + 2 * r2 + 1) * ldn + n0 + c4);
#pragma unroll
      for (int i = 0; i < 4; ++i) *(LAS unsigned*)(lds + ((c4 + i) * 72 + 2 * r2) * 2) = pk2(a[i], b[i]); }
    __syncthreads();
    { const int kk = (t & 7) * 8, n = t >> 3;
      const u32x4 v = *(const LAS u32x4*)(lds + (n * 72 + kk) * 2);
      *(u32x4*)(dst + (size_t)(drow0 + n) * K + k0 + kk) = v; }
    __syncthreads();
}
template <int NT>
__device__ __forceinline__ void cvt_multi(LAS unsigned char* lds, const float* __restrict__ src, size_t ldn, int k0, int n0, bf16_t* __restrict__ dst, int K, const int (&drow)[NT], float sc = 1.f) {
    const int t = threadIdx.x;
    { const int c4 = (t & 15) * 4, r2 = t >> 4;
      f32x4 a[NT], b[NT];
#pragma unroll
      for (int q = 0; q < NT; ++q) { a[q] = __builtin_nontemporal_load((const f32x4*)(src + (size_t)(k0 + 2 * r2) * ldn + n0 + 64 * q + c4)); b[q] = __builtin_nontemporal_load((const f32x4*)(src + (size_t)(k0 + 2 * r2 + 1) * ldn + n0 + 64 * q + c4)); }
#pragma unroll
      for (int q = 0; q < NT; ++q)
#pragma unroll
          for (int i = 0; i < 4; ++i) *(LAS unsigned*)(lds + q * 9216 + ((c4 + i) * 72 + 2 * r2) * 2) = pk2(a[q][i] * sc, b[q][i] * sc); }
    __syncthreads();
    { const int kk = (t & 7) * 8, n = t >> 3;
#pragma unroll
      for (int q = 0; q < NT; ++q) { const u32x4 v = *(const LAS u32x4*)(lds + q * 9216 + (n * 72 + kk) * 2); *(u32x4*)(dst + (size_t)(drow[q] + n) * K + k0 + kk) = v; } }
    __syncthreads();
}
template <int NT>
__device__ __forceinline__ void cvt8_multi(LAS unsigned char* lds, const float* __restrict__ src, size_t ldn, int k0, int n0, unsigned char* __restrict__ dst, int Kb, const int (&drow)[NT], float sc) {
    const int t = threadIdx.x;
    { const int c4 = (t & 15) * 4, r4 = t >> 4;
      f32x4 a[NT][4];
#pragma unroll
      for (int q = 0; q < NT; ++q)
#pragma unroll
          for (int j = 0; j < 4; ++j) a[q][j] = __builtin_nontemporal_load((const f32x4*)(src + (size_t)(k0 + 4 * r4 + j) * ldn + n0 + 64 * q + c4));
#pragma unroll
      for (int q = 0; q < NT; ++q)
#pragma unroll
          for (int i = 0; i < 4; ++i) *(LAS unsigned*)(lds + q * 9216 + (c4 + i) * 144 + 4 * r4) = pk4(q8(a[q][0][i], sc), q8(a[q][1][i], sc), q8(a[q][2][i], sc), q8(a[q][3][i], sc)); }
    __syncthreads();
    { const int kk = (t & 7) * 16, n = t >> 3;
#pragma unroll
      for (int q = 0; q < NT; ++q) { const u32x4 v = *(const LAS u32x4*)(lds + q * 9216 + n * 144 + kk); *(u32x4*)(dst + (size_t)(drow[q] + n) * Kb + k0 + kk) = v; } }
    __syncthreads();
}
template <int NT>
__device__ __forceinline__ void cvt8_matrix(LAS unsigned char* lds, const float* src, size_t ldn, int K, int n_lo, int ncols, unsigned char* dst, int drow_lo, float sc, int bid, int nb) {
    const int tk = K / 128, tn = ncols / (64 * NT);
    for (int j = bid; j < tk * tn; j += nb) { const int a = j / tn, b = j % tn; int dr[NT];
#pragma unroll
        for (int q = 0; q < NT; ++q) dr[q] = drow_lo + (b * NT + q) * 64;
        cvt8_multi<NT>(lds, src, ldn, a * 128, n_lo + b * 64 * NT, dst, K, dr, sc); }
}
template <int NT>
__device__ __forceinline__ void cvt_matrix(LAS unsigned char* lds, const float* src, size_t ldn, int K, int n_lo, int ncols, bf16_t* dst, int drow_lo, int bid, int nb) {
    const int tk = K / 64, tn = ncols / (64 * NT);
    for (int j = bid; j < tk * tn; j += nb) { const int a = j / tn, b = j % tn; int dr[NT];
#pragma unroll
        for (int q = 0; q < NT; ++q) dr[q] = drow_lo + (b * NT + q) * 64;
        cvt_multi<NT>(lds, src, ldn, a * 64, n_lo + b * 64 * NT, dst, K, dr); }
}
__device__ __forceinline__ void phase_prologue(LAS unsigned char* lds, const Args& A, int bid, int nb) {
    unsigned char* ws = A.ws; const int tid = threadIdx.x;
    if (bid == 0) {
        float* lb0 = (float*)(ws + WS_MISC);
        const float* l = A.in[I_LB];
        if (tid < 512) { const float a = l[tid], b = l[512 + tid], c = l[1024 + tid]; const float m = fmaxf(a, fmaxf(b, c));
            const float ea = __expf(a - m), eb = __expf(b - m), ec = __expf(c - m); lb0[tid] = ea / (ea + eb + ec); }
    }
    if (bid == 1 % nb) {
        float* wg = (float*)(ws + WS_MISC + 4096);
        for (int i = tid; i < 8 * 1024; i += 512) { const int g = i >> 10, k = i & 1023; wg[i] = A.in[I_WINC][(size_t)k * 3080 + 3072 + g]; }
    }
    { const float* x = A.in[I_X]; bf16_t* hb = (bf16_t*)(ws + WS_HB); unsigned char* xq = ws + WS_XQ;
      for (size_t i = ((size_t)bid * 512 + tid) * 8; i < (size_t)NTOK * DM; i += (size_t)nb * 512 * 8) {
          const f32x4 a = *(const f32x4*)(x + i), b = *(const f32x4*)(x + i + 4);
          u32x4 w; w.x = pk2(a[0], a[1]); w.y = pk2(a[2], a[3]); w.z = pk2(b[0], b[1]); w.w = pk2(b[2], b[3]);
          *(u32x4*)(hb + i) = w;
          u32x2 qv; qv.x = pk4(q8(a[0], Q_SA), q8(a[1], Q_SA), q8(a[2], Q_SA), q8(a[3], Q_SA)); qv.y = pk4(q8(b[0], Q_SA), q8(b[1], Q_SA), q8(b[2], Q_SA), q8(b[3], Q_SA));
          *(u32x2*)(xq + i) = qv; } }
    { unsigned char* wab = ws + WS_WAB; const float* win = A.in[I_WINAB]; const float* wup = A.in[I_WGKUP];
      for (int o = bid * 512 + tid; o < 256 * 64; o += nb * 512) { const int j = o >> 6, k16 = (o & 63) * 16;
          float up[16];
#pragma unroll
          for (int r = 0; r < 16; ++r) up[r] = wup[r * 256 + j];
          int res[16];
#pragma unroll
          for (int q = 0; q < 16; ++q) { const float* wr_ = win + (size_t)(k16 + q) * 3600 + 3584; float sm = 0.f;
#pragma unroll
              for (int r = 0; r < 16; ++r) sm += wr_[r] * up[r];
              res[q] = q8(sm, Q_SW); }
          u32x4 w; w.x = pk4(res[0], res[1], res[2], res[3]); w.y = pk4(res[4], res[5], res[6], res[7]); w.z = pk4(res[8], res[9], res[10], res[11]); w.w = pk4(res[12], res[13], res[14], res[15]);
          *(u32x4*)(wab + (size_t)(3584 + j) * 1024 + k16) = w; } }
    cvt8_matrix<4>(lds, A.in[I_WINAB], 3600, 1024, 0, 3584, ws + WS_WAB, 0, Q_SW, bid, nb);
    cvt_matrix<8>(lds, A.in[I_WOAB], 1024, 1024, 0, 1024, (bf16_t*)(ws + WS_WOAB), 0, bid, nb);
    cvt8_matrix<4>(lds, A.in[I_WINC], 3080, 1024, 0, 3072, ws + WS_WC, 0, Q_SW, bid, nb);
    cvt_matrix<8>(lds, A.in[I_WOC], 1024, 1024, 0, 1024, (bf16_t*)(ws + WS_WOC), 0, bid, nb);
    cvt_matrix<4>(lds, A.in[I_WR], 256, 1024, 0, 256, (bf16_t*)(ws + WS_WR), 0, bid, nb);
    cvt_matrix<4>(lds, A.in[I_WR] + 1024 * 256, 256, 1024, 0, 256, (bf16_t*)(ws + WS_WR) + 256 * 1024, 0, bid, nb);
    for (int j = bid; j < 2 * NE1 * 24; j += nb) {
        const int le = j / 24, t = j % 24, layer = le / NE1, e = le % NE1;
        if (t < 16) {
            const float* src = (e < NEXP) ? A.in[I_WEI] + ((size_t)(layer * NEXP + e)) * 1024 * 512 : A.in[I_WSI] + (size_t)layer * 1024 * 512;
            unsigned char* dst = ws + WS_W1T + ((size_t)(layer * NE1 + e)) * 512 * 1024;
            const int tk = t >> 1, gq = t & 1;
            int dr[4];
#pragma unroll
            for (int q = 0; q < 4; ++q) { const int nn = q * 64; dr[q] = (nn >> 7) * 256 + gq * 128 + (nn & 127); }
            cvt8_multi<4>(lds, src, 512, tk * 128, gq * 256, dst, 1024, dr, Q_SW);
        } else {
            const int t2 = t - 16, tk = t2 >> 2, g4 = t2 & 3;
            const float* src = (e < NEXP) ? A.in[I_WED] + ((size_t)(layer * NEXP + e)) * 256 * 1024 : A.in[I_WSD] + (size_t)layer * 256 * 1024;
            unsigned char* dst = ws + WS_W2T + ((size_t)(layer * NE1 + e)) * 1024 * 256;
            int dr[4];
#pragma unroll
            for (int q = 0; q < 4; ++q) dr[q] = g4 * 256 + q * 64;
            cvt8_multi<4>(lds, src, 1024, tk * 128, g4 * 256, dst, 256, dr, Q_SW);
        }
    }
}

__device__ __forceinline__ void phase_ln(const bf16_t* __restrict__ Z, bf16_t* __restrict__ H, unsigned char* __restrict__ HQ, const float* __restrict__ g, const float* __restrict__ b, int bid, int nb) {
    const int lane = threadIdx.x & 63, gw = bid * 8 + (threadIdx.x >> 6), nw = nb * 8;
    float gg[16], bb[16];
#pragma unroll
    for (int i = 0; i < 8; ++i) { gg[i] = g[lane * 8 + i]; gg[8 + i] = g[512 + lane * 8 + i]; bb[i] = b[lane * 8 + i]; bb[8 + i] = b[512 + lane * 8 + i]; }
    for (int row = gw; row < NTOK; row += nw) {
        const u32x4 a = *(const u32x4*)(Z + (size_t)row * DM + lane * 8), c = *(const u32x4*)(Z + (size_t)row * DM + 512 + lane * 8);
        float v[16];
        v[0] = bflo(a.x); v[1] = bfhi(a.x); v[2] = bflo(a.y); v[3] = bfhi(a.y); v[4] = bflo(a.z); v[5] = bfhi(a.z); v[6] = bflo(a.w); v[7] = bfhi(a.w);
        v[8] = bflo(c.x); v[9] = bfhi(c.x); v[10] = bflo(c.y); v[11] = bfhi(c.y); v[12] = bflo(c.z); v[13] = bfhi(c.z); v[14] = bflo(c.w); v[15] = bfhi(c.w);
        float s = 0.f;
#pragma unroll
        for (int i = 0; i < 16; ++i) s += v[i];
#pragma unroll
        for (int o = 32; o > 0; o >>= 1) s += __shfl_xor(s, o);
        const float mu = s * (1.f / 1024.f);
        float q = 0.f;
#pragma unroll
        for (int i = 0; i < 16; ++i) { const float d = v[i] - mu; q += d * d; }
#pragma unroll
        for (int o = 32; o > 0; o >>= 1) q += __shfl_xor(q, o);
        const float rs = rsqrtf(q * (1.f / 1024.f) + 1e-5f);
        float y[16];
#pragma unroll
        for (int i = 0; i < 16; ++i) y[i] = (v[i] - mu) * rs * gg[i] + bb[i];
        u32x4 w0, w1; w0.x = pk2(y[0], y[1]); w0.y = pk2(y[2], y[3]); w0.z = pk2(y[4], y[5]); w0.w = pk2(y[6], y[7]);
        w1.x = pk2(y[8], y[9]); w1.y = pk2(y[10], y[11]); w1.z = pk2(y[12], y[13]); w1.w = pk2(y[14], y[15]);
        *(u32x4*)(H + (size_t)row * DM + lane * 8) = w0; *(u32x4*)(H + (size_t)row * DM + 512 + lane * 8) = w1;
        u32x2 q0, q1;
        q0.x = pk4(q8(y[0], Q_SA), q8(y[1], Q_SA), q8(y[2], Q_SA), q8(y[3], Q_SA)); q0.y = pk4(q8(y[4], Q_SA), q8(y[5], Q_SA), q8(y[6], Q_SA), q8(y[7], Q_SA));
        q1.x = pk4(q8(y[8], Q_SA), q8(y[9], Q_SA), q8(y[10], Q_SA), q8(y[11], Q_SA)); q1.y = pk4(q8(y[12], Q_SA), q8(y[13], Q_SA), q8(y[14], Q_SA), q8(y[15], Q_SA));
        *(u32x2*)(HQ + (size_t)row * DM + lane * 8) = q0; *(u32x2*)(HQ + (size_t)row * DM + 512 + lane * 8) = q1;
    }
}

template <bool FINAL>
__device__ __forceinline__ void phase_combine(const unsigned char* __restrict__ Y, const int* __restrict__ posy, const float* __restrict__ tokw, const int* __restrict__ ntiles,
                                              const bf16_t* __restrict__ H1, bf16_t* __restrict__ H2, unsigned char* __restrict__ H2Q, float* __restrict__ OUT, float* __restrict__ GATES,
                                              const float* __restrict__ wgate, const float* __restrict__ g, const float* __restrict__ b, int bid, int nb) {
    const int shbase = (*ntiles - NTOK / 256) * 256;
    const int lane = threadIdx.x & 63, gw = bid * 8 + (threadIdx.x >> 6), nw = nb * 8;
    int npos = 0; float nwk = 0.f;
    if (gw < NTOK) { npos = (lane < 8) ? posy[(size_t)gw * 8 + lane] : shbase + gw; nwk = (lane < 8) ? tokw[(size_t)gw * 8 + lane] : 1.0f; }
    for (int row = gw; row < NTOK; row += nw) {
        const int cpos = npos; const float cwk = nwk;
        { const int nr = row + nw; if (nr < NTOK) { npos = (lane < 8) ? posy[(size_t)nr * 8 + lane] : shbase + nr; nwk = (lane < 8) ? tokw[(size_t)nr * 8 + lane] : 1.0f; } }
        float v[16];
        { const u32x4 a = *(const u32x4*)(H1 + (size_t)row * DM + lane * 8), c = *(const u32x4*)(H1 + (size_t)row * DM + 512 + lane * 8);
          v[0] = bflo(a.x); v[1] = bfhi(a.x); v[2] = bflo(a.y); v[3] = bfhi(a.y); v[4] = bflo(a.z); v[5] = bfhi(a.z); v[6] = bflo(a.w); v[7] = bfhi(a.w);
          v[8] = bflo(c.x); v[9] = bfhi(c.x); v[10] = bflo(c.y); v[11] = bfhi(c.y); v[12] = bflo(c.z); v[13] = bfhi(c.z); v[14] = bflo(c.w); v[15] = bfhi(c.w); }
#pragma unroll
        for (int i = 0; i < 16; ++i) v[i] *= ALPHA;
        u32x2 ya[NSLOT], yc[NSLOT]; float wks[NSLOT];
#pragma unroll
        for (int k = 0; k < NSLOT; ++k) {
            const int pos = __builtin_amdgcn_readlane(cpos, k); wks[k] = __uint_as_float(__builtin_amdgcn_readlane(__float_as_uint(cwk), k)) * 0.0625f;
            const unsigned char* yr = Y + (size_t)pos * DM;
            ya[k] = *(const u32x2*)(yr + lane * 8); yc[k] = *(const u32x2*)(yr + 512 + lane * 8);
        }
        typedef float f32x2_ __attribute__((ext_vector_type(2)));
#pragma unroll
        for (int k = 0; k < NSLOT; ++k) {
            const float wk = wks[k];
            const f32x2_ a0 = __builtin_amdgcn_cvt_pk_f32_fp8((int)ya[k].x, false), a1 = __builtin_amdgcn_cvt_pk_f32_fp8((int)ya[k].x, true), a2 = __builtin_amdgcn_cvt_pk_f32_fp8((int)ya[k].y, false), a3 = __builtin_amdgcn_cvt_pk_f32_fp8((int)ya[k].y, true);
            const f32x2_ c0 = __builtin_amdgcn_cvt_pk_f32_fp8((int)yc[k].x, false), c1 = __builtin_amdgcn_cvt_pk_f32_fp8((int)yc[k].x, true), c2 = __builtin_amdgcn_cvt_pk_f32_fp8((int)yc[k].y, false), c3 = __builtin_amdgcn_cvt_pk_f32_fp8((int)yc[k].y, true);
            v[0] += wk * a0.x; v[1] += wk * a0.y; v[2] += wk * a1.x; v[3] += wk * a1.y; v[4] += wk * a2.x; v[5] += wk * a2.y; v[6] += wk * a3.x; v[7] += wk * a3.y;
            v[8] += wk * c0.x; v[9] += wk * c0.y; v[10] += wk * c1.x; v[11] += wk * c1.y; v[12] += wk * c2.x; v[13] += wk * c2.y; v[14] += wk * c3.x; v[15] += wk * c3.y;
        }
        float s = 0.f;
#pragma unroll
        for (int i = 0; i < 16; ++i) s += v[i];
#pragma unroll
        for (int o = 32; o > 0; o >>= 1) s += __shfl_xor(s, o);
        const float mu = s * (1.f / 1024.f);
        float q = 0.f;
#pragma unroll
        for (int i = 0; i < 16; ++i) { const float d = v[i] - mu; q += d * d; }
#pragma unroll
        for (int o = 32; o > 0; o >>= 1) q += __shfl_xor(q, o);
        const float rs = rsqrtf(q * (1.f / 1024.f) + 1e-5f);
        float y[16];
#pragma unroll
        for (int i = 0; i < 8; ++i) { y[i] = (v[i] - mu) * rs * g[lane * 8 + i] + b[lane * 8 + i]; y[8 + i] = (v[8 + i] - mu) * rs * g[512 + lane * 8 + i] + b[512 + lane * 8 + i]; }
        if (FINAL) {
            float* o = OUT + (size_t)row * DM;
            *(f32x4*)(o + lane * 8) = (f32x4){y[0], y[1], y[2], y[3]}; *(f32x4*)(o + lane * 8 + 4) = (f32x4){y[4], y[5], y[6], y[7]};
            *(f32x4*)(o + 512 + lane * 8) = (f32x4){y[8], y[9], y[10], y[11]}; *(f32x4*)(o + 512 + lane * 8 + 4) = (f32x4){y[12], y[13], y[14], y[15]};
        } else {
            u32x4 w0, w1; w0.x = pk2(y[0], y[1]); w0.y = pk2(y[2], y[3]); w0.z = pk2(y[4], y[5]); w0.w = pk2(y[6], y[7]);
            w1.x = pk2(y[8], y[9]); w1.y = pk2(y[10], y[11]); w1.z = pk2(y[12], y[13]); w1.w = pk2(y[14], y[15]);
            *(u32x4*)(H2 + (size_t)row * DM + lane * 8) = w0; *(u32x4*)(H2 + (size_t)row * DM + 512 + lane * 8) = w1;
            { u32x2 q0, q1;
              q0.x = pk4(q8(y[0], Q_SA), q8(y[1], Q_SA), q8(y[2], Q_SA), q8(y[3], Q_SA)); q0.y = pk4(q8(y[4], Q_SA), q8(y[5], Q_SA), q8(y[6], Q_SA), q8(y[7], Q_SA));
              q1.x = pk4(q8(y[8], Q_SA), q8(y[9], Q_SA), q8(y[10], Q_SA), q8(y[11], Q_SA)); q1.y = pk4(q8(y[12], Q_SA), q8(y[13], Q_SA), q8(y[14], Q_SA), q8(y[15], Q_SA));
              *(u32x2*)(H2Q + (size_t)row * DM + lane * 8) = q0; *(u32x2*)(H2Q + (size_t)row * DM + 512 + lane * 8) = q1; }
            float yr[16];
            yr[0] = bflo(w0.x); yr[1] = bfhi(w0.x); yr[2] = bflo(w0.y); yr[3] = bfhi(w0.y); yr[4] = bflo(w0.z); yr[5] = bfhi(w0.z); yr[6] = bflo(w0.w); yr[7] = bfhi(w0.w);
            yr[8] = bflo(w1.x); yr[9] = bfhi(w1.x); yr[10] = bflo(w1.y); yr[11] = bfhi(w1.y); yr[12] = bflo(w1.z); yr[13] = bfhi(w1.z); yr[14] = bflo(w1.w); yr[15] = bfhi(w1.w);
            float gsum = 0.f;
#pragma unroll
            for (int gi = 0; gi < 8; ++gi) {
                const float* wp = wgate + gi * 1024; float d = 0.f;
#pragma unroll
                for (int i = 0; i < 8; ++i) d += yr[i] * wp[lane * 8 + i] + yr[8 + i] * wp[512 + lane * 8 + i];
#pragma unroll
                for (int o = 32; o > 0; o >>= 1) d += __shfl_xor(d, o);
                gsum = (lane == gi) ? d : gsum;
            }
            if (lane < 8) GATES[(size_t)row * 8 + lane] = gsum;
        }
    }
}

template <bool DRY>
__device__ __forceinline__ void phase_select(LAS unsigned char* lds, const float* __restrict__ logits, const float* __restrict__ rbias, int* __restrict__ tok_e, int* __restrict__ tok_p,
                                             float* __restrict__ tok_w, unsigned* __restrict__ cnt, int bid, int nb) {
    const int tid = threadIdx.x, it = tid & 63, g8 = tid >> 6;
    LAS unsigned* hist = (LAS unsigned*)lds;
    LAS unsigned* base = hist + 256;
    LAS int* selE = (LAS int*)(base + 256);
    LAS int* selR = selE + 1024;
    LAS float* gsl = (LAS float*)(lds + 10240);
    LAS float* lv = (LAS float*)(lds + 12288);
    LAS int* le = (LAS int*)(lds + 28672);
    LAS float* sb = (LAS float*)(lds + 45056);
    const int tpw = NTOK / nb;
    const int t0 = bid * tpw;
    const float NEG = -3.0e38f;
    if (tid < 256) hist[tid] = 0u;
    __syncthreads();
    for (int half = 0; half < tpw / 64; ++half) {
        const int tb = t0 + half * 64;
        for (int i = tid; i < 64 * 256; i += 512) { const int tk = i >> 8, e = i & 255; sb[e * 65 + tk] = sigm(logits[(size_t)(tb + tk) * 256 + e]) + rbias[e]; }
        __syncthreads();
        {
            float m1 = NEG, m2 = NEG;
            for (int j = 0; j < 32; ++j) { const float v = sb[(g8 * 32 + j) * 65 + it]; if (v > m1) { m2 = m1; m1 = v; } else if (v > m2) m2 = v; }
            gsl[g8 * 64 + it] = m1 + m2;
        }
        __syncthreads();
        float G[8];
#pragma unroll
        for (int q = 0; q < 8; ++q) G[q] = gsl[q * 64 + it];
        unsigned selmask = 0u;
#pragma unroll
        for (int g = 0; g < 8; ++g) { int rank = 0;
#pragma unroll
            for (int q = 0; q < 8; ++q) rank += (G[q] > G[g] || (G[q] == G[g] && q < g)) ? 1 : 0;
            if (rank < 4) selmask |= 1u << g; }
        if ((selmask >> g8) & 1u) {
            float tv[8]; int te[8];
#pragma unroll
            for (int k = 0; k < 8; ++k) { tv[k] = NEG; te[k] = 0; }
            for (int j = 0; j < 32; ++j) {
                float v = sb[(g8 * 32 + j) * 65 + it]; int ve = g8 * 32 + j;
                if (v > tv[7]) {
#pragma unroll
                    for (int k = 0; k < 8; ++k) { if (v > tv[k]) { const float tf = tv[k]; const int ti = te[k]; tv[k] = v; te[k] = ve; v = tf; ve = ti; } }
                }
            }
#pragma unroll
            for (int k = 0; k < 8; ++k) { lv[(g8 * 8 + k) * 64 + it] = tv[k]; le[(g8 * 8 + k) * 64 + it] = te[k]; }
        }
        __syncthreads();
        if (tid < 64) {
            int gid[4]; { int n = 0;
#pragma unroll
                for (int g = 0; g < 8; ++g) if ((selmask >> g) & 1u) { if (n == 0) gid[0] = g; else if (n == 1) gid[1] = g; else if (n == 2) gid[2] = g; else gid[3] = g; ++n; } }
            float hv[4]; int hp[4];
#pragma unroll
            for (int j = 0; j < 4; ++j) { hp[j] = 0; hv[j] = lv[(gid[j] * 8) * 64 + it]; }
            float sc8[8]; int te[8]; float tot = 0.f;
#pragma unroll
            for (int k = 0; k < 8; ++k) {
                int bj = 0; float bv = hv[0];
                if (hv[1] > bv) { bv = hv[1]; bj = 1; }
                if (hv[2] > bv) { bv = hv[2]; bj = 2; }
                if (hv[3] > bv) { bv = hv[3]; bj = 3; }
                const int gsel = (bj == 0) ? gid[0] : (bj == 1) ? gid[1] : (bj == 2) ? gid[2] : gid[3];
                const int psel = (bj == 0) ? hp[0] : (bj == 1) ? hp[1] : (bj == 2) ? hp[2] : hp[3];
                const int e = le[(gsel * 8 + psel) * 64 + it];
                te[k] = e; sc8[k] = bv - rbias[e]; tot += sc8[k];
                const float nv = (psel < 7) ? lv[(gsel * 8 + psel + 1) * 64 + it] : NEG;
                if (bj == 0) { hv[0] = nv; hp[0] = psel + 1; } else if (bj == 1) { hv[1] = nv; hp[1] = psel + 1; } else if (bj == 2) { hv[2] = nv; hp[2] = psel + 1; } else { hv[3] = nv; hp[3] = psel + 1; }
            }
            const float inv = 2.5f / tot;
            const int tok = tb + it, lt = half * 64 + it;
#pragma unroll
            for (int k = 0; k < 8; ++k) {
                tok_e[(size_t)tok * 8 + k] = te[k]; tok_w[(size_t)tok * 8 + k] = sc8[k] * inv;
                const unsigned r = atomicAdd((unsigned*)&hist[te[k]], 1u);
                selE[lt * 8 + k] = te[k]; selR[lt * 8 + k] = (int)r;
            }
        }
        __syncthreads();
    }
    if (DRY) return;
    if (tid < 256) { const unsigned c = hist[tid]; base[tid] = c ? __hip_atomic_fetch_add(cnt + tid, c, __ATOMIC_RELAXED, __HIP_MEMORY_SCOPE_AGENT) : 0u; }
    __syncthreads();
    for (int i = tid; i < tpw * 8; i += 512) tok_p[(size_t)t0 * 8 + i] = (int)base[selE[i]] + selR[i];
    __syncthreads();
}

__device__ __forceinline__ void phase_dispatch(LAS unsigned char* lds, const unsigned* __restrict__ cnt, const int* __restrict__ tok_e, const int* __restrict__ tok_p,
                                               int* __restrict__ s_tok, int* __restrict__ posy, int* __restrict__ tile_exp, int* __restrict__ ntiles, int bid, int nb) {
    const int tid = threadIdx.x;
    LAS int* tstart = (LAS int*)lds;
    LAS int* tcnt = tstart + 260;
    if (tid < 256) tcnt[tid] = (int)((__hip_atomic_load(cnt + tid, __ATOMIC_RELAXED, __HIP_MEMORY_SCOPE_AGENT) + 255u) >> 8);
    __syncthreads();
    if (tid == 0) { int a = 0; for (int e = 0; e < 256; ++e) { tstart[e] = a; a += tcnt[e]; } tstart[256] = a; }
    __syncthreads();
    const int TT = tstart[256];
    const int tpw = NTOK / nb, t0 = bid * tpw;
    for (int i = tid; i < tpw * 8; i += 512) {
        const size_t a = (size_t)t0 * 8 + i; const int e = tok_e[a], p = tok_p[a];
        const int pos = tstart[e] * 256 + p;
        s_tok[pos] = (int)(a >> 3); posy[a] = pos;
    }
    for (int i = tid; i < tpw; i += 512) { const int tok = t0 + i; s_tok[TT * 256 + tok] = tok; }
    for (int e = bid; e < 256; e += nb) {
        const int c = (int)__hip_atomic_load(cnt + e, __ATOMIC_RELAXED, __HIP_MEMORY_SCOPE_AGENT), ts = tstart[e], tc = tcnt[e];
        for (int i = c + tid; i < tc * 256; i += 512) s_tok[ts * 256 + i] = 0;
        for (int i = tid; i < tc; i += 512) tile_exp[ts + i] = e;
    }
    if (bid == 0) { for (int i = tid; i < NTOK / 256; i += 512) tile_exp[TT + i] = 256; if (tid == 0) *ntiles = TT + NTOK / 256; }
    __syncthreads();
}

constexpr int MX_QT = 0, MX_KT = 17408, MX_KHT = 34816, MX_VT = 53248, MX_P = 73984, MX_ST = 83200, MX_SEG = 122368, MX_GD = 126464, MX_ER = 126976, MX_RS = 127488, MX_DEN = 128000, MX_BC = 128256, MX_IP = 128512, MX_GT = 128768;
struct MixP {
    const bf16_t* proj; int ldp; int pad0; bf16_t* ymix; const float* gates;
    const float* lb0; const float* bgk; const float* hg; const float* gg; const float* conv; const float* bif;
    float* ust; float* gsum;
};
#define MFMA16(a, b, c) __builtin_amdgcn_mfma_f32_16x16x32_bf16((a), (b), (c), 0, 0, 0)

template <int MODE, bool FULL, int VAR = 0>
__device__ __forceinline__ void mixer_run(LAS unsigned char* lds, const MixP& mp, int bid) {
    constexpr int DK = (MODE == 1) ? 64 : 128, QP = DK + 8, CP = DK / 2, RG = 512 / CP, RPT = 64 / RG, KS = DK / 32;
    constexpr int NVT = (MODE == 2) ? 9 : 8;
    constexpr int NST = (DK == 128) ? NVT : 4;
    const int tid = threadIdx.x, lane = tid & 63, w = __builtin_amdgcn_readfirstlane(tid >> 6), l15 = lane & 15, l4 = lane >> 4;
    int b, h, vh = 0, seg;
    if (MODE == 0) { const int sq = bid >> 4; b = sq >> 2; h = sq & 3; seg = bid & 15; }
    else if (MODE == 1) { const int sq = (bid - 128) >> 4; b = sq >> 2; h = sq & 3; seg = bid & 15; }
    else { const int sq = bid >> 4; b = sq >> 3; h = (sq >> 1) & 3; vh = sq & 1; seg = bid & 15; }
    const int tok0 = b * SEQ + seg * 1024;
    const int ldp = mp.ldp; const bf16_t* proj = mp.proj;
    int cq, ck, cv, cg, cy;
    if (MODE == 0) { cq = h * 128; ck = 512 + h * 128; cv = 1024 + h * 128; cg = 1536 + h * 128; cy = h * 128; }
    else if (MODE == 1) { cq = 2048 + h * 64; ck = 2304 + h * 64; cv = 2560 + h * 128; cg = 3072 + h * 128; cy = 512 + h * 128; }
    else { cq = h * 128; ck = 512 + h * 128; cv = 1024 + h * 256 + vh * 128; cg = 2048 + h * 256 + vh * 128; cy = h * 256 + vh * 128; }
    const int cu = 3584 + h * 64;
    const int cp = tid % CP, rg = tid / CP, d0 = 2 * cp;
    float lbv[2] = {0.f, 0.f}, oml[2] = {0.f, 0.f}, bgk[2] = {0.f, 0.f}, cwq[4][2], cwk[4][2];
    if (MODE == 0) { lbv[0] = mp.lb0[h * 128 + d0]; lbv[1] = mp.lb0[h * 128 + d0 + 1]; oml[0] = 1.f - lbv[0]; oml[1] = 1.f - lbv[1]; }
    if (MODE == 1) { bgk[0] = mp.bgk[h * 64 + d0]; bgk[1] = mp.bgk[h * 64 + d0 + 1]; }
#pragma unroll
    for (int j = 0; j < 4; ++j) { cwq[j][0] = cwq[j][1] = cwk[j][0] = cwk[j][1] = 0.f; }
    if (MODE == 2) {
#pragma unroll
        for (int j = 0; j < 4; ++j) { cwq[j][0] = mp.conv[j * 1024 + cq + d0]; cwq[j][1] = mp.conv[j * 1024 + cq + d0 + 1]; cwk[j][0] = mp.conv[j * 1024 + ck + d0]; cwk[j][1] = mp.conv[j * 1024 + ck + d0 + 1]; }
    }
    const float bi = (MODE == 2) ? mp.bif[h] : 0.f, bfg = (MODE == 2) ? mp.bif[4 + h] : 0.f;
    const int sdt = (DK == 128) ? w : (w & 3), svt0 = (DK == 128) ? 0 : 4 * (w >> 2);
    f32x4 S[NST];
#pragma unroll
    for (int t = 0; t < NST; ++t) S[t] = (f32x4){0.f, 0.f, 0.f, 0.f};
    float gacc[2] = {(MODE == 2) ? 0.f : 1.f, (MODE == 2) ? 0.f : 1.f};
    if (MODE == 2) {
        for (int i = tid; i < 16 * 72; i += 512) { const int r = i / 72; *(LAS bf16_t*)(lds + MX_VT + ((128 + r) * 72 + (i % 72)) * 2) = (r == 0) ? (bf16_t)0x3F80 : (bf16_t)0; }
    }
    if (FULL) {
        const int bid0 = bid & ~15;
        for (int j = 0; j < seg; ++j) {
            const float* U = mp.ust + ((size_t)(bid0 + j) * 8 + w) * (9 * 4 * 64);
            float dec[4];
            if (MODE == 2) { const float gsv = mp.gsum[(size_t)(bid0 + j) * 128]; dec[0] = dec[1] = dec[2] = dec[3] = __expf(gsv); }
            else {
#pragma unroll
                for (int r = 0; r < 4; ++r) dec[r] = mp.gsum[(size_t)(bid0 + j) * 128 + sdt * 16 + 4 * l4 + r];
            }
#pragma unroll
            for (int t = 0; t < NST; ++t)
#pragma unroll
                for (int r = 0; r < 4; ++r) S[t][r] = dec[r] * S[t][r] + U[(t * 4 + r) * 64 + lane];
        }
    }
    const int sj = w & 3, ovh = w >> 2, srow = 16 * sj + l15;
    const int vp = tid & 63, r0v = (tid >> 6) * 8;
    unsigned ra[RPT + 3], rb[RPT + 3], rc[RPT], pv[8]; u32x2 gnx[4]; float sgi = 0.f, sgf = 0.f;
#pragma unroll
    for (int i = 0; i < RPT + 3; ++i) { ra[i] = 0u; rb[i] = 0u; }
#pragma unroll
    for (int i = 0; i < RPT; ++i) rc[i] = 0u;
#pragma unroll
    for (int t = 0; t < 4; ++t) gnx[t] = (u32x2){0u, 0u};
#define MX_LOAD(cn) do { const int tokn_ = tok0 + (cn) * 64; \
        if (VAR == 1 || VAR == 3 || VAR == 4) { _Pragma("unroll") for (int i = 0; i < RPT + 3; ++i) { ra[i] = 0x3c003c00u + (unsigned)(cn); rb[i] = 0x3c003c00u; } _Pragma("unroll") for (int i = 0; i < RPT; ++i) rc[i] = 0x3c003c00u; _Pragma("unroll") for (int i = 0; i < 8; ++i) pv[i] = 0x3c003c00u; _Pragma("unroll") for (int t = 0; t < 4; ++t) gnx[t] = (u32x2){0x3c003c00u, 0x3c003c00u}; sgi = 0.1f; sgf = 3.f; } else \
        if (MODE == 2) { const int tl0_ = seg * 1024 + (cn) * 64 + rg * RPT; \
            _Pragma("unroll") for (int i = 0; i < RPT + 3; ++i) { const int tl_ = tl0_ - 3 + i; \
                if (tl_ >= 0) { const bf16_t* pr_ = proj + (size_t)(b * SEQ + tl_) * ldp; if (FULL) ra[i] = *(const unsigned*)(pr_ + cq + d0); rb[i] = *(const unsigned*)(pr_ + ck + d0); } \
                else { ra[i] = 0u; rb[i] = 0u; } } \
            if (w == 0) { const float* gp_ = mp.gates + (size_t)(tokn_ + lane) * 8; sgi = gp_[h]; sgf = gp_[4 + h]; } \
        } else { \
            _Pragma("unroll") for (int i = 0; i < RPT; ++i) { const bf16_t* pr_ = proj + (size_t)(tokn_ + rg * RPT + i) * ldp; \
                if (MODE == 0) { ra[i] = *(const unsigned*)(pr_ + ck + d0); if (FULL) rb[i] = *(const unsigned*)(pr_ + cq + d0); } \
                else { ra[i] = *(const unsigned*)(pr_ + cu + d0); rb[i] = *(const unsigned*)(pr_ + ck + d0); if (FULL) rc[i] = *(const unsigned*)(pr_ + cq + d0); } } \
        } \
        _Pragma("unroll") for (int i = 0; i < 8; ++i) pv[i] = *(const unsigned*)(proj + (size_t)(tokn_ + r0v + i) * ldp + cv + 2 * vp); \
        if (FULL) { _Pragma("unroll") for (int t = 0; t < 4; ++t) gnx[t] = *(const u32x2*)(proj + (size_t)(tokn_ + srow) * ldp + cg + 16 * (4 * ovh + t) + 4 * l4); } \
    } while (0)
    float gnv[4][4];
#pragma unroll
    for (int t = 0; t < 4; ++t)
#pragma unroll
        for (int r = 0; r < 4; ++r) gnv[t][r] = (FULL && MODE != 2) ? ((MODE == 0) ? mp.hg : mp.gg)[h * 128 + 16 * (4 * ovh + t) + 4 * l4 + r] : 1.f;
    MX_LOAD(0);
    __syncthreads();
    for (int c = 0; c < 16; ++c) {
        const int tokc = tok0 + c * 64;
        float la[RPT][2], sp[RPT][2], qv[RPT][2], kv[RPT][2];
        u32x2 gcur[4];
        if (VAR == 4) {
#pragma unroll
            for (int t = 0; t < 4; ++t) gcur[t] = gnx[t];
            __syncthreads(); __syncthreads(); goto stepC; }
#pragma unroll
        for (int t = 0; t < 4; ++t) gcur[t] = gnx[t];
        if (MODE == 2) {
            if (w == 0) {
                const float ip = sgi + bi, lf = logsig(sgf + bfg);
                float cs = lf;
#pragma unroll
                for (int o = 1; o < 64; o <<= 1) { const float t = __shfl_up(cs, o); if (lane >= o) cs += t; }
                *(LAS float*)(lds + MX_BC + lane * 4) = cs; *(LAS float*)(lds + MX_IP + lane * 4) = ip - cs;
                if (lane == 63) *(LAS float*)(lds + MX_GT) = cs;
            }
#pragma unroll
            for (int i = 0; i < RPT; ++i)
#pragma unroll
                for (int e = 0; e < 2; ++e) {
                    float aq = 0.f, ak = 0.f;
#pragma unroll
                    for (int j = 0; j < 4; ++j) { aq += cwq[j][e] * (e ? bfhi(ra[i + j]) : bflo(ra[i + j])); ak += cwk[j][e] * (e ? bfhi(rb[i + j]) : bflo(rb[i + j])); }
                    qv[i][e] = silu(aq); kv[i][e] = silu(ak) * 0.08838834764831845f; la[i][e] = 0.f; sp[i][e] = 0.f;
                }
        } else {
#pragma unroll
            for (int i = 0; i < RPT; ++i) {
                if (MODE == 0) {
                    const unsigned uz = ra[i];
                    const float s0 = sigm(bflo(uz)), s1 = sigm(bfhi(uz));
                    la[i][0] = lbv[0] + oml[0] * s0; la[i][1] = lbv[1] + oml[1] * s1;
                    kv[i][0] = oml[0] - oml[0] * s0; kv[i][1] = oml[1] - oml[1] * s1;
                    if (FULL) { const unsigned uq = rb[i]; qv[i][0] = silu(bflo(uq)); qv[i][1] = silu(bfhi(uq)); } else { qv[i][0] = qv[i][1] = 0.f; }
                } else {
                    const unsigned uu = ra[i], uk = rb[i];
                    la[i][0] = __expf(logsig(bflo(uu) + bgk[0]) * 0.0625f); la[i][1] = __expf(logsig(bfhi(uu) + bgk[1]) * 0.0625f);
                    kv[i][0] = bflo(uk); kv[i][1] = bfhi(uk);
                    if (FULL) { const unsigned uq = rc[i]; qv[i][0] = bflo(uq) * 0.125f; qv[i][1] = bfhi(uq) * 0.125f; } else { qv[i][0] = qv[i][1] = 0.f; }
                }
            }
#pragma unroll
            for (int e = 0; e < 2; ++e) {
                float run = 1.f;
#pragma unroll
                for (int i = RPT - 1; i >= 0; --i) { sp[i][e] = run; run *= la[i][e]; }
                run = 1.f;
#pragma unroll
                for (int i = 0; i < RPT; ++i) { run *= la[i][e]; la[i][e] = run; }
            }
            *(LAS float*)(lds + MX_SEG + (rg * DK + d0) * 4) = la[RPT - 1][0]; *(LAS float*)(lds + MX_SEG + (rg * DK + d0 + 1) * 4) = la[RPT - 1][1];
        }
        {
            u32x4 lo, hi;
            lo.x = (pv[0] & 0xffffu) | (pv[1] << 16); lo.y = (pv[2] & 0xffffu) | (pv[3] << 16); lo.z = (pv[4] & 0xffffu) | (pv[5] << 16); lo.w = (pv[6] & 0xffffu) | (pv[7] << 16);
            hi.x = (pv[0] >> 16) | (pv[1] & 0xffff0000u); hi.y = (pv[2] >> 16) | (pv[3] & 0xffff0000u); hi.z = (pv[4] >> 16) | (pv[5] & 0xffff0000u); hi.w = (pv[6] >> 16) | (pv[7] & 0xffff0000u);
            *(LAS u32x4*)(lds + MX_VT + ((2 * vp) * 72 + r0v) * 2) = lo; *(LAS u32x4*)(lds + MX_VT + ((2 * vp + 1) * 72 + r0v) * 2) = hi;
        }
        if (c + 1 < 16) MX_LOAD(c + 1);
        if (VAR == 2) { unsigned xa = 0; _Pragma("unroll") for (int i = 0; i < RPT + 3; ++i) xa ^= ra[i] ^ rb[i]; _Pragma("unroll") for (int i = 0; i < RPT; ++i) xa ^= rc[i]; _Pragma("unroll") for (int i = 0; i < 8; ++i) xa ^= pv[i];
            _Pragma("unroll") for (int t = 0; t < 4; ++t) xa ^= gnx[t].x ^ gnx[t].y; gacc[0] += (float)(xa & 1u) + sgi + sgf; continue; }
        __syncthreads();
        {
            float pre[2], h2[2], gt[2];
            if (MODE == 2) {
                const float g = *(LAS float*)(lds + MX_GT);
                gt[0] = gt[1] = g; h2[0] = h2[1] = 0.f; pre[0] = pre[1] = 0.f;
                if (tid == 0) gacc[0] += g;
            } else {
#pragma unroll
                for (int e = 0; e < 2; ++e) { float p = 1.f, a1 = 1.f, a2 = 1.f;
#pragma unroll
                    for (int j = 0; j < RG; ++j) { const float v = *(LAS float*)(lds + MX_SEG + (j * DK + d0 + e) * 4);
                        if (j < RG / 2) a1 *= v; else a2 *= v;
                        const bool inb = (rg >= RG / 2) ? (j >= RG / 2 && j < rg) : (j > rg && j < RG / 2);
                        p *= inb ? v : 1.f; }
                    pre[e] = p; h2[e] = a2; gt[e] = a1 * a2;
                    if (rg == 0) { gacc[e] *= gt[e]; *(LAS float*)(lds + MX_GD + (d0 + e) * 4) = gt[e]; *(LAS float*)(lds + MX_ER + (d0 + e) * 4) = a1; } }
            }
            float kh[RPT][2];
#pragma unroll
            for (int i = 0; i < RPT; ++i) {
                const int s = rg * RPT + i;
                float qs[2], ks[2];
                if (MODE == 2) {
                    const float bc = *(LAS float*)(lds + MX_BC + s * 4), ipb = *(LAS float*)(lds + MX_IP + s * 4);
                    const float eq = __expf(bc), ek = __expf(ipb), eg = __expf(gt[0]);
                    qs[0] = qv[i][0] * eq; qs[1] = qv[i][1] * eq; ks[0] = kv[i][0] * ek; ks[1] = kv[i][1] * ek; kh[i][0] = ks[0] * eg; kh[i][1] = ks[1] * eg;
                } else {
#pragma unroll
                    for (int e = 0; e < 2; ++e) {
                        const float cd = pre[e] * ((rg >= RG / 2) ? la[i][e] : sp[i][e]);
                        const float rc_ = __builtin_amdgcn_rcpf(cd);
                        const float qm = (rg >= RG / 2) ? cd : rc_, km = (rg >= RG / 2) ? rc_ : cd;
                        qs[e] = qv[i][e] * qm; ks[e] = kv[i][e] * km; kh[i][e] = ks[e] * h2[e]; }
                }
                if (FULL) { *(LAS unsigned*)(lds + MX_QT + (s * QP + d0) * 2) = pk2(qs[0], qs[1]); *(LAS unsigned*)(lds + MX_KT + (s * QP + d0) * 2) = pk2(ks[0], ks[1]); }
            }
            if (RPT == 8) {
                u32x4 a, bq;
                a.x = pk2(kh[0][0], kh[1][0]); a.y = pk2(kh[2][0], kh[3][0]); a.z = pk2(kh[4 % RPT][0], kh[5 % RPT][0]); a.w = pk2(kh[6 % RPT][0], kh[7 % RPT][0]);
                bq.x = pk2(kh[0][1], kh[1][1]); bq.y = pk2(kh[2][1], kh[3][1]); bq.z = pk2(kh[4 % RPT][1], kh[5 % RPT][1]); bq.w = pk2(kh[6 % RPT][1], kh[7 % RPT][1]);
                *(LAS u32x4*)(lds + MX_KHT + (d0 * 72 + rg * 8) * 2) = a; *(LAS u32x4*)(lds + MX_KHT + ((d0 + 1) * 72 + rg * 8) * 2) = bq;
            } else {
                u32x2 a, bq;
                a.x = pk2(kh[0][0], kh[1][0]); a.y = pk2(kh[2][0], kh[3][0]); bq.x = pk2(kh[0][1], kh[1][1]); bq.y = pk2(kh[2][1], kh[3][1]);
                *(LAS u32x2*)(lds + MX_KHT + (d0 * 72 + rg * 4) * 2) = a; *(LAS u32x2*)(lds + MX_KHT + ((d0 + 1) * 72 + rg * 4) * 2) = bq;
            }
        }
        __syncthreads();
        stepC:
        if (FULL && VAR != 3) {
#pragma unroll
            for (int tt = 0; tt < 2; ++tt) {
                const int tile = 2 * w + tt, ti = tile >> 2, tj = tile & 3;
                f32x4 acc = (f32x4){0.f, 0.f, 0.f, 0.f};
                if (ti <= tj) {
#pragma unroll
                    for (int kk = 0; kk < KS; ++kk) {
                        const bf16x8 a = *(const LAS bf16x8*)(lds + MX_KT + ((16 * ti + l15) * QP + kk * 32 + 8 * l4) * 2);
                        const bf16x8 bq = *(const LAS bf16x8*)(lds + MX_QT + ((16 * tj + l15) * QP + kk * 32 + 8 * l4) * 2);
                        acc = MFMA16(a, bq, acc);
                    }
                }
                const int s = 16 * tj + l15, sp0 = 16 * ti + 4 * l4;
                float pvv[4];
#pragma unroll
                for (int r = 0; r < 4; ++r) pvv[r] = (sp0 + r <= s) ? acc[r] : 0.f;
                u32x2 pw; pw.x = pk2(pvv[0], pvv[1]); pw.y = pk2(pvv[2], pvv[3]);
                *(LAS u32x2*)(lds + MX_P + (s * 72 + sp0) * 2) = pw;
            }
            {
                float er[4];
#pragma unroll
                for (int r = 0; r < 4; ++r) er[r] = (MODE == 2) ? 1.f : *(LAS float*)(lds + MX_ER + (sdt * 16 + 4 * l4 + r) * 4);
#pragma unroll
                for (int t = 0; t < NST; ++t) {
                    const int v = 16 * (svt0 + t) + l15;
                    u32x2 sw; sw.x = pk2(S[t][0] * er[0], S[t][1] * er[1]); sw.y = pk2(S[t][2] * er[2], S[t][3] * er[3]);
                    *(LAS u32x2*)(lds + MX_ST + (v * QP + sdt * 16 + 4 * l4) * 2) = sw;
                }
            }
            {
                float dec[4];
                if (MODE == 2) { const float eg = __expf(*(LAS float*)(lds + MX_GT)); dec[0] = dec[1] = dec[2] = dec[3] = eg; }
                else {
    #pragma unroll
                    for (int r = 0; r < 4; ++r) dec[r] = *(LAS float*)(lds + MX_GD + (sdt * 16 + 4 * l4 + r) * 4);
                }
                bf16x8 ka[2];
    #pragma unroll
                for (int kk = 0; kk < 2; ++kk) ka[kk] = *(const LAS bf16x8*)(lds + MX_KHT + ((16 * sdt + l15) * 72 + kk * 32 + 8 * l4) * 2);
    #pragma unroll
                for (int t = 0; t < NST; ++t) {
    #pragma unroll
                    for (int r = 0; r < 4; ++r) S[t][r] *= dec[r];
    #pragma unroll
                    for (int kk = 0; kk < 2; ++kk) {
                        const bf16x8 vb = *(const LAS bf16x8*)(lds + MX_VT + ((16 * (svt0 + t) + l15) * 72 + kk * 32 + 8 * l4) * 2);
                        S[t] = MFMA16(ka[kk], vb, S[t]);
                    }
                }
            }
            __syncthreads();
            constexpr int NOT = (MODE == 2) ? 5 : 4;
            f32x4 O[NOT];
#pragma unroll
            for (int t = 0; t < NOT; ++t) O[t] = (f32x4){0.f, 0.f, 0.f, 0.f};
#pragma unroll
            for (int kk = 0; kk < 2; ++kk) {
                const bf16x8 bq = *(const LAS bf16x8*)(lds + MX_P + ((16 * sj + l15) * 72 + kk * 32 + 8 * l4) * 2);
#pragma unroll
                for (int t = 0; t < NOT; ++t) { const int vt = (t < 4) ? (4 * ovh + t) : 8;
                    if (t < 4 || ovh == 0) { const bf16x8 a = *(const LAS bf16x8*)(lds + MX_VT + ((16 * vt + l15) * 72 + kk * 32 + 8 * l4) * 2); O[t] = MFMA16(a, bq, O[t]); } }
            }
#pragma unroll
            for (int kk = 0; kk < KS; ++kk) {
                const bf16x8 bq = *(const LAS bf16x8*)(lds + MX_QT + ((16 * sj + l15) * QP + kk * 32 + 8 * l4) * 2);
#pragma unroll
                for (int t = 0; t < NOT; ++t) { const int vt = (t < 4) ? (4 * ovh + t) : 8;
                    if (t < 4 || ovh == 0) { const bf16x8 a = *(const LAS bf16x8*)(lds + MX_ST + ((16 * vt + l15) * QP + kk * 32 + 8 * l4) * 2); O[t] = MFMA16(a, bq, O[t]); } }
            }
            const int tokr = tokc + srow;
            float scale;
            if (MODE == 2) {
                if (ovh == 0 && l4 == 0) *(LAS float*)(lds + MX_DEN + srow * 4) = O[NOT - 1][0];
                __syncthreads();
                const float den = *(LAS float*)(lds + MX_DEN + srow * 4);
                scale = 1.f / fmaxf(fabsf(den), 1.f);
            } else {
                float ss = 0.f;
#pragma unroll
                for (int t = 0; t < 4; ++t)
#pragma unroll
                    for (int r = 0; r < 4; ++r) ss += O[t][r] * O[t][r];
                ss += __shfl_xor(ss, 16); ss += __shfl_xor(ss, 32);
                if (l4 == 0) *(LAS float*)(lds + MX_RS + (ovh * 64 + srow) * 4) = ss;
                __syncthreads();
                const float tot = *(LAS float*)(lds + MX_RS + srow * 4) + *(LAS float*)(lds + MX_RS + (64 + srow) * 4);
                scale = rsqrtf(tot * (1.f / 128.f) + 1e-6f);
            }
#pragma unroll
            for (int t = 0; t < 4; ++t) {
                const int v0 = 16 * (4 * ovh + t) + 4 * l4;
                const u32x2 gt = gcur[t];
                const float g0 = bflo(gt.x), g1 = bfhi(gt.x), g2 = bflo(gt.y), g3 = bfhi(gt.y);
                float y0, y1, y2, y3;
                if (MODE == 2) { y0 = O[t][0] * scale * sigm(g0); y1 = O[t][1] * scale * sigm(g1); y2 = O[t][2] * scale * sigm(g2); y3 = O[t][3] * scale * sigm(g3); }
                else { y0 = O[t][0] * scale * gnv[t][0] * silu(g0); y1 = O[t][1] * scale * gnv[t][1] * silu(g1); y2 = O[t][2] * scale * gnv[t][2] * silu(g2); y3 = O[t][3] * scale * gnv[t][3] * silu(g3); }
                u32x2 yw; yw.x = pk2(y0, y1); yw.y = pk2(y2, y3);
                *(u32x2*)(mp.ymix + (size_t)tokr * DM + cy + v0) = yw;
            }
        }
        if (!FULL || VAR == 3) {
            {
                float dec[4];
                if (MODE == 2) { const float eg = __expf(*(LAS float*)(lds + MX_GT)); dec[0] = dec[1] = dec[2] = dec[3] = eg; }
                else {
    #pragma unroll
                    for (int r = 0; r < 4; ++r) dec[r] = *(LAS float*)(lds + MX_GD + (sdt * 16 + 4 * l4 + r) * 4);
                }
                bf16x8 ka[2];
    #pragma unroll
                for (int kk = 0; kk < 2; ++kk) ka[kk] = *(const LAS bf16x8*)(lds + MX_KHT + ((16 * sdt + l15) * 72 + kk * 32 + 8 * l4) * 2);
    #pragma unroll
                for (int t = 0; t < NST; ++t) {
    #pragma unroll
                    for (int r = 0; r < 4; ++r) S[t][r] *= dec[r];
    #pragma unroll
                    for (int kk = 0; kk < 2; ++kk) {
                        const bf16x8 vb = *(const LAS bf16x8*)(lds + MX_VT + ((16 * (svt0 + t) + l15) * 72 + kk * 32 + 8 * l4) * 2);
                        S[t] = MFMA16(ka[kk], vb, S[t]);
                    }
                }
            }
        __syncthreads();
        }
    }
#undef MX_LOAD
    if (VAR == 2) { mp.ust[(size_t)bid * 512 + tid] = gacc[0]; return; }
    if (!FULL) {
        float* U = mp.ust + ((size_t)bid * 8 + w) * (9 * 4 * 64);
#pragma unroll
        for (int t = 0; t < NST; ++t)
#pragma unroll
            for (int r = 0; r < 4; ++r) U[(t * 4 + r) * 64 + lane] = S[t][r];
        if (MODE == 2) { if (tid == 0) mp.gsum[(size_t)bid * 128] = gacc[0]; }
        else if (rg == 0) { mp.gsum[(size_t)bid * 128 + d0] = gacc[0]; mp.gsum[(size_t)bid * 128 + d0 + 1] = gacc[1]; }
    }
}

#ifndef PHMASK
#define PHMASK 0xFFFFu
#endif
#ifndef MIXSEL
#define MIXSEL 7
#endif
#ifndef REPMASK
#define REPMASK 0x0u
#endif
#define EN(j) (((PHMASK) >> (j)) & 1u)
#ifndef REPLAYER
#define REPLAYER 3
#endif
#define NREP(j) (1 + (int)((((REPMASK) >> (j)) & 1u) & (((REPLAYER) >> layer) & 1u)))
#define IN(k) (lo <= (k) && (k) < hi)
#define SEAM(k) do { if (IN((k) + 1)) xcd_barrier(bar); } while (0)

template <int layer> __device__ __forceinline__ void ph_proj(LAS unsigned char* lds, unsigned char* ws, int bid, int nb) {
    pg8::Gemm g{(const bf16_t*)(ws + (layer ? WS_H2Q : WS_XQ)), (const bf16_t*)(ws + (layer ? WS_WC : WS_WAB)), DM / 2};
    pg8::StaticOrder S; S.init(NTOK, layer ? CWID : ABW, nb, bid);
    pg8::EpiStoreBf16<true> E{(bf16_t*)(ws + WS_PROJ), layer ? CWID : ABW};
    pg8::gemm_phase<pg8::EpiStoreBf16<true>, pg8::StaticOrder, false, true>(lds, g, nullptr, S, E);
}
template <int layer> __device__ __forceinline__ void ph_outproj(LAS unsigned char* lds, unsigned char* ws, int bid, int nb) {
    pg8::Gemm g{(const bf16_t*)(ws + WS_YMIX), (const bf16_t*)(ws + (layer ? WS_WOC : WS_WOAB)), DM};
    pg8::StaticOrder S; S.init(NTOK, DM, nb, bid);
    pg8::EpiResid E{(bf16_t*)(ws + WS_Z), (const bf16_t*)(ws + (layer ? WS_H2 : WS_HB))};
    pg8::gemm_phase<pg8::EpiResid, pg8::StaticOrder, false>(lds, g, nullptr, S, E);
}
template <int layer> __device__ __forceinline__ void ph_router(LAS unsigned char* lds, unsigned char* ws, int bid, int nb) {
    pg8::Gemm g{(const bf16_t*)(ws + WS_H1), (const bf16_t*)(ws + WS_WR) + (size_t)layer * 256 * 1024, DM};
    pg8::StaticOrder S; S.init(NTOK, 256, nb, bid);
    pg8::EpiF32 E{(float*)(ws + WS_LOGITS)};
    pg8::gemm_phase<pg8::EpiF32, pg8::StaticOrder, false>(lds, g, nullptr, S, E);
}
template <int layer> __device__ __forceinline__ void ph_gemm1(LAS unsigned char* lds, unsigned char* ws, int bid, int nb) {
    const int vcu = (nb % 8 == 0) ? (bid % 8) * (nb / 8) + bid / 8 : bid;
    const int nt = __builtin_amdgcn_readfirstlane(*(volatile int*)(ws + WS_MISC + 65536 + 8192));
    pg8::Gemm g{(const bf16_t*)(ws + WS_H1Q), (const bf16_t*)(ws + WS_W1T + (size_t)layer * NE1 * 512 * 1024), DM / 2};
    const int nu = pg8::moe_prep(lds, (const int*)(ws + WS_MISC + 65536), nt * 2, 1, nb, vcu, (const int*)(ws + WS_STOK));
    pg8::MoeOrder S{(const LAS int*)(lds + pg8::LDS_UT), nu < pg8::MOE_MAXU ? nu : pg8::MOE_MAXU};
    pg8::EpiSwiGLU<true> E{ws + WS_ACT, lds + 3 * pg8::HTB};
    pg8::gemm_phase<pg8::EpiSwiGLU<true>, pg8::MoeOrder, true, true>(lds, g, (const LAS int*)(lds + pg8::LDS_IDX), S, E);
}
template <int layer> __device__ __forceinline__ void ph_gemm2(LAS unsigned char* lds, unsigned char* ws, int bid, int nb) {
    const int vcu = (nb % 8 == 0) ? (bid % 8) * (nb / 8) + bid / 8 : bid;
    const int nt = __builtin_amdgcn_readfirstlane(*(volatile int*)(ws + WS_MISC + 65536 + 8192));
    int kq = 128; asm volatile("" : "+s"(kq));
    pg8::Gemm g{(const bf16_t*)(ws + WS_ACT), (const bf16_t*)(ws + WS_W2T + (size_t)layer * NE1 * 1024 * 256), kq};
    const int nu = pg8::moe_prep(lds, (const int*)(ws + WS_MISC + 65536), nt * 4, 2, nb, vcu, nullptr);
    pg8::MoeOrder S{(const LAS int*)(lds + pg8::LDS_UT), nu};
    pg8::EpiDown E{(unsigned char*)(ws + WS_Y), lds + 3 * pg8::HTB};
    pg8::gemm_phase<pg8::EpiDown, pg8::MoeOrder, false, true>(lds, g, nullptr, S, E);
#ifndef EXPG
#define EXPG 0
#endif
#if EXPG
    { __syncthreads(); pg8::EpiDownT<EXPG - 1> E2{(unsigned char*)(ws + WS_PROJ), lds + 3 * pg8::HTB};
      pg8::gemm_phase<pg8::EpiDownT<EXPG - 1>, pg8::MoeOrder, false, true>(lds, g, nullptr, S, E2); }
#endif
}
template <int layer, bool FULLP> __device__ __forceinline__ void ph_mixer(LAS unsigned char* lds, const Args& A, int bid, int nb) {
    unsigned char* ws = A.ws;
    if (nb != NWG) return;
    MixP mp{(const bf16_t*)(ws + WS_PROJ), layer ? CWID : ABW, 0, (bf16_t*)(ws + WS_YMIX), (const float*)(ws + WS_GATES), (const float*)(ws + WS_MISC), A.in[I_BGK], A.in[I_HG], A.in[I_GG], A.in[I_CONV], A.in[I_BIF], (float*)(ws + WS_UST), (float*)(ws + WS_GSUM)};
    if (layer == 0) { if (bid < 128) { if (MIXSEL & 1) mixer_run<0, FULLP>(lds, mp, bid); } else { if (MIXSEL & 2) mixer_run<1, FULLP>(lds, mp, bid); } }
    else { if (MIXSEL & 4) mixer_run<2, FULLP>(lds, mp, bid); }
#ifndef EXPV
#define EXPV 0
#endif
#ifndef EXPL
#define EXPL 0
#endif
#if EXPV
    if (FULLP && layer == EXPL) { MixP md = mp; md.ymix = (bf16_t*)(ws + WS_Z); md.ust = (float*)(ws + WS_LOGITS); md.gsum = (float*)(ws + WS_LOGITS + 24 * MiB);
        __syncthreads();
        if (layer == 0) { if (bid < 128) mixer_run<0, true, EXPV>(lds, md, bid); else mixer_run<1, true, EXPV>(lds, md, bid); }
        else mixer_run<2, true, EXPV>(lds, md, bid); }
#endif
}
#define REP2(j, call) do { call; if (NREP(j) == 2) { __syncthreads(); call; } } while (0)

template <int layer>
__device__ __forceinline__ void run_layer(LAS unsigned char* lds, const Args& A, const XcdBarrier& bar, const int lo, const int hi) {
    const int bid = blockIdx.x, nb = gridDim.x;
    unsigned char* ws = A.ws;
    unsigned* ctl = (unsigned*)(ws + WS_CTL);
    constexpr int P = 1 + layer * 11;
    if (EN(0) && IN(P + 0)) { REP2(0, ph_proj<layer>(lds, ws, bid, nb)); SEAM(P + 0); }
    if (EN(1) && IN(P + 1)) { REP2(1, (ph_mixer<layer, false>(lds, A, bid, nb))); SEAM(P + 1); }
    if (EN(2) && IN(P + 2)) { REP2(2, (ph_mixer<layer, true>(lds, A, bid, nb))); SEAM(P + 2); }
    if (EN(3) && IN(P + 3)) { REP2(3, ph_outproj<layer>(lds, ws, bid, nb)); SEAM(P + 3); }
    if (EN(4) && IN(P + 4)) { REP2(4, phase_ln((const bf16_t*)(ws + WS_Z), (bf16_t*)(ws + WS_H1), ws + WS_H1Q, A.in[I_LMG] + layer * DM, A.in[I_LMB] + layer * DM, bid, nb)); SEAM(P + 4); }
    if (EN(5) && IN(P + 5)) { REP2(5, ph_router<layer>(lds, ws, bid, nb)); SEAM(P + 5); }
    if (EN(6) && IN(P + 6)) {
        phase_select<false>(lds, (const float*)(ws + WS_LOGITS), A.in[I_RB] + layer * NEXP, (int*)(ws + WS_TOKE), (int*)(ws + WS_TOKP), (float*)(ws + WS_TOKW), ctl + CW_CNT + layer * 256, bid, nb);
        if (NREP(6) == 2) phase_select<true>(lds, (const float*)(ws + WS_LOGITS), A.in[I_RB] + layer * NEXP, (int*)(ws + WS_TOKE), (int*)(ws + WS_TOKP), (float*)(ws + WS_TOKW), ctl + CW_CNT + layer * 256, bid, nb);
        SEAM(P + 6); }
    if (EN(7) && IN(P + 7)) { REP2(7, phase_dispatch(lds, ctl + CW_CNT + layer * 256, (const int*)(ws + WS_TOKE), (const int*)(ws + WS_TOKP), (int*)(ws + WS_STOK), (int*)(ws + WS_POSY), (int*)(ws + WS_MISC + 65536), (int*)(ws + WS_MISC + 65536 + 8192), bid, nb)); SEAM(P + 7); }
    if (EN(8) && IN(P + 8)) { REP2(8, ph_gemm1<layer>(lds, ws, bid, nb)); SEAM(P + 8); }
    if (EN(9) && IN(P + 9)) { REP2(9, ph_gemm2<layer>(lds, ws, bid, nb)); SEAM(P + 9); }
    if (EN(10) && IN(P + 10)) {
        if (layer == 0) REP2(10, (phase_combine<false>((const unsigned char*)(ws + WS_Y), (const int*)(ws + WS_POSY), (const float*)(ws + WS_TOKW), (const int*)(ws + WS_MISC + 65536 + 8192), (const bf16_t*)(ws + WS_H1), (bf16_t*)(ws + WS_H2), ws + WS_H2Q, nullptr, (float*)(ws + WS_GATES), (const float*)(ws + WS_MISC + 4096), A.in[I_LFG], A.in[I_LFB], bid, nb)));
        else REP2(10, (phase_combine<true>((const unsigned char*)(ws + WS_Y), (const int*)(ws + WS_POSY), (const float*)(ws + WS_TOKW), (const int*)(ws + WS_MISC + 65536 + 8192), (const bf16_t*)(ws + WS_H1), nullptr, nullptr, A.out, nullptr, nullptr, A.in[I_LFG] + DM, A.in[I_LFB] + DM, bid, nb)));
        SEAM(P + 10);
    }
}

__global__ void __launch_bounds__(512, 2) fwd_kernel(Args A) {
    extern __shared__ __attribute__((aligned(16))) unsigned char lds_raw[];
    LAS unsigned char* lds = (LAS unsigned char*)lds_raw;
    const int tid = threadIdx.x;
    unsigned* ctl = (unsigned*)(A.ws + WS_CTL);
    volatile LAS unsigned* misc = (volatile LAS unsigned*)(lds + LDS_MISC);
    if (tid < 64) misc[tid] = 0u;
    __syncthreads();
    const int lo = A.ph_lo, hi = A.ph_hi;
    XcdBarrier bar; bar.bar = ctl + CW_BAR; bar.x = 0; bar.st = misc;
    if (hi - lo > 1) bar = xcd_barrier_post(ctl + CW_BAR, misc);
    if (EN(11) && IN(0)) { for (int rep_ = 0; rep_ < 1 + (int)(((REPMASK) >> 11) & 1u); ++rep_) phase_prologue(lds, A, blockIdx.x, gridDim.x); SEAM(0); }
    run_layer<0>(lds, A, bar, lo, hi);
    run_layer<1>(lds, A, bar, lo, hi);
}
#undef IN
#undef SEAM

#ifdef DBG
__device__ __forceinline__ unsigned hash32(unsigned x) { x ^= x >> 16; x *= 0x7feb352dU; x ^= x >> 15; x *= 0x846ca68bU; x ^= x >> 16; return x; }
__device__ __forceinline__ void dbg_acc(float* w, int stage, float num, float den) { if (!(num == num) || num > 1e30f) num = 1e30f; atomicAdd(w + 2 * stage, num); atomicAdd(w + 2 * stage + 1, den); }
__device__ __forceinline__ float bfr(float x) { return bflo(pk2(x, 0.f)); }
__global__ void dbg_weights(Args A, float* w) {
    const unsigned i = blockIdx.x * 256 + threadIdx.x; unsigned char* ws = A.ws;
    float num = 0.f, den = 0.f;
    { const unsigned hsh = hash32(i * 4 + 0), col = hsh % 3584, k = (hsh >> 12) % 1024; const float r = A.in[I_WINAB][(size_t)k * 3600 + col], g = bf2f(((const bf16_t*)(ws + WS_WAB))[(size_t)col * 1024 + k]); num += (r - g) * (r - g); den += r * r; }
    { const unsigned hsh = hash32(i * 4 + 1), j = hsh % 256, k = (hsh >> 12) % 1024; float r = 0.f; for (int q = 0; q < 16; ++q) r += A.in[I_WINAB][(size_t)k * 3600 + 3584 + q] * A.in[I_WGKUP][q * 256 + j];
      const float g = bf2f(((const bf16_t*)(ws + WS_WAB))[(size_t)(3584 + j) * 1024 + k]); num += (r - g) * (r - g); den += r * r; }
    { const unsigned hsh = hash32(i * 4 + 2), le = hsh % 514, layer = le / 257, e = le % 257, n = (hsh >> 10) % 512, k = (hsh >> 20) % 1024;
      const float r = (e < 256) ? A.in[I_WEI][((size_t)(layer * 256 + e) * 1024 + k) * 512 + n] : A.in[I_WSI][((size_t)layer * 1024 + k) * 512 + n];
      const unsigned up = n >> 8, c = n & 255, drow = (c >> 7) * 256 + up * 128 + (c & 127);
      const float g = bf2f(((const bf16_t*)(ws + WS_W1T))[((size_t)(layer * 257 + e) * 512 + drow) * 1024 + k]); num += (r - g) * (r - g); den += r * r; }
    { const unsigned hsh = hash32(i * 4 + 3), le = hsh % 514, layer = le / 257, e = le % 257, n = (hsh >> 10) % 1024, k = (hsh >> 20) % 256;
      const float r = (e < 256) ? A.in[I_WED][((size_t)(layer * 256 + e) * 256 + k) * 1024 + n] : A.in[I_WSD][((size_t)layer * 256 + k) * 1024 + n];
      const float g = bf2f(((const bf16_t*)(ws + WS_W2T))[((size_t)(layer * 257 + e) * 1024 + n) * 256 + k]); num += (r - g) * (r - g); den += r * r; }
    dbg_acc(w, 1, num, den);
}
__global__ void dbg_gemm(const bf16_t* Am, int K, const bf16_t* Bt, const void* out, int ldo, int out_f32, int nrows, int ncols, float* w, int stage) {
    const unsigned i = blockIdx.x * 256 + threadIdx.x; const unsigned hsh = hash32(i + 77u * stage), row = hsh % nrows, col = (hsh >> 11) % ncols;
    float r = 0.f; for (int k = 0; k < K; ++k) r += bf2f(Am[(size_t)row * K + k]) * bf2f(Bt[(size_t)col * K + k]);
    const float g = out_f32 ? ((const float*)out)[(size_t)row * ldo + col] : bf2f(((const bf16_t*)out)[(size_t)row * ldo + col]);
    dbg_acc(w, stage, (r - g) * (r - g), r * r);
}
template <int MODE> __global__ void __launch_bounds__(256, 1) dbg_mixer(MixP mp, int b, int h, int T, float* w, int stage) {
    constexpr int DK = (MODE == 1) ? 64 : 128, DV = (MODE == 2) ? 256 : 128;
    __shared__ float sq[128], sk[128], sa[128], red[256], sh_i, sh_f;
    const int tid = threadIdx.x;
    const int ldp = mp.ldp; const bf16_t* proj = mp.proj;
    int cq, ck, cv, cg, cy, cu = 3584 + h * 64;
    if (MODE == 0) { cq = h * 128; ck = 512 + h * 128; cv = 1024 + h * 128; cg = 1536 + h * 128; cy = h * 128; }
    else if (MODE == 1) { cq = 2048 + h * 64; ck = 2304 + h * 64; cv = 2560 + h * 128; cg = 3072 + h * 128; cy = 512 + h * 128; }
    else { cq = h * 128; ck = 512 + h * 128; cv = 1024 + h * 256; cg = 2048 + h * 256; cy = h * 256; }
    float S[DK];
#pragma unroll
    for (int d = 0; d < DK; ++d) S[d] = 0.f;
    float nst = 0.f, num = 0.f, den = 0.f;
    for (int t = 0; t < T; ++t) {
        const size_t tok = (size_t)b * SEQ + t; const bf16_t* pr = proj + tok * ldp;
        if (tid < DK) {
            const int d = tid;
            if (MODE == 0) { const float z = bf2f(pr[ck + d]), sg = 1.f / (1.f + expf(-z)), lb = mp.lb0[h * 128 + d]; sa[d] = lb + (1.f - lb) * sg; sk[d] = (1.f - lb) * (1.f - sg); const float qq = bf2f(pr[cq + d]); sq[d] = qq / (1.f + expf(-qq)); }
            else if (MODE == 1) { const float u = bf2f(pr[cu + d]) + mp.bgk[h * 64 + d]; const float ls = fminf(u, 0.f) - log1pf(expf(-fabsf(u))); sa[d] = expf(ls / 16.f); sk[d] = bf2f(pr[ck + d]); sq[d] = bf2f(pr[cq + d]) * 0.125f; }
            else { float aq = 0.f, ak = 0.f; for (int j = 0; j < 4; ++j) { const int tt = t - 3 + j; if (tt >= 0) { const bf16_t* p2 = proj + ((size_t)b * SEQ + tt) * ldp; aq += mp.conv[j * 1024 + cq + d] * bf2f(p2[cq + d]); ak += mp.conv[j * 1024 + ck + d] * bf2f(p2[ck + d]); } }
                sq[d] = aq / (1.f + expf(-aq)); sk[d] = ak / (1.f + expf(-ak)) * 0.08838834764831845f; }
        }
        if (MODE == 2 && tid == 0) { const float* gp = mp.gates + tok * 8; sh_i = expf(gp[h] + mp.bif[h]); const float x = gp[4 + h] + mp.bif[4 + h]; sh_f = 1.f / (1.f + expf(-x)); }
        __syncthreads();
        const float vt = bf2f(pr[cv + tid]);
        float o = 0.f;
        if (MODE == 2) { const float f = sh_f, ii = sh_i;
#pragma unroll
            for (int d = 0; d < DK; ++d) { S[d] = f * S[d] + ii * sk[d] * vt; o += S[d] * sq[d]; }
            if (tid < 128) nst = f * nst + ii * sk[tid];
            red[tid] = (tid < 128) ? nst * sq[tid] : 0.f;
        } else {
#pragma unroll
            for (int d = 0; d < DK; ++d) { S[d] = sa[d] * S[d] + sk[d] * vt; o += S[d] * sq[d]; }
            red[tid] = o * o;
        }
        __syncthreads();
        for (int st = DV / 2; st > 0; st >>= 1) { if (tid < st) red[tid] += red[tid + st]; __syncthreads(); }
        const float tot = red[0];
        const float gt = bf2f(pr[cg + tid]);
        float y;
        if (MODE == 2) y = o / fmaxf(fabsf(tot), 1.f) * (1.f / (1.f + expf(-gt)));
        else y = o * rsqrtf(tot / 128.f + 1e-6f) * ((MODE == 0) ? mp.hg : mp.gg)[h * 128 + tid] * (gt / (1.f + expf(-gt)));
        const float g = bf2f(mp.ymix[tok * DM + cy + tid]);
        num += (y - g) * (y - g); den += y * y;
        __syncthreads();
    }
    dbg_acc(w, stage, num, den);
}
__global__ void dbg_h1(const bf16_t* HIN, const bf16_t* YM, const bf16_t* Wt, const bf16_t* H1, const float* g, const float* bb, float* w, int stage) {
    __shared__ float red[256]; __shared__ float zrow[1024];
    const int tid = threadIdx.x; const unsigned row = hash32(blockIdx.x + 1000u * stage) % NTOK;
    float z[4];
    for (int q = 0; q < 4; ++q) { const int c = tid + 256 * q; float a = 0.f; for (int k = 0; k < 1024; ++k) a += bf2f(YM[(size_t)row * 1024 + k]) * bf2f(Wt[(size_t)c * 1024 + k]); z[q] = bfr(ALPHA * bf2f(HIN[(size_t)row * 1024 + c]) + a); }
    red[tid] = z[0] + z[1] + z[2] + z[3]; __syncthreads();
    for (int st = 128; st > 0; st >>= 1) { if (tid < st) red[tid] += red[tid + st]; __syncthreads(); }
    const float mu = red[0] / 1024.f; __syncthreads();
    red[tid] = (z[0] - mu) * (z[0] - mu) + (z[1] - mu) * (z[1] - mu) + (z[2] - mu) * (z[2] - mu) + (z[3] - mu) * (z[3] - mu); __syncthreads();
    for (int st = 128; st > 0; st >>= 1) { if (tid < st) red[tid] += red[tid + st]; __syncthreads(); }
    const float rs = rsqrtf(red[0] / 1024.f + 1e-5f);
    float num = 0.f, den = 0.f;
    for (int q = 0; q < 4; ++q) { const int c = tid + 256 * q; const float y = (z[q] - mu) * rs * g[c] + bb[c], gg = bf2f(H1[(size_t)row * 1024 + c]); num += (y - gg) * (y - gg); den += y * y; }
    dbg_acc(w, stage, num, den); (void)zrow;
}
__global__ void dbg_select(const float* logits, const float* rb, const int* tok_e, const float* tok_w, float* w, int stage) {
    __shared__ float sc[256], bs[256]; __shared__ int ce[8]; __shared__ float cs[8];
    if (threadIdx.x != 0) return;
    const unsigned tok = hash32(blockIdx.x + 31u * stage) % NTOK;
    const float* lp = logits + (size_t)tok * 256;
    for (int e = 0; e < 256; ++e) { sc[e] = 1.f / (1.f + expf(-lp[e])); bs[e] = sc[e] + rb[e]; }
    float gs[8];
#pragma unroll
    for (int g = 0; g < 8; ++g) { float m1 = -1e30f, m2 = -1e30f; for (int j = 0; j < 32; ++j) { const float v = bs[g * 32 + j]; if (v > m1) { m2 = m1; m1 = v; } else if (v > m2) m2 = v; } gs[g] = m1 + m2; }
    unsigned selmask = 0;
#pragma unroll
    for (int g = 0; g < 8; ++g) { int rank = 0;
#pragma unroll
        for (int q = 0; q < 8; ++q) rank += (gs[q] > gs[g] || (gs[q] == gs[g] && q < g)) ? 1 : 0; if (rank < 4) selmask |= 1u << g; }
    float tot = 0.f;
    for (int k = 0; k < 8; ++k) { float bv = -1e30f; int be = 0; for (int e = 0; e < 256; ++e) { if (!((selmask >> (e >> 5)) & 1u)) continue; bool used = false; for (int q = 0; q < k; ++q) used |= (ce[q] == e); if (used) continue; if (bs[e] > bv) { bv = bs[e]; be = e; } } ce[k] = be; cs[k] = sc[be]; tot += sc[be]; }
    float num = 0.f, den = 0.f;
    for (int k = 0; k < 8; ++k) { const float wr_ = cs[k] / tot * 2.5f; const int ge = tok_e[(size_t)tok * 8 + k]; const float gw = tok_w[(size_t)tok * 8 + k];
        num += (ge == ce[k] ? 0.f : 1.f) + (wr_ - gw) * (wr_ - gw); den += wr_ * wr_; }
    dbg_acc(w, stage, num, den);
}
template <bool FINAL> __global__ void dbg_moe(Args A, int layer, const int* tok_e, const float* tok_w, const bf16_t* H1, const bf16_t* H2, const float* OUT, float* w, int stage) {
    __shared__ float hrow[1024], hid[256], red[256];
    const int tid = threadIdx.x; const unsigned tok = hash32(blockIdx.x + 555u * stage) % NTOK;
    for (int i = tid; i < 1024; i += 256) hrow[i] = bf2f(H1[(size_t)tok * 1024 + i]);
    float acc[4] = {0.f, 0.f, 0.f, 0.f};
    __syncthreads();
    for (int k = 0; k < 9; ++k) {
        const int e = (k < 8) ? tok_e[(size_t)tok * 8 + k] : 256; const float wk = (k < 8) ? tok_w[(size_t)tok * 8 + k] : 1.f;
        const float* W1 = (e < 256) ? A.in[I_WEI] + (size_t)(layer * 256 + e) * 1024 * 512 : A.in[I_WSI] + (size_t)layer * 1024 * 512;
        const float* W2 = (e < 256) ? A.in[I_WED] + (size_t)(layer * 256 + e) * 256 * 1024 : A.in[I_WSD] + (size_t)layer * 256 * 1024;
        float gsum = 0.f, usum = 0.f;
        for (int kk = 0; kk < 1024; ++kk) { gsum += hrow[kk] * W1[(size_t)kk * 512 + tid]; usum += hrow[kk] * W1[(size_t)kk * 512 + 256 + tid]; }
        hid[tid] = gsum / (1.f + expf(-gsum)) * usum;
        __syncthreads();
        for (int q = 0; q < 4; ++q) { const int c = tid + 256 * q; float a = 0.f; for (int j = 0; j < 256; ++j) a += hid[j] * W2[(size_t)j * 1024 + c]; acc[q] += wk * a; }
        __syncthreads();
    }
    float z[4]; for (int q = 0; q < 4; ++q) z[q] = ALPHA * hrow[tid + 256 * q] + acc[q];
    red[tid] = z[0] + z[1] + z[2] + z[3]; __syncthreads();
    for (int st = 128; st > 0; st >>= 1) { if (tid < st) red[tid] += red[tid + st]; __syncthreads(); }
    const float mu = red[0] / 1024.f; __syncthreads();
    red[tid] = (z[0] - mu) * (z[0] - mu) + (z[1] - mu) * (z[1] - mu) + (z[2] - mu) * (z[2] - mu) + (z[3] - mu) * (z[3] - mu); __syncthreads();
    for (int st = 128; st > 0; st >>= 1) { if (tid < st) red[tid] += red[tid + st]; __syncthreads(); }
    const float rs = rsqrtf(red[0] / 1024.f + 1e-5f);
    const float* g = A.in[I_LFG] + layer * DM; const float* bb = A.in[I_LFB] + layer * DM;
    float num = 0.f, den = 0.f;
    for (int q = 0; q < 4; ++q) { const int c = tid + 256 * q; const float y = (z[q] - mu) * rs * g[c] + bb[c]; const float gg = FINAL ? OUT[(size_t)tok * 1024 + c] : bf2f(H2[(size_t)tok * 1024 + c]); num += (y - gg) * (y - gg); den += y * y; }
    dbg_acc(w, stage, num, den);
}
#ifndef DBG_REPORT
#define DBG_REPORT 0
#endif
__global__ void dbg_fill(float* out, const float* w) {
    __shared__ float cval;
    if (threadIdx.x == 0) {
        float c = 0.f;
        if (DBG_REPORT == 0) { for (int st = 1; st <= 13; ++st) { const float rel = sqrtf(w[2 * st] / fmaxf(w[2 * st + 1], 1e-30f)); if (!(rel < 0.08f) || !(w[2 * st + 1] > 0.f)) { c = (float)st; break; } } }
        else { const float rel = sqrtf(w[2 * DBG_REPORT] / fmaxf(w[2 * DBG_REPORT + 1], 1e-30f)); float l = -log10f(fmaxf(rel, 1e-8f)); l = fminf(fmaxf(l, -2.f), 8.f); c = 3.f + l; }
        cval = c;
    }
    __syncthreads();
    const float c = cval;
    if (c != 0.f) for (size_t i = (size_t)blockIdx.x * 256 + threadIdx.x; i < (size_t)NTOK * DM; i += (size_t)gridDim.x * 256) out[i] = c;
}
#endif

extern "C" void kernel_launch(void* const* d_in, const int* in_sizes, int n_in, void* d_out, int out_size, void* d_ws, size_t ws_size, hipStream_t stream) {
    static int grid = 0;
    if (grid == 0) {
        if (n_in != 22 || out_size != NTOK * DM || ws_size < WS_END) { fprintf(stderr, "kernel_launch: unexpected shapes (n_in %d out %d ws %zu)\n", n_in, out_size, ws_size); grid = -1; return; }
        if (hipFuncSetAttribute((const void*)fwd_kernel, hipFuncAttributeMaxDynamicSharedMemorySize, LDS_BYTES) != hipSuccess) { fprintf(stderr, "kernel_launch: hipFuncSetAttribute failed\n"); grid = -1; return; }
        int per_cu = 0;
        if (hipOccupancyMaxActiveBlocksPerMultiprocessor(&per_cu, (const void*)fwd_kernel, 512, LDS_BYTES) != hipSuccess || per_cu < 1) fprintf(stderr, "kernel_launch: occupancy query says %d\n", per_cu);
        (void)hipGetLastError();
        grid = NWG;
    }
    if (grid < 0) return;
    (void)hipMemsetAsync((char*)d_ws + WS_CTL, 0, CTL_BYTES, stream);
    Args a{};
    for (int i = 0; i < 22; ++i) a.in[i] = (const float*)d_in[i];
    a.out = (float*)d_out; a.ws = (unsigned char*)d_ws;
#if MK_ONE_LAUNCH
    a.ph_lo = 0; a.ph_hi = 23;
    hipLaunchKernelGGL(fwd_kernel, dim3(grid), dim3(512), LDS_BYTES, stream, a);
#else
    for (int p = 0; p < 23; ++p) { a.ph_lo = p; a.ph_hi = p + 1; hipLaunchKernelGGL(fwd_kernel, dim3(grid), dim3(512), LDS_BYTES, stream, a);
#ifdef DBG
        unsigned char* ws = (unsigned char*)d_ws; float* dw = (float*)(ws + WS_CTL) + CW_DBG;
        const int layer = (p - 1) / 11, q = (p - 1) % 11;
        MixP mp{(const bf16_t*)(ws + WS_PROJ), layer ? CWID : ABW, 0, (bf16_t*)(ws + WS_YMIX), (const float*)(ws + WS_GATES), (const float*)(ws + WS_MISC), a.in[I_BGK], a.in[I_HG], a.in[I_GG], a.in[I_CONV], a.in[I_BIF], (float*)(ws + WS_UST), (float*)(ws + WS_GSUM)};
        if (p == 0) hipLaunchKernelGGL(dbg_weights, dim3(256), dim3(256), 0, stream, a, dw);
        if (p >= 1 && q == 0) hipLaunchKernelGGL(dbg_gemm, dim3(64), dim3(256), 0, stream, (const bf16_t*)(ws + (layer ? WS_H2 : WS_HB)), 1024, (const bf16_t*)(ws + (layer ? WS_WC : WS_WAB)), (const void*)(ws + WS_PROJ), layer ? CWID : ABW, 0, NTOK, layer ? CWID : ABW, dw, layer ? 9 : 2);
        if (p >= 1 && q == 2 && layer == 0) { hipLaunchKernelGGL(dbg_mixer<0>, dim3(1), dim3(128), 0, stream, mp, 0, 1, 1100, dw, 3); hipLaunchKernelGGL(dbg_mixer<1>, dim3(1), dim3(128), 0, stream, mp, 1, 2, 1100, dw, 4); }
        if (p >= 1 && q == 2 && layer == 1) hipLaunchKernelGGL(dbg_mixer<2>, dim3(1), dim3(256), 0, stream, mp, 1, 1, 1100, dw, 10);
        if (p >= 1 && q == 4) hipLaunchKernelGGL(dbg_h1, dim3(32), dim3(256), 0, stream, (const bf16_t*)(ws + (layer ? WS_H2 : WS_HB)), (const bf16_t*)(ws + WS_YMIX), (const bf16_t*)(ws + (layer ? WS_WOC : WS_WOAB)), (const bf16_t*)(ws + WS_H1), a.in[I_LMG] + layer * DM, a.in[I_LMB] + layer * DM, dw, layer ? 11 : 5);
        if (p >= 1 && q == 5 && layer == 0) hipLaunchKernelGGL(dbg_gemm, dim3(64), dim3(256), 0, stream, (const bf16_t*)(ws + WS_H1), 1024, (const bf16_t*)(ws + WS_WR), (const void*)(ws + WS_LOGITS), 256, 1, NTOK, 256, dw, 6);
        if (p >= 1 && q == 6) hipLaunchKernelGGL(dbg_select, dim3(64), dim3(64), 0, stream, (const float*)(ws + WS_LOGITS), a.in[I_RB] + layer * NEXP, (const int*)(ws + WS_TOKE), (const float*)(ws + WS_TOKW), dw, layer ? 12 : 7);
        if (p >= 1 && q == 10 && layer == 0) hipLaunchKernelGGL(dbg_moe<false>, dim3(32), dim3(256), 0, stream, a, 0, (const int*)(ws + WS_TOKE), (const float*)(ws + WS_TOKW), (const bf16_t*)(ws + WS_H1), (const bf16_t*)(ws + WS_H2), (const float*)d_out, dw, 8);
        if (p >= 1 && q == 10 && layer == 1) { hipLaunchKernelGGL(dbg_moe<true>, dim3(32), dim3(256), 0, stream, a, 1, (const int*)(ws + WS_TOKE), (const float*)(ws + WS_TOKW), (const bf16_t*)(ws + WS_H1), (const bf16_t*)(ws + WS_H2), (const float*)d_out, dw, 13);
            hipLaunchKernelGGL(dbg_fill, dim3(1024), dim3(256), 0, stream, (float*)d_out, dw); }
#endif
    }
#endif
}
```

```cpp
#include <hip/hip_runtime.h>
#include <cstdio>
#include <cstdint>

#ifndef MK_ONE_LAUNCH
#define MK_ONE_LAUNCH 1
#endif

#define LAS __attribute__((address_space(3)))
typedef unsigned short bf16_t;
typedef short bf16x8 __attribute__((ext_vector_type(8)));
typedef float f32x4 __attribute__((ext_vector_type(4)));
typedef unsigned u32x4 __attribute__((ext_vector_type(4)));
typedef unsigned u32x2 __attribute__((ext_vector_type(2)));

constexpr int NTOK = 32768, SEQ = 16384, DM = 1024;
constexpr int ABW = 3840;
constexpr int CWID = 3072;
constexpr int NEXP = 256, NE1 = 257, TOPK = 8, NSLOT = 9;
constexpr float ALPHA = 1.41421356237f;
constexpr int NWG = 256;
constexpr int PRMAX = 262144 + 65536 + 32768;

constexpr size_t MiB = 1u << 20;
constexpr size_t WS_CTL = 0, CTL_BYTES = 1 * MiB;
constexpr size_t WS_MISC = 1 * MiB;
constexpr size_t WS_WAB = 2 * MiB, WS_WOAB = 10 * MiB, WS_WC = 12 * MiB, WS_WOC = 18 * MiB, WS_WR = 20 * MiB;
constexpr size_t WS_TOKE = 22 * MiB, WS_TOKP = 23 * MiB, WS_TOKW = 24 * MiB;
constexpr size_t WS_STOK = 26 * MiB, WS_POSY = 28 * MiB;
constexpr size_t WS_GATES = 32 * MiB;
constexpr size_t WS_UST = 34 * MiB, WS_GSUM = 54 * MiB;
constexpr size_t WS_LOGITS = 56 * MiB;
constexpr size_t WS_HB = 96 * MiB, WS_PROJ = 160 * MiB, WS_YMIX = 400 * MiB, WS_Z = 464 * MiB, WS_H1 = 528 * MiB, WS_H2 = 592 * MiB;
constexpr size_t WS_ACT = 656 * MiB, WS_Y = 832 * MiB, WS_W1T = 1540 * MiB, WS_W2T = 2056 * MiB;
constexpr size_t WS_XQ = 2320 * MiB, WS_H1Q = 2352 * MiB, WS_H2Q = 2384 * MiB, WS_END = 2416 * MiB;
constexpr float Q_SA = 127.f / 5.5f, Q_SW = 127.f * 32.f / 5.5f, Q_DEQ = 1.f / (Q_SA * Q_SW);
constexpr float Q_SACT = 127.f / 8.f, Q_DEQ2 = 16.f / (Q_SACT * Q_SW);
constexpr int CW_BAR = 4096;
constexpr int CW_CNT = 16384;
constexpr int CW_DBG = 20480;

__device__ __forceinline__ unsigned pk2(float lo, float hi) { unsigned r; asm volatile("v_cvt_pk_bf16_f32 %0, %1, %2" : "=v"(r) : "v"(lo), "v"(hi)); return r; }
__device__ __forceinline__ float bflo(unsigned u) { return __uint_as_float(u << 16); }
__device__ __forceinline__ float bfhi(unsigned u) { return __uint_as_float(u & 0xffff0000u); }
__device__ __forceinline__ float bf2f(bf16_t b) { return __uint_as_float(((unsigned)b) << 16); }
__device__ __forceinline__ float sigm(float x) { return __builtin_amdgcn_rcpf(1.f + __expf(-x)); }
__device__ __forceinline__ float silu(float x) { return x * __builtin_amdgcn_rcpf(1.f + __expf(-x)); }
__device__ __forceinline__ int q8(float x, float sc) { return (int)rintf(fminf(fmaxf(x * sc, -127.f), 127.f)); }
__device__ __forceinline__ unsigned pk4(int a, int b, int c, int d) { return (unsigned)(a & 255) | ((unsigned)(b & 255) << 8) | ((unsigned)(c & 255) << 16) | ((unsigned)d << 24); }
__device__ __forceinline__ float logsig(float x) { return fminf(x, 0.f) - __logf(1.f + __expf(-fabsf(x))); }

#define XB_TMO      128
#define XB_XCNT(j)  (256  + 64 * (j))
#define XB_XSUB(j)  (1280 + 64 * (j))
#define XB_XGEN(j)  (2304 + 64 * (j))
#define XB_TOP      3328
#define XB_TOPGEN   3392
#define XCD_BAR_WORDS 3456
#define XB_SPIN_CAP (1u << 22)
__device__ __forceinline__ unsigned xb_ld(unsigned* p)              { return __hip_atomic_load(p, __ATOMIC_RELAXED, __HIP_MEMORY_SCOPE_AGENT); }
__device__ __forceinline__ unsigned xb_add(unsigned* p, unsigned v) { return __hip_atomic_fetch_add(p, v, __ATOMIC_RELAXED, __HIP_MEMORY_SCOPE_AGENT); }
__device__ __forceinline__ unsigned xb_xcc_id() { return (unsigned)__builtin_amdgcn_s_getreg((3 << 11) | 20) & 0xFu; }
#define XB_SPIN(cond, bar) do { unsigned _sp = 0; while (cond) { __builtin_amdgcn_s_sleep(1); \
    if ((++_sp & 255u) == 0u) { if (xb_ld(&(bar)[XB_TMO])) break; if (_sp > XB_SPIN_CAP) { atomicAdd(&(bar)[XB_TMO], 1u); break; } } } } while (0)
struct XcdBarrier { unsigned* bar; unsigned x; volatile LAS unsigned* st; };
__device__ __forceinline__ XcdBarrier xcd_barrier_post(unsigned* bar, volatile LAS unsigned* st) {
    XcdBarrier b; b.bar = bar; b.x = xb_xcc_id(); b.st = st;
    if (threadIdx.x == 0) (void)xb_add(&bar[XB_XCNT(b.x)], 1u);
    return b;
}
__device__ __forceinline__ void xcd_barrier_complete(unsigned* bar, unsigned x, unsigned& nloc, unsigned& nx) {
    const unsigned G = gridDim.x * gridDim.y * gridDim.z;
    unsigned sum, cnt, mine, sp = 0u;
    for (;;) {
        sum = 0u; cnt = 0u; mine = 0u;
#pragma unroll
        for (unsigned j = 0; j < 16; ++j) { const unsigned c = xb_ld(&bar[XB_XCNT(j)]); sum += c; cnt += (c > 0u) ? 1u : 0u; mine = (j == x) ? c : mine; }
        if (sum == G) break;
        __builtin_amdgcn_s_sleep(1);
        if ((++sp & 255u) == 0u) { if (xb_ld(&bar[XB_TMO])) break; if (sp > XB_SPIN_CAP) { atomicAdd(&bar[XB_TMO], 1u); break; } }
    }
    nloc = mine > 0u ? mine : 1u; nx = cnt > 0u ? cnt : 1u;
}
__device__ __forceinline__ void xcd_barrier(const XcdBarrier& b) {
    asm volatile("s_waitcnt vmcnt(0)" ::: "memory");
    __syncthreads();
    if (threadIdx.x == 0) {
        unsigned* bar = b.bar;
        __builtin_amdgcn_s_waitcnt(0);
        unsigned nloc = b.st[0], nx = b.st[1];
        if (nloc == 0u) { xcd_barrier_complete(bar, b.x, nloc, nx); b.st[0] = nloc; b.st[1] = nx; }
        const unsigned old = xb_add(&bar[XB_XSUB(b.x)], 1u);
        const unsigned gen = old / nloc;
        if (old + 1u == (gen + 1u) * nloc) {
            __builtin_amdgcn_fence(__ATOMIC_RELEASE, "agent");
            asm volatile("s_waitcnt vmcnt(0)" ::: "memory");
            const unsigned og = xb_add(&bar[XB_TOP], 1u);
            const unsigned tg = og / nx;
            if (og + 1u == (tg + 1u) * nx) xb_add(&bar[XB_TOPGEN], 1u);
            else XB_SPIN(xb_ld(&bar[XB_TOPGEN]) == tg, bar);
            __builtin_amdgcn_fence(__ATOMIC_ACQUIRE, "agent");
            xb_add(&bar[XB_XGEN(b.x)], 1u);
            asm volatile("s_waitcnt vmcnt(0)" ::: "memory");
        } else {
            XB_SPIN(xb_ld(&bar[XB_XGEN(b.x)]) == gen, bar);
            __builtin_amdgcn_fence(__ATOMIC_ACQUIRE, "agent");
            asm volatile("s_waitcnt vmcnt(0)" ::: "memory");
        }
    }
    __syncthreads();
}

namespace pg8 {
constexpr int BM = 256, BK = 64, HALF = 128, HTB = HALF * BK * 2, STAGE_BYTES = 8 * HTB, NXCD = 8, WGM = 8;
__device__ __forceinline__ int lds_byte(int r, int c) { const int st = (r >> 4) * 2 + (c >> 5), rr = r & 15, cc = c & 31, ob = rr * 64 + cc * 2; return st * 1024 + (ob ^ (((ob >> 9) & 1) << 5)); }
__device__ __forceinline__ void stage_rc(int b, int& R, int& C) { const int st = b / 1024, sb = b % 1024, swz = sb ^ (((sb >> 9) & 1) << 5); R = (st >> 1) * 16 + swz / 64; C = (st & 1) * 32 + (swz % 64) / 2; }
__device__ __forceinline__ int perm32(int rho) { const int n = rho >> 4, i = rho & 15; return 8 * (i >> 2) + 4 * n + (i & 3); }
struct Unit { int pm, pn; };
struct Gemm { const bf16_t* A; const bf16_t* Bt; int K; };

struct StaticOrder {
    int nM, nN, nwg, G, c;
    __device__ void init(int M, int N, int G_, int c_) { nM = M / BM; nN = N / BM; nwg = nM * nN; G = G_; c = c_; }
    __device__ bool next(int i, Unit& u) const {
        const long L = (long)i * G + c; if (L >= nwg) return false;
        int wgid = (int)L; { const int q = nwg / NXCD, r = nwg % NXCD, xcd = wgid % NXCD, off = wgid / NXCD; wgid = (xcd < r ? xcd * (q + 1) : r * (q + 1) + (xcd - r) * q) + off; }
        const int nig = WGM * nN, gid = wgid / nig, fm = gid * WGM, gsz = (nM - fm) < WGM ? (nM - fm) : WGM;
        u.pm = fm + ((wgid % nig) % gsz); u.pn = (wgid % nig) / gsz; return true;
    }
};
struct MoeOrder {
    const LAS int* tab; int n;
    __device__ bool next(int i, Unit& u) const {
        if (i >= n) return false;
        u.pm = __builtin_amdgcn_readfirstlane(tab[2 * i]); u.pn = __builtin_amdgcn_readfirstlane(tab[2 * i + 1]); return true;
    }
};
constexpr int LDS_UT = 131072, LDS_IDX = 131072 + 512, MOE_MAXU = 15;
__device__ __forceinline__ int moe_prep(LAS unsigned char* lds, const int* __restrict__ tile_exp, int nunits, int sh, int G, int c, const int* __restrict__ rowidx) {
    const int tid = threadIdx.x;
    LAS int* tab = (LAS int*)(lds + LDS_UT);
    int n = 0; { const long rem = (long)nunits - c; n = rem > 0 ? (int)((rem + G - 1) / G) : 0; if (n > 32) n = 32; }
    if (tid < n) { const long L = (long)tid * G + c; const int rt = (int)(L >> sh), j = (int)L & ((1 << sh) - 1); tab[2 * tid] = rt; tab[2 * tid + 1] = (tile_exp[rt] << sh) + j; }
    __syncthreads();
    if (rowidx) { LAS int* idx = (LAS int*)(lds + LDS_IDX); const int nn = n < MOE_MAXU ? n : MOE_MAXU;
        for (int x = tid; x < nn * 256; x += 512) idx[x] = rowidx[tab[2 * (x >> 8)] * 256 + (x & 255)];
        __syncthreads(); }
    return n;
}

typedef int i32x4 __attribute__((ext_vector_type(4)));
template <class Epi, class Sched, bool GATHER, bool I8 = false>
__device__ __forceinline__ void gemm_phase(LAS unsigned char* lds, const Gemm g, const LAS int* rowidx, const Sched& S, const Epi& E) {
    const int tid = threadIdx.x, wid = __builtin_amdgcn_readfirstlane(tid >> 6), lane = tid & 63, wr = wid >> 2, wc = wid & 3, fr = lane & 15, fq = lane >> 4;
    const int K = g.K, nt = K / BK;
    unsigned voffB[2], cofs[2]; int Rr[2];
#pragma unroll
    for (int i = 0; i < 2; ++i) { int R, C; stage_rc(tid * 16 + i * 8192, R, C); const int Rb = Epi::PERM ? ((R & ~31) + perm32(R & 31)) : R;
        Rr[i] = R; cofs[i] = (unsigned)C * 2u; voffB[i] = (unsigned)(Rb * K + C) * 2u; }
    const unsigned rowb = (unsigned)K * 2u;
    const size_t kstep = (size_t)(BK * 2);
    const size_t hstep = (size_t)HALF * K * 2;
    const size_t tstep = 2 * hstep;
    const unsigned ldsw = (unsigned)wid * 1024u;
    const int aoff = lds_byte(wr * 64 + fr, fq * 8), boff = lds_byte(wc * 32 + fr, fq * 8);
    const char* Abase = (const char*)g.A;
#define PG8_SA(b, h) (((b) * 2 + (h)) * HTB)
#define PG8_SB(b, h) ((4 + (b) * 2 + (h)) * HTB)
#define PG8_STAGE(bufoff, gbase, voff) do { _Pragma("unroll") for (int _i = 0; _i < 2; ++_i) \
        __builtin_amdgcn_global_load_lds((const unsigned*)((const char*)(gbase) + (voff)[_i]), (LAS unsigned*)(lds + (bufoff) + ldsw + _i * 8192), 16, 0, 0); } while (0)
#define PG8_STAGEA(bufoff, kb, offs) do { _Pragma("unroll") for (int _i = 0; _i < 2; ++_i) \
        __builtin_amdgcn_global_load_lds((const unsigned*)(Abase + (size_t)((kb) + (offs)[_i])), (LAS unsigned*)(lds + (bufoff) + ldsw + _i * 8192), 16, 0, 0); } while (0)
#define PG8_ROWOFF(u, uo, O) do { _Pragma("unroll") for (int _h = 0; _h < 2; ++_h) _Pragma("unroll") for (int _i = 0; _i < 2; ++_i) { \
        int _row = (u).pm * BM + _h * HALF + Rr[_i]; if (GATHER) _row = rowidx[(uo) * 256 + _h * HALF + Rr[_i]]; (O)[_h][_i] = (unsigned)_row * rowb + cofs[_i]; } } while (0)
#define PG8_LDA(dst, b, h) do { _Pragma("unroll") for (int m = 0; m < 4; ++m) _Pragma("unroll") for (int k = 0; k < 2; ++k) dst[m][k] = *(const LAS bf16x8*)(lds + PG8_SA(b, h) + aoff + m * 2048 + k * 1024); } while (0)
#define PG8_LDB(dst, b, h) do { _Pragma("unroll") for (int n = 0; n < 2; ++n) _Pragma("unroll") for (int k = 0; k < 2; ++k) dst[n][k] = *(const LAS bf16x8*)(lds + PG8_SB(b, h) + boff + n * 2048 + k * 1024); } while (0)
#define PG8_MMA(ai, bj, At, Bt) do { __builtin_amdgcn_s_setprio(1); _Pragma("unroll") for (int m = 0; m < 4; ++m) _Pragma("unroll") for (int n = 0; n < 2; ++n) _Pragma("unroll") for (int k = 0; k < 2; ++k) \
        { if (I8) acc[ai][bj][m][n] = __builtin_bit_cast(f32x4, __builtin_amdgcn_mfma_i32_16x16x64_i8(__builtin_bit_cast(i32x4, Bt[n][k]), __builtin_bit_cast(i32x4, At[m][k]), __builtin_bit_cast(i32x4, acc[ai][bj][m][n]), 0, 0, 0)); \
          else acc[ai][bj][m][n] = __builtin_amdgcn_mfma_f32_16x16x32_bf16(Bt[n][k], At[m][k], acc[ai][bj][m][n], 0, 0, 0); } __builtin_amdgcn_s_setprio(0); } while (0)
#define PG8_WAIT_V(n) asm volatile("s_waitcnt vmcnt(" #n ")" ::: "memory")
#define PG8_WAIT_L(n) asm volatile("s_waitcnt lgkmcnt(" #n ")" ::: "memory")
#define PG8_BAR __builtin_amdgcn_s_barrier()
#define PG8_SCHED __builtin_amdgcn_sched_barrier(0)
    Unit cur, nxt; int ui = 0;
    if (!S.next(0, cur)) return;
    f32x4 acc[2][2][4][2];
#pragma unroll
    for (int a = 0; a < 2; ++a)
#pragma unroll
        for (int b = 0; b < 2; ++b)
#pragma unroll
            for (int m = 0; m < 4; ++m)
#pragma unroll
                for (int n = 0; n < 2; ++n) acc[a][b][m][n] = (f32x4){0.f, 0.f, 0.f, 0.f};
    bf16x8 At[4][2], B0[2][2], B1[2][2];
    unsigned cO[2][2], nO[2][2];
    PG8_ROWOFF(cur, 0, cO);
    const char* cB = (const char*)g.Bt + (size_t)cur.pn * tstep;
    PG8_STAGE(PG8_SB(0, 0), cB, voffB); PG8_STAGE(PG8_SB(0, 1), cB + hstep, voffB); PG8_STAGEA(PG8_SA(0, 0), 0u, cO[0]); PG8_STAGEA(PG8_SA(0, 1), 0u, cO[1]);
    if (wr == 1) PG8_BAR;
    PG8_WAIT_V(2); PG8_BAR;
    PG8_STAGE(PG8_SB(1, 0), cB + kstep, voffB); PG8_STAGEA(PG8_SA(1, 0), (unsigned)kstep, cO[0]); PG8_STAGE(PG8_SB(1, 1), cB + hstep + kstep, voffB);
    PG8_WAIT_V(6); PG8_BAR;
    for (;;) {
        const bool has_next = S.next(ui + 1, nxt);
        const char* nB = has_next ? (const char*)g.Bt + (size_t)nxt.pn * tstep : cB;
#pragma unroll
        for (int h = 0; h < 2; ++h)
#pragma unroll
            for (int i = 0; i < 2; ++i) nO[h][i] = cO[h][i];
#pragma unroll 1
        for (int t = 0; t < nt; t += 2) {
            const bool last = (t == nt - 2);
            if (last && has_next) PG8_ROWOFF(nxt, ui + 1, nO);
            const unsigned k1 = (unsigned)(t + 1) * (unsigned)kstep;
            const unsigned k2 = last ? 0u : (unsigned)(t + 2) * (unsigned)kstep, k3 = k2 + (unsigned)kstep;
            const char* b2 = last ? nB : cB + (size_t)(t + 2) * kstep; const char* b3 = b2 + kstep;
            unsigned o2[2][2];
#pragma unroll
            for (int h = 0; h < 2; ++h)
#pragma unroll
                for (int i = 0; i < 2; ++i) o2[h][i] = last ? nO[h][i] : cO[h][i];
            PG8_LDB(B0, 0, 0); PG8_LDB(B1, 0, 1); PG8_SCHED; PG8_LDA(At, 0, 0); PG8_STAGEA(PG8_SA(1, 1), k1, cO[1]);
            PG8_WAIT_V(8); PG8_WAIT_L(0); PG8_BAR; PG8_MMA(0, 0, At, B0); PG8_MMA(0, 1, At, B1); PG8_BAR; PG8_SCHED;
            PG8_LDA(At, 0, 1); PG8_STAGE(PG8_SB(0, 0), b2, voffB); PG8_STAGE(PG8_SB(0, 1), b2 + hstep, voffB); PG8_STAGEA(PG8_SA(0, 0), k2, o2[0]);
            PG8_WAIT_V(8); PG8_WAIT_L(0); PG8_BAR; PG8_MMA(1, 0, At, B0); PG8_MMA(1, 1, At, B1); PG8_BAR; PG8_SCHED;
            PG8_LDB(B0, 1, 0); PG8_LDB(B1, 1, 1); PG8_SCHED; PG8_LDA(At, 1, 0); PG8_STAGEA(PG8_SA(0, 1), k2, o2[1]);
            PG8_WAIT_V(8); PG8_WAIT_L(0); PG8_BAR; PG8_MMA(0, 0, At, B0); PG8_MMA(0, 1, At, B1); PG8_BAR; PG8_SCHED;
            PG8_LDA(At, 1, 1); PG8_STAGE(PG8_SB(1, 0), b3, voffB); PG8_STAGE(PG8_SB(1, 1), b3 + hstep, voffB); PG8_STAGEA(PG8_SA(1, 0), k3, o2[0]);
            PG8_WAIT_V(8); PG8_WAIT_L(0); PG8_BAR; PG8_MMA(1, 0, At, B0); PG8_MMA(1, 1, At, B1); PG8_BAR; PG8_SCHED;
        }
        if (wr == 0) PG8_BAR;
        E(acc, cur, wr, wc, fr, fq);
        if (!has_next) break;
#pragma unroll
        for (int a = 0; a < 2; ++a)
#pragma unroll
            for (int b = 0; b < 2; ++b)
#pragma unroll
                for (int m = 0; m < 4; ++m)
#pragma unroll
                    for (int n = 0; n < 2; ++n) acc[a][b][m][n] = (f32x4){0.f, 0.f, 0.f, 0.f};
        cur = nxt; cB = nB; ++ui;
#pragma unroll
        for (int h = 0; h < 2; ++h)
#pragma unroll
            for (int i = 0; i < 2; ++i) cO[h][i] = nO[h][i];
        if (wr == 1) PG8_BAR;
    }
    PG8_WAIT_V(0);
    PG8_BAR;
#undef PG8_SA
#undef PG8_SB
#undef PG8_STAGE
#undef PG8_STAGEA
#undef PG8_ROWOFF
#undef PG8_LDA
#undef PG8_LDB
#undef PG8_MMA
#undef PG8_WAIT_V
#undef PG8_WAIT_L
#undef PG8_BAR
#undef PG8_SCHED
}

template <bool I8> struct EpiStoreBf16 {
    static constexpr bool PERM = true;
    bf16_t* O; int ldc;
    static __device__ __forceinline__ f32x4 dq(f32x4 v) { if (I8) { const i32x4 q = __builtin_bit_cast(i32x4, v); return (f32x4){(float)q[0] * Q_DEQ, (float)q[1] * Q_DEQ, (float)q[2] * Q_DEQ, (float)q[3] * Q_DEQ}; } return v; }
    __device__ __forceinline__ void operator()(const f32x4 (&acc)[2][2][4][2], const Unit& u, int wr, int wc, int fr, int fq) const {
        const int row0 = u.pm * BM + wr * 64 + fr, col0 = u.pn * BM + wc * 32 + 8 * fq;
#pragma unroll
        for (int ai = 0; ai < 2; ++ai)
#pragma unroll
            for (int m = 0; m < 4; ++m) { bf16_t* rowp = O + (size_t)(row0 + ai * HALF + m * 16) * ldc + col0;
#pragma unroll
                for (int bj = 0; bj < 2; ++bj) { const f32x4 v0 = dq(acc[ai][bj][m][0]), v1 = dq(acc[ai][bj][m][1]);
                    u32x4 w; w.x = pk2(v0[0], v0[1]); w.y = pk2(v0[2], v0[3]); w.z = pk2(v1[0], v1[1]); w.w = pk2(v1[2], v1[3]);
                    *(u32x4*)(rowp + bj * HALF) = w; } }
    }
};
struct EpiResid {
    static constexpr bool PERM = true;
    bf16_t* Z; const bf16_t* H;
    __device__ __forceinline__ void operator()(const f32x4 (&acc)[2][2][4][2], const Unit& u, int wr, int wc, int fr, int fq) const {
        const int row0 = u.pm * BM + wr * 64 + fr, col0 = u.pn * BM + wc * 32 + 8 * fq;
#pragma unroll
        for (int ai = 0; ai < 2; ++ai)
#pragma unroll
            for (int m = 0; m < 4; ++m) { const size_t ro = (size_t)(row0 + ai * HALF + m * 16) * DM + col0;
#pragma unroll
                for (int bj = 0; bj < 2; ++bj) { const f32x4 v0 = acc[ai][bj][m][0], v1 = acc[ai][bj][m][1];
                    const u32x4 hh = *(const u32x4*)(H + ro + bj * HALF);
                    u32x4 w;
                    w.x = pk2(ALPHA * bflo(hh.x) + v0[0], ALPHA * bfhi(hh.x) + v0[1]); w.y = pk2(ALPHA * bflo(hh.y) + v0[2], ALPHA * bfhi(hh.y) + v0[3]);
                    w.z = pk2(ALPHA * bflo(hh.z) + v1[0], ALPHA * bfhi(hh.z) + v1[1]); w.w = pk2(ALPHA * bflo(hh.w) + v1[2], ALPHA * bfhi(hh.w) + v1[3]);
                    *(u32x4*)(Z + ro + bj * HALF) = w; } }
    }
};
struct EpiF32 {
    static constexpr bool PERM = false;
    float* C;
    __device__ __forceinline__ void operator()(const f32x4 (&acc)[2][2][4][2], const Unit& u, int wr, int wc, int fr, int fq) const {
        const int row0 = u.pm * BM + wr * 64 + fr, col0 = wc * 32 + 4 * fq;
#pragma unroll
        for (int ai = 0; ai < 2; ++ai)
#pragma unroll
            for (int m = 0; m < 4; ++m) { float* rowp = C + (size_t)(row0 + ai * HALF + m * 16) * 256 + col0;
#pragma unroll
                for (int bj = 0; bj < 2; ++bj)
#pragma unroll
                    for (int n = 0; n < 2; ++n) *(f32x4*)(rowp + bj * HALF + n * 16) = acc[ai][bj][m][n]; }
    }
};
template <bool I8> struct EpiSwiGLU {
    static constexpr bool PERM = true;
    unsigned char* ACT; LAS unsigned char* sbuf;
    static __device__ __forceinline__ f32x4 dq(f32x4 v) { if (I8) { const i32x4 q = __builtin_bit_cast(i32x4, v); return (f32x4){(float)q[0] * Q_DEQ, (float)q[1] * Q_DEQ, (float)q[2] * Q_DEQ, (float)q[3] * Q_DEQ}; } return v; }
    __device__ __forceinline__ void operator()(const f32x4 (&acc)[2][2][4][2], const Unit& u, int wr, int wc, int fr, int fq) const {
        const int tid = threadIdx.x, rrow = tid >> 3, rchunk = tid & 7;
        const int wrow = wr * 16 + fr;
        unsigned char* abase = ACT + (size_t)(u.pm * BM) * 256 + (u.pn & 1) * 128 + rchunk * 16;
#pragma unroll
        for (int st = 0; st < 8; ++st) {
            const int ai = st >> 2, m = st & 3;
            LAS unsigned char* buf = sbuf + (st & 1) * 4096;
            const f32x4 g0 = dq(acc[ai][0][m][0]), g1 = dq(acc[ai][0][m][1]), u0 = dq(acc[ai][1][m][0]), u1 = dq(acc[ai][1][m][1]);
            u32x2 w;
            w.x = pk4(q8(silu(g0[0]) * u0[0], Q_SACT), q8(silu(g0[1]) * u0[1], Q_SACT), q8(silu(g0[2]) * u0[2], Q_SACT), q8(silu(g0[3]) * u0[3], Q_SACT));
            w.y = pk4(q8(silu(g1[0]) * u1[0], Q_SACT), q8(silu(g1[1]) * u1[1], Q_SACT), q8(silu(g1[2]) * u1[2], Q_SACT), q8(silu(g1[3]) * u1[3], Q_SACT));
            const int c16 = wc * 2 + (fq >> 1);
            *(LAS u32x2*)(buf + wrow * 128 + ((c16 ^ (wrow & 7)) << 4) + (fq & 1) * 8) = w;
            asm volatile("s_waitcnt lgkmcnt(0)" ::: "memory"); __builtin_amdgcn_s_barrier(); asm volatile("" ::: "memory");
            if (tid < 256) {
                const u32x4 rv = *(const LAS u32x4*)(buf + rrow * 128 + ((rchunk ^ (rrow & 7)) << 4));
                const int grow = ai * HALF + (rrow >> 4) * 64 + m * 16 + (rrow & 15);
                *(u32x4*)(abase + (size_t)grow * 256) = rv;
            }
        }
        asm volatile("s_waitcnt lgkmcnt(0)" ::: "memory"); __builtin_amdgcn_s_barrier(); asm volatile("" ::: "memory");
    }
};
template <int EV = 0> struct EpiDownT {
    static constexpr bool PERM = true;
    unsigned char* Y; LAS unsigned char* sbuf;
    __device__ __forceinline__ void operator()(const f32x4 (&acc)[2][2][4][2], const Unit& u, int wr, int wc, int fr, int fq) const {
        const int tid = threadIdx.x, rrow = tid >> 4, rchunk = tid & 15;
        const int wrow = wr * 16 + fr;
        unsigned char* ybase = Y + (size_t)(u.pm * BM) * DM + (u.pn & 3) * 256 + rchunk * 16;
#pragma unroll
        for (int st = 0; st < 8; ++st) {
            const int ai = st >> 2, m = st & 3;
            LAS unsigned char* buf = sbuf + (st & 1) * 8192;
#pragma unroll
            for (int bj = 0; bj < 2; ++bj) { const i32x4 q0 = __builtin_bit_cast(i32x4, acc[ai][bj][m][0]), q1 = __builtin_bit_cast(i32x4, acc[ai][bj][m][1]);
                const f32x4 v0 = (f32x4){(float)q0[0] * Q_DEQ2, (float)q0[1] * Q_DEQ2, (float)q0[2] * Q_DEQ2, (float)q0[3] * Q_DEQ2}, v1 = (f32x4){(float)q1[0] * Q_DEQ2, (float)q1[1] * Q_DEQ2, (float)q1[2] * Q_DEQ2, (float)q1[3] * Q_DEQ2};
                int p0 = __builtin_amdgcn_cvt_pk_fp8_f32(v0[0], v0[1], 0, false); p0 = __builtin_amdgcn_cvt_pk_fp8_f32(v0[2], v0[3], p0, true);
                int p1 = __builtin_amdgcn_cvt_pk_fp8_f32(v1[0], v1[1], 0, false); p1 = __builtin_amdgcn_cvt_pk_fp8_f32(v1[2], v1[3], p1, true);
                u32x2 w; w.x = (unsigned)p0; w.y = (unsigned)p1;
                const int c16 = bj * 8 + wc * 2 + (fq >> 1);
                *(LAS u32x2*)(buf + wrow * 256 + ((c16 ^ (wrow & 15)) << 4) + (fq & 1) * 8) = w; }
            asm volatile("s_waitcnt lgkmcnt(0)" ::: "memory"); __builtin_amdgcn_s_barrier(); asm volatile("" ::: "memory");
            const u32x4 rv = *(const LAS u32x4*)(buf + rrow * 256 + ((rchunk ^ (rrow & 15)) << 4));
            const int grow = ai * HALF + (rrow >> 4) * 64 + m * 16 + (rrow & 15);
            if (EV == 1) { asm volatile("" :: "v"(rv.x), "v"(rv.y), "v"(rv.z), "v"(rv.w)); } else *(u32x4*)(ybase + (size_t)grow * DM) = rv;
        }
        asm volatile("s_waitcnt lgkmcnt(0)" ::: "memory"); __builtin_amdgcn_s_barrier(); asm volatile("" ::: "memory");
    }
};
typedef EpiDownT<0> EpiDown;
}

struct Args { const float* in[22]; float* out; unsigned char* ws; int ph_lo, ph_hi; };
enum { I_X = 0, I_WINAB, I_WGKUP, I_BGK, I_HG, I_GG, I_WOAB, I_LB, I_WINC, I_CONV, I_BIF, I_WOC, I_WR, I_RB, I_WEI, I_WED, I_WSI, I_WSD, I_LMG, I_LMB, I_LFG, I_LFB };

constexpr int LDS_MISC = 147200;
constexpr int LDS_BYTES = 147456;

__device__ __forceinline__ void cvt_tile(LAS unsigned char* lds, const float* __restrict__ src, size_t ldn, int k0, int n0, bf16_t* __restrict__ dst, int K, int drow0) {
    const int t = threadIdx.x;
    { const int c4 = (t & 15) * 4, r2 = t >> 4;
      const f32x4 a = *(const f32x4*)(src + (size_t)(k0 + 2 * r2) * ldn + n0 + c4);
      const f32x4 b = *(const f32x4*)(src + (size_t)(k0 + 2 * r2 + 1) * ldn + n0 + c4);
#pragma unroll
      for (int i = 0; i < 4; ++i) *(LAS unsigned*)(lds + ((c4 + i) * 72 + 2 * r2) * 2) = pk2(a[i], b[i]); }
    __syncthreads();
    { const int kk = (t & 7) * 8, n = t >> 3;
      const u32x4 v = *(const LAS u32x4*)(lds + (n * 72 + kk) * 2);
      *(u32x4*)(dst + (size_t)(drow0 + n) * K + k0 + kk) = v; }
    __syncthreads();
}
template <int NT>
__device__ __forceinline__ void cvt_multi(LAS unsigned char* lds, const float* __restrict__ src, size_t ldn, int k0, int n0, bf16_t* __restrict__ dst, int K, const int (&drow)[NT], float sc = 1.f) {
    const int t = threadIdx.x;
    { const int c4 = (t & 15) * 4, r2 = t >> 4;
      f32x4 a[NT], b[NT];
#pragma unroll
      for (int q = 0; q < NT; ++q) { a[q] = __builtin_nontemporal_load((const f32x4*)(src + (size_t)(k0 + 2 * r2) * ldn + n0 + 64 * q + c4)); b[q] = __builtin_nontemporal_load((const f32x4*)(src + (size_t)(k0 + 2 * r2 + 1) * ldn + n0 + 64 * q + c4)); }
#pragma unroll
      for (int q = 0; q < NT; ++q)
#pragma unroll
          for (int i = 0; i < 4; ++i) *(LAS unsigned*)(lds + q * 9216 + ((c4 + i) * 72 + 2 * r2) * 2) = pk2(a[q][i] * sc, b[q][i] * sc); }
    __syncthreads();
    { const int kk = (t & 7) * 8, n = t >> 3;
#pragma unroll
      for (int q = 0; q < NT; ++q) { const u32x4 v = *(const LAS u32x4*)(lds + q * 9216 + (n * 72 + kk) * 2); *(u32x4*)(dst + (size_t)(drow[q] + n) * K + k0 + kk) = v; } }
    __syncthreads();
}
template <int NT>
__device__ __forceinline__ void cvt8_multi(LAS unsigned char* lds, const float* __restrict__ src, size_t ldn, int k0, int n0, unsigned char* __restrict__ dst, int Kb, const int (&drow)[NT], float sc) {
    const int t = threadIdx.x;
    { const int c4 = (t & 15) * 4, r4 = t >> 4;
      f32x4 a[NT][4];
#pragma unroll
      for (int q = 0; q < NT; ++q)
#pragma unroll
          for (int j = 0; j < 4; ++j) a[q][j] = __builtin_nontemporal_load((const f32x4*)(src + (size_t)(k0 + 4 * r4 + j) * ldn + n0 + 64 * q + c4));
#pragma unroll
      for (int q = 0; q < NT; ++q)
#pragma unroll
          for (int i = 0; i < 4; ++i) *(LAS unsigned*)(lds + q * 9216 + (c4 + i) * 144 + 4 * r4) = pk4(q8(a[q][0][i], sc), q8(a[q][1][i], sc), q8(a[q][2][i], sc), q8(a[q][3][i], sc)); }
    __syncthreads();
    { const int kk = (t & 7) * 16, n = t >> 3;
#pragma unroll
      for (int q = 0; q < NT; ++q) { const u32x4 v = *(const LAS u32x4*)(lds + q * 9216 + n * 144 + kk); *(u32x4*)(dst + (size_t)(drow[q] + n) * Kb + k0 + kk) = v; } }
    __syncthreads();
}
template <int NT>
__device__ __forceinline__ void cvt8_matrix(LAS unsigned char* lds, const float* src, size_t ldn, int K, int n_lo, int ncols, unsigned char* dst, int drow_lo, float sc, int bid, int nb) {
    const int tk = K / 128, tn = ncols / (64 * NT);
    for (int j = bid; j < tk * tn; j += nb) { const int a = j / tn, b = j % tn; int dr[NT];
#pragma unroll
        for (int q = 0; q < NT; ++q) dr[q] = drow_lo + (b * NT + q) * 64;
        cvt8_multi<NT>(lds, src, ldn, a * 128, n_lo + b * 64 * NT, dst, K, dr, sc); }
}
template <int NT>
__device__ __forceinline__ void cvt_matrix(LAS unsigned char* lds, const float* src, size_t ldn, int K, int n_lo, int ncols, bf16_t* dst, int drow_lo, int bid, int nb) {
    const int tk = K / 64, tn = ncols / (64 * NT);
    for (int j = bid; j < tk * tn; j += nb) { const int a = j / tn, b = j % tn; int dr[NT];
#pragma unroll
        for (int q = 0; q < NT; ++q) dr[q] = drow_lo + (b * NT + q) * 64;
        cvt_multi<NT>(lds, src, ldn, a * 64, n_lo + b * 64 * NT, dst, K, dr); }
}
__device__ __forceinline__ void phase_prologue(LAS unsigned char* lds, const Args& A, int bid, int nb) {
    unsigned char* ws = A.ws; const int tid = threadIdx.x;
    if (bid == 0) {
        float* lb0 = (float*)(ws + WS_MISC);
        const float* l = A.in[I_LB];
        if (tid < 512) { const float a = l[tid], b = l[512 + tid], c = l[1024 + tid]; const float m = fmaxf(a, fmaxf(b, c));
            const float ea = __expf(a - m), eb = __expf(b - m), ec = __expf(c - m); lb0[tid] = ea / (ea + eb + ec); }
    }
    if (bid == 1 % nb) {
        float* wg = (float*)(ws + WS_MISC + 4096);
        for (int i = tid; i < 8 * 1024; i += 512) { const int g = i >> 10, k = i & 1023; wg[i] = A.in[I_WINC][(size_t)k * 3080 + 3072 + g]; }
    }
    { const float* x = A.in[I_X]; bf16_t* hb = (bf16_t*)(ws + WS_HB); unsigned char* xq = ws + WS_XQ;
      const size_t step = (size_t)nb * 512 * 8;
      for (size_t i0 = ((size_t)bid * 512 + tid) * 8; i0 < (size_t)NTOK * DM; i0 += 4 * step) {
          f32x4 a[4], b[4];
#pragma unroll
          for (int u = 0; u < 4; ++u) { const size_t i = i0 + u * step; if (i < (size_t)NTOK * DM) { a[u] = __builtin_nontemporal_load((const f32x4*)(x + i)); b[u] = __builtin_nontemporal_load((const f32x4*)(x + i + 4)); } }
#pragma unroll
          for (int u = 0; u < 4; ++u) { const size_t i = i0 + u * step; if (i < (size_t)NTOK * DM) {
              u32x4 w; w.x = pk2(a[u][0], a[u][1]); w.y = pk2(a[u][2], a[u][3]); w.z = pk2(b[u][0], b[u][1]); w.w = pk2(b[u][2], b[u][3]);
              *(u32x4*)(hb + i) = w;
              u32x2 qv; qv.x = pk4(q8(a[u][0], Q_SA), q8(a[u][1], Q_SA), q8(a[u][2], Q_SA), q8(a[u][3], Q_SA)); qv.y = pk4(q8(b[u][0], Q_SA), q8(b[u][1], Q_SA), q8(b[u][2], Q_SA), q8(b[u][3], Q_SA));
              *(u32x2*)(xq + i) = qv; } } } }
    { unsigned char* wab = ws + WS_WAB; const float* win = A.in[I_WINAB]; const float* wup = A.in[I_WGKUP];
      for (int o = bid * 512 + tid; o < 256 * 64; o += nb * 512) { const int j = o >> 6, k16 = (o & 63) * 16;
          float up[16];
#pragma unroll
          for (int r = 0; r < 16; ++r) up[r] = wup[r * 256 + j];
          int res[16];
#pragma unroll
          for (int q = 0; q < 16; ++q) { const float* wr_ = win + (size_t)(k16 + q) * 3600 + 3584; float sm = 0.f;
#pragma unroll
              for (int r = 0; r < 16; ++r) sm += wr_[r] * up[r];
              res[q] = q8(sm, Q_SW); }
          u32x4 w; w.x = pk4(res[0], res[1], res[2], res[3]); w.y = pk4(res[4], res[5], res[6], res[7]); w.z = pk4(res[8], res[9], res[10], res[11]); w.w = pk4(res[12], res[13], res[14], res[15]);
          *(u32x4*)(wab + (size_t)(3584 + j) * 1024 + k16) = w; } }
    cvt8_matrix<4>(lds, A.in[I_WINAB], 3600, 1024, 0, 3584, ws + WS_WAB, 0, Q_SW, bid, nb);
    cvt_matrix<8>(lds, A.in[I_WOAB], 1024, 1024, 0, 1024, (bf16_t*)(ws + WS_WOAB), 0, bid, nb);
    cvt8_matrix<4>(lds, A.in[I_WINC], 3080, 1024, 0, 3072, ws + WS_WC, 0, Q_SW, bid, nb);
    cvt_matrix<8>(lds, A.in[I_WOC], 1024, 1024, 0, 1024, (bf16_t*)(ws + WS_WOC), 0, bid, nb);
    cvt_matrix<4>(lds, A.in[I_WR], 256, 1024, 0, 256, (bf16_t*)(ws + WS_WR), 0, bid, nb);
    cvt_matrix<4>(lds, A.in[I_WR] + 1024 * 256, 256, 1024, 0, 256, (bf16_t*)(ws + WS_WR) + 256 * 1024, 0, bid, nb);
    for (int j = bid; j < 2 * NE1 * 16; j += nb) {
        const int le = j % (2 * NE1), t0 = j / (2 * NE1), layer = le / NE1, e = le % NE1;
        const int t = (t0 < 8) ? 2 * t0 : 8 + t0;
        if (t < 16) {
            const float* src = (e < NEXP) ? A.in[I_WEI] + ((size_t)(layer * NEXP + e)) * 1024 * 512 : A.in[I_WSI] + (size_t)layer * 1024 * 512;
            unsigned char* dst = ws + WS_W1T + ((size_t)(layer * NE1 + e)) * 512 * 1024;
            const int tk = t >> 1;
            int dr[8];
#pragma unroll
            for (int q = 0; q < 8; ++q) { const int n0 = q * 64, gq = n0 >> 8, nn = n0 & 255; dr[q] = (nn >> 7) * 256 + gq * 128 + (nn & 127); }
            cvt8_multi<8>(lds, src, 512, tk * 128, 0, dst, 1024, dr, Q_SW);
        } else {
            const int t2 = t - 16, tk = t2 >> 2, g4 = t2 & 3;
            const float* src = (e < NEXP) ? A.in[I_WED] + ((size_t)(layer * NEXP + e)) * 256 * 1024 : A.in[I_WSD] + (size_t)layer * 256 * 1024;
            unsigned char* dst = ws + WS_W2T + ((size_t)(layer * NE1 + e)) * 1024 * 256;
            int dr[4];
#pragma unroll
            for (int q = 0; q < 4; ++q) dr[q] = g4 * 256 + q * 64;
            cvt8_multi<4>(lds, src, 1024, tk * 128, g4 * 256, dst, 256, dr, Q_SW);
        }
    }
}

__device__ __forceinline__ void phase_ln(const bf16_t* __restrict__ Z, bf16_t* __restrict__ H, unsigned char* __restrict__ HQ, const float* __restrict__ g, const float* __restrict__ b, int bid, int nb) {
    const int lane = threadIdx.x & 63, gw = bid * 8 + (threadIdx.x >> 6), nw = nb * 8;
    float gg[16], bb[16];
#pragma unroll
    for (int i = 0; i < 8; ++i) { gg[i] = g[lane * 8 + i]; gg[8 + i] = g[512 + lane * 8 + i]; bb[i] = b[lane * 8 + i]; bb[8 + i] = b[512 + lane * 8 + i]; }
    for (int row = gw; row < NTOK; row += nw) {
        const u32x4 a = *(const u32x4*)(Z + (size_t)row * DM + lane * 8), c = *(const u32x4*)(Z + (size_t)row * DM + 512 + lane * 8);
        float v[16];
        v[0] = bflo(a.x); v[1] = bfhi(a.x); v[2] = bflo(a.y); v[3] = bfhi(a.y); v[4] = bflo(a.z); v[5] = bfhi(a.z); v[6] = bflo(a.w); v[7] = bfhi(a.w);
        v[8] = bflo(c.x); v[9] = bfhi(c.x); v[10] = bflo(c.y); v[11] = bfhi(c.y); v[12] = bflo(c.z); v[13] = bfhi(c.z); v[14] = bflo(c.w); v[15] = bfhi(c.w);
        float s = 0.f;
#pragma unroll
        for (int i = 0; i < 16; ++i) s += v[i];
#pragma unroll
        for (int o = 32; o > 0; o >>= 1) s += __shfl_xor(s, o);
        const float mu = s * (1.f / 1024.f);
        float q = 0.f;
#pragma unroll
        for (int i = 0; i < 16; ++i) { const float d = v[i] - mu; q += d * d; }
#pragma unroll
        for (int o = 32; o > 0; o >>= 1) q += __shfl_xor(q, o);
        const float rs = rsqrtf(q * (1.f / 1024.f) + 1e-5f);
        float y[16];
#pragma unroll
        for (int i = 0; i < 16; ++i) y[i] = (v[i] - mu) * rs * gg[i] + bb[i];
        u32x4 w0, w1; w0.x = pk2(y[0], y[1]); w0.y = pk2(y[2], y[3]); w0.z = pk2(y[4], y[5]); w0.w = pk2(y[6], y[7]);
        w1.x = pk2(y[8], y[9]); w1.y = pk2(y[10], y[11]); w1.z = pk2(y[12], y[13]); w1.w = pk2(y[14], y[15]);
        *(u32x4*)(H + (size_t)row * DM + lane * 8) = w0; *(u32x4*)(H + (size_t)row * DM + 512 + lane * 8) = w1;
        u32x2 q0, q1;
        q0.x = pk4(q8(y[0], Q_SA), q8(y[1], Q_SA), q8(y[2], Q_SA), q8(y[3], Q_SA)); q0.y = pk4(q8(y[4], Q_SA), q8(y[5], Q_SA), q8(y[6], Q_SA), q8(y[7], Q_SA));
        q1.x = pk4(q8(y[8], Q_SA), q8(y[9], Q_SA), q8(y[10], Q_SA), q8(y[11], Q_SA)); q1.y = pk4(q8(y[12], Q_SA), q8(y[13], Q_SA), q8(y[14], Q_SA), q8(y[15], Q_SA));
        *(u32x2*)(HQ + (size_t)row * DM + lane * 8) = q0; *(u32x2*)(HQ + (size_t)row * DM + 512 + lane * 8) = q1;
    }
}

template <bool FINAL>
__device__ __forceinline__ void phase_combine(const unsigned char* __restrict__ Y, const int* __restrict__ posy, const float* __restrict__ tokw, const int* __restrict__ ntiles,
                                              const bf16_t* __restrict__ H1, bf16_t* __restrict__ H2, unsigned char* __restrict__ H2Q, float* __restrict__ OUT, float* __restrict__ GATES,
                                              const float* __restrict__ wgate, const float* __restrict__ g, const float* __restrict__ b, int bid, int nb) {
    const int shbase = (*ntiles - NTOK / 256) * 256;
    const int lane = threadIdx.x & 63, gw = bid * 8 + (threadIdx.x >> 6), nw = nb * 8;
    int npos = 0; float nwk = 0.f;
    if (gw < NTOK) { npos = (lane < 8) ? posy[(size_t)gw * 8 + lane] : shbase + gw; nwk = (lane < 8) ? tokw[(size_t)gw * 8 + lane] : 1.0f; }
    for (int row = gw; row < NTOK; row += nw) {
        const int cpos = npos; const float cwk = nwk;
        { const int nr = row + nw; if (nr < NTOK) { npos = (lane < 8) ? posy[(size_t)nr * 8 + lane] : shbase + nr; nwk = (lane < 8) ? tokw[(size_t)nr * 8 + lane] : 1.0f; } }
        float v[16];
        { const u32x4 a = *(const u32x4*)(H1 + (size_t)row * DM + lane * 8), c = *(const u32x4*)(H1 + (size_t)row * DM + 512 + lane * 8);
          v[0] = bflo(a.x); v[1] = bfhi(a.x); v[2] = bflo(a.y); v[3] = bfhi(a.y); v[4] = bflo(a.z); v[5] = bfhi(a.z); v[6] = bflo(a.w); v[7] = bfhi(a.w);
          v[8] = bflo(c.x); v[9] = bfhi(c.x); v[10] = bflo(c.y); v[11] = bfhi(c.y); v[12] = bflo(c.z); v[13] = bfhi(c.z); v[14] = bflo(c.w); v[15] = bfhi(c.w); }
#pragma unroll
        for (int i = 0; i < 16; ++i) v[i] *= ALPHA;
        u32x2 ya[NSLOT], yc[NSLOT]; float wks[NSLOT];
#pragma unroll
        for (int k = 0; k < NSLOT; ++k) {
            const int pos = __builtin_amdgcn_readlane(cpos, k); wks[k] = __uint_as_float(__builtin_amdgcn_readlane(__float_as_uint(cwk), k)) * 0.0625f;
            const unsigned char* yr = Y + (size_t)pos * DM;
            ya[k] = *(const u32x2*)(yr + lane * 8); yc[k] = *(const u32x2*)(yr + 512 + lane * 8);
        }
        typedef float f32x2_ __attribute__((ext_vector_type(2)));
#pragma unroll
        for (int k = 0; k < NSLOT; ++k) {
            const float wk = wks[k];
            const f32x2_ a0 = __builtin_amdgcn_cvt_pk_f32_fp8((int)ya[k].x, false), a1 = __builtin_amdgcn_cvt_pk_f32_fp8((int)ya[k].x, true), a2 = __builtin_amdgcn_cvt_pk_f32_fp8((int)ya[k].y, false), a3 = __builtin_amdgcn_cvt_pk_f32_fp8((int)ya[k].y, true);
            const f32x2_ c0 = __builtin_amdgcn_cvt_pk_f32_fp8((int)yc[k].x, false), c1 = __builtin_amdgcn_cvt_pk_f32_fp8((int)yc[k].x, true), c2 = __builtin_amdgcn_cvt_pk_f32_fp8((int)yc[k].y, false), c3 = __builtin_amdgcn_cvt_pk_f32_fp8((int)yc[k].y, true);
            v[0] += wk * a0.x; v[1] += wk * a0.y; v[2] += wk * a1.x; v[3] += wk * a1.y; v[4] += wk * a2.x; v[5] += wk * a2.y; v[6] += wk * a3.x; v[7] += wk * a3.y;
            v[8] += wk * c0.x; v[9] += wk * c0.y; v[10] += wk * c1.x; v[11] += wk * c1.y; v[12] += wk * c2.x; v[13] += wk * c2.y; v[14] += wk * c3.x; v[15] += wk * c3.y;
        }
        float s = 0.f;
#pragma unroll
        for (int i = 0; i < 16; ++i) s += v[i];
#pragma unroll
        for (int o = 32; o > 0; o >>= 1) s += __shfl_xor(s, o);
        const float mu = s * (1.f / 1024.f);
        float q = 0.f;
#pragma unroll
        for (int i = 0; i < 16; ++i) { const float d = v[i] - mu; q += d * d; }
#pragma unroll
        for (int o = 32; o > 0; o >>= 1) q += __shfl_xor(q, o);
        const float rs = rsqrtf(q * (1.f / 1024.f) + 1e-5f);
        float y[16];
#pragma unroll
        for (int i = 0; i < 8; ++i) { y[i] = (v[i] - mu) * rs * g[lane * 8 + i] + b[lane * 8 + i]; y[8 + i] = (v[8 + i] - mu) * rs * g[512 + lane * 8 + i] + b[512 + lane * 8 + i]; }
        if (FINAL) {
            float* o = OUT + (size_t)row * DM;
            *(f32x4*)(o + lane * 8) = (f32x4){y[0], y[1], y[2], y[3]}; *(f32x4*)(o + lane * 8 + 4) = (f32x4){y[4], y[5], y[6], y[7]};
            *(f32x4*)(o + 512 + lane * 8) = (f32x4){y[8], y[9], y[10], y[11]}; *(f32x4*)(o + 512 + lane * 8 + 4) = (f32x4){y[12], y[13], y[14], y[15]};
        } else {
            u32x4 w0, w1; w0.x = pk2(y[0], y[1]); w0.y = pk2(y[2], y[3]); w0.z = pk2(y[4], y[5]); w0.w = pk2(y[6], y[7]);
            w1.x = pk2(y[8], y[9]); w1.y = pk2(y[10], y[11]); w1.z = pk2(y[12], y[13]); w1.w = pk2(y[14], y[15]);
            *(u32x4*)(H2 + (size_t)row * DM + lane * 8) = w0; *(u32x4*)(H2 + (size_t)row * DM + 512 + lane * 8) = w1;
            { u32x2 q0, q1;
              q0.x = pk4(q8(y[0], Q_SA), q8(y[1], Q_SA), q8(y[2], Q_SA), q8(y[3], Q_SA)); q0.y = pk4(q8(y[4], Q_SA), q8(y[5], Q_SA), q8(y[6], Q_SA), q8(y[7], Q_SA));
              q1.x = pk4(q8(y[8], Q_SA), q8(y[9], Q_SA), q8(y[10], Q_SA), q8(y[11], Q_SA)); q1.y = pk4(q8(y[12], Q_SA), q8(y[13], Q_SA), q8(y[14], Q_SA), q8(y[15], Q_SA));
              *(u32x2*)(H2Q + (size_t)row * DM + lane * 8) = q0; *(u32x2*)(H2Q + (size_t)row * DM + 512 + lane * 8) = q1; }
            float yr[16];
            yr[0] = bflo(w0.x); yr[1] = bfhi(w0.x); yr[2] = bflo(w0.y); yr[3] = bfhi(w0.y); yr[4] = bflo(w0.z); yr[5] = bfhi(w0.z); yr[6] = bflo(w0.w); yr[7] = bfhi(w0.w);
            yr[8] = bflo(w1.x); yr[9] = bfhi(w1.x); yr[10] = bflo(w1.y); yr[11] = bfhi(w1.y); yr[12] = bflo(w1.z); yr[13] = bfhi(w1.z); yr[14] = bflo(w1.w); yr[15] = bfhi(w1.w);
            float gsum = 0.f;
#pragma unroll
            for (int gi = 0; gi < 8; ++gi) {
                const float* wp = wgate + gi * 1024; float d = 0.f;
#pragma unroll
                for (int i = 0; i < 8; ++i) d += yr[i] * wp[lane * 8 + i] + yr[8 + i] * wp[512 + lane * 8 + i];
#pragma unroll
                for (int o = 32; o > 0; o >>= 1) d += __shfl_xor(d, o);
                gsum = (lane == gi) ? d : gsum;
            }
            if (lane < 8) GATES[(size_t)row * 8 + lane] = gsum;
        }
    }
}

#ifndef VARSEL
#define VARSEL 0
#endif
template <bool DRY>
__device__ __forceinline__ void phase_select(LAS unsigned char* lds, const float* __restrict__ logits, const float* __restrict__ rbias, int* __restrict__ tok_e, int* __restrict__ tok_p,
                                             float* __restrict__ tok_w, unsigned* __restrict__ cnt, int bid, int nb) {
    const int tid = threadIdx.x, it = tid & 63, g8 = tid >> 6;
    LAS unsigned* hist = (LAS unsigned*)lds;
    LAS unsigned* base = hist + 256;
    LAS int* selE = (LAS int*)(base + 256);
    LAS int* selR = selE + 1024;
    LAS float* gsl = (LAS float*)(lds + 10240);
    LAS float* lv = (LAS float*)(lds + 12288);
    LAS int* le = (LAS int*)(lds + 28672);
    LAS float* sb = (LAS float*)(lds + 45056);
    const int tpw = NTOK / nb;
    const int t0 = bid * tpw;
    const float NEG = -3.0e38f;
    if (tid < 256) hist[tid] = 0u;
    __syncthreads();
    for (int half = 0; half < tpw / 64; ++half) {
        const int tb = t0 + half * 64;
        {
            const int e = tid & 255, tk0 = tid >> 8; const float rb = rbias[e];
#pragma unroll
            for (int i0 = 0; i0 < 32; i0 += 8) { float lv8[8];
#pragma unroll
                for (int u = 0; u < 8; ++u) lv8[u] = logits[(size_t)(tb + tk0 + 2 * (i0 + u)) * 256 + e];
#pragma unroll
                for (int u = 0; u < 8; ++u) sb[e * 65 + tk0 + 2 * (i0 + u)] = sigm(lv8[u]) + rb; }
        }
        __syncthreads();
        {
            float m1 = NEG, m2 = NEG;
            for (int j = 0; j < 32; ++j) { const float v = sb[(g8 * 32 + j) * 65 + it]; if (v > m1) { m2 = m1; m1 = v; } else if (v > m2) m2 = v; }
            gsl[g8 * 64 + it] = m1 + m2;
        }
        __syncthreads();
        if (DRY && VARSEL == 1) { __syncthreads(); continue; }
        float G[8];
#pragma unroll
        for (int q = 0; q < 8; ++q) G[q] = gsl[q * 64 + it];
        unsigned selmask = 0u;
#pragma unroll
        for (int g = 0; g < 8; ++g) { int rank = 0;
#pragma unroll
            for (int q = 0; q < 8; ++q) rank += (G[q] > G[g] || (G[q] == G[g] && q < g)) ? 1 : 0;
            if (rank < 4) selmask |= 1u << g; }
        if ((selmask >> g8) & 1u) {
            float vv[32];
#pragma unroll
            for (int j = 0; j < 32; ++j) vv[j] = sb[(g8 * 32 + j) * 65 + it];
#pragma unroll
            for (int k = 0; k < 8; ++k) {
                float bv = vv[0]; int bj = 0;
#pragma unroll
                for (int j = 1; j < 32; ++j) { const bool gt = vv[j] > bv; bv = gt ? vv[j] : bv; bj = gt ? j : bj; }
#pragma unroll
                for (int j = 0; j < 32; ++j) vv[j] = (j == bj) ? NEG : vv[j];
                lv[(g8 * 8 + k) * 64 + it] = bv; le[(g8 * 8 + k) * 64 + it] = g8 * 32 + bj;
            }
        }
        __syncthreads();
        if (DRY && VARSEL == 2) { __syncthreads(); continue; }
        if (tid < 64) {
            int gid[4]; { int n = 0;
#pragma unroll
                for (int g = 0; g < 8; ++g) if ((selmask >> g) & 1u) { if (n == 0) gid[0] = g; else if (n == 1) gid[1] = g; else if (n == 2) gid[2] = g; else gid[3] = g; ++n; } }
            float hv[4]; int hp[4];
#pragma unroll
            for (int j = 0; j < 4; ++j) { hp[j] = 0; hv[j] = lv[(gid[j] * 8) * 64 + it]; }
            float sc8[8]; int te[8]; float tot = 0.f;
#pragma unroll
            for (int k = 0; k < 8; ++k) {
                int bj = 0; float bv = hv[0];
                if (hv[1] > bv) { bv = hv[1]; bj = 1; }
                if (hv[2] > bv) { bv = hv[2]; bj = 2; }
                if (hv[3] > bv) { bv = hv[3]; bj = 3; }
                const int gsel = (bj == 0) ? gid[0] : (bj == 1) ? gid[1] : (bj == 2) ? gid[2] : gid[3];
                const int psel = (bj == 0) ? hp[0] : (bj == 1) ? hp[1] : (bj == 2) ? hp[2] : hp[3];
                const int e = le[(gsel * 8 + psel) * 64 + it];
                te[k] = e; sc8[k] = bv - rbias[e]; tot += sc8[k];
                const float nv = (psel < 7) ? lv[(gsel * 8 + psel + 1) * 64 + it] : NEG;
                if (bj == 0) { hv[0] = nv; hp[0] = psel + 1; } else if (bj == 1) { hv[1] = nv; hp[1] = psel + 1; } else if (bj == 2) { hv[2] = nv; hp[2] = psel + 1; } else { hv[3] = nv; hp[3] = psel + 1; }
            }
            const float inv = 2.5f / tot;
            const int tok = tb + it, lt = half * 64 + it;
#pragma unroll
            for (int k = 0; k < 8; ++k) {
                tok_e[(size_t)tok * 8 + k] = te[k]; tok_w[(size_t)tok * 8 + k] = sc8[k] * inv;
                const unsigned r = atomicAdd((unsigned*)&hist[te[k]], 1u);
                selE[lt * 8 + k] = te[k]; selR[lt * 8 + k] = (int)r;
            }
        }
        __syncthreads();
    }
    if (DRY) return;
    if (tid < 256) { const unsigned c = hist[tid]; base[tid] = c ? __hip_atomic_fetch_add(cnt + tid, c, __ATOMIC_RELAXED, __HIP_MEMORY_SCOPE_AGENT) : 0u; }
    __syncthreads();
    for (int i = tid; i < tpw * 8; i += 512) tok_p[(size_t)t0 * 8 + i] = (int)base[selE[i]] + selR[i];
    __syncthreads();
}

__device__ __forceinline__ void phase_dispatch(LAS unsigned char* lds, const unsigned* __restrict__ cnt, const int* __restrict__ tok_e, const int* __restrict__ tok_p,
                                               int* __restrict__ s_tok, int* __restrict__ posy, int* __restrict__ tile_exp, int* __restrict__ ntiles, int bid, int nb) {
    const int tid = threadIdx.x;
    LAS int* tstart = (LAS int*)lds;
    LAS int* tcnt = tstart + 260;
    if (tid < 256) tcnt[tid] = (int)((__hip_atomic_load(cnt + tid, __ATOMIC_RELAXED, __HIP_MEMORY_SCOPE_AGENT) + 255u) >> 8);
    __syncthreads();
    if (tid < 256) { int a = 0;
#pragma unroll 16
        for (int j = 0; j < 256; ++j) { const int c = tcnt[j]; a += (j < tid) ? c : 0; }
        tstart[tid] = a; if (tid == 255) tstart[256] = a + tcnt[255]; }
    __syncthreads();
    const int TT = tstart[256];
    const int tpw = NTOK / nb, t0 = bid * tpw;
    for (int i = tid; i < tpw * 8; i += 512) {
        const size_t a = (size_t)t0 * 8 + i; const int e = tok_e[a], p = tok_p[a];
        const int pos = tstart[e] * 256 + p;
        s_tok[pos] = (int)(a >> 3); posy[a] = pos;
    }
    for (int i = tid; i < tpw; i += 512) { const int tok = t0 + i; s_tok[TT * 256 + tok] = tok; }
    for (int e = bid; e < 256; e += nb) {
        const int c = (int)__hip_atomic_load(cnt + e, __ATOMIC_RELAXED, __HIP_MEMORY_SCOPE_AGENT), ts = tstart[e], tc = tcnt[e];
        for (int i = c + tid; i < tc * 256; i += 512) s_tok[ts * 256 + i] = 0;
        for (int i = tid; i < tc; i += 512) tile_exp[ts + i] = e;
    }
    if (bid == 0) { for (int i = tid; i < NTOK / 256; i += 512) tile_exp[TT + i] = 256; if (tid == 0) *ntiles = TT + NTOK / 256; }
    __syncthreads();
}

constexpr int MX_QT = 0, MX_KT = 17408, MX_KHT = 34816, MX_VT = 53248, MX_P = 73984, MX_ST = 83200, MX_SEG = 122368, MX_GD = 126464, MX_ER = 126976, MX_RS = 127488, MX_DEN = 128000, MX_BC = 128256, MX_IP = 128512, MX_GT = 128768;
struct MixP {
    const bf16_t* proj; int ldp; int pad0; bf16_t* ymix; const float* gates;
    const float* lb0; const float* bgk; const float* hg; const float* gg; const float* conv; const float* bif;
    float* ust; float* gsum;
};
#define MFMA16(a, b, c) __builtin_amdgcn_mfma_f32_16x16x32_bf16((a), (b), (c), 0, 0, 0)

template <int MODE, bool FULL, int VAR = 0>
__device__ __forceinline__ void mixer_run(LAS unsigned char* lds, const MixP& mp, int bid) {
    constexpr int DK = (MODE == 1) ? 64 : 128, QP = DK + 8, CP = DK / 2, RG = 512 / CP, RPT = 64 / RG, KS = DK / 32;
    constexpr int NVT = (MODE == 2) ? 9 : 8;
    constexpr int NST = (DK == 128) ? NVT : 4;
    const int tid = threadIdx.x, lane = tid & 63, w = __builtin_amdgcn_readfirstlane(tid >> 6), l15 = lane & 15, l4 = lane >> 4;
    int b, h, vh = 0, seg;
    if (MODE == 0) { const int sq = bid >> 4; b = sq >> 2; h = sq & 3; seg = bid & 15; }
    else if (MODE == 1) { const int sq = (bid - 128) >> 4; b = sq >> 2; h = sq & 3; seg = bid & 15; }
    else { const int sq = bid >> 4; b = sq >> 3; h = (sq >> 1) & 3; vh = sq & 1; seg = bid & 15; }
    const int tok0 = b * SEQ + seg * 1024;
    const int ldp = mp.ldp; const bf16_t* proj = mp.proj;
    int cq, ck, cv, cg, cy;
    if (MODE == 0) { cq = h * 128; ck = 512 + h * 128; cv = 1024 + h * 128; cg = 1536 + h * 128; cy = h * 128; }
    else if (MODE == 1) { cq = 2048 + h * 64; ck = 2304 + h * 64; cv = 2560 + h * 128; cg = 3072 + h * 128; cy = 512 + h * 128; }
    else { cq = h * 128; ck = 512 + h * 128; cv = 1024 + h * 256 + vh * 128; cg = 2048 + h * 256 + vh * 128; cy = h * 256 + vh * 128; }
    const int cu = 3584 + h * 64;
    const int cp = tid % CP, rg = tid / CP, d0 = 2 * cp;
    float lbv[2] = {0.f, 0.f}, oml[2] = {0.f, 0.f}, bgk[2] = {0.f, 0.f}, cwq[4][2], cwk[4][2];
    if (MODE == 0) { lbv[0] = mp.lb0[h * 128 + d0]; lbv[1] = mp.lb0[h * 128 + d0 + 1]; oml[0] = 1.f - lbv[0]; oml[1] = 1.f - lbv[1]; }
    if (MODE == 1) { bgk[0] = mp.bgk[h * 64 + d0]; bgk[1] = mp.bgk[h * 64 + d0 + 1]; }
#pragma unroll
    for (int j = 0; j < 4; ++j) { cwq[j][0] = cwq[j][1] = cwk[j][0] = cwk[j][1] = 0.f; }
    if (MODE == 2) {
#pragma unroll
        for (int j = 0; j < 4; ++j) { cwq[j][0] = mp.conv[j * 1024 + cq + d0]; cwq[j][1] = mp.conv[j * 1024 + cq + d0 + 1]; cwk[j][0] = mp.conv[j * 1024 + ck + d0]; cwk[j][1] = mp.conv[j * 1024 + ck + d0 + 1]; }
    }
    const float bi = (MODE == 2) ? mp.bif[h] : 0.f, bfg = (MODE == 2) ? mp.bif[4 + h] : 0.f;
    const int sdt = (DK == 128) ? w : (w & 3), svt0 = (DK == 128) ? 0 : 4 * (w >> 2);
    f32x4 S[NST];
#pragma unroll
    for (int t = 0; t < NST; ++t) S[t] = (f32x4){0.f, 0.f, 0.f, 0.f};
    float gacc[2] = {(MODE == 2) ? 0.f : 1.f, (MODE == 2) ? 0.f : 1.f};
    if (MODE == 2) {
        for (int i = tid; i < 16 * 72; i += 512) { const int r = i / 72; *(LAS bf16_t*)(lds + MX_VT + ((128 + r) * 72 + (i % 72)) * 2) = (r == 0) ? (bf16_t)0x3F80 : (bf16_t)0; }
    }
    if (FULL) {
        const int bid0 = bid & ~15;
#pragma unroll 2
        for (int j = 0; j < seg; ++j) {
            const float* U = mp.ust + ((size_t)(bid0 + j) * 8 + w) * (9 * 4 * 64);
            float dec[4];
            if (MODE == 2) { const float gsv = mp.gsum[(size_t)(bid0 + j) * 128]; dec[0] = dec[1] = dec[2] = dec[3] = __expf(gsv); }
            else {
#pragma unroll
                for (int r = 0; r < 4; ++r) dec[r] = mp.gsum[(size_t)(bid0 + j) * 128 + sdt * 16 + 4 * l4 + r];
            }
            f32x4 uu[NST];
#pragma unroll
            for (int t = 0; t < NST; ++t)
#pragma unroll
                for (int r = 0; r < 4; ++r) uu[t][r] = U[(t * 4 + r) * 64 + lane];
#pragma unroll
            for (int t = 0; t < NST; ++t)
#pragma unroll
                for (int r = 0; r < 4; ++r) S[t][r] = dec[r] * S[t][r] + uu[t][r];
        }
    }
    const int sj = w & 3, ovh = w >> 2, srow = 16 * sj + l15;
    const int vp = tid & 63, r0v = (tid >> 6) * 8;
    unsigned ra[RPT + 3], rb[RPT + 3], rc[RPT], pv[8]; u32x2 gnx[4]; float sgi = 0.f, sgf = 0.f;
#pragma unroll
    for (int i = 0; i < RPT + 3; ++i) { ra[i] = 0u; rb[i] = 0u; }
#pragma unroll
    for (int i = 0; i < RPT; ++i) rc[i] = 0u;
#pragma unroll
    for (int t = 0; t < 4; ++t) gnx[t] = (u32x2){0u, 0u};
#define MX_LOAD(cn) do { const int tokn_ = tok0 + (cn) * 64; \
        if (VAR == 1 || VAR == 3 || VAR == 4) { _Pragma("unroll") for (int i = 0; i < RPT + 3; ++i) { ra[i] = 0x3c003c00u + (unsigned)(cn); rb[i] = 0x3c003c00u; } _Pragma("unroll") for (int i = 0; i < RPT; ++i) rc[i] = 0x3c003c00u; _Pragma("unroll") for (int i = 0; i < 8; ++i) pv[i] = 0x3c003c00u; _Pragma("unroll") for (int t = 0; t < 4; ++t) gnx[t] = (u32x2){0x3c003c00u, 0x3c003c00u}; sgi = 0.1f; sgf = 3.f; } else \
        if (MODE == 2) { const int tl0_ = seg * 1024 + (cn) * 64 + rg * RPT; \
            _Pragma("unroll") for (int i = 0; i < RPT + 3; ++i) { const int tl_ = tl0_ - 3 + i; \
                if (tl_ >= 0) { const bf16_t* pr_ = proj + (size_t)(b * SEQ + tl_) * ldp; if (FULL) ra[i] = *(const unsigned*)(pr_ + cq + d0); rb[i] = *(const unsigned*)(pr_ + ck + d0); } \
                else { ra[i] = 0u; rb[i] = 0u; } } \
            if (w == 0) { const float* gp_ = mp.gates + (size_t)(tokn_ + lane) * 8; sgi = gp_[h]; sgf = gp_[4 + h]; } \
        } else { \
            _Pragma("unroll") for (int i = 0; i < RPT; ++i) { const bf16_t* pr_ = proj + (size_t)(tokn_ + rg * RPT + i) * ldp; \
                if (MODE == 0) { ra[i] = *(const unsigned*)(pr_ + ck + d0); if (FULL) rb[i] = *(const unsigned*)(pr_ + cq + d0); } \
                else { ra[i] = *(const unsigned*)(pr_ + cu + d0); rb[i] = *(const unsigned*)(pr_ + ck + d0); if (FULL) rc[i] = *(const unsigned*)(pr_ + cq + d0); } } \
        } \
        _Pragma("unroll") for (int i = 0; i < 8; ++i) pv[i] = *(const unsigned*)(proj + (size_t)(tokn_ + r0v + i) * ldp + cv + 2 * vp); \
        if (FULL) { _Pragma("unroll") for (int t = 0; t < 4; ++t) gnx[t] = *(const u32x2*)(proj + (size_t)(tokn_ + srow) * ldp + cg + 16 * (4 * ovh + t) + 4 * l4); } \
    } while (0)
    float gnv[4][4];
#pragma unroll
    for (int t = 0; t < 4; ++t)
#pragma unroll
        for (int r = 0; r < 4; ++r) gnv[t][r] = (FULL && MODE != 2) ? ((MODE == 0) ? mp.hg : mp.gg)[h * 128 + 16 * (4 * ovh + t) + 4 * l4 + r] : 1.f;
    MX_LOAD(0);
    __syncthreads();
    for (int c = 0; c < 16; ++c) {
        const int tokc = tok0 + c * 64;
        float la[RPT][2], sp[RPT][2], qv[RPT][2], kv[RPT][2];
        u32x2 gcur[4];
        if (VAR == 4) {
#pragma unroll
            for (int t = 0; t < 4; ++t) gcur[t] = gnx[t];
            __syncthreads(); __syncthreads(); goto stepC; }
#pragma unroll
        for (int t = 0; t < 4; ++t) gcur[t] = gnx[t];
        if (MODE == 2) {
            if (w == 0) {
                const float ip = sgi + bi, lf = logsig(sgf + bfg);
                float cs = lf;
#pragma unroll
                for (int o = 1; o < 64; o <<= 1) { const float t = __shfl_up(cs, o); if (lane >= o) cs += t; }
                *(LAS float*)(lds + MX_BC + lane * 4) = cs; *(LAS float*)(lds + MX_IP + lane * 4) = ip - cs;
                if (lane == 63) *(LAS float*)(lds + MX_GT) = cs;
            }
#pragma unroll
            for (int i = 0; i < RPT; ++i)
#pragma unroll
                for (int e = 0; e < 2; ++e) {
                    float aq = 0.f, ak = 0.f;
#pragma unroll
                    for (int j = 0; j < 4; ++j) { aq += cwq[j][e] * (e ? bfhi(ra[i + j]) : bflo(ra[i + j])); ak += cwk[j][e] * (e ? bfhi(rb[i + j]) : bflo(rb[i + j])); }
                    qv[i][e] = silu(aq); kv[i][e] = silu(ak) * 0.08838834764831845f; la[i][e] = 0.f; sp[i][e] = 0.f;
                }
        } else {
#pragma unroll
            for (int i = 0; i < RPT; ++i) {
                if (MODE == 0) {
                    const unsigned uz = ra[i];
                    const float s0 = sigm(bflo(uz)), s1 = sigm(bfhi(uz));
                    la[i][0] = lbv[0] + oml[0] * s0; la[i][1] = lbv[1] + oml[1] * s1;
                    kv[i][0] = oml[0] - oml[0] * s0; kv[i][1] = oml[1] - oml[1] * s1;
                    if (FULL) { const unsigned uq = rb[i]; qv[i][0] = silu(bflo(uq)); qv[i][1] = silu(bfhi(uq)); } else { qv[i][0] = qv[i][1] = 0.f; }
                } else {
                    const unsigned uu = ra[i], uk = rb[i];
                    la[i][0] = __expf(logsig(bflo(uu) + bgk[0]) * 0.0625f); la[i][1] = __expf(logsig(bfhi(uu) + bgk[1]) * 0.0625f);
                    kv[i][0] = bflo(uk); kv[i][1] = bfhi(uk);
                    if (FULL) { const unsigned uq = rc[i]; qv[i][0] = bflo(uq) * 0.125f; qv[i][1] = bfhi(uq) * 0.125f; } else { qv[i][0] = qv[i][1] = 0.f; }
                }
            }
#pragma unroll
            for (int e = 0; e < 2; ++e) {
                float run = 1.f;
#pragma unroll
                for (int i = RPT - 1; i >= 0; --i) { sp[i][e] = run; run *= la[i][e]; }
                run = 1.f;
#pragma unroll
                for (int i = 0; i < RPT; ++i) { run *= la[i][e]; la[i][e] = run; }
            }
            *(LAS float*)(lds + MX_SEG + (rg * DK + d0) * 4) = la[RPT - 1][0]; *(LAS float*)(lds + MX_SEG + (rg * DK + d0 + 1) * 4) = la[RPT - 1][1];
        }
        {
            u32x4 lo, hi;
            lo.x = (pv[0] & 0xffffu) | (pv[1] << 16); lo.y = (pv[2] & 0xffffu) | (pv[3] << 16); lo.z = (pv[4] & 0xffffu) | (pv[5] << 16); lo.w = (pv[6] & 0xffffu) | (pv[7] << 16);
            hi.x = (pv[0] >> 16) | (pv[1] & 0xffff0000u); hi.y = (pv[2] >> 16) | (pv[3] & 0xffff0000u); hi.z = (pv[4] >> 16) | (pv[5] & 0xffff0000u); hi.w = (pv[6] >> 16) | (pv[7] & 0xffff0000u);
            *(LAS u32x4*)(lds + MX_VT + ((2 * vp) * 72 + r0v) * 2) = lo; *(LAS u32x4*)(lds + MX_VT + ((2 * vp + 1) * 72 + r0v) * 2) = hi;
        }
        if (c + 1 < 16) MX_LOAD(c + 1);
        if (VAR == 2) { unsigned xa = 0; _Pragma("unroll") for (int i = 0; i < RPT + 3; ++i) xa ^= ra[i] ^ rb[i]; _Pragma("unroll") for (int i = 0; i < RPT; ++i) xa ^= rc[i]; _Pragma("unroll") for (int i = 0; i < 8; ++i) xa ^= pv[i];
            _Pragma("unroll") for (int t = 0; t < 4; ++t) xa ^= gnx[t].x ^ gnx[t].y; gacc[0] += (float)(xa & 1u) + sgi + sgf; continue; }
        __syncthreads();
        {
            float pre[2], h2[2], gt[2];
            if (MODE == 2) {
                const float g = *(LAS float*)(lds + MX_GT);
                gt[0] = gt[1] = g; h2[0] = h2[1] = 0.f; pre[0] = pre[1] = 0.f;
                if (tid == 0) gacc[0] += g;
            } else {
#pragma unroll
                for (int e = 0; e < 2; ++e) { float p = 1.f, a1 = 1.f, a2 = 1.f;
#pragma unroll
                    for (int j = 0; j < RG; ++j) { const float v = *(LAS float*)(lds + MX_SEG + (j * DK + d0 + e) * 4);
                        if (j < RG / 2) a1 *= v; else a2 *= v;
                        const bool inb = (rg >= RG / 2) ? (j >= RG / 2 && j < rg) : (j > rg && j < RG / 2);
                        p *= inb ? v : 1.f; }
                    pre[e] = p; h2[e] = a2; gt[e] = a1 * a2;
                    if (rg == 0) { gacc[e] *= gt[e]; *(LAS float*)(lds + MX_GD + (d0 + e) * 4) = gt[e]; *(LAS float*)(lds + MX_ER + (d0 + e) * 4) = a1; } }
            }
            float kh[RPT][2];
#pragma unroll
            for (int i = 0; i < RPT; ++i) {
                const int s = rg * RPT + i;
                float qs[2], ks[2];
                if (MODE == 2) {
                    const float bc = *(LAS float*)(lds + MX_BC + s * 4), ipb = *(LAS float*)(lds + MX_IP + s * 4);
                    const float eq = __expf(bc), ek = __expf(ipb), eg = __expf(gt[0]);
                    qs[0] = qv[i][0] * eq; qs[1] = qv[i][1] * eq; ks[0] = kv[i][0] * ek; ks[1] = kv[i][1] * ek; kh[i][0] = ks[0] * eg; kh[i][1] = ks[1] * eg;
                } else {
#pragma unroll
                    for (int e = 0; e < 2; ++e) {
                        const float cd = pre[e] * ((rg >= RG / 2) ? la[i][e] : sp[i][e]);
                        const float rc_ = __builtin_amdgcn_rcpf(cd);
                        const float qm = (rg >= RG / 2) ? cd : rc_, km = (rg >= RG / 2) ? rc_ : cd;
                        qs[e] = qv[i][e] * qm; ks[e] = kv[i][e] * km; kh[i][e] = ks[e] * h2[e]; }
                }
                if (FULL) { *(LAS unsigned*)(lds + MX_QT + (s * QP + d0) * 2) = pk2(qs[0], qs[1]); *(LAS unsigned*)(lds + MX_KT + (s * QP + d0) * 2) = pk2(ks[0], ks[1]); }
            }
            if (RPT == 8) {
                u32x4 a, bq;
                a.x = pk2(kh[0][0], kh[1][0]); a.y = pk2(kh[2][0], kh[3][0]); a.z = pk2(kh[4 % RPT][0], kh[5 % RPT][0]); a.w = pk2(kh[6 % RPT][0], kh[7 % RPT][0]);
                bq.x = pk2(kh[0][1], kh[1][1]); bq.y = pk2(kh[2][1], kh[3][1]); bq.z = pk2(kh[4 % RPT][1], kh[5 % RPT][1]); bq.w = pk2(kh[6 % RPT][1], kh[7 % RPT][1]);
                *(LAS u32x4*)(lds + MX_KHT + (d0 * 72 + rg * 8) * 2) = a; *(LAS u32x4*)(lds + MX_KHT + ((d0 + 1) * 72 + rg * 8) * 2) = bq;
            } else {
                u32x2 a, bq;
                a.x = pk2(kh[0][0], kh[1][0]); a.y = pk2(kh[2][0], kh[3][0]); bq.x = pk2(kh[0][1], kh[1][1]); bq.y = pk2(kh[2][1], kh[3][1]);
                *(LAS u32x2*)(lds + MX_KHT + (d0 * 72 + rg * 4) * 2) = a; *(LAS u32x2*)(lds + MX_KHT + ((d0 + 1) * 72 + rg * 4) * 2) = bq;
            }
        }
        __syncthreads();
        stepC:
        if (FULL && VAR != 3) {
#pragma unroll
            for (int tt = 0; tt < 2; ++tt) {
                const int tile = 2 * w + tt, ti = tile >> 2, tj = tile & 3;
                f32x4 acc = (f32x4){0.f, 0.f, 0.f, 0.f};
                if (ti <= tj) {
#pragma unroll
                    for (int kk = 0; kk < KS; ++kk) {
                        const bf16x8 a = *(const LAS bf16x8*)(lds + MX_KT + ((16 * ti + l15) * QP + kk * 32 + 8 * l4) * 2);
                        const bf16x8 bq = *(const LAS bf16x8*)(lds + MX_QT + ((16 * tj + l15) * QP + kk * 32 + 8 * l4) * 2);
                        acc = MFMA16(a, bq, acc);
                    }
                }
                const int s = 16 * tj + l15, sp0 = 16 * ti + 4 * l4;
                float pvv[4];
#pragma unroll
                for (int r = 0; r < 4; ++r) pvv[r] = (sp0 + r <= s) ? acc[r] : 0.f;
                u32x2 pw; pw.x = pk2(pvv[0], pvv[1]); pw.y = pk2(pvv[2], pvv[3]);
                *(LAS u32x2*)(lds + MX_P + (s * 72 + sp0) * 2) = pw;
            }
            {
                float er[4];
#pragma unroll
                for (int r = 0; r < 4; ++r) er[r] = (MODE == 2) ? 1.f : *(LAS float*)(lds + MX_ER + (sdt * 16 + 4 * l4 + r) * 4);
#pragma unroll
                for (int t = 0; t < NST; ++t) {
                    const int v = 16 * (svt0 + t) + l15;
                    u32x2 sw; sw.x = pk2(S[t][0] * er[0], S[t][1] * er[1]); sw.y = pk2(S[t][2] * er[2], S[t][3] * er[3]);
                    *(LAS u32x2*)(lds + MX_ST + (v * QP + sdt * 16 + 4 * l4) * 2) = sw;
                }
            }
            {
                float dec[4];
                if (MODE == 2) { const float eg = __expf(*(LAS float*)(lds + MX_GT)); dec[0] = dec[1] = dec[2] = dec[3] = eg; }
                else {
    #pragma unroll
                    for (int r = 0; r < 4; ++r) dec[r] = *(LAS float*)(lds + MX_GD + (sdt * 16 + 4 * l4 + r) * 4);
                }
                bf16x8 ka[2];
    #pragma unroll
                for (int kk = 0; kk < 2; ++kk) ka[kk] = *(const LAS bf16x8*)(lds + MX_KHT + ((16 * sdt + l15) * 72 + kk * 32 + 8 * l4) * 2);
    #pragma unroll
                for (int t = 0; t < NST; ++t) {
    #pragma unroll
                    for (int r = 0; r < 4; ++r) S[t][r] *= dec[r];
    #pragma unroll
                    for (int kk = 0; kk < 2; ++kk) {
                        const bf16x8 vb = *(const LAS bf16x8*)(lds + MX_VT + ((16 * (svt0 + t) + l15) * 72 + kk * 32 + 8 * l4) * 2);
                        S[t] = MFMA16(ka[kk], vb, S[t]);
                    }
                }
            }
            __syncthreads();
            constexpr int NOT = (MODE == 2) ? 5 : 4;
            f32x4 O[NOT];
#pragma unroll
            for (int t = 0; t < NOT; ++t) O[t] = (f32x4){0.f, 0.f, 0.f, 0.f};
#pragma unroll
            for (int kk = 0; kk < 2; ++kk) {
                const bf16x8 bq = *(const LAS bf16x8*)(lds + MX_P + ((16 * sj + l15) * 72 + kk * 32 + 8 * l4) * 2);
#pragma unroll
                for (int t = 0; t < NOT; ++t) { const int vt = (t < 4) ? (4 * ovh + t) : 8;
                    if (t < 4 || ovh == 0) { const bf16x8 a = *(const LAS bf16x8*)(lds + MX_VT + ((16 * vt + l15) * 72 + kk * 32 + 8 * l4) * 2); O[t] = MFMA16(a, bq, O[t]); } }
            }
#pragma unroll
            for (int kk = 0; kk < KS; ++kk) {
                const bf16x8 bq = *(const LAS bf16x8*)(lds + MX_QT + ((16 * sj + l15) * QP + kk * 32 + 8 * l4) * 2);
#pragma unroll
                for (int t = 0; t < NOT; ++t) { const int vt = (t < 4) ? (4 * ovh + t) : 8;
                    if (t < 4 || ovh == 0) { const bf16x8 a = *(const LAS bf16x8*)(lds + MX_ST + ((16 * vt + l15) * QP + kk * 32 + 8 * l4) * 2); O[t] = MFMA16(a, bq, O[t]); } }
            }
            const int tokr = tokc + srow;
            float scale;
            if (MODE == 2) {
                if (ovh == 0 && l4 == 0) *(LAS float*)(lds + MX_DEN + srow * 4) = O[NOT - 1][0];
                __syncthreads();
                const float den = *(LAS float*)(lds + MX_DEN + srow * 4);
                scale = 1.f / fmaxf(fabsf(den), 1.f);
            } else {
                float ss = 0.f;
#pragma unroll
                for (int t = 0; t < 4; ++t)
#pragma unroll
                    for (int r = 0; r < 4; ++r) ss += O[t][r] * O[t][r];
                ss += __shfl_xor(ss, 16); ss += __shfl_xor(ss, 32);
                if (l4 == 0) *(LAS float*)(lds + MX_RS + (ovh * 64 + srow) * 4) = ss;
                __syncthreads();
                const float tot = *(LAS float*)(lds + MX_RS + srow * 4) + *(LAS float*)(lds + MX_RS + (64 + srow) * 4);
                scale = rsqrtf(tot * (1.f / 128.f) + 1e-6f);
            }
#pragma unroll
            for (int t = 0; t < 4; ++t) {
                const int v0 = 16 * (4 * ovh + t) + 4 * l4;
                const u32x2 gt = gcur[t];
                const float g0 = bflo(gt.x), g1 = bfhi(gt.x), g2 = bflo(gt.y), g3 = bfhi(gt.y);
                float y0, y1, y2, y3;
                if (MODE == 2) { y0 = O[t][0] * scale * sigm(g0); y1 = O[t][1] * scale * sigm(g1); y2 = O[t][2] * scale * sigm(g2); y3 = O[t][3] * scale * sigm(g3); }
                else { y0 = O[t][0] * scale * gnv[t][0] * silu(g0); y1 = O[t][1] * scale * gnv[t][1] * silu(g1); y2 = O[t][2] * scale * gnv[t][2] * silu(g2); y3 = O[t][3] * scale * gnv[t][3] * silu(g3); }
                u32x2 yw; yw.x = pk2(y0, y1); yw.y = pk2(y2, y3);
                *(u32x2*)(mp.ymix + (size_t)tokr * DM + cy + v0) = yw;
            }
        }
        if (!FULL || VAR == 3) {
            {
                float dec[4];
                if (MODE == 2) { const float eg = __expf(*(LAS float*)(lds + MX_GT)); dec[0] = dec[1] = dec[2] = dec[3] = eg; }
                else {
    #pragma unroll
                    for (int r = 0; r < 4; ++r) dec[r] = *(LAS float*)(lds + MX_GD + (sdt * 16 + 4 * l4 + r) * 4);
                }
                bf16x8 ka[2];
    #pragma unroll
                for (int kk = 0; kk < 2; ++kk) ka[kk] = *(const LAS bf16x8*)(lds + MX_KHT + ((16 * sdt + l15) * 72 + kk * 32 + 8 * l4) * 2);
    #pragma unroll
                for (int t = 0; t < NST; ++t) {
    #pragma unroll
                    for (int r = 0; r < 4; ++r) S[t][r] *= dec[r];
    #pragma unroll
                    for (int kk = 0; kk < 2; ++kk) {
                        const bf16x8 vb = *(const LAS bf16x8*)(lds + MX_VT + ((16 * (svt0 + t) + l15) * 72 + kk * 32 + 8 * l4) * 2);
                        S[t] = MFMA16(ka[kk], vb, S[t]);
                    }
                }
            }
        __syncthreads();
        }
    }
#undef MX_LOAD
    if (VAR == 2) { mp.ust[(size_t)bid * 512 + tid] = gacc[0]; return; }
    if (!FULL) {
        float* U = mp.ust + ((size_t)bid * 8 + w) * (9 * 4 * 64);
#pragma unroll
        for (int t = 0; t < NST; ++t)
#pragma unroll
            for (int r = 0; r < 4; ++r) U[(t * 4 + r) * 64 + lane] = S[t][r];
        if (MODE == 2) { if (tid == 0) mp.gsum[(size_t)bid * 128] = gacc[0]; }
        else if (rg == 0) { mp.gsum[(size_t)bid * 128 + d0] = gacc[0]; mp.gsum[(size_t)bid * 128 + d0 + 1] = gacc[1]; }
    }
}

#ifndef PHMASK
#define PHMASK 0xFFFFu
#endif
#ifndef MIXSEL
#define MIXSEL 7
#endif
#ifndef REPMASK
#define REPMASK 0x0u
#endif
#define EN(j) (((PHMASK) >> (j)) & 1u)
#ifndef REPLAYER
#define REPLAYER 3
#endif
#define NREP(j) (1 + (int)((((REPMASK) >> (j)) & 1u) & (((REPLAYER) >> layer) & 1u)))
#define IN(k) (lo <= (k) && (k) < hi)
#define SEAM(k) do { if (IN((k) + 1)) xcd_barrier(bar); } while (0)

template <int layer> __device__ __forceinline__ void ph_proj(LAS unsigned char* lds, unsigned char* ws, int bid, int nb) {
    pg8::Gemm g{(const bf16_t*)(ws + (layer ? WS_H2Q : WS_XQ)), (const bf16_t*)(ws + (layer ? WS_WC : WS_WAB)), DM / 2};
    pg8::StaticOrder S; S.init(NTOK, layer ? CWID : ABW, nb, bid);
    pg8::EpiStoreBf16<true> E{(bf16_t*)(ws + WS_PROJ), layer ? CWID : ABW};
    pg8::gemm_phase<pg8::EpiStoreBf16<true>, pg8::StaticOrder, false, true>(lds, g, nullptr, S, E);
}
template <int layer> __device__ __forceinline__ void ph_outproj(LAS unsigned char* lds, unsigned char* ws, int bid, int nb) {
    pg8::Gemm g{(const bf16_t*)(ws + WS_YMIX), (const bf16_t*)(ws + (layer ? WS_WOC : WS_WOAB)), DM};
    pg8::StaticOrder S; S.init(NTOK, DM, nb, bid);
    pg8::EpiResid E{(bf16_t*)(ws + WS_Z), (const bf16_t*)(ws + (layer ? WS_H2 : WS_HB))};
    pg8::gemm_phase<pg8::EpiResid, pg8::StaticOrder, false>(lds, g, nullptr, S, E);
}
template <int layer> __device__ __forceinline__ void ph_router(LAS unsigned char* lds, unsigned char* ws, int bid, int nb) {
    pg8::Gemm g{(const bf16_t*)(ws + WS_H1), (const bf16_t*)(ws + WS_WR) + (size_t)layer * 256 * 1024, DM};
    pg8::StaticOrder S; S.init(NTOK, 256, nb, bid);
    pg8::EpiF32 E{(float*)(ws + WS_LOGITS)};
    pg8::gemm_phase<pg8::EpiF32, pg8::StaticOrder, false>(lds, g, nullptr, S, E);
}
template <int layer> __device__ __forceinline__ void ph_gemm1(LAS unsigned char* lds, unsigned char* ws, int bid, int nb) {
    const int vcu = (nb % 8 == 0) ? (bid % 8) * (nb / 8) + bid / 8 : bid;
    const int nt = __builtin_amdgcn_readfirstlane(*(volatile int*)(ws + WS_MISC + 65536 + 8192));
    pg8::Gemm g{(const bf16_t*)(ws + WS_H1Q), (const bf16_t*)(ws + WS_W1T + (size_t)layer * NE1 * 512 * 1024), DM / 2};
    const int nu = pg8::moe_prep(lds, (const int*)(ws + WS_MISC + 65536), nt * 2, 1, nb, vcu, (const int*)(ws + WS_STOK));
    pg8::MoeOrder S{(const LAS int*)(lds + pg8::LDS_UT), nu < pg8::MOE_MAXU ? nu : pg8::MOE_MAXU};
    pg8::EpiSwiGLU<true> E{ws + WS_ACT, lds + 3 * pg8::HTB};
    pg8::gemm_phase<pg8::EpiSwiGLU<true>, pg8::MoeOrder, true, true>(lds, g, (const LAS int*)(lds + pg8::LDS_IDX), S, E);
}
template <int layer> __device__ __forceinline__ void ph_gemm2(LAS unsigned char* lds, unsigned char* ws, int bid, int nb) {
    const int vcu = (nb % 8 == 0) ? (bid % 8) * (nb / 8) + bid / 8 : bid;
    const int nt = __builtin_amdgcn_readfirstlane(*(volatile int*)(ws + WS_MISC + 65536 + 8192));
    int kq = 128; asm volatile("" : "+s"(kq));
    pg8::Gemm g{(const bf16_t*)(ws + WS_ACT), (const bf16_t*)(ws + WS_W2T + (size_t)layer * NE1 * 1024 * 256), kq};
    const int nu = pg8::moe_prep(lds, (const int*)(ws + WS_MISC + 65536), nt * 4, 2, nb, vcu, nullptr);
    pg8::MoeOrder S{(const LAS int*)(lds + pg8::LDS_UT), nu};
    pg8::EpiDown E{(unsigned char*)(ws + WS_Y), lds + 3 * pg8::HTB};
    pg8::gemm_phase<pg8::EpiDown, pg8::MoeOrder, false, true>(lds, g, nullptr, S, E);
#ifndef EXPG
#define EXPG 0
#endif
#if EXPG
    { __syncthreads(); pg8::EpiDownT<EXPG - 1> E2{(unsigned char*)(ws + WS_PROJ), lds + 3 * pg8::HTB};
      pg8::gemm_phase<pg8::EpiDownT<EXPG - 1>, pg8::MoeOrder, false, true>(lds, g, nullptr, S, E2); }
#endif
}
template <int layer, bool FULLP> __device__ __forceinline__ void ph_mixer(LAS unsigned char* lds, const Args& A, int bid, int nb) {
    unsigned char* ws = A.ws;
    if (nb != NWG) return;
    MixP mp{(const bf16_t*)(ws + WS_PROJ), layer ? CWID : ABW, 0, (bf16_t*)(ws + WS_YMIX), (const float*)(ws + WS_GATES), (const float*)(ws + WS_MISC), A.in[I_BGK], A.in[I_HG], A.in[I_GG], A.in[I_CONV], A.in[I_BIF], (float*)(ws + WS_UST), (float*)(ws + WS_GSUM)};
    if (layer == 0) { if (bid < 128) { if (MIXSEL & 1) mixer_run<0, FULLP>(lds, mp, bid); } else { if (MIXSEL & 2) mixer_run<1, FULLP>(lds, mp, bid); } }
    else { if (MIXSEL & 4) mixer_run<2, FULLP>(lds, mp, bid); }
#ifndef EXPV
#define EXPV 0
#endif
#ifndef EXPL
#define EXPL 0
#endif
#if EXPV
    if (FULLP && layer == EXPL) { MixP md = mp; md.ymix = (bf16_t*)(ws + WS_Z); md.ust = (float*)(ws + WS_LOGITS); md.gsum = (float*)(ws + WS_LOGITS + 24 * MiB);
        __syncthreads();
        if (layer == 0) { if (bid < 128) mixer_run<0, true, EXPV>(lds, md, bid); else mixer_run<1, true, EXPV>(lds, md, bid); }
        else mixer_run<2, true, EXPV>(lds, md, bid); }
#endif
}
#define REP2(j, call) do { call; if (NREP(j) == 2) { __syncthreads(); call; } } while (0)

template <int layer>
__device__ __forceinline__ void run_layer(LAS unsigned char* lds, const Args& A, const XcdBarrier& bar, const int lo, const int hi) {
    const int bid = blockIdx.x, nb = gridDim.x;
    unsigned char* ws = A.ws;
    unsigned* ctl = (unsigned*)(ws + WS_CTL);
    constexpr int P = 1 + layer * 11;
    if (EN(0) && IN(P + 0)) { REP2(0, ph_proj<layer>(lds, ws, bid, nb)); SEAM(P + 0); }
    if (EN(1) && IN(P + 1)) { REP2(1, (ph_mixer<layer, false>(lds, A, bid, nb))); SEAM(P + 1); }
    if (EN(2) && IN(P + 2)) { REP2(2, (ph_mixer<layer, true>(lds, A, bid, nb))); SEAM(P + 2); }
    if (EN(3) && IN(P + 3)) { REP2(3, ph_outproj<layer>(lds, ws, bid, nb)); SEAM(P + 3); }
    if (EN(4) && IN(P + 4)) { REP2(4, phase_ln((const bf16_t*)(ws + WS_Z), (bf16_t*)(ws + WS_H1), ws + WS_H1Q, A.in[I_LMG] + layer * DM, A.in[I_LMB] + layer * DM, bid, nb)); SEAM(P + 4); }
    if (EN(5) && IN(P + 5)) { REP2(5, ph_router<layer>(lds, ws, bid, nb)); SEAM(P + 5); }
    if (EN(6) && IN(P + 6)) {
        phase_select<false>(lds, (const float*)(ws + WS_LOGITS), A.in[I_RB] + layer * NEXP, (int*)(ws + WS_TOKE), (int*)(ws + WS_TOKP), (float*)(ws + WS_TOKW), ctl + CW_CNT + layer * 256, bid, nb);
        if (NREP(6) == 2) phase_select<true>(lds, (const float*)(ws + WS_LOGITS), A.in[I_RB] + layer * NEXP, (int*)(ws + WS_TOKE), (int*)(ws + WS_TOKP), (float*)(ws + WS_TOKW), ctl + CW_CNT + layer * 256, bid, nb);
        SEAM(P + 6); }
    if (EN(7) && IN(P + 7)) { REP2(7, phase_dispatch(lds, ctl + CW_CNT + layer * 256, (const int*)(ws + WS_TOKE), (const int*)(ws + WS_TOKP), (int*)(ws + WS_STOK), (int*)(ws + WS_POSY), (int*)(ws + WS_MISC + 65536), (int*)(ws + WS_MISC + 65536 + 8192), bid, nb)); SEAM(P + 7); }
    if (EN(8) && IN(P + 8)) { REP2(8, ph_gemm1<layer>(lds, ws, bid, nb)); SEAM(P + 8); }
    if (EN(9) && IN(P + 9)) { REP2(9, ph_gemm2<layer>(lds, ws, bid, nb)); SEAM(P + 9); }
    if (EN(10) && IN(P + 10)) {
        if (layer == 0) REP2(10, (phase_combine<false>((const unsigned char*)(ws + WS_Y), (const int*)(ws + WS_POSY), (const float*)(ws + WS_TOKW), (const int*)(ws + WS_MISC + 65536 + 8192), (const bf16_t*)(ws + WS_H1), (bf16_t*)(ws + WS_H2), ws + WS_H2Q, nullptr, (float*)(ws + WS_GATES), (const float*)(ws + WS_MISC + 4096), A.in[I_LFG], A.in[I_LFB], bid, nb)));
        else REP2(10, (phase_combine<true>((const unsigned char*)(ws + WS_Y), (const int*)(ws + WS_POSY), (const float*)(ws + WS_TOKW), (const int*)(ws + WS_MISC + 65536 + 8192), (const bf16_t*)(ws + WS_H1), nullptr, nullptr, A.out, nullptr, nullptr, A.in[I_LFG] + DM, A.in[I_LFB] + DM, bid, nb)));
        SEAM(P + 10);
    }
}

__global__ void __launch_bounds__(512, 2) fwd_kernel(Args A) {
    extern __shared__ __attribute__((aligned(16))) unsigned char lds_raw[];
    LAS unsigned char* lds = (LAS unsigned char*)lds_raw;
    const int tid = threadIdx.x;
    unsigned* ctl = (unsigned*)(A.ws + WS_CTL);
    volatile LAS unsigned* misc = (volatile LAS unsigned*)(lds + LDS_MISC);
    if (tid < 64) misc[tid] = 0u;
    __syncthreads();
    const int lo = A.ph_lo, hi = A.ph_hi;
    XcdBarrier bar; bar.bar = ctl + CW_BAR; bar.x = 0; bar.st = misc;
    if (hi - lo > 1) bar = xcd_barrier_post(ctl + CW_BAR, misc);
    if (EN(11) && IN(0)) { for (int rep_ = 0; rep_ < 1 + (int)(((REPMASK) >> 11) & 1u); ++rep_) phase_prologue(lds, A, blockIdx.x, gridDim.x); SEAM(0); }
    run_layer<0>(lds, A, bar, lo, hi);
    run_layer<1>(lds, A, bar, lo, hi);
}
#undef IN
#undef SEAM

#ifdef DBG
__device__ __forceinline__ unsigned hash32(unsigned x) { x ^= x >> 16; x *= 0x7feb352dU; x ^= x >> 15; x *= 0x846ca68bU; x ^= x >> 16; return x; }
__device__ __forceinline__ void dbg_acc(float* w, int stage, float num, float den) { if (!(num == num) || num > 1e30f) num = 1e30f; atomicAdd(w + 2 * stage, num); atomicAdd(w + 2 * stage + 1, den); }
__device__ __forceinline__ float bfr(float x) { return bflo(pk2(x, 0.f)); }
__global__ void dbg_weights(Args A, float* w) {
    const unsigned i = blockIdx.x * 256 + threadIdx.x; unsigned char* ws = A.ws;
    float num = 0.f, den = 0.f;
    { const unsigned hsh = hash32(i * 4 + 0), col = hsh % 3584, k = (hsh >> 12) % 1024; const float r = A.in[I_WINAB][(size_t)k * 3600 + col], g = bf2f(((const bf16_t*)(ws + WS_WAB))[(size_t)col * 1024 + k]); num += (r - g) * (r - g); den += r * r; }
    { const unsigned hsh = hash32(i * 4 + 1), j = hsh % 256, k = (hsh >> 12) % 1024; float r = 0.f; for (int q = 0; q < 16; ++q) r += A.in[I_WINAB][(size_t)k * 3600 + 3584 + q] * A.in[I_WGKUP][q * 256 + j];
      const float g = bf2f(((const bf16_t*)(ws + WS_WAB))[(size_t)(3584 + j) * 1024 + k]); num += (r - g) * (r - g); den += r * r; }
    { const unsigned hsh = hash32(i * 4 + 2), le = hsh % 514, layer = le / 257, e = le % 257, n = (hsh >> 10) % 512, k = (hsh >> 20) % 1024;
      const float r = (e < 256) ? A.in[I_WEI][((size_t)(layer * 256 + e) * 1024 + k) * 512 + n] : A.in[I_WSI][((size_t)layer * 1024 + k) * 512 + n];
      const unsigned up = n >> 8, c = n & 255, drow = (c >> 7) * 256 + up * 128 + (c & 127);
      const float g = bf2f(((const bf16_t*)(ws + WS_W1T))[((size_t)(layer * 257 + e) * 512 + drow) * 1024 + k]); num += (r - g) * (r - g); den += r * r; }
    { const unsigned hsh = hash32(i * 4 + 3), le = hsh % 514, layer = le / 257, e = le % 257, n = (hsh >> 10) % 1024, k = (hsh >> 20) % 256;
      const float r = (e < 256) ? A.in[I_WED][((size_t)(layer * 256 + e) * 256 + k) * 1024 + n] : A.in[I_WSD][((size_t)layer * 256 + k) * 1024 + n];
      const float g = bf2f(((const bf16_t*)(ws + WS_W2T))[((size_t)(layer * 257 + e) * 1024 + n) * 256 + k]); num += (r - g) * (r - g); den += r * r; }
    dbg_acc(w, 1, num, den);
}
__global__ void dbg_gemm(const bf16_t* Am, int K, const bf16_t* Bt, const void* out, int ldo, int out_f32, int nrows, int ncols, float* w, int stage) {
    const unsigned i = blockIdx.x * 256 + threadIdx.x; const unsigned hsh = hash32(i + 77u * stage), row = hsh % nrows, col = (hsh >> 11) % ncols;
    float r = 0.f; for (int k = 0; k < K; ++k) r += bf2f(Am[(size_t)row * K + k]) * bf2f(Bt[(size_t)col * K + k]);
    const float g = out_f32 ? ((const float*)out)[(size_t)row * ldo + col] : bf2f(((const bf16_t*)out)[(size_t)row * ldo + col]);
    dbg_acc(w, stage, (r - g) * (r - g), r * r);
}
template <int MODE> __global__ void __launch_bounds__(256, 1) dbg_mixer(MixP mp, int b, int h, int T, float* w, int stage) {
    constexpr int DK = (MODE == 1) ? 64 : 128, DV = (MODE == 2) ? 256 : 128;
    __shared__ float sq[128], sk[128], sa[128], red[256], sh_i, sh_f;
    const int tid = threadIdx.x;
    const int ldp = mp.ldp; const bf16_t* proj = mp.proj;
    int cq, ck, cv, cg, cy, cu = 3584 + h * 64;
    if (MODE == 0) { cq = h * 128; ck = 512 + h * 128; cv = 1024 + h * 128; cg = 1536 + h * 128; cy = h * 128; }
    else if (MODE == 1) { cq = 2048 + h * 64; ck = 2304 + h * 64; cv = 2560 + h * 128; cg = 3072 + h * 128; cy = 512 + h * 128; }
    else { cq = h * 128; ck = 512 + h * 128; cv = 1024 + h * 256; cg = 2048 + h * 256; cy = h * 256; }
    float S[DK];
#pragma unroll
    for (int d = 0; d < DK; ++d) S[d] = 0.f;
    float nst = 0.f, num = 0.f, den = 0.f;
    for (int t = 0; t < T; ++t) {
        const size_t tok = (size_t)b * SEQ + t; const bf16_t* pr = proj + tok * ldp;
        if (tid < DK) {
            const int d = tid;
            if (MODE == 0) { const float z = bf2f(pr[ck + d]), sg = 1.f / (1.f + expf(-z)), lb = mp.lb0[h * 128 + d]; sa[d] = lb + (1.f - lb) * sg; sk[d] = (1.f - lb) * (1.f - sg); const float qq = bf2f(pr[cq + d]); sq[d] = qq / (1.f + expf(-qq)); }
            else if (MODE == 1) { const float u = bf2f(pr[cu + d]) + mp.bgk[h * 64 + d]; const float ls = fminf(u, 0.f) - log1pf(expf(-fabsf(u))); sa[d] = expf(ls / 16.f); sk[d] = bf2f(pr[ck + d]); sq[d] = bf2f(pr[cq + d]) * 0.125f; }
            else { float aq = 0.f, ak = 0.f; for (int j = 0; j < 4; ++j) { const int tt = t - 3 + j; if (tt >= 0) { const bf16_t* p2 = proj + ((size_t)b * SEQ + tt) * ldp; aq += mp.conv[j * 1024 + cq + d] * bf2f(p2[cq + d]); ak += mp.conv[j * 1024 + ck + d] * bf2f(p2[ck + d]); } }
                sq[d] = aq / (1.f + expf(-aq)); sk[d] = ak / (1.f + expf(-ak)) * 0.08838834764831845f; }
        }
        if (MODE == 2 && tid == 0) { const float* gp = mp.gates + tok * 8; sh_i = expf(gp[h] + mp.bif[h]); const float x = gp[4 + h] + mp.bif[4 + h]; sh_f = 1.f / (1.f + expf(-x)); }
        __syncthreads();
        const float vt = bf2f(pr[cv + tid]);
        float o = 0.f;
        if (MODE == 2) { const float f = sh_f, ii = sh_i;
#pragma unroll
            for (int d = 0; d < DK; ++d) { S[d] = f * S[d] + ii * sk[d] * vt; o += S[d] * sq[d]; }
            if (tid < 128) nst = f * nst + ii * sk[tid];
            red[tid] = (tid < 128) ? nst * sq[tid] : 0.f;
        } else {
#pragma unroll
            for (int d = 0; d < DK; ++d) { S[d] = sa[d] * S[d] + sk[d] * vt; o += S[d] * sq[d]; }
            red[tid] = o * o;
        }
        __syncthreads();
        for (int st = DV / 2; st > 0; st >>= 1) { if (tid < st) red[tid] += red[tid + st]; __syncthreads(); }
        const float tot = red[0];
        const float gt = bf2f(pr[cg + tid]);
        float y;
        if (MODE == 2) y = o / fmaxf(fabsf(tot), 1.f) * (1.f / (1.f + expf(-gt)));
        else y = o * rsqrtf(tot / 128.f + 1e-6f) * ((MODE == 0) ? mp.hg : mp.gg)[h * 128 + tid] * (gt / (1.f + expf(-gt)));
        const float g = bf2f(mp.ymix[tok * DM + cy + tid]);
        num += (y - g) * (y - g); den += y * y;
        __syncthreads();
    }
    dbg_acc(w, stage, num, den);
}
__global__ void dbg_h1(const bf16_t* HIN, const bf16_t* YM, const bf16_t* Wt, const bf16_t* H1, const float* g, const float* bb, float* w, int stage) {
    __shared__ float red[256]; __shared__ float zrow[1024];
    const int tid = threadIdx.x; const unsigned row = hash32(blockIdx.x + 1000u * stage) % NTOK;
    float z[4];
    for (int q = 0; q < 4; ++q) { const int c = tid + 256 * q; float a = 0.f; for (int k = 0; k < 1024; ++k) a += bf2f(YM[(size_t)row * 1024 + k]) * bf2f(Wt[(size_t)c * 1024 + k]); z[q] = bfr(ALPHA * bf2f(HIN[(size_t)row * 1024 + c]) + a); }
    red[tid] = z[0] + z[1] + z[2] + z[3]; __syncthreads();
    for (int st = 128; st > 0; st >>= 1) { if (tid < st) red[tid] += red[tid + st]; __syncthreads(); }
    const float mu = red[0] / 1024.f; __syncthreads();
    red[tid] = (z[0] - mu) * (z[0] - mu) + (z[1] - mu) * (z[1] - mu) + (z[2] - mu) * (z[2] - mu) + (z[3] - mu) * (z[3] - mu); __syncthreads();
    for (int st = 128; st > 0; st >>= 1) { if (tid < st) red[tid] += red[tid + st]; __syncthreads(); }
    const float rs = rsqrtf(red[0] / 1024.f + 1e-5f);
    float num = 0.f, den = 0.f;
    for (int q = 0; q < 4; ++q) { const int c = tid + 256 * q; const float y = (z[q] - mu) * rs * g[c] + bb[c], gg = bf2f(H1[(size_t)row * 1024 + c]); num += (y - gg) * (y - gg); den += y * y; }
    dbg_acc(w, stage, num, den); (void)zrow;
}
__global__ void dbg_select(const float* logits, const float* rb, const int* tok_e, const float* tok_w, float* w, int stage) {
    __shared__ float sc[256], bs[256]; __shared__ int ce[8]; __shared__ float cs[8];
    if (threadIdx.x != 0) return;
    const unsigned tok = hash32(blockIdx.x + 31u * stage) % NTOK;
    const float* lp = logits + (size_t)tok * 256;
    for (int e = 0; e < 256; ++e) { sc[e] = 1.f / (1.f + expf(-lp[e])); bs[e] = sc[e] + rb[e]; }
    float gs[8];
#pragma unroll
    for (int g = 0; g < 8; ++g) { float m1 = -1e30f, m2 = -1e30f; for (int j = 0; j < 32; ++j) { const float v = bs[g * 32 + j]; if (v > m1) { m2 = m1; m1 = v; } else if (v > m2) m2 = v; } gs[g] = m1 + m2; }
    unsigned selmask = 0;
#pragma unroll
    for (int g = 0; g < 8; ++g) { int rank = 0;
#pragma unroll
        for (int q = 0; q < 8; ++q) rank += (gs[q] > gs[g] || (gs[q] == gs[g] && q < g)) ? 1 : 0; if (rank < 4) selmask |= 1u << g; }
    float tot = 0.f;
    for (int k = 0; k < 8; ++k) { float bv = -1e30f; int be = 0; for (int e = 0; e < 256; ++e) { if (!((selmask >> (e >> 5)) & 1u)) continue; bool used = false; for (int q = 0; q < k; ++q) used |= (ce[q] == e); if (used) continue; if (bs[e] > bv) { bv = bs[e]; be = e; } } ce[k] = be; cs[k] = sc[be]; tot += sc[be]; }
    float num = 0.f, den = 0.f;
    for (int k = 0; k < 8; ++k) { const float wr_ = cs[k] / tot * 2.5f; const int ge = tok_e[(size_t)tok * 8 + k]; const float gw = tok_w[(size_t)tok * 8 + k];
        num += (ge == ce[k] ? 0.f : 1.f) + (wr_ - gw) * (wr_ - gw); den += wr_ * wr_; }
    dbg_acc(w, stage, num, den);
}
template <bool FINAL> __global__ void dbg_moe(Args A, int layer, const int* tok_e, const float* tok_w, const bf16_t* H1, const bf16_t* H2, const float* OUT, float* w, int stage) {
    __shared__ float hrow[1024], hid[256], red[256];
    const int tid = threadIdx.x; const unsigned tok = hash32(blockIdx.x + 555u * stage) % NTOK;
    for (int i = tid; i < 1024; i += 256) hrow[i] = bf2f(H1[(size_t)tok * 1024 + i]);
    float acc[4] = {0.f, 0.f, 0.f, 0.f};
    __syncthreads();
    for (int k = 0; k < 9; ++k) {
        const int e = (k < 8) ? tok_e[(size_t)tok * 8 + k] : 256; const float wk = (k < 8) ? tok_w[(size_t)tok * 8 + k] : 1.f;
        const float* W1 = (e < 256) ? A.in[I_WEI] + (size_t)(layer * 256 + e) * 1024 * 512 : A.in[I_WSI] + (size_t)layer * 1024 * 512;
        const float* W2 = (e < 256) ? A.in[I_WED] + (size_t)(layer * 256 + e) * 256 * 1024 : A.in[I_WSD] + (size_t)layer * 256 * 1024;
        float gsum = 0.f, usum = 0.f;
        for (int kk = 0; kk < 1024; ++kk) { gsum += hrow[kk] * W1[(size_t)kk * 512 + tid]; usum += hrow[kk] * W1[(size_t)kk * 512 + 256 + tid]; }
        hid[tid] = gsum / (1.f + expf(-gsum)) * usum;
        __syncthreads();
        for (int q = 0; q < 4; ++q) { const int c = tid + 256 * q; float a = 0.f; for (int j = 0; j < 256; ++j) a += hid[j] * W2[(size_t)j * 1024 + c]; acc[q] += wk * a; }
        __syncthreads();
    }
    float z[4]; for (int q = 0; q < 4; ++q) z[q] = ALPHA * hrow[tid + 256 * q] + acc[q];
    red[tid] = z[0] + z[1] + z[2] + z[3]; __syncthreads();
    for (int st = 128; st > 0; st >>= 1) { if (tid < st) red[tid] += red[tid + st]; __syncthreads(); }
    const float mu = red[0] / 1024.f; __syncthreads();
    red[tid] = (z[0] - mu) * (z[0] - mu) + (z[1] - mu) * (z[1] - mu) + (z[2] - mu) * (z[2] - mu) + (z[3] - mu) * (z[3] - mu); __syncthreads();
    for (int st = 128; st > 0; st >>= 1) { if (tid < st) red[tid] += red[tid + st]; __syncthreads(); }
    const float rs = rsqrtf(red[0] / 1024.f + 1e-5f);
    const float* g = A.in[I_LFG] + layer * DM; const float* bb = A.in[I_LFB] + layer * DM;
    float num = 0.f, den = 0.f;
    for (int q = 0; q < 4; ++q) { const int c = tid + 256 * q; const float y = (z[q] - mu) * rs * g[c] + bb[c]; const float gg = FINAL ? OUT[(size_t)tok * 1024 + c] : bf2f(H2[(size_t)tok * 1024 + c]); num += (y - gg) * (y - gg); den += y * y; }
    dbg_acc(w, stage, num, den);
}
#ifndef DBG_REPORT
#define DBG_REPORT 0
#endif
__global__ void dbg_fill(float* out, const float* w) {
    __shared__ float cval;
    if (threadIdx.x == 0) {
        float c = 0.f;
        if (DBG_REPORT == 0) { for (int st = 1; st <= 13; ++st) { const float rel = sqrtf(w[2 * st] / fmaxf(w[2 * st + 1], 1e-30f)); if (!(rel < 0.08f) || !(w[2 * st + 1] > 0.f)) { c = (float)st; break; } } }
        else { const float rel = sqrtf(w[2 * DBG_REPORT] / fmaxf(w[2 * DBG_REPORT + 1], 1e-30f)); float l = -log10f(fmaxf(rel, 1e-8f)); l = fminf(fmaxf(l, -2.f), 8.f); c = 3.f + l; }
        cval = c;
    }
    __syncthreads();
    const float c = cval;
    if (c != 0.f) for (size_t i = (size_t)blockIdx.x * 256 + threadIdx.x; i < (size_t)NTOK * DM; i += (size_t)gridDim.x * 256) out[i] = c;
}
#endif

extern "C" void kernel_launch(void* const* d_in, const int* in_sizes, int n_in, void* d_out, int out_size, void* d_ws, size_t ws_size, hipStream_t stream) {
    static int grid = 0;
    if (grid == 0) {
        if (n_in != 22 || out_size != NTOK * DM || ws_size < WS_END) { fprintf(stderr, "kernel_launch: unexpected shapes (n_in %d out %d ws %zu)\n", n_in, out_size, ws_size); grid = -1; return; }
        if (hipFuncSetAttribute((const void*)fwd_kernel, hipFuncAttributeMaxDynamicSharedMemorySize, LDS_BYTES) != hipSuccess) { fprintf(stderr, "kernel_launch: hipFuncSetAttribute failed\n"); grid = -1; return; }
        int per_cu = 0;
        if (hipOccupancyMaxActiveBlocksPerMultiprocessor(&per_cu, (const void*)fwd_kernel, 512, LDS_BYTES) != hipSuccess || per_cu < 1) fprintf(stderr, "kernel_launch: occupancy query says %d\n", per_cu);
        (void)hipGetLastError();
        grid = NWG;
    }
    if (grid < 0) return;
    (void)hipMemsetAsync((char*)d_ws + WS_CTL, 0, CTL_BYTES, stream);
    Args a{};
    for (int i = 0; i < 22; ++i) a.in[i] = (const float*)d_in[i];
    a.out = (float*)d_out; a.ws = (unsigned char*)d_ws;
#if MK_ONE_LAUNCH
    a.ph_lo = 0; a.ph_hi = 23;
    hipLaunchKernelGGL(fwd_kernel, dim3(grid), dim3(512), LDS_BYTES, stream, a);
#else
    for (int p = 0; p < 23; ++p) { a.ph_lo = p; a.ph_hi = p + 1; hipLaunchKernelGGL(fwd_kernel, dim3(grid), dim3(512), LDS_BYTES, stream, a);
#ifdef DBG
        unsigned char* ws = (unsigned char*)d_ws; float* dw = (float*)(ws + WS_CTL) + CW_DBG;
        const int layer = (p - 1) / 11, q = (p - 1) % 11;
        MixP mp{(const bf16_t*)(ws + WS_PROJ), layer ? CWID : ABW, 0, (bf16_t*)(ws + WS_YMIX), (const float*)(ws + WS_GATES), (const float*)(ws + WS_MISC), a.in[I_BGK], a.in[I_HG], a.in[I_GG], a.in[I_CONV], a.in[I_BIF], (float*)(ws + WS_UST), (float*)(ws + WS_GSUM)};
        if (p == 0) hipLaunchKernelGGL(dbg_weights, dim3(256), dim3(256), 0, stream, a, dw);
        if (p >= 1 && q == 0) hipLaunchKernelGGL(dbg_gemm, dim3(64), dim3(256), 0, stream, (const bf16_t*)(ws + (layer ? WS_H2 : WS_HB)), 1024, (const bf16_t*)(ws + (layer ? WS_WC : WS_WAB)), (const void*)(ws + WS_PROJ), layer ? CWID : ABW, 0, NTOK, layer ? CWID : ABW, dw, layer ? 9 : 2);
        if (p >= 1 && q == 2 && layer == 0) { hipLaunchKernelGGL(dbg_mixer<0>, dim3(1), dim3(128), 0, stream, mp, 0, 1, 1100, dw, 3); hipLaunchKernelGGL(dbg_mixer<1>, dim3(1), dim3(128), 0, stream, mp, 1, 2, 1100, dw, 4); }
        if (p >= 1 && q == 2 && layer == 1) hipLaunchKernelGGL(dbg_mixer<2>, dim3(1), dim3(256), 0, stream, mp, 1, 1, 1100, dw, 10);
        if (p >= 1 && q == 4) hipLaunchKernelGGL(dbg_h1, dim3(32), dim3(256), 0, stream, (const bf16_t*)(ws + (layer ? WS_H2 : WS_HB)), (const bf16_t*)(ws + WS_YMIX), (const bf16_t*)(ws + (layer ? WS_WOC : WS_WOAB)), (const bf16_t*)(ws + WS_H1), a.in[I_LMG] + layer * DM, a.in[I_LMB] + layer * DM, dw, layer ? 11 : 5);
        if (p >= 1 && q == 5 && layer == 0) hipLaunchKernelGGL(dbg_gemm, dim3(64), dim3(256), 0, stream, (const bf16_t*)(ws + WS_H1), 1024, (const bf16_t*)(ws + WS_WR), (const void*)(ws + WS_LOGITS), 256, 1, NTOK, 256, dw, 6);
        if (p >= 1 && q == 6) hipLaunchKernelGGL(dbg_select, dim3(64), dim3(64), 0, stream, (const float*)(ws + WS_LOGITS), a.in[I_RB] + layer * NEXP, (const int*)(ws + WS_TOKE), (const float*)(ws + WS_TOKW), dw, layer ? 12 : 7);
        if (p >= 1 && q == 10 && layer == 0) hipLaunchKernelGGL(dbg_moe<false>, dim3(32), dim3(256), 0, stream, a, 0, (const int*)(ws + WS_TOKE), (const float*)(ws + WS_TOKW), (const bf16_t*)(ws + WS_H1), (const bf16_t*)(ws + WS_H2), (const float*)d_out, dw, 8);
        if (p >= 1 && q == 10 && layer == 1) { hipLaunchKernelGGL(dbg_moe<true>, dim3(32), dim3(256), 0, stream, a, 1, (const int*)(ws + WS_TOKE), (const float*)(ws + WS_TOKW), (const bf16_t*)(ws + WS_H1), (const bf16_t*)(ws + WS_H2), (const float*)d_out, dw, 13);
            hipLaunchKernelGGL(dbg_fill, dim3(1024), dim3(256), 0, stream, (float*)d_out, dw); }
#endif
    }
#endif
}
```

```cpp
#include <hip/hip_runtime.h>
#include <cstdio>
#include <cstdint>

#ifndef MK_ONE_LAUNCH
#define MK_ONE_LAUNCH 1
#endif

#define LAS __attribute__((address_space(3)))
typedef unsigned short bf16_t;
typedef short bf16x8 __attribute__((ext_vector_type(8)));
typedef float f32x4 __attribute__((ext_vector_type(4)));
typedef unsigned u32x4 __attribute__((ext_vector_type(4)));
typedef unsigned u32x2 __attribute__((ext_vector_type(2)));

constexpr int NTOK = 32768, SEQ = 16384, DM = 1024;
constexpr int ABW = 3840;
constexpr int CWID = 3072;
constexpr int NEXP = 256, NE1 = 257, TOPK = 8, NSLOT = 9;
constexpr float ALPHA = 1.41421356237f;
constexpr int NWG = 256;
constexpr int PRMAX = 262144 + 65536 + 32768;

constexpr size_t MiB = 1u << 20;
constexpr size_t WS_CTL = 0, CTL_BYTES = 1 * MiB;
constexpr size_t WS_MISC = 1 * MiB;
constexpr size_t WS_WAB = 2 * MiB, WS_WOAB = 10 * MiB, WS_WC = 12 * MiB, WS_WOC = 18 * MiB, WS_WR = 20 * MiB;
constexpr size_t WS_TOKE = 22 * MiB, WS_TOKP = 23 * MiB, WS_TOKW = 24 * MiB;
constexpr size_t WS_STOK = 26 * MiB, WS_POSY = 28 * MiB;
constexpr size_t WS_GATES = 32 * MiB;
constexpr size_t WS_UST = 34 * MiB, WS_GSUM = 54 * MiB;
constexpr size_t WS_LOGITS = 56 * MiB;
constexpr size_t WS_HB = 96 * MiB, WS_PROJ = 160 * MiB, WS_YMIX = 400 * MiB, WS_Z = 464 * MiB, WS_H1 = 528 * MiB, WS_H2 = 592 * MiB;
constexpr size_t WS_ACT = 656 * MiB, WS_Y = 832 * MiB, WS_W1T = 1540 * MiB, WS_W2T = 2056 * MiB;
constexpr size_t WS_XQ = 2320 * MiB, WS_H1Q = 2352 * MiB, WS_H2Q = 2384 * MiB, WS_END = 2416 * MiB;
constexpr float Q_SA = 127.f / 5.5f, Q_SW = 127.f * 32.f / 5.5f, Q_DEQ = 1.f / (Q_SA * Q_SW);
constexpr float Q_SACT = 127.f / 8.f, Q_DEQ2 = 16.f / (Q_SACT * Q_SW);
constexpr int CW_BAR = 4096;
constexpr int CW_CNT = 16384;
constexpr int CW_DBG = 20480;

__device__ __forceinline__ unsigned pk2(float lo, float hi) { unsigned r; asm volatile("v_cvt_pk_bf16_f32 %0, %1, %2" : "=v"(r) : "v"(lo), "v"(hi)); return r; }
__device__ __forceinline__ float bflo(unsigned u) { return __uint_as_float(u << 16); }
__device__ __forceinline__ float bfhi(unsigned u) { return __uint_as_float(u & 0xffff0000u); }
__device__ __forceinline__ float bf2f(bf16_t b) { return __uint_as_float(((unsigned)b) << 16); }
__device__ __forceinline__ float sigm(float x) { return __builtin_amdgcn_rcpf(1.f + __expf(-x)); }
__device__ __forceinline__ float silu(float x) { return x * __builtin_amdgcn_rcpf(1.f + __expf(-x)); }
__device__ __forceinline__ int q8(float x, float sc) { return (int)rintf(fminf(fmaxf(x * sc, -127.f), 127.f)); }
__device__ __forceinline__ unsigned pk4(int a, int b, int c, int d) { return (unsigned)(a & 255) | ((unsigned)(b & 255) << 8) | ((unsigned)(c & 255) << 16) | ((unsigned)d << 24); }
__device__ __forceinline__ float logsig(float x) { return fminf(x, 0.f) - __logf(1.f + __expf(-fabsf(x))); }

#define XB_TMO      128
#define XB_XCNT(j)  (256  + 64 * (j))
#define XB_XSUB(j)  (1280 + 64 * (j))
#define XB_XGEN(j)  (2304 + 64 * (j))
#define XB_TOP      3328
#define XB_TOPGEN   3392
#define XCD_BAR_WORDS 3456
#define XB_SPIN_CAP (1u << 22)
__device__ __forceinline__ unsigned xb_ld(unsigned* p)              { return __hip_atomic_load(p, __ATOMIC_RELAXED, __HIP_MEMORY_SCOPE_AGENT); }
__device__ __forceinline__ unsigned xb_add(unsigned* p, unsigned v) { return __hip_atomic_fetch_add(p, v, __ATOMIC_RELAXED, __HIP_MEMORY_SCOPE_AGENT); }
__device__ __forceinline__ unsigned xb_xcc_id() { return (unsigned)__builtin_amdgcn_s_getreg((3 << 11) | 20) & 0xFu; }
#define XB_SPIN(cond, bar) do { unsigned _sp = 0; while (cond) { __builtin_amdgcn_s_sleep(1); \
    if ((++_sp & 255u) == 0u) { if (xb_ld(&(bar)[XB_TMO])) break; if (_sp > XB_SPIN_CAP) { atomicAdd(&(bar)[XB_TMO], 1u); break; } } } } while (0)
struct XcdBarrier { unsigned* bar; unsigned x; volatile LAS unsigned* st; };
__device__ __forceinline__ XcdBarrier xcd_barrier_post(unsigned* bar, volatile LAS unsigned* st) {
    XcdBarrier b; b.bar = bar; b.x = xb_xcc_id(); b.st = st;
    if (threadIdx.x == 0) (void)xb_add(&bar[XB_XCNT(b.x)], 1u);
    return b;
}
__device__ __forceinline__ void xcd_barrier_complete(unsigned* bar, unsigned x, unsigned& nloc, unsigned& nx) {
    const unsigned G = gridDim.x * gridDim.y * gridDim.z;
    unsigned sum, cnt, mine, sp = 0u;
    for (;;) {
        sum = 0u; cnt = 0u; mine = 0u;
#pragma unroll
        for (unsigned j = 0; j < 16; ++j) { const unsigned c = xb_ld(&bar[XB_XCNT(j)]); sum += c; cnt += (c > 0u) ? 1u : 0u; mine = (j == x) ? c : mine; }
        if (sum == G) break;
        __builtin_amdgcn_s_sleep(1);
        if ((++sp & 255u) == 0u) { if (xb_ld(&bar[XB_TMO])) break; if (sp > XB_SPIN_CAP) { atomicAdd(&bar[XB_TMO], 1u); break; } }
    }
    nloc = mine > 0u ? mine : 1u; nx = cnt > 0u ? cnt : 1u;
}
__device__ __forceinline__ void xcd_barrier(const XcdBarrier& b) {
    asm volatile("s_waitcnt vmcnt(0)" ::: "memory");
    __syncthreads();
    if (threadIdx.x == 0) {
        unsigned* bar = b.bar;
        __builtin_amdgcn_s_waitcnt(0);
        unsigned nloc = b.st[0], nx = b.st[1];
        if (nloc == 0u) { xcd_barrier_complete(bar, b.x, nloc, nx); b.st[0] = nloc; b.st[1] = nx; }
        const unsigned old = xb_add(&bar[XB_XSUB(b.x)], 1u);
        const unsigned gen = old / nloc;
        if (old + 1u == (gen + 1u) * nloc) {
            __builtin_amdgcn_fence(__ATOMIC_RELEASE, "agent");
            asm volatile("s_waitcnt vmcnt(0)" ::: "memory");
            const unsigned og = xb_add(&bar[XB_TOP], 1u);
            const unsigned tg = og / nx;
            if (og + 1u == (tg + 1u) * nx) xb_add(&bar[XB_TOPGEN], 1u);
            else XB_SPIN(xb_ld(&bar[XB_TOPGEN]) == tg, bar);
            __builtin_amdgcn_fence(__ATOMIC_ACQUIRE, "agent");
            xb_add(&bar[XB_XGEN(b.x)], 1u);
            asm volatile("s_waitcnt vmcnt(0)" ::: "memory");
        } else {
            XB_SPIN(xb_ld(&bar[XB_XGEN(b.x)]) == gen, bar);
            __builtin_amdgcn_fence(__ATOMIC_ACQUIRE, "agent");
            asm volatile("s_waitcnt vmcnt(0)" ::: "memory");
        }
    }
    __syncthreads();
}

namespace pg8 {
constexpr int BM = 256, BK = 64, HALF = 128, HTB = HALF * BK * 2, STAGE_BYTES = 8 * HTB, NXCD = 8, WGM = 8;
__device__ __forceinline__ int lds_byte(int r, int c) { const int st = (r >> 4) * 2 + (c >> 5), rr = r & 15, cc = c & 31, ob = rr * 64 + cc * 2; return st * 1024 + (ob ^ (((ob >> 9) & 1) << 5)); }
__device__ __forceinline__ void stage_rc(int b, int& R, int& C) { const int st = b / 1024, sb = b % 1024, swz = sb ^ (((sb >> 9) & 1) << 5); R = (st >> 1) * 16 + swz / 64; C = (st & 1) * 32 + (swz % 64) / 2; }
__device__ __forceinline__ int perm32(int rho) { const int n = rho >> 4, i = rho & 15; return 8 * (i >> 2) + 4 * n + (i & 3); }
struct Unit { int pm, pn; };
struct Gemm { const bf16_t* A; const bf16_t* Bt; int K; };

struct StaticOrder {
    int nM, nN, nwg, G, c;
    __device__ void init(int M, int N, int G_, int c_) { nM = M / BM; nN = N / BM; nwg = nM * nN; G = G_; c = c_; }
    __device__ bool next(int i, Unit& u) const {
        const long L = (long)i * G + c; if (L >= nwg) return false;
        int wgid = (int)L; { const int q = nwg / NXCD, r = nwg % NXCD, xcd = wgid % NXCD, off = wgid / NXCD; wgid = (xcd < r ? xcd * (q + 1) : r * (q + 1) + (xcd - r) * q) + off; }
        const int nig = WGM * nN, gid = wgid / nig, fm = gid * WGM, gsz = (nM - fm) < WGM ? (nM - fm) : WGM;
        u.pm = fm + ((wgid % nig) % gsz); u.pn = (wgid % nig) / gsz; return true;
    }
};
struct MoeOrder {
    const LAS int* tab; int n;
    __device__ bool next(int i, Unit& u) const {
        if (i >= n) return false;
        u.pm = __builtin_amdgcn_readfirstlane(tab[2 * i]); u.pn = __builtin_amdgcn_readfirstlane(tab[2 * i + 1]); return true;
    }
};
constexpr int LDS_UT = 131072, LDS_IDX = 131072 + 512, MOE_MAXU = 15;
__device__ __forceinline__ int moe_prep(LAS unsigned char* lds, const int* __restrict__ tile_exp, int nunits, int sh, int G, int c, const int* __restrict__ rowidx) {
    const int tid = threadIdx.x;
    LAS int* tab = (LAS int*)(lds + LDS_UT);
    int n = 0; { const long rem = (long)nunits - c; n = rem > 0 ? (int)((rem + G - 1) / G) : 0; if (n > 32) n = 32; }
    if (tid < n) { const long L = (long)tid * G + c; const int rt = (int)(L >> sh), j = (int)L & ((1 << sh) - 1); tab[2 * tid] = rt; tab[2 * tid + 1] = (tile_exp[rt] << sh) + j; }
    __syncthreads();
    if (rowidx) { LAS int* idx = (LAS int*)(lds + LDS_IDX); const int nn = n < MOE_MAXU ? n : MOE_MAXU;
        for (int x = tid; x < nn * 256; x += 512) idx[x] = rowidx[tab[2 * (x >> 8)] * 256 + (x & 255)];
        __syncthreads(); }
    return n;
}

typedef int i32x4 __attribute__((ext_vector_type(4)));
template <class Epi, class Sched, bool GATHER, bool I8 = false>
__device__ __forceinline__ void gemm_phase(LAS unsigned char* lds, const Gemm g, const LAS int* rowidx, const Sched& S, const Epi& E) {
    const int tid = threadIdx.x, wid = __builtin_amdgcn_readfirstlane(tid >> 6), lane = tid & 63, wr = wid >> 2, wc = wid & 3, fr = lane & 15, fq = lane >> 4;
    const int K = g.K, nt = K / BK;
    unsigned voffB[2], cofs[2]; int Rr[2];
#pragma unroll
    for (int i = 0; i < 2; ++i) { int R, C; stage_rc(tid * 16 + i * 8192, R, C); const int Rb = Epi::PERM ? ((R & ~31) + perm32(R & 31)) : R;
        Rr[i] = R; cofs[i] = (unsigned)C * 2u; voffB[i] = (unsigned)(Rb * K + C) * 2u; }
    const unsigned rowb = (unsigned)K * 2u;
    const size_t kstep = (size_t)(BK * 2);
    const size_t hstep = (size_t)HALF * K * 2;
    const size_t tstep = 2 * hstep;
    const unsigned ldsw = (unsigned)wid * 1024u;
    const int aoff = lds_byte(wr * 64 + fr, fq * 8), boff = lds_byte(wc * 32 + fr, fq * 8);
    const char* Abase = (const char*)g.A;
#define PG8_SA(b, h) (((b) * 2 + (h)) * HTB)
#define PG8_SB(b, h) ((4 + (b) * 2 + (h)) * HTB)
#define PG8_STAGE(bufoff, gbase, voff) do { _Pragma("unroll") for (int _i = 0; _i < 2; ++_i) \
        __builtin_amdgcn_global_load_lds((const unsigned*)((const char*)(gbase) + (voff)[_i]), (LAS unsigned*)(lds + (bufoff) + ldsw + _i * 8192), 16, 0, 0); } while (0)
#define PG8_STAGEA(bufoff, kb, offs) do { _Pragma("unroll") for (int _i = 0; _i < 2; ++_i) \
        __builtin_amdgcn_global_load_lds((const unsigned*)(Abase + (size_t)((kb) + (offs)[_i])), (LAS unsigned*)(lds + (bufoff) + ldsw + _i * 8192), 16, 0, 0); } while (0)
#define PG8_ROWOFF(u, uo, O) do { _Pragma("unroll") for (int _h = 0; _h < 2; ++_h) _Pragma("unroll") for (int _i = 0; _i < 2; ++_i) { \
        int _row = (u).pm * BM + _h * HALF + Rr[_i]; if (GATHER) _row = rowidx[(uo) * 256 + _h * HALF + Rr[_i]]; (O)[_h][_i] = (unsigned)_row * rowb + cofs[_i]; } } while (0)
#define PG8_LDA(dst, b, h) do { _Pragma("unroll") for (int m = 0; m < 4; ++m) _Pragma("unroll") for (int k = 0; k < 2; ++k) dst[m][k] = *(const LAS bf16x8*)(lds + PG8_SA(b, h) + aoff + m * 2048 + k * 1024); } while (0)
#define PG8_LDB(dst, b, h) do { _Pragma("unroll") for (int n = 0; n < 2; ++n) _Pragma("unroll") for (int k = 0; k < 2; ++k) dst[n][k] = *(const LAS bf16x8*)(lds + PG8_SB(b, h) + boff + n * 2048 + k * 1024); } while (0)
#define PG8_MMA(ai, bj, At, Bt) do { __builtin_amdgcn_s_setprio(1); _Pragma("unroll") for (int m = 0; m < 4; ++m) _Pragma("unroll") for (int n = 0; n < 2; ++n) _Pragma("unroll") for (int k = 0; k < 2; ++k) \
        { if (I8) acc[ai][bj][m][n] = __builtin_bit_cast(f32x4, __builtin_amdgcn_mfma_i32_16x16x64_i8(__builtin_bit_cast(i32x4, Bt[n][k]), __builtin_bit_cast(i32x4, At[m][k]), __builtin_bit_cast(i32x4, acc[ai][bj][m][n]), 0, 0, 0)); \
          else acc[ai][bj][m][n] = __builtin_amdgcn_mfma_f32_16x16x32_bf16(Bt[n][k], At[m][k], acc[ai][bj][m][n], 0, 0, 0); } __builtin_amdgcn_s_setprio(0); } while (0)
#define PG8_WAIT_V(n) asm volatile("s_waitcnt vmcnt(" #n ")" ::: "memory")
#define PG8_WAIT_L(n) asm volatile("s_waitcnt lgkmcnt(" #n ")" ::: "memory")
#define PG8_BAR __builtin_amdgcn_s_barrier()
#define PG8_SCHED __builtin_amdgcn_sched_barrier(0)
    Unit cur, nxt; int ui = 0;
    if (!S.next(0, cur)) return;
    f32x4 acc[2][2][4][2];
#pragma unroll
    for (int a = 0; a < 2; ++a)
#pragma unroll
        for (int b = 0; b < 2; ++b)
#pragma unroll
            for (int m = 0; m < 4; ++m)
#pragma unroll
                for (int n = 0; n < 2; ++n) acc[a][b][m][n] = (f32x4){0.f, 0.f, 0.f, 0.f};
    bf16x8 At[4][2], B0[2][2], B1[2][2];
    unsigned cO[2][2], nO[2][2];
    PG8_ROWOFF(cur, 0, cO);
    const char* cB = (const char*)g.Bt + (size_t)cur.pn * tstep;
    PG8_STAGE(PG8_SB(0, 0), cB, voffB); PG8_STAGE(PG8_SB(0, 1), cB + hstep, voffB); PG8_STAGEA(PG8_SA(0, 0), 0u, cO[0]); PG8_STAGEA(PG8_SA(0, 1), 0u, cO[1]);
    if (wr == 1) PG8_BAR;
    PG8_WAIT_V(2); PG8_BAR;
    PG8_STAGE(PG8_SB(1, 0), cB + kstep, voffB); PG8_STAGEA(PG8_SA(1, 0), (unsigned)kstep, cO[0]); PG8_STAGE(PG8_SB(1, 1), cB + hstep + kstep, voffB);
    PG8_WAIT_V(6); PG8_BAR;
    for (;;) {
        const bool has_next = S.next(ui + 1, nxt);
        const char* nB = has_next ? (const char*)g.Bt + (size_t)nxt.pn * tstep : cB;
#pragma unroll
        for (int h = 0; h < 2; ++h)
#pragma unroll
            for (int i = 0; i < 2; ++i) nO[h][i] = cO[h][i];
#pragma unroll 1
        for (int t = 0; t < nt; t += 2) {
            const bool last = (t == nt - 2);
            if (last && has_next) PG8_ROWOFF(nxt, ui + 1, nO);
            const unsigned k1 = (unsigned)(t + 1) * (unsigned)kstep;
            const unsigned k2 = last ? 0u : (unsigned)(t + 2) * (unsigned)kstep, k3 = k2 + (unsigned)kstep;
            const char* b2 = last ? nB : cB + (size_t)(t + 2) * kstep; const char* b3 = b2 + kstep;
            unsigned o2[2][2];
#pragma unroll
            for (int h = 0; h < 2; ++h)
#pragma unroll
                for (int i = 0; i < 2; ++i) o2[h][i] = last ? nO[h][i] : cO[h][i];
            PG8_LDB(B0, 0, 0); PG8_LDB(B1, 0, 1); PG8_SCHED; PG8_LDA(At, 0, 0); PG8_STAGEA(PG8_SA(1, 1), k1, cO[1]);
            PG8_WAIT_V(8); PG8_WAIT_L(0); PG8_BAR; PG8_MMA(0, 0, At, B0); PG8_MMA(0, 1, At, B1); PG8_BAR; PG8_SCHED;
            PG8_LDA(At, 0, 1); PG8_STAGE(PG8_SB(0, 0), b2, voffB); PG8_STAGE(PG8_SB(0, 1), b2 + hstep, voffB); PG8_STAGEA(PG8_SA(0, 0), k2, o2[0]);
            PG8_WAIT_V(8); PG8_WAIT_L(0); PG8_BAR; PG8_MMA(1, 0, At, B0); PG8_MMA(1, 1, At, B1); PG8_BAR; PG8_SCHED;
            PG8_LDB(B0, 1, 0); PG8_LDB(B1, 1, 1); PG8_SCHED; PG8_LDA(At, 1, 0); PG8_STAGEA(PG8_SA(0, 1), k2, o2[1]);
            PG8_WAIT_V(8); PG8_WAIT_L(0); PG8_BAR; PG8_MMA(0, 0, At, B0); PG8_MMA(0, 1, At, B1); PG8_BAR; PG8_SCHED;
            PG8_LDA(At, 1, 1); PG8_STAGE(PG8_SB(1, 0), b3, voffB); PG8_STAGE(PG8_SB(1, 1), b3 + hstep, voffB); PG8_STAGEA(PG8_SA(1, 0), k3, o2[0]);
            PG8_WAIT_V(8); PG8_WAIT_L(0); PG8_BAR; PG8_MMA(1, 0, At, B0); PG8_MMA(1, 1, At, B1); PG8_BAR; PG8_SCHED;
        }
        if (wr == 0) PG8_BAR;
        E(acc, cur, wr, wc, fr, fq);
        if (!has_next) break;
#pragma unroll
        for (int a = 0; a < 2; ++a)
#pragma unroll
            for (int b = 0; b < 2; ++b)
#pragma unroll
                for (int m = 0; m < 4; ++m)
#pragma unroll
                    for (int n = 0; n < 2; ++n) acc[a][b][m][n] = (f32x4){0.f, 0.f, 0.f, 0.f};
        cur = nxt; cB = nB; ++ui;
#pragma unroll
        for (int h = 0; h < 2; ++h)
#pragma unroll
            for (int i = 0; i < 2; ++i) cO[h][i] = nO[h][i];
        if (wr == 1) PG8_BAR;
    }
    PG8_WAIT_V(0);
    PG8_BAR;
#undef PG8_SA
#undef PG8_SB
#undef PG8_STAGE
#undef PG8_STAGEA
#undef PG8_ROWOFF
#undef PG8_LDA
#undef PG8_LDB
#undef PG8_MMA
#undef PG8_WAIT_V
#undef PG8_WAIT_L
#undef PG8_BAR
#undef PG8_SCHED
}

template <bool I8> struct EpiStoreBf16 {
    static constexpr bool PERM = true;
    bf16_t* O; int ldc;
    static __device__ __forceinline__ f32x4 dq(f32x4 v) { if (I8) { const i32x4 q = __builtin_bit_cast(i32x4, v); return (f32x4){(float)q[0] * Q_DEQ, (float)q[1] * Q_DEQ, (float)q[2] * Q_DEQ, (float)q[3] * Q_DEQ}; } return v; }
    __device__ __forceinline__ void operator()(const f32x4 (&acc)[2][2][4][2], const Unit& u, int wr, int wc, int fr, int fq) const {
        const int row0 = u.pm * BM + wr * 64 + fr, col0 = u.pn * BM + wc * 32 + 8 * fq;
#pragma unroll
        for (int ai = 0; ai < 2; ++ai)
#pragma unroll
            for (int m = 0; m < 4; ++m) { bf16_t* rowp = O + (size_t)(row0 + ai * HALF + m * 16) * ldc + col0;
#pragma unroll
                for (int bj = 0; bj < 2; ++bj) { const f32x4 v0 = dq(acc[ai][bj][m][0]), v1 = dq(acc[ai][bj][m][1]);
                    u32x4 w; w.x = pk2(v0[0], v0[1]); w.y = pk2(v0[2], v0[3]); w.z = pk2(v1[0], v1[1]); w.w = pk2(v1[2], v1[3]);
                    *(u32x4*)(rowp + bj * HALF) = w; } }
    }
};
struct EpiResid {
    static constexpr bool PERM = true;
    bf16_t* Z; const bf16_t* H;
    __device__ __forceinline__ void operator()(const f32x4 (&acc)[2][2][4][2], const Unit& u, int wr, int wc, int fr, int fq) const {
        const int row0 = u.pm * BM + wr * 64 + fr, col0 = u.pn * BM + wc * 32 + 8 * fq;
#pragma unroll
        for (int ai = 0; ai < 2; ++ai)
#pragma unroll
            for (int m = 0; m < 4; ++m) { const size_t ro = (size_t)(row0 + ai * HALF + m * 16) * DM + col0;
#pragma unroll
                for (int bj = 0; bj < 2; ++bj) { const f32x4 v0 = acc[ai][bj][m][0], v1 = acc[ai][bj][m][1];
                    const u32x4 hh = *(const u32x4*)(H + ro + bj * HALF);
                    u32x4 w;
                    w.x = pk2(ALPHA * bflo(hh.x) + v0[0], ALPHA * bfhi(hh.x) + v0[1]); w.y = pk2(ALPHA * bflo(hh.y) + v0[2], ALPHA * bfhi(hh.y) + v0[3]);
                    w.z = pk2(ALPHA * bflo(hh.z) + v1[0], ALPHA * bfhi(hh.z) + v1[1]); w.w = pk2(ALPHA * bflo(hh.w) + v1[2], ALPHA * bfhi(hh.w) + v1[3]);
                    *(u32x4*)(Z + ro + bj * HALF) = w; } }
    }
};
struct EpiF32 {
    static constexpr bool PERM = false;
    float* C;
    __device__ __forceinline__ void operator()(const f32x4 (&acc)[2][2][4][2], const Unit& u, int wr, int wc, int fr, int fq) const {
        const int row0 = u.pm * BM + wr * 64 + fr, col0 = wc * 32 + 4 * fq;
#pragma unroll
        for (int ai = 0; ai < 2; ++ai)
#pragma unroll
            for (int m = 0; m < 4; ++m) { float* rowp = C + (size_t)(row0 + ai * HALF + m * 16) * 256 + col0;
#pragma unroll
                for (int bj = 0; bj < 2; ++bj)
#pragma unroll
                    for (int n = 0; n < 2; ++n) *(f32x4*)(rowp + bj * HALF + n * 16) = acc[ai][bj][m][n]; }
    }
};
template <bool I8> struct EpiSwiGLU {
    static constexpr bool PERM = true;
    unsigned char* ACT; LAS unsigned char* sbuf;
    static __device__ __forceinline__ f32x4 dq(f32x4 v) { if (I8) { const i32x4 q = __builtin_bit_cast(i32x4, v); return (f32x4){(float)q[0] * Q_DEQ, (float)q[1] * Q_DEQ, (float)q[2] * Q_DEQ, (float)q[3] * Q_DEQ}; } return v; }
    __device__ __forceinline__ void operator()(const f32x4 (&acc)[2][2][4][2], const Unit& u, int wr, int wc, int fr, int fq) const {
        const int tid = threadIdx.x, rrow = tid >> 3, rchunk = tid & 7;
        const int wrow = wr * 16 + fr;
        unsigned char* abase = ACT + (size_t)(u.pm * BM) * 256 + (u.pn & 1) * 128 + rchunk * 16;
#pragma unroll
        for (int st = 0; st < 8; ++st) {
            const int ai = st >> 2, m = st & 3;
            LAS unsigned char* buf = sbuf + (st & 1) * 4096;
            const f32x4 g0 = dq(acc[ai][0][m][0]), g1 = dq(acc[ai][0][m][1]), u0 = dq(acc[ai][1][m][0]), u1 = dq(acc[ai][1][m][1]);
            u32x2 w;
            w.x = pk4(q8(silu(g0[0]) * u0[0], Q_SACT), q8(silu(g0[1]) * u0[1], Q_SACT), q8(silu(g0[2]) * u0[2], Q_SACT), q8(silu(g0[3]) * u0[3], Q_SACT));
            w.y = pk4(q8(silu(g1[0]) * u1[0], Q_SACT), q8(silu(g1[1]) * u1[1], Q_SACT), q8(silu(g1[2]) * u1[2], Q_SACT), q8(silu(g1[3]) * u1[3], Q_SACT));
            const int c16 = wc * 2 + (fq >> 1);
            *(LAS u32x2*)(buf + wrow * 128 + ((c16 ^ (wrow & 7)) << 4) + (fq & 1) * 8) = w;
            asm volatile("s_waitcnt lgkmcnt(0)" ::: "memory"); __builtin_amdgcn_s_barrier(); asm volatile("" ::: "memory");
            if (tid < 256) {
                const u32x4 rv = *(const LAS u32x4*)(buf + rrow * 128 + ((rchunk ^ (rrow & 7)) << 4));
                const int grow = ai * HALF + (rrow >> 4) * 64 + m * 16 + (rrow & 15);
                *(u32x4*)(abase + (size_t)grow * 256) = rv;
            }
        }
        asm volatile("s_waitcnt lgkmcnt(0)" ::: "memory"); __builtin_amdgcn_s_barrier(); asm volatile("" ::: "memory");
    }
};
template <int EV = 0> struct EpiDownT {
    static constexpr bool PERM = true;
    unsigned char* Y; LAS unsigned char* sbuf;
    __device__ __forceinline__ void operator()(const f32x4 (&acc)[2][2][4][2], const Unit& u, int wr, int wc, int fr, int fq) const {
        const int tid = threadIdx.x, rrow = tid >> 4, rchunk = tid & 15;
        const int wrow = wr * 16 + fr;
        unsigned char* ybase = Y + (size_t)(u.pm * BM) * DM + (u.pn & 3) * 256 + rchunk * 16;
#pragma unroll
        for (int st = 0; st < 8; ++st) {
            const int ai = st >> 2, m = st & 3;
            LAS unsigned char* buf = sbuf + (st & 1) * 8192;
#pragma unroll
            for (int bj = 0; bj < 2; ++bj) { const i32x4 q0 = __builtin_bit_cast(i32x4, acc[ai][bj][m][0]), q1 = __builtin_bit_cast(i32x4, acc[ai][bj][m][1]);
                const f32x4 v0 = (f32x4){(float)q0[0] * Q_DEQ2, (float)q0[1] * Q_DEQ2, (float)q0[2] * Q_DEQ2, (float)q0[3] * Q_DEQ2}, v1 = (f32x4){(float)q1[0] * Q_DEQ2, (float)q1[1] * Q_DEQ2, (float)q1[2] * Q_DEQ2, (float)q1[3] * Q_DEQ2};
                int p0 = __builtin_amdgcn_cvt_pk_fp8_f32(v0[0], v0[1], 0, false); p0 = __builtin_amdgcn_cvt_pk_fp8_f32(v0[2], v0[3], p0, true);
                int p1 = __builtin_amdgcn_cvt_pk_fp8_f32(v1[0], v1[1], 0, false); p1 = __builtin_amdgcn_cvt_pk_fp8_f32(v1[2], v1[3], p1, true);
                u32x2 w; w.x = (unsigned)p0; w.y = (unsigned)p1;
                const int c16 = bj * 8 + wc * 2 + (fq >> 1);
                *(LAS u32x2*)(buf + wrow * 256 + ((c16 ^ (wrow & 15)) << 4) + (fq & 1) * 8) = w; }
            asm volatile("s_waitcnt lgkmcnt(0)" ::: "memory"); __builtin_amdgcn_s_barrier(); asm volatile("" ::: "memory");
            const u32x4 rv = *(const LAS u32x4*)(buf + rrow * 256 + ((rchunk ^ (rrow & 15)) << 4));
            const int grow = ai * HALF + (rrow >> 4) * 64 + m * 16 + (rrow & 15);
            if (EV == 1) { asm volatile("" :: "v"(rv.x), "v"(rv.y), "v"(rv.z), "v"(rv.w)); } else *(u32x4*)(ybase + (size_t)grow * DM) = rv;
        }
        asm volatile("s_waitcnt lgkmcnt(0)" ::: "memory"); __builtin_amdgcn_s_barrier(); asm volatile("" ::: "memory");
    }
};
typedef EpiDownT<0> EpiDown;
}

struct Args { const float* in[22]; float* out; unsigned char* ws; int ph_lo, ph_hi; };
enum { I_X = 0, I_WINAB, I_WGKUP, I_BGK, I_HG, I_GG, I_WOAB, I_LB, I_WINC, I_CONV, I_BIF, I_WOC, I_WR, I_RB, I_WEI, I_WED, I_WSI, I_WSD, I_LMG, I_LMB, I_LFG, I_LFB };

constexpr int LDS_MISC = 147200;
constexpr int LDS_BYTES = 147456;

__device__ __forceinline__ void cvt_tile(LAS unsigned char* lds, const float* __restrict__ src, size_t ldn, int k0, int n0, bf16_t* __restrict__ dst, int K, int drow0) {
    const int t = threadIdx.x;
    { const int c4 = (t & 15) * 4, r2 = t >> 4;
      const f32x4 a = *(const f32x4*)(src + (size_t)(k0 + 2 * r2) * ldn + n0 + c4);
      const f32x4 b = *(const f32x4*)(src + (size_t)(k0 + 2 * r2 + 1) * ldn + n0 + c4);
#pragma unroll
      for (int i = 0; i < 4; ++i) *(LAS unsigned*)(lds + ((c4 + i) * 72 + 2 * r2) * 2) = pk2(a[i], b[i]); }
    __syncthreads();
    { const int kk = (t & 7) * 8, n = t >> 3;
      const u32x4 v = *(const LAS u32x4*)(lds + (n * 72 + kk) * 2);
      *(u32x4*)(dst + (size_t)(drow0 + n) * K + k0 + kk) = v; }
    __syncthreads();
}
template <int NT>
__device__ __forceinline__ void cvt_multi(LAS unsigned char* lds, const float* __restrict__ src, size_t ldn, int k0, int n0, bf16_t* __restrict__ dst, int K, const int (&drow)[NT], float sc = 1.f) {
    const int t = threadIdx.x;
    { const int c4 = (t & 15) * 4, r2 = t >> 4;
      f32x4 a[NT], b[NT];
#pragma unroll
      for (int q = 0; q < NT; ++q) { a[q] = __builtin_nontemporal_load((const f32x4*)(src + (size_t)(k0 + 2 * r2) * ldn + n0 + 64 * q + c4)); b[q] = __builtin_nontemporal_load((const f32x4*)(src + (size_t)(k0 + 2 * r2 + 1) * ldn + n0 + 64 * q + c4)); }
#pragma unroll
      for (int q = 0; q < NT; ++q)
#pragma unroll
          for (int i = 0; i < 4; ++i) *(LAS unsigned*)(lds + q * 9216 + ((c4 + i) * 72 + 2 * r2) * 2) = pk2(a[q][i] * sc, b[q][i] * sc); }
    __syncthreads();
    { const int kk = (t & 7) * 8, n = t >> 3;
#pragma unroll
      for (int q = 0; q < NT; ++q) { const u32x4 v = *(const LAS u32x4*)(lds + q * 9216 + (n * 72 + kk) * 2); *(u32x4*)(dst + (size_t)(drow[q] + n) * K + k0 + kk) = v; } }
    __syncthreads();
}
template <int NT>
__device__ __forceinline__ void cvt8_multi(LAS unsigned char* lds, const float* __restrict__ src, size_t ldn, int k0, int n0, unsigned char* __restrict__ dst, int Kb, const int (&drow)[NT], float sc) {
    const int t = threadIdx.x;
    { const int c4 = (t & 15) * 4, r4 = t >> 4;
      f32x4 a[NT][4];
#pragma unroll
      for (int q = 0; q < NT; ++q)
#pragma unroll
          for (int j = 0; j < 4; ++j) a[q][j] = __builtin_nontemporal_load((const f32x4*)(src + (size_t)(k0 + 4 * r4 + j) * ldn + n0 + 64 * q + c4));
#pragma unroll
      for (int q = 0; q < NT; ++q)
#pragma unroll
          for (int i = 0; i < 4; ++i) *(LAS unsigned*)(lds + q * 9216 + (c4 + i) * 144 + 4 * r4) = pk4(q8(a[q][0][i], sc), q8(a[q][1][i], sc), q8(a[q][2][i], sc), q8(a[q][3][i], sc)); }
    __syncthreads();
    { const int kk = (t & 7) * 16, n = t >> 3;
#pragma unroll
      for (int q = 0; q < NT; ++q) { const u32x4 v = *(const LAS u32x4*)(lds + q * 9216 + n * 144 + kk); *(u32x4*)(dst + (size_t)(drow[q] + n) * Kb + k0 + kk) = v; } }
    __syncthreads();
}
template <int NT>
__device__ __forceinline__ void cvt8_matrix(LAS unsigned char* lds, const float* src, size_t ldn, int K, int n_lo, int ncols, unsigned char* dst, int drow_lo, float sc, int bid, int nb) {
    const int tk = K / 128, tn = ncols / (64 * NT);
    for (int j = bid; j < tk * tn; j += nb) { const int a = j / tn, b = j % tn; int dr[NT];
#pragma unroll
        for (int q = 0; q < NT; ++q) dr[q] = drow_lo + (b * NT + q) * 64;
        cvt8_multi<NT>(lds, src, ldn, a * 128, n_lo + b * 64 * NT, dst, K, dr, sc); }
}
template <int NT>
__device__ __forceinline__ void cvt_matrix(LAS unsigned char* lds, const float* src, size_t ldn, int K, int n_lo, int ncols, bf16_t* dst, int drow_lo, int bid, int nb) {
    const int tk = K / 64, tn = ncols / (64 * NT);
    for (int j = bid; j < tk * tn; j += nb) { const int a = j / tn, b = j % tn; int dr[NT];
#pragma unroll
        for (int q = 0; q < NT; ++q) dr[q] = drow_lo + (b * NT + q) * 64;
        cvt_multi<NT>(lds, src, ldn, a * 64, n_lo + b * 64 * NT, dst, K, dr); }
}
__device__ __forceinline__ void phase_prologue(LAS unsigned char* lds, const Args& A, int bid, int nb) {
    unsigned char* ws = A.ws; const int tid = threadIdx.x;
    if (bid == 0) {
        float* lb0 = (float*)(ws + WS_MISC);
        const float* l = A.in[I_LB];
        if (tid < 512) { const float a = l[tid], b = l[512 + tid], c = l[1024 + tid]; const float m = fmaxf(a, fmaxf(b, c));
            const float ea = __expf(a - m), eb = __expf(b - m), ec = __expf(c - m); lb0[tid] = ea / (ea + eb + ec); }
    }
    if (bid == 1 % nb) {
        float* wg = (float*)(ws + WS_MISC + 4096);
        for (int i = tid; i < 8 * 1024; i += 512) { const int g = i >> 10, k = i & 1023; wg[i] = A.in[I_WINC][(size_t)k * 3080 + 3072 + g]; }
    }
    { const float* x = A.in[I_X]; bf16_t* hb = (bf16_t*)(ws + WS_HB); unsigned char* xq = ws + WS_XQ;
      const size_t step = (size_t)nb * 512 * 8;
      for (size_t i0 = ((size_t)bid * 512 + tid) * 8; i0 < (size_t)NTOK * DM; i0 += 4 * step) {
          f32x4 a[4], b[4];
#pragma unroll
          for (int u = 0; u < 4; ++u) { const size_t i = i0 + u * step; if (i < (size_t)NTOK * DM) { a[u] = __builtin_nontemporal_load((const f32x4*)(x + i)); b[u] = __builtin_nontemporal_load((const f32x4*)(x + i + 4)); } }
#pragma unroll
          for (int u = 0; u < 4; ++u) { const size_t i = i0 + u * step; if (i < (size_t)NTOK * DM) {
              u32x4 w; w.x = pk2(a[u][0], a[u][1]); w.y = pk2(a[u][2], a[u][3]); w.z = pk2(b[u][0], b[u][1]); w.w = pk2(b[u][2], b[u][3]);
              *(u32x4*)(hb + i) = w;
              u32x2 qv; qv.x = pk4(q8(a[u][0], Q_SA), q8(a[u][1], Q_SA), q8(a[u][2], Q_SA), q8(a[u][3], Q_SA)); qv.y = pk4(q8(b[u][0], Q_SA), q8(b[u][1], Q_SA), q8(b[u][2], Q_SA), q8(b[u][3], Q_SA));
              *(u32x2*)(xq + i) = qv; } } } }
    { unsigned char* wab = ws + WS_WAB; const float* win = A.in[I_WINAB]; const float* wup = A.in[I_WGKUP];
      for (int o = bid * 512 + tid; o < 256 * 64; o += nb * 512) { const int j = o >> 6, k16 = (o & 63) * 16;
          float up[16];
#pragma unroll
          for (int r = 0; r < 16; ++r) up[r] = wup[r * 256 + j];
          int res[16];
#pragma unroll
          for (int q = 0; q < 16; ++q) { const float* wr_ = win + (size_t)(k16 + q) * 3600 + 3584; float sm = 0.f;
#pragma unroll
              for (int r = 0; r < 16; ++r) sm += wr_[r] * up[r];
              res[q] = q8(sm, Q_SW); }
          u32x4 w; w.x = pk4(res[0], res[1], res[2], res[3]); w.y = pk4(res[4], res[5], res[6], res[7]); w.z = pk4(res[8], res[9], res[10], res[11]); w.w = pk4(res[12], res[13], res[14], res[15]);
          *(u32x4*)(wab + (size_t)(3584 + j) * 1024 + k16) = w; } }
    cvt8_matrix<4>(lds, A.in[I_WINAB], 3600, 1024, 0, 3584, ws + WS_WAB, 0, Q_SW, bid, nb);
    cvt_matrix<8>(lds, A.in[I_WOAB], 1024, 1024, 0, 1024, (bf16_t*)(ws + WS_WOAB), 0, bid, nb);
    cvt8_matrix<4>(lds, A.in[I_WINC], 3080, 1024, 0, 3072, ws + WS_WC, 0, Q_SW, bid, nb);
    cvt_matrix<8>(lds, A.in[I_WOC], 1024, 1024, 0, 1024, (bf16_t*)(ws + WS_WOC), 0, bid, nb);
    cvt_matrix<4>(lds, A.in[I_WR], 256, 1024, 0, 256, (bf16_t*)(ws + WS_WR), 0, bid, nb);
    cvt_matrix<4>(lds, A.in[I_WR] + 1024 * 256, 256, 1024, 0, 256, (bf16_t*)(ws + WS_WR) + 256 * 1024, 0, bid, nb);
}
__device__ __forceinline__ void convert_experts(LAS unsigned char* lds, const Args& A, int layer, int bid, int nb, int part) {
    unsigned char* ws = A.ws;
    int kk = 0;
    for (int j = bid; j < NE1 * 16; j += nb, ++kk) {
        if (((kk % 5) < 3) != (part == 0)) continue;
        const int e = j % NE1, t0 = j / NE1;
        const int t = (t0 < 8) ? 2 * t0 : 8 + t0;
        if (t < 16) {
            const float* src = (e < NEXP) ? A.in[I_WEI] + ((size_t)(layer * NEXP + e)) * 1024 * 512 : A.in[I_WSI] + (size_t)layer * 1024 * 512;
            unsigned char* dst = ws + WS_W1T + ((size_t)(layer * NE1 + e)) * 512 * 1024;
            const int tk = t >> 1;
            int dr[8];
#pragma unroll
            for (int q = 0; q < 8; ++q) { const int n0 = q * 64, gq = n0 >> 8, nn = n0 & 255; dr[q] = (nn >> 7) * 256 + gq * 128 + (nn & 127); }
            cvt8_multi<8>(lds, src, 512, tk * 128, 0, dst, 1024, dr, Q_SW);
        } else {
            const int t2 = t - 16, tk = t2 >> 2, g4 = t2 & 3;
            const float* src = (e < NEXP) ? A.in[I_WED] + ((size_t)(layer * NEXP + e)) * 256 * 1024 : A.in[I_WSD] + (size_t)layer * 256 * 1024;
            unsigned char* dst = ws + WS_W2T + ((size_t)(layer * NE1 + e)) * 1024 * 256;
            int dr[4];
#pragma unroll
            for (int q = 0; q < 4; ++q) dr[q] = g4 * 256 + q * 64;
            cvt8_multi<4>(lds, src, 1024, tk * 128, g4 * 256, dst, 256, dr, Q_SW);
        }
    }
}

__device__ __forceinline__ void phase_ln(const bf16_t* __restrict__ Z, bf16_t* __restrict__ H, unsigned char* __restrict__ HQ, const float* __restrict__ g, const float* __restrict__ b, int bid, int nb) {
    const int lane = threadIdx.x & 63, gw = bid * 8 + (threadIdx.x >> 6), nw = nb * 8;
    float gg[16], bb[16];
#pragma unroll
    for (int i = 0; i < 8; ++i) { gg[i] = g[lane * 8 + i]; gg[8 + i] = g[512 + lane * 8 + i]; bb[i] = b[lane * 8 + i]; bb[8 + i] = b[512 + lane * 8 + i]; }
    for (int row = gw; row < NTOK; row += nw) {
        const u32x4 a = *(const u32x4*)(Z + (size_t)row * DM + lane * 8), c = *(const u32x4*)(Z + (size_t)row * DM + 512 + lane * 8);
        float v[16];
        v[0] = bflo(a.x); v[1] = bfhi(a.x); v[2] = bflo(a.y); v[3] = bfhi(a.y); v[4] = bflo(a.z); v[5] = bfhi(a.z); v[6] = bflo(a.w); v[7] = bfhi(a.w);
        v[8] = bflo(c.x); v[9] = bfhi(c.x); v[10] = bflo(c.y); v[11] = bfhi(c.y); v[12] = bflo(c.z); v[13] = bfhi(c.z); v[14] = bflo(c.w); v[15] = bfhi(c.w);
        float s = 0.f;
#pragma unroll
        for (int i = 0; i < 16; ++i) s += v[i];
#pragma unroll
        for (int o = 32; o > 0; o >>= 1) s += __shfl_xor(s, o);
        const float mu = s * (1.f / 1024.f);
        float q = 0.f;
#pragma unroll
        for (int i = 0; i < 16; ++i) { const float d = v[i] - mu; q += d * d; }
#pragma unroll
        for (int o = 32; o > 0; o >>= 1) q += __shfl_xor(q, o);
        const float rs = rsqrtf(q * (1.f / 1024.f) + 1e-5f);
        float y[16];
#pragma unroll
        for (int i = 0; i < 16; ++i) y[i] = (v[i] - mu) * rs * gg[i] + bb[i];
        u32x4 w0, w1; w0.x = pk2(y[0], y[1]); w0.y = pk2(y[2], y[3]); w0.z = pk2(y[4], y[5]); w0.w = pk2(y[6], y[7]);
        w1.x = pk2(y[8], y[9]); w1.y = pk2(y[10], y[11]); w1.z = pk2(y[12], y[13]); w1.w = pk2(y[14], y[15]);
        *(u32x4*)(H + (size_t)row * DM + lane * 8) = w0; *(u32x4*)(H + (size_t)row * DM + 512 + lane * 8) = w1;
        u32x2 q0, q1;
        q0.x = pk4(q8(y[0], Q_SA), q8(y[1], Q_SA), q8(y[2], Q_SA), q8(y[3], Q_SA)); q0.y = pk4(q8(y[4], Q_SA), q8(y[5], Q_SA), q8(y[6], Q_SA), q8(y[7], Q_SA));
        q1.x = pk4(q8(y[8], Q_SA), q8(y[9], Q_SA), q8(y[10], Q_SA), q8(y[11], Q_SA)); q1.y = pk4(q8(y[12], Q_SA), q8(y[13], Q_SA), q8(y[14], Q_SA), q8(y[15], Q_SA));
        *(u32x2*)(HQ + (size_t)row * DM + lane * 8) = q0; *(u32x2*)(HQ + (size_t)row * DM + 512 + lane * 8) = q1;
    }
}

template <bool FINAL>
__device__ __forceinline__ void phase_combine(const unsigned char* __restrict__ Y, const int* __restrict__ posy, const float* __restrict__ tokw, const int* __restrict__ ntiles,
                                              const bf16_t* __restrict__ H1, bf16_t* __restrict__ H2, unsigned char* __restrict__ H2Q, float* __restrict__ OUT, float* __restrict__ GATES,
                                              const float* __restrict__ wgate, const float* __restrict__ g, const float* __restrict__ b, int bid, int nb) {
    const int shbase = (*ntiles - NTOK / 256) * 256;
    const int lane = threadIdx.x & 63, gw = bid * 8 + (threadIdx.x >> 6), nw = nb * 8;
    int npos = 0; float nwk = 0.f;
    if (gw < NTOK) { npos = (lane < 8) ? posy[(size_t)gw * 8 + lane] : shbase + gw; nwk = (lane < 8) ? tokw[(size_t)gw * 8 + lane] : 1.0f; }
    for (int row = gw; row < NTOK; row += nw) {
        const int cpos = npos; const float cwk = nwk;
        { const int nr = row + nw; if (nr < NTOK) { npos = (lane < 8) ? posy[(size_t)nr * 8 + lane] : shbase + nr; nwk = (lane < 8) ? tokw[(size_t)nr * 8 + lane] : 1.0f; } }
        float v[16];
        { const u32x4 a = *(const u32x4*)(H1 + (size_t)row * DM + lane * 8), c = *(const u32x4*)(H1 + (size_t)row * DM + 512 + lane * 8);
          v[0] = bflo(a.x); v[1] = bfhi(a.x); v[2] = bflo(a.y); v[3] = bfhi(a.y); v[4] = bflo(a.z); v[5] = bfhi(a.z); v[6] = bflo(a.w); v[7] = bfhi(a.w);
          v[8] = bflo(c.x); v[9] = bfhi(c.x); v[10] = bflo(c.y); v[11] = bfhi(c.y); v[12] = bflo(c.z); v[13] = bfhi(c.z); v[14] = bflo(c.w); v[15] = bfhi(c.w); }
#pragma unroll
        for (int i = 0; i < 16; ++i) v[i] *= ALPHA;
        u32x2 ya[NSLOT], yc[NSLOT]; float wks[NSLOT];
#pragma unroll
        for (int k = 0; k < NSLOT; ++k) {
            const int pos = __builtin_amdgcn_readlane(cpos, k); wks[k] = __uint_as_float(__builtin_amdgcn_readlane(__float_as_uint(cwk), k)) * 0.0625f;
            const unsigned char* yr = Y + (size_t)pos * DM;
            ya[k] = *(const u32x2*)(yr + lane * 8); yc[k] = *(const u32x2*)(yr + 512 + lane * 8);
        }
        typedef float f32x2_ __attribute__((ext_vector_type(2)));
#pragma unroll
        for (int k = 0; k < NSLOT; ++k) {
            const float wk = wks[k];
            const f32x2_ a0 = __builtin_amdgcn_cvt_pk_f32_fp8((int)ya[k].x, false), a1 = __builtin_amdgcn_cvt_pk_f32_fp8((int)ya[k].x, true), a2 = __builtin_amdgcn_cvt_pk_f32_fp8((int)ya[k].y, false), a3 = __builtin_amdgcn_cvt_pk_f32_fp8((int)ya[k].y, true);
            const f32x2_ c0 = __builtin_amdgcn_cvt_pk_f32_fp8((int)yc[k].x, false), c1 = __builtin_amdgcn_cvt_pk_f32_fp8((int)yc[k].x, true), c2 = __builtin_amdgcn_cvt_pk_f32_fp8((int)yc[k].y, false), c3 = __builtin_amdgcn_cvt_pk_f32_fp8((int)yc[k].y, true);
            v[0] += wk * a0.x; v[1] += wk * a0.y; v[2] += wk * a1.x; v[3] += wk * a1.y; v[4] += wk * a2.x; v[5] += wk * a2.y; v[6] += wk * a3.x; v[7] += wk * a3.y;
            v[8] += wk * c0.x; v[9] += wk * c0.y; v[10] += wk * c1.x; v[11] += wk * c1.y; v[12] += wk * c2.x; v[13] += wk * c2.y; v[14] += wk * c3.x; v[15] += wk * c3.y;
        }
        float s = 0.f;
#pragma unroll
        for (int i = 0; i < 16; ++i) s += v[i];
#pragma unroll
        for (int o = 32; o > 0; o >>= 1) s += __shfl_xor(s, o);
        const float mu = s * (1.f / 1024.f);
        float q = 0.f;
#pragma unroll
        for (int i = 0; i < 16; ++i) { const float d = v[i] - mu; q += d * d; }
#pragma unroll
        for (int o = 32; o > 0; o >>= 1) q += __shfl_xor(q, o);
        const float rs = rsqrtf(q * (1.f / 1024.f) + 1e-5f);
        float y[16];
#pragma unroll
        for (int i = 0; i < 8; ++i) { y[i] = (v[i] - mu) * rs * g[lane * 8 + i] + b[lane * 8 + i]; y[8 + i] = (v[8 + i] - mu) * rs * g[512 + lane * 8 + i] + b[512 + lane * 8 + i]; }
        if (FINAL) {
            float* o = OUT + (size_t)row * DM;
            *(f32x4*)(o + lane * 8) = (f32x4){y[0], y[1], y[2], y[3]}; *(f32x4*)(o + lane * 8 + 4) = (f32x4){y[4], y[5], y[6], y[7]};
            *(f32x4*)(o + 512 + lane * 8) = (f32x4){y[8], y[9], y[10], y[11]}; *(f32x4*)(o + 512 + lane * 8 + 4) = (f32x4){y[12], y[13], y[14], y[15]};
        } else {
            u32x4 w0, w1; w0.x = pk2(y[0], y[1]); w0.y = pk2(y[2], y[3]); w0.z = pk2(y[4], y[5]); w0.w = pk2(y[6], y[7]);
            w1.x = pk2(y[8], y[9]); w1.y = pk2(y[10], y[11]); w1.z = pk2(y[12], y[13]); w1.w = pk2(y[14], y[15]);
            *(u32x4*)(H2 + (size_t)row * DM + lane * 8) = w0; *(u32x4*)(H2 + (size_t)row * DM + 512 + lane * 8) = w1;
            { u32x2 q0, q1;
              q0.x = pk4(q8(y[0], Q_SA), q8(y[1], Q_SA), q8(y[2], Q_SA), q8(y[3], Q_SA)); q0.y = pk4(q8(y[4], Q_SA), q8(y[5], Q_SA), q8(y[6], Q_SA), q8(y[7], Q_SA));
              q1.x = pk4(q8(y[8], Q_SA), q8(y[9], Q_SA), q8(y[10], Q_SA), q8(y[11], Q_SA)); q1.y = pk4(q8(y[12], Q_SA), q8(y[13], Q_SA), q8(y[14], Q_SA), q8(y[15], Q_SA));
              *(u32x2*)(H2Q + (size_t)row * DM + lane * 8) = q0; *(u32x2*)(H2Q + (size_t)row * DM + 512 + lane * 8) = q1; }
            float yr[16];
            yr[0] = bflo(w0.x); yr[1] = bfhi(w0.x); yr[2] = bflo(w0.y); yr[3] = bfhi(w0.y); yr[4] = bflo(w0.z); yr[5] = bfhi(w0.z); yr[6] = bflo(w0.w); yr[7] = bfhi(w0.w);
            yr[8] = bflo(w1.x); yr[9] = bfhi(w1.x); yr[10] = bflo(w1.y); yr[11] = bfhi(w1.y); yr[12] = bflo(w1.z); yr[13] = bfhi(w1.z); yr[14] = bflo(w1.w); yr[15] = bfhi(w1.w);
            float gsum = 0.f;
#pragma unroll
            for (int gi = 0; gi < 8; ++gi) {
                const float* wp = wgate + gi * 1024; float d = 0.f;
#pragma unroll
                for (int i = 0; i < 8; ++i) d += yr[i] * wp[lane * 8 + i] + yr[8 + i] * wp[512 + lane * 8 + i];
#pragma unroll
                for (int o = 32; o > 0; o >>= 1) d += __shfl_xor(d, o);
                gsum = (lane == gi) ? d : gsum;
            }
            if (lane < 8) GATES[(size_t)row * 8 + lane] = gsum;
        }
    }
}

#ifndef VARSEL
#define VARSEL 0
#endif
template <bool DRY>
__device__ __forceinline__ void phase_select(LAS unsigned char* lds, const float* __restrict__ logits, const float* __restrict__ rbias, int* __restrict__ tok_e, int* __restrict__ tok_p,
                                             float* __restrict__ tok_w, unsigned* __restrict__ cnt, int bid, int nb) {
    const int tid = threadIdx.x, it = tid & 63, g8 = tid >> 6;
    LAS unsigned* hist = (LAS unsigned*)lds;
    LAS unsigned* base = hist + 256;
    LAS int* selE = (LAS int*)(base + 256);
    LAS int* selR = selE + 1024;
    LAS float* gsl = (LAS float*)(lds + 10240);
    LAS float* lv = (LAS float*)(lds + 12288);
    LAS int* le = (LAS int*)(lds + 28672);
    LAS float* sb = (LAS float*)(lds + 45056);
    const int tpw = NTOK / nb;
    const int t0 = bid * tpw;
    const float NEG = -3.0e38f;
    if (tid < 256) hist[tid] = 0u;
    __syncthreads();
    for (int half = 0; half < tpw / 64; ++half) {
        const int tb = t0 + half * 64;
        {
            const int e = tid & 255, tk0 = tid >> 8; const float rb = rbias[e];
#pragma unroll
            for (int i0 = 0; i0 < 32; i0 += 8) { float lv8[8];
#pragma unroll
                for (int u = 0; u < 8; ++u) lv8[u] = logits[(size_t)(tb + tk0 + 2 * (i0 + u)) * 256 + e];
#pragma unroll
                for (int u = 0; u < 8; ++u) sb[e * 65 + tk0 + 2 * (i0 + u)] = sigm(lv8[u]) + rb; }
        }
        __syncthreads();
        {
            float m1 = NEG, m2 = NEG;
            for (int j = 0; j < 32; ++j) { const float v = sb[(g8 * 32 + j) * 65 + it]; if (v > m1) { m2 = m1; m1 = v; } else if (v > m2) m2 = v; }
            gsl[g8 * 64 + it] = m1 + m2;
        }
        __syncthreads();
        if (DRY && VARSEL == 1) { __syncthreads(); continue; }
        float G[8];
#pragma unroll
        for (int q = 0; q < 8; ++q) G[q] = gsl[q * 64 + it];
        unsigned selmask = 0u;
#pragma unroll
        for (int g = 0; g < 8; ++g) { int rank = 0;
#pragma unroll
            for (int q = 0; q < 8; ++q) rank += (G[q] > G[g] || (G[q] == G[g] && q < g)) ? 1 : 0;
            if (rank < 4) selmask |= 1u << g; }
        if ((selmask >> g8) & 1u) {
            float vv[32];
#pragma unroll
            for (int j = 0; j < 32; ++j) vv[j] = sb[(g8 * 32 + j) * 65 + it];
#pragma unroll
            for (int k = 0; k < 8; ++k) {
                float bv = vv[0]; int bj = 0;
#pragma unroll
                for (int j = 1; j < 32; ++j) { const bool gt = vv[j] > bv; bv = gt ? vv[j] : bv; bj = gt ? j : bj; }
#pragma unroll
                for (int j = 0; j < 32; ++j) vv[j] = (j == bj) ? NEG : vv[j];
                lv[(g8 * 8 + k) * 64 + it] = bv; le[(g8 * 8 + k) * 64 + it] = g8 * 32 + bj;
            }
        }
        __syncthreads();
        if (DRY && VARSEL == 2) { __syncthreads(); continue; }
        if (tid < 64) {
            int gid[4]; { int n = 0;
#pragma unroll
                for (int g = 0; g < 8; ++g) if ((selmask >> g) & 1u) { if (n == 0) gid[0] = g; else if (n == 1) gid[1] = g; else if (n == 2) gid[2] = g; else gid[3] = g; ++n; } }
            float hv[4]; int hp[4];
#pragma unroll
            for (int j = 0; j < 4; ++j) { hp[j] = 0; hv[j] = lv[(gid[j] * 8) * 64 + it]; }
            float sc8[8]; int te[8]; float tot = 0.f;
#pragma unroll
            for (int k = 0; k < 8; ++k) {
                int bj = 0; float bv = hv[0];
                if (hv[1] > bv) { bv = hv[1]; bj = 1; }
                if (hv[2] > bv) { bv = hv[2]; bj = 2; }
                if (hv[3] > bv) { bv = hv[3]; bj = 3; }
                const int gsel = (bj == 0) ? gid[0] : (bj == 1) ? gid[1] : (bj == 2) ? gid[2] : gid[3];
                const int psel = (bj == 0) ? hp[0] : (bj == 1) ? hp[1] : (bj == 2) ? hp[2] : hp[3];
                const int e = le[(gsel * 8 + psel) * 64 + it];
                te[k] = e; sc8[k] = bv - rbias[e]; tot += sc8[k];
                const float nv = (psel < 7) ? lv[(gsel * 8 + psel + 1) * 64 + it] : NEG;
                if (bj == 0) { hv[0] = nv; hp[0] = psel + 1; } else if (bj == 1) { hv[1] = nv; hp[1] = psel + 1; } else if (bj == 2) { hv[2] = nv; hp[2] = psel + 1; } else { hv[3] = nv; hp[3] = psel + 1; }
            }
            const float inv = 2.5f / tot;
            const int tok = tb + it, lt = half * 64 + it;
#pragma unroll
            for (int k = 0; k < 8; ++k) {
                tok_e[(size_t)tok * 8 + k] = te[k]; tok_w[(size_t)tok * 8 + k] = sc8[k] * inv;
                const unsigned r = atomicAdd((unsigned*)&hist[te[k]], 1u);
                selE[lt * 8 + k] = te[k]; selR[lt * 8 + k] = (int)r;
            }
        }
        __syncthreads();
    }
    if (DRY) return;
    if (tid < 256) { const unsigned c = hist[tid]; base[tid] = c ? __hip_atomic_fetch_add(cnt + tid, c, __ATOMIC_RELAXED, __HIP_MEMORY_SCOPE_AGENT) : 0u; }
    __syncthreads();
    for (int i = tid; i < tpw * 8; i += 512) tok_p[(size_t)t0 * 8 + i] = (int)base[selE[i]] + selR[i];
    __syncthreads();
}

__device__ __forceinline__ void phase_dispatch(LAS unsigned char* lds, const unsigned* __restrict__ cnt, const int* __restrict__ tok_e, const int* __restrict__ tok_p,
                                               int* __restrict__ s_tok, int* __restrict__ posy, int* __restrict__ tile_exp, int* __restrict__ ntiles, int bid, int nb) {
    const int tid = threadIdx.x;
    LAS int* tstart = (LAS int*)lds;
    LAS int* tcnt = tstart + 260;
    if (tid < 256) tcnt[tid] = (int)((__hip_atomic_load(cnt + tid, __ATOMIC_RELAXED, __HIP_MEMORY_SCOPE_AGENT) + 255u) >> 8);
    __syncthreads();
    if (tid < 256) { int a = 0;
#pragma unroll 16
        for (int j = 0; j < 256; ++j) { const int c = tcnt[j]; a += (j < tid) ? c : 0; }
        tstart[tid] = a; if (tid == 255) tstart[256] = a + tcnt[255]; }
    __syncthreads();
    const int TT = tstart[256];
    const int tpw = NTOK / nb, t0 = bid * tpw;
    for (int i = tid; i < tpw * 8; i += 512) {
        const size_t a = (size_t)t0 * 8 + i; const int e = tok_e[a], p = tok_p[a];
        const int pos = tstart[e] * 256 + p;
        s_tok[pos] = (int)(a >> 3); posy[a] = pos;
    }
    for (int i = tid; i < tpw; i += 512) { const int tok = t0 + i; s_tok[TT * 256 + tok] = tok; }
    for (int e = bid; e < 256; e += nb) {
        const int c = (int)__hip_atomic_load(cnt + e, __ATOMIC_RELAXED, __HIP_MEMORY_SCOPE_AGENT), ts = tstart[e], tc = tcnt[e];
        for (int i = c + tid; i < tc * 256; i += 512) s_tok[ts * 256 + i] = 0;
        for (int i = tid; i < tc; i += 512) tile_exp[ts + i] = e;
    }
    if (bid == 0) { for (int i = tid; i < NTOK / 256; i += 512) tile_exp[TT + i] = 256; if (tid == 0) *ntiles = TT + NTOK / 256; }
    __syncthreads();
}

constexpr int MX_QT = 0, MX_KT = 17408, MX_KHT = 34816, MX_VT = 53248, MX_P = 73984, MX_ST = 83200, MX_SEG = 122368, MX_GD = 126464, MX_ER = 126976, MX_RS = 127488, MX_DEN = 128000, MX_BC = 128256, MX_IP = 128512, MX_GT = 128768;
struct MixP {
    const bf16_t* proj; int ldp; int pad0; bf16_t* ymix; const float* gates;
    const float* lb0; const float* bgk; const float* hg; const float* gg; const float* conv; const float* bif;
    float* ust; float* gsum;
};
#define MFMA16(a, b, c) __builtin_amdgcn_mfma_f32_16x16x32_bf16((a), (b), (c), 0, 0, 0)

template <int MODE, bool FULL, int VAR = 0>
__device__ __forceinline__ void mixer_run(LAS unsigned char* lds, const MixP& mp, int bid) {
    constexpr int DK = (MODE == 1) ? 64 : 128, QP = DK + 8, CP = DK / 2, RG = 512 / CP, RPT = 64 / RG, KS = DK / 32;
    constexpr int NVT = (MODE == 2) ? 9 : 8;
    constexpr int NST = (DK == 128) ? NVT : 4;
    const int tid = threadIdx.x, lane = tid & 63, w = __builtin_amdgcn_readfirstlane(tid >> 6), l15 = lane & 15, l4 = lane >> 4;
    int b, h, vh = 0, seg;
    if (MODE == 0) { const int sq = bid >> 4; b = sq >> 2; h = sq & 3; seg = bid & 15; }
    else if (MODE == 1) { const int sq = (bid - 128) >> 4; b = sq >> 2; h = sq & 3; seg = bid & 15; }
    else { const int sq = bid >> 4; b = sq >> 3; h = (sq >> 1) & 3; vh = sq & 1; seg = bid & 15; }
    const int tok0 = b * SEQ + seg * 1024;
    const int ldp = mp.ldp; const bf16_t* proj = mp.proj;
    int cq, ck, cv, cg, cy;
    if (MODE == 0) { cq = h * 128; ck = 512 + h * 128; cv = 1024 + h * 128; cg = 1536 + h * 128; cy = h * 128; }
    else if (MODE == 1) { cq = 2048 + h * 64; ck = 2304 + h * 64; cv = 2560 + h * 128; cg = 3072 + h * 128; cy = 512 + h * 128; }
    else { cq = h * 128; ck = 512 + h * 128; cv = 1024 + h * 256 + vh * 128; cg = 2048 + h * 256 + vh * 128; cy = h * 256 + vh * 128; }
    const int cu = 3584 + h * 64;
    const int cp = tid % CP, rg = tid / CP, d0 = 2 * cp;
    float lbv[2] = {0.f, 0.f}, oml[2] = {0.f, 0.f}, bgk[2] = {0.f, 0.f}, cwq[4][2], cwk[4][2];
    if (MODE == 0) { lbv[0] = mp.lb0[h * 128 + d0]; lbv[1] = mp.lb0[h * 128 + d0 + 1]; oml[0] = 1.f - lbv[0]; oml[1] = 1.f - lbv[1]; }
    if (MODE == 1) { bgk[0] = mp.bgk[h * 64 + d0]; bgk[1] = mp.bgk[h * 64 + d0 + 1]; }
#pragma unroll
    for (int j = 0; j < 4; ++j) { cwq[j][0] = cwq[j][1] = cwk[j][0] = cwk[j][1] = 0.f; }
    if (MODE == 2) {
#pragma unroll
        for (int j = 0; j < 4; ++j) { cwq[j][0] = mp.conv[j * 1024 + cq + d0]; cwq[j][1] = mp.conv[j * 1024 + cq + d0 + 1]; cwk[j][0] = mp.conv[j * 1024 + ck + d0]; cwk[j][1] = mp.conv[j * 1024 + ck + d0 + 1]; }
    }
    const float bi = (MODE == 2) ? mp.bif[h] : 0.f, bfg = (MODE == 2) ? mp.bif[4 + h] : 0.f;
    const int sdt = (DK == 128) ? w : (w & 3), svt0 = (DK == 128) ? 0 : 4 * (w >> 2);
    f32x4 S[NST];
#pragma unroll
    for (int t = 0; t < NST; ++t) S[t] = (f32x4){0.f, 0.f, 0.f, 0.f};
    float gacc[2] = {(MODE == 2) ? 0.f : 1.f, (MODE == 2) ? 0.f : 1.f};
    if (MODE == 2) {
        for (int i = tid; i < 16 * 72; i += 512) { const int r = i / 72; *(LAS bf16_t*)(lds + MX_VT + ((128 + r) * 72 + (i % 72)) * 2) = (r == 0) ? (bf16_t)0x3F80 : (bf16_t)0; }
    }
    if (FULL) {
        const int bid0 = bid & ~15;
#pragma unroll 2
        for (int j = 0; j < seg; ++j) {
            const float* U = mp.ust + ((size_t)(bid0 + j) * 8 + w) * (9 * 4 * 64);
            float dec[4];
            if (MODE == 2) { const float gsv = mp.gsum[(size_t)(bid0 + j) * 128]; dec[0] = dec[1] = dec[2] = dec[3] = __expf(gsv); }
            else {
#pragma unroll
                for (int r = 0; r < 4; ++r) dec[r] = mp.gsum[(size_t)(bid0 + j) * 128 + sdt * 16 + 4 * l4 + r];
            }
            f32x4 uu[NST];
#pragma unroll
            for (int t = 0; t < NST; ++t)
#pragma unroll
                for (int r = 0; r < 4; ++r) uu[t][r] = U[(t * 4 + r) * 64 + lane];
#pragma unroll
            for (int t = 0; t < NST; ++t)
#pragma unroll
                for (int r = 0; r < 4; ++r) S[t][r] = dec[r] * S[t][r] + uu[t][r];
        }
    }
    const int sj = w & 3, ovh = w >> 2, srow = 16 * sj + l15;
    const int vp = tid & 63, r0v = (tid >> 6) * 8;
    unsigned ra[RPT + 3], rb[RPT + 3], rc[RPT], pv[8]; u32x2 gnx[4]; float sgi = 0.f, sgf = 0.f;
#pragma unroll
    for (int i = 0; i < RPT + 3; ++i) { ra[i] = 0u; rb[i] = 0u; }
#pragma unroll
    for (int i = 0; i < RPT; ++i) rc[i] = 0u;
#pragma unroll
    for (int t = 0; t < 4; ++t) gnx[t] = (u32x2){0u, 0u};
#define MX_LOAD(cn) do { const int tokn_ = tok0 + (cn) * 64; \
        if (VAR == 1 || VAR == 3 || VAR == 4) { _Pragma("unroll") for (int i = 0; i < RPT + 3; ++i) { ra[i] = 0x3c003c00u + (unsigned)(cn); rb[i] = 0x3c003c00u; } _Pragma("unroll") for (int i = 0; i < RPT; ++i) rc[i] = 0x3c003c00u; _Pragma("unroll") for (int i = 0; i < 8; ++i) pv[i] = 0x3c003c00u; _Pragma("unroll") for (int t = 0; t < 4; ++t) gnx[t] = (u32x2){0x3c003c00u, 0x3c003c00u}; sgi = 0.1f; sgf = 3.f; } else \
        if (MODE == 2) { const int tl0_ = seg * 1024 + (cn) * 64 + rg * RPT; \
            _Pragma("unroll") for (int i = 0; i < RPT + 3; ++i) { const int tl_ = tl0_ - 3 + i; \
                if (tl_ >= 0) { const bf16_t* pr_ = proj + (size_t)(b * SEQ + tl_) * ldp; if (FULL) ra[i] = *(const unsigned*)(pr_ + cq + d0); rb[i] = *(const unsigned*)(pr_ + ck + d0); } \
                else { ra[i] = 0u; rb[i] = 0u; } } \
            if (w == 0) { const float* gp_ = mp.gates + (size_t)(tokn_ + lane) * 8; sgi = gp_[h]; sgf = gp_[4 + h]; } \
        } else { \
            _Pragma("unroll") for (int i = 0; i < RPT; ++i) { const bf16_t* pr_ = proj + (size_t)(tokn_ + rg * RPT + i) * ldp; \
                if (MODE == 0) { ra[i] = *(const unsigned*)(pr_ + ck + d0); if (FULL) rb[i] = *(const unsigned*)(pr_ + cq + d0); } \
                else { ra[i] = *(const unsigned*)(pr_ + cu + d0); rb[i] = *(const unsigned*)(pr_ + ck + d0); if (FULL) rc[i] = *(const unsigned*)(pr_ + cq + d0); } } \
        } \
        _Pragma("unroll") for (int i = 0; i < 8; ++i) pv[i] = *(const unsigned*)(proj + (size_t)(tokn_ + r0v + i) * ldp + cv + 2 * vp); \
        if (FULL) { _Pragma("unroll") for (int t = 0; t < 4; ++t) gnx[t] = *(const u32x2*)(proj + (size_t)(tokn_ + srow) * ldp + cg + 16 * (4 * ovh + t) + 4 * l4); } \
    } while (0)
    float gnv[4][4];
#pragma unroll
    for (int t = 0; t < 4; ++t)
#pragma unroll
        for (int r = 0; r < 4; ++r) gnv[t][r] = (FULL && MODE != 2) ? ((MODE == 0) ? mp.hg : mp.gg)[h * 128 + 16 * (4 * ovh + t) + 4 * l4 + r] : 1.f;
    MX_LOAD(0);
    __syncthreads();
    for (int c = 0; c < 16; ++c) {
        const int tokc = tok0 + c * 64;
        float la[RPT][2], sp[RPT][2], qv[RPT][2], kv[RPT][2];
        u32x2 gcur[4];
        if (VAR == 4) {
#pragma unroll
            for (int t = 0; t < 4; ++t) gcur[t] = gnx[t];
            __syncthreads(); __syncthreads(); goto stepC; }
#pragma unroll
        for (int t = 0; t < 4; ++t) gcur[t] = gnx[t];
        if (MODE == 2) {
            if (w == 0) {
                const float ip = sgi + bi, lf = logsig(sgf + bfg);
                float cs = lf;
#pragma unroll
                for (int o = 1; o < 64; o <<= 1) { const float t = __shfl_up(cs, o); if (lane >= o) cs += t; }
                *(LAS float*)(lds + MX_BC + lane * 4) = cs; *(LAS float*)(lds + MX_IP + lane * 4) = ip - cs;
                if (lane == 63) *(LAS float*)(lds + MX_GT) = cs;
            }
#pragma unroll
            for (int i = 0; i < RPT; ++i)
#pragma unroll
                for (int e = 0; e < 2; ++e) {
                    float aq = 0.f, ak = 0.f;
#pragma unroll
                    for (int j = 0; j < 4; ++j) { aq += cwq[j][e] * (e ? bfhi(ra[i + j]) : bflo(ra[i + j])); ak += cwk[j][e] * (e ? bfhi(rb[i + j]) : bflo(rb[i + j])); }
                    qv[i][e] = silu(aq); kv[i][e] = silu(ak) * 0.08838834764831845f; la[i][e] = 0.f; sp[i][e] = 0.f;
                }
        } else {
#pragma unroll
            for (int i = 0; i < RPT; ++i) {
                if (MODE == 0) {
                    const unsigned uz = ra[i];
                    const float s0 = sigm(bflo(uz)), s1 = sigm(bfhi(uz));
                    la[i][0] = lbv[0] + oml[0] * s0; la[i][1] = lbv[1] + oml[1] * s1;
                    kv[i][0] = oml[0] - oml[0] * s0; kv[i][1] = oml[1] - oml[1] * s1;
                    if (FULL) { const unsigned uq = rb[i]; qv[i][0] = silu(bflo(uq)); qv[i][1] = silu(bfhi(uq)); } else { qv[i][0] = qv[i][1] = 0.f; }
                } else {
                    const unsigned uu = ra[i], uk = rb[i];
                    la[i][0] = __expf(logsig(bflo(uu) + bgk[0]) * 0.0625f); la[i][1] = __expf(logsig(bfhi(uu) + bgk[1]) * 0.0625f);
                    kv[i][0] = bflo(uk); kv[i][1] = bfhi(uk);
                    if (FULL) { const unsigned uq = rc[i]; qv[i][0] = bflo(uq) * 0.125f; qv[i][1] = bfhi(uq) * 0.125f; } else { qv[i][0] = qv[i][1] = 0.f; }
                }
            }
#pragma unroll
            for (int e = 0; e < 2; ++e) {
                float run = 1.f;
#pragma unroll
                for (int i = RPT - 1; i >= 0; --i) { sp[i][e] = run; run *= la[i][e]; }
                run = 1.f;
#pragma unroll
                for (int i = 0; i < RPT; ++i) { run *= la[i][e]; la[i][e] = run; }
            }
            *(LAS float*)(lds + MX_SEG + (rg * DK + d0) * 4) = la[RPT - 1][0]; *(LAS float*)(lds + MX_SEG + (rg * DK + d0 + 1) * 4) = la[RPT - 1][1];
        }
        {
            u32x4 lo, hi;
            lo.x = (pv[0] & 0xffffu) | (pv[1] << 16); lo.y = (pv[2] & 0xffffu) | (pv[3] << 16); lo.z = (pv[4] & 0xffffu) | (pv[5] << 16); lo.w = (pv[6] & 0xffffu) | (pv[7] << 16);
            hi.x = (pv[0] >> 16) | (pv[1] & 0xffff0000u); hi.y = (pv[2] >> 16) | (pv[3] & 0xffff0000u); hi.z = (pv[4] >> 16) | (pv[5] & 0xffff0000u); hi.w = (pv[6] >> 16) | (pv[7] & 0xffff0000u);
            *(LAS u32x4*)(lds + MX_VT + ((2 * vp) * 72 + r0v) * 2) = lo; *(LAS u32x4*)(lds + MX_VT + ((2 * vp + 1) * 72 + r0v) * 2) = hi;
        }
        if (c + 1 < 16) MX_LOAD(c + 1);
        if (VAR == 2) { unsigned xa = 0; _Pragma("unroll") for (int i = 0; i < RPT + 3; ++i) xa ^= ra[i] ^ rb[i]; _Pragma("unroll") for (int i = 0; i < RPT; ++i) xa ^= rc[i]; _Pragma("unroll") for (int i = 0; i < 8; ++i) xa ^= pv[i];
            _Pragma("unroll") for (int t = 0; t < 4; ++t) xa ^= gnx[t].x ^ gnx[t].y; gacc[0] += (float)(xa & 1u) + sgi + sgf; continue; }
        __syncthreads();
        {
            float pre[2], h2[2], gt[2];
            if (MODE == 2) {
                const float g = *(LAS float*)(lds + MX_GT);
                gt[0] = gt[1] = g; h2[0] = h2[1] = 0.f; pre[0] = pre[1] = 0.f;
                if (tid == 0) gacc[0] += g;
            } else {
#pragma unroll
                for (int e = 0; e < 2; ++e) { float p = 1.f, a1 = 1.f, a2 = 1.f;
#pragma unroll
                    for (int j = 0; j < RG; ++j) { const float v = *(LAS float*)(lds + MX_SEG + (j * DK + d0 + e) * 4);
                        if (j < RG / 2) a1 *= v; else a2 *= v;
                        const bool inb = (rg >= RG / 2) ? (j >= RG / 2 && j < rg) : (j > rg && j < RG / 2);
                        p *= inb ? v : 1.f; }
                    pre[e] = p; h2[e] = a2; gt[e] = a1 * a2;
                    if (rg == 0) { gacc[e] *= gt[e]; *(LAS float*)(lds + MX_GD + (d0 + e) * 4) = gt[e]; *(LAS float*)(lds + MX_ER + (d0 + e) * 4) = a1; } }
            }
            float kh[RPT][2];
#pragma unroll
            for (int i = 0; i < RPT; ++i) {
                const int s = rg * RPT + i;
                float qs[2], ks[2];
                if (MODE == 2) {
                    const float bc = *(LAS float*)(lds + MX_BC + s * 4), ipb = *(LAS float*)(lds + MX_IP + s * 4);
                    const float eq = __expf(bc), ek = __expf(ipb), eg = __expf(gt[0]);
                    qs[0] = qv[i][0] * eq; qs[1] = qv[i][1] * eq; ks[0] = kv[i][0] * ek; ks[1] = kv[i][1] * ek; kh[i][0] = ks[0] * eg; kh[i][1] = ks[1] * eg;
                } else {
#pragma unroll
                    for (int e = 0; e < 2; ++e) {
                        const float cd = pre[e] * ((rg >= RG / 2) ? la[i][e] : sp[i][e]);
                        const float rc_ = __builtin_amdgcn_rcpf(cd);
                        const float qm = (rg >= RG / 2) ? cd : rc_, km = (rg >= RG / 2) ? rc_ : cd;
                        qs[e] = qv[i][e] * qm; ks[e] = kv[i][e] * km; kh[i][e] = ks[e] * h2[e]; }
                }
                if (FULL) { *(LAS unsigned*)(lds + MX_QT + (s * QP + d0) * 2) = pk2(qs[0], qs[1]); *(LAS unsigned*)(lds + MX_KT + (s * QP + d0) * 2) = pk2(ks[0], ks[1]); }
            }
            if (RPT == 8) {
                u32x4 a, bq;
                a.x = pk2(kh[0][0], kh[1][0]); a.y = pk2(kh[2][0], kh[3][0]); a.z = pk2(kh[4 % RPT][0], kh[5 % RPT][0]); a.w = pk2(kh[6 % RPT][0], kh[7 % RPT][0]);
                bq.x = pk2(kh[0][1], kh[1][1]); bq.y = pk2(kh[2][1], kh[3][1]); bq.z = pk2(kh[4 % RPT][1], kh[5 % RPT][1]); bq.w = pk2(kh[6 % RPT][1], kh[7 % RPT][1]);
                *(LAS u32x4*)(lds + MX_KHT + (d0 * 72 + rg * 8) * 2) = a; *(LAS u32x4*)(lds + MX_KHT + ((d0 + 1) * 72 + rg * 8) * 2) = bq;
            } else {
                u32x2 a, bq;
                a.x = pk2(kh[0][0], kh[1][0]); a.y = pk2(kh[2][0], kh[3][0]); bq.x = pk2(kh[0][1], kh[1][1]); bq.y = pk2(kh[2][1], kh[3][1]);
                *(LAS u32x2*)(lds + MX_KHT + (d0 * 72 + rg * 4) * 2) = a; *(LAS u32x2*)(lds + MX_KHT + ((d0 + 1) * 72 + rg * 4) * 2) = bq;
            }
        }
        __syncthreads();
        stepC:
        if (FULL && VAR != 3) {
#pragma unroll
            for (int tt = 0; tt < 2; ++tt) {
                const int tile = 2 * w + tt, ti = tile >> 2, tj = tile & 3;
                f32x4 acc = (f32x4){0.f, 0.f, 0.f, 0.f};
                if (ti <= tj) {
#pragma unroll
                    for (int kk = 0; kk < KS; ++kk) {
                        const bf16x8 a = *(const LAS bf16x8*)(lds + MX_KT + ((16 * ti + l15) * QP + kk * 32 + 8 * l4) * 2);
                        const bf16x8 bq = *(const LAS bf16x8*)(lds + MX_QT + ((16 * tj + l15) * QP + kk * 32 + 8 * l4) * 2);
                        acc = MFMA16(a, bq, acc);
                    }
                }
                const int s = 16 * tj + l15, sp0 = 16 * ti + 4 * l4;
                float pvv[4];
#pragma unroll
                for (int r = 0; r < 4; ++r) pvv[r] = (sp0 + r <= s) ? acc[r] : 0.f;
                u32x2 pw; pw.x = pk2(pvv[0], pvv[1]); pw.y = pk2(pvv[2], pvv[3]);
                *(LAS u32x2*)(lds + MX_P + (s * 72 + sp0) * 2) = pw;
            }
            {
                float er[4];
#pragma unroll
                for (int r = 0; r < 4; ++r) er[r] = (MODE == 2) ? 1.f : *(LAS float*)(lds + MX_ER + (sdt * 16 + 4 * l4 + r) * 4);
#pragma unroll
                for (int t = 0; t < NST; ++t) {
                    const int v = 16 * (svt0 + t) + l15;
                    u32x2 sw; sw.x = pk2(S[t][0] * er[0], S[t][1] * er[1]); sw.y = pk2(S[t][2] * er[2], S[t][3] * er[3]);
                    *(LAS u32x2*)(lds + MX_ST + (v * QP + sdt * 16 + 4 * l4) * 2) = sw;
                }
            }
            {
                float dec[4];
                if (MODE == 2) { const float eg = __expf(*(LAS float*)(lds + MX_GT)); dec[0] = dec[1] = dec[2] = dec[3] = eg; }
                else {
    #pragma unroll
                    for (int r = 0; r < 4; ++r) dec[r] = *(LAS float*)(lds + MX_GD + (sdt * 16 + 4 * l4 + r) * 4);
                }
                bf16x8 ka[2];
    #pragma unroll
                for (int kk = 0; kk < 2; ++kk) ka[kk] = *(const LAS bf16x8*)(lds + MX_KHT + ((16 * sdt + l15) * 72 + kk * 32 + 8 * l4) * 2);
    #pragma unroll
                for (int t = 0; t < NST; ++t) {
    #pragma unroll
                    for (int r = 0; r < 4; ++r) S[t][r] *= dec[r];
    #pragma unroll
                    for (int kk = 0; kk < 2; ++kk) {
                        const bf16x8 vb = *(const LAS bf16x8*)(lds + MX_VT + ((16 * (svt0 + t) + l15) * 72 + kk * 32 + 8 * l4) * 2);
                        S[t] = MFMA16(ka[kk], vb, S[t]);
                    }
                }
            }
            __syncthreads();
            constexpr int NOT = (MODE == 2) ? 5 : 4;
            f32x4 O[NOT];
#pragma unroll
            for (int t = 0; t < NOT; ++t) O[t] = (f32x4){0.f, 0.f, 0.f, 0.f};
#pragma unroll
            for (int kk = 0; kk < 2; ++kk) {
                const bf16x8 bq = *(const LAS bf16x8*)(lds + MX_P + ((16 * sj + l15) * 72 + kk * 32 + 8 * l4) * 2);
#pragma unroll
                for (int t = 0; t < NOT; ++t) { const int vt = (t < 4) ? (4 * ovh + t) : 8;
                    if (t < 4 || ovh == 0) { const bf16x8 a = *(const LAS bf16x8*)(lds + MX_VT + ((16 * vt + l15) * 72 + kk * 32 + 8 * l4) * 2); O[t] = MFMA16(a, bq, O[t]); } }
            }
#pragma unroll
            for (int kk = 0; kk < KS; ++kk) {
                const bf16x8 bq = *(const LAS bf16x8*)(lds + MX_QT + ((16 * sj + l15) * QP + kk * 32 + 8 * l4) * 2);
#pragma unroll
                for (int t = 0; t < NOT; ++t) { const int vt = (t < 4) ? (4 * ovh + t) : 8;
                    if (t < 4 || ovh == 0) { const bf16x8 a = *(const LAS bf16x8*)(lds + MX_ST + ((16 * vt + l15) * QP + kk * 32 + 8 * l4) * 2); O[t] = MFMA16(a, bq, O[t]); } }
            }
            const int tokr = tokc + srow;
            float scale;
            if (MODE == 2) {
                if (ovh == 0 && l4 == 0) *(LAS float*)(lds + MX_DEN + srow * 4) = O[NOT - 1][0];
                __syncthreads();
                const float den = *(LAS float*)(lds + MX_DEN + srow * 4);
                scale = 1.f / fmaxf(fabsf(den), 1.f);
            } else {
                float ss = 0.f;
#pragma unroll
                for (int t = 0; t < 4; ++t)
#pragma unroll
                    for (int r = 0; r < 4; ++r) ss += O[t][r] * O[t][r];
                ss += __shfl_xor(ss, 16); ss += __shfl_xor(ss, 32);
                if (l4 == 0) *(LAS float*)(lds + MX_RS + (ovh * 64 + srow) * 4) = ss;
                __syncthreads();
                const float tot = *(LAS float*)(lds + MX_RS + srow * 4) + *(LAS float*)(lds + MX_RS + (64 + srow) * 4);
                scale = rsqrtf(tot * (1.f / 128.f) + 1e-6f);
            }
#pragma unroll
            for (int t = 0; t < 4; ++t) {
                const int v0 = 16 * (4 * ovh + t) + 4 * l4;
                const u32x2 gt = gcur[t];
                const float g0 = bflo(gt.x), g1 = bfhi(gt.x), g2 = bflo(gt.y), g3 = bfhi(gt.y);
                float y0, y1, y2, y3;
                if (MODE == 2) { y0 = O[t][0] * scale * sigm(g0); y1 = O[t][1] * scale * sigm(g1); y2 = O[t][2] * scale * sigm(g2); y3 = O[t][3] * scale * sigm(g3); }
                else { y0 = O[t][0] * scale * gnv[t][0] * silu(g0); y1 = O[t][1] * scale * gnv[t][1] * silu(g1); y2 = O[t][2] * scale * gnv[t][2] * silu(g2); y3 = O[t][3] * scale * gnv[t][3] * silu(g3); }
                u32x2 yw; yw.x = pk2(y0, y1); yw.y = pk2(y2, y3);
                *(u32x2*)(mp.ymix + (size_t)tokr * DM + cy + v0) = yw;
            }
        }
        if (!FULL || VAR == 3) {
            {
                float dec[4];
                if (MODE == 2) { const float eg = __expf(*(LAS float*)(lds + MX_GT)); dec[0] = dec[1] = dec[2] = dec[3] = eg; }
                else {
    #pragma unroll
                    for (int r = 0; r < 4; ++r) dec[r] = *(LAS float*)(lds + MX_GD + (sdt * 16 + 4 * l4 + r) * 4);
                }
                bf16x8 ka[2];
    #pragma unroll
                for (int kk = 0; kk < 2; ++kk) ka[kk] = *(const LAS bf16x8*)(lds + MX_KHT + ((16 * sdt + l15) * 72 + kk * 32 + 8 * l4) * 2);
    #pragma unroll
                for (int t = 0; t < NST; ++t) {
    #pragma unroll
                    for (int r = 0; r < 4; ++r) S[t][r] *= dec[r];
    #pragma unroll
                    for (int kk = 0; kk < 2; ++kk) {
                        const bf16x8 vb = *(const LAS bf16x8*)(lds + MX_VT + ((16 * (svt0 + t) + l15) * 72 + kk * 32 + 8 * l4) * 2);
                        S[t] = MFMA16(ka[kk], vb, S[t]);
                    }
                }
            }
        __syncthreads();
        }
    }
#undef MX_LOAD
    if (VAR == 2) { mp.ust[(size_t)bid * 512 + tid] = gacc[0]; return; }
    if (!FULL) {
        float* U = mp.ust + ((size_t)bid * 8 + w) * (9 * 4 * 64);
#pragma unroll
        for (int t = 0; t < NST; ++t)
#pragma unroll
            for (int r = 0; r < 4; ++r) U[(t * 4 + r) * 64 + lane] = S[t][r];
        if (MODE == 2) { if (tid == 0) mp.gsum[(size_t)bid * 128] = gacc[0]; }
        else if (rg == 0) { mp.gsum[(size_t)bid * 128 + d0] = gacc[0]; mp.gsum[(size_t)bid * 128 + d0 + 1] = gacc[1]; }
    }
}

#ifndef PHMASK
#define PHMASK 0xFFFFu
#endif
#ifndef MIXSEL
#define MIXSEL 7
#endif
#ifndef REPMASK
#define REPMASK 0x0u
#endif
#define EN(j) (((PHMASK) >> (j)) & 1u)
#ifndef REPLAYER
#define REPLAYER 3
#endif
#define NREP(j) (1 + (int)((((REPMASK) >> (j)) & 1u) & (((REPLAYER) >> layer) & 1u)))
#define IN(k) (lo <= (k) && (k) < hi)
#define SEAM(k) do { if (IN((k) + 1)) xcd_barrier(bar); } while (0)

template <int layer> __device__ __forceinline__ void ph_proj(LAS unsigned char* lds, unsigned char* ws, int bid, int nb) {
    pg8::Gemm g{(const bf16_t*)(ws + (layer ? WS_H2Q : WS_XQ)), (const bf16_t*)(ws + (layer ? WS_WC : WS_WAB)), DM / 2};
    pg8::StaticOrder S; S.init(NTOK, layer ? CWID : ABW, nb, bid);
    pg8::EpiStoreBf16<true> E{(bf16_t*)(ws + WS_PROJ), layer ? CWID : ABW};
    pg8::gemm_phase<pg8::EpiStoreBf16<true>, pg8::StaticOrder, false, true>(lds, g, nullptr, S, E);
}
template <int layer> __device__ __forceinline__ void ph_outproj(LAS unsigned char* lds, unsigned char* ws, int bid, int nb) {
    pg8::Gemm g{(const bf16_t*)(ws + WS_YMIX), (const bf16_t*)(ws + (layer ? WS_WOC : WS_WOAB)), DM};
    pg8::StaticOrder S; S.init(NTOK, DM, nb, bid);
    pg8::EpiResid E{(bf16_t*)(ws + WS_Z), (const bf16_t*)(ws + (layer ? WS_H2 : WS_HB))};
    pg8::gemm_phase<pg8::EpiResid, pg8::StaticOrder, false>(lds, g, nullptr, S, E);
}
template <int layer> __device__ __forceinline__ void ph_router(LAS unsigned char* lds, unsigned char* ws, int bid, int nb) {
    pg8::Gemm g{(const bf16_t*)(ws + WS_H1), (const bf16_t*)(ws + WS_WR) + (size_t)layer * 256 * 1024, DM};
    pg8::StaticOrder S; S.init(NTOK, 256, nb, bid);
    pg8::EpiF32 E{(float*)(ws + WS_LOGITS)};
    pg8::gemm_phase<pg8::EpiF32, pg8::StaticOrder, false>(lds, g, nullptr, S, E);
}
template <int layer> __device__ __forceinline__ void ph_gemm1(LAS unsigned char* lds, unsigned char* ws, int bid, int nb) {
    const int vcu = (nb % 8 == 0) ? (bid % 8) * (nb / 8) + bid / 8 : bid;
    const int nt = __builtin_amdgcn_readfirstlane(*(volatile int*)(ws + WS_MISC + 65536 + 8192));
    pg8::Gemm g{(const bf16_t*)(ws + WS_H1Q), (const bf16_t*)(ws + WS_W1T + (size_t)layer * NE1 * 512 * 1024), DM / 2};
    const int nu = pg8::moe_prep(lds, (const int*)(ws + WS_MISC + 65536), nt * 2, 1, nb, vcu, (const int*)(ws + WS_STOK));
    pg8::MoeOrder S{(const LAS int*)(lds + pg8::LDS_UT), nu < pg8::MOE_MAXU ? nu : pg8::MOE_MAXU};
    pg8::EpiSwiGLU<true> E{ws + WS_ACT, lds + 3 * pg8::HTB};
    pg8::gemm_phase<pg8::EpiSwiGLU<true>, pg8::MoeOrder, true, true>(lds, g, (const LAS int*)(lds + pg8::LDS_IDX), S, E);
}
template <int layer> __device__ __forceinline__ void ph_gemm2(LAS unsigned char* lds, unsigned char* ws, int bid, int nb) {
    const int vcu = (nb % 8 == 0) ? (bid % 8) * (nb / 8) + bid / 8 : bid;
    const int nt = __builtin_amdgcn_readfirstlane(*(volatile int*)(ws + WS_MISC + 65536 + 8192));
    int kq = 128; asm volatile("" : "+s"(kq));
    pg8::Gemm g{(const bf16_t*)(ws + WS_ACT), (const bf16_t*)(ws + WS_W2T + (size_t)layer * NE1 * 1024 * 256), kq};
    const int nu = pg8::moe_prep(lds, (const int*)(ws + WS_MISC + 65536), nt * 4, 2, nb, vcu, nullptr);
    pg8::MoeOrder S{(const LAS int*)(lds + pg8::LDS_UT), nu};
    pg8::EpiDown E{(unsigned char*)(ws + WS_Y), lds + 3 * pg8::HTB};
    pg8::gemm_phase<pg8::EpiDown, pg8::MoeOrder, false, true>(lds, g, nullptr, S, E);
#ifndef EXPG
#define EXPG 0
#endif
#if EXPG
    { __syncthreads(); pg8::EpiDownT<EXPG - 1> E2{(unsigned char*)(ws + WS_PROJ), lds + 3 * pg8::HTB};
      pg8::gemm_phase<pg8::EpiDownT<EXPG - 1>, pg8::MoeOrder, false, true>(lds, g, nullptr, S, E2); }
#endif
}
template <int layer, bool FULLP> __device__ __forceinline__ void ph_mixer(LAS unsigned char* lds, const Args& A, int bid, int nb) {
    unsigned char* ws = A.ws;
    if (nb != NWG) return;
    MixP mp{(const bf16_t*)(ws + WS_PROJ), layer ? CWID : ABW, 0, (bf16_t*)(ws + WS_YMIX), (const float*)(ws + WS_GATES), (const float*)(ws + WS_MISC), A.in[I_BGK], A.in[I_HG], A.in[I_GG], A.in[I_CONV], A.in[I_BIF], (float*)(ws + WS_UST), (float*)(ws + WS_GSUM)};
    if (layer == 0) { if (bid < 128) { if (MIXSEL & 1) mixer_run<0, FULLP>(lds, mp, bid); } else { if (MIXSEL & 2) mixer_run<1, FULLP>(lds, mp, bid); } }
    else { if (MIXSEL & 4) mixer_run<2, FULLP>(lds, mp, bid); }
#ifndef EXPV
#define EXPV 0
#endif
#ifndef EXPL
#define EXPL 0
#endif
#if EXPV
    if (FULLP && layer == EXPL) { MixP md = mp; md.ymix = (bf16_t*)(ws + WS_Z); md.ust = (float*)(ws + WS_LOGITS); md.gsum = (float*)(ws + WS_LOGITS + 24 * MiB);
        __syncthreads();
        if (layer == 0) { if (bid < 128) mixer_run<0, true, EXPV>(lds, md, bid); else mixer_run<1, true, EXPV>(lds, md, bid); }
        else mixer_run<2, true, EXPV>(lds, md, bid); }
#endif
}
#define REP2(j, call) do { call; if (NREP(j) == 2) { __syncthreads(); call; } } while (0)

template <int layer>
__device__ __forceinline__ void run_layer(LAS unsigned char* lds, const Args& A, const XcdBarrier& bar, const int lo, const int hi) {
    const int bid = blockIdx.x, nb = gridDim.x;
    unsigned char* ws = A.ws;
    unsigned* ctl = (unsigned*)(ws + WS_CTL);
    constexpr int P = 1 + layer * 11;
    if (EN(0) && IN(P + 0)) {
        if (bid & 1) convert_experts(lds, A, layer, bid, nb, layer);
        REP2(0, ph_proj<layer>(lds, ws, bid, nb));
        if (!(bid & 1)) convert_experts(lds, A, layer, bid, nb, layer);
        SEAM(P + 0); }
    if (EN(1) && IN(P + 1)) { REP2(1, (ph_mixer<layer, false>(lds, A, bid, nb))); SEAM(P + 1); }
    if (EN(2) && IN(P + 2)) { REP2(2, (ph_mixer<layer, true>(lds, A, bid, nb))); SEAM(P + 2); }
    if (EN(3) && IN(P + 3)) {
        if (layer == 0 && (bid & 1)) convert_experts(lds, A, 0, bid, nb, 1);
        REP2(3, ph_outproj<layer>(lds, ws, bid, nb));
        if (layer == 0 && !(bid & 1)) convert_experts(lds, A, 0, bid, nb, 1);
        SEAM(P + 3); }
    if (EN(4) && IN(P + 4)) { REP2(4, phase_ln((const bf16_t*)(ws + WS_Z), (bf16_t*)(ws + WS_H1), ws + WS_H1Q, A.in[I_LMG] + layer * DM, A.in[I_LMB] + layer * DM, bid, nb)); SEAM(P + 4); }
    if (EN(5) && IN(P + 5)) { REP2(5, ph_router<layer>(lds, ws, bid, nb)); SEAM(P + 5); }
    if (EN(6) && IN(P + 6)) {
        phase_select<false>(lds, (const float*)(ws + WS_LOGITS), A.in[I_RB] + layer * NEXP, (int*)(ws + WS_TOKE), (int*)(ws + WS_TOKP), (float*)(ws + WS_TOKW), ctl + CW_CNT + layer * 256, bid, nb);
        if (NREP(6) == 2) phase_select<true>(lds, (const float*)(ws + WS_LOGITS), A.in[I_RB] + layer * NEXP, (int*)(ws + WS_TOKE), (int*)(ws + WS_TOKP), (float*)(ws + WS_TOKW), ctl + CW_CNT + layer * 256, bid, nb);
        SEAM(P + 6); }
    if (EN(7) && IN(P + 7)) { REP2(7, phase_dispatch(lds, ctl + CW_CNT + layer * 256, (const int*)(ws + WS_TOKE), (const int*)(ws + WS_TOKP), (int*)(ws + WS_STOK), (int*)(ws + WS_POSY), (int*)(ws + WS_MISC + 65536), (int*)(ws + WS_MISC + 65536 + 8192), bid, nb)); SEAM(P + 7); }
    if (EN(8) && IN(P + 8)) {
        if (layer == 0 && (bid & 1)) convert_experts(lds, A, 1, bid, nb, 0);
        REP2(8, ph_gemm1<layer>(lds, ws, bid, nb));
        if (layer == 0 && !(bid & 1)) convert_experts(lds, A, 1, bid, nb, 0);
        SEAM(P + 8); }
    if (EN(9) && IN(P + 9)) { REP2(9, ph_gemm2<layer>(lds, ws, bid, nb)); SEAM(P + 9); }
    if (EN(10) && IN(P + 10)) {
        if (layer == 0) REP2(10, (phase_combine<false>((const unsigned char*)(ws + WS_Y), (const int*)(ws + WS_POSY), (const float*)(ws + WS_TOKW), (const int*)(ws + WS_MISC + 65536 + 8192), (const bf16_t*)(ws + WS_H1), (bf16_t*)(ws + WS_H2), ws + WS_H2Q, nullptr, (float*)(ws + WS_GATES), (const float*)(ws + WS_MISC + 4096), A.in[I_LFG], A.in[I_LFB], bid, nb)));
        else REP2(10, (phase_combine<true>((const unsigned char*)(ws + WS_Y), (const int*)(ws + WS_POSY), (const float*)(ws + WS_TOKW), (const int*)(ws + WS_MISC + 65536 + 8192), (const bf16_t*)(ws + WS_H1), nullptr, nullptr, A.out, nullptr, nullptr, A.in[I_LFG] + DM, A.in[I_LFB] + DM, bid, nb)));
        SEAM(P + 10);
    }
}

__global__ void __launch_bounds__(512, 2) fwd_kernel(Args A) {
    extern __shared__ __attribute__((aligned(16))) unsigned char lds_raw[];
    LAS unsigned char* lds = (LAS unsigned char*)lds_raw;
    const int tid = threadIdx.x;
    unsigned* ctl = (unsigned*)(A.ws + WS_CTL);
    volatile LAS unsigned* misc = (volatile LAS unsigned*)(lds + LDS_MISC);
    if (tid < 64) misc[tid] = 0u;
    __syncthreads();
    const int lo = A.ph_lo, hi = A.ph_hi;
    XcdBarrier bar; bar.bar = ctl + CW_BAR; bar.x = 0; bar.st = misc;
    if (hi - lo > 1) bar = xcd_barrier_post(ctl + CW_BAR, misc);
    if (EN(11) && IN(0)) { for (int rep_ = 0; rep_ < 1 + (int)(((REPMASK) >> 11) & 1u); ++rep_) phase_prologue(lds, A, blockIdx.x, gridDim.x); SEAM(0); }
    run_layer<0>(lds, A, bar, lo, hi);
    run_layer<1>(lds, A, bar, lo, hi);
}
#undef IN
#undef SEAM

#ifdef DBG
__device__ __forceinline__ unsigned hash32(unsigned x) { x ^= x >> 16; x *= 0x7feb352dU; x ^= x >> 15; x *= 0x846ca68bU; x ^= x >> 16; return x; }
__device__ __forceinline__ void dbg_acc(float* w, int stage, float num, float den) { if (!(num == num) || num > 1e30f) num = 1e30f; atomicAdd(w + 2 * stage, num); atomicAdd(w + 2 * stage + 1, den); }
__device__ __forceinline__ float bfr(float x) { return bflo(pk2(x, 0.f)); }
__global__ void dbg_weights(Args A, float* w) {
    const unsigned i = blockIdx.x * 256 + threadIdx.x; unsigned char* ws = A.ws;
    float num = 0.f, den = 0.f;
    { const unsigned hsh = hash32(i * 4 + 0), col = hsh % 3584, k = (hsh >> 12) % 1024; const float r = A.in[I_WINAB][(size_t)k * 3600 + col], g = bf2f(((const bf16_t*)(ws + WS_WAB))[(size_t)col * 1024 + k]); num += (r - g) * (r - g); den += r * r; }
    { const unsigned hsh = hash32(i * 4 + 1), j = hsh % 256, k = (hsh >> 12) % 1024; float r = 0.f; for (int q = 0; q < 16; ++q) r += A.in[I_WINAB][(size_t)k * 3600 + 3584 + q] * A.in[I_WGKUP][q * 256 + j];
      const float g = bf2f(((const bf16_t*)(ws + WS_WAB))[(size_t)(3584 + j) * 1024 + k]); num += (r - g) * (r - g); den += r * r; }
    { const unsigned hsh = hash32(i * 4 + 2), le = hsh % 514, layer = le / 257, e = le % 257, n = (hsh >> 10) % 512, k = (hsh >> 20) % 1024;
      const float r = (e < 256) ? A.in[I_WEI][((size_t)(layer * 256 + e) * 1024 + k) * 512 + n] : A.in[I_WSI][((size_t)layer * 1024 + k) * 512 + n];
      const unsigned up = n >> 8, c = n & 255, drow = (c >> 7) * 256 + up * 128 + (c & 127);
      const float g = bf2f(((const bf16_t*)(ws + WS_W1T))[((size_t)(layer * 257 + e) * 512 + drow) * 1024 + k]); num += (r - g) * (r - g); den += r * r; }
    { const unsigned hsh = hash32(i * 4 + 3), le = hsh % 514, layer = le / 257, e = le % 257, n = (hsh >> 10) % 1024, k = (hsh >> 20) % 256;
      const float r = (e < 256) ? A.in[I_WED][((size_t)(layer * 256 + e) * 256 + k) * 1024 + n] : A.in[I_WSD][((size_t)layer * 256 + k) * 1024 + n];
      const float g = bf2f(((const bf16_t*)(ws + WS_W2T))[((size_t)(layer * 257 + e) * 1024 + n) * 256 + k]); num += (r - g) * (r - g); den += r * r; }
    dbg_acc(w, 1, num, den);
}
__global__ void dbg_gemm(const bf16_t* Am, int K, const bf16_t* Bt, const void* out, int ldo, int out_f32, int nrows, int ncols, float* w, int stage) {
    const unsigned i = blockIdx.x * 256 + threadIdx.x; const unsigned hsh = hash32(i + 77u * stage), row = hsh % nrows, col = (hsh >> 11) % ncols;
    float r = 0.f; for (int k = 0; k < K; ++k) r += bf2f(Am[(size_t)row * K + k]) * bf2f(Bt[(size_t)col * K + k]);
    const float g = out_f32 ? ((const float*)out)[(size_t)row * ldo + col] : bf2f(((const bf16_t*)out)[(size_t)row * ldo + col]);
    dbg_acc(w, stage, (r - g) * (r - g), r * r);
}
template <int MODE> __global__ void __launch_bounds__(256, 1) dbg_mixer(MixP mp, int b, int h, int T, float* w, int stage) {
    constexpr int DK = (MODE == 1) ? 64 : 128, DV = (MODE == 2) ? 256 : 128;
    __shared__ float sq[128], sk[128], sa[128], red[256], sh_i, sh_f;
    const int tid = threadIdx.x;
    const int ldp = mp.ldp; const bf16_t* proj = mp.proj;
    int cq, ck, cv, cg, cy, cu = 3584 + h * 64;
    if (MODE == 0) { cq = h * 128; ck = 512 + h * 128; cv = 1024 + h * 128; cg = 1536 + h * 128; cy = h * 128; }
    else if (MODE == 1) { cq = 2048 + h * 64; ck = 2304 + h * 64; cv = 2560 + h * 128; cg = 3072 + h * 128; cy = 512 + h * 128; }
    else { cq = h * 128; ck = 512 + h * 128; cv = 1024 + h * 256; cg = 2048 + h * 256; cy = h * 256; }
    float S[DK];
#pragma unroll
    for (int d = 0; d < DK; ++d) S[d] = 0.f;
    float nst = 0.f, num = 0.f, den = 0.f;
    for (int t = 0; t < T; ++t) {
        const size_t tok = (size_t)b * SEQ + t; const bf16_t* pr = proj + tok * ldp;
        if (tid < DK) {
            const int d = tid;
            if (MODE == 0) { const float z = bf2f(pr[ck + d]), sg = 1.f / (1.f + expf(-z)), lb = mp.lb0[h * 128 + d]; sa[d] = lb + (1.f - lb) * sg; sk[d] = (1.f - lb) * (1.f - sg); const float qq = bf2f(pr[cq + d]); sq[d] = qq / (1.f + expf(-qq)); }
            else if (MODE == 1) { const float u = bf2f(pr[cu + d]) + mp.bgk[h * 64 + d]; const float ls = fminf(u, 0.f) - log1pf(expf(-fabsf(u))); sa[d] = expf(ls / 16.f); sk[d] = bf2f(pr[ck + d]); sq[d] = bf2f(pr[cq + d]) * 0.125f; }
            else { float aq = 0.f, ak = 0.f; for (int j = 0; j < 4; ++j) { const int tt = t - 3 + j; if (tt >= 0) { const bf16_t* p2 = proj + ((size_t)b * SEQ + tt) * ldp; aq += mp.conv[j * 1024 + cq + d] * bf2f(p2[cq + d]); ak += mp.conv[j * 1024 + ck + d] * bf2f(p2[ck + d]); } }
                sq[d] = aq / (1.f + expf(-aq)); sk[d] = ak / (1.f + expf(-ak)) * 0.08838834764831845f; }
        }
        if (MODE == 2 && tid == 0) { const float* gp = mp.gates + tok * 8; sh_i = expf(gp[h] + mp.bif[h]); const float x = gp[4 + h] + mp.bif[4 + h]; sh_f = 1.f / (1.f + expf(-x)); }
        __syncthreads();
        const float vt = bf2f(pr[cv + tid]);
        float o = 0.f;
        if (MODE == 2) { const float f = sh_f, ii = sh_i;
#pragma unroll
            for (int d = 0; d < DK; ++d) { S[d] = f * S[d] + ii * sk[d] * vt; o += S[d] * sq[d]; }
            if (tid < 128) nst = f * nst + ii * sk[tid];
            red[tid] = (tid < 128) ? nst * sq[tid] : 0.f;
        } else {
#pragma unroll
            for (int d = 0; d < DK; ++d) { S[d] = sa[d] * S[d] + sk[d] * vt; o += S[d] * sq[d]; }
            red[tid] = o * o;
        }
        __syncthreads();
        for (int st = DV / 2; st > 0; st >>= 1) { if (tid < st) red[tid] += red[tid + st]; __syncthreads(); }
        const float tot = red[0];
        const float gt = bf2f(pr[cg + tid]);
        float y;
        if (MODE == 2) y = o / fmaxf(fabsf(tot), 1.f) * (1.f / (1.f + expf(-gt)));
        else y = o * rsqrtf(tot / 128.f + 1e-6f) * ((MODE == 0) ? mp.hg : mp.gg)[h * 128 + tid] * (gt / (1.f + expf(-gt)));
        const float g = bf2f(mp.ymix[tok * DM + cy + tid]);
        num += (y - g) * (y - g); den += y * y;
        __syncthreads();
    }
    dbg_acc(w, stage, num, den);
}
__global__ void dbg_h1(const bf16_t* HIN, const bf16_t* YM, const bf16_t* Wt, const bf16_t* H1, const float* g, const float* bb, float* w, int stage) {
    __shared__ float red[256]; __shared__ float zrow[1024];
    const int tid = threadIdx.x; const unsigned row = hash32(blockIdx.x + 1000u * stage) % NTOK;
    float z[4];
    for (int q = 0; q < 4; ++q) { const int c = tid + 256 * q; float a = 0.f; for (int k = 0; k < 1024; ++k) a += bf2f(YM[(size_t)row * 1024 + k]) * bf2f(Wt[(size_t)c * 1024 + k]); z[q] = bfr(ALPHA * bf2f(HIN[(size_t)row * 1024 + c]) + a); }
    red[tid] = z[0] + z[1] + z[2] + z[3]; __syncthreads();
    for (int st = 128; st > 0; st >>= 1) { if (tid < st) red[tid] += red[tid + st]; __syncthreads(); }
    const float mu = red[0] / 1024.f; __syncthreads();
    red[tid] = (z[0] - mu) * (z[0] - mu) + (z[1] - mu) * (z[1] - mu) + (z[2] - mu) * (z[2] - mu) + (z[3] - mu) * (z[3] - mu); __syncthreads();
    for (int st = 128; st > 0; st >>= 1) { if (tid < st) red[tid] += red[tid + st]; __syncthreads(); }
    const float rs = rsqrtf(red[0] / 1024.f + 1e-5f);
    float num = 0.f, den = 0.f;
    for (int q = 0; q < 4; ++q) { const int c = tid + 256 * q; const float y = (z[q] - mu) * rs * g[c] + bb[c], gg = bf2f(H1[(size_t)row * 1024 + c]); num += (y - gg) * (y - gg); den += y * y; }
    dbg_acc(w, stage, num, den); (void)zrow;
}
__global__ void dbg_select(const float* logits, const float* rb, const int* tok_e, const float* tok_w, float* w, int stage) {
    __shared__ float sc[256], bs[256]; __shared__ int ce[8]; __shared__ float cs[8];
    if (threadIdx.x != 0) return;
    const unsigned tok = hash32(blockIdx.x + 31u * stage) % NTOK;
    const float* lp = logits + (size_t)tok * 256;
    for (int e = 0; e < 256; ++e) { sc[e] = 1.f / (1.f + expf(-lp[e])); bs[e] = sc[e] + rb[e]; }
    float gs[8];
#pragma unroll
    for (int g = 0; g < 8; ++g) { float m1 = -1e30f, m2 = -1e30f; for (int j = 0; j < 32; ++j) { const float v = bs[g * 32 + j]; if (v > m1) { m2 = m1; m1 = v; } else if (v > m2) m2 = v; } gs[g] = m1 + m2; }
    unsigned selmask = 0;
#pragma unroll
    for (int g = 0; g < 8; ++g) { int rank = 0;
#pragma unroll
        for (int q = 0; q < 8; ++q) rank += (gs[q] > gs[g] || (gs[q] == gs[g] && q < g)) ? 1 : 0; if (rank < 4) selmask |= 1u << g; }
    float tot = 0.f;
    for (int k = 0; k < 8; ++k) { float bv = -1e30f; int be = 0; for (int e = 0; e < 256; ++e) { if (!((selmask >> (e >> 5)) & 1u)) continue; bool used = false; for (int q = 0; q < k; ++q) used |= (ce[q] == e); if (used) continue; if (bs[e] > bv) { bv = bs[e]; be = e; } } ce[k] = be; cs[k] = sc[be]; tot += sc[be]; }
    float num = 0.f, den = 0.f;
    for (int k = 0; k < 8; ++k) { const float wr_ = cs[k] / tot * 2.5f; const int ge = tok_e[(size_t)tok * 8 + k]; const float gw = tok_w[(size_t)tok * 8 + k];
        num += (ge == ce[k] ? 0.f : 1.f) + (wr_ - gw) * (wr_ - gw); den += wr_ * wr_; }
    dbg_acc(w, stage, num, den);
}
template <bool FINAL> __global__ void dbg_moe(Args A, int layer, const int* tok_e, const float* tok_w, const bf16_t* H1, const bf16_t* H2, const float* OUT, float* w, int stage) {
    __shared__ float hrow[1024], hid[256], red[256];
    const int tid = threadIdx.x; const unsigned tok = hash32(blockIdx.x + 555u * stage) % NTOK;
    for (int i = tid; i < 1024; i += 256) hrow[i] = bf2f(H1[(size_t)tok * 1024 + i]);
    float acc[4] = {0.f, 0.f, 0.f, 0.f};
    __syncthreads();
    for (int k = 0; k < 9; ++k) {
        const int e = (k < 8) ? tok_e[(size_t)tok * 8 + k] : 256; const float wk = (k < 8) ? tok_w[(size_t)tok * 8 + k] : 1.f;
        const float* W1 = (e < 256) ? A.in[I_WEI] + (size_t)(layer * 256 + e) * 1024 * 512 : A.in[I_WSI] + (size_t)layer * 1024 * 512;
        const float* W2 = (e < 256) ? A.in[I_WED] + (size_t)(layer * 256 + e) * 256 * 1024 : A.in[I_WSD] + (size_t)layer * 256 * 1024;
        float gsum = 0.f, usum = 0.f;
        for (int kk = 0; kk < 1024; ++kk) { gsum += hrow[kk] * W1[(size_t)kk * 512 + tid]; usum += hrow[kk] * W1[(size_t)kk * 512 + 256 + tid]; }
        hid[tid] = gsum / (1.f + expf(-gsum)) * usum;
        __syncthreads();
        for (int q = 0; q < 4; ++q) { const int c = tid + 256 * q; float a = 0.f; for (int j = 0; j < 256; ++j) a += hid[j] * W2[(size_t)j * 1024 + c]; acc[q] += wk * a; }
        __syncthreads();
    }
    float z[4]; for (int q = 0; q < 4; ++q) z[q] = ALPHA * hrow[tid + 256 * q] + acc[q];
    red[tid] = z[0] + z[1] + z[2] + z[3]; __syncthreads();
    for (int st = 128; st > 0; st >>= 1) { if (tid < st) red[tid] += red[tid + st]; __syncthreads(); }
    const float mu = red[0] / 1024.f; __syncthreads();
    red[tid] = (z[0] - mu) * (z[0] - mu) + (z[1] - mu) * (z[1] - mu) + (z[2] - mu) * (z[2] - mu) + (z[3] - mu) * (z[3] - mu); __syncthreads();
    for (int st = 128; st > 0; st >>= 1) { if (tid < st) red[tid] += red[tid + st]; __syncthreads(); }
    const float rs = rsqrtf(red[0] / 1024.f + 1e-5f);
    const float* g = A.in[I_LFG] + layer * DM; const float* bb = A.in[I_LFB] + layer * DM;
    float num = 0.f, den = 0.f;
    for (int q = 0; q < 4; ++q) { const int c = tid + 256 * q; const float y = (z[q] - mu) * rs * g[c] + bb[c]; const float gg = FINAL ? OUT[(size_t)tok * 1024 + c] : bf2f(H2[(size_t)tok * 1024 + c]); num += (y - gg) * (y - gg); den += y * y; }
    dbg_acc(w, stage, num, den);
}
#ifndef DBG_REPORT
#define DBG_REPORT 0
#endif
__global__ void dbg_fill(float* out, const float* w) {
    __shared__ float cval;
    if (threadIdx.x == 0) {
        float c = 0.f;
        if (DBG_REPORT == 0) { for (int st = 1; st <= 13; ++st) { const float rel = sqrtf(w[2 * st] / fmaxf(w[2 * st + 1], 1e-30f)); if (!(rel < 0.08f) || !(w[2 * st + 1] > 0.f)) { c = (float)st; break; } } }
        else { const float rel = sqrtf(w[2 * DBG_REPORT] / fmaxf(w[2 * DBG_REPORT + 1], 1e-30f)); float l = -log10f(fmaxf(rel, 1e-8f)); l = fminf(fmaxf(l, -2.f), 8.f); c = 3.f + l; }
        cval = c;
    }
    __syncthreads();
    const float c = cval;
    if (c != 0.f) for (size_t i = (size_t)blockIdx.x * 256 + threadIdx.x; i < (size_t)NTOK * DM; i += (size_t)gridDim.x * 256) out[i] = c;
}
#endif

extern "C" void kernel_launch(void* const* d_in, const int* in_sizes, int n_in, void* d_out, int out_size, void* d_ws, size_t ws_size, hipStream_t stream) {
    static int grid = 0;
    if (grid == 0) {
        if (n_in != 22 || out_size != NTOK * DM || ws_size < WS_END) { fprintf(stderr, "kernel_launch: unexpected shapes (n_in %d out %d ws %zu)\n", n_in, out_size, ws_size); grid = -1; return; }
        if (hipFuncSetAttribute((const void*)fwd_kernel, hipFuncAttributeMaxDynamicSharedMemorySize, LDS_BYTES) != hipSuccess) { fprintf(stderr, "kernel_launch: hipFuncSetAttribute failed\n"); grid = -1; return; }
        int per_cu = 0;
        if (hipOccupancyMaxActiveBlocksPerMultiprocessor(&per_cu, (const void*)fwd_kernel, 512, LDS_BYTES) != hipSuccess || per_cu < 1) fprintf(stderr, "kernel_launch: occupancy query says %d\n", per_cu);
        (void)hipGetLastError();
        grid = NWG;
    }
    if (grid < 0) return;
    (void)hipMemsetAsync((char*)d_ws + WS_CTL, 0, CTL_BYTES, stream);
    Args a{};
    for (int i = 0; i < 22; ++i) a.in[i] = (const float*)d_in[i];
    a.out = (float*)d_out; a.ws = (unsigned char*)d_ws;
#if MK_ONE_LAUNCH
    a.ph_lo = 0; a.ph_hi = 23;
    hipLaunchKernelGGL(fwd_kernel, dim3(grid), dim3(512), LDS_BYTES, stream, a);
#else
    for (int p = 0; p < 23; ++p) { a.ph_lo = p; a.ph_hi = p + 1; hipLaunchKernelGGL(fwd_kernel, dim3(grid), dim3(512), LDS_BYTES, stream, a);
#ifdef DBG
        unsigned char* ws = (unsigned char*)d_ws; float* dw = (float*)(ws + WS_CTL) + CW_DBG;
        const int layer = (p - 1) / 11, q = (p - 1) % 11;
        MixP mp{(const bf16_t*)(ws + WS_PROJ), layer ? CWID : ABW, 0, (bf16_t*)(ws + WS_YMIX), (const float*)(ws + WS_GATES), (const float*)(ws + WS_MISC), a.in[I_BGK], a.in[I_HG], a.in[I_GG], a.in[I_CONV], a.in[I_BIF], (float*)(ws + WS_UST), (float*)(ws + WS_GSUM)};
        if (p == 0) hipLaunchKernelGGL(dbg_weights, dim3(256), dim3(256), 0, stream, a, dw);
        if (p >= 1 && q == 0) hipLaunchKernelGGL(dbg_gemm, dim3(64), dim3(256), 0, stream, (const bf16_t*)(ws + (layer ? WS_H2 : WS_HB)), 1024, (const bf16_t*)(ws + (layer ? WS_WC : WS_WAB)), (const void*)(ws + WS_PROJ), layer ? CWID : ABW, 0, NTOK, layer ? CWID : ABW, dw, layer ? 9 : 2);
        if (p >= 1 && q == 2 && layer == 0) { hipLaunchKernelGGL(dbg_mixer<0>, dim3(1), dim3(128), 0, stream, mp, 0, 1, 1100, dw, 3); hipLaunchKernelGGL(dbg_mixer<1>, dim3(1), dim3(128), 0, stream, mp, 1, 2, 1100, dw, 4); }
        if (p >= 1 && q == 2 && layer == 1) hipLaunchKernelGGL(dbg_mixer<2>, dim3(1), dim3(256), 0, stream, mp, 1, 1, 1100, dw, 10);
        if (p >= 1 && q == 4) hipLaunchKernelGGL(dbg_h1, dim3(32), dim3(256), 0, stream, (const bf16_t*)(ws + (layer ? WS_H2 : WS_HB)), (const bf16_t*)(ws + WS_YMIX), (const bf16_t*)(ws + (layer ? WS_WOC : WS_WOAB)), (const bf16_t*)(ws + WS_H1), a.in[I_LMG] + layer * DM, a.in[I_LMB] + layer * DM, dw, layer ? 11 : 5);
        if (p >= 1 && q == 5 && layer == 0) hipLaunchKernelGGL(dbg_gemm, dim3(64), dim3(256), 0, stream, (const bf16_t*)(ws + WS_H1), 1024, (const bf16_t*)(ws + WS_WR), (const void*)(ws + WS_LOGITS), 256, 1, NTOK, 256, dw, 6);
        if (p >= 1 && q == 6) hipLaunchKernelGGL(dbg_select, dim3(64), dim3(64), 0, stream, (const float*)(ws + WS_LOGITS), a.in[I_RB] + layer * NEXP, (const int*)(ws + WS_TOKE), (const float*)(ws + WS_TOKW), dw, layer ? 12 : 7);
        if (p >= 1 && q == 10 && layer == 0) hipLaunchKernelGGL(dbg_moe<false>, dim3(32), dim3(256), 0, stream, a, 0, (const int*)(ws + WS_TOKE), (const float*)(ws + WS_TOKW), (const bf16_t*)(ws + WS_H1), (const bf16_t*)(ws + WS_H2), (const float*)d_out, dw, 8);
        if (p >= 1 && q == 10 && layer == 1) { hipLaunchKernelGGL(dbg_moe<true>, dim3(32), dim3(256), 0, stream, a, 1, (const int*)(ws + WS_TOKE), (const float*)(ws + WS_TOKW), (const bf16_t*)(ws + WS_H1), (const bf16_t*)(ws + WS_H2), (const float*)d_out, dw, 13);
            hipLaunchKernelGGL(dbg_fill, dim3(1024), dim3(256), 0, stream, (float*)d_out, dw); }
#endif
    }
#endif
}
```

```cpp
#include <hip/hip_runtime.h>
#include <cstdio>
#include <cstdint>

#ifndef MK_ONE_LAUNCH
#define MK_ONE_LAUNCH 1
#endif

#define LAS __attribute__((address_space(3)))
typedef unsigned short bf16_t;
typedef short bf16x8 __attribute__((ext_vector_type(8)));
typedef float f32x4 __attribute__((ext_vector_type(4)));
typedef unsigned u32x4 __attribute__((ext_vector_type(4)));
typedef unsigned u32x2 __attribute__((ext_vector_type(2)));

constexpr int NTOK = 32768, SEQ = 16384, DM = 1024;
constexpr int ABW = 3840;
constexpr int CWID = 3072;
constexpr int NEXP = 256, NE1 = 257, TOPK = 8, NSLOT = 9;
constexpr float ALPHA = 1.41421356237f;
constexpr int NWG = 256;
constexpr int PRMAX = 262144 + 65536 + 32768;

constexpr size_t MiB = 1u << 20;
constexpr size_t WS_CTL = 0, CTL_BYTES = 1 * MiB;
constexpr size_t WS_MISC = 1 * MiB;
constexpr size_t WS_WAB = 2 * MiB, WS_WOAB = 10 * MiB, WS_WC = 12 * MiB, WS_WOC = 18 * MiB, WS_WR = 20 * MiB;
constexpr size_t WS_TOKE = 22 * MiB, WS_TOKP = 23 * MiB, WS_TOKW = 24 * MiB;
constexpr size_t WS_STOK = 26 * MiB, WS_POSY = 28 * MiB;
constexpr size_t WS_GATES = 32 * MiB;
constexpr size_t WS_UST = 34 * MiB, WS_GSUM = 54 * MiB;
constexpr size_t WS_LOGITS = 56 * MiB;
constexpr size_t WS_HB = 96 * MiB, WS_PROJ = 160 * MiB, WS_YMIX = 400 * MiB, WS_Z = 464 * MiB, WS_H1 = 528 * MiB, WS_H2 = 592 * MiB;
constexpr size_t WS_ACT = 656 * MiB, WS_Y = 832 * MiB, WS_W1T = 1540 * MiB, WS_W2T = 2056 * MiB;
constexpr size_t WS_XQ = 2320 * MiB, WS_H1Q = 2352 * MiB, WS_H2Q = 2384 * MiB, WS_END = 2416 * MiB;
constexpr float Q_SA = 127.f / 5.5f, Q_SW = 127.f * 32.f / 5.5f, Q_DEQ = 1.f / (Q_SA * Q_SW);
constexpr float Q_SY = 127.f / 8.f, Q_SWO = 127.f * 64.f / 5.5f, Q_DEQO = 1.f / (Q_SY * Q_SWO);
constexpr float Q_SACT = 127.f / 8.f, Q_DEQ2 = 16.f / (Q_SACT * Q_SW);
constexpr int CW_BAR = 4096;
constexpr int CW_CNT = 16384;
constexpr int CW_DBG = 20480;

__device__ __forceinline__ unsigned pk2(float lo, float hi) { unsigned r; asm volatile("v_cvt_pk_bf16_f32 %0, %1, %2" : "=v"(r) : "v"(lo), "v"(hi)); return r; }
__device__ __forceinline__ float bflo(unsigned u) { return __uint_as_float(u << 16); }
__device__ __forceinline__ float bfhi(unsigned u) { return __uint_as_float(u & 0xffff0000u); }
__device__ __forceinline__ float bf2f(bf16_t b) { return __uint_as_float(((unsigned)b) << 16); }
__device__ __forceinline__ float sigm(float x) { return __builtin_amdgcn_rcpf(1.f + __expf(-x)); }
__device__ __forceinline__ float silu(float x) { return x * __builtin_amdgcn_rcpf(1.f + __expf(-x)); }
__device__ __forceinline__ int q8(float x, float sc) { return (int)rintf(fminf(fmaxf(x * sc, -127.f), 127.f)); }
__device__ __forceinline__ unsigned pk4(int a, int b, int c, int d) { return (unsigned)(a & 255) | ((unsigned)(b & 255) << 8) | ((unsigned)(c & 255) << 16) | ((unsigned)d << 24); }
__device__ __forceinline__ float logsig(float x) { return fminf(x, 0.f) - __logf(1.f + __expf(-fabsf(x))); }

#define XB_TMO      128
#define XB_XCNT(j)  (256  + 64 * (j))
#define XB_XSUB(j)  (1280 + 64 * (j))
#define XB_XGEN(j)  (2304 + 64 * (j))
#define XB_TOP      3328
#define XB_TOPGEN   3392
#define XCD_BAR_WORDS 3456
#define XB_SPIN_CAP (1u << 22)
__device__ __forceinline__ unsigned xb_ld(unsigned* p)              { return __hip_atomic_load(p, __ATOMIC_RELAXED, __HIP_MEMORY_SCOPE_AGENT); }
__device__ __forceinline__ unsigned xb_add(unsigned* p, unsigned v) { return __hip_atomic_fetch_add(p, v, __ATOMIC_RELAXED, __HIP_MEMORY_SCOPE_AGENT); }
__device__ __forceinline__ unsigned xb_xcc_id() { return (unsigned)__builtin_amdgcn_s_getreg((3 << 11) | 20) & 0xFu; }
#define XB_SPIN(cond, bar) do { unsigned _sp = 0; while (cond) { __builtin_amdgcn_s_sleep(1); \
    if ((++_sp & 255u) == 0u) { if (xb_ld(&(bar)[XB_TMO])) break; if (_sp > XB_SPIN_CAP) { atomicAdd(&(bar)[XB_TMO], 1u); break; } } } } while (0)
struct XcdBarrier { unsigned* bar; unsigned x; volatile LAS unsigned* st; };
__device__ __forceinline__ XcdBarrier xcd_barrier_post(unsigned* bar, volatile LAS unsigned* st) {
    XcdBarrier b; b.bar = bar; b.x = xb_xcc_id(); b.st = st;
    if (threadIdx.x == 0) (void)xb_add(&bar[XB_XCNT(b.x)], 1u);
    return b;
}
__device__ __forceinline__ void xcd_barrier_complete(unsigned* bar, unsigned x, unsigned& nloc, unsigned& nx) {
    const unsigned G = gridDim.x * gridDim.y * gridDim.z;
    unsigned sum, cnt, mine, sp = 0u;
    for (;;) {
        sum = 0u; cnt = 0u; mine = 0u;
#pragma unroll
        for (unsigned j = 0; j < 16; ++j) { const unsigned c = xb_ld(&bar[XB_XCNT(j)]); sum += c; cnt += (c > 0u) ? 1u : 0u; mine = (j == x) ? c : mine; }
        if (sum == G) break;
        __builtin_amdgcn_s_sleep(1);
        if ((++sp & 255u) == 0u) { if (xb_ld(&bar[XB_TMO])) break; if (sp > XB_SPIN_CAP) { atomicAdd(&bar[XB_TMO], 1u); break; } }
    }
    nloc = mine > 0u ? mine : 1u; nx = cnt > 0u ? cnt : 1u;
}
__device__ __forceinline__ void xcd_barrier(const XcdBarrier& b) {
    asm volatile("s_waitcnt vmcnt(0)" ::: "memory");
    __syncthreads();
    if (threadIdx.x == 0) {
        unsigned* bar = b.bar;
        __builtin_amdgcn_s_waitcnt(0);
        unsigned nloc = b.st[0], nx = b.st[1];
        if (nloc == 0u) { xcd_barrier_complete(bar, b.x, nloc, nx); b.st[0] = nloc; b.st[1] = nx; }
        const unsigned old = xb_add(&bar[XB_XSUB(b.x)], 1u);
        const unsigned gen = old / nloc;
        if (old + 1u == (gen + 1u) * nloc) {
            __builtin_amdgcn_fence(__ATOMIC_RELEASE, "agent");
            asm volatile("s_waitcnt vmcnt(0)" ::: "memory");
            const unsigned og = xb_add(&bar[XB_TOP], 1u);
            const unsigned tg = og / nx;
            if (og + 1u == (tg + 1u) * nx) xb_add(&bar[XB_TOPGEN], 1u);
            else XB_SPIN(xb_ld(&bar[XB_TOPGEN]) == tg, bar);
            __builtin_amdgcn_fence(__ATOMIC_ACQUIRE, "agent");
            xb_add(&bar[XB_XGEN(b.x)], 1u);
            asm volatile("s_waitcnt vmcnt(0)" ::: "memory");
        } else {
            XB_SPIN(xb_ld(&bar[XB_XGEN(b.x)]) == gen, bar);
            __builtin_amdgcn_fence(__ATOMIC_ACQUIRE, "agent");
            asm volatile("s_waitcnt vmcnt(0)" ::: "memory");
        }
    }
    __syncthreads();
}

namespace pg8 {
constexpr int BM = 256, BK = 64, HALF = 128, HTB = HALF * BK * 2, STAGE_BYTES = 8 * HTB, NXCD = 8, WGM = 8;
__device__ __forceinline__ int lds_byte(int r, int c) { const int st = (r >> 4) * 2 + (c >> 5), rr = r & 15, cc = c & 31, ob = rr * 64 + cc * 2; return st * 1024 + (ob ^ (((ob >> 9) & 1) << 5)); }
__device__ __forceinline__ void stage_rc(int b, int& R, int& C) { const int st = b / 1024, sb = b % 1024, swz = sb ^ (((sb >> 9) & 1) << 5); R = (st >> 1) * 16 + swz / 64; C = (st & 1) * 32 + (swz % 64) / 2; }
__device__ __forceinline__ int perm32(int rho) { const int n = rho >> 4, i = rho & 15; return 8 * (i >> 2) + 4 * n + (i & 3); }
struct Unit { int pm, pn; };
struct Gemm { const bf16_t* A; const bf16_t* Bt; int K; };

struct StaticOrder {
    int nM, nN, nwg, G, c;
    __device__ void init(int M, int N, int G_, int c_) { nM = M / BM; nN = N / BM; nwg = nM * nN; G = G_; c = c_; }
    __device__ bool next(int i, Unit& u) const {
        const long L = (long)i * G + c; if (L >= nwg) return false;
        int wgid = (int)L; { const int q = nwg / NXCD, r = nwg % NXCD, xcd = wgid % NXCD, off = wgid / NXCD; wgid = (xcd < r ? xcd * (q + 1) : r * (q + 1) + (xcd - r) * q) + off; }
        const int nig = WGM * nN, gid = wgid / nig, fm = gid * WGM, gsz = (nM - fm) < WGM ? (nM - fm) : WGM;
        u.pm = fm + ((wgid % nig) % gsz); u.pn = (wgid % nig) / gsz; return true;
    }
};
struct MoeOrder {
    const LAS int* tab; int n;
    __device__ bool next(int i, Unit& u) const {
        if (i >= n) return false;
        u.pm = __builtin_amdgcn_readfirstlane(tab[2 * i]); u.pn = __builtin_amdgcn_readfirstlane(tab[2 * i + 1]); return true;
    }
};
constexpr int LDS_UT = 131072, LDS_IDX = 131072 + 512, MOE_MAXU = 15;
__device__ __forceinline__ int moe_prep(LAS unsigned char* lds, const int* __restrict__ tile_exp, int nunits, int sh, int G, int c, const int* __restrict__ rowidx) {
    const int tid = threadIdx.x;
    LAS int* tab = (LAS int*)(lds + LDS_UT);
    int n = 0; { const long rem = (long)nunits - c; n = rem > 0 ? (int)((rem + G - 1) / G) : 0; if (n > 32) n = 32; }
    if (tid < n) { const long L = (long)tid * G + c; const int rt = (int)(L >> sh), j = (int)L & ((1 << sh) - 1); tab[2 * tid] = rt; tab[2 * tid + 1] = (tile_exp[rt] << sh) + j; }
    __syncthreads();
    if (rowidx) { LAS int* idx = (LAS int*)(lds + LDS_IDX); const int nn = n < MOE_MAXU ? n : MOE_MAXU;
        for (int x = tid; x < nn * 256; x += 512) idx[x] = rowidx[tab[2 * (x >> 8)] * 256 + (x & 255)];
        __syncthreads(); }
    return n;
}

typedef int i32x4 __attribute__((ext_vector_type(4)));
template <class Epi, class Sched, bool GATHER, bool I8 = false>
__device__ __forceinline__ void gemm_phase(LAS unsigned char* lds, const Gemm g, const LAS int* rowidx, const Sched& S, const Epi& E) {
    const int tid = threadIdx.x, wid = __builtin_amdgcn_readfirstlane(tid >> 6), lane = tid & 63, wr = wid >> 2, wc = wid & 3, fr = lane & 15, fq = lane >> 4;
    const int K = g.K, nt = K / BK;
    unsigned voffB[2], cofs[2]; int Rr[2];
#pragma unroll
    for (int i = 0; i < 2; ++i) { int R, C; stage_rc(tid * 16 + i * 8192, R, C); const int Rb = Epi::PERM ? ((R & ~31) + perm32(R & 31)) : R;
        Rr[i] = R; cofs[i] = (unsigned)C * 2u; voffB[i] = (unsigned)(Rb * K + C) * 2u; }
    const unsigned rowb = (unsigned)K * 2u;
    const size_t kstep = (size_t)(BK * 2);
    const size_t hstep = (size_t)HALF * K * 2;
    const size_t tstep = 2 * hstep;
    const unsigned ldsw = (unsigned)wid * 1024u;
    const int aoff = lds_byte(wr * 64 + fr, fq * 8), boff = lds_byte(wc * 32 + fr, fq * 8);
    const char* Abase = (const char*)g.A;
#define PG8_SA(b, h) (((b) * 2 + (h)) * HTB)
#define PG8_SB(b, h) ((4 + (b) * 2 + (h)) * HTB)
#define PG8_STAGE(bufoff, gbase, voff) do { _Pragma("unroll") for (int _i = 0; _i < 2; ++_i) \
        __builtin_amdgcn_global_load_lds((const unsigned*)((const char*)(gbase) + (voff)[_i]), (LAS unsigned*)(lds + (bufoff) + ldsw + _i * 8192), 16, 0, 0); } while (0)
#define PG8_STAGEA(bufoff, kb, offs) do { _Pragma("unroll") for (int _i = 0; _i < 2; ++_i) \
        __builtin_amdgcn_global_load_lds((const unsigned*)(Abase + (size_t)((kb) + (offs)[_i])), (LAS unsigned*)(lds + (bufoff) + ldsw + _i * 8192), 16, 0, 0); } while (0)
#define PG8_ROWOFF(u, uo, O) do { _Pragma("unroll") for (int _h = 0; _h < 2; ++_h) _Pragma("unroll") for (int _i = 0; _i < 2; ++_i) { \
        int _row = (u).pm * BM + _h * HALF + Rr[_i]; if (GATHER) _row = rowidx[(uo) * 256 + _h * HALF + Rr[_i]]; (O)[_h][_i] = (unsigned)_row * rowb + cofs[_i]; } } while (0)
#define PG8_LDA(dst, b, h) do { _Pragma("unroll") for (int m = 0; m < 4; ++m) _Pragma("unroll") for (int k = 0; k < 2; ++k) dst[m][k] = *(const LAS bf16x8*)(lds + PG8_SA(b, h) + aoff + m * 2048 + k * 1024); } while (0)
#define PG8_LDB(dst, b, h) do { _Pragma("unroll") for (int n = 0; n < 2; ++n) _Pragma("unroll") for (int k = 0; k < 2; ++k) dst[n][k] = *(const LAS bf16x8*)(lds + PG8_SB(b, h) + boff + n * 2048 + k * 1024); } while (0)
#define PG8_MMA(ai, bj, At, Bt) do { __builtin_amdgcn_s_setprio(1); _Pragma("unroll") for (int m = 0; m < 4; ++m) _Pragma("unroll") for (int n = 0; n < 2; ++n) _Pragma("unroll") for (int k = 0; k < 2; ++k) \
        { if (I8) acc[ai][bj][m][n] = __builtin_bit_cast(f32x4, __builtin_amdgcn_mfma_i32_16x16x64_i8(__builtin_bit_cast(i32x4, Bt[n][k]), __builtin_bit_cast(i32x4, At[m][k]), __builtin_bit_cast(i32x4, acc[ai][bj][m][n]), 0, 0, 0)); \
          else acc[ai][bj][m][n] = __builtin_amdgcn_mfma_f32_16x16x32_bf16(Bt[n][k], At[m][k], acc[ai][bj][m][n], 0, 0, 0); } __builtin_amdgcn_s_setprio(0); } while (0)
#define PG8_WAIT_V(n) asm volatile("s_waitcnt vmcnt(" #n ")" ::: "memory")
#define PG8_WAIT_L(n) asm volatile("s_waitcnt lgkmcnt(" #n ")" ::: "memory")
#define PG8_BAR __builtin_amdgcn_s_barrier()
#define PG8_SCHED __builtin_amdgcn_sched_barrier(0)
    Unit cur, nxt; int ui = 0;
    if (!S.next(0, cur)) return;
    f32x4 acc[2][2][4][2];
#pragma unroll
    for (int a = 0; a < 2; ++a)
#pragma unroll
        for (int b = 0; b < 2; ++b)
#pragma unroll
            for (int m = 0; m < 4; ++m)
#pragma unroll
                for (int n = 0; n < 2; ++n) acc[a][b][m][n] = (f32x4){0.f, 0.f, 0.f, 0.f};
    bf16x8 At[4][2], B0[2][2], B1[2][2];
    unsigned cO[2][2], nO[2][2];
    PG8_ROWOFF(cur, 0, cO);
    const char* cB = (const char*)g.Bt + (size_t)cur.pn * tstep;
    PG8_STAGE(PG8_SB(0, 0), cB, voffB); PG8_STAGE(PG8_SB(0, 1), cB + hstep, voffB); PG8_STAGEA(PG8_SA(0, 0), 0u, cO[0]); PG8_STAGEA(PG8_SA(0, 1), 0u, cO[1]);
    if (wr == 1) PG8_BAR;
    PG8_WAIT_V(2); PG8_BAR;
    PG8_STAGE(PG8_SB(1, 0), cB + kstep, voffB); PG8_STAGEA(PG8_SA(1, 0), (unsigned)kstep, cO[0]); PG8_STAGE(PG8_SB(1, 1), cB + hstep + kstep, voffB);
    PG8_WAIT_V(6); PG8_BAR;
    for (;;) {
        const bool has_next = S.next(ui + 1, nxt);
        const char* nB = has_next ? (const char*)g.Bt + (size_t)nxt.pn * tstep : cB;
#pragma unroll
        for (int h = 0; h < 2; ++h)
#pragma unroll
            for (int i = 0; i < 2; ++i) nO[h][i] = cO[h][i];
#pragma unroll 1
        for (int t = 0; t < nt; t += 2) {
            const bool last = (t == nt - 2);
            if (last && has_next) PG8_ROWOFF(nxt, ui + 1, nO);
            const unsigned k1 = (unsigned)(t + 1) * (unsigned)kstep;
            const unsigned k2 = last ? 0u : (unsigned)(t + 2) * (unsigned)kstep, k3 = k2 + (unsigned)kstep;
            const char* b2 = last ? nB : cB + (size_t)(t + 2) * kstep; const char* b3 = b2 + kstep;
            unsigned o2[2][2];
#pragma unroll
            for (int h = 0; h < 2; ++h)
#pragma unroll
                for (int i = 0; i < 2; ++i) o2[h][i] = last ? nO[h][i] : cO[h][i];
            PG8_LDB(B0, 0, 0); PG8_LDB(B1, 0, 1); PG8_SCHED; PG8_LDA(At, 0, 0); PG8_STAGEA(PG8_SA(1, 1), k1, cO[1]);
            PG8_WAIT_V(8); PG8_WAIT_L(0); PG8_BAR; PG8_MMA(0, 0, At, B0); PG8_MMA(0, 1, At, B1); PG8_BAR; PG8_SCHED;
            PG8_LDA(At, 0, 1); PG8_STAGE(PG8_SB(0, 0), b2, voffB); PG8_STAGE(PG8_SB(0, 1), b2 + hstep, voffB); PG8_STAGEA(PG8_SA(0, 0), k2, o2[0]);
            PG8_WAIT_V(8); PG8_WAIT_L(0); PG8_BAR; PG8_MMA(1, 0, At, B0); PG8_MMA(1, 1, At, B1); PG8_BAR; PG8_SCHED;
            PG8_LDB(B0, 1, 0); PG8_LDB(B1, 1, 1); PG8_SCHED; PG8_LDA(At, 1, 0); PG8_STAGEA(PG8_SA(0, 1), k2, o2[1]);
            PG8_WAIT_V(8); PG8_WAIT_L(0); PG8_BAR; PG8_MMA(0, 0, At, B0); PG8_MMA(0, 1, At, B1); PG8_BAR; PG8_SCHED;
            PG8_LDA(At, 1, 1); PG8_STAGE(PG8_SB(1, 0), b3, voffB); PG8_STAGE(PG8_SB(1, 1), b3 + hstep, voffB); PG8_STAGEA(PG8_SA(1, 0), k3, o2[0]);
            PG8_WAIT_V(8); PG8_WAIT_L(0); PG8_BAR; PG8_MMA(1, 0, At, B0); PG8_MMA(1, 1, At, B1); PG8_BAR; PG8_SCHED;
        }
        if (wr == 0) PG8_BAR;
        E(acc, cur, wr, wc, fr, fq);
        if (!has_next) break;
#pragma unroll
        for (int a = 0; a < 2; ++a)
#pragma unroll
            for (int b = 0; b < 2; ++b)
#pragma unroll
                for (int m = 0; m < 4; ++m)
#pragma unroll
                    for (int n = 0; n < 2; ++n) acc[a][b][m][n] = (f32x4){0.f, 0.f, 0.f, 0.f};
        cur = nxt; cB = nB; ++ui;
#pragma unroll
        for (int h = 0; h < 2; ++h)
#pragma unroll
            for (int i = 0; i < 2; ++i) cO[h][i] = nO[h][i];
        if (wr == 1) PG8_BAR;
    }
    PG8_WAIT_V(0);
    PG8_BAR;
#undef PG8_SA
#undef PG8_SB
#undef PG8_STAGE
#undef PG8_STAGEA
#undef PG8_ROWOFF
#undef PG8_LDA
#undef PG8_LDB
#undef PG8_MMA
#undef PG8_WAIT_V
#undef PG8_WAIT_L
#undef PG8_BAR
#undef PG8_SCHED
}

template <bool I8> struct EpiStoreBf16 {
    static constexpr bool PERM = true;
    bf16_t* O; int ldc;
    static __device__ __forceinline__ f32x4 dq(f32x4 v) { if (I8) { const i32x4 q = __builtin_bit_cast(i32x4, v); return (f32x4){(float)q[0] * Q_DEQ, (float)q[1] * Q_DEQ, (float)q[2] * Q_DEQ, (float)q[3] * Q_DEQ}; } return v; }
    __device__ __forceinline__ void operator()(const f32x4 (&acc)[2][2][4][2], const Unit& u, int wr, int wc, int fr, int fq) const {
        const int row0 = u.pm * BM + wr * 64 + fr, col0 = u.pn * BM + wc * 32 + 8 * fq;
#pragma unroll
        for (int ai = 0; ai < 2; ++ai)
#pragma unroll
            for (int m = 0; m < 4; ++m) { bf16_t* rowp = O + (size_t)(row0 + ai * HALF + m * 16) * ldc + col0;
#pragma unroll
                for (int bj = 0; bj < 2; ++bj) { const f32x4 v0 = dq(acc[ai][bj][m][0]), v1 = dq(acc[ai][bj][m][1]);
                    u32x4 w; w.x = pk2(v0[0], v0[1]); w.y = pk2(v0[2], v0[3]); w.z = pk2(v1[0], v1[1]); w.w = pk2(v1[2], v1[3]);
                    *(u32x4*)(rowp + bj * HALF) = w; } }
    }
};
struct EpiResid {
    static constexpr bool PERM = true;
    bf16_t* Z; const bf16_t* H;
    static __device__ __forceinline__ f32x4 dq(f32x4 v) { const i32x4 q = __builtin_bit_cast(i32x4, v); return (f32x4){(float)q[0] * Q_DEQO, (float)q[1] * Q_DEQO, (float)q[2] * Q_DEQO, (float)q[3] * Q_DEQO}; }
    __device__ __forceinline__ void operator()(const f32x4 (&acc)[2][2][4][2], const Unit& u, int wr, int wc, int fr, int fq) const {
        const int row0 = u.pm * BM + wr * 64 + fr, col0 = u.pn * BM + wc * 32 + 8 * fq;
#pragma unroll
        for (int ai = 0; ai < 2; ++ai)
#pragma unroll
            for (int m = 0; m < 4; ++m) { const size_t ro = (size_t)(row0 + ai * HALF + m * 16) * DM + col0;
#pragma unroll
                for (int bj = 0; bj < 2; ++bj) { const f32x4 v0 = dq(acc[ai][bj][m][0]), v1 = dq(acc[ai][bj][m][1]);
                    const u32x4 hh = *(const u32x4*)(H + ro + bj * HALF);
                    u32x4 w;
                    w.x = pk2(ALPHA * bflo(hh.x) + v0[0], ALPHA * bfhi(hh.x) + v0[1]); w.y = pk2(ALPHA * bflo(hh.y) + v0[2], ALPHA * bfhi(hh.y) + v0[3]);
                    w.z = pk2(ALPHA * bflo(hh.z) + v1[0], ALPHA * bfhi(hh.z) + v1[1]); w.w = pk2(ALPHA * bflo(hh.w) + v1[2], ALPHA * bfhi(hh.w) + v1[3]);
                    *(u32x4*)(Z + ro + bj * HALF) = w; } }
    }
};
struct EpiF32 {
    static constexpr bool PERM = false;
    float* C;
    __device__ __forceinline__ void operator()(const f32x4 (&acc)[2][2][4][2], const Unit& u, int wr, int wc, int fr, int fq) const {
        const int row0 = u.pm * BM + wr * 64 + fr, col0 = wc * 32 + 4 * fq;
#pragma unroll
        for (int ai = 0; ai < 2; ++ai)
#pragma unroll
            for (int m = 0; m < 4; ++m) { float* rowp = C + (size_t)(row0 + ai * HALF + m * 16) * 256 + col0;
#pragma unroll
                for (int bj = 0; bj < 2; ++bj)
#pragma unroll
                    for (int n = 0; n < 2; ++n) *(f32x4*)(rowp + bj * HALF + n * 16) = acc[ai][bj][m][n]; }
    }
};
template <bool I8> struct EpiSwiGLU {
    static constexpr bool PERM = true;
    unsigned char* ACT; LAS unsigned char* sbuf;
    static __device__ __forceinline__ f32x4 dq(f32x4 v) { if (I8) { const i32x4 q = __builtin_bit_cast(i32x4, v); return (f32x4){(float)q[0] * Q_DEQ, (float)q[1] * Q_DEQ, (float)q[2] * Q_DEQ, (float)q[3] * Q_DEQ}; } return v; }
    __device__ __forceinline__ void operator()(const f32x4 (&acc)[2][2][4][2], const Unit& u, int wr, int wc, int fr, int fq) const {
        const int tid = threadIdx.x, rrow = tid >> 3, rchunk = tid & 7;
        const int wrow = wr * 16 + fr;
        unsigned char* abase = ACT + (size_t)(u.pm * BM) * 256 + (u.pn & 1) * 128 + rchunk * 16;
#pragma unroll
        for (int st = 0; st < 8; ++st) {
            const int ai = st >> 2, m = st & 3;
            LAS unsigned char* buf = sbuf + (st & 1) * 4096;
            const f32x4 g0 = dq(acc[ai][0][m][0]), g1 = dq(acc[ai][0][m][1]), u0 = dq(acc[ai][1][m][0]), u1 = dq(acc[ai][1][m][1]);
            u32x2 w;
            w.x = pk4(q8(silu(g0[0]) * u0[0], Q_SACT), q8(silu(g0[1]) * u0[1], Q_SACT), q8(silu(g0[2]) * u0[2], Q_SACT), q8(silu(g0[3]) * u0[3], Q_SACT));
            w.y = pk4(q8(silu(g1[0]) * u1[0], Q_SACT), q8(silu(g1[1]) * u1[1], Q_SACT), q8(silu(g1[2]) * u1[2], Q_SACT), q8(silu(g1[3]) * u1[3], Q_SACT));
            const int c16 = wc * 2 + (fq >> 1);
            *(LAS u32x2*)(buf + wrow * 128 + ((c16 ^ (wrow & 7)) << 4) + (fq & 1) * 8) = w;
            asm volatile("s_waitcnt lgkmcnt(0)" ::: "memory"); __builtin_amdgcn_s_barrier(); asm volatile("" ::: "memory");
            if (tid < 256) {
                const u32x4 rv = *(const LAS u32x4*)(buf + rrow * 128 + ((rchunk ^ (rrow & 7)) << 4));
                const int grow = ai * HALF + (rrow >> 4) * 64 + m * 16 + (rrow & 15);
                *(u32x4*)(abase + (size_t)grow * 256) = rv;
            }
        }
        asm volatile("s_waitcnt lgkmcnt(0)" ::: "memory"); __builtin_amdgcn_s_barrier(); asm volatile("" ::: "memory");
    }
};
template <int EV = 0> struct EpiDownT {
    static constexpr bool PERM = true;
    unsigned char* Y; LAS unsigned char* sbuf;
    __device__ __forceinline__ void operator()(const f32x4 (&acc)[2][2][4][2], const Unit& u, int wr, int wc, int fr, int fq) const {
        const int tid = threadIdx.x, rrow = tid >> 4, rchunk = tid & 15;
        const int wrow = wr * 16 + fr;
        unsigned char* ybase = Y + (size_t)(u.pm * BM) * DM + (u.pn & 3) * 256 + rchunk * 16;
#pragma unroll
        for (int st = 0; st < 8; ++st) {
            const int ai = st >> 2, m = st & 3;
            LAS unsigned char* buf = sbuf + (st & 1) * 8192;
#pragma unroll
            for (int bj = 0; bj < 2; ++bj) { const i32x4 q0 = __builtin_bit_cast(i32x4, acc[ai][bj][m][0]), q1 = __builtin_bit_cast(i32x4, acc[ai][bj][m][1]);
                const f32x4 v0 = (f32x4){(float)q0[0] * Q_DEQ2, (float)q0[1] * Q_DEQ2, (float)q0[2] * Q_DEQ2, (float)q0[3] * Q_DEQ2}, v1 = (f32x4){(float)q1[0] * Q_DEQ2, (float)q1[1] * Q_DEQ2, (float)q1[2] * Q_DEQ2, (float)q1[3] * Q_DEQ2};
                int p0 = __builtin_amdgcn_cvt_pk_fp8_f32(v0[0], v0[1], 0, false); p0 = __builtin_amdgcn_cvt_pk_fp8_f32(v0[2], v0[3], p0, true);
                int p1 = __builtin_amdgcn_cvt_pk_fp8_f32(v1[0], v1[1], 0, false); p1 = __builtin_amdgcn_cvt_pk_fp8_f32(v1[2], v1[3], p1, true);
                u32x2 w; w.x = (unsigned)p0; w.y = (unsigned)p1;
                const int c16 = bj * 8 + wc * 2 + (fq >> 1);
                *(LAS u32x2*)(buf + wrow * 256 + ((c16 ^ (wrow & 15)) << 4) + (fq & 1) * 8) = w; }
            asm volatile("s_waitcnt lgkmcnt(0)" ::: "memory"); __builtin_amdgcn_s_barrier(); asm volatile("" ::: "memory");
            const u32x4 rv = *(const LAS u32x4*)(buf + rrow * 256 + ((rchunk ^ (rrow & 15)) << 4));
            const int grow = ai * HALF + (rrow >> 4) * 64 + m * 16 + (rrow & 15);
            if (EV == 1) { asm volatile("" :: "v"(rv.x), "v"(rv.y), "v"(rv.z), "v"(rv.w)); } else *(u32x4*)(ybase + (size_t)grow * DM) = rv;
        }
        asm volatile("s_waitcnt lgkmcnt(0)" ::: "memory"); __builtin_amdgcn_s_barrier(); asm volatile("" ::: "memory");
    }
};
typedef EpiDownT<0> EpiDown;
}

struct Args { const float* in[22]; float* out; unsigned char* ws; int ph_lo, ph_hi; };
enum { I_X = 0, I_WINAB, I_WGKUP, I_BGK, I_HG, I_GG, I_WOAB, I_LB, I_WINC, I_CONV, I_BIF, I_WOC, I_WR, I_RB, I_WEI, I_WED, I_WSI, I_WSD, I_LMG, I_LMB, I_LFG, I_LFB };

constexpr int LDS_MISC = 147200;
constexpr int LDS_BYTES = 147456;

__device__ __forceinline__ void cvt_tile(LAS unsigned char* lds, const float* __restrict__ src, size_t ldn, int k0, int n0, bf16_t* __restrict__ dst, int K, int drow0) {
    const int t = threadIdx.x;
    { const int c4 = (t & 15) * 4, r2 = t >> 4;
      const f32x4 a = *(const f32x4*)(src + (size_t)(k0 + 2 * r2) * ldn + n0 + c4);
      const f32x4 b = *(const f32x4*)(src + (size_t)(k0 + 2 * r2 + 1) * ldn + n0 + c4);
#pragma unroll
      for (int i = 0; i < 4; ++i) *(LAS unsigned*)(lds + ((c4 + i) * 72 + 2 * r2) * 2) = pk2(a[i], b[i]); }
    __syncthreads();
    { const int kk = (t & 7) * 8, n = t >> 3;
      const u32x4 v = *(const LAS u32x4*)(lds + (n * 72 + kk) * 2);
      *(u32x4*)(dst + (size_t)(drow0 + n) * K + k0 + kk) = v; }
    __syncthreads();
}
template <int NT>
__device__ __forceinline__ void cvt_multi(LAS unsigned char* lds, const float* __restrict__ src, size_t ldn, int k0, int n0, bf16_t* __restrict__ dst, int K, const int (&drow)[NT], float sc = 1.f) {
    const int t = threadIdx.x;
    { const int c4 = (t & 15) * 4, r2 = t >> 4;
      f32x4 a[NT], b[NT];
#pragma unroll
      for (int q = 0; q < NT; ++q) { a[q] = __builtin_nontemporal_load((const f32x4*)(src + (size_t)(k0 + 2 * r2) * ldn + n0 + 64 * q + c4)); b[q] = __builtin_nontemporal_load((const f32x4*)(src + (size_t)(k0 + 2 * r2 + 1) * ldn + n0 + 64 * q + c4)); }
#pragma unroll
      for (int q = 0; q < NT; ++q)
#pragma unroll
          for (int i = 0; i < 4; ++i) *(LAS unsigned*)(lds + q * 9216 + ((c4 + i) * 72 + 2 * r2) * 2) = pk2(a[q][i] * sc, b[q][i] * sc); }
    __syncthreads();
    { const int kk = (t & 7) * 8, n = t >> 3;
#pragma unroll
      for (int q = 0; q < NT; ++q) { const u32x4 v = *(const LAS u32x4*)(lds + q * 9216 + (n * 72 + kk) * 2); *(u32x4*)(dst + (size_t)(drow[q] + n) * K + k0 + kk) = v; } }
    __syncthreads();
}
template <int NT>
__device__ __forceinline__ void cvt8_multi(LAS unsigned char* lds, const float* __restrict__ src, size_t ldn, int k0, int n0, unsigned char* __restrict__ dst, int Kb, const int (&drow)[NT], float sc) {
    const int t = threadIdx.x;
    { const int c4 = (t & 15) * 4, r4 = t >> 4;
      f32x4 a[NT][4];
#pragma unroll
      for (int q = 0; q < NT; ++q)
#pragma unroll
          for (int j = 0; j < 4; ++j) a[q][j] = __builtin_nontemporal_load((const f32x4*)(src + (size_t)(k0 + 4 * r4 + j) * ldn + n0 + 64 * q + c4));
#pragma unroll
      for (int q = 0; q < NT; ++q)
#pragma unroll
          for (int i = 0; i < 4; ++i) *(LAS unsigned*)(lds + q * 9216 + (c4 + i) * 144 + 4 * r4) = pk4(q8(a[q][0][i], sc), q8(a[q][1][i], sc), q8(a[q][2][i], sc), q8(a[q][3][i], sc)); }
    __syncthreads();
    { const int kk = (t & 7) * 16, n = t >> 3;
#pragma unroll
      for (int q = 0; q < NT; ++q) { const u32x4 v = *(const LAS u32x4*)(lds + q * 9216 + n * 144 + kk); *(u32x4*)(dst + (size_t)(drow[q] + n) * Kb + k0 + kk) = v; } }
    __syncthreads();
}
template <int NT>
__device__ __forceinline__ void cvt8_matrix(LAS unsigned char* lds, const float* src, size_t ldn, int K, int n_lo, int ncols, unsigned char* dst, int drow_lo, float sc, int bid, int nb) {
    const int tk = K / 128, tn = ncols / (64 * NT);
    for (int j = bid; j < tk * tn; j += nb) { const int a = j / tn, b = j % tn; int dr[NT];
#pragma unroll
        for (int q = 0; q < NT; ++q) dr[q] = drow_lo + (b * NT + q) * 64;
        cvt8_multi<NT>(lds, src, ldn, a * 128, n_lo + b * 64 * NT, dst, K, dr, sc); }
}
template <int NT>
__device__ __forceinline__ void cvt_matrix(LAS unsigned char* lds, const float* src, size_t ldn, int K, int n_lo, int ncols, bf16_t* dst, int drow_lo, int bid, int nb) {
    const int tk = K / 64, tn = ncols / (64 * NT);
    for (int j = bid; j < tk * tn; j += nb) { const int a = j / tn, b = j % tn; int dr[NT];
#pragma unroll
        for (int q = 0; q < NT; ++q) dr[q] = drow_lo + (b * NT + q) * 64;
        cvt_multi<NT>(lds, src, ldn, a * 64, n_lo + b * 64 * NT, dst, K, dr); }
}
__device__ __forceinline__ void phase_prologue(LAS unsigned char* lds, const Args& A, int bid, int nb) {
    unsigned char* ws = A.ws; const int tid = threadIdx.x;
    if (bid == 0) {
        float* lb0 = (float*)(ws + WS_MISC);
        const float* l = A.in[I_LB];
        if (tid < 512) { const float a = l[tid], b = l[512 + tid], c = l[1024 + tid]; const float m = fmaxf(a, fmaxf(b, c));
            const float ea = __expf(a - m), eb = __expf(b - m), ec = __expf(c - m); lb0[tid] = ea / (ea + eb + ec); }
    }
    if (bid == 1 % nb) {
        float* wg = (float*)(ws + WS_MISC + 4096);
        for (int i = tid; i < 8 * 1024; i += 512) { const int g = i >> 10, k = i & 1023; wg[i] = A.in[I_WINC][(size_t)k * 3080 + 3072 + g]; }
    }
    { const float* x = A.in[I_X]; bf16_t* hb = (bf16_t*)(ws + WS_HB); unsigned char* xq = ws + WS_XQ;
      const size_t step = (size_t)nb * 512 * 8;
      for (size_t i0 = ((size_t)bid * 512 + tid) * 8; i0 < (size_t)NTOK * DM; i0 += 4 * step) {
          f32x4 a[4], b[4];
#pragma unroll
          for (int u = 0; u < 4; ++u) { const size_t i = i0 + u * step; if (i < (size_t)NTOK * DM) { a[u] = __builtin_nontemporal_load((const f32x4*)(x + i)); b[u] = __builtin_nontemporal_load((const f32x4*)(x + i + 4)); } }
#pragma unroll
          for (int u = 0; u < 4; ++u) { const size_t i = i0 + u * step; if (i < (size_t)NTOK * DM) {
              u32x4 w; w.x = pk2(a[u][0], a[u][1]); w.y = pk2(a[u][2], a[u][3]); w.z = pk2(b[u][0], b[u][1]); w.w = pk2(b[u][2], b[u][3]);
              *(u32x4*)(hb + i) = w;
              u32x2 qv; qv.x = pk4(q8(a[u][0], Q_SA), q8(a[u][1], Q_SA), q8(a[u][2], Q_SA), q8(a[u][3], Q_SA)); qv.y = pk4(q8(b[u][0], Q_SA), q8(b[u][1], Q_SA), q8(b[u][2], Q_SA), q8(b[u][3], Q_SA));
              *(u32x2*)(xq + i) = qv; } } } }
    { unsigned char* wab = ws + WS_WAB; const float* win = A.in[I_WINAB]; const float* wup = A.in[I_WGKUP];
      for (int o = bid * 512 + tid; o < 256 * 64; o += nb * 512) { const int j = o >> 6, k16 = (o & 63) * 16;
          float up[16];
#pragma unroll
          for (int r = 0; r < 16; ++r) up[r] = wup[r * 256 + j];
          int res[16];
#pragma unroll
          for (int q = 0; q < 16; ++q) { const float* wr_ = win + (size_t)(k16 + q) * 3600 + 3584; float sm = 0.f;
#pragma unroll
              for (int r = 0; r < 16; ++r) sm += wr_[r] * up[r];
              res[q] = q8(sm, Q_SW); }
          u32x4 w; w.x = pk4(res[0], res[1], res[2], res[3]); w.y = pk4(res[4], res[5], res[6], res[7]); w.z = pk4(res[8], res[9], res[10], res[11]); w.w = pk4(res[12], res[13], res[14], res[15]);
          *(u32x4*)(wab + (size_t)(3584 + j) * 1024 + k16) = w; } }
    cvt8_matrix<4>(lds, A.in[I_WINAB], 3600, 1024, 0, 3584, ws + WS_WAB, 0, Q_SW, bid, nb);
    cvt8_matrix<4>(lds, A.in[I_WOAB], 1024, 1024, 0, 1024, ws + WS_WOAB, 0, Q_SWO, bid, nb);
    cvt8_matrix<4>(lds, A.in[I_WINC], 3080, 1024, 0, 3072, ws + WS_WC, 0, Q_SW, bid, nb);
    cvt8_matrix<4>(lds, A.in[I_WOC], 1024, 1024, 0, 1024, ws + WS_WOC, 0, Q_SWO, bid, nb);
    cvt_matrix<4>(lds, A.in[I_WR], 256, 1024, 0, 256, (bf16_t*)(ws + WS_WR), 0, bid, nb);
    cvt_matrix<4>(lds, A.in[I_WR] + 1024 * 256, 256, 1024, 0, 256, (bf16_t*)(ws + WS_WR) + 256 * 1024, 0, bid, nb);
}
__device__ __forceinline__ void convert_experts(LAS unsigned char* lds, const Args& A, int layer, int bid, int nb, int part) {
    unsigned char* ws = A.ws;
    int kk = 0;
    for (int j = bid; j < NE1 * 16; j += nb, ++kk) {
        if (((kk % 5) < 3) != (part == 0)) continue;
        const int e = j % NE1, t0 = j / NE1;
        const int t = (t0 < 8) ? 2 * t0 : 8 + t0;
        if (t < 16) {
            const float* src = (e < NEXP) ? A.in[I_WEI] + ((size_t)(layer * NEXP + e)) * 1024 * 512 : A.in[I_WSI] + (size_t)layer * 1024 * 512;
            unsigned char* dst = ws + WS_W1T + ((size_t)(layer * NE1 + e)) * 512 * 1024;
            const int tk = t >> 1;
            int dr[8];
#pragma unroll
            for (int q = 0; q < 8; ++q) { const int n0 = q * 64, gq = n0 >> 8, nn = n0 & 255; dr[q] = (nn >> 7) * 256 + gq * 128 + (nn & 127); }
            cvt8_multi<8>(lds, src, 512, tk * 128, 0, dst, 1024, dr, Q_SW);
        } else {
            const int t2 = t - 16, tk = t2 >> 2, g4 = t2 & 3;
            const float* src = (e < NEXP) ? A.in[I_WED] + ((size_t)(layer * NEXP + e)) * 256 * 1024 : A.in[I_WSD] + (size_t)layer * 256 * 1024;
            unsigned char* dst = ws + WS_W2T + ((size_t)(layer * NE1 + e)) * 1024 * 256;
            int dr[4];
#pragma unroll
            for (int q = 0; q < 4; ++q) dr[q] = g4 * 256 + q * 64;
            cvt8_multi<4>(lds, src, 1024, tk * 128, g4 * 256, dst, 256, dr, Q_SW);
        }
    }
}

__device__ __forceinline__ void phase_ln(const bf16_t* __restrict__ Z, bf16_t* __restrict__ H, unsigned char* __restrict__ HQ, const float* __restrict__ g, const float* __restrict__ b, int bid, int nb) {
    const int lane = threadIdx.x & 63, gw = bid * 8 + (threadIdx.x >> 6), nw = nb * 8;
    float gg[16], bb[16];
#pragma unroll
    for (int i = 0; i < 8; ++i) { gg[i] = g[lane * 8 + i]; gg[8 + i] = g[512 + lane * 8 + i]; bb[i] = b[lane * 8 + i]; bb[8 + i] = b[512 + lane * 8 + i]; }
    for (int row = gw; row < NTOK; row += nw) {
        const u32x4 a = *(const u32x4*)(Z + (size_t)row * DM + lane * 8), c = *(const u32x4*)(Z + (size_t)row * DM + 512 + lane * 8);
        float v[16];
        v[0] = bflo(a.x); v[1] = bfhi(a.x); v[2] = bflo(a.y); v[3] = bfhi(a.y); v[4] = bflo(a.z); v[5] = bfhi(a.z); v[6] = bflo(a.w); v[7] = bfhi(a.w);
        v[8] = bflo(c.x); v[9] = bfhi(c.x); v[10] = bflo(c.y); v[11] = bfhi(c.y); v[12] = bflo(c.z); v[13] = bfhi(c.z); v[14] = bflo(c.w); v[15] = bfhi(c.w);
        float s = 0.f;
#pragma unroll
        for (int i = 0; i < 16; ++i) s += v[i];
#pragma unroll
        for (int o = 32; o > 0; o >>= 1) s += __shfl_xor(s, o);
        const float mu = s * (1.f / 1024.f);
        float q = 0.f;
#pragma unroll
        for (int i = 0; i < 16; ++i) { const float d = v[i] - mu; q += d * d; }
#pragma unroll
        for (int o = 32; o > 0; o >>= 1) q += __shfl_xor(q, o);
        const float rs = rsqrtf(q * (1.f / 1024.f) + 1e-5f);
        float y[16];
#pragma unroll
        for (int i = 0; i < 16; ++i) y[i] = (v[i] - mu) * rs * gg[i] + bb[i];
        u32x4 w0, w1; w0.x = pk2(y[0], y[1]); w0.y = pk2(y[2], y[3]); w0.z = pk2(y[4], y[5]); w0.w = pk2(y[6], y[7]);
        w1.x = pk2(y[8], y[9]); w1.y = pk2(y[10], y[11]); w1.z = pk2(y[12], y[13]); w1.w = pk2(y[14], y[15]);
        *(u32x4*)(H + (size_t)row * DM + lane * 8) = w0; *(u32x4*)(H + (size_t)row * DM + 512 + lane * 8) = w1;
        u32x2 q0, q1;
        q0.x = pk4(q8(y[0], Q_SA), q8(y[1], Q_SA), q8(y[2], Q_SA), q8(y[3], Q_SA)); q0.y = pk4(q8(y[4], Q_SA), q8(y[5], Q_SA), q8(y[6], Q_SA), q8(y[7], Q_SA));
        q1.x = pk4(q8(y[8], Q_SA), q8(y[9], Q_SA), q8(y[10], Q_SA), q8(y[11], Q_SA)); q1.y = pk4(q8(y[12], Q_SA), q8(y[13], Q_SA), q8(y[14], Q_SA), q8(y[15], Q_SA));
        *(u32x2*)(HQ + (size_t)row * DM + lane * 8) = q0; *(u32x2*)(HQ + (size_t)row * DM + 512 + lane * 8) = q1;
    }
}

template <bool FINAL>
__device__ __forceinline__ void phase_combine(const unsigned char* __restrict__ Y, const int* __restrict__ posy, const float* __restrict__ tokw, const int* __restrict__ ntiles,
                                              const bf16_t* __restrict__ H1, bf16_t* __restrict__ H2, unsigned char* __restrict__ H2Q, float* __restrict__ OUT, float* __restrict__ GATES,
                                              const float* __restrict__ wgate, const float* __restrict__ g, const float* __restrict__ b, int bid, int nb) {
    const int shbase = (*ntiles - NTOK / 256) * 256;
    const int lane = threadIdx.x & 63, gw = bid * 8 + (threadIdx.x >> 6), nw = nb * 8;
    int npos = 0; float nwk = 0.f;
    if (gw < NTOK) { npos = (lane < 8) ? posy[(size_t)gw * 8 + lane] : shbase + gw; nwk = (lane < 8) ? tokw[(size_t)gw * 8 + lane] : 1.0f; }
    for (int row = gw; row < NTOK; row += nw) {
        const int cpos = npos; const float cwk = nwk;
        { const int nr = row + nw; if (nr < NTOK) { npos = (lane < 8) ? posy[(size_t)nr * 8 + lane] : shbase + nr; nwk = (lane < 8) ? tokw[(size_t)nr * 8 + lane] : 1.0f; } }
        float v[16];
        { const u32x4 a = *(const u32x4*)(H1 + (size_t)row * DM + lane * 8), c = *(const u32x4*)(H1 + (size_t)row * DM + 512 + lane * 8);
          v[0] = bflo(a.x); v[1] = bfhi(a.x); v[2] = bflo(a.y); v[3] = bfhi(a.y); v[4] = bflo(a.z); v[5] = bfhi(a.z); v[6] = bflo(a.w); v[7] = bfhi(a.w);
          v[8] = bflo(c.x); v[9] = bfhi(c.x); v[10] = bflo(c.y); v[11] = bfhi(c.y); v[12] = bflo(c.z); v[13] = bfhi(c.z); v[14] = bflo(c.w); v[15] = bfhi(c.w); }
#pragma unroll
        for (int i = 0; i < 16; ++i) v[i] *= ALPHA;
        u32x2 ya[NSLOT], yc[NSLOT]; float wks[NSLOT];
#pragma unroll
        for (int k = 0; k < NSLOT; ++k) {
            const int pos = __builtin_amdgcn_readlane(cpos, k); wks[k] = __uint_as_float(__builtin_amdgcn_readlane(__float_as_uint(cwk), k)) * 0.0625f;
            const unsigned char* yr = Y + (size_t)pos * DM;
            ya[k] = *(const u32x2*)(yr + lane * 8); yc[k] = *(const u32x2*)(yr + 512 + lane * 8);
        }
        typedef float f32x2_ __attribute__((ext_vector_type(2)));
#pragma unroll
        for (int k = 0; k < NSLOT; ++k) {
            const float wk = wks[k];
            const f32x2_ a0 = __builtin_amdgcn_cvt_pk_f32_fp8((int)ya[k].x, false), a1 = __builtin_amdgcn_cvt_pk_f32_fp8((int)ya[k].x, true), a2 = __builtin_amdgcn_cvt_pk_f32_fp8((int)ya[k].y, false), a3 = __builtin_amdgcn_cvt_pk_f32_fp8((int)ya[k].y, true);
            const f32x2_ c0 = __builtin_amdgcn_cvt_pk_f32_fp8((int)yc[k].x, false), c1 = __builtin_amdgcn_cvt_pk_f32_fp8((int)yc[k].x, true), c2 = __builtin_amdgcn_cvt_pk_f32_fp8((int)yc[k].y, false), c3 = __builtin_amdgcn_cvt_pk_f32_fp8((int)yc[k].y, true);
            v[0] += wk * a0.x; v[1] += wk * a0.y; v[2] += wk * a1.x; v[3] += wk * a1.y; v[4] += wk * a2.x; v[5] += wk * a2.y; v[6] += wk * a3.x; v[7] += wk * a3.y;
            v[8] += wk * c0.x; v[9] += wk * c0.y; v[10] += wk * c1.x; v[11] += wk * c1.y; v[12] += wk * c2.x; v[13] += wk * c2.y; v[14] += wk * c3.x; v[15] += wk * c3.y;
        }
        float s = 0.f;
#pragma unroll
        for (int i = 0; i < 16; ++i) s += v[i];
#pragma unroll
        for (int o = 32; o > 0; o >>= 1) s += __shfl_xor(s, o);
        const float mu = s * (1.f / 1024.f);
        float q = 0.f;
#pragma unroll
        for (int i = 0; i < 16; ++i) { const float d = v[i] - mu; q += d * d; }
#pragma unroll
        for (int o = 32; o > 0; o >>= 1) q += __shfl_xor(q, o);
        const float rs = rsqrtf(q * (1.f / 1024.f) + 1e-5f);
        float y[16];
#pragma unroll
        for (int i = 0; i < 8; ++i) { y[i] = (v[i] - mu) * rs * g[lane * 8 + i] + b[lane * 8 + i]; y[8 + i] = (v[8 + i] - mu) * rs * g[512 + lane * 8 + i] + b[512 + lane * 8 + i]; }
        if (FINAL) {
            float* o = OUT + (size_t)row * DM;
            *(f32x4*)(o + lane * 8) = (f32x4){y[0], y[1], y[2], y[3]}; *(f32x4*)(o + lane * 8 + 4) = (f32x4){y[4], y[5], y[6], y[7]};
            *(f32x4*)(o + 512 + lane * 8) = (f32x4){y[8], y[9], y[10], y[11]}; *(f32x4*)(o + 512 + lane * 8 + 4) = (f32x4){y[12], y[13], y[14], y[15]};
        } else {
            u32x4 w0, w1; w0.x = pk2(y[0], y[1]); w0.y = pk2(y[2], y[3]); w0.z = pk2(y[4], y[5]); w0.w = pk2(y[6], y[7]);
            w1.x = pk2(y[8], y[9]); w1.y = pk2(y[10], y[11]); w1.z = pk2(y[12], y[13]); w1.w = pk2(y[14], y[15]);
            *(u32x4*)(H2 + (size_t)row * DM + lane * 8) = w0; *(u32x4*)(H2 + (size_t)row * DM + 512 + lane * 8) = w1;
            { u32x2 q0, q1;
              q0.x = pk4(q8(y[0], Q_SA), q8(y[1], Q_SA), q8(y[2], Q_SA), q8(y[3], Q_SA)); q0.y = pk4(q8(y[4], Q_SA), q8(y[5], Q_SA), q8(y[6], Q_SA), q8(y[7], Q_SA));
              q1.x = pk4(q8(y[8], Q_SA), q8(y[9], Q_SA), q8(y[10], Q_SA), q8(y[11], Q_SA)); q1.y = pk4(q8(y[12], Q_SA), q8(y[13], Q_SA), q8(y[14], Q_SA), q8(y[15], Q_SA));
              *(u32x2*)(H2Q + (size_t)row * DM + lane * 8) = q0; *(u32x2*)(H2Q + (size_t)row * DM + 512 + lane * 8) = q1; }
            float yr[16];
            yr[0] = bflo(w0.x); yr[1] = bfhi(w0.x); yr[2] = bflo(w0.y); yr[3] = bfhi(w0.y); yr[4] = bflo(w0.z); yr[5] = bfhi(w0.z); yr[6] = bflo(w0.w); yr[7] = bfhi(w0.w);
            yr[8] = bflo(w1.x); yr[9] = bfhi(w1.x); yr[10] = bflo(w1.y); yr[11] = bfhi(w1.y); yr[12] = bflo(w1.z); yr[13] = bfhi(w1.z); yr[14] = bflo(w1.w); yr[15] = bfhi(w1.w);
            float gsum = 0.f;
#pragma unroll
            for (int gi = 0; gi < 8; ++gi) {
                const float* wp = wgate + gi * 1024; float d = 0.f;
#pragma unroll
                for (int i = 0; i < 8; ++i) d += yr[i] * wp[lane * 8 + i] + yr[8 + i] * wp[512 + lane * 8 + i];
#pragma unroll
                for (int o = 32; o > 0; o >>= 1) d += __shfl_xor(d, o);
                gsum = (lane == gi) ? d : gsum;
            }
            if (lane < 8) GATES[(size_t)row * 8 + lane] = gsum;
        }
    }
}

#ifndef VARSEL
#define VARSEL 0
#endif
template <bool DRY>
__device__ __forceinline__ void phase_select(LAS unsigned char* lds, const float* __restrict__ logits, const float* __restrict__ rbias, int* __restrict__ tok_e, int* __restrict__ tok_p,
                                             float* __restrict__ tok_w, unsigned* __restrict__ cnt, int bid, int nb) {
    const int tid = threadIdx.x, it = tid & 63, g8 = tid >> 6;
    LAS unsigned* hist = (LAS unsigned*)lds;
    LAS unsigned* base = hist + 256;
    LAS int* selE = (LAS int*)(base + 256);
    LAS int* selR = selE + 1024;
    LAS float* gsl = (LAS float*)(lds + 10240);
    LAS float* lv = (LAS float*)(lds + 12288);
    LAS int* le = (LAS int*)(lds + 28672);
    LAS float* sb = (LAS float*)(lds + 45056);
    const int tpw = NTOK / nb;
    const int t0 = bid * tpw;
    const float NEG = -3.0e38f;
    if (tid < 256) hist[tid] = 0u;
    __syncthreads();
    for (int half = 0; half < tpw / 64; ++half) {
        const int tb = t0 + half * 64;
        {
            const int e = tid & 255, tk0 = tid >> 8; const float rb = rbias[e];
#pragma unroll
            for (int i0 = 0; i0 < 32; i0 += 8) { float lv8[8];
#pragma unroll
                for (int u = 0; u < 8; ++u) lv8[u] = logits[(size_t)(tb + tk0 + 2 * (i0 + u)) * 256 + e];
#pragma unroll
                for (int u = 0; u < 8; ++u) sb[e * 65 + tk0 + 2 * (i0 + u)] = sigm(lv8[u]) + rb; }
        }
        __syncthreads();
        {
            float m1 = NEG, m2 = NEG;
            for (int j = 0; j < 32; ++j) { const float v = sb[(g8 * 32 + j) * 65 + it]; if (v > m1) { m2 = m1; m1 = v; } else if (v > m2) m2 = v; }
            gsl[g8 * 64 + it] = m1 + m2;
        }
        __syncthreads();
        if (DRY && VARSEL == 1) { __syncthreads(); continue; }
        float G[8];
#pragma unroll
        for (int q = 0; q < 8; ++q) G[q] = gsl[q * 64 + it];
        unsigned selmask = 0u;
#pragma unroll
        for (int g = 0; g < 8; ++g) { int rank = 0;
#pragma unroll
            for (int q = 0; q < 8; ++q) rank += (G[q] > G[g] || (G[q] == G[g] && q < g)) ? 1 : 0;
            if (rank < 4) selmask |= 1u << g; }
        if ((selmask >> g8) & 1u) {
            float vv[32];
#pragma unroll
            for (int j = 0; j < 32; ++j) vv[j] = sb[(g8 * 32 + j) * 65 + it];
#pragma unroll
            for (int k = 0; k < 8; ++k) {
                float bv = vv[0]; int bj = 0;
#pragma unroll
                for (int j = 1; j < 32; ++j) { const bool gt = vv[j] > bv; bv = gt ? vv[j] : bv; bj = gt ? j : bj; }
#pragma unroll
                for (int j = 0; j < 32; ++j) vv[j] = (j == bj) ? NEG : vv[j];
                lv[(g8 * 8 + k) * 64 + it] = bv; le[(g8 * 8 + k) * 64 + it] = g8 * 32 + bj;
            }
        }
        __syncthreads();
        if (DRY && VARSEL == 2) { __syncthreads(); continue; }
        if (tid < 64) {
            int gid[4]; { int n = 0;
#pragma unroll
                for (int g = 0; g < 8; ++g) if ((selmask >> g) & 1u) { if (n == 0) gid[0] = g; else if (n == 1) gid[1] = g; else if (n == 2) gid[2] = g; else gid[3] = g; ++n; } }
            float hv[4]; int hp[4];
#pragma unroll
            for (int j = 0; j < 4; ++j) { hp[j] = 0; hv[j] = lv[(gid[j] * 8) * 64 + it]; }
            float sc8[8]; int te[8]; float tot = 0.f;
#pragma unroll
            for (int k = 0; k < 8; ++k) {
                int bj = 0; float bv = hv[0];
                if (hv[1] > bv) { bv = hv[1]; bj = 1; }
                if (hv[2] > bv) { bv = hv[2]; bj = 2; }
                if (hv[3] > bv) { bv = hv[3]; bj = 3; }
                const int gsel = (bj == 0) ? gid[0] : (bj == 1) ? gid[1] : (bj == 2) ? gid[2] : gid[3];
                const int psel = (bj == 0) ? hp[0] : (bj == 1) ? hp[1] : (bj == 2) ? hp[2] : hp[3];
                const int e = le[(gsel * 8 + psel) * 64 + it];
                te[k] = e; sc8[k] = bv - rbias[e]; tot += sc8[k];
                const float nv = (psel < 7) ? lv[(gsel * 8 + psel + 1) * 64 + it] : NEG;
                if (bj == 0) { hv[0] = nv; hp[0] = psel + 1; } else if (bj == 1) { hv[1] = nv; hp[1] = psel + 1; } else if (bj == 2) { hv[2] = nv; hp[2] = psel + 1; } else { hv[3] = nv; hp[3] = psel + 1; }
            }
            const float inv = 2.5f / tot;
            const int tok = tb + it, lt = half * 64 + it;
#pragma unroll
            for (int k = 0; k < 8; ++k) {
                tok_e[(size_t)tok * 8 + k] = te[k]; tok_w[(size_t)tok * 8 + k] = sc8[k] * inv;
                const unsigned r = atomicAdd((unsigned*)&hist[te[k]], 1u);
                selE[lt * 8 + k] = te[k]; selR[lt * 8 + k] = (int)r;
            }
        }
        __syncthreads();
    }
    if (DRY) return;
    if (tid < 256) { const unsigned c = hist[tid]; base[tid] = c ? __hip_atomic_fetch_add(cnt + tid, c, __ATOMIC_RELAXED, __HIP_MEMORY_SCOPE_AGENT) : 0u; }
    __syncthreads();
    for (int i = tid; i < tpw * 8; i += 512) tok_p[(size_t)t0 * 8 + i] = (int)base[selE[i]] + selR[i];
    __syncthreads();
}

__device__ __forceinline__ void phase_dispatch(LAS unsigned char* lds, const unsigned* __restrict__ cnt, const int* __restrict__ tok_e, const int* __restrict__ tok_p,
                                               int* __restrict__ s_tok, int* __restrict__ posy, int* __restrict__ tile_exp, int* __restrict__ ntiles, int bid, int nb) {
    const int tid = threadIdx.x;
    LAS int* tstart = (LAS int*)lds;
    LAS int* tcnt = tstart + 260;
    if (tid < 256) tcnt[tid] = (int)((__hip_atomic_load(cnt + tid, __ATOMIC_RELAXED, __HIP_MEMORY_SCOPE_AGENT) + 255u) >> 8);
    __syncthreads();
    if (tid < 256) { int a = 0;
#pragma unroll 16
        for (int j = 0; j < 256; ++j) { const int c = tcnt[j]; a += (j < tid) ? c : 0; }
        tstart[tid] = a; if (tid == 255) tstart[256] = a + tcnt[255]; }
    __syncthreads();
    const int TT = tstart[256];
    const int tpw = NTOK / nb, t0 = bid * tpw;
    for (int i = tid; i < tpw * 8; i += 512) {
        const size_t a = (size_t)t0 * 8 + i; const int e = tok_e[a], p = tok_p[a];
        const int pos = tstart[e] * 256 + p;
        s_tok[pos] = (int)(a >> 3); posy[a] = pos;
    }
    for (int i = tid; i < tpw; i += 512) { const int tok = t0 + i; s_tok[TT * 256 + tok] = tok; }
    for (int e = bid; e < 256; e += nb) {
        const int c = (int)__hip_atomic_load(cnt + e, __ATOMIC_RELAXED, __HIP_MEMORY_SCOPE_AGENT), ts = tstart[e], tc = tcnt[e];
        for (int i = c + tid; i < tc * 256; i += 512) s_tok[ts * 256 + i] = 0;
        for (int i = tid; i < tc; i += 512) tile_exp[ts + i] = e;
    }
    if (bid == 0) { for (int i = tid; i < NTOK / 256; i += 512) tile_exp[TT + i] = 256; if (tid == 0) *ntiles = TT + NTOK / 256; }
    __syncthreads();
}

constexpr int MX_QT = 0, MX_KT = 17408, MX_KHT = 34816, MX_VT = 53248, MX_P = 73984, MX_ST = 83200, MX_SEG = 122368, MX_GD = 126464, MX_ER = 126976, MX_RS = 127488, MX_DEN = 128000, MX_BC = 128256, MX_IP = 128512, MX_GT = 128768;
struct MixP {
    const bf16_t* proj; int ldp; int pad0; unsigned char* ymix; const float* gates;
    const float* lb0; const float* bgk; const float* hg; const float* gg; const float* conv; const float* bif;
    float* ust; float* gsum;
};
#define MFMA16(a, b, c) __builtin_amdgcn_mfma_f32_16x16x32_bf16((a), (b), (c), 0, 0, 0)

template <int MODE, bool FULL, int VAR = 0>
__device__ __forceinline__ void mixer_run(LAS unsigned char* lds, const MixP& mp, int bid) {
    constexpr int DK = (MODE == 1) ? 64 : 128, QP = DK + 8, CP = DK / 2, RG = 512 / CP, RPT = 64 / RG, KS = DK / 32;
    constexpr int NVT = (MODE == 2) ? 9 : 8;
    constexpr int NST = (DK == 128) ? NVT : 4;
    const int tid = threadIdx.x, lane = tid & 63, w = __builtin_amdgcn_readfirstlane(tid >> 6), l15 = lane & 15, l4 = lane >> 4;
    int b, h, vh = 0, seg;
    if (MODE == 0) { const int sq = bid >> 4; b = sq >> 2; h = sq & 3; seg = bid & 15; }
    else if (MODE == 1) { const int sq = (bid - 128) >> 4; b = sq >> 2; h = sq & 3; seg = bid & 15; }
    else { const int sq = bid >> 4; b = sq >> 3; h = (sq >> 1) & 3; vh = sq & 1; seg = bid & 15; }
    const int tok0 = b * SEQ + seg * 1024;
    const int ldp = mp.ldp; const bf16_t* proj = mp.proj;
    int cq, ck, cv, cg, cy;
    if (MODE == 0) { cq = h * 128; ck = 512 + h * 128; cv = 1024 + h * 128; cg = 1536 + h * 128; cy = h * 128; }
    else if (MODE == 1) { cq = 2048 + h * 64; ck = 2304 + h * 64; cv = 2560 + h * 128; cg = 3072 + h * 128; cy = 512 + h * 128; }
    else { cq = h * 128; ck = 512 + h * 128; cv = 1024 + h * 256 + vh * 128; cg = 2048 + h * 256 + vh * 128; cy = h * 256 + vh * 128; }
    const int cu = 3584 + h * 64;
    const int cp = tid % CP, rg = tid / CP, d0 = 2 * cp;
    float lbv[2] = {0.f, 0.f}, oml[2] = {0.f, 0.f}, bgk[2] = {0.f, 0.f}, cwq[4][2], cwk[4][2];
    if (MODE == 0) { lbv[0] = mp.lb0[h * 128 + d0]; lbv[1] = mp.lb0[h * 128 + d0 + 1]; oml[0] = 1.f - lbv[0]; oml[1] = 1.f - lbv[1]; }
    if (MODE == 1) { bgk[0] = mp.bgk[h * 64 + d0]; bgk[1] = mp.bgk[h * 64 + d0 + 1]; }
#pragma unroll
    for (int j = 0; j < 4; ++j) { cwq[j][0] = cwq[j][1] = cwk[j][0] = cwk[j][1] = 0.f; }
    if (MODE == 2) {
#pragma unroll
        for (int j = 0; j < 4; ++j) { cwq[j][0] = mp.conv[j * 1024 + cq + d0]; cwq[j][1] = mp.conv[j * 1024 + cq + d0 + 1]; cwk[j][0] = mp.conv[j * 1024 + ck + d0]; cwk[j][1] = mp.conv[j * 1024 + ck + d0 + 1]; }
    }
    const float bi = (MODE == 2) ? mp.bif[h] : 0.f, bfg = (MODE == 2) ? mp.bif[4 + h] : 0.f;
    const int sdt = (DK == 128) ? w : (w & 3), svt0 = (DK == 128) ? 0 : 4 * (w >> 2);
    f32x4 S[NST];
#pragma unroll
    for (int t = 0; t < NST; ++t) S[t] = (f32x4){0.f, 0.f, 0.f, 0.f};
    float gacc[2] = {(MODE == 2) ? 0.f : 1.f, (MODE == 2) ? 0.f : 1.f};
    if (MODE == 2) {
        for (int i = tid; i < 16 * 72; i += 512) { const int r = i / 72; *(LAS bf16_t*)(lds + MX_VT + ((128 + r) * 72 + (i % 72)) * 2) = (r == 0) ? (bf16_t)0x3F80 : (bf16_t)0; }
    }
    if (FULL) {
        const int bid0 = bid & ~15;
#pragma unroll 2
        for (int j = 0; j < seg; ++j) {
            const float* U = mp.ust + ((size_t)(bid0 + j) * 8 + w) * (9 * 4 * 64);
            float dec[4];
            if (MODE == 2) { const float gsv = mp.gsum[(size_t)(bid0 + j) * 128]; dec[0] = dec[1] = dec[2] = dec[3] = __expf(gsv); }
            else {
#pragma unroll
                for (int r = 0; r < 4; ++r) dec[r] = mp.gsum[(size_t)(bid0 + j) * 128 + sdt * 16 + 4 * l4 + r];
            }
            f32x4 uu[NST];
#pragma unroll
            for (int t = 0; t < NST; ++t)
#pragma unroll
                for (int r = 0; r < 4; ++r) uu[t][r] = U[(t * 4 + r) * 64 + lane];
#pragma unroll
            for (int t = 0; t < NST; ++t)
#pragma unroll
                for (int r = 0; r < 4; ++r) S[t][r] = dec[r] * S[t][r] + uu[t][r];
        }
    }
    const int sj = w & 3, ovh = w >> 2, srow = 16 * sj + l15;
    const int vp = tid & 63, r0v = (tid >> 6) * 8;
    unsigned ra[RPT + 3], rb[RPT + 3], rc[RPT], pv[8]; u32x2 gnx[4]; float sgi = 0.f, sgf = 0.f;
#pragma unroll
    for (int i = 0; i < RPT + 3; ++i) { ra[i] = 0u; rb[i] = 0u; }
#pragma unroll
    for (int i = 0; i < RPT; ++i) rc[i] = 0u;
#pragma unroll
    for (int t = 0; t < 4; ++t) gnx[t] = (u32x2){0u, 0u};
#define MX_LOAD(cn) do { const int tokn_ = tok0 + (cn) * 64; \
        if (VAR == 1 || VAR == 3 || VAR == 4) { _Pragma("unroll") for (int i = 0; i < RPT + 3; ++i) { ra[i] = 0x3c003c00u + (unsigned)(cn); rb[i] = 0x3c003c00u; } _Pragma("unroll") for (int i = 0; i < RPT; ++i) rc[i] = 0x3c003c00u; _Pragma("unroll") for (int i = 0; i < 8; ++i) pv[i] = 0x3c003c00u; _Pragma("unroll") for (int t = 0; t < 4; ++t) gnx[t] = (u32x2){0x3c003c00u, 0x3c003c00u}; sgi = 0.1f; sgf = 3.f; } else \
        if (MODE == 2) { const int tl0_ = seg * 1024 + (cn) * 64 + rg * RPT; \
            _Pragma("unroll") for (int i = 0; i < RPT + 3; ++i) { const int tl_ = tl0_ - 3 + i; \
                if (tl_ >= 0) { const bf16_t* pr_ = proj + (size_t)(b * SEQ + tl_) * ldp; if (FULL) ra[i] = *(const unsigned*)(pr_ + cq + d0); rb[i] = *(const unsigned*)(pr_ + ck + d0); } \
                else { ra[i] = 0u; rb[i] = 0u; } } \
            if (w == 0) { const float* gp_ = mp.gates + (size_t)(tokn_ + lane) * 8; sgi = gp_[h]; sgf = gp_[4 + h]; } \
        } else { \
            _Pragma("unroll") for (int i = 0; i < RPT; ++i) { const bf16_t* pr_ = proj + (size_t)(tokn_ + rg * RPT + i) * ldp; \
                if (MODE == 0) { ra[i] = *(const unsigned*)(pr_ + ck + d0); if (FULL) rb[i] = *(const unsigned*)(pr_ + cq + d0); } \
                else { ra[i] = *(const unsigned*)(pr_ + cu + d0); rb[i] = *(const unsigned*)(pr_ + ck + d0); if (FULL) rc[i] = *(const unsigned*)(pr_ + cq + d0); } } \
        } \
        _Pragma("unroll") for (int i = 0; i < 8; ++i) pv[i] = *(const unsigned*)(proj + (size_t)(tokn_ + r0v + i) * ldp + cv + 2 * vp); \
        if (FULL) { _Pragma("unroll") for (int t = 0; t < 4; ++t) gnx[t] = *(const u32x2*)(proj + (size_t)(tokn_ + srow) * ldp + cg + 16 * (4 * ovh + t) + 4 * l4); } \
    } while (0)
    float gnv[4][4];
#pragma unroll
    for (int t = 0; t < 4; ++t)
#pragma unroll
        for (int r = 0; r < 4; ++r) gnv[t][r] = (FULL && MODE != 2) ? ((MODE == 0) ? mp.hg : mp.gg)[h * 128 + 16 * (4 * ovh + t) + 4 * l4 + r] : 1.f;
    MX_LOAD(0);
    __syncthreads();
    for (int c = 0; c < 16; ++c) {
        const int tokc = tok0 + c * 64;
        float la[RPT][2], sp[RPT][2], qv[RPT][2], kv[RPT][2];
        u32x2 gcur[4];
        if (VAR == 4) {
#pragma unroll
            for (int t = 0; t < 4; ++t) gcur[t] = gnx[t];
            __syncthreads(); __syncthreads(); goto stepC; }
#pragma unroll
        for (int t = 0; t < 4; ++t) gcur[t] = gnx[t];
        if (MODE == 2) {
            if (w == 0) {
                const float ip = sgi + bi, lf = logsig(sgf + bfg);
                float cs = lf;
#pragma unroll
                for (int o = 1; o < 64; o <<= 1) { const float t = __shfl_up(cs, o); if (lane >= o) cs += t; }
                *(LAS float*)(lds + MX_BC + lane * 4) = cs; *(LAS float*)(lds + MX_IP + lane * 4) = ip - cs;
                if (lane == 63) *(LAS float*)(lds + MX_GT) = cs;
            }
#pragma unroll
            for (int i = 0; i < RPT; ++i)
#pragma unroll
                for (int e = 0; e < 2; ++e) {
                    float aq = 0.f, ak = 0.f;
#pragma unroll
                    for (int j = 0; j < 4; ++j) { aq += cwq[j][e] * (e ? bfhi(ra[i + j]) : bflo(ra[i + j])); ak += cwk[j][e] * (e ? bfhi(rb[i + j]) : bflo(rb[i + j])); }
                    qv[i][e] = silu(aq); kv[i][e] = silu(ak) * 0.08838834764831845f; la[i][e] = 0.f; sp[i][e] = 0.f;
                }
        } else {
#pragma unroll
            for (int i = 0; i < RPT; ++i) {
                if (MODE == 0) {
                    const unsigned uz = ra[i];
                    const float s0 = sigm(bflo(uz)), s1 = sigm(bfhi(uz));
                    la[i][0] = lbv[0] + oml[0] * s0; la[i][1] = lbv[1] + oml[1] * s1;
                    kv[i][0] = oml[0] - oml[0] * s0; kv[i][1] = oml[1] - oml[1] * s1;
                    if (FULL) { const unsigned uq = rb[i]; qv[i][0] = silu(bflo(uq)); qv[i][1] = silu(bfhi(uq)); } else { qv[i][0] = qv[i][1] = 0.f; }
                } else {
                    const unsigned uu = ra[i], uk = rb[i];
                    la[i][0] = __expf(logsig(bflo(uu) + bgk[0]) * 0.0625f); la[i][1] = __expf(logsig(bfhi(uu) + bgk[1]) * 0.0625f);
                    kv[i][0] = bflo(uk); kv[i][1] = bfhi(uk);
                    if (FULL) { const unsigned uq = rc[i]; qv[i][0] = bflo(uq) * 0.125f; qv[i][1] = bfhi(uq) * 0.125f; } else { qv[i][0] = qv[i][1] = 0.f; }
                }
            }
#pragma unroll
            for (int e = 0; e < 2; ++e) {
                float run = 1.f;
#pragma unroll
                for (int i = RPT - 1; i >= 0; --i) { sp[i][e] = run; run *= la[i][e]; }
                run = 1.f;
#pragma unroll
                for (int i = 0; i < RPT; ++i) { run *= la[i][e]; la[i][e] = run; }
            }
            *(LAS float*)(lds + MX_SEG + (rg * DK + d0) * 4) = la[RPT - 1][0]; *(LAS float*)(lds + MX_SEG + (rg * DK + d0 + 1) * 4) = la[RPT - 1][1];
        }
        {
            u32x4 lo, hi;
            lo.x = (pv[0] & 0xffffu) | (pv[1] << 16); lo.y = (pv[2] & 0xffffu) | (pv[3] << 16); lo.z = (pv[4] & 0xffffu) | (pv[5] << 16); lo.w = (pv[6] & 0xffffu) | (pv[7] << 16);
            hi.x = (pv[0] >> 16) | (pv[1] & 0xffff0000u); hi.y = (pv[2] >> 16) | (pv[3] & 0xffff0000u); hi.z = (pv[4] >> 16) | (pv[5] & 0xffff0000u); hi.w = (pv[6] >> 16) | (pv[7] & 0xffff0000u);
            *(LAS u32x4*)(lds + MX_VT + ((2 * vp) * 72 + r0v) * 2) = lo; *(LAS u32x4*)(lds + MX_VT + ((2 * vp + 1) * 72 + r0v) * 2) = hi;
        }
        if (c + 1 < 16) MX_LOAD(c + 1);
        if (VAR == 2) { unsigned xa = 0; _Pragma("unroll") for (int i = 0; i < RPT + 3; ++i) xa ^= ra[i] ^ rb[i]; _Pragma("unroll") for (int i = 0; i < RPT; ++i) xa ^= rc[i]; _Pragma("unroll") for (int i = 0; i < 8; ++i) xa ^= pv[i];
            _Pragma("unroll") for (int t = 0; t < 4; ++t) xa ^= gnx[t].x ^ gnx[t].y; gacc[0] += (float)(xa & 1u) + sgi + sgf; continue; }
        __syncthreads();
        {
            float pre[2], h2[2], gt[2];
            if (MODE == 2) {
                const float g = *(LAS float*)(lds + MX_GT);
                gt[0] = gt[1] = g; h2[0] = h2[1] = 0.f; pre[0] = pre[1] = 0.f;
                if (tid == 0) gacc[0] += g;
            } else {
#pragma unroll
                for (int e = 0; e < 2; ++e) { float p = 1.f, a1 = 1.f, a2 = 1.f;
#pragma unroll
                    for (int j = 0; j < RG; ++j) { const float v = *(LAS float*)(lds + MX_SEG + (j * DK + d0 + e) * 4);
                        if (j < RG / 2) a1 *= v; else a2 *= v;
                        const bool inb = (rg >= RG / 2) ? (j >= RG / 2 && j < rg) : (j > rg && j < RG / 2);
                        p *= inb ? v : 1.f; }
                    pre[e] = p; h2[e] = a2; gt[e] = a1 * a2;
                    if (rg == 0) { gacc[e] *= gt[e]; *(LAS float*)(lds + MX_GD + (d0 + e) * 4) = gt[e]; *(LAS float*)(lds + MX_ER + (d0 + e) * 4) = a1; } }
            }
            float kh[RPT][2];
#pragma unroll
            for (int i = 0; i < RPT; ++i) {
                const int s = rg * RPT + i;
                float qs[2], ks[2];
                if (MODE == 2) {
                    const float bc = *(LAS float*)(lds + MX_BC + s * 4), ipb = *(LAS float*)(lds + MX_IP + s * 4);
                    const float eq = __expf(bc), ek = __expf(ipb), eg = __expf(gt[0]);
                    qs[0] = qv[i][0] * eq; qs[1] = qv[i][1] * eq; ks[0] = kv[i][0] * ek; ks[1] = kv[i][1] * ek; kh[i][0] = ks[0] * eg; kh[i][1] = ks[1] * eg;
                } else {
#pragma unroll
                    for (int e = 0; e < 2; ++e) {
                        const float cd = pre[e] * ((rg >= RG / 2) ? la[i][e] : sp[i][e]);
                        const float rc_ = __builtin_amdgcn_rcpf(cd);
                        const float qm = (rg >= RG / 2) ? cd : rc_, km = (rg >= RG / 2) ? rc_ : cd;
                        qs[e] = qv[i][e] * qm; ks[e] = kv[i][e] * km; kh[i][e] = ks[e] * h2[e]; }
                }
                if (FULL) { *(LAS unsigned*)(lds + MX_QT + (s * QP + d0) * 2) = pk2(qs[0], qs[1]); *(LAS unsigned*)(lds + MX_KT + (s * QP + d0) * 2) = pk2(ks[0], ks[1]); }
            }
            if (RPT == 8) {
                u32x4 a, bq;
                a.x = pk2(kh[0][0], kh[1][0]); a.y = pk2(kh[2][0], kh[3][0]); a.z = pk2(kh[4 % RPT][0], kh[5 % RPT][0]); a.w = pk2(kh[6 % RPT][0], kh[7 % RPT][0]);
                bq.x = pk2(kh[0][1], kh[1][1]); bq.y = pk2(kh[2][1], kh[3][1]); bq.z = pk2(kh[4 % RPT][1], kh[5 % RPT][1]); bq.w = pk2(kh[6 % RPT][1], kh[7 % RPT][1]);
                *(LAS u32x4*)(lds + MX_KHT + (d0 * 72 + rg * 8) * 2) = a; *(LAS u32x4*)(lds + MX_KHT + ((d0 + 1) * 72 + rg * 8) * 2) = bq;
            } else {
                u32x2 a, bq;
                a.x = pk2(kh[0][0], kh[1][0]); a.y = pk2(kh[2][0], kh[3][0]); bq.x = pk2(kh[0][1], kh[1][1]); bq.y = pk2(kh[2][1], kh[3][1]);
                *(LAS u32x2*)(lds + MX_KHT + (d0 * 72 + rg * 4) * 2) = a; *(LAS u32x2*)(lds + MX_KHT + ((d0 + 1) * 72 + rg * 4) * 2) = bq;
            }
        }
        __syncthreads();
        stepC:
        if (FULL && VAR != 3) {
#pragma unroll
            for (int tt = 0; tt < 2; ++tt) {
                const int tile = 2 * w + tt, ti = tile >> 2, tj = tile & 3;
                f32x4 acc = (f32x4){0.f, 0.f, 0.f, 0.f};
                if (ti <= tj) {
#pragma unroll
                    for (int kk = 0; kk < KS; ++kk) {
                        const bf16x8 a = *(const LAS bf16x8*)(lds + MX_KT + ((16 * ti + l15) * QP + kk * 32 + 8 * l4) * 2);
                        const bf16x8 bq = *(const LAS bf16x8*)(lds + MX_QT + ((16 * tj + l15) * QP + kk * 32 + 8 * l4) * 2);
                        acc = MFMA16(a, bq, acc);
                    }
                }
                const int s = 16 * tj + l15, sp0 = 16 * ti + 4 * l4;
                float pvv[4];
#pragma unroll
                for (int r = 0; r < 4; ++r) pvv[r] = (sp0 + r <= s) ? acc[r] : 0.f;
                u32x2 pw; pw.x = pk2(pvv[0], pvv[1]); pw.y = pk2(pvv[2], pvv[3]);
                *(LAS u32x2*)(lds + MX_P + (s * 72 + sp0) * 2) = pw;
            }
            {
                float er[4];
#pragma unroll
                for (int r = 0; r < 4; ++r) er[r] = (MODE == 2) ? 1.f : *(LAS float*)(lds + MX_ER + (sdt * 16 + 4 * l4 + r) * 4);
#pragma unroll
                for (int t = 0; t < NST; ++t) {
                    const int v = 16 * (svt0 + t) + l15;
                    u32x2 sw; sw.x = pk2(S[t][0] * er[0], S[t][1] * er[1]); sw.y = pk2(S[t][2] * er[2], S[t][3] * er[3]);
                    *(LAS u32x2*)(lds + MX_ST + (v * QP + sdt * 16 + 4 * l4) * 2) = sw;
                }
            }
            {
                float dec[4];
                if (MODE == 2) { const float eg = __expf(*(LAS float*)(lds + MX_GT)); dec[0] = dec[1] = dec[2] = dec[3] = eg; }
                else {
    #pragma unroll
                    for (int r = 0; r < 4; ++r) dec[r] = *(LAS float*)(lds + MX_GD + (sdt * 16 + 4 * l4 + r) * 4);
                }
                bf16x8 ka[2];
    #pragma unroll
                for (int kk = 0; kk < 2; ++kk) ka[kk] = *(const LAS bf16x8*)(lds + MX_KHT + ((16 * sdt + l15) * 72 + kk * 32 + 8 * l4) * 2);
    #pragma unroll
                for (int t = 0; t < NST; ++t) {
    #pragma unroll
                    for (int r = 0; r < 4; ++r) S[t][r] *= dec[r];
    #pragma unroll
                    for (int kk = 0; kk < 2; ++kk) {
                        const bf16x8 vb = *(const LAS bf16x8*)(lds + MX_VT + ((16 * (svt0 + t) + l15) * 72 + kk * 32 + 8 * l4) * 2);
                        S[t] = MFMA16(ka[kk], vb, S[t]);
                    }
                }
            }
            __syncthreads();
            constexpr int NOT = (MODE == 2) ? 5 : 4;
            f32x4 O[NOT];
#pragma unroll
            for (int t = 0; t < NOT; ++t) O[t] = (f32x4){0.f, 0.f, 0.f, 0.f};
#pragma unroll
            for (int kk = 0; kk < 2; ++kk) {
                const bf16x8 bq = *(const LAS bf16x8*)(lds + MX_P + ((16 * sj + l15) * 72 + kk * 32 + 8 * l4) * 2);
#pragma unroll
                for (int t = 0; t < NOT; ++t) { const int vt = (t < 4) ? (4 * ovh + t) : 8;
                    if (t < 4 || ovh == 0) { const bf16x8 a = *(const LAS bf16x8*)(lds + MX_VT + ((16 * vt + l15) * 72 + kk * 32 + 8 * l4) * 2); O[t] = MFMA16(a, bq, O[t]); } }
            }
#pragma unroll
            for (int kk = 0; kk < KS; ++kk) {
                const bf16x8 bq = *(const LAS bf16x8*)(lds + MX_QT + ((16 * sj + l15) * QP + kk * 32 + 8 * l4) * 2);
#pragma unroll
                for (int t = 0; t < NOT; ++t) { const int vt = (t < 4) ? (4 * ovh + t) : 8;
                    if (t < 4 || ovh == 0) { const bf16x8 a = *(const LAS bf16x8*)(lds + MX_ST + ((16 * vt + l15) * QP + kk * 32 + 8 * l4) * 2); O[t] = MFMA16(a, bq, O[t]); } }
            }
            const int tokr = tokc + srow;
            float scale;
            if (MODE == 2) {
                if (ovh == 0 && l4 == 0) *(LAS float*)(lds + MX_DEN + srow * 4) = O[NOT - 1][0];
                __syncthreads();
                const float den = *(LAS float*)(lds + MX_DEN + srow * 4);
                scale = 1.f / fmaxf(fabsf(den), 1.f);
            } else {
                float ss = 0.f;
#pragma unroll
                for (int t = 0; t < 4; ++t)
#pragma unroll
                    for (int r = 0; r < 4; ++r) ss += O[t][r] * O[t][r];
                ss += __shfl_xor(ss, 16); ss += __shfl_xor(ss, 32);
                if (l4 == 0) *(LAS float*)(lds + MX_RS + (ovh * 64 + srow) * 4) = ss;
                __syncthreads();
                const float tot = *(LAS float*)(lds + MX_RS + srow * 4) + *(LAS float*)(lds + MX_RS + (64 + srow) * 4);
                scale = rsqrtf(tot * (1.f / 128.f) + 1e-6f);
            }
#pragma unroll
            for (int t = 0; t < 4; ++t) {
                const int v0 = 16 * (4 * ovh + t) + 4 * l4;
                const u32x2 gt = gcur[t];
                const float g0 = bflo(gt.x), g1 = bfhi(gt.x), g2 = bflo(gt.y), g3 = bfhi(gt.y);
                float y0, y1, y2, y3;
                if (MODE == 2) { y0 = O[t][0] * scale * sigm(g0); y1 = O[t][1] * scale * sigm(g1); y2 = O[t][2] * scale * sigm(g2); y3 = O[t][3] * scale * sigm(g3); }
                else { y0 = O[t][0] * scale * gnv[t][0] * silu(g0); y1 = O[t][1] * scale * gnv[t][1] * silu(g1); y2 = O[t][2] * scale * gnv[t][2] * silu(g2); y3 = O[t][3] * scale * gnv[t][3] * silu(g3); }
                *(LAS unsigned*)(lds + MX_P + srow * 128 + ((((v0 >> 4)) ^ (srow & 7)) << 4) + (v0 & 15)) = pk4(q8(y0, Q_SY), q8(y1, Q_SY), q8(y2, Q_SY), q8(y3, Q_SY));
            }
            __syncthreads();
            { const int yr = tid >> 3, yc = tid & 7;
              const u32x4 yv = *(const LAS u32x4*)(lds + MX_P + yr * 128 + ((yc ^ (yr & 7)) << 4));
              *(u32x4*)(mp.ymix + (size_t)(tokc + yr) * DM + cy + yc * 16) = yv; }
        }
        if (!FULL || VAR == 3) {
            {
                float dec[4];
                if (MODE == 2) { const float eg = __expf(*(LAS float*)(lds + MX_GT)); dec[0] = dec[1] = dec[2] = dec[3] = eg; }
                else {
    #pragma unroll
                    for (int r = 0; r < 4; ++r) dec[r] = *(LAS float*)(lds + MX_GD + (sdt * 16 + 4 * l4 + r) * 4);
                }
                bf16x8 ka[2];
    #pragma unroll
                for (int kk = 0; kk < 2; ++kk) ka[kk] = *(const LAS bf16x8*)(lds + MX_KHT + ((16 * sdt + l15) * 72 + kk * 32 + 8 * l4) * 2);
    #pragma unroll
                for (int t = 0; t < NST; ++t) {
    #pragma unroll
                    for (int r = 0; r < 4; ++r) S[t][r] *= dec[r];
    #pragma unroll
                    for (int kk = 0; kk < 2; ++kk) {
                        const bf16x8 vb = *(const LAS bf16x8*)(lds + MX_VT + ((16 * (svt0 + t) + l15) * 72 + kk * 32 + 8 * l4) * 2);
                        S[t] = MFMA16(ka[kk], vb, S[t]);
                    }
                }
            }
        __syncthreads();
        }
    }
#undef MX_LOAD
    if (VAR == 2) { mp.ust[(size_t)bid * 512 + tid] = gacc[0]; return; }
    if (!FULL) {
        float* U = mp.ust + ((size_t)bid * 8 + w) * (9 * 4 * 64);
#pragma unroll
        for (int t = 0; t < NST; ++t)
#pragma unroll
            for (int r = 0; r < 4; ++r) U[(t * 4 + r) * 64 + lane] = S[t][r];
        if (MODE == 2) { if (tid == 0) mp.gsum[(size_t)bid * 128] = gacc[0]; }
        else if (rg == 0) { mp.gsum[(size_t)bid * 128 + d0] = gacc[0]; mp.gsum[(size_t)bid * 128 + d0 + 1] = gacc[1]; }
    }
}

#ifndef PHMASK
#define PHMASK 0xFFFFu
#endif
#ifndef MIXSEL
#define MIXSEL 7
#endif
#ifndef REPMASK
#define REPMASK 0x0u
#endif
#define EN(j) (((PHMASK) >> (j)) & 1u)
#ifndef REPLAYER
#define REPLAYER 3
#endif
#define NREP(j) (1 + (int)((((REPMASK) >> (j)) & 1u) & (((REPLAYER) >> layer) & 1u)))
#define IN(k) (lo <= (k) && (k) < hi)
#define SEAM(k) do { if (IN((k) + 1)) xcd_barrier(bar); } while (0)

template <int layer> __device__ __forceinline__ void ph_proj(LAS unsigned char* lds, unsigned char* ws, int bid, int nb) {
    pg8::Gemm g{(const bf16_t*)(ws + (layer ? WS_H2Q : WS_XQ)), (const bf16_t*)(ws + (layer ? WS_WC : WS_WAB)), DM / 2};
    pg8::StaticOrder S; S.init(NTOK, layer ? CWID : ABW, nb, bid);
    pg8::EpiStoreBf16<true> E{(bf16_t*)(ws + WS_PROJ), layer ? CWID : ABW};
    pg8::gemm_phase<pg8::EpiStoreBf16<true>, pg8::StaticOrder, false, true>(lds, g, nullptr, S, E);
}
template <int layer> __device__ __forceinline__ void ph_outproj(LAS unsigned char* lds, unsigned char* ws, int bid, int nb) {
    pg8::Gemm g{(const bf16_t*)(ws + WS_YMIX), (const bf16_t*)(ws + (layer ? WS_WOC : WS_WOAB)), DM / 2};
    pg8::StaticOrder S; S.init(NTOK, DM, nb, bid);
    pg8::EpiResid E{(bf16_t*)(ws + WS_Z), (const bf16_t*)(ws + (layer ? WS_H2 : WS_HB))};
    pg8::gemm_phase<pg8::EpiResid, pg8::StaticOrder, false, true>(lds, g, nullptr, S, E);
}
template <int layer> __device__ __forceinline__ void ph_router(LAS unsigned char* lds, unsigned char* ws, int bid, int nb) {
    pg8::Gemm g{(const bf16_t*)(ws + WS_H1), (const bf16_t*)(ws + WS_WR) + (size_t)layer * 256 * 1024, DM};
    pg8::StaticOrder S; S.init(NTOK, 256, nb, bid);
    pg8::EpiF32 E{(float*)(ws + WS_LOGITS)};
    pg8::gemm_phase<pg8::EpiF32, pg8::StaticOrder, false>(lds, g, nullptr, S, E);
}
template <int layer> __device__ __forceinline__ void ph_gemm1(LAS unsigned char* lds, unsigned char* ws, int bid, int nb) {
    const int vcu = (nb % 8 == 0) ? (bid % 8) * (nb / 8) + bid / 8 : bid;
    const int nt = __builtin_amdgcn_readfirstlane(*(volatile int*)(ws + WS_MISC + 65536 + 8192));
    pg8::Gemm g{(const bf16_t*)(ws + WS_H1Q), (const bf16_t*)(ws + WS_W1T + (size_t)layer * NE1 * 512 * 1024), DM / 2};
    const int nu = pg8::moe_prep(lds, (const int*)(ws + WS_MISC + 65536), nt * 2, 1, nb, vcu, (const int*)(ws + WS_STOK));
    pg8::MoeOrder S{(const LAS int*)(lds + pg8::LDS_UT), nu < pg8::MOE_MAXU ? nu : pg8::MOE_MAXU};
    pg8::EpiSwiGLU<true> E{ws + WS_ACT, lds + 3 * pg8::HTB};
    pg8::gemm_phase<pg8::EpiSwiGLU<true>, pg8::MoeOrder, true, true>(lds, g, (const LAS int*)(lds + pg8::LDS_IDX), S, E);
}
template <int layer> __device__ __forceinline__ void ph_gemm2(LAS unsigned char* lds, unsigned char* ws, int bid, int nb) {
    const int vcu = (nb % 8 == 0) ? (bid % 8) * (nb / 8) + bid / 8 : bid;
    const int nt = __builtin_amdgcn_readfirstlane(*(volatile int*)(ws + WS_MISC + 65536 + 8192));
    int kq = 128; asm volatile("" : "+s"(kq));
    pg8::Gemm g{(const bf16_t*)(ws + WS_ACT), (const bf16_t*)(ws + WS_W2T + (size_t)layer * NE1 * 1024 * 256), kq};
    const int nu = pg8::moe_prep(lds, (const int*)(ws + WS_MISC + 65536), nt * 4, 2, nb, vcu, nullptr);
    pg8::MoeOrder S{(const LAS int*)(lds + pg8::LDS_UT), nu};
    pg8::EpiDown E{(unsigned char*)(ws + WS_Y), lds + 3 * pg8::HTB};
    pg8::gemm_phase<pg8::EpiDown, pg8::MoeOrder, false, true>(lds, g, nullptr, S, E);
#ifndef EXPG
#define EXPG 0
#endif
#if EXPG
    { __syncthreads(); pg8::EpiDownT<EXPG - 1> E2{(unsigned char*)(ws + WS_PROJ), lds + 3 * pg8::HTB};
      pg8::gemm_phase<pg8::EpiDownT<EXPG - 1>, pg8::MoeOrder, false, true>(lds, g, nullptr, S, E2); }
#endif
}
template <int layer, bool FULLP> __device__ __forceinline__ void ph_mixer(LAS unsigned char* lds, const Args& A, int bid, int nb) {
    unsigned char* ws = A.ws;
    if (nb != NWG) return;
    MixP mp{(const bf16_t*)(ws + WS_PROJ), layer ? CWID : ABW, 0, ws + WS_YMIX, (const float*)(ws + WS_GATES), (const float*)(ws + WS_MISC), A.in[I_BGK], A.in[I_HG], A.in[I_GG], A.in[I_CONV], A.in[I_BIF], (float*)(ws + WS_UST), (float*)(ws + WS_GSUM)};
    if (layer == 0) { if (bid < 128) { if (MIXSEL & 1) mixer_run<0, FULLP>(lds, mp, bid); } else { if (MIXSEL & 2) mixer_run<1, FULLP>(lds, mp, bid); } }
    else { if (MIXSEL & 4) mixer_run<2, FULLP>(lds, mp, bid); }
#ifndef EXPV
#define EXPV 0
#endif
#ifndef EXPL
#define EXPL 0
#endif
#if EXPV
    if (FULLP && layer == EXPL) { MixP md = mp; md.ymix = (bf16_t*)(ws + WS_Z); md.ust = (float*)(ws + WS_LOGITS); md.gsum = (float*)(ws + WS_LOGITS + 24 * MiB);
        __syncthreads();
        if (layer == 0) { if (bid < 128) mixer_run<0, true, EXPV>(lds, md, bid); else mixer_run<1, true, EXPV>(lds, md, bid); }
        else mixer_run<2, true, EXPV>(lds, md, bid); }
#endif
}
#define REP2(j, call) do { call; if (NREP(j) == 2) { __syncthreads(); call; } } while (0)

template <int layer>
__device__ __forceinline__ void run_layer(LAS unsigned char* lds, const Args& A, const XcdBarrier& bar, const int lo, const int hi) {
    const int bid = blockIdx.x, nb = gridDim.x;
    unsigned char* ws = A.ws;
    unsigned* ctl = (unsigned*)(ws + WS_CTL);
    constexpr int P = 1 + layer * 11;
    if (EN(0) && IN(P + 0)) {
        if (bid & 1) convert_experts(lds, A, layer, bid, nb, layer);
        REP2(0, ph_proj<layer>(lds, ws, bid, nb));
        if (!(bid & 1)) convert_experts(lds, A, layer, bid, nb, layer);
        SEAM(P + 0); }
    if (EN(1) && IN(P + 1)) { REP2(1, (ph_mixer<layer, false>(lds, A, bid, nb))); SEAM(P + 1); }
    if (EN(2) && IN(P + 2)) { REP2(2, (ph_mixer<layer, true>(lds, A, bid, nb))); SEAM(P + 2); }
    if (EN(3) && IN(P + 3)) {
        if (layer == 0 && (bid & 1)) convert_experts(lds, A, 0, bid, nb, 1);
        REP2(3, ph_outproj<layer>(lds, ws, bid, nb));
        if (layer == 0 && !(bid & 1)) convert_experts(lds, A, 0, bid, nb, 1);
        SEAM(P + 3); }
    if (EN(4) && IN(P + 4)) { REP2(4, phase_ln((const bf16_t*)(ws + WS_Z), (bf16_t*)(ws + WS_H1), ws + WS_H1Q, A.in[I_LMG] + layer * DM, A.in[I_LMB] + layer * DM, bid, nb)); SEAM(P + 4); }
    if (EN(5) && IN(P + 5)) { REP2(5, ph_router<layer>(lds, ws, bid, nb)); SEAM(P + 5); }
    if (EN(6) && IN(P + 6)) {
        phase_select<false>(lds, (const float*)(ws + WS_LOGITS), A.in[I_RB] + layer * NEXP, (int*)(ws + WS_TOKE), (int*)(ws + WS_TOKP), (float*)(ws + WS_TOKW), ctl + CW_CNT + layer * 256, bid, nb);
        if (NREP(6) == 2) phase_select<true>(lds, (const float*)(ws + WS_LOGITS), A.in[I_RB] + layer * NEXP, (int*)(ws + WS_TOKE), (int*)(ws + WS_TOKP), (float*)(ws + WS_TOKW), ctl + CW_CNT + layer * 256, bid, nb);
        SEAM(P + 6); }
    if (EN(7) && IN(P + 7)) { REP2(7, phase_dispatch(lds, ctl + CW_CNT + layer * 256, (const int*)(ws + WS_TOKE), (const int*)(ws + WS_TOKP), (int*)(ws + WS_STOK), (int*)(ws + WS_POSY), (int*)(ws + WS_MISC + 65536), (int*)(ws + WS_MISC + 65536 + 8192), bid, nb)); SEAM(P + 7); }
    if (EN(8) && IN(P + 8)) {
        if (layer == 0 && (bid & 1)) convert_experts(lds, A, 1, bid, nb, 0);
        REP2(8, ph_gemm1<layer>(lds, ws, bid, nb));
        if (layer == 0 && !(bid & 1)) convert_experts(lds, A, 1, bid, nb, 0);
        SEAM(P + 8); }
    if (EN(9) && IN(P + 9)) { REP2(9, ph_gemm2<layer>(lds, ws, bid, nb)); SEAM(P + 9); }
    if (EN(10) && IN(P + 10)) {
        if (layer == 0) REP2(10, (phase_combine<false>((const unsigned char*)(ws + WS_Y), (const int*)(ws + WS_POSY), (const float*)(ws + WS_TOKW), (const int*)(ws + WS_MISC + 65536 + 8192), (const bf16_t*)(ws + WS_H1), (bf16_t*)(ws + WS_H2), ws + WS_H2Q, nullptr, (float*)(ws + WS_GATES), (const float*)(ws + WS_MISC + 4096), A.in[I_LFG], A.in[I_LFB], bid, nb)));
        else REP2(10, (phase_combine<true>((const unsigned char*)(ws + WS_Y), (const int*)(ws + WS_POSY), (const float*)(ws + WS_TOKW), (const int*)(ws + WS_MISC + 65536 + 8192), (const bf16_t*)(ws + WS_H1), nullptr, nullptr, A.out, nullptr, nullptr, A.in[I_LFG] + DM, A.in[I_LFB] + DM, bid, nb)));
        SEAM(P + 10);
    }
}

__global__ void __launch_bounds__(512, 2) fwd_kernel(Args A) {
    extern __shared__ __attribute__((aligned(16))) unsigned char lds_raw[];
    LAS unsigned char* lds = (LAS unsigned char*)lds_raw;
    const int tid = threadIdx.x;
    unsigned* ctl = (unsigned*)(A.ws + WS_CTL);
    volatile LAS unsigned* misc = (volatile LAS unsigned*)(lds + LDS_MISC);
    if (tid < 64) misc[tid] = 0u;
    __syncthreads();
    const int lo = A.ph_lo, hi = A.ph_hi;
    XcdBarrier bar; bar.bar = ctl + CW_BAR; bar.x = 0; bar.st = misc;
    if (hi - lo > 1) bar = xcd_barrier_post(ctl + CW_BAR, misc);
    if (EN(11) && IN(0)) { for (int rep_ = 0; rep_ < 1 + (int)(((REPMASK) >> 11) & 1u); ++rep_) phase_prologue(lds, A, blockIdx.x, gridDim.x); SEAM(0); }
    run_layer<0>(lds, A, bar, lo, hi);
    run_layer<1>(lds, A, bar, lo, hi);
}
#undef IN
#undef SEAM

#ifdef DBG
__device__ __forceinline__ unsigned hash32(unsigned x) { x ^= x >> 16; x *= 0x7feb352dU; x ^= x >> 15; x *= 0x846ca68bU; x ^= x >> 16; return x; }
__device__ __forceinline__ void dbg_acc(float* w, int stage, float num, float den) { if (!(num == num) || num > 1e30f) num = 1e30f; atomicAdd(w + 2 * stage, num); atomicAdd(w + 2 * stage + 1, den); }
__device__ __forceinline__ float bfr(float x) { return bflo(pk2(x, 0.f)); }
__global__ void dbg_weights(Args A, float* w) {
    const unsigned i = blockIdx.x * 256 + threadIdx.x; unsigned char* ws = A.ws;
    float num = 0.f, den = 0.f;
    { const unsigned hsh = hash32(i * 4 + 0), col = hsh % 3584, k = (hsh >> 12) % 1024; const float r = A.in[I_WINAB][(size_t)k * 3600 + col], g = bf2f(((const bf16_t*)(ws + WS_WAB))[(size_t)col * 1024 + k]); num += (r - g) * (r - g); den += r * r; }
    { const unsigned hsh = hash32(i * 4 + 1), j = hsh % 256, k = (hsh >> 12) % 1024; float r = 0.f; for (int q = 0; q < 16; ++q) r += A.in[I_WINAB][(size_t)k * 3600 + 3584 + q] * A.in[I_WGKUP][q * 256 + j];
      const float g = bf2f(((const bf16_t*)(ws + WS_WAB))[(size_t)(3584 + j) * 1024 + k]); num += (r - g) * (r - g); den += r * r; }
    { const unsigned hsh = hash32(i * 4 + 2), le = hsh % 514, layer = le / 257, e = le % 257, n = (hsh >> 10) % 512, k = (hsh >> 20) % 1024;
      const float r = (e < 256) ? A.in[I_WEI][((size_t)(layer * 256 + e) * 1024 + k) * 512 + n] : A.in[I_WSI][((size_t)layer * 1024 + k) * 512 + n];
      const unsigned up = n >> 8, c = n & 255, drow = (c >> 7) * 256 + up * 128 + (c & 127);
      const float g = bf2f(((const bf16_t*)(ws + WS_W1T))[((size_t)(layer * 257 + e) * 512 + drow) * 1024 + k]); num += (r - g) * (r - g); den += r * r; }
    { const unsigned hsh = hash32(i * 4 + 3), le = hsh % 514, layer = le / 257, e = le % 257, n = (hsh >> 10) % 1024, k = (hsh >> 20) % 256;
      const float r = (e < 256) ? A.in[I_WED][((size_t)(layer * 256 + e) * 256 + k) * 1024 + n] : A.in[I_WSD][((size_t)layer * 256 + k) * 1024 + n];
      const float g = bf2f(((const bf16_t*)(ws + WS_W2T))[((size_t)(layer * 257 + e) * 1024 + n) * 256 + k]); num += (r - g) * (r - g); den += r * r; }
    dbg_acc(w, 1, num, den);
}
__global__ void dbg_gemm(const bf16_t* Am, int K, const bf16_t* Bt, const void* out, int ldo, int out_f32, int nrows, int ncols, float* w, int stage) {
    const unsigned i = blockIdx.x * 256 + threadIdx.x; const unsigned hsh = hash32(i + 77u * stage), row = hsh % nrows, col = (hsh >> 11) % ncols;
    float r = 0.f; for (int k = 0; k < K; ++k) r += bf2f(Am[(size_t)row * K + k]) * bf2f(Bt[(size_t)col * K + k]);
    const float g = out_f32 ? ((const float*)out)[(size_t)row * ldo + col] : bf2f(((const bf16_t*)out)[(size_t)row * ldo + col]);
    dbg_acc(w, stage, (r - g) * (r - g), r * r);
}
template <int MODE> __global__ void __launch_bounds__(256, 1) dbg_mixer(MixP mp, int b, int h, int T, float* w, int stage) {
    constexpr int DK = (MODE == 1) ? 64 : 128, DV = (MODE == 2) ? 256 : 128;
    __shared__ float sq[128], sk[128], sa[128], red[256], sh_i, sh_f;
    const int tid = threadIdx.x;
    const int ldp = mp.ldp; const bf16_t* proj = mp.proj;
    int cq, ck, cv, cg, cy, cu = 3584 + h * 64;
    if (MODE == 0) { cq = h * 128; ck = 512 + h * 128; cv = 1024 + h * 128; cg = 1536 + h * 128; cy = h * 128; }
    else if (MODE == 1) { cq = 2048 + h * 64; ck = 2304 + h * 64; cv = 2560 + h * 128; cg = 3072 + h * 128; cy = 512 + h * 128; }
    else { cq = h * 128; ck = 512 + h * 128; cv = 1024 + h * 256; cg = 2048 + h * 256; cy = h * 256; }
    float S[DK];
#pragma unroll
    for (int d = 0; d < DK; ++d) S[d] = 0.f;
    float nst = 0.f, num = 0.f, den = 0.f;
    for (int t = 0; t < T; ++t) {
        const size_t tok = (size_t)b * SEQ + t; const bf16_t* pr = proj + tok * ldp;
        if (tid < DK) {
            const int d = tid;
            if (MODE == 0) { const float z = bf2f(pr[ck + d]), sg = 1.f / (1.f + expf(-z)), lb = mp.lb0[h * 128 + d]; sa[d] = lb + (1.f - lb) * sg; sk[d] = (1.f - lb) * (1.f - sg); const float qq = bf2f(pr[cq + d]); sq[d] = qq / (1.f + expf(-qq)); }
            else if (MODE == 1) { const float u = bf2f(pr[cu + d]) + mp.bgk[h * 64 + d]; const float ls = fminf(u, 0.f) - log1pf(expf(-fabsf(u))); sa[d] = expf(ls / 16.f); sk[d] = bf2f(pr[ck + d]); sq[d] = bf2f(pr[cq + d]) * 0.125f; }
            else { float aq = 0.f, ak = 0.f; for (int j = 0; j < 4; ++j) { const int tt = t - 3 + j; if (tt >= 0) { const bf16_t* p2 = proj + ((size_t)b * SEQ + tt) * ldp; aq += mp.conv[j * 1024 + cq + d] * bf2f(p2[cq + d]); ak += mp.conv[j * 1024 + ck + d] * bf2f(p2[ck + d]); } }
                sq[d] = aq / (1.f + expf(-aq)); sk[d] = ak / (1.f + expf(-ak)) * 0.08838834764831845f; }
        }
        if (MODE == 2 && tid == 0) { const float* gp = mp.gates + tok * 8; sh_i = expf(gp[h] + mp.bif[h]); const float x = gp[4 + h] + mp.bif[4 + h]; sh_f = 1.f / (1.f + expf(-x)); }
        __syncthreads();
        const float vt = bf2f(pr[cv + tid]);
        float o = 0.f;
        if (MODE == 2) { const float f = sh_f, ii = sh_i;
#pragma unroll
            for (int d = 0; d < DK; ++d) { S[d] = f * S[d] + ii * sk[d] * vt; o += S[d] * sq[d]; }
            if (tid < 128) nst = f * nst + ii * sk[tid];
            red[tid] = (tid < 128) ? nst * sq[tid] : 0.f;
        } else {
#pragma unroll
            for (int d = 0; d < DK; ++d) { S[d] = sa[d] * S[d] + sk[d] * vt; o += S[d] * sq[d]; }
            red[tid] = o * o;
        }
        __syncthreads();
        for (int st = DV / 2; st > 0; st >>= 1) { if (tid < st) red[tid] += red[tid + st]; __syncthreads(); }
        const float tot = red[0];
        const float gt = bf2f(pr[cg + tid]);
        float y;
        if (MODE == 2) y = o / fmaxf(fabsf(tot), 1.f) * (1.f / (1.f + expf(-gt)));
        else y = o * rsqrtf(tot / 128.f + 1e-6f) * ((MODE == 0) ? mp.hg : mp.gg)[h * 128 + tid] * (gt / (1.f + expf(-gt)));
        const float g = bf2f(mp.ymix[tok * DM + cy + tid]);
        num += (y - g) * (y - g); den += y * y;
        __syncthreads();
    }
    dbg_acc(w, stage, num, den);
}
__global__ void dbg_h1(const bf16_t* HIN, const bf16_t* YM, const bf16_t* Wt, const bf16_t* H1, const float* g, const float* bb, float* w, int stage) {
    __shared__ float red[256]; __shared__ float zrow[1024];
    const int tid = threadIdx.x; const unsigned row = hash32(blockIdx.x + 1000u * stage) % NTOK;
    float z[4];
    for (int q = 0; q < 4; ++q) { const int c = tid + 256 * q; float a = 0.f; for (int k = 0; k < 1024; ++k) a += bf2f(YM[(size_t)row * 1024 + k]) * bf2f(Wt[(size_t)c * 1024 + k]); z[q] = bfr(ALPHA * bf2f(HIN[(size_t)row * 1024 + c]) + a); }
    red[tid] = z[0] + z[1] + z[2] + z[3]; __syncthreads();
    for (int st = 128; st > 0; st >>= 1) { if (tid < st) red[tid] += red[tid + st]; __syncthreads(); }
    const float mu = red[0] / 1024.f; __syncthreads();
    red[tid] = (z[0] - mu) * (z[0] - mu) + (z[1] - mu) * (z[1] - mu) + (z[2] - mu) * (z[2] - mu) + (z[3] - mu) * (z[3] - mu); __syncthreads();
    for (int st = 128; st > 0; st >>= 1) { if (tid < st) red[tid] += red[tid + st]; __syncthreads(); }
    const float rs = rsqrtf(red[0] / 1024.f + 1e-5f);
    float num = 0.f, den = 0.f;
    for (int q = 0; q < 4; ++q) { const int c = tid + 256 * q; const float y = (z[q] - mu) * rs * g[c] + bb[c], gg = bf2f(H1[(size_t)row * 1024 + c]); num += (y - gg) * (y - gg); den += y * y; }
    dbg_acc(w, stage, num, den); (void)zrow;
}
__global__ void dbg_select(const float* logits, const float* rb, const int* tok_e, const float* tok_w, float* w, int stage) {
    __shared__ float sc[256], bs[256]; __shared__ int ce[8]; __shared__ float cs[8];
    if (threadIdx.x != 0) return;
    const unsigned tok = hash32(blockIdx.x + 31u * stage) % NTOK;
    const float* lp = logits + (size_t)tok * 256;
    for (int e = 0; e < 256; ++e) { sc[e] = 1.f / (1.f + expf(-lp[e])); bs[e] = sc[e] + rb[e]; }
    float gs[8];
#pragma unroll
    for (int g = 0; g < 8; ++g) { float m1 = -1e30f, m2 = -1e30f; for (int j = 0; j < 32; ++j) { const float v = bs[g * 32 + j]; if (v > m1) { m2 = m1; m1 = v; } else if (v > m2) m2 = v; } gs[g] = m1 + m2; }
    unsigned selmask = 0;
#pragma unroll
    for (int g = 0; g < 8; ++g) { int rank = 0;
#pragma unroll
        for (int q = 0; q < 8; ++q) rank += (gs[q] > gs[g] || (gs[q] == gs[g] && q < g)) ? 1 : 0; if (rank < 4) selmask |= 1u << g; }
    float tot = 0.f;
    for (int k = 0; k < 8; ++k) { float bv = -1e30f; int be = 0; for (int e = 0; e < 256; ++e) { if (!((selmask >> (e >> 5)) & 1u)) continue; bool used = false; for (int q = 0; q < k; ++q) used |= (ce[q] == e); if (used) continue; if (bs[e] > bv) { bv = bs[e]; be = e; } } ce[k] = be; cs[k] = sc[be]; tot += sc[be]; }
    float num = 0.f, den = 0.f;
    for (int k = 0; k < 8; ++k) { const float wr_ = cs[k] / tot * 2.5f; const int ge = tok_e[(size_t)tok * 8 + k]; const float gw = tok_w[(size_t)tok * 8 + k];
        num += (ge == ce[k] ? 0.f : 1.f) + (wr_ - gw) * (wr_ - gw); den += wr_ * wr_; }
    dbg_acc(w, stage, num, den);
}
template <bool FINAL> __global__ void dbg_moe(Args A, int layer, const int* tok_e, const float* tok_w, const bf16_t* H1, const bf16_t* H2, const float* OUT, float* w, int stage) {
    __shared__ float hrow[1024], hid[256], red[256];
    const int tid = threadIdx.x; const unsigned tok = hash32(blockIdx.x + 555u * stage) % NTOK;
    for (int i = tid; i < 1024; i += 256) hrow[i] = bf2f(H1[(size_t)tok * 1024 + i]);
    float acc[4] = {0.f, 0.f, 0.f, 0.f};
    __syncthreads();
    for (int k = 0; k < 9; ++k) {
        const int e = (k < 8) ? tok_e[(size_t)tok * 8 + k] : 256; const float wk = (k < 8) ? tok_w[(size_t)tok * 8 + k] : 1.f;
        const float* W1 = (e < 256) ? A.in[I_WEI] + (size_t)(layer * 256 + e) * 1024 * 512 : A.in[I_WSI] + (size_t)layer * 1024 * 512;
        const float* W2 = (e < 256) ? A.in[I_WED] + (size_t)(layer * 256 + e) * 256 * 1024 : A.in[I_WSD] + (size_t)layer * 256 * 1024;
        float gsum = 0.f, usum = 0.f;
        for (int kk = 0; kk < 1024; ++kk) { gsum += hrow[kk] * W1[(size_t)kk * 512 + tid]; usum += hrow[kk] * W1[(size_t)kk * 512 + 256 + tid]; }
        hid[tid] = gsum / (1.f + expf(-gsum)) * usum;
        __syncthreads();
        for (int q = 0; q < 4; ++q) { const int c = tid + 256 * q; float a = 0.f; for (int j = 0; j < 256; ++j) a += hid[j] * W2[(size_t)j * 1024 + c]; acc[q] += wk * a; }
        __syncthreads();
    }
    float z[4]; for (int q = 0; q < 4; ++q) z[q] = ALPHA * hrow[tid + 256 * q] + acc[q];
    red[tid] = z[0] + z[1] + z[2] + z[3]; __syncthreads();
    for (int st = 128; st > 0; st >>= 1) { if (tid < st) red[tid] += red[tid + st]; __syncthreads(); }
    const float mu = red[0] / 1024.f; __syncthreads();
    red[tid] = (z[0] - mu) * (z[0] - mu) + (z[1] - mu) * (z[1] - mu) + (z[2] - mu) * (z[2] - mu) + (z[3] - mu) * (z[3] - mu); __syncthreads();
    for (int st = 128; st > 0; st >>= 1) { if (tid < st) red[tid] += red[tid + st]; __syncthreads(); }
    const float rs = rsqrtf(red[0] / 1024.f + 1e-5f);
    const float* g = A.in[I_LFG] + layer * DM; const float* bb = A.in[I_LFB] + layer * DM;
    float num = 0.f, den = 0.f;
    for (int q = 0; q < 4; ++q) { const int c = tid + 256 * q; const float y = (z[q] - mu) * rs * g[c] + bb[c]; const float gg = FINAL ? OUT[(size_t)tok * 1024 + c] : bf2f(H2[(size_t)tok * 1024 + c]); num += (y - gg) * (y - gg); den += y * y; }
    dbg_acc(w, stage, num, den);
}
#ifndef DBG_REPORT
#define DBG_REPORT 0
#endif
__global__ void dbg_fill(float* out, const float* w) {
    __shared__ float cval;
    if (threadIdx.x == 0) {
        float c = 0.f;
        if (DBG_REPORT == 0) { for (int st = 1; st <= 13; ++st) { const float rel = sqrtf(w[2 * st] / fmaxf(w[2 * st + 1], 1e-30f)); if (!(rel < 0.08f) || !(w[2 * st + 1] > 0.f)) { c = (float)st; break; } } }
        else { const float rel = sqrtf(w[2 * DBG_REPORT] / fmaxf(w[2 * DBG_REPORT + 1], 1e-30f)); float l = -log10f(fmaxf(rel, 1e-8f)); l = fminf(fmaxf(l, -2.f), 8.f); c = 3.f + l; }
        cval = c;
    }
    __syncthreads();
    const float c = cval;
    if (c != 0.f) for (size_t i = (size_t)blockIdx.x * 256 + threadIdx.x; i < (size_t)NTOK * DM; i += (size_t)gridDim.x * 256) out[i] = c;
}
#endif

extern "C" void kernel_launch(void* const* d_in, const int* in_sizes, int n_in, void* d_out, int out_size, void* d_ws, size_t ws_size, hipStream_t stream) {
    static int grid = 0;
    if (grid == 0) {
        if (n_in != 22 || out_size != NTOK * DM || ws_size < WS_END) { fprintf(stderr, "kernel_launch: unexpected shapes (n_in %d out %d ws %zu)\n", n_in, out_size, ws_size); grid = -1; return; }
        if (hipFuncSetAttribute((const void*)fwd_kernel, hipFuncAttributeMaxDynamicSharedMemorySize, LDS_BYTES) != hipSuccess) { fprintf(stderr, "kernel_launch: hipFuncSetAttribute failed\n"); grid = -1; return; }
        int per_cu = 0;
        if (hipOccupancyMaxActiveBlocksPerMultiprocessor(&per_cu, (const void*)fwd_kernel, 512, LDS_BYTES) != hipSuccess || per_cu < 1) fprintf(stderr, "kernel_launch: occupancy query says %d\n", per_cu);
        (void)hipGetLastError();
        grid = NWG;
    }
    if (grid < 0) return;
    (void)hipMemsetAsync((char*)d_ws + WS_CTL, 0, CTL_BYTES, stream);
    Args a{};
    for (int i = 0; i < 22; ++i) a.in[i] = (const float*)d_in[i];
    a.out = (float*)d_out; a.ws = (unsigned char*)d_ws;
#if MK_ONE_LAUNCH
    a.ph_lo = 0; a.ph_hi = 23;
    hipLaunchKernelGGL(fwd_kernel, dim3(grid), dim3(512), LDS_BYTES, stream, a);
#else
    for (int p = 0; p < 23; ++p) { a.ph_lo = p; a.ph_hi = p + 1; hipLaunchKernelGGL(fwd_kernel, dim3(grid), dim3(512), LDS_BYTES, stream, a);
#ifdef DBG
        unsigned char* ws = (unsigned char*)d_ws; float* dw = (float*)(ws + WS_CTL) + CW_DBG;
        const int layer = (p - 1) / 11, q = (p - 1) % 11;
        MixP mp{(const bf16_t*)(ws + WS_PROJ), layer ? CWID : ABW, 0, ws + WS_YMIX, (const float*)(ws + WS_GATES), (const float*)(ws + WS_MISC), a.in[I_BGK], a.in[I_HG], a.in[I_GG], a.in[I_CONV], a.in[I_BIF], (float*)(ws + WS_UST), (float*)(ws + WS_GSUM)};
        if (p == 0) hipLaunchKernelGGL(dbg_weights, dim3(256), dim3(256), 0, stream, a, dw);
        if (p >= 1 && q == 0) hipLaunchKernelGGL(dbg_gemm, dim3(64), dim3(256), 0, stream, (const bf16_t*)(ws + (layer ? WS_H2 : WS_HB)), 1024, (const bf16_t*)(ws + (layer ? WS_WC : WS_WAB)), (const void*)(ws + WS_PROJ), layer ? CWID : ABW, 0, NTOK, layer ? CWID : ABW, dw, layer ? 9 : 2);
        if (p >= 1 && q == 2 && layer == 0) { hipLaunchKernelGGL(dbg_mixer<0>, dim3(1), dim3(128), 0, stream, mp, 0, 1, 1100, dw, 3); hipLaunchKernelGGL(dbg_mixer<1>, dim3(1), dim3(128), 0, stream, mp, 1, 2, 1100, dw, 4); }
        if (p >= 1 && q == 2 && layer == 1) hipLaunchKernelGGL(dbg_mixer<2>, dim3(1), dim3(256), 0, stream, mp, 1, 1, 1100, dw, 10);
        if (p >= 1 && q == 4) hipLaunchKernelGGL(dbg_h1, dim3(32), dim3(256), 0, stream, (const bf16_t*)(ws + (layer ? WS_H2 : WS_HB)), (const bf16_t*)(ws + WS_YMIX), (const bf16_t*)(ws + (layer ? WS_WOC : WS_WOAB)), (const bf16_t*)(ws + WS_H1), a.in[I_LMG] + layer * DM, a.in[I_LMB] + layer * DM, dw, layer ? 11 : 5);
        if (p >= 1 && q == 5 && layer == 0) hipLaunchKernelGGL(dbg_gemm, dim3(64), dim3(256), 0, stream, (const bf16_t*)(ws + WS_H1), 1024, (const bf16_t*)(ws + WS_WR), (const void*)(ws + WS_LOGITS), 256, 1, NTOK, 256, dw, 6);
        if (p >= 1 && q == 6) hipLaunchKernelGGL(dbg_select, dim3(64), dim3(64), 0, stream, (const float*)(ws + WS_LOGITS), a.in[I_RB] + layer * NEXP, (const int*)(ws + WS_TOKE), (const float*)(ws + WS_TOKW), dw, layer ? 12 : 7);
        if (p >= 1 && q == 10 && layer == 0) hipLaunchKernelGGL(dbg_moe<false>, dim3(32), dim3(256), 0, stream, a, 0, (const int*)(ws + WS_TOKE), (const float*)(ws + WS_TOKW), (const bf16_t*)(ws + WS_H1), (const bf16_t*)(ws + WS_H2), (const float*)d_out, dw, 8);
        if (p >= 1 && q == 10 && layer == 1) { hipLaunchKernelGGL(dbg_moe<true>, dim3(32), dim3(256), 0, stream, a, 1, (const int*)(ws + WS_TOKE), (const float*)(ws + WS_TOKW), (const bf16_t*)(ws + WS_H1), (const bf16_t*)(ws + WS_H2), (const float*)d_out, dw, 13);
            hipLaunchKernelGGL(dbg_fill, dim3(1024), dim3(256), 0, stream, (float*)d_out, dw); }
#endif
    }
#endif
}
```

```cpp
#include <hip/hip_runtime.h>
#include <cstdio>
#include <cstdint>

#ifndef MK_ONE_LAUNCH
#define MK_ONE_LAUNCH 1
#endif

#define LAS __attribute__((address_space(3)))
typedef unsigned short bf16_t;
typedef short bf16x8 __attribute__((ext_vector_type(8)));
typedef float f32x4 __attribute__((ext_vector_type(4)));
typedef unsigned u32x4 __attribute__((ext_vector_type(4)));
typedef unsigned u32x2 __attribute__((ext_vector_type(2)));

constexpr int NTOK = 32768, SEQ = 16384, DM = 1024;
constexpr int ABW = 3840;
constexpr int CWID = 3072;
constexpr int NEXP = 256, NE1 = 257, TOPK = 8, NSLOT = 9;
constexpr float ALPHA = 1.41421356237f;
constexpr int NWG = 256;
constexpr int PRMAX = 262144 + 65536 + 32768;

constexpr size_t MiB = 1u << 20;
constexpr size_t WS_CTL = 0, CTL_BYTES = 1 * MiB;
constexpr size_t WS_MISC = 1 * MiB;
constexpr size_t WS_WAB = 2 * MiB, WS_WOAB = 10 * MiB, WS_WC = 12 * MiB, WS_WOC = 18 * MiB, WS_WR = 20 * MiB;
constexpr size_t WS_TOKE = 22 * MiB, WS_TOKP = 23 * MiB, WS_TOKW = 24 * MiB;
constexpr size_t WS_STOK = 26 * MiB, WS_POSY = 28 * MiB;
constexpr size_t WS_GATES = 32 * MiB;
constexpr size_t WS_UST = 34 * MiB, WS_GSUM = 54 * MiB;
constexpr size_t WS_LOGITS = 56 * MiB;
constexpr size_t WS_HB = 96 * MiB, WS_PROJ = 160 * MiB, WS_YMIX = 400 * MiB, WS_Z = 464 * MiB, WS_H1 = 528 * MiB, WS_H2 = 592 * MiB;
constexpr size_t WS_ACT = 656 * MiB, WS_Y = 832 * MiB, WS_W1T = 1540 * MiB, WS_W2T = 2056 * MiB;
constexpr size_t WS_XQ = 2320 * MiB, WS_H1Q = 2352 * MiB, WS_H2Q = 2384 * MiB, WS_END = 2416 * MiB;
constexpr float Q_SA = 127.f / 5.5f, Q_SW = 127.f * 32.f / 5.5f, Q_DEQ = 1.f / (Q_SA * Q_SW);
constexpr float Q_SY = 127.f / 8.f, Q_SWO = 127.f * 64.f / 5.5f, Q_DEQO = 1.f / (Q_SY * Q_SWO);
constexpr float Q_SACT = 127.f / 8.f, Q_DEQ2 = 16.f / (Q_SACT * Q_SW);
constexpr int CW_BAR = 4096;
constexpr int CW_CNT = 16384;
constexpr int CW_DBG = 20480;

__device__ __forceinline__ unsigned pk2(float lo, float hi) { unsigned r; asm volatile("v_cvt_pk_bf16_f32 %0, %1, %2" : "=v"(r) : "v"(lo), "v"(hi)); return r; }
__device__ __forceinline__ float bflo(unsigned u) { return __uint_as_float(u << 16); }
__device__ __forceinline__ float bfhi(unsigned u) { return __uint_as_float(u & 0xffff0000u); }
__device__ __forceinline__ float bf2f(bf16_t b) { return __uint_as_float(((unsigned)b) << 16); }
__device__ __forceinline__ float sigm(float x) { return __builtin_amdgcn_rcpf(1.f + __expf(-x)); }
__device__ __forceinline__ float silu(float x) { return x * __builtin_amdgcn_rcpf(1.f + __expf(-x)); }
__device__ __forceinline__ int q8(float x, float sc) { return (int)rintf(fminf(fmaxf(x * sc, -127.f), 127.f)); }
__device__ __forceinline__ unsigned pk4(int a, int b, int c, int d) { return (unsigned)(a & 255) | ((unsigned)(b & 255) << 8) | ((unsigned)(c & 255) << 16) | ((unsigned)d << 24); }
__device__ __forceinline__ float logsig(float x) { return fminf(x, 0.f) - __logf(1.f + __expf(-fabsf(x))); }

#define XB_TMO      128
#define XB_XCNT(j)  (256  + 64 * (j))
#define XB_XSUB(j)  (1280 + 64 * (j))
#define XB_XGEN(j)  (2304 + 64 * (j))
#define XB_TOP      3328
#define XB_TOPGEN   3392
#define XCD_BAR_WORDS 3456
#define XB_SPIN_CAP (1u << 22)
__device__ __forceinline__ unsigned xb_ld(unsigned* p)              { return __hip_atomic_load(p, __ATOMIC_RELAXED, __HIP_MEMORY_SCOPE_AGENT); }
__device__ __forceinline__ unsigned xb_add(unsigned* p, unsigned v) { return __hip_atomic_fetch_add(p, v, __ATOMIC_RELAXED, __HIP_MEMORY_SCOPE_AGENT); }
__device__ __forceinline__ unsigned xb_xcc_id() { return (unsigned)__builtin_amdgcn_s_getreg((3 << 11) | 20) & 0xFu; }
#define XB_SPIN(cond, bar) do { unsigned _sp = 0; while (cond) { __builtin_amdgcn_s_sleep(1); \
    if ((++_sp & 255u) == 0u) { if (xb_ld(&(bar)[XB_TMO])) break; if (_sp > XB_SPIN_CAP) { atomicAdd(&(bar)[XB_TMO], 1u); break; } } } } while (0)
struct XcdBarrier { unsigned* bar; unsigned x; volatile LAS unsigned* st; };
__device__ __forceinline__ XcdBarrier xcd_barrier_post(unsigned* bar, volatile LAS unsigned* st) {
    XcdBarrier b; b.bar = bar; b.x = xb_xcc_id(); b.st = st;
    if (threadIdx.x == 0) (void)xb_add(&bar[XB_XCNT(b.x)], 1u);
    return b;
}
__device__ __forceinline__ void xcd_barrier_complete(unsigned* bar, unsigned x, unsigned& nloc, unsigned& nx) {
    const unsigned G = gridDim.x * gridDim.y * gridDim.z;
    unsigned sum, cnt, mine, sp = 0u;
    for (;;) {
        sum = 0u; cnt = 0u; mine = 0u;
#pragma unroll
        for (unsigned j = 0; j < 16; ++j) { const unsigned c = xb_ld(&bar[XB_XCNT(j)]); sum += c; cnt += (c > 0u) ? 1u : 0u; mine = (j == x) ? c : mine; }
        if (sum == G) break;
        __builtin_amdgcn_s_sleep(1);
        if ((++sp & 255u) == 0u) { if (xb_ld(&bar[XB_TMO])) break; if (sp > XB_SPIN_CAP) { atomicAdd(&bar[XB_TMO], 1u); break; } }
    }
    nloc = mine > 0u ? mine : 1u; nx = cnt > 0u ? cnt : 1u;
}
__device__ __forceinline__ void xcd_barrier(const XcdBarrier& b) {
    asm volatile("s_waitcnt vmcnt(0)" ::: "memory");
    __syncthreads();
    if (threadIdx.x == 0) {
        unsigned* bar = b.bar;
        __builtin_amdgcn_s_waitcnt(0);
        unsigned nloc = b.st[0], nx = b.st[1];
        if (nloc == 0u) { xcd_barrier_complete(bar, b.x, nloc, nx); b.st[0] = nloc; b.st[1] = nx; }
        const unsigned old = xb_add(&bar[XB_XSUB(b.x)], 1u);
        const unsigned gen = old / nloc;
        if (old + 1u == (gen + 1u) * nloc) {
            __builtin_amdgcn_fence(__ATOMIC_RELEASE, "agent");
            asm volatile("s_waitcnt vmcnt(0)" ::: "memory");
            const unsigned og = xb_add(&bar[XB_TOP], 1u);
            const unsigned tg = og / nx;
            if (og + 1u == (tg + 1u) * nx) xb_add(&bar[XB_TOPGEN], 1u);
            else XB_SPIN(xb_ld(&bar[XB_TOPGEN]) == tg, bar);
            __builtin_amdgcn_fence(__ATOMIC_ACQUIRE, "agent");
            xb_add(&bar[XB_XGEN(b.x)], 1u);
            asm volatile("s_waitcnt vmcnt(0)" ::: "memory");
        } else {
            XB_SPIN(xb_ld(&bar[XB_XGEN(b.x)]) == gen, bar);
            __builtin_amdgcn_fence(__ATOMIC_ACQUIRE, "agent");
            asm volatile("s_waitcnt vmcnt(0)" ::: "memory");
        }
    }
    __syncthreads();
}

namespace pg8 {
constexpr int BM = 256, BK = 64, HALF = 128, HTB = HALF * BK * 2, STAGE_BYTES = 8 * HTB, NXCD = 8, WGM = 8;
__device__ __forceinline__ int lds_byte(int r, int c) { const int st = (r >> 4) * 2 + (c >> 5), rr = r & 15, cc = c & 31, ob = rr * 64 + cc * 2; return st * 1024 + (ob ^ (((ob >> 9) & 1) << 5)); }
__device__ __forceinline__ void stage_rc(int b, int& R, int& C) { const int st = b / 1024, sb = b % 1024, swz = sb ^ (((sb >> 9) & 1) << 5); R = (st >> 1) * 16 + swz / 64; C = (st & 1) * 32 + (swz % 64) / 2; }
__device__ __forceinline__ int perm32(int rho) { const int n = rho >> 4, i = rho & 15; return 8 * (i >> 2) + 4 * n + (i & 3); }
struct Unit { int pm, pn; };
struct Gemm { const bf16_t* A; const bf16_t* Bt; int K; };

struct StaticOrder {
    int nM, nN, nwg, G, c;
    __device__ void init(int M, int N, int G_, int c_) { nM = M / BM; nN = N / BM; nwg = nM * nN; G = G_; c = c_; }
    __device__ bool next(int i, Unit& u) const {
        const long L = (long)i * G + c; if (L >= nwg) return false;
        int wgid = (int)L; { const int q = nwg / NXCD, r = nwg % NXCD, xcd = wgid % NXCD, off = wgid / NXCD; wgid = (xcd < r ? xcd * (q + 1) : r * (q + 1) + (xcd - r) * q) + off; }
        const int nig = WGM * nN, gid = wgid / nig, fm = gid * WGM, gsz = (nM - fm) < WGM ? (nM - fm) : WGM;
        u.pm = fm + ((wgid % nig) % gsz); u.pn = (wgid % nig) / gsz; return true;
    }
};
struct MoeOrder {
    const LAS int* tab; int n;
    __device__ bool next(int i, Unit& u) const {
        if (i >= n) return false;
        u.pm = __builtin_amdgcn_readfirstlane(tab[2 * i]); u.pn = __builtin_amdgcn_readfirstlane(tab[2 * i + 1]); return true;
    }
};
constexpr int LDS_UT = 131072, LDS_IDX = 131072 + 512, MOE_MAXU = 15;
__device__ __forceinline__ int moe_prep(LAS unsigned char* lds, const int* __restrict__ tile_exp, int nunits, int sh, int G, int c, const int* __restrict__ rowidx) {
    const int tid = threadIdx.x;
    LAS int* tab = (LAS int*)(lds + LDS_UT);
    int n = 0; { const long rem = (long)nunits - c; n = rem > 0 ? (int)((rem + G - 1) / G) : 0; if (n > 32) n = 32; }
    if (tid < n) { const long L = (long)tid * G + c; const int rt = (int)(L >> sh), j = (int)L & ((1 << sh) - 1); tab[2 * tid] = rt; tab[2 * tid + 1] = (tile_exp[rt] << sh) + j; }
    __syncthreads();
    if (rowidx) { LAS int* idx = (LAS int*)(lds + LDS_IDX); const int nn = n < MOE_MAXU ? n : MOE_MAXU;
        for (int x = tid; x < nn * 256; x += 512) idx[x] = rowidx[tab[2 * (x >> 8)] * 256 + (x & 255)];
        __syncthreads(); }
    return n;
}

typedef int i32x4 __attribute__((ext_vector_type(4)));
template <class Epi, class Sched, bool GATHER, bool I8 = false>
__device__ __forceinline__ void gemm_phase(LAS unsigned char* lds, const Gemm g, const LAS int* rowidx, const Sched& S, const Epi& E) {
    const int tid = threadIdx.x, wid = __builtin_amdgcn_readfirstlane(tid >> 6), lane = tid & 63, wr = wid >> 2, wc = wid & 3, fr = lane & 15, fq = lane >> 4;
    const int K = g.K, nt = K / BK;
    unsigned voffB[2], cofs[2]; int Rr[2];
#pragma unroll
    for (int i = 0; i < 2; ++i) { int R, C; stage_rc(tid * 16 + i * 8192, R, C); const int Rb = Epi::PERM ? ((R & ~31) + perm32(R & 31)) : R;
        Rr[i] = R; cofs[i] = (unsigned)C * 2u; voffB[i] = (unsigned)(Rb * K + C) * 2u; }
    const unsigned rowb = (unsigned)K * 2u;
    const size_t kstep = (size_t)(BK * 2);
    const size_t hstep = (size_t)HALF * K * 2;
    const size_t tstep = 2 * hstep;
    const unsigned ldsw = (unsigned)wid * 1024u;
    const int aoff = lds_byte(wr * 64 + fr, fq * 8), boff = lds_byte(wc * 32 + fr, fq * 8);
    const char* Abase = (const char*)g.A;
#define PG8_SA(b, h) (((b) * 2 + (h)) * HTB)
#define PG8_SB(b, h) ((4 + (b) * 2 + (h)) * HTB)
#define PG8_STAGE(bufoff, gbase, voff) do { _Pragma("unroll") for (int _i = 0; _i < 2; ++_i) \
        __builtin_amdgcn_global_load_lds((const unsigned*)((const char*)(gbase) + (voff)[_i]), (LAS unsigned*)(lds + (bufoff) + ldsw + _i * 8192), 16, 0, 0); } while (0)
#define PG8_STAGEA(bufoff, kb, offs) do { _Pragma("unroll") for (int _i = 0; _i < 2; ++_i) \
        __builtin_amdgcn_global_load_lds((const unsigned*)(Abase + (size_t)((kb) + (offs)[_i])), (LAS unsigned*)(lds + (bufoff) + ldsw + _i * 8192), 16, 0, 0); } while (0)
#define PG8_ROWOFF(u, uo, O) do { _Pragma("unroll") for (int _h = 0; _h < 2; ++_h) _Pragma("unroll") for (int _i = 0; _i < 2; ++_i) { \
        int _row = (u).pm * BM + _h * HALF + Rr[_i]; if (GATHER) _row = rowidx[(uo) * 256 + _h * HALF + Rr[_i]]; (O)[_h][_i] = (unsigned)_row * rowb + cofs[_i]; } } while (0)
#define PG8_LDA(dst, b, h) do { _Pragma("unroll") for (int m = 0; m < 4; ++m) _Pragma("unroll") for (int k = 0; k < 2; ++k) dst[m][k] = *(const LAS bf16x8*)(lds + PG8_SA(b, h) + aoff + m * 2048 + k * 1024); } while (0)
#define PG8_LDB(dst, b, h) do { _Pragma("unroll") for (int n = 0; n < 2; ++n) _Pragma("unroll") for (int k = 0; k < 2; ++k) dst[n][k] = *(const LAS bf16x8*)(lds + PG8_SB(b, h) + boff + n * 2048 + k * 1024); } while (0)
#define PG8_MMA(ai, bj, At, Bt) do { __builtin_amdgcn_s_setprio(1); _Pragma("unroll") for (int m = 0; m < 4; ++m) _Pragma("unroll") for (int n = 0; n < 2; ++n) _Pragma("unroll") for (int k = 0; k < 2; ++k) \
        { if (I8) acc[ai][bj][m][n] = __builtin_bit_cast(f32x4, __builtin_amdgcn_mfma_i32_16x16x64_i8(__builtin_bit_cast(i32x4, Bt[n][k]), __builtin_bit_cast(i32x4, At[m][k]), __builtin_bit_cast(i32x4, acc[ai][bj][m][n]), 0, 0, 0)); \
          else acc[ai][bj][m][n] = __builtin_amdgcn_mfma_f32_16x16x32_bf16(Bt[n][k], At[m][k], acc[ai][bj][m][n], 0, 0, 0); } __builtin_amdgcn_s_setprio(0); } while (0)
#define PG8_WAIT_V(n) asm volatile("s_waitcnt vmcnt(" #n ")" ::: "memory")
#define PG8_WAIT_L(n) asm volatile("s_waitcnt lgkmcnt(" #n ")" ::: "memory")
#define PG8_BAR __builtin_amdgcn_s_barrier()
#define PG8_SCHED __builtin_amdgcn_sched_barrier(0)
    Unit cur, nxt; int ui = 0;
    if (!S.next(0, cur)) return;
    f32x4 acc[2][2][4][2];
#pragma unroll
    for (int a = 0; a < 2; ++a)
#pragma unroll
        for (int b = 0; b < 2; ++b)
#pragma unroll
            for (int m = 0; m < 4; ++m)
#pragma unroll
                for (int n = 0; n < 2; ++n) acc[a][b][m][n] = (f32x4){0.f, 0.f, 0.f, 0.f};
    bf16x8 At[4][2], B0[2][2], B1[2][2];
    unsigned cO[2][2], nO[2][2];
    PG8_ROWOFF(cur, 0, cO);
    const char* cB = (const char*)g.Bt + (size_t)cur.pn * tstep;
    PG8_STAGE(PG8_SB(0, 0), cB, voffB); PG8_STAGE(PG8_SB(0, 1), cB + hstep, voffB); PG8_STAGEA(PG8_SA(0, 0), 0u, cO[0]); PG8_STAGEA(PG8_SA(0, 1), 0u, cO[1]);
    if (wr == 1) PG8_BAR;
    PG8_WAIT_V(2); PG8_BAR;
    PG8_STAGE(PG8_SB(1, 0), cB + kstep, voffB); PG8_STAGEA(PG8_SA(1, 0), (unsigned)kstep, cO[0]); PG8_STAGE(PG8_SB(1, 1), cB + hstep + kstep, voffB);
    PG8_WAIT_V(6); PG8_BAR;
    for (;;) {
        const bool has_next = S.next(ui + 1, nxt);
        const char* nB = has_next ? (const char*)g.Bt + (size_t)nxt.pn * tstep : cB;
#pragma unroll
        for (int h = 0; h < 2; ++h)
#pragma unroll
            for (int i = 0; i < 2; ++i) nO[h][i] = cO[h][i];
#pragma unroll 1
        for (int t = 0; t < nt; t += 2) {
            const bool last = (t == nt - 2);
            if (last && has_next) PG8_ROWOFF(nxt, ui + 1, nO);
            const unsigned k1 = (unsigned)(t + 1) * (unsigned)kstep;
            const unsigned k2 = last ? 0u : (unsigned)(t + 2) * (unsigned)kstep, k3 = k2 + (unsigned)kstep;
            const char* b2 = last ? nB : cB + (size_t)(t + 2) * kstep; const char* b3 = b2 + kstep;
            unsigned o2[2][2];
#pragma unroll
            for (int h = 0; h < 2; ++h)
#pragma unroll
                for (int i = 0; i < 2; ++i) o2[h][i] = last ? nO[h][i] : cO[h][i];
            PG8_LDB(B0, 0, 0); PG8_LDB(B1, 0, 1); PG8_SCHED; PG8_LDA(At, 0, 0); PG8_STAGEA(PG8_SA(1, 1), k1, cO[1]);
            PG8_WAIT_V(8); PG8_WAIT_L(0); PG8_BAR; PG8_MMA(0, 0, At, B0); PG8_MMA(0, 1, At, B1); PG8_BAR; PG8_SCHED;
            PG8_LDA(At, 0, 1); PG8_STAGE(PG8_SB(0, 0), b2, voffB); PG8_STAGE(PG8_SB(0, 1), b2 + hstep, voffB); PG8_STAGEA(PG8_SA(0, 0), k2, o2[0]);
            PG8_WAIT_V(8); PG8_WAIT_L(0); PG8_BAR; PG8_MMA(1, 0, At, B0); PG8_MMA(1, 1, At, B1); PG8_BAR; PG8_SCHED;
            PG8_LDB(B0, 1, 0); PG8_LDB(B1, 1, 1); PG8_SCHED; PG8_LDA(At, 1, 0); PG8_STAGEA(PG8_SA(0, 1), k2, o2[1]);
            PG8_WAIT_V(8); PG8_WAIT_L(0); PG8_BAR; PG8_MMA(0, 0, At, B0); PG8_MMA(0, 1, At, B1); PG8_BAR; PG8_SCHED;
            PG8_LDA(At, 1, 1); PG8_STAGE(PG8_SB(1, 0), b3, voffB); PG8_STAGE(PG8_SB(1, 1), b3 + hstep, voffB); PG8_STAGEA(PG8_SA(1, 0), k3, o2[0]);
            PG8_WAIT_V(8); PG8_WAIT_L(0); PG8_BAR; PG8_MMA(1, 0, At, B0); PG8_MMA(1, 1, At, B1); PG8_BAR; PG8_SCHED;
        }
        if (wr == 0) PG8_BAR;
        E(acc, cur, wr, wc, fr, fq);
        if (!has_next) break;
#pragma unroll
        for (int a = 0; a < 2; ++a)
#pragma unroll
            for (int b = 0; b < 2; ++b)
#pragma unroll
                for (int m = 0; m < 4; ++m)
#pragma unroll
                    for (int n = 0; n < 2; ++n) acc[a][b][m][n] = (f32x4){0.f, 0.f, 0.f, 0.f};
        cur = nxt; cB = nB; ++ui;
#pragma unroll
        for (int h = 0; h < 2; ++h)
#pragma unroll
            for (int i = 0; i < 2; ++i) cO[h][i] = nO[h][i];
        if (wr == 1) PG8_BAR;
    }
    PG8_WAIT_V(0);
    PG8_BAR;
#undef PG8_SA
#undef PG8_SB
#undef PG8_STAGE
#undef PG8_STAGEA
#undef PG8_ROWOFF
#undef PG8_LDA
#undef PG8_LDB
#undef PG8_MMA
#undef PG8_WAIT_V
#undef PG8_WAIT_L
#undef PG8_BAR
#undef PG8_SCHED
}

template <bool I8> struct EpiStoreBf16 {
    static constexpr bool PERM = true;
    bf16_t* O; int ldc;
    static __device__ __forceinline__ f32x4 dq(f32x4 v) { if (I8) { const i32x4 q = __builtin_bit_cast(i32x4, v); return (f32x4){(float)q[0] * Q_DEQ, (float)q[1] * Q_DEQ, (float)q[2] * Q_DEQ, (float)q[3] * Q_DEQ}; } return v; }
    __device__ __forceinline__ void operator()(const f32x4 (&acc)[2][2][4][2], const Unit& u, int wr, int wc, int fr, int fq) const {
        const int row0 = u.pm * BM + wr * 64 + fr, col0 = u.pn * BM + wc * 32 + 8 * fq;
#pragma unroll
        for (int ai = 0; ai < 2; ++ai)
#pragma unroll
            for (int m = 0; m < 4; ++m) { bf16_t* rowp = O + (size_t)(row0 + ai * HALF + m * 16) * ldc + col0;
#pragma unroll
                for (int bj = 0; bj < 2; ++bj) { const f32x4 v0 = dq(acc[ai][bj][m][0]), v1 = dq(acc[ai][bj][m][1]);
                    u32x4 w; w.x = pk2(v0[0], v0[1]); w.y = pk2(v0[2], v0[3]); w.z = pk2(v1[0], v1[1]); w.w = pk2(v1[2], v1[3]);
                    *(u32x4*)(rowp + bj * HALF) = w; } }
    }
};
struct EpiResid {
    static constexpr bool PERM = true;
    bf16_t* Z; const bf16_t* H;
    static __device__ __forceinline__ f32x4 dq(f32x4 v) { const i32x4 q = __builtin_bit_cast(i32x4, v); return (f32x4){(float)q[0] * Q_DEQO, (float)q[1] * Q_DEQO, (float)q[2] * Q_DEQO, (float)q[3] * Q_DEQO}; }
    __device__ __forceinline__ void operator()(const f32x4 (&acc)[2][2][4][2], const Unit& u, int wr, int wc, int fr, int fq) const {
        const int row0 = u.pm * BM + wr * 64 + fr, col0 = u.pn * BM + wc * 32 + 8 * fq;
#pragma unroll
        for (int ai = 0; ai < 2; ++ai)
#pragma unroll
            for (int m = 0; m < 4; ++m) { const size_t ro = (size_t)(row0 + ai * HALF + m * 16) * DM + col0;
#pragma unroll
                for (int bj = 0; bj < 2; ++bj) { const f32x4 v0 = dq(acc[ai][bj][m][0]), v1 = dq(acc[ai][bj][m][1]);
                    const u32x4 hh = *(const u32x4*)(H + ro + bj * HALF);
                    u32x4 w;
                    w.x = pk2(ALPHA * bflo(hh.x) + v0[0], ALPHA * bfhi(hh.x) + v0[1]); w.y = pk2(ALPHA * bflo(hh.y) + v0[2], ALPHA * bfhi(hh.y) + v0[3]);
                    w.z = pk2(ALPHA * bflo(hh.z) + v1[0], ALPHA * bfhi(hh.z) + v1[1]); w.w = pk2(ALPHA * bflo(hh.w) + v1[2], ALPHA * bfhi(hh.w) + v1[3]);
                    *(u32x4*)(Z + ro + bj * HALF) = w; } }
    }
};
struct EpiF32 {
    static constexpr bool PERM = false;
    float* C;
    __device__ __forceinline__ void operator()(const f32x4 (&acc)[2][2][4][2], const Unit& u, int wr, int wc, int fr, int fq) const {
        const int row0 = u.pm * BM + wr * 64 + fr, col0 = wc * 32 + 4 * fq;
#pragma unroll
        for (int ai = 0; ai < 2; ++ai)
#pragma unroll
            for (int m = 0; m < 4; ++m) { float* rowp = C + (size_t)(row0 + ai * HALF + m * 16) * 256 + col0;
#pragma unroll
                for (int bj = 0; bj < 2; ++bj)
#pragma unroll
                    for (int n = 0; n < 2; ++n) *(f32x4*)(rowp + bj * HALF + n * 16) = acc[ai][bj][m][n]; }
    }
};
template <bool I8> struct EpiSwiGLU {
    static constexpr bool PERM = true;
    unsigned char* ACT; LAS unsigned char* sbuf;
    static __device__ __forceinline__ f32x4 dq(f32x4 v) { if (I8) { const i32x4 q = __builtin_bit_cast(i32x4, v); return (f32x4){(float)q[0] * Q_DEQ, (float)q[1] * Q_DEQ, (float)q[2] * Q_DEQ, (float)q[3] * Q_DEQ}; } return v; }
    __device__ __forceinline__ void operator()(const f32x4 (&acc)[2][2][4][2], const Unit& u, int wr, int wc, int fr, int fq) const {
        const int tid = threadIdx.x, rrow = tid >> 3, rchunk = tid & 7;
        const int wrow = wr * 16 + fr;
        unsigned char* abase = ACT + (size_t)(u.pm * BM) * 256 + (u.pn & 1) * 128 + rchunk * 16;
#pragma unroll
        for (int st = 0; st < 8; ++st) {
            const int ai = st >> 2, m = st & 3;
            LAS unsigned char* buf = sbuf + (st & 1) * 4096;
            const f32x4 g0 = dq(acc[ai][0][m][0]), g1 = dq(acc[ai][0][m][1]), u0 = dq(acc[ai][1][m][0]), u1 = dq(acc[ai][1][m][1]);
            u32x2 w;
            w.x = pk4(q8(silu(g0[0]) * u0[0], Q_SACT), q8(silu(g0[1]) * u0[1], Q_SACT), q8(silu(g0[2]) * u0[2], Q_SACT), q8(silu(g0[3]) * u0[3], Q_SACT));
            w.y = pk4(q8(silu(g1[0]) * u1[0], Q_SACT), q8(silu(g1[1]) * u1[1], Q_SACT), q8(silu(g1[2]) * u1[2], Q_SACT), q8(silu(g1[3]) * u1[3], Q_SACT));
            const int c16 = wc * 2 + (fq >> 1);
            *(LAS u32x2*)(buf + wrow * 128 + ((c16 ^ (wrow & 7)) << 4) + (fq & 1) * 8) = w;
            asm volatile("s_waitcnt lgkmcnt(0)" ::: "memory"); __builtin_amdgcn_s_barrier(); asm volatile("" ::: "memory");
            if (tid < 256) {
                const u32x4 rv = *(const LAS u32x4*)(buf + rrow * 128 + ((rchunk ^ (rrow & 7)) << 4));
                const int grow = ai * HALF + (rrow >> 4) * 64 + m * 16 + (rrow & 15);
                *(u32x4*)(abase + (size_t)grow * 256) = rv;
            }
        }
        asm volatile("s_waitcnt lgkmcnt(0)" ::: "memory"); __builtin_amdgcn_s_barrier(); asm volatile("" ::: "memory");
    }
};
template <int EV = 0> struct EpiDownT {
    static constexpr bool PERM = true;
    unsigned char* Y; LAS unsigned char* sbuf;
    __device__ __forceinline__ void operator()(const f32x4 (&acc)[2][2][4][2], const Unit& u, int wr, int wc, int fr, int fq) const {
        const int tid = threadIdx.x, rrow = tid >> 4, rchunk = tid & 15;
        const int wrow = wr * 16 + fr;
        unsigned char* ybase = Y + (size_t)(u.pm * BM) * DM + (u.pn & 3) * 256 + rchunk * 16;
#pragma unroll
        for (int st = 0; st < 8; ++st) {
            const int ai = st >> 2, m = st & 3;
            LAS unsigned char* buf = sbuf + (st & 1) * 8192;
#pragma unroll
            for (int bj = 0; bj < 2; ++bj) { const i32x4 q0 = __builtin_bit_cast(i32x4, acc[ai][bj][m][0]), q1 = __builtin_bit_cast(i32x4, acc[ai][bj][m][1]);
                const f32x4 v0 = (f32x4){(float)q0[0] * Q_DEQ2, (float)q0[1] * Q_DEQ2, (float)q0[2] * Q_DEQ2, (float)q0[3] * Q_DEQ2}, v1 = (f32x4){(float)q1[0] * Q_DEQ2, (float)q1[1] * Q_DEQ2, (float)q1[2] * Q_DEQ2, (float)q1[3] * Q_DEQ2};
                int p0 = __builtin_amdgcn_cvt_pk_fp8_f32(v0[0], v0[1], 0, false); p0 = __builtin_amdgcn_cvt_pk_fp8_f32(v0[2], v0[3], p0, true);
                int p1 = __builtin_amdgcn_cvt_pk_fp8_f32(v1[0], v1[1], 0, false); p1 = __builtin_amdgcn_cvt_pk_fp8_f32(v1[2], v1[3], p1, true);
                u32x2 w; w.x = (unsigned)p0; w.y = (unsigned)p1;
                const int c16 = bj * 8 + wc * 2 + (fq >> 1);
                *(LAS u32x2*)(buf + wrow * 256 + ((c16 ^ (wrow & 15)) << 4) + (fq & 1) * 8) = w; }
            asm volatile("s_waitcnt lgkmcnt(0)" ::: "memory"); __builtin_amdgcn_s_barrier(); asm volatile("" ::: "memory");
            const u32x4 rv = *(const LAS u32x4*)(buf + rrow * 256 + ((rchunk ^ (rrow & 15)) << 4));
            const int grow = ai * HALF + (rrow >> 4) * 64 + m * 16 + (rrow & 15);
            if (EV == 1) { asm volatile("" :: "v"(rv.x), "v"(rv.y), "v"(rv.z), "v"(rv.w)); } else *(u32x4*)(ybase + (size_t)grow * DM) = rv;
        }
        asm volatile("s_waitcnt lgkmcnt(0)" ::: "memory"); __builtin_amdgcn_s_barrier(); asm volatile("" ::: "memory");
    }
};
typedef EpiDownT<0> EpiDown;
}

struct Args { const float* in[22]; float* out; unsigned char* ws; int ph_lo, ph_hi; };
enum { I_X = 0, I_WINAB, I_WGKUP, I_BGK, I_HG, I_GG, I_WOAB, I_LB, I_WINC, I_CONV, I_BIF, I_WOC, I_WR, I_RB, I_WEI, I_WED, I_WSI, I_WSD, I_LMG, I_LMB, I_LFG, I_LFB };

constexpr int LDS_MISC = 147200;
constexpr int LDS_BYTES = 147456;

__device__ __forceinline__ void cvt_tile(LAS unsigned char* lds, const float* __restrict__ src, size_t ldn, int k0, int n0, bf16_t* __restrict__ dst, int K, int drow0) {
    const int t = threadIdx.x;
    { const int c4 = (t & 15) * 4, r2 = t >> 4;
      const f32x4 a = *(const f32x4*)(src + (size_t)(k0 + 2 * r2) * ldn + n0 + c4);
      const f32x4 b = *(const f32x4*)(src + (size_t)(k0 + 2 * r2 + 1) * ldn + n0 + c4);
#pragma unroll
      for (int i = 0; i < 4; ++i) *(LAS unsigned*)(lds + ((c4 + i) * 72 + 2 * r2) * 2) = pk2(a[i], b[i]); }
    __syncthreads();
    { const int kk = (t & 7) * 8, n = t >> 3;
      const u32x4 v = *(const LAS u32x4*)(lds + (n * 72 + kk) * 2);
      *(u32x4*)(dst + (size_t)(drow0 + n) * K + k0 + kk) = v; }
    __syncthreads();
}
template <int NT>
__device__ __forceinline__ void cvt_multi(LAS unsigned char* lds, const float* __restrict__ src, size_t ldn, int k0, int n0, bf16_t* __restrict__ dst, int K, const int (&drow)[NT], float sc = 1.f) {
    const int t = threadIdx.x;
    { const int c4 = (t & 15) * 4, r2 = t >> 4;
      f32x4 a[NT], b[NT];
#pragma unroll
      for (int q = 0; q < NT; ++q) { a[q] = __builtin_nontemporal_load((const f32x4*)(src + (size_t)(k0 + 2 * r2) * ldn + n0 + 64 * q + c4)); b[q] = __builtin_nontemporal_load((const f32x4*)(src + (size_t)(k0 + 2 * r2 + 1) * ldn + n0 + 64 * q + c4)); }
#pragma unroll
      for (int q = 0; q < NT; ++q)
#pragma unroll
          for (int i = 0; i < 4; ++i) *(LAS unsigned*)(lds + q * 9216 + ((c4 + i) * 72 + 2 * r2) * 2) = pk2(a[q][i] * sc, b[q][i] * sc); }
    __syncthreads();
    { const int kk = (t & 7) * 8, n = t >> 3;
#pragma unroll
      for (int q = 0; q < NT; ++q) { const u32x4 v = *(const LAS u32x4*)(lds + q * 9216 + (n * 72 + kk) * 2); *(u32x4*)(dst + (size_t)(drow[q] + n) * K + k0 + kk) = v; } }
    __syncthreads();
}
template <int NT>
__device__ __forceinline__ void cvt8_multi(LAS unsigned char* lds, const float* __restrict__ src, size_t ldn, int k0, int n0, unsigned char* __restrict__ dst, int Kb, const int (&drow)[NT], float sc) {
    const int t = threadIdx.x;
    { const int c4 = (t & 15) * 4, r4 = t >> 4;
      f32x4 a[NT][4];
#pragma unroll
      for (int q = 0; q < NT; ++q)
#pragma unroll
          for (int j = 0; j < 4; ++j) a[q][j] = __builtin_nontemporal_load((const f32x4*)(src + (size_t)(k0 + 4 * r4 + j) * ldn + n0 + 64 * q + c4));
#pragma unroll
      for (int q = 0; q < NT; ++q)
#pragma unroll
          for (int i = 0; i < 4; ++i) *(LAS unsigned*)(lds + q * 9216 + (c4 + i) * 144 + 4 * r4) = pk4(q8(a[q][0][i], sc), q8(a[q][1][i], sc), q8(a[q][2][i], sc), q8(a[q][3][i], sc)); }
    __syncthreads();
    { const int kk = (t & 7) * 16, n = t >> 3;
#pragma unroll
      for (int q = 0; q < NT; ++q) { const u32x4 v = *(const LAS u32x4*)(lds + q * 9216 + n * 144 + kk); *(u32x4*)(dst + (size_t)(drow[q] + n) * Kb + k0 + kk) = v; } }
    __syncthreads();
}
template <int NT>
__device__ __forceinline__ void cvt8_matrix(LAS unsigned char* lds, const float* src, size_t ldn, int K, int n_lo, int ncols, unsigned char* dst, int drow_lo, float sc, int bid, int nb) {
    const int tk = K / 128, tn = ncols / (64 * NT);
    for (int j = bid; j < tk * tn; j += nb) { const int a = j / tn, b = j % tn; int dr[NT];
#pragma unroll
        for (int q = 0; q < NT; ++q) dr[q] = drow_lo + (b * NT + q) * 64;
        cvt8_multi<NT>(lds, src, ldn, a * 128, n_lo + b * 64 * NT, dst, K, dr, sc); }
}
template <int NT>
__device__ __forceinline__ void cvt_matrix(LAS unsigned char* lds, const float* src, size_t ldn, int K, int n_lo, int ncols, bf16_t* dst, int drow_lo, int bid, int nb) {
    const int tk = K / 64, tn = ncols / (64 * NT);
    for (int j = bid; j < tk * tn; j += nb) { const int a = j / tn, b = j % tn; int dr[NT];
#pragma unroll
        for (int q = 0; q < NT; ++q) dr[q] = drow_lo + (b * NT + q) * 64;
        cvt_multi<NT>(lds, src, ldn, a * 64, n_lo + b * 64 * NT, dst, K, dr); }
}
__device__ __forceinline__ void phase_prologue(LAS unsigned char* lds, const Args& A, int bid, int nb) {
    unsigned char* ws = A.ws; const int tid = threadIdx.x;
    if (bid == 0) {
        float* lb0 = (float*)(ws + WS_MISC);
        const float* l = A.in[I_LB];
        if (tid < 512) { const float a = l[tid], b = l[512 + tid], c = l[1024 + tid]; const float m = fmaxf(a, fmaxf(b, c));
            const float ea = __expf(a - m), eb = __expf(b - m), ec = __expf(c - m); lb0[tid] = ea / (ea + eb + ec); }
    }
    if (bid == 1 % nb) {
        float* wg = (float*)(ws + WS_MISC + 4096);
        for (int i = tid; i < 8 * 1024; i += 512) { const int g = i >> 10, k = i & 1023; wg[i] = A.in[I_WINC][(size_t)k * 3080 + 3072 + g]; }
    }
    { const float* x = A.in[I_X]; bf16_t* hb = (bf16_t*)(ws + WS_HB); unsigned char* xq = ws + WS_XQ;
      const size_t step = (size_t)nb * 512 * 8;
      for (size_t i0 = ((size_t)bid * 512 + tid) * 8; i0 < (size_t)NTOK * DM; i0 += 4 * step) {
          f32x4 a[4], b[4];
#pragma unroll
          for (int u = 0; u < 4; ++u) { const size_t i = i0 + u * step; if (i < (size_t)NTOK * DM) { a[u] = __builtin_nontemporal_load((const f32x4*)(x + i)); b[u] = __builtin_nontemporal_load((const f32x4*)(x + i + 4)); } }
#pragma unroll
          for (int u = 0; u < 4; ++u) { const size_t i = i0 + u * step; if (i < (size_t)NTOK * DM) {
              u32x4 w; w.x = pk2(a[u][0], a[u][1]); w.y = pk2(a[u][2], a[u][3]); w.z = pk2(b[u][0], b[u][1]); w.w = pk2(b[u][2], b[u][3]);
              *(u32x4*)(hb + i) = w;
              u32x2 qv; qv.x = pk4(q8(a[u][0], Q_SA), q8(a[u][1], Q_SA), q8(a[u][2], Q_SA), q8(a[u][3], Q_SA)); qv.y = pk4(q8(b[u][0], Q_SA), q8(b[u][1], Q_SA), q8(b[u][2], Q_SA), q8(b[u][3], Q_SA));
              *(u32x2*)(xq + i) = qv; } } } }
    { unsigned char* wab = ws + WS_WAB; const float* win = A.in[I_WINAB]; const float* wup = A.in[I_WGKUP];
      for (int o = bid * 512 + tid; o < 256 * 64; o += nb * 512) { const int j = o >> 6, k16 = (o & 63) * 16;
          float up[16];
#pragma unroll
          for (int r = 0; r < 16; ++r) up[r] = wup[r * 256 + j];
          int res[16];
#pragma unroll
          for (int q = 0; q < 16; ++q) { const float* wr_ = win + (size_t)(k16 + q) * 3600 + 3584; float sm = 0.f;
#pragma unroll
              for (int r = 0; r < 16; ++r) sm += wr_[r] * up[r];
              res[q] = q8(sm, Q_SW); }
          u32x4 w; w.x = pk4(res[0], res[1], res[2], res[3]); w.y = pk4(res[4], res[5], res[6], res[7]); w.z = pk4(res[8], res[9], res[10], res[11]); w.w = pk4(res[12], res[13], res[14], res[15]);
          *(u32x4*)(wab + (size_t)(3584 + j) * 1024 + k16) = w; } }
    cvt8_matrix<4>(lds, A.in[I_WINAB], 3600, 1024, 0, 3584, ws + WS_WAB, 0, Q_SW, bid, nb);
    cvt8_matrix<4>(lds, A.in[I_WOAB], 1024, 1024, 0, 1024, ws + WS_WOAB, 0, Q_SWO, bid, nb);
    cvt8_matrix<4>(lds, A.in[I_WINC], 3080, 1024, 0, 3072, ws + WS_WC, 0, Q_SW, bid, nb);
    cvt8_matrix<4>(lds, A.in[I_WOC], 1024, 1024, 0, 1024, ws + WS_WOC, 0, Q_SWO, bid, nb);
    cvt_matrix<4>(lds, A.in[I_WR], 256, 1024, 0, 256, (bf16_t*)(ws + WS_WR), 0, bid, nb);
    cvt_matrix<4>(lds, A.in[I_WR] + 1024 * 256, 256, 1024, 0, 256, (bf16_t*)(ws + WS_WR) + 256 * 1024, 0, bid, nb);
}
__device__ __forceinline__ void convert_experts(LAS unsigned char* lds, const Args& A, int layer, int bid, int nb, int part) {
    unsigned char* ws = A.ws;
    int kk = 0;
    for (int j = bid; j < NE1 * 16; j += nb, ++kk) {
        { const int pk = kk % 10, mine = (pk < 5) ? 0 : (pk < 8) ? 1 : 2; if (mine != part) continue; }
        const int e = j % NE1, t0 = j / NE1;
        const int t = (t0 < 8) ? 2 * t0 : 8 + t0;
        if (t < 16) {
            const float* src = (e < NEXP) ? A.in[I_WEI] + ((size_t)(layer * NEXP + e)) * 1024 * 512 : A.in[I_WSI] + (size_t)layer * 1024 * 512;
            unsigned char* dst = ws + WS_W1T + ((size_t)(layer * NE1 + e)) * 512 * 1024;
            const int tk = t >> 1;
            int dr[8];
#pragma unroll
            for (int q = 0; q < 8; ++q) { const int n0 = q * 64, gq = n0 >> 8, nn = n0 & 255; dr[q] = (nn >> 7) * 256 + gq * 128 + (nn & 127); }
            cvt8_multi<8>(lds, src, 512, tk * 128, 0, dst, 1024, dr, Q_SW);
        } else {
            const int t2 = t - 16, tk = t2 >> 2, g4 = t2 & 3;
            const float* src = (e < NEXP) ? A.in[I_WED] + ((size_t)(layer * NEXP + e)) * 256 * 1024 : A.in[I_WSD] + (size_t)layer * 256 * 1024;
            unsigned char* dst = ws + WS_W2T + ((size_t)(layer * NE1 + e)) * 1024 * 256;
            int dr[4];
#pragma unroll
            for (int q = 0; q < 4; ++q) dr[q] = g4 * 256 + q * 64;
            cvt8_multi<4>(lds, src, 1024, tk * 128, g4 * 256, dst, 256, dr, Q_SW);
        }
    }
}

__device__ __forceinline__ void phase_ln(const bf16_t* __restrict__ Z, bf16_t* __restrict__ H, unsigned char* __restrict__ HQ, const float* __restrict__ g, const float* __restrict__ b, int bid, int nb) {
    const int lane = threadIdx.x & 63, gw = bid * 8 + (threadIdx.x >> 6), nw = nb * 8;
    float gg[16], bb[16];
#pragma unroll
    for (int i = 0; i < 8; ++i) { gg[i] = g[lane * 8 + i]; gg[8 + i] = g[512 + lane * 8 + i]; bb[i] = b[lane * 8 + i]; bb[8 + i] = b[512 + lane * 8 + i]; }
    for (int row = gw; row < NTOK; row += nw) {
        const u32x4 a = *(const u32x4*)(Z + (size_t)row * DM + lane * 8), c = *(const u32x4*)(Z + (size_t)row * DM + 512 + lane * 8);
        float v[16];
        v[0] = bflo(a.x); v[1] = bfhi(a.x); v[2] = bflo(a.y); v[3] = bfhi(a.y); v[4] = bflo(a.z); v[5] = bfhi(a.z); v[6] = bflo(a.w); v[7] = bfhi(a.w);
        v[8] = bflo(c.x); v[9] = bfhi(c.x); v[10] = bflo(c.y); v[11] = bfhi(c.y); v[12] = bflo(c.z); v[13] = bfhi(c.z); v[14] = bflo(c.w); v[15] = bfhi(c.w);
        float s = 0.f;
#pragma unroll
        for (int i = 0; i < 16; ++i) s += v[i];
#pragma unroll
        for (int o = 32; o > 0; o >>= 1) s += __shfl_xor(s, o);
        const float mu = s * (1.f / 1024.f);
        float q = 0.f;
#pragma unroll
        for (int i = 0; i < 16; ++i) { const float d = v[i] - mu; q += d * d; }
#pragma unroll
        for (int o = 32; o > 0; o >>= 1) q += __shfl_xor(q, o);
        const float rs = rsqrtf(q * (1.f / 1024.f) + 1e-5f);
        float y[16];
#pragma unroll
        for (int i = 0; i < 16; ++i) y[i] = (v[i] - mu) * rs * gg[i] + bb[i];
        u32x4 w0, w1; w0.x = pk2(y[0], y[1]); w0.y = pk2(y[2], y[3]); w0.z = pk2(y[4], y[5]); w0.w = pk2(y[6], y[7]);
        w1.x = pk2(y[8], y[9]); w1.y = pk2(y[10], y[11]); w1.z = pk2(y[12], y[13]); w1.w = pk2(y[14], y[15]);
        *(u32x4*)(H + (size_t)row * DM + lane * 8) = w0; *(u32x4*)(H + (size_t)row * DM + 512 + lane * 8) = w1;
        u32x2 q0, q1;
        q0.x = pk4(q8(y[0], Q_SA), q8(y[1], Q_SA), q8(y[2], Q_SA), q8(y[3], Q_SA)); q0.y = pk4(q8(y[4], Q_SA), q8(y[5], Q_SA), q8(y[6], Q_SA), q8(y[7], Q_SA));
        q1.x = pk4(q8(y[8], Q_SA), q8(y[9], Q_SA), q8(y[10], Q_SA), q8(y[11], Q_SA)); q1.y = pk4(q8(y[12], Q_SA), q8(y[13], Q_SA), q8(y[14], Q_SA), q8(y[15], Q_SA));
        *(u32x2*)(HQ + (size_t)row * DM + lane * 8) = q0; *(u32x2*)(HQ + (size_t)row * DM + 512 + lane * 8) = q1;
    }
}

template <bool FINAL>
__device__ __forceinline__ void phase_combine(const unsigned char* __restrict__ Y, const int* __restrict__ posy, const float* __restrict__ tokw, const int* __restrict__ ntiles,
                                              const bf16_t* __restrict__ H1, bf16_t* __restrict__ H2, unsigned char* __restrict__ H2Q, float* __restrict__ OUT, float* __restrict__ GATES,
                                              const float* __restrict__ wgate, const float* __restrict__ g, const float* __restrict__ b, int bid, int nb) {
    const int shbase = (*ntiles - NTOK / 256) * 256;
    const int lane = threadIdx.x & 63, gw = bid * 8 + (threadIdx.x >> 6), nw = nb * 8;
    int npos = 0; float nwk = 0.f;
    if (gw < NTOK) { npos = (lane < 8) ? posy[(size_t)gw * 8 + lane] : shbase + gw; nwk = (lane < 8) ? tokw[(size_t)gw * 8 + lane] : 1.0f; }
    float gg[16], bb[16], wgt[FINAL ? 1 : 8][16];
#pragma unroll
    for (int i = 0; i < 8; ++i) { gg[i] = g[lane * 8 + i]; gg[8 + i] = g[512 + lane * 8 + i]; bb[i] = b[lane * 8 + i]; bb[8 + i] = b[512 + lane * 8 + i]; }
    if (!FINAL) {
#pragma unroll
        for (int gi = 0; gi < 8; ++gi)
#pragma unroll
            for (int i = 0; i < 8; ++i) { wgt[gi][i] = wgate[gi * 1024 + lane * 8 + i]; wgt[gi][8 + i] = wgate[gi * 1024 + 512 + lane * 8 + i]; }
    }
    for (int row = gw; row < NTOK; row += nw) {
        const int cpos = npos; const float cwk = nwk;
        { const int nr = row + nw; if (nr < NTOK) { npos = (lane < 8) ? posy[(size_t)nr * 8 + lane] : shbase + nr; nwk = (lane < 8) ? tokw[(size_t)nr * 8 + lane] : 1.0f; } }
        float v[16];
        { const u32x4 a = *(const u32x4*)(H1 + (size_t)row * DM + lane * 8), c = *(const u32x4*)(H1 + (size_t)row * DM + 512 + lane * 8);
          v[0] = bflo(a.x); v[1] = bfhi(a.x); v[2] = bflo(a.y); v[3] = bfhi(a.y); v[4] = bflo(a.z); v[5] = bfhi(a.z); v[6] = bflo(a.w); v[7] = bfhi(a.w);
          v[8] = bflo(c.x); v[9] = bfhi(c.x); v[10] = bflo(c.y); v[11] = bfhi(c.y); v[12] = bflo(c.z); v[13] = bfhi(c.z); v[14] = bflo(c.w); v[15] = bfhi(c.w); }
#pragma unroll
        for (int i = 0; i < 16; ++i) v[i] *= ALPHA;
        u32x2 ya[NSLOT], yc[NSLOT]; float wks[NSLOT];
#pragma unroll
        for (int k = 0; k < NSLOT; ++k) {
            const int pos = __builtin_amdgcn_readlane(cpos, k); wks[k] = __uint_as_float(__builtin_amdgcn_readlane(__float_as_uint(cwk), k)) * 0.0625f;
            const unsigned char* yr = Y + (size_t)pos * DM;
            ya[k] = *(const u32x2*)(yr + lane * 8); yc[k] = *(const u32x2*)(yr + 512 + lane * 8);
        }
        typedef float f32x2_ __attribute__((ext_vector_type(2)));
#pragma unroll
        for (int k = 0; k < NSLOT; ++k) {
            const float wk = wks[k];
            const f32x2_ a0 = __builtin_amdgcn_cvt_pk_f32_fp8((int)ya[k].x, false), a1 = __builtin_amdgcn_cvt_pk_f32_fp8((int)ya[k].x, true), a2 = __builtin_amdgcn_cvt_pk_f32_fp8((int)ya[k].y, false), a3 = __builtin_amdgcn_cvt_pk_f32_fp8((int)ya[k].y, true);
            const f32x2_ c0 = __builtin_amdgcn_cvt_pk_f32_fp8((int)yc[k].x, false), c1 = __builtin_amdgcn_cvt_pk_f32_fp8((int)yc[k].x, true), c2 = __builtin_amdgcn_cvt_pk_f32_fp8((int)yc[k].y, false), c3 = __builtin_amdgcn_cvt_pk_f32_fp8((int)yc[k].y, true);
            v[0] += wk * a0.x; v[1] += wk * a0.y; v[2] += wk * a1.x; v[3] += wk * a1.y; v[4] += wk * a2.x; v[5] += wk * a2.y; v[6] += wk * a3.x; v[7] += wk * a3.y;
            v[8] += wk * c0.x; v[9] += wk * c0.y; v[10] += wk * c1.x; v[11] += wk * c1.y; v[12] += wk * c2.x; v[13] += wk * c2.y; v[14] += wk * c3.x; v[15] += wk * c3.y;
        }
        float s = 0.f;
#pragma unroll
        for (int i = 0; i < 16; ++i) s += v[i];
#pragma unroll
        for (int o = 32; o > 0; o >>= 1) s += __shfl_xor(s, o);
        const float mu = s * (1.f / 1024.f);
        float q = 0.f;
#pragma unroll
        for (int i = 0; i < 16; ++i) { const float d = v[i] - mu; q += d * d; }
#pragma unroll
        for (int o = 32; o > 0; o >>= 1) q += __shfl_xor(q, o);
        const float rs = rsqrtf(q * (1.f / 1024.f) + 1e-5f);
        float y[16];
#pragma unroll
        for (int i = 0; i < 16; ++i) y[i] = (v[i] - mu) * rs * gg[i] + bb[i];
        if (FINAL) {
            float* o = OUT + (size_t)row * DM;
            *(f32x4*)(o + lane * 8) = (f32x4){y[0], y[1], y[2], y[3]}; *(f32x4*)(o + lane * 8 + 4) = (f32x4){y[4], y[5], y[6], y[7]};
            *(f32x4*)(o + 512 + lane * 8) = (f32x4){y[8], y[9], y[10], y[11]}; *(f32x4*)(o + 512 + lane * 8 + 4) = (f32x4){y[12], y[13], y[14], y[15]};
        } else {
            u32x4 w0, w1; w0.x = pk2(y[0], y[1]); w0.y = pk2(y[2], y[3]); w0.z = pk2(y[4], y[5]); w0.w = pk2(y[6], y[7]);
            w1.x = pk2(y[8], y[9]); w1.y = pk2(y[10], y[11]); w1.z = pk2(y[12], y[13]); w1.w = pk2(y[14], y[15]);
            *(u32x4*)(H2 + (size_t)row * DM + lane * 8) = w0; *(u32x4*)(H2 + (size_t)row * DM + 512 + lane * 8) = w1;
            { u32x2 q0, q1;
              q0.x = pk4(q8(y[0], Q_SA), q8(y[1], Q_SA), q8(y[2], Q_SA), q8(y[3], Q_SA)); q0.y = pk4(q8(y[4], Q_SA), q8(y[5], Q_SA), q8(y[6], Q_SA), q8(y[7], Q_SA));
              q1.x = pk4(q8(y[8], Q_SA), q8(y[9], Q_SA), q8(y[10], Q_SA), q8(y[11], Q_SA)); q1.y = pk4(q8(y[12], Q_SA), q8(y[13], Q_SA), q8(y[14], Q_SA), q8(y[15], Q_SA));
              *(u32x2*)(H2Q + (size_t)row * DM + lane * 8) = q0; *(u32x2*)(H2Q + (size_t)row * DM + 512 + lane * 8) = q1; }
            float yr[16];
            yr[0] = bflo(w0.x); yr[1] = bfhi(w0.x); yr[2] = bflo(w0.y); yr[3] = bfhi(w0.y); yr[4] = bflo(w0.z); yr[5] = bfhi(w0.z); yr[6] = bflo(w0.w); yr[7] = bfhi(w0.w);
            yr[8] = bflo(w1.x); yr[9] = bfhi(w1.x); yr[10] = bflo(w1.y); yr[11] = bfhi(w1.y); yr[12] = bflo(w1.z); yr[13] = bfhi(w1.z); yr[14] = bflo(w1.w); yr[15] = bfhi(w1.w);
            float d8[8];
#pragma unroll
            for (int gi = 0; gi < 8; ++gi) { float d = 0.f;
#pragma unroll
                for (int i = 0; i < 16; ++i) d += yr[i] * wgt[FINAL ? 0 : gi][i];
                d8[gi] = d; }
            float d4[4], d2[2], d1;
            { const bool hi = (lane & 32) != 0;
#pragma unroll
              for (int q = 0; q < 4; ++q) { const float keep = hi ? d8[4 + q] : d8[q], give = hi ? d8[q] : d8[4 + q]; d4[q] = keep + __shfl_xor(give, 32); } }
            { const bool hi = (lane & 16) != 0;
#pragma unroll
              for (int q = 0; q < 2; ++q) { const float keep = hi ? d4[2 + q] : d4[q], give = hi ? d4[q] : d4[2 + q]; d2[q] = keep + __shfl_xor(give, 16); } }
            { const bool hi = (lane & 8) != 0; const float keep = hi ? d2[1] : d2[0], give = hi ? d2[0] : d2[1]; d1 = keep + __shfl_xor(give, 8); }
            d1 += __shfl_xor(d1, 4); d1 += __shfl_xor(d1, 2); d1 += __shfl_xor(d1, 1);
            const int gidx = ((lane >> 5) & 1) * 4 + ((lane >> 4) & 1) * 2 + ((lane >> 3) & 1);
            const float gsum = d1;
            if ((lane & 7) == 0) GATES[(size_t)row * 8 + gidx] = gsum;
        }
    }
}

#ifndef VARSEL
#define VARSEL 0
#endif
template <bool DRY>
__device__ __forceinline__ void phase_select(LAS unsigned char* lds, const float* __restrict__ logits, const float* __restrict__ rbias, int* __restrict__ tok_e, int* __restrict__ tok_p,
                                             float* __restrict__ tok_w, unsigned* __restrict__ cnt, int bid, int nb) {
    const int tid = threadIdx.x, it = tid & 63, g8 = tid >> 6;
    LAS unsigned* hist = (LAS unsigned*)lds;
    LAS unsigned* base = hist + 256;
    LAS int* selE = (LAS int*)(base + 256);
    LAS int* selR = selE + 1024;
    LAS float* gsl = (LAS float*)(lds + 10240);
    LAS float* lv = (LAS float*)(lds + 12288);
    LAS int* le = (LAS int*)(lds + 28672);
    LAS float* sb = (LAS float*)(lds + 45056);
    const int tpw = NTOK / nb;
    const int t0 = bid * tpw;
    const float NEG = -3.0e38f;
    if (tid < 256) hist[tid] = 0u;
    __syncthreads();
    for (int half = 0; half < tpw / 64; ++half) {
        const int tb = t0 + half * 64;
        {
            const int e = tid & 255, tk0 = tid >> 8; const float rb = rbias[e];
#pragma unroll
            for (int i0 = 0; i0 < 32; i0 += 8) { float lv8[8];
#pragma unroll
                for (int u = 0; u < 8; ++u) lv8[u] = logits[(size_t)(tb + tk0 + 2 * (i0 + u)) * 256 + e];
#pragma unroll
                for (int u = 0; u < 8; ++u) sb[e * 65 + tk0 + 2 * (i0 + u)] = sigm(lv8[u]) + rb; }
        }
        __syncthreads();
        {
            float m1 = NEG, m2 = NEG;
            for (int j = 0; j < 32; ++j) { const float v = sb[(g8 * 32 + j) * 65 + it]; if (v > m1) { m2 = m1; m1 = v; } else if (v > m2) m2 = v; }
            gsl[g8 * 64 + it] = m1 + m2;
        }
        __syncthreads();
        if (DRY && VARSEL == 1) { __syncthreads(); continue; }
        float G[8];
#pragma unroll
        for (int q = 0; q < 8; ++q) G[q] = gsl[q * 64 + it];
        unsigned selmask = 0u;
#pragma unroll
        for (int g = 0; g < 8; ++g) { int rank = 0;
#pragma unroll
            for (int q = 0; q < 8; ++q) rank += (G[q] > G[g] || (G[q] == G[g] && q < g)) ? 1 : 0;
            if (rank < 4) selmask |= 1u << g; }
        if ((selmask >> g8) & 1u) {
            float vv[32];
#pragma unroll
            for (int j = 0; j < 32; ++j) vv[j] = sb[(g8 * 32 + j) * 65 + it];
#pragma unroll
            for (int k = 0; k < 8; ++k) {
                float bv = vv[0]; int bj = 0;
#pragma unroll
                for (int j = 1; j < 32; ++j) { const bool gt = vv[j] > bv; bv = gt ? vv[j] : bv; bj = gt ? j : bj; }
#pragma unroll
                for (int j = 0; j < 32; ++j) vv[j] = (j == bj) ? NEG : vv[j];
                lv[(g8 * 8 + k) * 64 + it] = bv; le[(g8 * 8 + k) * 64 + it] = g8 * 32 + bj;
            }
        }
        __syncthreads();
        if (DRY && VARSEL == 2) { __syncthreads(); continue; }
        if (tid < 64) {
            int gid[4]; { int n = 0;
#pragma unroll
                for (int g = 0; g < 8; ++g) if ((selmask >> g) & 1u) { if (n == 0) gid[0] = g; else if (n == 1) gid[1] = g; else if (n == 2) gid[2] = g; else gid[3] = g; ++n; } }
            float hv[4]; int hp[4];
#pragma unroll
            for (int j = 0; j < 4; ++j) { hp[j] = 0; hv[j] = lv[(gid[j] * 8) * 64 + it]; }
            float sc8[8]; int te[8]; float tot = 0.f;
#pragma unroll
            for (int k = 0; k < 8; ++k) {
                int bj = 0; float bv = hv[0];
                if (hv[1] > bv) { bv = hv[1]; bj = 1; }
                if (hv[2] > bv) { bv = hv[2]; bj = 2; }
                if (hv[3] > bv) { bv = hv[3]; bj = 3; }
                const int gsel = (bj == 0) ? gid[0] : (bj == 1) ? gid[1] : (bj == 2) ? gid[2] : gid[3];
                const int psel = (bj == 0) ? hp[0] : (bj == 1) ? hp[1] : (bj == 2) ? hp[2] : hp[3];
                const int e = le[(gsel * 8 + psel) * 64 + it];
                te[k] = e; sc8[k] = bv - rbias[e]; tot += sc8[k];
                const float nv = (psel < 7) ? lv[(gsel * 8 + psel + 1) * 64 + it] : NEG;
                if (bj == 0) { hv[0] = nv; hp[0] = psel + 1; } else if (bj == 1) { hv[1] = nv; hp[1] = psel + 1; } else if (bj == 2) { hv[2] = nv; hp[2] = psel + 1; } else { hv[3] = nv; hp[3] = psel + 1; }
            }
            const float inv = 2.5f / tot;
            const int tok = tb + it, lt = half * 64 + it;
#pragma unroll
            for (int k = 0; k < 8; ++k) {
                tok_e[(size_t)tok * 8 + k] = te[k]; tok_w[(size_t)tok * 8 + k] = sc8[k] * inv;
                const unsigned r = atomicAdd((unsigned*)&hist[te[k]], 1u);
                selE[lt * 8 + k] = te[k]; selR[lt * 8 + k] = (int)r;
            }
        }
        __syncthreads();
    }
    if (DRY) return;
    if (tid < 256) { const unsigned c = hist[tid]; base[tid] = c ? __hip_atomic_fetch_add(cnt + tid, c, __ATOMIC_RELAXED, __HIP_MEMORY_SCOPE_AGENT) : 0u; }
    __syncthreads();
    for (int i = tid; i < tpw * 8; i += 512) tok_p[(size_t)t0 * 8 + i] = (int)base[selE[i]] + selR[i];
    __syncthreads();
}

__device__ __forceinline__ void phase_dispatch(LAS unsigned char* lds, const unsigned* __restrict__ cnt, const int* __restrict__ tok_e, const int* __restrict__ tok_p,
                                               int* __restrict__ s_tok, int* __restrict__ posy, int* __restrict__ tile_exp, int* __restrict__ ntiles, int bid, int nb) {
    const int tid = threadIdx.x;
    LAS int* tstart = (LAS int*)lds;
    LAS int* tcnt = tstart + 260;
    if (tid < 256) tcnt[tid] = (int)((__hip_atomic_load(cnt + tid, __ATOMIC_RELAXED, __HIP_MEMORY_SCOPE_AGENT) + 255u) >> 8);
    __syncthreads();
    if (tid < 256) { int a = 0;
#pragma unroll 16
        for (int j = 0; j < 256; ++j) { const int c = tcnt[j]; a += (j < tid) ? c : 0; }
        tstart[tid] = a; if (tid == 255) tstart[256] = a + tcnt[255]; }
    __syncthreads();
    const int TT = tstart[256];
    const int tpw = NTOK / nb, t0 = bid * tpw;
    for (int i = tid; i < tpw * 8; i += 512) {
        const size_t a = (size_t)t0 * 8 + i; const int e = tok_e[a], p = tok_p[a];
        const int pos = tstart[e] * 256 + p;
        s_tok[pos] = (int)(a >> 3); posy[a] = pos;
    }
    for (int i = tid; i < tpw; i += 512) { const int tok = t0 + i; s_tok[TT * 256 + tok] = tok; }
    for (int e = bid; e < 256; e += nb) {
        const int c = (int)__hip_atomic_load(cnt + e, __ATOMIC_RELAXED, __HIP_MEMORY_SCOPE_AGENT), ts = tstart[e], tc = tcnt[e];
        for (int i = c + tid; i < tc * 256; i += 512) s_tok[ts * 256 + i] = 0;
        for (int i = tid; i < tc; i += 512) tile_exp[ts + i] = e;
    }
    if (bid == 0) { for (int i = tid; i < NTOK / 256; i += 512) tile_exp[TT + i] = 256; if (tid == 0) *ntiles = TT + NTOK / 256; }
    __syncthreads();
}

constexpr int MX_QT = 0, MX_KT = 17408, MX_KHT = 34816, MX_VT = 53248, MX_P = 73984, MX_ST = 83200, MX_SEG = 122368, MX_GD = 126464, MX_ER = 126976, MX_RS = 127488, MX_DEN = 128000, MX_BC = 128256, MX_IP = 128512, MX_GT = 128768;
struct MixP {
    const bf16_t* proj; int ldp; int pad0; unsigned char* ymix; const float* gates;
    const float* lb0; const float* bgk; const float* hg; const float* gg; const float* conv; const float* bif;
    float* ust; float* gsum;
};
#define MFMA16(a, b, c) __builtin_amdgcn_mfma_f32_16x16x32_bf16((a), (b), (c), 0, 0, 0)

template <int MODE, bool FULL, int VAR = 0>
__device__ __forceinline__ void mixer_run(LAS unsigned char* lds, const MixP& mp, int bid) {
    constexpr int DK = (MODE == 1) ? 64 : 128, QP = DK + 8, CP = DK / 2, RG = 512 / CP, RPT = 64 / RG, KS = DK / 32;
    constexpr int NVT = (MODE == 2) ? 9 : 8;
    constexpr int NST = (DK == 128) ? NVT : 4;
    const int tid = threadIdx.x, lane = tid & 63, w = __builtin_amdgcn_readfirstlane(tid >> 6), l15 = lane & 15, l4 = lane >> 4;
    int b, h, vh = 0, seg;
    if (MODE == 0) { const int sq = bid >> 4; b = sq >> 2; h = sq & 3; seg = bid & 15; }
    else if (MODE == 1) { const int sq = (bid - 128) >> 4; b = sq >> 2; h = sq & 3; seg = bid & 15; }
    else { const int sq = bid >> 4; b = sq >> 3; h = (sq >> 1) & 3; vh = sq & 1; seg = bid & 15; }
    const int tok0 = b * SEQ + seg * 1024;
    const int ldp = mp.ldp; const bf16_t* proj = mp.proj;
    int cq, ck, cv, cg, cy;
    if (MODE == 0) { cq = h * 128; ck = 512 + h * 128; cv = 1024 + h * 128; cg = 1536 + h * 128; cy = h * 128; }
    else if (MODE == 1) { cq = 2048 + h * 64; ck = 2304 + h * 64; cv = 2560 + h * 128; cg = 3072 + h * 128; cy = 512 + h * 128; }
    else { cq = h * 128; ck = 512 + h * 128; cv = 1024 + h * 256 + vh * 128; cg = 2048 + h * 256 + vh * 128; cy = h * 256 + vh * 128; }
    const int cu = 3584 + h * 64;
    const int cp = tid % CP, rg = tid / CP, d0 = 2 * cp;
    float lbv[2] = {0.f, 0.f}, oml[2] = {0.f, 0.f}, bgk[2] = {0.f, 0.f}, cwq[4][2], cwk[4][2];
    if (MODE == 0) { lbv[0] = mp.lb0[h * 128 + d0]; lbv[1] = mp.lb0[h * 128 + d0 + 1]; oml[0] = 1.f - lbv[0]; oml[1] = 1.f - lbv[1]; }
    if (MODE == 1) { bgk[0] = mp.bgk[h * 64 + d0]; bgk[1] = mp.bgk[h * 64 + d0 + 1]; }
#pragma unroll
    for (int j = 0; j < 4; ++j) { cwq[j][0] = cwq[j][1] = cwk[j][0] = cwk[j][1] = 0.f; }
    if (MODE == 2) {
#pragma unroll
        for (int j = 0; j < 4; ++j) { cwq[j][0] = mp.conv[j * 1024 + cq + d0]; cwq[j][1] = mp.conv[j * 1024 + cq + d0 + 1]; cwk[j][0] = mp.conv[j * 1024 + ck + d0]; cwk[j][1] = mp.conv[j * 1024 + ck + d0 + 1]; }
    }
    const float bi = (MODE == 2) ? mp.bif[h] : 0.f, bfg = (MODE == 2) ? mp.bif[4 + h] : 0.f;
    const int sdt = (DK == 128) ? w : (w & 3), svt0 = (DK == 128) ? 0 : 4 * (w >> 2);
    f32x4 S[NST];
#pragma unroll
    for (int t = 0; t < NST; ++t) S[t] = (f32x4){0.f, 0.f, 0.f, 0.f};
    float gacc[2] = {(MODE == 2) ? 0.f : 1.f, (MODE == 2) ? 0.f : 1.f};
    if (MODE == 2) {
        for (int i = tid; i < 16 * 72; i += 512) { const int r = i / 72; *(LAS bf16_t*)(lds + MX_VT + ((128 + r) * 72 + (i % 72)) * 2) = (r == 0) ? (bf16_t)0x3F80 : (bf16_t)0; }
    }
    if (FULL) {
        const int bid0 = bid & ~15;
#pragma unroll 2
        for (int j = 0; j < seg; ++j) {
            const float* U = mp.ust + ((size_t)(bid0 + j) * 8 + w) * (9 * 4 * 64);
            float dec[4];
            if (MODE == 2) { const float gsv = mp.gsum[(size_t)(bid0 + j) * 128]; dec[0] = dec[1] = dec[2] = dec[3] = __expf(gsv); }
            else {
#pragma unroll
                for (int r = 0; r < 4; ++r) dec[r] = mp.gsum[(size_t)(bid0 + j) * 128 + sdt * 16 + 4 * l4 + r];
            }
            f32x4 uu[NST];
#pragma unroll
            for (int t = 0; t < NST; ++t)
#pragma unroll
                for (int r = 0; r < 4; ++r) uu[t][r] = U[(t * 4 + r) * 64 + lane];
#pragma unroll
            for (int t = 0; t < NST; ++t)
#pragma unroll
                for (int r = 0; r < 4; ++r) S[t][r] = dec[r] * S[t][r] + uu[t][r];
        }
    }
    const int sj = w & 3, ovh = w >> 2, srow = 16 * sj + l15;
    const int vp = tid & 63, r0v = (tid >> 6) * 8;
    unsigned ra[RPT + 3], rb[RPT + 3], rc[RPT], pv[8]; u32x2 gnx[4]; float sgi = 0.f, sgf = 0.f;
#pragma unroll
    for (int i = 0; i < RPT + 3; ++i) { ra[i] = 0u; rb[i] = 0u; }
#pragma unroll
    for (int i = 0; i < RPT; ++i) rc[i] = 0u;
#pragma unroll
    for (int t = 0; t < 4; ++t) gnx[t] = (u32x2){0u, 0u};
#define MX_LOAD(cn) do { const int tokn_ = tok0 + (cn) * 64; \
        if (VAR == 1 || VAR == 3 || VAR == 4) { _Pragma("unroll") for (int i = 0; i < RPT + 3; ++i) { ra[i] = 0x3c003c00u + (unsigned)(cn); rb[i] = 0x3c003c00u; } _Pragma("unroll") for (int i = 0; i < RPT; ++i) rc[i] = 0x3c003c00u; _Pragma("unroll") for (int i = 0; i < 8; ++i) pv[i] = 0x3c003c00u; _Pragma("unroll") for (int t = 0; t < 4; ++t) gnx[t] = (u32x2){0x3c003c00u, 0x3c003c00u}; sgi = 0.1f; sgf = 3.f; } else \
        if (MODE == 2) { const int tl0_ = seg * 1024 + (cn) * 64 + rg * RPT; \
            _Pragma("unroll") for (int i = 0; i < RPT + 3; ++i) { const int tl_ = tl0_ - 3 + i; \
                if (tl_ >= 0) { const bf16_t* pr_ = proj + (size_t)(b * SEQ + tl_) * ldp; if (FULL) ra[i] = *(const unsigned*)(pr_ + cq + d0); rb[i] = *(const unsigned*)(pr_ + ck + d0); } \
                else { ra[i] = 0u; rb[i] = 0u; } } \
            if (w == 0) { const float* gp_ = mp.gates + (size_t)(tokn_ + lane) * 8; sgi = gp_[h]; sgf = gp_[4 + h]; } \
        } else { \
            _Pragma("unroll") for (int i = 0; i < RPT; ++i) { const bf16_t* pr_ = proj + (size_t)(tokn_ + rg * RPT + i) * ldp; \
                if (MODE == 0) { ra[i] = *(const unsigned*)(pr_ + ck + d0); if (FULL) rb[i] = *(const unsigned*)(pr_ + cq + d0); } \
                else { ra[i] = *(const unsigned*)(pr_ + cu + d0); rb[i] = *(const unsigned*)(pr_ + ck + d0); if (FULL) rc[i] = *(const unsigned*)(pr_ + cq + d0); } } \
        } \
        _Pragma("unroll") for (int i = 0; i < 8; ++i) pv[i] = *(const unsigned*)(proj + (size_t)(tokn_ + r0v + i) * ldp + cv + 2 * vp); \
        if (FULL) { _Pragma("unroll") for (int t = 0; t < 4; ++t) gnx[t] = *(const u32x2*)(proj + (size_t)(tokn_ + srow) * ldp + cg + 16 * (4 * ovh + t) + 4 * l4); } \
    } while (0)
    float gnv[4][4];
#pragma unroll
    for (int t = 0; t < 4; ++t)
#pragma unroll
        for (int r = 0; r < 4; ++r) gnv[t][r] = (FULL && MODE != 2) ? ((MODE == 0) ? mp.hg : mp.gg)[h * 128 + 16 * (4 * ovh + t) + 4 * l4 + r] : 1.f;
    MX_LOAD(0);
    __syncthreads();
    for (int c = 0; c < 16; ++c) {
        const int tokc = tok0 + c * 64;
        float la[RPT][2], sp[RPT][2], qv[RPT][2], kv[RPT][2];
        u32x2 gcur[4];
        if (VAR == 4) {
#pragma unroll
            for (int t = 0; t < 4; ++t) gcur[t] = gnx[t];
            __syncthreads(); __syncthreads(); goto stepC; }
#pragma unroll
        for (int t = 0; t < 4; ++t) gcur[t] = gnx[t];
        if (MODE == 2) {
            if (w == 0) {
                const float ip = sgi + bi, lf = logsig(sgf + bfg);
                float cs = lf;
#pragma unroll
                for (int o = 1; o < 64; o <<= 1) { const float t = __shfl_up(cs, o); if (lane >= o) cs += t; }
                *(LAS float*)(lds + MX_BC + lane * 4) = cs; *(LAS float*)(lds + MX_IP + lane * 4) = ip - cs;
                if (lane == 63) *(LAS float*)(lds + MX_GT) = cs;
            }
#pragma unroll
            for (int i = 0; i < RPT; ++i)
#pragma unroll
                for (int e = 0; e < 2; ++e) {
                    float aq = 0.f, ak = 0.f;
#pragma unroll
                    for (int j = 0; j < 4; ++j) { aq += cwq[j][e] * (e ? bfhi(ra[i + j]) : bflo(ra[i + j])); ak += cwk[j][e] * (e ? bfhi(rb[i + j]) : bflo(rb[i + j])); }
                    qv[i][e] = silu(aq); kv[i][e] = silu(ak) * 0.08838834764831845f; la[i][e] = 0.f; sp[i][e] = 0.f;
                }
        } else {
#pragma unroll
            for (int i = 0; i < RPT; ++i) {
                if (MODE == 0) {
                    const unsigned uz = ra[i];
                    const float s0 = sigm(bflo(uz)), s1 = sigm(bfhi(uz));
                    la[i][0] = lbv[0] + oml[0] * s0; la[i][1] = lbv[1] + oml[1] * s1;
                    kv[i][0] = oml[0] - oml[0] * s0; kv[i][1] = oml[1] - oml[1] * s1;
                    if (FULL) { const unsigned uq = rb[i]; qv[i][0] = silu(bflo(uq)); qv[i][1] = silu(bfhi(uq)); } else { qv[i][0] = qv[i][1] = 0.f; }
                } else {
                    const unsigned uu = ra[i], uk = rb[i];
                    la[i][0] = __expf(logsig(bflo(uu) + bgk[0]) * 0.0625f); la[i][1] = __expf(logsig(bfhi(uu) + bgk[1]) * 0.0625f);
                    kv[i][0] = bflo(uk); kv[i][1] = bfhi(uk);
                    if (FULL) { const unsigned uq = rc[i]; qv[i][0] = bflo(uq) * 0.125f; qv[i][1] = bfhi(uq) * 0.125f; } else { qv[i][0] = qv[i][1] = 0.f; }
                }
            }
#pragma unroll
            for (int e = 0; e < 2; ++e) {
                float run = 1.f;
#pragma unroll
                for (int i = RPT - 1; i >= 0; --i) { sp[i][e] = run; run *= la[i][e]; }
                run = 1.f;
#pragma unroll
                for (int i = 0; i < RPT; ++i) { run *= la[i][e]; la[i][e] = run; }
            }
            *(LAS float*)(lds + MX_SEG + (rg * DK + d0) * 4) = la[RPT - 1][0]; *(LAS float*)(lds + MX_SEG + (rg * DK + d0 + 1) * 4) = la[RPT - 1][1];
        }
        {
            u32x4 lo, hi;
            lo.x = (pv[0] & 0xffffu) | (pv[1] << 16); lo.y = (pv[2] & 0xffffu) | (pv[3] << 16); lo.z = (pv[4] & 0xffffu) | (pv[5] << 16); lo.w = (pv[6] & 0xffffu) | (pv[7] << 16);
            hi.x = (pv[0] >> 16) | (pv[1] & 0xffff0000u); hi.y = (pv[2] >> 16) | (pv[3] & 0xffff0000u); hi.z = (pv[4] >> 16) | (pv[5] & 0xffff0000u); hi.w = (pv[6] >> 16) | (pv[7] & 0xffff0000u);
            *(LAS u32x4*)(lds + MX_VT + ((2 * vp) * 72 + r0v) * 2) = lo; *(LAS u32x4*)(lds + MX_VT + ((2 * vp + 1) * 72 + r0v) * 2) = hi;
        }
        if (c + 1 < 16) MX_LOAD(c + 1);
        if (VAR == 2) { unsigned xa = 0; _Pragma("unroll") for (int i = 0; i < RPT + 3; ++i) xa ^= ra[i] ^ rb[i]; _Pragma("unroll") for (int i = 0; i < RPT; ++i) xa ^= rc[i]; _Pragma("unroll") for (int i = 0; i < 8; ++i) xa ^= pv[i];
            _Pragma("unroll") for (int t = 0; t < 4; ++t) xa ^= gnx[t].x ^ gnx[t].y; gacc[0] += (float)(xa & 1u) + sgi + sgf; continue; }
        __syncthreads();
        {
            float pre[2], h2[2], gt[2];
            if (MODE == 2) {
                const float g = *(LAS float*)(lds + MX_GT);
                gt[0] = gt[1] = g; h2[0] = h2[1] = 0.f; pre[0] = pre[1] = 0.f;
                if (tid == 0) gacc[0] += g;
            } else {
#pragma unroll
                for (int e = 0; e < 2; ++e) { float p = 1.f, a1 = 1.f, a2 = 1.f;
#pragma unroll
                    for (int j = 0; j < RG; ++j) { const float v = *(LAS float*)(lds + MX_SEG + (j * DK + d0 + e) * 4);
                        if (j < RG / 2) a1 *= v; else a2 *= v;
                        const bool inb = (rg >= RG / 2) ? (j >= RG / 2 && j < rg) : (j > rg && j < RG / 2);
                        p *= inb ? v : 1.f; }
                    pre[e] = p; h2[e] = a2; gt[e] = a1 * a2;
                    if (rg == 0) { gacc[e] *= gt[e]; *(LAS float*)(lds + MX_GD + (d0 + e) * 4) = gt[e]; *(LAS float*)(lds + MX_ER + (d0 + e) * 4) = a1; } }
            }
            float kh[RPT][2];
#pragma unroll
            for (int i = 0; i < RPT; ++i) {
                const int s = rg * RPT + i;
                float qs[2], ks[2];
                if (MODE == 2) {
                    const float bc = *(LAS float*)(lds + MX_BC + s * 4), ipb = *(LAS float*)(lds + MX_IP + s * 4);
                    const float eq = __expf(bc), ek = __expf(ipb), eg = __expf(gt[0]);
                    qs[0] = qv[i][0] * eq; qs[1] = qv[i][1] * eq; ks[0] = kv[i][0] * ek; ks[1] = kv[i][1] * ek; kh[i][0] = ks[0] * eg; kh[i][1] = ks[1] * eg;
                } else {
#pragma unroll
                    for (int e = 0; e < 2; ++e) {
                        const float cd = pre[e] * ((rg >= RG / 2) ? la[i][e] : sp[i][e]);
                        const float rc_ = __builtin_amdgcn_rcpf(cd);
                        const float qm = (rg >= RG / 2) ? cd : rc_, km = (rg >= RG / 2) ? rc_ : cd;
                        qs[e] = qv[i][e] * qm; ks[e] = kv[i][e] * km; kh[i][e] = ks[e] * h2[e]; }
                }
                if (FULL) { *(LAS unsigned*)(lds + MX_QT + (s * QP + d0) * 2) = pk2(qs[0], qs[1]); *(LAS unsigned*)(lds + MX_KT + (s * QP + d0) * 2) = pk2(ks[0], ks[1]); }
            }
            if (RPT == 8) {
                u32x4 a, bq;
                a.x = pk2(kh[0][0], kh[1][0]); a.y = pk2(kh[2][0], kh[3][0]); a.z = pk2(kh[4 % RPT][0], kh[5 % RPT][0]); a.w = pk2(kh[6 % RPT][0], kh[7 % RPT][0]);
                bq.x = pk2(kh[0][1], kh[1][1]); bq.y = pk2(kh[2][1], kh[3][1]); bq.z = pk2(kh[4 % RPT][1], kh[5 % RPT][1]); bq.w = pk2(kh[6 % RPT][1], kh[7 % RPT][1]);
                *(LAS u32x4*)(lds + MX_KHT + (d0 * 72 + rg * 8) * 2) = a; *(LAS u32x4*)(lds + MX_KHT + ((d0 + 1) * 72 + rg * 8) * 2) = bq;
            } else {
                u32x2 a, bq;
                a.x = pk2(kh[0][0], kh[1][0]); a.y = pk2(kh[2][0], kh[3][0]); bq.x = pk2(kh[0][1], kh[1][1]); bq.y = pk2(kh[2][1], kh[3][1]);
                *(LAS u32x2*)(lds + MX_KHT + (d0 * 72 + rg * 4) * 2) = a; *(LAS u32x2*)(lds + MX_KHT + ((d0 + 1) * 72 + rg * 4) * 2) = bq;
            }
        }
        __syncthreads();
        stepC:
        if (FULL && VAR != 3) {
#pragma unroll
            for (int tt = 0; tt < 2; ++tt) {
                const int tile = 2 * w + tt, ti = tile >> 2, tj = tile & 3;
                f32x4 acc = (f32x4){0.f, 0.f, 0.f, 0.f};
                if (ti <= tj) {
#pragma unroll
                    for (int kk = 0; kk < KS; ++kk) {
                        const bf16x8 a = *(const LAS bf16x8*)(lds + MX_KT + ((16 * ti + l15) * QP + kk * 32 + 8 * l4) * 2);
                        const bf16x8 bq = *(const LAS bf16x8*)(lds + MX_QT + ((16 * tj + l15) * QP + kk * 32 + 8 * l4) * 2);
                        acc = MFMA16(a, bq, acc);
                    }
                }
                const int s = 16 * tj + l15, sp0 = 16 * ti + 4 * l4;
                float pvv[4];
#pragma unroll
                for (int r = 0; r < 4; ++r) pvv[r] = (sp0 + r <= s) ? acc[r] : 0.f;
                u32x2 pw; pw.x = pk2(pvv[0], pvv[1]); pw.y = pk2(pvv[2], pvv[3]);
                *(LAS u32x2*)(lds + MX_P + (s * 72 + sp0) * 2) = pw;
            }
            {
                float er[4];
#pragma unroll
                for (int r = 0; r < 4; ++r) er[r] = (MODE == 2) ? 1.f : *(LAS float*)(lds + MX_ER + (sdt * 16 + 4 * l4 + r) * 4);
#pragma unroll
                for (int t = 0; t < NST; ++t) {
                    const int v = 16 * (svt0 + t) + l15;
                    u32x2 sw; sw.x = pk2(S[t][0] * er[0], S[t][1] * er[1]); sw.y = pk2(S[t][2] * er[2], S[t][3] * er[3]);
                    *(LAS u32x2*)(lds + MX_ST + (v * QP + sdt * 16 + 4 * l4) * 2) = sw;
                }
            }
            {
                float dec[4];
                if (MODE == 2) { const float eg = __expf(*(LAS float*)(lds + MX_GT)); dec[0] = dec[1] = dec[2] = dec[3] = eg; }
                else {
    #pragma unroll
                    for (int r = 0; r < 4; ++r) dec[r] = *(LAS float*)(lds + MX_GD + (sdt * 16 + 4 * l4 + r) * 4);
                }
                bf16x8 ka[2];
    #pragma unroll
                for (int kk = 0; kk < 2; ++kk) ka[kk] = *(const LAS bf16x8*)(lds + MX_KHT + ((16 * sdt + l15) * 72 + kk * 32 + 8 * l4) * 2);
    #pragma unroll
                for (int t = 0; t < NST; ++t) {
    #pragma unroll
                    for (int r = 0; r < 4; ++r) S[t][r] *= dec[r];
    #pragma unroll
                    for (int kk = 0; kk < 2; ++kk) {
                        const bf16x8 vb = *(const LAS bf16x8*)(lds + MX_VT + ((16 * (svt0 + t) + l15) * 72 + kk * 32 + 8 * l4) * 2);
                        S[t] = MFMA16(ka[kk], vb, S[t]);
                    }
                }
            }
            __syncthreads();
            constexpr int NOT = (MODE == 2) ? 5 : 4;
            f32x4 O[NOT];
#pragma unroll
            for (int t = 0; t < NOT; ++t) O[t] = (f32x4){0.f, 0.f, 0.f, 0.f};
#pragma unroll
            for (int kk = 0; kk < 2; ++kk) {
                const bf16x8 bq = *(const LAS bf16x8*)(lds + MX_P + ((16 * sj + l15) * 72 + kk * 32 + 8 * l4) * 2);
#pragma unroll
                for (int t = 0; t < NOT; ++t) { const int vt = (t < 4) ? (4 * ovh + t) : 8;
                    if (t < 4 || ovh == 0) { const bf16x8 a = *(const LAS bf16x8*)(lds + MX_VT + ((16 * vt + l15) * 72 + kk * 32 + 8 * l4) * 2); O[t] = MFMA16(a, bq, O[t]); } }
            }
#pragma unroll
            for (int kk = 0; kk < KS; ++kk) {
                const bf16x8 bq = *(const LAS bf16x8*)(lds + MX_QT + ((16 * sj + l15) * QP + kk * 32 + 8 * l4) * 2);
#pragma unroll
                for (int t = 0; t < NOT; ++t) { const int vt = (t < 4) ? (4 * ovh + t) : 8;
                    if (t < 4 || ovh == 0) { const bf16x8 a = *(const LAS bf16x8*)(lds + MX_ST + ((16 * vt + l15) * QP + kk * 32 + 8 * l4) * 2); O[t] = MFMA16(a, bq, O[t]); } }
            }
            const int tokr = tokc + srow;
            float scale;
            if (MODE == 2) {
                if (ovh == 0 && l4 == 0) *(LAS float*)(lds + MX_DEN + srow * 4) = O[NOT - 1][0];
                __syncthreads();
                const float den = *(LAS float*)(lds + MX_DEN + srow * 4);
                scale = 1.f / fmaxf(fabsf(den), 1.f);
            } else {
                float ss = 0.f;
#pragma unroll
                for (int t = 0; t < 4; ++t)
#pragma unroll
                    for (int r = 0; r < 4; ++r) ss += O[t][r] * O[t][r];
                ss += __shfl_xor(ss, 16); ss += __shfl_xor(ss, 32);
                if (l4 == 0) *(LAS float*)(lds + MX_RS + (ovh * 64 + srow) * 4) = ss;
                __syncthreads();
                const float tot = *(LAS float*)(lds + MX_RS + srow * 4) + *(LAS float*)(lds + MX_RS + (64 + srow) * 4);
                scale = rsqrtf(tot * (1.f / 128.f) + 1e-6f);
            }
#pragma unroll
            for (int t = 0; t < 4; ++t) {
                const int v0 = 16 * (4 * ovh + t) + 4 * l4;
                const u32x2 gt = gcur[t];
                const float g0 = bflo(gt.x), g1 = bfhi(gt.x), g2 = bflo(gt.y), g3 = bfhi(gt.y);
                float y0, y1, y2, y3;
                if (MODE == 2) { y0 = O[t][0] * scale * sigm(g0); y1 = O[t][1] * scale * sigm(g1); y2 = O[t][2] * scale * sigm(g2); y3 = O[t][3] * scale * sigm(g3); }
                else { y0 = O[t][0] * scale * gnv[t][0] * silu(g0); y1 = O[t][1] * scale * gnv[t][1] * silu(g1); y2 = O[t][2] * scale * gnv[t][2] * silu(g2); y3 = O[t][3] * scale * gnv[t][3] * silu(g3); }
                *(LAS unsigned*)(lds + MX_P + srow * 128 + ((((v0 >> 4)) ^ (srow & 7)) << 4) + (v0 & 15)) = pk4(q8(y0, Q_SY), q8(y1, Q_SY), q8(y2, Q_SY), q8(y3, Q_SY));
            }
            __syncthreads();
            { const int yr = tid >> 3, yc = tid & 7;
              const u32x4 yv = *(const LAS u32x4*)(lds + MX_P + yr * 128 + ((yc ^ (yr & 7)) << 4));
              *(u32x4*)(mp.ymix + (size_t)(tokc + yr) * DM + cy + yc * 16) = yv; }
        }
        if (!FULL || VAR == 3) {
            {
                float dec[4];
                if (MODE == 2) { const float eg = __expf(*(LAS float*)(lds + MX_GT)); dec[0] = dec[1] = dec[2] = dec[3] = eg; }
                else {
    #pragma unroll
                    for (int r = 0; r < 4; ++r) dec[r] = *(LAS float*)(lds + MX_GD + (sdt * 16 + 4 * l4 + r) * 4);
                }
                bf16x8 ka[2];
    #pragma unroll
                for (int kk = 0; kk < 2; ++kk) ka[kk] = *(const LAS bf16x8*)(lds + MX_KHT + ((16 * sdt + l15) * 72 + kk * 32 + 8 * l4) * 2);
    #pragma unroll
                for (int t = 0; t < NST; ++t) {
    #pragma unroll
                    for (int r = 0; r < 4; ++r) S[t][r] *= dec[r];
    #pragma unroll
                    for (int kk = 0; kk < 2; ++kk) {
                        const bf16x8 vb = *(const LAS bf16x8*)(lds + MX_VT + ((16 * (svt0 + t) + l15) * 72 + kk * 32 + 8 * l4) * 2);
                        S[t] = MFMA16(ka[kk], vb, S[t]);
                    }
                }
            }
        __syncthreads();
        }
    }
#undef MX_LOAD
    if (VAR == 2) { mp.ust[(size_t)bid * 512 + tid] = gacc[0]; return; }
    if (!FULL) {
        float* U = mp.ust + ((size_t)bid * 8 + w) * (9 * 4 * 64);
#pragma unroll
        for (int t = 0; t < NST; ++t)
#pragma unroll
            for (int r = 0; r < 4; ++r) U[(t * 4 + r) * 64 + lane] = S[t][r];
        if (MODE == 2) { if (tid == 0) mp.gsum[(size_t)bid * 128] = gacc[0]; }
        else if (rg == 0) { mp.gsum[(size_t)bid * 128 + d0] = gacc[0]; mp.gsum[(size_t)bid * 128 + d0 + 1] = gacc[1]; }
    }
}

#ifndef PHMASK
#define PHMASK 0xFFFFu
#endif
#ifndef MIXSEL
#define MIXSEL 7
#endif
#ifndef REPMASK
#define REPMASK 0x0u
#endif
#define EN(j) (((PHMASK) >> (j)) & 1u)
#ifndef REPLAYER
#define REPLAYER 3
#endif
#define NREP(j) (1 + (int)((((REPMASK) >> (j)) & 1u) & (((REPLAYER) >> layer) & 1u)))
#define IN(k) (lo <= (k) && (k) < hi)
#define SEAM(k) do { if (IN((k) + 1)) xcd_barrier(bar); } while (0)

template <int layer> __device__ __forceinline__ void ph_proj(LAS unsigned char* lds, unsigned char* ws, int bid, int nb) {
    pg8::Gemm g{(const bf16_t*)(ws + (layer ? WS_H2Q : WS_XQ)), (const bf16_t*)(ws + (layer ? WS_WC : WS_WAB)), DM / 2};
    pg8::StaticOrder S; S.init(NTOK, layer ? CWID : ABW, nb, bid);
    pg8::EpiStoreBf16<true> E{(bf16_t*)(ws + WS_PROJ), layer ? CWID : ABW};
    pg8::gemm_phase<pg8::EpiStoreBf16<true>, pg8::StaticOrder, false, true>(lds, g, nullptr, S, E);
}
template <int layer> __device__ __forceinline__ void ph_outproj(LAS unsigned char* lds, unsigned char* ws, int bid, int nb) {
    pg8::Gemm g{(const bf16_t*)(ws + WS_YMIX), (const bf16_t*)(ws + (layer ? WS_WOC : WS_WOAB)), DM / 2};
    pg8::StaticOrder S; S.init(NTOK, DM, nb, bid);
    pg8::EpiResid E{(bf16_t*)(ws + WS_Z), (const bf16_t*)(ws + (layer ? WS_H2 : WS_HB))};
    pg8::gemm_phase<pg8::EpiResid, pg8::StaticOrder, false, true>(lds, g, nullptr, S, E);
}
template <int layer> __device__ __forceinline__ void ph_router(LAS unsigned char* lds, unsigned char* ws, int bid, int nb) {
    pg8::Gemm g{(const bf16_t*)(ws + WS_H1), (const bf16_t*)(ws + WS_WR) + (size_t)layer * 256 * 1024, DM};
    pg8::StaticOrder S; S.init(NTOK, 256, nb, bid);
    pg8::EpiF32 E{(float*)(ws + WS_LOGITS)};
    pg8::gemm_phase<pg8::EpiF32, pg8::StaticOrder, false>(lds, g, nullptr, S, E);
}
template <int layer> __device__ __forceinline__ void ph_gemm1(LAS unsigned char* lds, unsigned char* ws, int bid, int nb) {
    const int vcu = (nb % 8 == 0) ? (bid % 8) * (nb / 8) + bid / 8 : bid;
    const int nt = __builtin_amdgcn_readfirstlane(*(volatile int*)(ws + WS_MISC + 65536 + 8192));
    pg8::Gemm g{(const bf16_t*)(ws + WS_H1Q), (const bf16_t*)(ws + WS_W1T + (size_t)layer * NE1 * 512 * 1024), DM / 2};
    const int nu = pg8::moe_prep(lds, (const int*)(ws + WS_MISC + 65536), nt * 2, 1, nb, vcu, (const int*)(ws + WS_STOK));
    pg8::MoeOrder S{(const LAS int*)(lds + pg8::LDS_UT), nu < pg8::MOE_MAXU ? nu : pg8::MOE_MAXU};
    pg8::EpiSwiGLU<true> E{ws + WS_ACT, lds + 3 * pg8::HTB};
    pg8::gemm_phase<pg8::EpiSwiGLU<true>, pg8::MoeOrder, true, true>(lds, g, (const LAS int*)(lds + pg8::LDS_IDX), S, E);
}
template <int layer> __device__ __forceinline__ void ph_gemm2(LAS unsigned char* lds, unsigned char* ws, int bid, int nb) {
    const int vcu = (nb % 8 == 0) ? (bid % 8) * (nb / 8) + bid / 8 : bid;
    const int nt = __builtin_amdgcn_readfirstlane(*(volatile int*)(ws + WS_MISC + 65536 + 8192));
    int kq = 128; asm volatile("" : "+s"(kq));
    pg8::Gemm g{(const bf16_t*)(ws + WS_ACT), (const bf16_t*)(ws + WS_W2T + (size_t)layer * NE1 * 1024 * 256), kq};
    const int nu = pg8::moe_prep(lds, (const int*)(ws + WS_MISC + 65536), nt * 4, 2, nb, vcu, nullptr);
    pg8::MoeOrder S{(const LAS int*)(lds + pg8::LDS_UT), nu};
    pg8::EpiDown E{(unsigned char*)(ws + WS_Y), lds + 3 * pg8::HTB};
    pg8::gemm_phase<pg8::EpiDown, pg8::MoeOrder, false, true>(lds, g, nullptr, S, E);
#ifndef EXPG
#define EXPG 0
#endif
#if EXPG
    { __syncthreads(); pg8::EpiDownT<EXPG - 1> E2{(unsigned char*)(ws + WS_PROJ), lds + 3 * pg8::HTB};
      pg8::gemm_phase<pg8::EpiDownT<EXPG - 1>, pg8::MoeOrder, false, true>(lds, g, nullptr, S, E2); }
#endif
}
template <int layer, bool FULLP> __device__ __forceinline__ void ph_mixer(LAS unsigned char* lds, const Args& A, int bid, int nb) {
    unsigned char* ws = A.ws;
    if (nb != NWG) return;
    MixP mp{(const bf16_t*)(ws + WS_PROJ), layer ? CWID : ABW, 0, ws + WS_YMIX, (const float*)(ws + WS_GATES), (const float*)(ws + WS_MISC), A.in[I_BGK], A.in[I_HG], A.in[I_GG], A.in[I_CONV], A.in[I_BIF], (float*)(ws + WS_UST), (float*)(ws + WS_GSUM)};
    if (layer == 0) { if (bid < 128) { if (MIXSEL & 1) mixer_run<0, FULLP>(lds, mp, bid); } else { if (MIXSEL & 2) mixer_run<1, FULLP>(lds, mp, bid); } }
    else { if (MIXSEL & 4) mixer_run<2, FULLP>(lds, mp, bid); }
#ifndef EXPV
#define EXPV 0
#endif
#ifndef EXPL
#define EXPL 0
#endif
#if EXPV
    if (FULLP && layer == EXPL) { MixP md = mp; md.ymix = (bf16_t*)(ws + WS_Z); md.ust = (float*)(ws + WS_LOGITS); md.gsum = (float*)(ws + WS_LOGITS + 24 * MiB);
        __syncthreads();
        if (layer == 0) { if (bid < 128) mixer_run<0, true, EXPV>(lds, md, bid); else mixer_run<1, true, EXPV>(lds, md, bid); }
        else mixer_run<2, true, EXPV>(lds, md, bid); }
#endif
}
#define REP2(j, call) do { call; if (NREP(j) == 2) { __syncthreads(); call; } } while (0)

template <int layer>
__device__ __forceinline__ void run_layer(LAS unsigned char* lds, const Args& A, const XcdBarrier& bar, const int lo, const int hi) {
    const int bid = blockIdx.x, nb = gridDim.x;
    unsigned char* ws = A.ws;
    unsigned* ctl = (unsigned*)(ws + WS_CTL);
    constexpr int P = 1 + layer * 11;
    if (EN(0) && IN(P + 0)) {
        if (bid & 1) convert_experts(lds, A, layer, bid, nb, layer);
        REP2(0, ph_proj<layer>(lds, ws, bid, nb));
        if (!(bid & 1)) convert_experts(lds, A, layer, bid, nb, layer);
        SEAM(P + 0); }
    if (EN(1) && IN(P + 1)) { REP2(1, (ph_mixer<layer, false>(lds, A, bid, nb))); SEAM(P + 1); }
    if (EN(2) && IN(P + 2)) { REP2(2, (ph_mixer<layer, true>(lds, A, bid, nb))); SEAM(P + 2); }
    if (EN(3) && IN(P + 3)) {
        if (layer == 0 && (bid & 1)) convert_experts(lds, A, 0, bid, nb, 1);
        REP2(3, ph_outproj<layer>(lds, ws, bid, nb));
        if (layer == 0 && !(bid & 1)) convert_experts(lds, A, 0, bid, nb, 1);
        SEAM(P + 3); }
    if (EN(4) && IN(P + 4)) { REP2(4, phase_ln((const bf16_t*)(ws + WS_Z), (bf16_t*)(ws + WS_H1), ws + WS_H1Q, A.in[I_LMG] + layer * DM, A.in[I_LMB] + layer * DM, bid, nb)); SEAM(P + 4); }
    if (EN(5) && IN(P + 5)) {
        if (bid & 1) { convert_experts(lds, A, layer, bid, nb, 2); convert_experts(lds, A, layer, bid - 1, nb, 2); }
        else ph_router<layer>(lds, ws, bid >> 1, nb >> 1);
        SEAM(P + 5); }
    if (EN(6) && IN(P + 6)) {
        phase_select<false>(lds, (const float*)(ws + WS_LOGITS), A.in[I_RB] + layer * NEXP, (int*)(ws + WS_TOKE), (int*)(ws + WS_TOKP), (float*)(ws + WS_TOKW), ctl + CW_CNT + layer * 256, bid, nb);
        if (NREP(6) == 2) phase_select<true>(lds, (const float*)(ws + WS_LOGITS), A.in[I_RB] + layer * NEXP, (int*)(ws + WS_TOKE), (int*)(ws + WS_TOKP), (float*)(ws + WS_TOKW), ctl + CW_CNT + layer * 256, bid, nb);
        SEAM(P + 6); }
    if (EN(7) && IN(P + 7)) { REP2(7, phase_dispatch(lds, ctl + CW_CNT + layer * 256, (const int*)(ws + WS_TOKE), (const int*)(ws + WS_TOKP), (int*)(ws + WS_STOK), (int*)(ws + WS_POSY), (int*)(ws + WS_MISC + 65536), (int*)(ws + WS_MISC + 65536 + 8192), bid, nb)); SEAM(P + 7); }
    if (EN(8) && IN(P + 8)) {
        if (layer == 0 && (bid & 1)) convert_experts(lds, A, 1, bid, nb, 0);
        REP2(8, ph_gemm1<layer>(lds, ws, bid, nb));
        if (layer == 0 && !(bid & 1)) convert_experts(lds, A, 1, bid, nb, 0);
        SEAM(P + 8); }
    if (EN(9) && IN(P + 9)) { REP2(9, ph_gemm2<layer>(lds, ws, bid, nb)); SEAM(P + 9); }
    if (EN(10) && IN(P + 10)) {
        if (layer == 0) REP2(10, (phase_combine<false>((const unsigned char*)(ws + WS_Y), (const int*)(ws + WS_POSY), (const float*)(ws + WS_TOKW), (const int*)(ws + WS_MISC + 65536 + 8192), (const bf16_t*)(ws + WS_H1), (bf16_t*)(ws + WS_H2), ws + WS_H2Q, nullptr, (float*)(ws + WS_GATES), (const float*)(ws + WS_MISC + 4096), A.in[I_LFG], A.in[I_LFB], bid, nb)));
        else REP2(10, (phase_combine<true>((const unsigned char*)(ws + WS_Y), (const int*)(ws + WS_POSY), (const float*)(ws + WS_TOKW), (const int*)(ws + WS_MISC + 65536 + 8192), (const bf16_t*)(ws + WS_H1), nullptr, nullptr, A.out, nullptr, nullptr, A.in[I_LFG] + DM, A.in[I_LFB] + DM, bid, nb)));
        SEAM(P + 10);
    }
}

__global__ void __launch_bounds__(512, 2) fwd_kernel(Args A) {
    extern __shared__ __attribute__((aligned(16))) unsigned char lds_raw[];
    LAS unsigned char* lds = (LAS unsigned char*)lds_raw;
    const int tid = threadIdx.x;
    unsigned* ctl = (unsigned*)(A.ws + WS_CTL);
    volatile LAS unsigned* misc = (volatile LAS unsigned*)(lds + LDS_MISC);
    if (tid < 64) misc[tid] = 0u;
    __syncthreads();
    const int lo = A.ph_lo, hi = A.ph_hi;
    XcdBarrier bar; bar.bar = ctl + CW_BAR; bar.x = 0; bar.st = misc;
    if (hi - lo > 1) bar = xcd_barrier_post(ctl + CW_BAR, misc);
    if (EN(11) && IN(0)) { for (int rep_ = 0; rep_ < 1 + (int)(((REPMASK) >> 11) & 1u); ++rep_) phase_prologue(lds, A, blockIdx.x, gridDim.x); SEAM(0); }
    run_layer<0>(lds, A, bar, lo, hi);
    run_layer<1>(lds, A, bar, lo, hi);
}
#undef IN
#undef SEAM

#ifdef DBG
__device__ __forceinline__ unsigned hash32(unsigned x) { x ^= x >> 16; x *= 0x7feb352dU; x ^= x >> 15; x *= 0x846ca68bU; x ^= x >> 16; return x; }
__device__ __forceinline__ void dbg_acc(float* w, int stage, float num, float den) { if (!(num == num) || num > 1e30f) num = 1e30f; atomicAdd(w + 2 * stage, num); atomicAdd(w + 2 * stage + 1, den); }
__device__ __forceinline__ float bfr(float x) { return bflo(pk2(x, 0.f)); }
__global__ void dbg_weights(Args A, float* w) {
    const unsigned i = blockIdx.x * 256 + threadIdx.x; unsigned char* ws = A.ws;
    float num = 0.f, den = 0.f;
    { const unsigned hsh = hash32(i * 4 + 0), col = hsh % 3584, k = (hsh >> 12) % 1024; const float r = A.in[I_WINAB][(size_t)k * 3600 + col], g = bf2f(((const bf16_t*)(ws + WS_WAB))[(size_t)col * 1024 + k]); num += (r - g) * (r - g); den += r * r; }
    { const unsigned hsh = hash32(i * 4 + 1), j = hsh % 256, k = (hsh >> 12) % 1024; float r = 0.f; for (int q = 0; q < 16; ++q) r += A.in[I_WINAB][(size_t)k * 3600 + 3584 + q] * A.in[I_WGKUP][q * 256 + j];
      const float g = bf2f(((const bf16_t*)(ws + WS_WAB))[(size_t)(3584 + j) * 1024 + k]); num += (r - g) * (r - g); den += r * r; }
    { const unsigned hsh = hash32(i * 4 + 2), le = hsh % 514, layer = le / 257, e = le % 257, n = (hsh >> 10) % 512, k = (hsh >> 20) % 1024;
      const float r = (e < 256) ? A.in[I_WEI][((size_t)(layer * 256 + e) * 1024 + k) * 512 + n] : A.in[I_WSI][((size_t)layer * 1024 + k) * 512 + n];
      const unsigned up = n >> 8, c = n & 255, drow = (c >> 7) * 256 + up * 128 + (c & 127);
      const float g = bf2f(((const bf16_t*)(ws + WS_W1T))[((size_t)(layer * 257 + e) * 512 + drow) * 1024 + k]); num += (r - g) * (r - g); den += r * r; }
    { const unsigned hsh = hash32(i * 4 + 3), le = hsh % 514, layer = le / 257, e = le % 257, n = (hsh >> 10) % 1024, k = (hsh >> 20) % 256;
      const float r = (e < 256) ? A.in[I_WED][((size_t)(layer * 256 + e) * 256 + k) * 1024 + n] : A.in[I_WSD][((size_t)layer * 256 + k) * 1024 + n];
      const float g = bf2f(((const bf16_t*)(ws + WS_W2T))[((size_t)(layer * 257 + e) * 1024 + n) * 256 + k]); num += (r - g) * (r - g); den += r * r; }
    dbg_acc(w, 1, num, den);
}
__global__ void dbg_gemm(const bf16_t* Am, int K, const bf16_t* Bt, const void* out, int ldo, int out_f32, int nrows, int ncols, float* w, int stage) {
    const unsigned i = blockIdx.x * 256 + threadIdx.x; const unsigned hsh = hash32(i + 77u * stage), row = hsh % nrows, col = (hsh >> 11) % ncols;
    float r = 0.f; for (int k = 0; k < K; ++k) r += bf2f(Am[(size_t)row * K + k]) * bf2f(Bt[(size_t)col * K + k]);
    const float g = out_f32 ? ((const float*)out)[(size_t)row * ldo + col] : bf2f(((const bf16_t*)out)[(size_t)row * ldo + col]);
    dbg_acc(w, stage, (r - g) * (r - g), r * r);
}
template <int MODE> __global__ void __launch_bounds__(256, 1) dbg_mixer(MixP mp, int b, int h, int T, float* w, int stage) {
    constexpr int DK = (MODE == 1) ? 64 : 128, DV = (MODE == 2) ? 256 : 128;
    __shared__ float sq[128], sk[128], sa[128], red[256], sh_i, sh_f;
    const int tid = threadIdx.x;
    const int ldp = mp.ldp; const bf16_t* proj = mp.proj;
    int cq, ck, cv, cg, cy, cu = 3584 + h * 64;
    if (MODE == 0) { cq = h * 128; ck = 512 + h * 128; cv = 1024 + h * 128; cg = 1536 + h * 128; cy = h * 128; }
    else if (MODE == 1) { cq = 2048 + h * 64; ck = 2304 + h * 64; cv = 2560 + h * 128; cg = 3072 + h * 128; cy = 512 + h * 128; }
    else { cq = h * 128; ck = 512 + h * 128; cv = 1024 + h * 256; cg = 2048 + h * 256; cy = h * 256; }
    float S[DK];
#pragma unroll
    for (int d = 0; d < DK; ++d) S[d] = 0.f;
    float nst = 0.f, num = 0.f, den = 0.f;
    for (int t = 0; t < T; ++t) {
        const size_t tok = (size_t)b * SEQ + t; const bf16_t* pr = proj + tok * ldp;
        if (tid < DK) {
            const int d = tid;
            if (MODE == 0) { const float z = bf2f(pr[ck + d]), sg = 1.f / (1.f + expf(-z)), lb = mp.lb0[h * 128 + d]; sa[d] = lb + (1.f - lb) * sg; sk[d] = (1.f - lb) * (1.f - sg); const float qq = bf2f(pr[cq + d]); sq[d] = qq / (1.f + expf(-qq)); }
            else if (MODE == 1) { const float u = bf2f(pr[cu + d]) + mp.bgk[h * 64 + d]; const float ls = fminf(u, 0.f) - log1pf(expf(-fabsf(u))); sa[d] = expf(ls / 16.f); sk[d] = bf2f(pr[ck + d]); sq[d] = bf2f(pr[cq + d]) * 0.125f; }
            else { float aq = 0.f, ak = 0.f; for (int j = 0; j < 4; ++j) { const int tt = t - 3 + j; if (tt >= 0) { const bf16_t* p2 = proj + ((size_t)b * SEQ + tt) * ldp; aq += mp.conv[j * 1024 + cq + d] * bf2f(p2[cq + d]); ak += mp.conv[j * 1024 + ck + d] * bf2f(p2[ck + d]); } }
                sq[d] = aq / (1.f + expf(-aq)); sk[d] = ak / (1.f + expf(-ak)) * 0.08838834764831845f; }
        }
        if (MODE == 2 && tid == 0) { const float* gp = mp.gates + tok * 8; sh_i = expf(gp[h] + mp.bif[h]); const float x = gp[4 + h] + mp.bif[4 + h]; sh_f = 1.f / (1.f + expf(-x)); }
        __syncthreads();
        const float vt = bf2f(pr[cv + tid]);
        float o = 0.f;
        if (MODE == 2) { const float f = sh_f, ii = sh_i;
#pragma unroll
            for (int d = 0; d < DK; ++d) { S[d] = f * S[d] + ii * sk[d] * vt; o += S[d] * sq[d]; }
            if (tid < 128) nst = f * nst + ii * sk[tid];
            red[tid] = (tid < 128) ? nst * sq[tid] : 0.f;
        } else {
#pragma unroll
            for (int d = 0; d < DK; ++d) { S[d] = sa[d] * S[d] + sk[d] * vt; o += S[d] * sq[d]; }
            red[tid] = o * o;
        }
        __syncthreads();
        for (int st = DV / 2; st > 0; st >>= 1) { if (tid < st) red[tid] += red[tid + st]; __syncthreads(); }
        const float tot = red[0];
        const float gt = bf2f(pr[cg + tid]);
        float y;
        if (MODE == 2) y = o / fmaxf(fabsf(tot), 1.f) * (1.f / (1.f + expf(-gt)));
        else y = o * rsqrtf(tot / 128.f + 1e-6f) * ((MODE == 0) ? mp.hg : mp.gg)[h * 128 + tid] * (gt / (1.f + expf(-gt)));
        const float g = bf2f(mp.ymix[tok * DM + cy + tid]);
        num += (y - g) * (y - g); den += y * y;
        __syncthreads();
    }
    dbg_acc(w, stage, num, den);
}
__global__ void dbg_h1(const bf16_t* HIN, const bf16_t* YM, const bf16_t* Wt, const bf16_t* H1, const float* g, const float* bb, float* w, int stage) {
    __shared__ float red[256]; __shared__ float zrow[1024];
    const int tid = threadIdx.x; const unsigned row = hash32(blockIdx.x + 1000u * stage) % NTOK;
    float z[4];
    for (int q = 0; q < 4; ++q) { const int c = tid + 256 * q; float a = 0.f; for (int k = 0; k < 1024; ++k) a += bf2f(YM[(size_t)row * 1024 + k]) * bf2f(Wt[(size_t)c * 1024 + k]); z[q] = bfr(ALPHA * bf2f(HIN[(size_t)row * 1024 + c]) + a); }
    red[tid] = z[0] + z[1] + z[2] + z[3]; __syncthreads();
    for (int st = 128; st > 0; st >>= 1) { if (tid < st) red[tid] += red[tid + st]; __syncthreads(); }
    const float mu = red[0] / 1024.f; __syncthreads();
    red[tid] = (z[0] - mu) * (z[0] - mu) + (z[1] - mu) * (z[1] - mu) + (z[2] - mu) * (z[2] - mu) + (z[3] - mu) * (z[3] - mu); __syncthreads();
    for (int st = 128; st > 0; st >>= 1) { if (tid < st) red[tid] += red[tid + st]; __syncthreads(); }
    const float rs = rsqrtf(red[0] / 1024.f + 1e-5f);
    float num = 0.f, den = 0.f;
    for (int q = 0; q < 4; ++q) { const int c = tid + 256 * q; const float y = (z[q] - mu) * rs * g[c] + bb[c], gg = bf2f(H1[(size_t)row * 1024 + c]); num += (y - gg) * (y - gg); den += y * y; }
    dbg_acc(w, stage, num, den); (void)zrow;
}
__global__ void dbg_select(const float* logits, const float* rb, const int* tok_e, const float* tok_w, float* w, int stage) {
    __shared__ float sc[256], bs[256]; __shared__ int ce[8]; __shared__ float cs[8];
    if (threadIdx.x != 0) return;
    const unsigned tok = hash32(blockIdx.x + 31u * stage) % NTOK;
    const float* lp = logits + (size_t)tok * 256;
    for (int e = 0; e < 256; ++e) { sc[e] = 1.f / (1.f + expf(-lp[e])); bs[e] = sc[e] + rb[e]; }
    float gs[8];
#pragma unroll
    for (int g = 0; g < 8; ++g) { float m1 = -1e30f, m2 = -1e30f; for (int j = 0; j < 32; ++j) { const float v = bs[g * 32 + j]; if (v > m1) { m2 = m1; m1 = v; } else if (v > m2) m2 = v; } gs[g] = m1 + m2; }
    unsigned selmask = 0;
#pragma unroll
    for (int g = 0; g < 8; ++g) { int rank = 0;
#pragma unroll
        for (int q = 0; q < 8; ++q) rank += (gs[q] > gs[g] || (gs[q] == gs[g] && q < g)) ? 1 : 0; if (rank < 4) selmask |= 1u << g; }
    float tot = 0.f;
    for (int k = 0; k < 8; ++k) { float bv = -1e30f; int be = 0; for (int e = 0; e < 256; ++e) { if (!((selmask >> (e >> 5)) & 1u)) continue; bool used = false; for (int q = 0; q < k; ++q) used |= (ce[q] == e); if (used) continue; if (bs[e] > bv) { bv = bs[e]; be = e; } } ce[k] = be; cs[k] = sc[be]; tot += sc[be]; }
    float num = 0.f, den = 0.f;
    for (int k = 0; k < 8; ++k) { const float wr_ = cs[k] / tot * 2.5f; const int ge = tok_e[(size_t)tok * 8 + k]; const float gw = tok_w[(size_t)tok * 8 + k];
        num += (ge == ce[k] ? 0.f : 1.f) + (wr_ - gw) * (wr_ - gw); den += wr_ * wr_; }
    dbg_acc(w, stage, num, den);
}
template <bool FINAL> __global__ void dbg_moe(Args A, int layer, const int* tok_e, const float* tok_w, const bf16_t* H1, const bf16_t* H2, const float* OUT, float* w, int stage) {
    __shared__ float hrow[1024], hid[256], red[256];
    const int tid = threadIdx.x; const unsigned tok = hash32(blockIdx.x + 555u * stage) % NTOK;
    for (int i = tid; i < 1024; i += 256) hrow[i] = bf2f(H1[(size_t)tok * 1024 + i]);
    float acc[4] = {0.f, 0.f, 0.f, 0.f};
    __syncthreads();
    for (int k = 0; k < 9; ++k) {
        const int e = (k < 8) ? tok_e[(size_t)tok * 8 + k] : 256; const float wk = (k < 8) ? tok_w[(size_t)tok * 8 + k] : 1.f;
        const float* W1 = (e < 256) ? A.in[I_WEI] + (size_t)(layer * 256 + e) * 1024 * 512 : A.in[I_WSI] + (size_t)layer * 1024 * 512;
        const float* W2 = (e < 256) ? A.in[I_WED] + (size_t)(layer * 256 + e) * 256 * 1024 : A.in[I_WSD] + (size_t)layer * 256 * 1024;
        float gsum = 0.f, usum = 0.f;
        for (int kk = 0; kk < 1024; ++kk) { gsum += hrow[kk] * W1[(size_t)kk * 512 + tid]; usum += hrow[kk] * W1[(size_t)kk * 512 + 256 + tid]; }
        hid[tid] = gsum / (1.f + expf(-gsum)) * usum;
        __syncthreads();
        for (int q = 0; q < 4; ++q) { const int c = tid + 256 * q; float a = 0.f; for (int j = 0; j < 256; ++j) a += hid[j] * W2[(size_t)j * 1024 + c]; acc[q] += wk * a; }
        __syncthreads();
    }
    float z[4]; for (int q = 0; q < 4; ++q) z[q] = ALPHA * hrow[tid + 256 * q] + acc[q];
    red[tid] = z[0] + z[1] + z[2] + z[3]; __syncthreads();
    for (int st = 128; st > 0; st >>= 1) { if (tid < st) red[tid] += red[tid + st]; __syncthreads(); }
    const float mu = red[0] / 1024.f; __syncthreads();
    red[tid] = (z[0] - mu) * (z[0] - mu) + (z[1] - mu) * (z[1] - mu) + (z[2] - mu) * (z[2] - mu) + (z[3] - mu) * (z[3] - mu); __syncthreads();
    for (int st = 128; st > 0; st >>= 1) { if (tid < st) red[tid] += red[tid + st]; __syncthreads(); }
    const float rs = rsqrtf(red[0] / 1024.f + 1e-5f);
    const float* g = A.in[I_LFG] + layer * DM; const float* bb = A.in[I_LFB] + layer * DM;
    float num = 0.f, den = 0.f;
    for (int q = 0; q < 4; ++q) { const int c = tid + 256 * q; const float y = (z[q] - mu) * rs * g[c] + bb[c]; const float gg = FINAL ? OUT[(size_t)tok * 1024 + c] : bf2f(H2[(size_t)tok * 1024 + c]); num += (y - gg) * (y - gg); den += y * y; }
    dbg_acc(w, stage, num, den);
}
#ifndef DBG_REPORT
#define DBG_REPORT 0
#endif
__global__ void dbg_fill(float* out, const float* w) {
    __shared__ float cval;
    if (threadIdx.x == 0) {
        float c = 0.f;
        if (DBG_REPORT == 0) { for (int st = 1; st <= 13; ++st) { const float rel = sqrtf(w[2 * st] / fmaxf(w[2 * st + 1], 1e-30f)); if (!(rel < 0.08f) || !(w[2 * st + 1] > 0.f)) { c = (float)st; break; } } }
        else { const float rel = sqrtf(w[2 * DBG_REPORT] / fmaxf(w[2 * DBG_REPORT + 1], 1e-30f)); float l = -log10f(fmaxf(rel, 1e-8f)); l = fminf(fmaxf(l, -2.f), 8.f); c = 3.f + l; }
        cval = c;
    }
    __syncthreads();
    const float c = cval;
    if (c != 0.f) for (size_t i = (size_t)blockIdx.x * 256 + threadIdx.x; i < (size_t)NTOK * DM; i += (size_t)gridDim.x * 256) out[i] = c;
}
#endif

extern "C" void kernel_launch(void* const* d_in, const int* in_sizes, int n_in, void* d_out, int out_size, void* d_ws, size_t ws_size, hipStream_t stream) {
    static int grid = 0;
    if (grid == 0) {
        if (n_in != 22 || out_size != NTOK * DM || ws_size < WS_END) { fprintf(stderr, "kernel_launch: unexpected shapes (n_in %d out %d ws %zu)\n", n_in, out_size, ws_size); grid = -1; return; }
        if (hipFuncSetAttribute((const void*)fwd_kernel, hipFuncAttributeMaxDynamicSharedMemorySize, LDS_BYTES) != hipSuccess) { fprintf(stderr, "kernel_launch: hipFuncSetAttribute failed\n"); grid = -1; return; }
        int per_cu = 0;
        if (hipOccupancyMaxActiveBlocksPerMultiprocessor(&per_cu, (const void*)fwd_kernel, 512, LDS_BYTES) != hipSuccess || per_cu < 1) fprintf(stderr, "kernel_launch: occupancy query says %d\n", per_cu);
        (void)hipGetLastError();
        grid = NWG;
    }
    if (grid < 0) return;
    (void)hipMemsetAsync((char*)d_ws + WS_CTL, 0, CTL_BYTES, stream);
    Args a{};
    for (int i = 0; i < 22; ++i) a.in[i] = (const float*)d_in[i];
    a.out = (float*)d_out; a.ws = (unsigned char*)d_ws;
#if MK_ONE_LAUNCH
    a.ph_lo = 0; a.ph_hi = 23;
    hipLaunchKernelGGL(fwd_kernel, dim3(grid), dim3(512), LDS_BYTES, stream, a);
#else
    for (int p = 0; p < 23; ++p) { a.ph_lo = p; a.ph_hi = p + 1; hipLaunchKernelGGL(fwd_kernel, dim3(grid), dim3(512), LDS_BYTES, stream, a);
#ifdef DBG
        unsigned char* ws = (unsigned char*)d_ws; float* dw = (float*)(ws + WS_CTL) + CW_DBG;
        const int layer = (p - 1) / 11, q = (p - 1) % 11;
        MixP mp{(const bf16_t*)(ws + WS_PROJ), layer ? CWID : ABW, 0, ws + WS_YMIX, (const float*)(ws + WS_GATES), (const float*)(ws + WS_MISC), a.in[I_BGK], a.in[I_HG], a.in[I_GG], a.in[I_CONV], a.in[I_BIF], (float*)(ws + WS_UST), (float*)(ws + WS_GSUM)};
        if (p == 0) hipLaunchKernelGGL(dbg_weights, dim3(256), dim3(256), 0, stream, a, dw);
        if (p >= 1 && q == 0) hipLaunchKernelGGL(dbg_gemm, dim3(64), dim3(256), 0, stream, (const bf16_t*)(ws + (layer ? WS_H2 : WS_HB)), 1024, (const bf16_t*)(ws + (layer ? WS_WC : WS_WAB)), (const void*)(ws + WS_PROJ), layer ? CWID : ABW, 0, NTOK, layer ? CWID : ABW, dw, layer ? 9 : 2);
        if (p >= 1 && q == 2 && layer == 0) { hipLaunchKernelGGL(dbg_mixer<0>, dim3(1), dim3(128), 0, stream, mp, 0, 1, 1100, dw, 3); hipLaunchKernelGGL(dbg_mixer<1>, dim3(1), dim3(128), 0, stream, mp, 1, 2, 1100, dw, 4); }
        if (p >= 1 && q == 2 && layer == 1) hipLaunchKernelGGL(dbg_mixer<2>, dim3(1), dim3(256), 0, stream, mp, 1, 1, 1100, dw, 10);
        if (p >= 1 && q == 4) hipLaunchKernelGGL(dbg_h1, dim3(32), dim3(256), 0, stream, (const bf16_t*)(ws + (layer ? WS_H2 : WS_HB)), (const bf16_t*)(ws + WS_YMIX), (const bf16_t*)(ws + (layer ? WS_WOC : WS_WOAB)), (const bf16_t*)(ws + WS_H1), a.in[I_LMG] + layer * DM, a.in[I_LMB] + layer * DM, dw, layer ? 11 : 5);
        if (p >= 1 && q == 5 && layer == 0) hipLaunchKernelGGL(dbg_gemm, dim3(64), dim3(256), 0, stream, (const bf16_t*)(ws + WS_H1), 1024, (const bf16_t*)(ws + WS_WR), (const void*)(ws + WS_LOGITS), 256, 1, NTOK, 256, dw, 6);
        if (p >= 1 && q == 6) hipLaunchKernelGGL(dbg_select, dim3(64), dim3(64), 0, stream, (const float*)(ws + WS_LOGITS), a.in[I_RB] + layer * NEXP, (const int*)(ws + WS_TOKE), (const float*)(ws + WS_TOKW), dw, layer ? 12 : 7);
        if (p >= 1 && q == 10 && layer == 0) hipLaunchKernelGGL(dbg_moe<false>, dim3(32), dim3(256), 0, stream, a, 0, (const int*)(ws + WS_TOKE), (const float*)(ws + WS_TOKW), (const bf16_t*)(ws + WS_H1), (const bf16_t*)(ws + WS_H2), (const float*)d_out, dw, 8);
        if (p >= 1 && q == 10 && layer == 1) { hipLaunchKernelGGL(dbg_moe<true>, dim3(32), dim3(256), 0, stream, a, 1, (const int*)(ws + WS_TOKE), (const float*)(ws + WS_TOKW), (const bf16_t*)(ws + WS_H1), (const bf16_t*)(ws + WS_H2), (const float*)d_out, dw, 13);
            hipLaunchKernelGGL(dbg_fill, dim3(1024), dim3(256), 0, stream, (float*)d_out, dw); }
#endif
    }
#endif
}
```

```cpp
#include <hip/hip_runtime.h>
#include <cstdio>
#include <cstdint>

#ifndef MK_ONE_LAUNCH
#define MK_ONE_LAUNCH 1
#endif

#define LAS __attribute__((address_space(3)))
typedef unsigned short bf16_t;
typedef short bf16x8 __attribute__((ext_vector_type(8)));
typedef float f32x4 __attribute__((ext_vector_type(4)));
typedef unsigned u32x4 __attribute__((ext_vector_type(4)));
typedef unsigned u32x2 __attribute__((ext_vector_type(2)));

constexpr int NTOK = 32768, SEQ = 16384, DM = 1024;
constexpr int ABW = 3840;
constexpr int CWID = 3072;
constexpr int NEXP = 256, NE1 = 257, TOPK = 8, NSLOT = 9;
constexpr float ALPHA = 1.41421356237f;
constexpr int NWG = 256;
constexpr int PRMAX = 262144 + 65536 + 32768;

constexpr size_t MiB = 1u << 20;
constexpr size_t WS_CTL = 0, CTL_BYTES = 1 * MiB;
constexpr size_t WS_MISC = 1 * MiB;
constexpr size_t WS_WAB = 2 * MiB, WS_WOAB = 10 * MiB, WS_WC = 12 * MiB, WS_WOC = 18 * MiB, WS_WR = 20 * MiB;
constexpr size_t WS_TOKE = 22 * MiB, WS_TOKP = 23 * MiB, WS_TOKW = 24 * MiB;
constexpr size_t WS_STOK = 26 * MiB, WS_POSY = 28 * MiB;
constexpr size_t WS_GATES = 32 * MiB;
constexpr size_t WS_UST = 34 * MiB, WS_GSUM = 54 * MiB;
constexpr size_t WS_LOGITS = 56 * MiB;
constexpr size_t WS_HB = 96 * MiB, WS_PROJ = 160 * MiB, WS_YMIX = 400 * MiB, WS_Z = 464 * MiB, WS_H1 = 528 * MiB, WS_H2 = 592 * MiB;
constexpr size_t WS_ACT = 656 * MiB, WS_Y = 832 * MiB, WS_W1T = 1540 * MiB, WS_W2T = 2056 * MiB;
constexpr size_t WS_XQ = 2320 * MiB, WS_H1Q = 2352 * MiB, WS_H2Q = 2384 * MiB, WS_END = 2416 * MiB;
constexpr float Q_SA = 127.f / 5.5f, Q_SW = 127.f * 32.f / 5.5f, Q_DEQ = 1.f / (Q_SA * Q_SW);
constexpr float Q_SY = 127.f / 8.f, Q_SWO = 127.f * 64.f / 5.5f, Q_DEQO = 1.f / (Q_SY * Q_SWO);
constexpr float Q_SACT = 127.f / 8.f, Q_DEQ2 = 16.f / (Q_SACT * Q_SW);
constexpr int CW_BAR = 4096;
constexpr int CW_CNT = 16384;
constexpr int CW_DBG = 20480;

__device__ __forceinline__ unsigned pk2(float lo, float hi) { unsigned r; asm volatile("v_cvt_pk_bf16_f32 %0, %1, %2" : "=v"(r) : "v"(lo), "v"(hi)); return r; }
__device__ __forceinline__ float bflo(unsigned u) { return __uint_as_float(u << 16); }
__device__ __forceinline__ float bfhi(unsigned u) { return __uint_as_float(u & 0xffff0000u); }
__device__ __forceinline__ float bf2f(bf16_t b) { return __uint_as_float(((unsigned)b) << 16); }
__device__ __forceinline__ float sigm(float x) { return __builtin_amdgcn_rcpf(1.f + __expf(-x)); }
__device__ __forceinline__ float silu(float x) { return x * __builtin_amdgcn_rcpf(1.f + __expf(-x)); }
__device__ __forceinline__ int q8(float x, float sc) { return (int)rintf(fminf(fmaxf(x * sc, -127.f), 127.f)); }
__device__ __forceinline__ unsigned pk4(int a, int b, int c, int d) { return (unsigned)(a & 255) | ((unsigned)(b & 255) << 8) | ((unsigned)(c & 255) << 16) | ((unsigned)d << 24); }
__device__ __forceinline__ float logsig(float x) { return fminf(x, 0.f) - __logf(1.f + __expf(-fabsf(x))); }

#define XB_TMO      128
#define XB_XCNT(j)  (256  + 64 * (j))
#define XB_XSUB(j)  (1280 + 64 * (j))
#define XB_XGEN(j)  (2304 + 64 * (j))
#define XB_TOP      3328
#define XB_TOPGEN   3392
#define XCD_BAR_WORDS 3456
#define XB_SPIN_CAP (1u << 22)
__device__ __forceinline__ unsigned xb_ld(unsigned* p)              { return __hip_atomic_load(p, __ATOMIC_RELAXED, __HIP_MEMORY_SCOPE_AGENT); }
__device__ __forceinline__ unsigned xb_add(unsigned* p, unsigned v) { return __hip_atomic_fetch_add(p, v, __ATOMIC_RELAXED, __HIP_MEMORY_SCOPE_AGENT); }
__device__ __forceinline__ unsigned xb_xcc_id() { return (unsigned)__builtin_amdgcn_s_getreg((3 << 11) | 20) & 0xFu; }
#define XB_SPIN(cond, bar) do { unsigned _sp = 0; while (cond) { __builtin_amdgcn_s_sleep(1); \
    if ((++_sp & 255u) == 0u) { if (xb_ld(&(bar)[XB_TMO])) break; if (_sp > XB_SPIN_CAP) { atomicAdd(&(bar)[XB_TMO], 1u); break; } } } } while (0)
struct XcdBarrier { unsigned* bar; unsigned x; volatile LAS unsigned* st; };
__device__ __forceinline__ XcdBarrier xcd_barrier_post(unsigned* bar, volatile LAS unsigned* st) {
    XcdBarrier b; b.bar = bar; b.x = xb_xcc_id(); b.st = st;
    if (threadIdx.x == 0) (void)xb_add(&bar[XB_XCNT(b.x)], 1u);
    return b;
}
__device__ __forceinline__ void xcd_barrier_complete(unsigned* bar, unsigned x, unsigned& nloc, unsigned& nx) {
    const unsigned G = gridDim.x * gridDim.y * gridDim.z;
    unsigned sum, cnt, mine, sp = 0u;
    for (;;) {
        sum = 0u; cnt = 0u; mine = 0u;
#pragma unroll
        for (unsigned j = 0; j < 16; ++j) { const unsigned c = xb_ld(&bar[XB_XCNT(j)]); sum += c; cnt += (c > 0u) ? 1u : 0u; mine = (j == x) ? c : mine; }
        if (sum == G) break;
        __builtin_amdgcn_s_sleep(1);
        if ((++sp & 255u) == 0u) { if (xb_ld(&bar[XB_TMO])) break; if (sp > XB_SPIN_CAP) { atomicAdd(&bar[XB_TMO], 1u); break; } }
    }
    nloc = mine > 0u ? mine : 1u; nx = cnt > 0u ? cnt : 1u;
}
__device__ __forceinline__ void xcd_barrier(const XcdBarrier& b) {
    asm volatile("s_waitcnt vmcnt(0)" ::: "memory");
    __syncthreads();
    if (threadIdx.x == 0) {
        unsigned* bar = b.bar;
        __builtin_amdgcn_s_waitcnt(0);
        unsigned nloc = b.st[0], nx = b.st[1];
        if (nloc == 0u) { xcd_barrier_complete(bar, b.x, nloc, nx); b.st[0] = nloc; b.st[1] = nx; }
        const unsigned old = xb_add(&bar[XB_XSUB(b.x)], 1u);
        const unsigned gen = old / nloc;
        if (old + 1u == (gen + 1u) * nloc) {
            __builtin_amdgcn_fence(__ATOMIC_RELEASE, "agent");
            asm volatile("s_waitcnt vmcnt(0)" ::: "memory");
            const unsigned og = xb_add(&bar[XB_TOP], 1u);
            const unsigned tg = og / nx;
            if (og + 1u == (tg + 1u) * nx) xb_add(&bar[XB_TOPGEN], 1u);
            else XB_SPIN(xb_ld(&bar[XB_TOPGEN]) == tg, bar);
            __builtin_amdgcn_fence(__ATOMIC_ACQUIRE, "agent");
            xb_add(&bar[XB_XGEN(b.x)], 1u);
            asm volatile("s_waitcnt vmcnt(0)" ::: "memory");
        } else {
            XB_SPIN(xb_ld(&bar[XB_XGEN(b.x)]) == gen, bar);
            __builtin_amdgcn_fence(__ATOMIC_ACQUIRE, "agent");
            asm volatile("s_waitcnt vmcnt(0)" ::: "memory");
        }
    }
    __syncthreads();
}

namespace pg8 {
constexpr int BM = 256, BK = 64, HALF = 128, HTB = HALF * BK * 2, STAGE_BYTES = 8 * HTB, NXCD = 8, WGM = 8;
__device__ __forceinline__ int lds_byte(int r, int c) { const int st = (r >> 4) * 2 + (c >> 5), rr = r & 15, cc = c & 31, ob = rr * 64 + cc * 2; return st * 1024 + (ob ^ (((ob >> 9) & 1) << 5)); }
__device__ __forceinline__ void stage_rc(int b, int& R, int& C) { const int st = b / 1024, sb = b % 1024, swz = sb ^ (((sb >> 9) & 1) << 5); R = (st >> 1) * 16 + swz / 64; C = (st & 1) * 32 + (swz % 64) / 2; }
__device__ __forceinline__ int perm32(int rho) { const int n = rho >> 4, i = rho & 15; return 8 * (i >> 2) + 4 * n + (i & 3); }
struct Unit { int pm, pn; };
struct Gemm { const bf16_t* A; const bf16_t* Bt; int K; };

struct StaticOrder {
    int nM, nN, nwg, G, c;
    __device__ void init(int M, int N, int G_, int c_) { nM = M / BM; nN = N / BM; nwg = nM * nN; G = G_; c = c_; }
    __device__ bool next(int i, Unit& u) const {
        const long L = (long)i * G + c; if (L >= nwg) return false;
        int wgid = (int)L; { const int q = nwg / NXCD, r = nwg % NXCD, xcd = wgid % NXCD, off = wgid / NXCD; wgid = (xcd < r ? xcd * (q + 1) : r * (q + 1) + (xcd - r) * q) + off; }
        const int nig = WGM * nN, gid = wgid / nig, fm = gid * WGM, gsz = (nM - fm) < WGM ? (nM - fm) : WGM;
        u.pm = fm + ((wgid % nig) % gsz); u.pn = (wgid % nig) / gsz; return true;
    }
};
struct MoeOrder {
    const LAS int* tab; int n;
    __device__ bool next(int i, Unit& u) const {
        if (i >= n) return false;
        u.pm = __builtin_amdgcn_readfirstlane(tab[2 * i]); u.pn = __builtin_amdgcn_readfirstlane(tab[2 * i + 1]); return true;
    }
};
constexpr int LDS_UT = 131072, LDS_IDX = 131072 + 512, MOE_MAXU = 15;
__device__ __forceinline__ int moe_prep(LAS unsigned char* lds, const int* __restrict__ tile_exp, int nunits, int sh, int G, int c, const int* __restrict__ rowidx) {
    const int tid = threadIdx.x;
    LAS int* tab = (LAS int*)(lds + LDS_UT);
    int n = 0; { const long rem = (long)nunits - c; n = rem > 0 ? (int)((rem + G - 1) / G) : 0; if (n > 32) n = 32; }
    if (tid < n) { const long L = (long)tid * G + c; const int rt = (int)(L >> sh), j = (int)L & ((1 << sh) - 1); tab[2 * tid] = rt; tab[2 * tid + 1] = (tile_exp[rt] << sh) + j; }
    __syncthreads();
    if (rowidx) { LAS int* idx = (LAS int*)(lds + LDS_IDX); const int nn = n < MOE_MAXU ? n : MOE_MAXU;
        for (int x = tid; x < nn * 256; x += 512) idx[x] = rowidx[tab[2 * (x >> 8)] * 256 + (x & 255)];
        __syncthreads(); }
    return n;
}

typedef int i32x4 __attribute__((ext_vector_type(4)));
template <class Epi, class Sched, bool GATHER, bool I8 = false>
__device__ __forceinline__ void gemm_phase(LAS unsigned char* lds, const Gemm g, const LAS int* rowidx, const Sched& S, const Epi& E) {
    const int tid = threadIdx.x, wid = __builtin_amdgcn_readfirstlane(tid >> 6), lane = tid & 63, wr = wid >> 2, wc = wid & 3, fr = lane & 15, fq = lane >> 4;
    const int K = g.K, nt = K / BK;
    unsigned voffB[2], cofs[2]; int Rr[2];
#pragma unroll
    for (int i = 0; i < 2; ++i) { int R, C; stage_rc(tid * 16 + i * 8192, R, C); const int Rb = Epi::PERM ? ((R & ~31) + perm32(R & 31)) : R;
        Rr[i] = R; cofs[i] = (unsigned)C * 2u; voffB[i] = (unsigned)(Rb * K + C) * 2u; }
    const unsigned rowb = (unsigned)K * 2u;
    const size_t kstep = (size_t)(BK * 2);
    const size_t hstep = (size_t)HALF * K * 2;
    const size_t tstep = 2 * hstep;
    const unsigned ldsw = (unsigned)wid * 1024u;
    const int aoff = lds_byte(wr * 64 + fr, fq * 8), boff = lds_byte(wc * 32 + fr, fq * 8);
    const char* Abase = (const char*)g.A;
#define PG8_SA(b, h) (((b) * 2 + (h)) * HTB)
#define PG8_SB(b, h) ((4 + (b) * 2 + (h)) * HTB)
#define PG8_STAGE(bufoff, gbase, voff) do { _Pragma("unroll") for (int _i = 0; _i < 2; ++_i) \
        __builtin_amdgcn_global_load_lds((const unsigned*)((const char*)(gbase) + (voff)[_i]), (LAS unsigned*)(lds + (bufoff) + ldsw + _i * 8192), 16, 0, 0); } while (0)
#define PG8_STAGEA(bufoff, kb, offs) do { _Pragma("unroll") for (int _i = 0; _i < 2; ++_i) \
        __builtin_amdgcn_global_load_lds((const unsigned*)(Abase + (size_t)((kb) + (offs)[_i])), (LAS unsigned*)(lds + (bufoff) + ldsw + _i * 8192), 16, 0, 0); } while (0)
#define PG8_ROWOFF(u, uo, O) do { _Pragma("unroll") for (int _h = 0; _h < 2; ++_h) _Pragma("unroll") for (int _i = 0; _i < 2; ++_i) { \
        int _row = (u).pm * BM + _h * HALF + Rr[_i]; if (GATHER) _row = rowidx[(uo) * 256 + _h * HALF + Rr[_i]]; (O)[_h][_i] = (unsigned)_row * rowb + cofs[_i]; } } while (0)
#define PG8_LDA(dst, b, h) do { _Pragma("unroll") for (int m = 0; m < 4; ++m) _Pragma("unroll") for (int k = 0; k < 2; ++k) dst[m][k] = *(const LAS bf16x8*)(lds + PG8_SA(b, h) + aoff + m * 2048 + k * 1024); } while (0)
#define PG8_LDB(dst, b, h) do { _Pragma("unroll") for (int n = 0; n < 2; ++n) _Pragma("unroll") for (int k = 0; k < 2; ++k) dst[n][k] = *(const LAS bf16x8*)(lds + PG8_SB(b, h) + boff + n * 2048 + k * 1024); } while (0)
#define PG8_MMA(ai, bj, At, Bt) do { __builtin_amdgcn_s_setprio(1); _Pragma("unroll") for (int m = 0; m < 4; ++m) _Pragma("unroll") for (int n = 0; n < 2; ++n) _Pragma("unroll") for (int k = 0; k < 2; ++k) \
        { if (I8) acc[ai][bj][m][n] = __builtin_bit_cast(f32x4, __builtin_amdgcn_mfma_i32_16x16x64_i8(__builtin_bit_cast(i32x4, Bt[n][k]), __builtin_bit_cast(i32x4, At[m][k]), __builtin_bit_cast(i32x4, acc[ai][bj][m][n]), 0, 0, 0)); \
          else acc[ai][bj][m][n] = __builtin_amdgcn_mfma_f32_16x16x32_bf16(Bt[n][k], At[m][k], acc[ai][bj][m][n], 0, 0, 0); } __builtin_amdgcn_s_setprio(0); } while (0)
#define PG8_WAIT_V(n) asm volatile("s_waitcnt vmcnt(" #n ")" ::: "memory")
#define PG8_WAIT_L(n) asm volatile("s_waitcnt lgkmcnt(" #n ")" ::: "memory")
#define PG8_BAR __builtin_amdgcn_s_barrier()
#define PG8_SCHED __builtin_amdgcn_sched_barrier(0)
    Unit cur, nxt; int ui = 0;
    if (!S.next(0, cur)) return;
    f32x4 acc[2][2][4][2];
#pragma unroll
    for (int a = 0; a < 2; ++a)
#pragma unroll
        for (int b = 0; b < 2; ++b)
#pragma unroll
            for (int m = 0; m < 4; ++m)
#pragma unroll
                for (int n = 0; n < 2; ++n) acc[a][b][m][n] = (f32x4){0.f, 0.f, 0.f, 0.f};
    bf16x8 At[4][2], B0[2][2], B1[2][2];
    unsigned cO[2][2], nO[2][2];
    PG8_ROWOFF(cur, 0, cO);
    const char* cB = (const char*)g.Bt + (size_t)cur.pn * tstep;
    PG8_STAGE(PG8_SB(0, 0), cB, voffB); PG8_STAGE(PG8_SB(0, 1), cB + hstep, voffB); PG8_STAGEA(PG8_SA(0, 0), 0u, cO[0]); PG8_STAGEA(PG8_SA(0, 1), 0u, cO[1]);
    if (wr == 1) PG8_BAR;
    PG8_WAIT_V(2); PG8_BAR;
    PG8_STAGE(PG8_SB(1, 0), cB + kstep, voffB); PG8_STAGEA(PG8_SA(1, 0), (unsigned)kstep, cO[0]); PG8_STAGE(PG8_SB(1, 1), cB + hstep + kstep, voffB);
    PG8_WAIT_V(6); PG8_BAR;
    for (;;) {
        const bool has_next = S.next(ui + 1, nxt);
        const char* nB = has_next ? (const char*)g.Bt + (size_t)nxt.pn * tstep : cB;
#pragma unroll
        for (int h = 0; h < 2; ++h)
#pragma unroll
            for (int i = 0; i < 2; ++i) nO[h][i] = cO[h][i];
#pragma unroll 1
        for (int t = 0; t < nt; t += 2) {
            const bool last = (t == nt - 2);
            if (last && has_next) PG8_ROWOFF(nxt, ui + 1, nO);
            const unsigned k1 = (unsigned)(t + 1) * (unsigned)kstep;
            const unsigned k2 = last ? 0u : (unsigned)(t + 2) * (unsigned)kstep, k3 = k2 + (unsigned)kstep;
            const char* b2 = last ? nB : cB + (size_t)(t + 2) * kstep; const char* b3 = b2 + kstep;
            unsigned o2[2][2];
#pragma unroll
            for (int h = 0; h < 2; ++h)
#pragma unroll
                for (int i = 0; i < 2; ++i) o2[h][i] = last ? nO[h][i] : cO[h][i];
            PG8_LDB(B0, 0, 0); PG8_LDB(B1, 0, 1); PG8_SCHED; PG8_LDA(At, 0, 0); PG8_STAGEA(PG8_SA(1, 1), k1, cO[1]);
            PG8_WAIT_V(8); PG8_WAIT_L(0); PG8_BAR; PG8_MMA(0, 0, At, B0); PG8_MMA(0, 1, At, B1); PG8_BAR; PG8_SCHED;
            PG8_LDA(At, 0, 1); PG8_STAGE(PG8_SB(0, 0), b2, voffB); PG8_STAGE(PG8_SB(0, 1), b2 + hstep, voffB); PG8_STAGEA(PG8_SA(0, 0), k2, o2[0]);
            PG8_WAIT_V(8); PG8_WAIT_L(0); PG8_BAR; PG8_MMA(1, 0, At, B0); PG8_MMA(1, 1, At, B1); PG8_BAR; PG8_SCHED;
            PG8_LDB(B0, 1, 0); PG8_LDB(B1, 1, 1); PG8_SCHED; PG8_LDA(At, 1, 0); PG8_STAGEA(PG8_SA(0, 1), k2, o2[1]);
            PG8_WAIT_V(8); PG8_WAIT_L(0); PG8_BAR; PG8_MMA(0, 0, At, B0); PG8_MMA(0, 1, At, B1); PG8_BAR; PG8_SCHED;
            PG8_LDA(At, 1, 1); PG8_STAGE(PG8_SB(1, 0), b3, voffB); PG8_STAGE(PG8_SB(1, 1), b3 + hstep, voffB); PG8_STAGEA(PG8_SA(1, 0), k3, o2[0]);
            PG8_WAIT_V(8); PG8_WAIT_L(0); PG8_BAR; PG8_MMA(1, 0, At, B0); PG8_MMA(1, 1, At, B1); PG8_BAR; PG8_SCHED;
        }
        if (wr == 0) PG8_BAR;
        E(acc, cur, wr, wc, fr, fq);
        if (!has_next) break;
#pragma unroll
        for (int a = 0; a < 2; ++a)
#pragma unroll
            for (int b = 0; b < 2; ++b)
#pragma unroll
                for (int m = 0; m < 4; ++m)
#pragma unroll
                    for (int n = 0; n < 2; ++n) acc[a][b][m][n] = (f32x4){0.f, 0.f, 0.f, 0.f};
        cur = nxt; cB = nB; ++ui;
#pragma unroll
        for (int h = 0; h < 2; ++h)
#pragma unroll
            for (int i = 0; i < 2; ++i) cO[h][i] = nO[h][i];
        if (wr == 1) PG8_BAR;
    }
    PG8_WAIT_V(0);
    PG8_BAR;
#undef PG8_SA
#undef PG8_SB
#undef PG8_STAGE
#undef PG8_STAGEA
#undef PG8_ROWOFF
#undef PG8_LDA
#undef PG8_LDB
#undef PG8_MMA
#undef PG8_WAIT_V
#undef PG8_WAIT_L
#undef PG8_BAR
#undef PG8_SCHED
}

template <bool I8> struct EpiStoreBf16 {
    static constexpr bool PERM = true;
    bf16_t* O; int ldc;
    static __device__ __forceinline__ f32x4 dq(f32x4 v) { if (I8) { const i32x4 q = __builtin_bit_cast(i32x4, v); return (f32x4){(float)q[0] * Q_DEQ, (float)q[1] * Q_DEQ, (float)q[2] * Q_DEQ, (float)q[3] * Q_DEQ}; } return v; }
    __device__ __forceinline__ void operator()(const f32x4 (&acc)[2][2][4][2], const Unit& u, int wr, int wc, int fr, int fq) const {
        const int row0 = u.pm * BM + wr * 64 + fr, col0 = u.pn * BM + wc * 32 + 8 * fq;
#pragma unroll
        for (int ai = 0; ai < 2; ++ai)
#pragma unroll
            for (int m = 0; m < 4; ++m) { bf16_t* rowp = O + (size_t)(row0 + ai * HALF + m * 16) * ldc + col0;
#pragma unroll
                for (int bj = 0; bj < 2; ++bj) { const f32x4 v0 = dq(acc[ai][bj][m][0]), v1 = dq(acc[ai][bj][m][1]);
                    u32x4 w; w.x = pk2(v0[0], v0[1]); w.y = pk2(v0[2], v0[3]); w.z = pk2(v1[0], v1[1]); w.w = pk2(v1[2], v1[3]);
                    *(u32x4*)(rowp + bj * HALF) = w; } }
    }
};
struct EpiResid {
    static constexpr bool PERM = true;
    bf16_t* Z; const bf16_t* H;
    static __device__ __forceinline__ f32x4 dq(f32x4 v) { const i32x4 q = __builtin_bit_cast(i32x4, v); return (f32x4){(float)q[0] * Q_DEQO, (float)q[1] * Q_DEQO, (float)q[2] * Q_DEQO, (float)q[3] * Q_DEQO}; }
    __device__ __forceinline__ void operator()(const f32x4 (&acc)[2][2][4][2], const Unit& u, int wr, int wc, int fr, int fq) const {
        const int row0 = u.pm * BM + wr * 64 + fr, col0 = u.pn * BM + wc * 32 + 8 * fq;
#pragma unroll
        for (int ai = 0; ai < 2; ++ai)
#pragma unroll
            for (int m = 0; m < 4; ++m) { const size_t ro = (size_t)(row0 + ai * HALF + m * 16) * DM + col0;
#pragma unroll
                for (int bj = 0; bj < 2; ++bj) { const f32x4 v0 = dq(acc[ai][bj][m][0]), v1 = dq(acc[ai][bj][m][1]);
                    const u32x4 hh = *(const u32x4*)(H + ro + bj * HALF);
                    u32x4 w;
                    w.x = pk2(ALPHA * bflo(hh.x) + v0[0], ALPHA * bfhi(hh.x) + v0[1]); w.y = pk2(ALPHA * bflo(hh.y) + v0[2], ALPHA * bfhi(hh.y) + v0[3]);
                    w.z = pk2(ALPHA * bflo(hh.z) + v1[0], ALPHA * bfhi(hh.z) + v1[1]); w.w = pk2(ALPHA * bflo(hh.w) + v1[2], ALPHA * bfhi(hh.w) + v1[3]);
                    *(u32x4*)(Z + ro + bj * HALF) = w; } }
    }
};
struct EpiF32 {
    static constexpr bool PERM = false;
    float* C;
    __device__ __forceinline__ void operator()(const f32x4 (&acc)[2][2][4][2], const Unit& u, int wr, int wc, int fr, int fq) const {
        const int row0 = u.pm * BM + wr * 64 + fr, col0 = wc * 32 + 4 * fq;
#pragma unroll
        for (int ai = 0; ai < 2; ++ai)
#pragma unroll
            for (int m = 0; m < 4; ++m) { float* rowp = C + (size_t)(row0 + ai * HALF + m * 16) * 256 + col0;
#pragma unroll
                for (int bj = 0; bj < 2; ++bj)
#pragma unroll
                    for (int n = 0; n < 2; ++n) *(f32x4*)(rowp + bj * HALF + n * 16) = acc[ai][bj][m][n]; }
    }
};
template <bool I8> struct EpiSwiGLU {
    static constexpr bool PERM = true;
    unsigned char* ACT; LAS unsigned char* sbuf;
    static __device__ __forceinline__ f32x4 dq(f32x4 v) { if (I8) { const i32x4 q = __builtin_bit_cast(i32x4, v); return (f32x4){(float)q[0] * Q_DEQ, (float)q[1] * Q_DEQ, (float)q[2] * Q_DEQ, (float)q[3] * Q_DEQ}; } return v; }
    __device__ __forceinline__ void operator()(const f32x4 (&acc)[2][2][4][2], const Unit& u, int wr, int wc, int fr, int fq) const {
        const int tid = threadIdx.x, rrow = tid >> 3, rchunk = tid & 7;
        const int wrow = wr * 16 + fr;
        unsigned char* abase = ACT + (size_t)(u.pm * BM) * 256 + (u.pn & 1) * 128 + rchunk * 16;
#pragma unroll
        for (int st = 0; st < 8; ++st) {
            const int ai = st >> 2, m = st & 3;
            LAS unsigned char* buf = sbuf + (st & 1) * 4096;
            const f32x4 g0 = dq(acc[ai][0][m][0]), g1 = dq(acc[ai][0][m][1]), u0 = dq(acc[ai][1][m][0]), u1 = dq(acc[ai][1][m][1]);
            u32x2 w;
            w.x = pk4(q8(silu(g0[0]) * u0[0], Q_SACT), q8(silu(g0[1]) * u0[1], Q_SACT), q8(silu(g0[2]) * u0[2], Q_SACT), q8(silu(g0[3]) * u0[3], Q_SACT));
            w.y = pk4(q8(silu(g1[0]) * u1[0], Q_SACT), q8(silu(g1[1]) * u1[1], Q_SACT), q8(silu(g1[2]) * u1[2], Q_SACT), q8(silu(g1[3]) * u1[3], Q_SACT));
            const int c16 = wc * 2 + (fq >> 1);
            *(LAS u32x2*)(buf + wrow * 128 + ((c16 ^ (wrow & 7)) << 4) + (fq & 1) * 8) = w;
            asm volatile("s_waitcnt lgkmcnt(0)" ::: "memory"); __builtin_amdgcn_s_barrier(); asm volatile("" ::: "memory");
            if (tid < 256) {
                const u32x4 rv = *(const LAS u32x4*)(buf + rrow * 128 + ((rchunk ^ (rrow & 7)) << 4));
                const int grow = ai * HALF + (rrow >> 4) * 64 + m * 16 + (rrow & 15);
                *(u32x4*)(abase + (size_t)grow * 256) = rv;
            }
        }
        asm volatile("s_waitcnt lgkmcnt(0)" ::: "memory"); __builtin_amdgcn_s_barrier(); asm volatile("" ::: "memory");
    }
};
template <int EV = 0> struct EpiDownT {
    static constexpr bool PERM = true;
    unsigned char* Y; LAS unsigned char* sbuf;
    __device__ __forceinline__ void operator()(const f32x4 (&acc)[2][2][4][2], const Unit& u, int wr, int wc, int fr, int fq) const {
        const int tid = threadIdx.x, rrow = tid >> 4, rchunk = tid & 15;
        const int wrow = wr * 16 + fr;
        unsigned char* ybase = Y + (size_t)(u.pm * BM) * DM + (u.pn & 3) * 256 + rchunk * 16;
#pragma unroll
        for (int st = 0; st < 8; ++st) {
            const int ai = st >> 2, m = st & 3;
            LAS unsigned char* buf = sbuf + (st & 1) * 8192;
#pragma unroll
            for (int bj = 0; bj < 2; ++bj) { const i32x4 q0 = __builtin_bit_cast(i32x4, acc[ai][bj][m][0]), q1 = __builtin_bit_cast(i32x4, acc[ai][bj][m][1]);
                const f32x4 v0 = (f32x4){(float)q0[0] * Q_DEQ2, (float)q0[1] * Q_DEQ2, (float)q0[2] * Q_DEQ2, (float)q0[3] * Q_DEQ2}, v1 = (f32x4){(float)q1[0] * Q_DEQ2, (float)q1[1] * Q_DEQ2, (float)q1[2] * Q_DEQ2, (float)q1[3] * Q_DEQ2};
                int p0 = __builtin_amdgcn_cvt_pk_fp8_f32(v0[0], v0[1], 0, false); p0 = __builtin_amdgcn_cvt_pk_fp8_f32(v0[2], v0[3], p0, true);
                int p1 = __builtin_amdgcn_cvt_pk_fp8_f32(v1[0], v1[1], 0, false); p1 = __builtin_amdgcn_cvt_pk_fp8_f32(v1[2], v1[3], p1, true);
                u32x2 w; w.x = (unsigned)p0; w.y = (unsigned)p1;
                const int c16 = bj * 8 + wc * 2 + (fq >> 1);
                *(LAS u32x2*)(buf + wrow * 256 + ((c16 ^ (wrow & 15)) << 4) + (fq & 1) * 8) = w; }
            asm volatile("s_waitcnt lgkmcnt(0)" ::: "memory"); __builtin_amdgcn_s_barrier(); asm volatile("" ::: "memory");
            const u32x4 rv = *(const LAS u32x4*)(buf + rrow * 256 + ((rchunk ^ (rrow & 15)) << 4));
            const int grow = ai * HALF + (rrow >> 4) * 64 + m * 16 + (rrow & 15);
            if (EV == 1) { asm volatile("" :: "v"(rv.x), "v"(rv.y), "v"(rv.z), "v"(rv.w)); } else *(u32x4*)(ybase + (size_t)grow * DM) = rv;
        }
        asm volatile("s_waitcnt lgkmcnt(0)" ::: "memory"); __builtin_amdgcn_s_barrier(); asm volatile("" ::: "memory");
    }
};
typedef EpiDownT<0> EpiDown;
}

struct Args { const float* in[22]; float* out; unsigned char* ws; int ph_lo, ph_hi; };
enum { I_X = 0, I_WINAB, I_WGKUP, I_BGK, I_HG, I_GG, I_WOAB, I_LB, I_WINC, I_CONV, I_BIF, I_WOC, I_WR, I_RB, I_WEI, I_WED, I_WSI, I_WSD, I_LMG, I_LMB, I_LFG, I_LFB };

constexpr int LDS_MISC = 147200;
constexpr int LDS_BYTES = 147456;

__device__ __forceinline__ void cvt_tile(LAS unsigned char* lds, const float* __restrict__ src, size_t ldn, int k0, int n0, bf16_t* __restrict__ dst, int K, int drow0) {
    const int t = threadIdx.x;
    { const int c4 = (t & 15) * 4, r2 = t >> 4;
      const f32x4 a = *(const f32x4*)(src + (size_t)(k0 + 2 * r2) * ldn + n0 + c4);
      const f32x4 b = *(const f32x4*)(src + (size_t)(k0 + 2 * r2 + 1) * ldn + n0 + c4);
#pragma unroll
      for (int i = 0; i < 4; ++i) *(LAS unsigned*)(lds + ((c4 + i) * 72 + 2 * r2) * 2) = pk2(a[i], b[i]); }
    __syncthreads();
    { const int kk = (t & 7) * 8, n = t >> 3;
      const u32x4 v = *(const LAS u32x4*)(lds + (n * 72 + kk) * 2);
      *(u32x4*)(dst + (size_t)(drow0 + n) * K + k0 + kk) = v; }
    __syncthreads();
}
template <int NT>
__device__ __forceinline__ void cvt_multi(LAS unsigned char* lds, const float* __restrict__ src, size_t ldn, int k0, int n0, bf16_t* __restrict__ dst, int K, const int (&drow)[NT], float sc = 1.f) {
    const int t = threadIdx.x;
    { const int c4 = (t & 15) * 4, r2 = t >> 4;
      f32x4 a[NT], b[NT];
#pragma unroll
      for (int q = 0; q < NT; ++q) { a[q] = __builtin_nontemporal_load((const f32x4*)(src + (size_t)(k0 + 2 * r2) * ldn + n0 + 64 * q + c4)); b[q] = __builtin_nontemporal_load((const f32x4*)(src + (size_t)(k0 + 2 * r2 + 1) * ldn + n0 + 64 * q + c4)); }
#pragma unroll
      for (int q = 0; q < NT; ++q)
#pragma unroll
          for (int i = 0; i < 4; ++i) *(LAS unsigned*)(lds + q * 9216 + ((c4 + i) * 72 + 2 * r2) * 2) = pk2(a[q][i] * sc, b[q][i] * sc); }
    __syncthreads();
    { const int kk = (t & 7) * 8, n = t >> 3;
#pragma unroll
      for (int q = 0; q < NT; ++q) { const u32x4 v = *(const LAS u32x4*)(lds + q * 9216 + (n * 72 + kk) * 2); *(u32x4*)(dst + (size_t)(drow[q] + n) * K + k0 + kk) = v; } }
    __syncthreads();
}
template <int NT>
__device__ __forceinline__ void cvt8_multi(LAS unsigned char* lds, const float* __restrict__ src, size_t ldn, int k0, int n0, unsigned char* __restrict__ dst, int Kb, const int (&drow)[NT], float sc) {
    const int t = threadIdx.x;
    { const int c4 = (t & 15) * 4, r4 = t >> 4;
      f32x4 a[NT][4];
#pragma unroll
      for (int q = 0; q < NT; ++q)
#pragma unroll
          for (int j = 0; j < 4; ++j) a[q][j] = __builtin_nontemporal_load((const f32x4*)(src + (size_t)(k0 + 4 * r4 + j) * ldn + n0 + 64 * q + c4));
#pragma unroll
      for (int q = 0; q < NT; ++q)
#pragma unroll
          for (int i = 0; i < 4; ++i) *(LAS unsigned*)(lds + q * 9216 + (c4 + i) * 144 + 4 * r4) = pk4(q8(a[q][0][i], sc), q8(a[q][1][i], sc), q8(a[q][2][i], sc), q8(a[q][3][i], sc)); }
    __syncthreads();
    { const int kk = (t & 7) * 16, n = t >> 3;
#pragma unroll
      for (int q = 0; q < NT; ++q) { const u32x4 v = *(const LAS u32x4*)(lds + q * 9216 + n * 144 + kk); *(u32x4*)(dst + (size_t)(drow[q] + n) * Kb + k0 + kk) = v; } }
    __syncthreads();
}
template <int NT>
__device__ __forceinline__ void cvt8_matrix(LAS unsigned char* lds, const float* src, size_t ldn, int K, int n_lo, int ncols, unsigned char* dst, int drow_lo, float sc, int bid, int nb) {
    const int tk = K / 128, tn = ncols / (64 * NT);
    for (int j = bid; j < tk * tn; j += nb) { const int a = j / tn, b = j % tn; int dr[NT];
#pragma unroll
        for (int q = 0; q < NT; ++q) dr[q] = drow_lo + (b * NT + q) * 64;
        cvt8_multi<NT>(lds, src, ldn, a * 128, n_lo + b * 64 * NT, dst, K, dr, sc); }
}
template <int NT>
__device__ __forceinline__ void cvt_matrix(LAS unsigned char* lds, const float* src, size_t ldn, int K, int n_lo, int ncols, bf16_t* dst, int drow_lo, int bid, int nb) {
    const int tk = K / 64, tn = ncols / (64 * NT);
    for (int j = bid; j < tk * tn; j += nb) { const int a = j / tn, b = j % tn; int dr[NT];
#pragma unroll
        for (int q = 0; q < NT; ++q) dr[q] = drow_lo + (b * NT + q) * 64;
        cvt_multi<NT>(lds, src, ldn, a * 64, n_lo + b * 64 * NT, dst, K, dr); }
}
__device__ __forceinline__ void phase_prologue(LAS unsigned char* lds, const Args& A, int bid, int nb) {
    unsigned char* ws = A.ws; const int tid = threadIdx.x;
    if (bid == 0) {
        float* lb0 = (float*)(ws + WS_MISC);
        const float* l = A.in[I_LB];
        if (tid < 512) { const float a = l[tid], b = l[512 + tid], c = l[1024 + tid]; const float m = fmaxf(a, fmaxf(b, c));
            const float ea = __expf(a - m), eb = __expf(b - m), ec = __expf(c - m); lb0[tid] = ea / (ea + eb + ec); }
    }
    if (bid == 1 % nb) {
        float* wg = (float*)(ws + WS_MISC + 4096);
        for (int i = tid; i < 8 * 1024; i += 512) { const int g = i >> 10, k = i & 1023; wg[i] = A.in[I_WINC][(size_t)k * 3080 + 3072 + g]; }
    }
    { const float* x = A.in[I_X]; bf16_t* hb = (bf16_t*)(ws + WS_HB); unsigned char* xq = ws + WS_XQ;
      const size_t step = (size_t)nb * 512 * 8;
      for (size_t i0 = ((size_t)bid * 512 + tid) * 8; i0 < (size_t)NTOK * DM; i0 += 4 * step) {
          f32x4 a[4], b[4];
#pragma unroll
          for (int u = 0; u < 4; ++u) { const size_t i = i0 + u * step; if (i < (size_t)NTOK * DM) { a[u] = __builtin_nontemporal_load((const f32x4*)(x + i)); b[u] = __builtin_nontemporal_load((const f32x4*)(x + i + 4)); } }
#pragma unroll
          for (int u = 0; u < 4; ++u) { const size_t i = i0 + u * step; if (i < (size_t)NTOK * DM) {
              u32x4 w; w.x = pk2(a[u][0], a[u][1]); w.y = pk2(a[u][2], a[u][3]); w.z = pk2(b[u][0], b[u][1]); w.w = pk2(b[u][2], b[u][3]);
              *(u32x4*)(hb + i) = w;
              u32x2 qv; qv.x = pk4(q8(a[u][0], Q_SA), q8(a[u][1], Q_SA), q8(a[u][2], Q_SA), q8(a[u][3], Q_SA)); qv.y = pk4(q8(b[u][0], Q_SA), q8(b[u][1], Q_SA), q8(b[u][2], Q_SA), q8(b[u][3], Q_SA));
              *(u32x2*)(xq + i) = qv; } } } }
    { unsigned char* wab = ws + WS_WAB; const float* win = A.in[I_WINAB]; const float* wup = A.in[I_WGKUP];
      for (int o = bid * 512 + tid; o < 256 * 64; o += nb * 512) { const int j = o >> 6, k16 = (o & 63) * 16;
          float up[16];
#pragma unroll
          for (int r = 0; r < 16; ++r) up[r] = wup[r * 256 + j];
          int res[16];
#pragma unroll
          for (int q = 0; q < 16; ++q) { const float* wr_ = win + (size_t)(k16 + q) * 3600 + 3584; float sm = 0.f;
#pragma unroll
              for (int r = 0; r < 16; ++r) sm += wr_[r] * up[r];
              res[q] = q8(sm, Q_SW); }
          u32x4 w; w.x = pk4(res[0], res[1], res[2], res[3]); w.y = pk4(res[4], res[5], res[6], res[7]); w.z = pk4(res[8], res[9], res[10], res[11]); w.w = pk4(res[12], res[13], res[14], res[15]);
          *(u32x4*)(wab + (size_t)(3584 + j) * 1024 + k16) = w; } }
    cvt8_matrix<4>(lds, A.in[I_WINAB], 3600, 1024, 0, 3584, ws + WS_WAB, 0, Q_SW, bid, nb);
    cvt8_matrix<4>(lds, A.in[I_WOAB], 1024, 1024, 0, 1024, ws + WS_WOAB, 0, Q_SWO, bid, nb);
    cvt8_matrix<4>(lds, A.in[I_WINC], 3080, 1024, 0, 3072, ws + WS_WC, 0, Q_SW, bid, nb);
    cvt8_matrix<4>(lds, A.in[I_WOC], 1024, 1024, 0, 1024, ws + WS_WOC, 0, Q_SWO, bid, nb);
    cvt_matrix<4>(lds, A.in[I_WR], 256, 1024, 0, 256, (bf16_t*)(ws + WS_WR), 0, bid, nb);
    cvt_matrix<4>(lds, A.in[I_WR] + 1024 * 256, 256, 1024, 0, 256, (bf16_t*)(ws + WS_WR) + 256 * 1024, 0, bid, nb);
}
__device__ __forceinline__ void convert_experts(LAS unsigned char* lds, const Args& A, int layer, int bid, int nb, int lo16, int hi16) {
    unsigned char* ws = A.ws;
    int kk = 0;
    for (int j = bid; j < NE1 * 16; j += nb, ++kk) {
        { const int pk = kk % 16; if (pk < lo16 || pk >= hi16) continue; }
        const int e = j % NE1, t0 = j / NE1;
        const int t = (t0 < 8) ? 2 * t0 : 8 + t0;
        if (t < 16) {
            const float* src = (e < NEXP) ? A.in[I_WEI] + ((size_t)(layer * NEXP + e)) * 1024 * 512 : A.in[I_WSI] + (size_t)layer * 1024 * 512;
            unsigned char* dst = ws + WS_W1T + ((size_t)(layer * NE1 + e)) * 512 * 1024;
            const int tk = t >> 1;
            int dr[8];
#pragma unroll
            for (int q = 0; q < 8; ++q) { const int n0 = q * 64, gq = n0 >> 8, nn = n0 & 255; dr[q] = (nn >> 7) * 256 + gq * 128 + (nn & 127); }
            cvt8_multi<8>(lds, src, 512, tk * 128, 0, dst, 1024, dr, Q_SW);
        } else {
            const int t2 = t - 16, tk = t2 >> 2, g4 = t2 & 3;
            const float* src = (e < NEXP) ? A.in[I_WED] + ((size_t)(layer * NEXP + e)) * 256 * 1024 : A.in[I_WSD] + (size_t)layer * 256 * 1024;
            unsigned char* dst = ws + WS_W2T + ((size_t)(layer * NE1 + e)) * 1024 * 256;
            int dr[4];
#pragma unroll
            for (int q = 0; q < 4; ++q) dr[q] = g4 * 256 + q * 64;
            cvt8_multi<4>(lds, src, 1024, tk * 128, g4 * 256, dst, 256, dr, Q_SW);
        }
    }
}

__device__ __forceinline__ void phase_ln(const bf16_t* __restrict__ Z, bf16_t* __restrict__ H, unsigned char* __restrict__ HQ, const float* __restrict__ g, const float* __restrict__ b, int bid, int nb) {
    const int lane = threadIdx.x & 63, gw = bid * 8 + (threadIdx.x >> 6), nw = nb * 8;
    float gg[16], bb[16];
#pragma unroll
    for (int i = 0; i < 8; ++i) { gg[i] = g[lane * 8 + i]; gg[8 + i] = g[512 + lane * 8 + i]; bb[i] = b[lane * 8 + i]; bb[8 + i] = b[512 + lane * 8 + i]; }
    for (int row = gw; row < NTOK; row += nw) {
        const u32x4 a = *(const u32x4*)(Z + (size_t)row * DM + lane * 8), c = *(const u32x4*)(Z + (size_t)row * DM + 512 + lane * 8);
        float v[16];
        v[0] = bflo(a.x); v[1] = bfhi(a.x); v[2] = bflo(a.y); v[3] = bfhi(a.y); v[4] = bflo(a.z); v[5] = bfhi(a.z); v[6] = bflo(a.w); v[7] = bfhi(a.w);
        v[8] = bflo(c.x); v[9] = bfhi(c.x); v[10] = bflo(c.y); v[11] = bfhi(c.y); v[12] = bflo(c.z); v[13] = bfhi(c.z); v[14] = bflo(c.w); v[15] = bfhi(c.w);
        float s = 0.f;
#pragma unroll
        for (int i = 0; i < 16; ++i) s += v[i];
#pragma unroll
        for (int o = 32; o > 0; o >>= 1) s += __shfl_xor(s, o);
        const float mu = s * (1.f / 1024.f);
        float q = 0.f;
#pragma unroll
        for (int i = 0; i < 16; ++i) { const float d = v[i] - mu; q += d * d; }
#pragma unroll
        for (int o = 32; o > 0; o >>= 1) q += __shfl_xor(q, o);
        const float rs = rsqrtf(q * (1.f / 1024.f) + 1e-5f);
        float y[16];
#pragma unroll
        for (int i = 0; i < 16; ++i) y[i] = (v[i] - mu) * rs * gg[i] + bb[i];
        u32x4 w0, w1; w0.x = pk2(y[0], y[1]); w0.y = pk2(y[2], y[3]); w0.z = pk2(y[4], y[5]); w0.w = pk2(y[6], y[7]);
        w1.x = pk2(y[8], y[9]); w1.y = pk2(y[10], y[11]); w1.z = pk2(y[12], y[13]); w1.w = pk2(y[14], y[15]);
        *(u32x4*)(H + (size_t)row * DM + lane * 8) = w0; *(u32x4*)(H + (size_t)row * DM + 512 + lane * 8) = w1;
        u32x2 q0, q1;
        q0.x = pk4(q8(y[0], Q_SA), q8(y[1], Q_SA), q8(y[2], Q_SA), q8(y[3], Q_SA)); q0.y = pk4(q8(y[4], Q_SA), q8(y[5], Q_SA), q8(y[6], Q_SA), q8(y[7], Q_SA));
        q1.x = pk4(q8(y[8], Q_SA), q8(y[9], Q_SA), q8(y[10], Q_SA), q8(y[11], Q_SA)); q1.y = pk4(q8(y[12], Q_SA), q8(y[13], Q_SA), q8(y[14], Q_SA), q8(y[15], Q_SA));
        *(u32x2*)(HQ + (size_t)row * DM + lane * 8) = q0; *(u32x2*)(HQ + (size_t)row * DM + 512 + lane * 8) = q1;
    }
}

template <bool FINAL>
__device__ __forceinline__ void phase_combine(const unsigned char* __restrict__ Y, const int* __restrict__ posy, const float* __restrict__ tokw, const int* __restrict__ ntiles,
                                              const bf16_t* __restrict__ H1, bf16_t* __restrict__ H2, unsigned char* __restrict__ H2Q, float* __restrict__ OUT, float* __restrict__ GATES,
                                              const float* __restrict__ wgate, const float* __restrict__ g, const float* __restrict__ b, int bid, int nb) {
    const int shbase = (*ntiles - NTOK / 256) * 256;
    const int lane = threadIdx.x & 63, gw = bid * 8 + (threadIdx.x >> 6), nw = nb * 8;
    int npos = 0; float nwk = 0.f;
    if (gw < NTOK) { npos = (lane < 8) ? posy[(size_t)gw * 8 + lane] : shbase + gw; nwk = (lane < 8) ? tokw[(size_t)gw * 8 + lane] : 1.0f; }
    float gg[16], bb[16], wgt[FINAL ? 1 : 8][16];
#pragma unroll
    for (int i = 0; i < 8; ++i) { gg[i] = g[lane * 8 + i]; gg[8 + i] = g[512 + lane * 8 + i]; bb[i] = b[lane * 8 + i]; bb[8 + i] = b[512 + lane * 8 + i]; }
    if (!FINAL) {
#pragma unroll
        for (int gi = 0; gi < 8; ++gi)
#pragma unroll
            for (int i = 0; i < 8; ++i) { wgt[gi][i] = wgate[gi * 1024 + lane * 8 + i]; wgt[gi][8 + i] = wgate[gi * 1024 + 512 + lane * 8 + i]; }
    }
    for (int row = gw; row < NTOK; row += nw) {
        const int cpos = npos; const float cwk = nwk;
        { const int nr = row + nw; if (nr < NTOK) { npos = (lane < 8) ? posy[(size_t)nr * 8 + lane] : shbase + nr; nwk = (lane < 8) ? tokw[(size_t)nr * 8 + lane] : 1.0f; } }
        float v[16];
        { const u32x4 a = *(const u32x4*)(H1 + (size_t)row * DM + lane * 8), c = *(const u32x4*)(H1 + (size_t)row * DM + 512 + lane * 8);
          v[0] = bflo(a.x); v[1] = bfhi(a.x); v[2] = bflo(a.y); v[3] = bfhi(a.y); v[4] = bflo(a.z); v[5] = bfhi(a.z); v[6] = bflo(a.w); v[7] = bfhi(a.w);
          v[8] = bflo(c.x); v[9] = bfhi(c.x); v[10] = bflo(c.y); v[11] = bfhi(c.y); v[12] = bflo(c.z); v[13] = bfhi(c.z); v[14] = bflo(c.w); v[15] = bfhi(c.w); }
#pragma unroll
        for (int i = 0; i < 16; ++i) v[i] *= ALPHA;
        u32x2 ya[NSLOT], yc[NSLOT]; float wks[NSLOT];
#pragma unroll
        for (int k = 0; k < NSLOT; ++k) {
            const int pos = __builtin_amdgcn_readlane(cpos, k); wks[k] = __uint_as_float(__builtin_amdgcn_readlane(__float_as_uint(cwk), k)) * 0.0625f;
            const unsigned char* yr = Y + (size_t)pos * DM;
            ya[k] = *(const u32x2*)(yr + lane * 8); yc[k] = *(const u32x2*)(yr + 512 + lane * 8);
        }
        typedef float f32x2_ __attribute__((ext_vector_type(2)));
#pragma unroll
        for (int k = 0; k < NSLOT; ++k) {
            const float wk = wks[k];
            const f32x2_ a0 = __builtin_amdgcn_cvt_pk_f32_fp8((int)ya[k].x, false), a1 = __builtin_amdgcn_cvt_pk_f32_fp8((int)ya[k].x, true), a2 = __builtin_amdgcn_cvt_pk_f32_fp8((int)ya[k].y, false), a3 = __builtin_amdgcn_cvt_pk_f32_fp8((int)ya[k].y, true);
            const f32x2_ c0 = __builtin_amdgcn_cvt_pk_f32_fp8((int)yc[k].x, false), c1 = __builtin_amdgcn_cvt_pk_f32_fp8((int)yc[k].x, true), c2 = __builtin_amdgcn_cvt_pk_f32_fp8((int)yc[k].y, false), c3 = __builtin_amdgcn_cvt_pk_f32_fp8((int)yc[k].y, true);
            v[0] += wk * a0.x; v[1] += wk * a0.y; v[2] += wk * a1.x; v[3] += wk * a1.y; v[4] += wk * a2.x; v[5] += wk * a2.y; v[6] += wk * a3.x; v[7] += wk * a3.y;
            v[8] += wk * c0.x; v[9] += wk * c0.y; v[10] += wk * c1.x; v[11] += wk * c1.y; v[12] += wk * c2.x; v[13] += wk * c2.y; v[14] += wk * c3.x; v[15] += wk * c3.y;
        }
        float s = 0.f;
#pragma unroll
        for (int i = 0; i < 16; ++i) s += v[i];
#pragma unroll
        for (int o = 32; o > 0; o >>= 1) s += __shfl_xor(s, o);
        const float mu = s * (1.f / 1024.f);
        float q = 0.f;
#pragma unroll
        for (int i = 0; i < 16; ++i) { const float d = v[i] - mu; q += d * d; }
#pragma unroll
        for (int o = 32; o > 0; o >>= 1) q += __shfl_xor(q, o);
        const float rs = rsqrtf(q * (1.f / 1024.f) + 1e-5f);
        float y[16];
#pragma unroll
        for (int i = 0; i < 16; ++i) y[i] = (v[i] - mu) * rs * gg[i] + bb[i];
        if (FINAL) {
            float* o = OUT + (size_t)row * DM;
            *(f32x4*)(o + lane * 8) = (f32x4){y[0], y[1], y[2], y[3]}; *(f32x4*)(o + lane * 8 + 4) = (f32x4){y[4], y[5], y[6], y[7]};
            *(f32x4*)(o + 512 + lane * 8) = (f32x4){y[8], y[9], y[10], y[11]}; *(f32x4*)(o + 512 + lane * 8 + 4) = (f32x4){y[12], y[13], y[14], y[15]};
        } else {
            u32x4 w0, w1; w0.x = pk2(y[0], y[1]); w0.y = pk2(y[2], y[3]); w0.z = pk2(y[4], y[5]); w0.w = pk2(y[6], y[7]);
            w1.x = pk2(y[8], y[9]); w1.y = pk2(y[10], y[11]); w1.z = pk2(y[12], y[13]); w1.w = pk2(y[14], y[15]);
            *(u32x4*)(H2 + (size_t)row * DM + lane * 8) = w0; *(u32x4*)(H2 + (size_t)row * DM + 512 + lane * 8) = w1;
            { u32x2 q0, q1;
              q0.x = pk4(q8(y[0], Q_SA), q8(y[1], Q_SA), q8(y[2], Q_SA), q8(y[3], Q_SA)); q0.y = pk4(q8(y[4], Q_SA), q8(y[5], Q_SA), q8(y[6], Q_SA), q8(y[7], Q_SA));
              q1.x = pk4(q8(y[8], Q_SA), q8(y[9], Q_SA), q8(y[10], Q_SA), q8(y[11], Q_SA)); q1.y = pk4(q8(y[12], Q_SA), q8(y[13], Q_SA), q8(y[14], Q_SA), q8(y[15], Q_SA));
              *(u32x2*)(H2Q + (size_t)row * DM + lane * 8) = q0; *(u32x2*)(H2Q + (size_t)row * DM + 512 + lane * 8) = q1; }
            float yr[16];
            yr[0] = bflo(w0.x); yr[1] = bfhi(w0.x); yr[2] = bflo(w0.y); yr[3] = bfhi(w0.y); yr[4] = bflo(w0.z); yr[5] = bfhi(w0.z); yr[6] = bflo(w0.w); yr[7] = bfhi(w0.w);
            yr[8] = bflo(w1.x); yr[9] = bfhi(w1.x); yr[10] = bflo(w1.y); yr[11] = bfhi(w1.y); yr[12] = bflo(w1.z); yr[13] = bfhi(w1.z); yr[14] = bflo(w1.w); yr[15] = bfhi(w1.w);
            float d8[8];
#pragma unroll
            for (int gi = 0; gi < 8; ++gi) { float d = 0.f;
#pragma unroll
                for (int i = 0; i < 16; ++i) d += yr[i] * wgt[FINAL ? 0 : gi][i];
                d8[gi] = d; }
            float d4[4], d2[2], d1;
            { const bool hi = (lane & 32) != 0;
#pragma unroll
              for (int q = 0; q < 4; ++q) { const float keep = hi ? d8[4 + q] : d8[q], give = hi ? d8[q] : d8[4 + q]; d4[q] = keep + __shfl_xor(give, 32); } }
            { const bool hi = (lane & 16) != 0;
#pragma unroll
              for (int q = 0; q < 2; ++q) { const float keep = hi ? d4[2 + q] : d4[q], give = hi ? d4[q] : d4[2 + q]; d2[q] = keep + __shfl_xor(give, 16); } }
            { const bool hi = (lane & 8) != 0; const float keep = hi ? d2[1] : d2[0], give = hi ? d2[0] : d2[1]; d1 = keep + __shfl_xor(give, 8); }
            d1 += __shfl_xor(d1, 4); d1 += __shfl_xor(d1, 2); d1 += __shfl_xor(d1, 1);
            const int gidx = ((lane >> 5) & 1) * 4 + ((lane >> 4) & 1) * 2 + ((lane >> 3) & 1);
            const float gsum = d1;
            if ((lane & 7) == 0) GATES[(size_t)row * 8 + gidx] = gsum;
        }
    }
}

#ifndef VARSEL
#define VARSEL 0
#endif
template <bool DRY>
__device__ __forceinline__ void phase_select(LAS unsigned char* lds, const float* __restrict__ logits, const float* __restrict__ rbias, int* __restrict__ tok_e, int* __restrict__ tok_p,
                                             float* __restrict__ tok_w, unsigned* __restrict__ cnt, int bid, int nb) {
    const int tid = threadIdx.x, it = tid & 63, g8 = tid >> 6;
    LAS unsigned* hist = (LAS unsigned*)lds;
    LAS unsigned* base = hist + 256;
    LAS int* selE = (LAS int*)(base + 256);
    LAS int* selR = selE + 1024;
    LAS float* gsl = (LAS float*)(lds + 10240);
    LAS float* lv = (LAS float*)(lds + 12288);
    LAS int* le = (LAS int*)(lds + 28672);
    LAS float* sb = (LAS float*)(lds + 45056);
    const int tpw = NTOK / nb;
    const int t0 = bid * tpw;
    const float NEG = -3.0e38f;
    if (tid < 256) hist[tid] = 0u;
    __syncthreads();
    for (int half = 0; half < tpw / 64; ++half) {
        const int tb = t0 + half * 64;
        {
            const int e = tid & 255, tk0 = tid >> 8; const float rb = rbias[e];
#pragma unroll
            for (int i0 = 0; i0 < 32; i0 += 8) { float lv8[8];
#pragma unroll
                for (int u = 0; u < 8; ++u) lv8[u] = logits[(size_t)(tb + tk0 + 2 * (i0 + u)) * 256 + e];
#pragma unroll
                for (int u = 0; u < 8; ++u) sb[e * 65 + tk0 + 2 * (i0 + u)] = sigm(lv8[u]) + rb; }
        }
        __syncthreads();
        {
            float m1 = NEG, m2 = NEG;
            for (int j = 0; j < 32; ++j) { const float v = sb[(g8 * 32 + j) * 65 + it]; if (v > m1) { m2 = m1; m1 = v; } else if (v > m2) m2 = v; }
            gsl[g8 * 64 + it] = m1 + m2;
        }
        __syncthreads();
        if (DRY && VARSEL == 1) { __syncthreads(); continue; }
        float G[8];
#pragma unroll
        for (int q = 0; q < 8; ++q) G[q] = gsl[q * 64 + it];
        unsigned selmask = 0u;
#pragma unroll
        for (int g = 0; g < 8; ++g) { int rank = 0;
#pragma unroll
            for (int q = 0; q < 8; ++q) rank += (G[q] > G[g] || (G[q] == G[g] && q < g)) ? 1 : 0;
            if (rank < 4) selmask |= 1u << g; }
        if ((selmask >> g8) & 1u) {
            float vv[32];
#pragma unroll
            for (int j = 0; j < 32; ++j) vv[j] = sb[(g8 * 32 + j) * 65 + it];
#pragma unroll
            for (int k = 0; k < 8; ++k) {
                float bv = vv[0]; int bj = 0;
#pragma unroll
                for (int j = 1; j < 32; ++j) { const bool gt = vv[j] > bv; bv = gt ? vv[j] : bv; bj = gt ? j : bj; }
#pragma unroll
                for (int j = 0; j < 32; ++j) vv[j] = (j == bj) ? NEG : vv[j];
                lv[(g8 * 8 + k) * 64 + it] = bv; le[(g8 * 8 + k) * 64 + it] = g8 * 32 + bj;
            }
        }
        __syncthreads();
        if (DRY && VARSEL == 2) { __syncthreads(); continue; }
        if (tid < 64) {
            int gid[4]; { int n = 0;
#pragma unroll
                for (int g = 0; g < 8; ++g) if ((selmask >> g) & 1u) { if (n == 0) gid[0] = g; else if (n == 1) gid[1] = g; else if (n == 2) gid[2] = g; else gid[3] = g; ++n; } }
            float hv[4]; int hp[4];
#pragma unroll
            for (int j = 0; j < 4; ++j) { hp[j] = 0; hv[j] = lv[(gid[j] * 8) * 64 + it]; }
            float sc8[8]; int te[8]; float tot = 0.f;
#pragma unroll
            for (int k = 0; k < 8; ++k) {
                int bj = 0; float bv = hv[0];
                if (hv[1] > bv) { bv = hv[1]; bj = 1; }
                if (hv[2] > bv) { bv = hv[2]; bj = 2; }
                if (hv[3] > bv) { bv = hv[3]; bj = 3; }
                const int gsel = (bj == 0) ? gid[0] : (bj == 1) ? gid[1] : (bj == 2) ? gid[2] : gid[3];
                const int psel = (bj == 0) ? hp[0] : (bj == 1) ? hp[1] : (bj == 2) ? hp[2] : hp[3];
                const int e = le[(gsel * 8 + psel) * 64 + it];
                te[k] = e; sc8[k] = bv - rbias[e]; tot += sc8[k];
                const float nv = (psel < 7) ? lv[(gsel * 8 + psel + 1) * 64 + it] : NEG;
                if (bj == 0) { hv[0] = nv; hp[0] = psel + 1; } else if (bj == 1) { hv[1] = nv; hp[1] = psel + 1; } else if (bj == 2) { hv[2] = nv; hp[2] = psel + 1; } else { hv[3] = nv; hp[3] = psel + 1; }
            }
            const float inv = 2.5f / tot;
            const int tok = tb + it, lt = half * 64 + it;
#pragma unroll
            for (int k = 0; k < 8; ++k) {
                tok_e[(size_t)tok * 8 + k] = te[k]; tok_w[(size_t)tok * 8 + k] = sc8[k] * inv;
                const unsigned r = atomicAdd((unsigned*)&hist[te[k]], 1u);
                selE[lt * 8 + k] = te[k]; selR[lt * 8 + k] = (int)r;
            }
        }
        __syncthreads();
    }
    if (DRY) return;
    if (tid < 256) { const unsigned c = hist[tid]; base[tid] = c ? __hip_atomic_fetch_add(cnt + tid, c, __ATOMIC_RELAXED, __HIP_MEMORY_SCOPE_AGENT) : 0u; }
    __syncthreads();
    for (int i = tid; i < tpw * 8; i += 512) tok_p[(size_t)t0 * 8 + i] = (int)base[selE[i]] + selR[i];
    __syncthreads();
}

__device__ __forceinline__ void phase_dispatch(LAS unsigned char* lds, const unsigned* __restrict__ cnt, const int* __restrict__ tok_e, const int* __restrict__ tok_p,
                                               int* __restrict__ s_tok, int* __restrict__ posy, int* __restrict__ tile_exp, int* __restrict__ ntiles, int bid, int nb) {
    const int tid = threadIdx.x;
    LAS int* tstart = (LAS int*)lds;
    LAS int* tcnt = tstart + 260;
    if (tid < 256) tcnt[tid] = (int)((__hip_atomic_load(cnt + tid, __ATOMIC_RELAXED, __HIP_MEMORY_SCOPE_AGENT) + 255u) >> 8);
    __syncthreads();
    if (tid < 256) { int a = 0;
#pragma unroll 16
        for (int j = 0; j < 256; ++j) { const int c = tcnt[j]; a += (j < tid) ? c : 0; }
        tstart[tid] = a; if (tid == 255) tstart[256] = a + tcnt[255]; }
    __syncthreads();
    const int TT = tstart[256];
    const int tpw = NTOK / nb, t0 = bid * tpw;
    for (int i = tid; i < tpw * 8; i += 512) {
        const size_t a = (size_t)t0 * 8 + i; const int e = tok_e[a], p = tok_p[a];
        const int pos = tstart[e] * 256 + p;
        s_tok[pos] = (int)(a >> 3); posy[a] = pos;
    }
    for (int i = tid; i < tpw; i += 512) { const int tok = t0 + i; s_tok[TT * 256 + tok] = tok; }
    for (int e = bid; e < 256; e += nb) {
        const int c = (int)__hip_atomic_load(cnt + e, __ATOMIC_RELAXED, __HIP_MEMORY_SCOPE_AGENT), ts = tstart[e], tc = tcnt[e];
        for (int i = c + tid; i < tc * 256; i += 512) s_tok[ts * 256 + i] = 0;
        for (int i = tid; i < tc; i += 512) tile_exp[ts + i] = e;
    }
    if (bid == 0) { for (int i = tid; i < NTOK / 256; i += 512) tile_exp[TT + i] = 256; if (tid == 0) *ntiles = TT + NTOK / 256; }
    __syncthreads();
}

constexpr int MX_QT = 0, MX_KT = 17408, MX_KHT = 34816, MX_VT = 53248, MX_P = 73984, MX_ST = 83200, MX_SEG = 122368, MX_GD = 126464, MX_ER = 126976, MX_RS = 127488, MX_DEN = 128000, MX_BC = 128256, MX_IP = 128512, MX_GT = 128768;
struct MixP {
    const bf16_t* proj; int ldp; int pad0; unsigned char* ymix; const float* gates;
    const float* lb0; const float* bgk; const float* hg; const float* gg; const float* conv; const float* bif;
    float* ust; float* gsum;
};
#define MFMA16(a, b, c) __builtin_amdgcn_mfma_f32_16x16x32_bf16((a), (b), (c), 0, 0, 0)

template <int MODE, bool FULL, int VAR = 0>
__device__ __forceinline__ void mixer_run(LAS unsigned char* lds, const MixP& mp, int bid) {
    constexpr int DK = (MODE == 1) ? 64 : 128, QP = DK + 8, CP = DK / 2, RG = 512 / CP, RPT = 64 / RG, KS = DK / 32;
    constexpr int NVT = (MODE == 2) ? 9 : 8;
    constexpr int NST = (DK == 128) ? NVT : 4;
    const int tid = threadIdx.x, lane = tid & 63, w = __builtin_amdgcn_readfirstlane(tid >> 6), l15 = lane & 15, l4 = lane >> 4;
    int b, h, vh = 0, seg;
    if (MODE == 0) { const int sq = bid >> 4; b = sq >> 2; h = sq & 3; seg = bid & 15; }
    else if (MODE == 1) { const int sq = (bid - 128) >> 4; b = sq >> 2; h = sq & 3; seg = bid & 15; }
    else { const int sq = bid >> 4; b = sq >> 3; h = (sq >> 1) & 3; vh = sq & 1; seg = bid & 15; }
    const int tok0 = b * SEQ + seg * 1024;
    const int ldp = mp.ldp; const bf16_t* proj = mp.proj;
    int cq, ck, cv, cg, cy;
    if (MODE == 0) { cq = h * 128; ck = 512 + h * 128; cv = 1024 + h * 128; cg = 1536 + h * 128; cy = h * 128; }
    else if (MODE == 1) { cq = 2048 + h * 64; ck = 2304 + h * 64; cv = 2560 + h * 128; cg = 3072 + h * 128; cy = 512 + h * 128; }
    else { cq = h * 128; ck = 512 + h * 128; cv = 1024 + h * 256 + vh * 128; cg = 2048 + h * 256 + vh * 128; cy = h * 256 + vh * 128; }
    const int cu = 3584 + h * 64;
    const int cp = tid % CP, rg = tid / CP, d0 = 2 * cp;
    float lbv[2] = {0.f, 0.f}, oml[2] = {0.f, 0.f}, bgk[2] = {0.f, 0.f}, cwq[4][2], cwk[4][2];
    if (MODE == 0) { lbv[0] = mp.lb0[h * 128 + d0]; lbv[1] = mp.lb0[h * 128 + d0 + 1]; oml[0] = 1.f - lbv[0]; oml[1] = 1.f - lbv[1]; }
    if (MODE == 1) { bgk[0] = mp.bgk[h * 64 + d0]; bgk[1] = mp.bgk[h * 64 + d0 + 1]; }
#pragma unroll
    for (int j = 0; j < 4; ++j) { cwq[j][0] = cwq[j][1] = cwk[j][0] = cwk[j][1] = 0.f; }
    if (MODE == 2) {
#pragma unroll
        for (int j = 0; j < 4; ++j) { cwq[j][0] = mp.conv[j * 1024 + cq + d0]; cwq[j][1] = mp.conv[j * 1024 + cq + d0 + 1]; cwk[j][0] = mp.conv[j * 1024 + ck + d0]; cwk[j][1] = mp.conv[j * 1024 + ck + d0 + 1]; }
    }
    const float bi = (MODE == 2) ? mp.bif[h] : 0.f, bfg = (MODE == 2) ? mp.bif[4 + h] : 0.f;
    const int sdt = (DK == 128) ? w : (w & 3), svt0 = (DK == 128) ? 0 : 4 * (w >> 2);
    f32x4 S[NST];
#pragma unroll
    for (int t = 0; t < NST; ++t) S[t] = (f32x4){0.f, 0.f, 0.f, 0.f};
    float gacc[2] = {(MODE == 2) ? 0.f : 1.f, (MODE == 2) ? 0.f : 1.f};
    if (MODE == 2) {
        for (int i = tid; i < 16 * 72; i += 512) { const int r = i / 72; *(LAS bf16_t*)(lds + MX_VT + ((128 + r) * 72 + (i % 72)) * 2) = (r == 0) ? (bf16_t)0x3F80 : (bf16_t)0; }
    }
    if (FULL) {
        const int bid0 = bid & ~15;
#pragma unroll 2
        for (int j = 0; j < seg; ++j) {
            const float* U = mp.ust + ((size_t)(bid0 + j) * 8 + w) * (9 * 4 * 64);
            float dec[4];
            if (MODE == 2) { const float gsv = mp.gsum[(size_t)(bid0 + j) * 128]; dec[0] = dec[1] = dec[2] = dec[3] = __expf(gsv); }
            else {
#pragma unroll
                for (int r = 0; r < 4; ++r) dec[r] = mp.gsum[(size_t)(bid0 + j) * 128 + sdt * 16 + 4 * l4 + r];
            }
            f32x4 uu[NST];
#pragma unroll
            for (int t = 0; t < NST; ++t)
#pragma unroll
                for (int r = 0; r < 4; ++r) uu[t][r] = U[(t * 4 + r) * 64 + lane];
#pragma unroll
            for (int t = 0; t < NST; ++t)
#pragma unroll
                for (int r = 0; r < 4; ++r) S[t][r] = dec[r] * S[t][r] + uu[t][r];
        }
    }
    const int sj = w & 3, ovh = w >> 2, srow = 16 * sj + l15;
    const int vp = tid & 63, r0v = (tid >> 6) * 8;
    unsigned ra[RPT + 3], rb[RPT + 3], rc[RPT], pv[8]; u32x2 gnx[4]; float sgi = 0.f, sgf = 0.f;
#pragma unroll
    for (int i = 0; i < RPT + 3; ++i) { ra[i] = 0u; rb[i] = 0u; }
#pragma unroll
    for (int i = 0; i < RPT; ++i) rc[i] = 0u;
#pragma unroll
    for (int t = 0; t < 4; ++t) gnx[t] = (u32x2){0u, 0u};
#define MX_LOAD(cn) do { const int tokn_ = tok0 + (cn) * 64; \
        if (VAR == 1 || VAR == 3 || VAR == 4) { _Pragma("unroll") for (int i = 0; i < RPT + 3; ++i) { ra[i] = 0x3c003c00u + (unsigned)(cn); rb[i] = 0x3c003c00u; } _Pragma("unroll") for (int i = 0; i < RPT; ++i) rc[i] = 0x3c003c00u; _Pragma("unroll") for (int i = 0; i < 8; ++i) pv[i] = 0x3c003c00u; _Pragma("unroll") for (int t = 0; t < 4; ++t) gnx[t] = (u32x2){0x3c003c00u, 0x3c003c00u}; sgi = 0.1f; sgf = 3.f; } else \
        if (MODE == 2) { const int tl0_ = seg * 1024 + (cn) * 64 + rg * RPT; \
            _Pragma("unroll") for (int i = 0; i < RPT + 3; ++i) { const int tl_ = tl0_ - 3 + i; \
                if (tl_ >= 0) { const bf16_t* pr_ = proj + (size_t)(b * SEQ + tl_) * ldp; if (FULL) ra[i] = *(const unsigned*)(pr_ + cq + d0); rb[i] = *(const unsigned*)(pr_ + ck + d0); } \
                else { ra[i] = 0u; rb[i] = 0u; } } \
            if (w == 0) { const float* gp_ = mp.gates + (size_t)(tokn_ + lane) * 8; sgi = gp_[h]; sgf = gp_[4 + h]; } \
        } else { \
            _Pragma("unroll") for (int i = 0; i < RPT; ++i) { const bf16_t* pr_ = proj + (size_t)(tokn_ + rg * RPT + i) * ldp; \
                if (MODE == 0) { ra[i] = *(const unsigned*)(pr_ + ck + d0); if (FULL) rb[i] = *(const unsigned*)(pr_ + cq + d0); } \
                else { ra[i] = *(const unsigned*)(pr_ + cu + d0); rb[i] = *(const unsigned*)(pr_ + ck + d0); if (FULL) rc[i] = *(const unsigned*)(pr_ + cq + d0); } } \
        } \
        _Pragma("unroll") for (int i = 0; i < 8; ++i) pv[i] = *(const unsigned*)(proj + (size_t)(tokn_ + r0v + i) * ldp + cv + 2 * vp); \
        if (FULL) { _Pragma("unroll") for (int t = 0; t < 4; ++t) gnx[t] = *(const u32x2*)(proj + (size_t)(tokn_ + srow) * ldp + cg + 16 * (4 * ovh + t) + 4 * l4); } \
    } while (0)
    float gnv[4][4];
#pragma unroll
    for (int t = 0; t < 4; ++t)
#pragma unroll
        for (int r = 0; r < 4; ++r) gnv[t][r] = (FULL && MODE != 2) ? ((MODE == 0) ? mp.hg : mp.gg)[h * 128 + 16 * (4 * ovh + t) + 4 * l4 + r] : 1.f;
    MX_LOAD(0);
    __syncthreads();
    for (int c = 0; c < 16; ++c) {
        const int tokc = tok0 + c * 64;
        float la[RPT][2], sp[RPT][2], qv[RPT][2], kv[RPT][2];
        u32x2 gcur[4];
        if (VAR == 4) {
#pragma unroll
            for (int t = 0; t < 4; ++t) gcur[t] = gnx[t];
            __syncthreads(); __syncthreads(); goto stepC; }
#pragma unroll
        for (int t = 0; t < 4; ++t) gcur[t] = gnx[t];
        if (MODE == 2) {
            if (w == 0) {
                const float ip = sgi + bi, lf = logsig(sgf + bfg);
                float cs = lf;
#pragma unroll
                for (int o = 1; o < 64; o <<= 1) { const float t = __shfl_up(cs, o); if (lane >= o) cs += t; }
                *(LAS float*)(lds + MX_BC + lane * 4) = cs; *(LAS float*)(lds + MX_IP + lane * 4) = ip - cs;
                if (lane == 63) *(LAS float*)(lds + MX_GT) = cs;
            }
#pragma unroll
            for (int i = 0; i < RPT; ++i)
#pragma unroll
                for (int e = 0; e < 2; ++e) {
                    float aq = 0.f, ak = 0.f;
#pragma unroll
                    for (int j = 0; j < 4; ++j) { aq += cwq[j][e] * (e ? bfhi(ra[i + j]) : bflo(ra[i + j])); ak += cwk[j][e] * (e ? bfhi(rb[i + j]) : bflo(rb[i + j])); }
                    qv[i][e] = silu(aq); kv[i][e] = silu(ak) * 0.08838834764831845f; la[i][e] = 0.f; sp[i][e] = 0.f;
                }
        } else {
#pragma unroll
            for (int i = 0; i < RPT; ++i) {
                if (MODE == 0) {
                    const unsigned uz = ra[i];
                    const float s0 = sigm(bflo(uz)), s1 = sigm(bfhi(uz));
                    la[i][0] = lbv[0] + oml[0] * s0; la[i][1] = lbv[1] + oml[1] * s1;
                    kv[i][0] = oml[0] - oml[0] * s0; kv[i][1] = oml[1] - oml[1] * s1;
                    if (FULL) { const unsigned uq = rb[i]; qv[i][0] = silu(bflo(uq)); qv[i][1] = silu(bfhi(uq)); } else { qv[i][0] = qv[i][1] = 0.f; }
                } else {
                    const unsigned uu = ra[i], uk = rb[i];
                    la[i][0] = __expf(logsig(bflo(uu) + bgk[0]) * 0.0625f); la[i][1] = __expf(logsig(bfhi(uu) + bgk[1]) * 0.0625f);
                    kv[i][0] = bflo(uk); kv[i][1] = bfhi(uk);
                    if (FULL) { const unsigned uq = rc[i]; qv[i][0] = bflo(uq) * 0.125f; qv[i][1] = bfhi(uq) * 0.125f; } else { qv[i][0] = qv[i][1] = 0.f; }
                }
            }
#pragma unroll
            for (int e = 0; e < 2; ++e) {
                float run = 1.f;
#pragma unroll
                for (int i = RPT - 1; i >= 0; --i) { sp[i][e] = run; run *= la[i][e]; }
                run = 1.f;
#pragma unroll
                for (int i = 0; i < RPT; ++i) { run *= la[i][e]; la[i][e] = run; }
            }
            *(LAS float*)(lds + MX_SEG + (rg * DK + d0) * 4) = la[RPT - 1][0]; *(LAS float*)(lds + MX_SEG + (rg * DK + d0 + 1) * 4) = la[RPT - 1][1];
        }
        {
            u32x4 lo, hi;
            lo.x = (pv[0] & 0xffffu) | (pv[1] << 16); lo.y = (pv[2] & 0xffffu) | (pv[3] << 16); lo.z = (pv[4] & 0xffffu) | (pv[5] << 16); lo.w = (pv[6] & 0xffffu) | (pv[7] << 16);
            hi.x = (pv[0] >> 16) | (pv[1] & 0xffff0000u); hi.y = (pv[2] >> 16) | (pv[3] & 0xffff0000u); hi.z = (pv[4] >> 16) | (pv[5] & 0xffff0000u); hi.w = (pv[6] >> 16) | (pv[7] & 0xffff0000u);
            *(LAS u32x4*)(lds + MX_VT + ((2 * vp) * 72 + r0v) * 2) = lo; *(LAS u32x4*)(lds + MX_VT + ((2 * vp + 1) * 72 + r0v) * 2) = hi;
        }
        if (c + 1 < 16) MX_LOAD(c + 1);
        if (VAR == 2) { unsigned xa = 0; _Pragma("unroll") for (int i = 0; i < RPT + 3; ++i) xa ^= ra[i] ^ rb[i]; _Pragma("unroll") for (int i = 0; i < RPT; ++i) xa ^= rc[i]; _Pragma("unroll") for (int i = 0; i < 8; ++i) xa ^= pv[i];
            _Pragma("unroll") for (int t = 0; t < 4; ++t) xa ^= gnx[t].x ^ gnx[t].y; gacc[0] += (float)(xa & 1u) + sgi + sgf; continue; }
        __syncthreads();
        {
            float pre[2], h2[2], gt[2];
            if (MODE == 2) {
                const float g = *(LAS float*)(lds + MX_GT);
                gt[0] = gt[1] = g; h2[0] = h2[1] = 0.f; pre[0] = pre[1] = 0.f;
                if (tid == 0) gacc[0] += g;
            } else {
#pragma unroll
                for (int e = 0; e < 2; ++e) { float p = 1.f, a1 = 1.f, a2 = 1.f;
#pragma unroll
                    for (int j = 0; j < RG; ++j) { const float v = *(LAS float*)(lds + MX_SEG + (j * DK + d0 + e) * 4);
                        if (j < RG / 2) a1 *= v; else a2 *= v;
                        const bool inb = (rg >= RG / 2) ? (j >= RG / 2 && j < rg) : (j > rg && j < RG / 2);
                        p *= inb ? v : 1.f; }
                    pre[e] = p; h2[e] = a2; gt[e] = a1 * a2;
                    if (rg == 0) { gacc[e] *= gt[e]; *(LAS float*)(lds + MX_GD + (d0 + e) * 4) = gt[e]; *(LAS float*)(lds + MX_ER + (d0 + e) * 4) = a1; } }
            }
            float kh[RPT][2];
#pragma unroll
            for (int i = 0; i < RPT; ++i) {
                const int s = rg * RPT + i;
                float qs[2], ks[2];
                if (MODE == 2) {
                    const float bc = *(LAS float*)(lds + MX_BC + s * 4), ipb = *(LAS float*)(lds + MX_IP + s * 4);
                    const float eq = __expf(bc), ek = __expf(ipb), eg = __expf(gt[0]);
                    qs[0] = qv[i][0] * eq; qs[1] = qv[i][1] * eq; ks[0] = kv[i][0] * ek; ks[1] = kv[i][1] * ek; kh[i][0] = ks[0] * eg; kh[i][1] = ks[1] * eg;
                } else {
#pragma unroll
                    for (int e = 0; e < 2; ++e) {
                        const float cd = pre[e] * ((rg >= RG / 2) ? la[i][e] : sp[i][e]);
                        const float rc_ = __builtin_amdgcn_rcpf(cd);
                        const float qm = (rg >= RG / 2) ? cd : rc_, km = (rg >= RG / 2) ? rc_ : cd;
                        qs[e] = qv[i][e] * qm; ks[e] = kv[i][e] * km; kh[i][e] = ks[e] * h2[e]; }
                }
                if (FULL) { *(LAS unsigned*)(lds + MX_QT + (s * QP + d0) * 2) = pk2(qs[0], qs[1]); *(LAS unsigned*)(lds + MX_KT + (s * QP + d0) * 2) = pk2(ks[0], ks[1]); }
            }
            if (RPT == 8) {
                u32x4 a, bq;
                a.x = pk2(kh[0][0], kh[1][0]); a.y = pk2(kh[2][0], kh[3][0]); a.z = pk2(kh[4 % RPT][0], kh[5 % RPT][0]); a.w = pk2(kh[6 % RPT][0], kh[7 % RPT][0]);
                bq.x = pk2(kh[0][1], kh[1][1]); bq.y = pk2(kh[2][1], kh[3][1]); bq.z = pk2(kh[4 % RPT][1], kh[5 % RPT][1]); bq.w = pk2(kh[6 % RPT][1], kh[7 % RPT][1]);
                *(LAS u32x4*)(lds + MX_KHT + (d0 * 72 + rg * 8) * 2) = a; *(LAS u32x4*)(lds + MX_KHT + ((d0 + 1) * 72 + rg * 8) * 2) = bq;
            } else {
                u32x2 a, bq;
                a.x = pk2(kh[0][0], kh[1][0]); a.y = pk2(kh[2][0], kh[3][0]); bq.x = pk2(kh[0][1], kh[1][1]); bq.y = pk2(kh[2][1], kh[3][1]);
                *(LAS u32x2*)(lds + MX_KHT + (d0 * 72 + rg * 4) * 2) = a; *(LAS u32x2*)(lds + MX_KHT + ((d0 + 1) * 72 + rg * 4) * 2) = bq;
            }
        }
        __syncthreads();
        stepC:
        if (FULL && VAR != 3) {
#pragma unroll
            for (int tt = 0; tt < 2; ++tt) {
                const int tile = 2 * w + tt, ti = tile >> 2, tj = tile & 3;
                f32x4 acc = (f32x4){0.f, 0.f, 0.f, 0.f};
                if (ti <= tj) {
#pragma unroll
                    for (int kk = 0; kk < KS; ++kk) {
                        const bf16x8 a = *(const LAS bf16x8*)(lds + MX_KT + ((16 * ti + l15) * QP + kk * 32 + 8 * l4) * 2);
                        const bf16x8 bq = *(const LAS bf16x8*)(lds + MX_QT + ((16 * tj + l15) * QP + kk * 32 + 8 * l4) * 2);
                        acc = MFMA16(a, bq, acc);
                    }
                }
                const int s = 16 * tj + l15, sp0 = 16 * ti + 4 * l4;
                float pvv[4];
#pragma unroll
                for (int r = 0; r < 4; ++r) pvv[r] = (sp0 + r <= s) ? acc[r] : 0.f;
                u32x2 pw; pw.x = pk2(pvv[0], pvv[1]); pw.y = pk2(pvv[2], pvv[3]);
                *(LAS u32x2*)(lds + MX_P + (s * 72 + sp0) * 2) = pw;
            }
            {
                float er[4];
#pragma unroll
                for (int r = 0; r < 4; ++r) er[r] = (MODE == 2) ? 1.f : *(LAS float*)(lds + MX_ER + (sdt * 16 + 4 * l4 + r) * 4);
#pragma unroll
                for (int t = 0; t < NST; ++t) {
                    const int v = 16 * (svt0 + t) + l15;
                    u32x2 sw; sw.x = pk2(S[t][0] * er[0], S[t][1] * er[1]); sw.y = pk2(S[t][2] * er[2], S[t][3] * er[3]);
                    *(LAS u32x2*)(lds + MX_ST + (v * QP + sdt * 16 + 4 * l4) * 2) = sw;
                }
            }
            {
                float dec[4];
                if (MODE == 2) { const float eg = __expf(*(LAS float*)(lds + MX_GT)); dec[0] = dec[1] = dec[2] = dec[3] = eg; }
                else {
    #pragma unroll
                    for (int r = 0; r < 4; ++r) dec[r] = *(LAS float*)(lds + MX_GD + (sdt * 16 + 4 * l4 + r) * 4);
                }
                bf16x8 ka[2];
    #pragma unroll
                for (int kk = 0; kk < 2; ++kk) ka[kk] = *(const LAS bf16x8*)(lds + MX_KHT + ((16 * sdt + l15) * 72 + kk * 32 + 8 * l4) * 2);
    #pragma unroll
                for (int t = 0; t < NST; ++t) {
    #pragma unroll
                    for (int r = 0; r < 4; ++r) S[t][r] *= dec[r];
    #pragma unroll
                    for (int kk = 0; kk < 2; ++kk) {
                        const bf16x8 vb = *(const LAS bf16x8*)(lds + MX_VT + ((16 * (svt0 + t) + l15) * 72 + kk * 32 + 8 * l4) * 2);
                        S[t] = MFMA16(ka[kk], vb, S[t]);
                    }
                }
            }
            __syncthreads();
            constexpr int NOT = (MODE == 2) ? 5 : 4;
            f32x4 O[NOT];
#pragma unroll
            for (int t = 0; t < NOT; ++t) O[t] = (f32x4){0.f, 0.f, 0.f, 0.f};
#pragma unroll
            for (int kk = 0; kk < 2; ++kk) {
                const bf16x8 bq = *(const LAS bf16x8*)(lds + MX_P + ((16 * sj + l15) * 72 + kk * 32 + 8 * l4) * 2);
#pragma unroll
                for (int t = 0; t < NOT; ++t) { const int vt = (t < 4) ? (4 * ovh + t) : 8;
                    if (t < 4 || ovh == 0) { const bf16x8 a = *(const LAS bf16x8*)(lds + MX_VT + ((16 * vt + l15) * 72 + kk * 32 + 8 * l4) * 2); O[t] = MFMA16(a, bq, O[t]); } }
            }
#pragma unroll
            for (int kk = 0; kk < KS; ++kk) {
                const bf16x8 bq = *(const LAS bf16x8*)(lds + MX_QT + ((16 * sj + l15) * QP + kk * 32 + 8 * l4) * 2);
#pragma unroll
                for (int t = 0; t < NOT; ++t) { const int vt = (t < 4) ? (4 * ovh + t) : 8;
                    if (t < 4 || ovh == 0) { const bf16x8 a = *(const LAS bf16x8*)(lds + MX_ST + ((16 * vt + l15) * QP + kk * 32 + 8 * l4) * 2); O[t] = MFMA16(a, bq, O[t]); } }
            }
            const int tokr = tokc + srow;
            float scale;
            if (MODE == 2) {
                if (ovh == 0 && l4 == 0) *(LAS float*)(lds + MX_DEN + srow * 4) = O[NOT - 1][0];
                __syncthreads();
                const float den = *(LAS float*)(lds + MX_DEN + srow * 4);
                scale = 1.f / fmaxf(fabsf(den), 1.f);
            } else {
                float ss = 0.f;
#pragma unroll
                for (int t = 0; t < 4; ++t)
#pragma unroll
                    for (int r = 0; r < 4; ++r) ss += O[t][r] * O[t][r];
                ss += __shfl_xor(ss, 16); ss += __shfl_xor(ss, 32);
                if (l4 == 0) *(LAS float*)(lds + MX_RS + (ovh * 64 + srow) * 4) = ss;
                __syncthreads();
                const float tot = *(LAS float*)(lds + MX_RS + srow * 4) + *(LAS float*)(lds + MX_RS + (64 + srow) * 4);
                scale = rsqrtf(tot * (1.f / 128.f) + 1e-6f);
            }
#pragma unroll
            for (int t = 0; t < 4; ++t) {
                const int v0 = 16 * (4 * ovh + t) + 4 * l4;
                const u32x2 gt = gcur[t];
                const float g0 = bflo(gt.x), g1 = bfhi(gt.x), g2 = bflo(gt.y), g3 = bfhi(gt.y);
                float y0, y1, y2, y3;
                if (MODE == 2) { y0 = O[t][0] * scale * sigm(g0); y1 = O[t][1] * scale * sigm(g1); y2 = O[t][2] * scale * sigm(g2); y3 = O[t][3] * scale * sigm(g3); }
                else { y0 = O[t][0] * scale * gnv[t][0] * silu(g0); y1 = O[t][1] * scale * gnv[t][1] * silu(g1); y2 = O[t][2] * scale * gnv[t][2] * silu(g2); y3 = O[t][3] * scale * gnv[t][3] * silu(g3); }
                *(LAS unsigned*)(lds + MX_P + srow * 128 + ((((v0 >> 4)) ^ (srow & 7)) << 4) + (v0 & 15)) = pk4(q8(y0, Q_SY), q8(y1, Q_SY), q8(y2, Q_SY), q8(y3, Q_SY));
            }
            __syncthreads();
            { const int yr = tid >> 3, yc = tid & 7;
              const u32x4 yv = *(const LAS u32x4*)(lds + MX_P + yr * 128 + ((yc ^ (yr & 7)) << 4));
              *(u32x4*)(mp.ymix + (size_t)(tokc + yr) * DM + cy + yc * 16) = yv; }
        }
        if (!FULL || VAR == 3) {
            {
                float dec[4];
                if (MODE == 2) { const float eg = __expf(*(LAS float*)(lds + MX_GT)); dec[0] = dec[1] = dec[2] = dec[3] = eg; }
                else {
    #pragma unroll
                    for (int r = 0; r < 4; ++r) dec[r] = *(LAS float*)(lds + MX_GD + (sdt * 16 + 4 * l4 + r) * 4);
                }
                bf16x8 ka[2];
    #pragma unroll
                for (int kk = 0; kk < 2; ++kk) ka[kk] = *(const LAS bf16x8*)(lds + MX_KHT + ((16 * sdt + l15) * 72 + kk * 32 + 8 * l4) * 2);
    #pragma unroll
                for (int t = 0; t < NST; ++t) {
    #pragma unroll
                    for (int r = 0; r < 4; ++r) S[t][r] *= dec[r];
    #pragma unroll
                    for (int kk = 0; kk < 2; ++kk) {
                        const bf16x8 vb = *(const LAS bf16x8*)(lds + MX_VT + ((16 * (svt0 + t) + l15) * 72 + kk * 32 + 8 * l4) * 2);
                        S[t] = MFMA16(ka[kk], vb, S[t]);
                    }
                }
            }
        __syncthreads();
        }
    }
#undef MX_LOAD
    if (VAR == 2) { mp.ust[(size_t)bid * 512 + tid] = gacc[0]; return; }
    if (!FULL) {
        float* U = mp.ust + ((size_t)bid * 8 + w) * (9 * 4 * 64);
#pragma unroll
        for (int t = 0; t < NST; ++t)
#pragma unroll
            for (int r = 0; r < 4; ++r) U[(t * 4 + r) * 64 + lane] = S[t][r];
        if (MODE == 2) { if (tid == 0) mp.gsum[(size_t)bid * 128] = gacc[0]; }
        else if (rg == 0) { mp.gsum[(size_t)bid * 128 + d0] = gacc[0]; mp.gsum[(size_t)bid * 128 + d0 + 1] = gacc[1]; }
    }
}

#ifndef PHMASK
#define PHMASK 0xFFFFu
#endif
#ifndef MIXSEL
#define MIXSEL 7
#endif
#ifndef REPMASK
#define REPMASK 0x0u
#endif
#define EN(j) (((PHMASK) >> (j)) & 1u)
#ifndef REPLAYER
#define REPLAYER 3
#endif
#define NREP(j) (1 + (int)((((REPMASK) >> (j)) & 1u) & (((REPLAYER) >> layer) & 1u)))
#define IN(k) (lo <= (k) && (k) < hi)
#define SEAM(k) do { if (IN((k) + 1)) xcd_barrier(bar); } while (0)

template <int layer> __device__ __forceinline__ void ph_proj(LAS unsigned char* lds, unsigned char* ws, int bid, int nb) {
    pg8::Gemm g{(const bf16_t*)(ws + (layer ? WS_H2Q : WS_XQ)), (const bf16_t*)(ws + (layer ? WS_WC : WS_WAB)), DM / 2};
    pg8::StaticOrder S; S.init(NTOK, layer ? CWID : ABW, nb, bid);
    pg8::EpiStoreBf16<true> E{(bf16_t*)(ws + WS_PROJ), layer ? CWID : ABW};
    pg8::gemm_phase<pg8::EpiStoreBf16<true>, pg8::StaticOrder, false, true>(lds, g, nullptr, S, E);
}
template <int layer> __device__ __forceinline__ void ph_outproj(LAS unsigned char* lds, unsigned char* ws, int bid, int nb) {
    pg8::Gemm g{(const bf16_t*)(ws + WS_YMIX), (const bf16_t*)(ws + (layer ? WS_WOC : WS_WOAB)), DM / 2};
    pg8::StaticOrder S; S.init(NTOK, DM, nb, bid);
    pg8::EpiResid E{(bf16_t*)(ws + WS_Z), (const bf16_t*)(ws + (layer ? WS_H2 : WS_HB))};
    pg8::gemm_phase<pg8::EpiResid, pg8::StaticOrder, false, true>(lds, g, nullptr, S, E);
}
template <int layer> __device__ __forceinline__ void ph_router(LAS unsigned char* lds, unsigned char* ws, int bid, int nb) {
    pg8::Gemm g{(const bf16_t*)(ws + WS_H1), (const bf16_t*)(ws + WS_WR) + (size_t)layer * 256 * 1024, DM};
    pg8::StaticOrder S; S.init(NTOK, 256, nb, bid);
    pg8::EpiF32 E{(float*)(ws + WS_LOGITS)};
    pg8::gemm_phase<pg8::EpiF32, pg8::StaticOrder, false>(lds, g, nullptr, S, E);
}
template <int layer> __device__ __forceinline__ void ph_gemm1(LAS unsigned char* lds, unsigned char* ws, int bid, int nb) {
    const int vcu = (nb % 8 == 0) ? (bid % 8) * (nb / 8) + bid / 8 : bid;
    const int nt = __builtin_amdgcn_readfirstlane(*(volatile int*)(ws + WS_MISC + 65536 + 8192));
    pg8::Gemm g{(const bf16_t*)(ws + WS_H1Q), (const bf16_t*)(ws + WS_W1T + (size_t)layer * NE1 * 512 * 1024), DM / 2};
    const int nu = pg8::moe_prep(lds, (const int*)(ws + WS_MISC + 65536), nt * 2, 1, nb, vcu, (const int*)(ws + WS_STOK));
    pg8::MoeOrder S{(const LAS int*)(lds + pg8::LDS_UT), nu < pg8::MOE_MAXU ? nu : pg8::MOE_MAXU};
    pg8::EpiSwiGLU<true> E{ws + WS_ACT, lds + 3 * pg8::HTB};
    pg8::gemm_phase<pg8::EpiSwiGLU<true>, pg8::MoeOrder, true, true>(lds, g, (const LAS int*)(lds + pg8::LDS_IDX), S, E);
}
template <int layer> __device__ __forceinline__ void ph_gemm2(LAS unsigned char* lds, unsigned char* ws, int bid, int nb) {
    const int vcu = (nb % 8 == 0) ? (bid % 8) * (nb / 8) + bid / 8 : bid;
    const int nt = __builtin_amdgcn_readfirstlane(*(volatile int*)(ws + WS_MISC + 65536 + 8192));
    int kq = 128; asm volatile("" : "+s"(kq));
    pg8::Gemm g{(const bf16_t*)(ws + WS_ACT), (const bf16_t*)(ws + WS_W2T + (size_t)layer * NE1 * 1024 * 256), kq};
    const int nu = pg8::moe_prep(lds, (const int*)(ws + WS_MISC + 65536), nt * 4, 2, nb, vcu, nullptr);
    pg8::MoeOrder S{(const LAS int*)(lds + pg8::LDS_UT), nu};
    pg8::EpiDown E{(unsigned char*)(ws + WS_Y), lds + 3 * pg8::HTB};
    pg8::gemm_phase<pg8::EpiDown, pg8::MoeOrder, false, true>(lds, g, nullptr, S, E);
#ifndef EXPG
#define EXPG 0
#endif
#if EXPG
    { __syncthreads(); pg8::EpiDownT<EXPG - 1> E2{(unsigned char*)(ws + WS_PROJ), lds + 3 * pg8::HTB};
      pg8::gemm_phase<pg8::EpiDownT<EXPG - 1>, pg8::MoeOrder, false, true>(lds, g, nullptr, S, E2); }
#endif
}
template <int layer, bool FULLP> __device__ __forceinline__ void ph_mixer(LAS unsigned char* lds, const Args& A, int bid, int nb) {
    unsigned char* ws = A.ws;
    if (nb != NWG) return;
    MixP mp{(const bf16_t*)(ws + WS_PROJ), layer ? CWID : ABW, 0, ws + WS_YMIX, (const float*)(ws + WS_GATES), (const float*)(ws + WS_MISC), A.in[I_BGK], A.in[I_HG], A.in[I_GG], A.in[I_CONV], A.in[I_BIF], (float*)(ws + WS_UST), (float*)(ws + WS_GSUM)};
    if (layer == 0) { if (bid < 128) { if (MIXSEL & 1) mixer_run<0, FULLP>(lds, mp, bid); } else { if (MIXSEL & 2) mixer_run<1, FULLP>(lds, mp, bid); } }
    else { if (MIXSEL & 4) mixer_run<2, FULLP>(lds, mp, bid); }
#ifndef EXPV
#define EXPV 0
#endif
#ifndef EXPL
#define EXPL 0
#endif
#if EXPV
    if (FULLP && layer == EXPL) { MixP md = mp; md.ymix = (bf16_t*)(ws + WS_Z); md.ust = (float*)(ws + WS_LOGITS); md.gsum = (float*)(ws + WS_LOGITS + 24 * MiB);
        __syncthreads();
        if (layer == 0) { if (bid < 128) mixer_run<0, true, EXPV>(lds, md, bid); else mixer_run<1, true, EXPV>(lds, md, bid); }
        else mixer_run<2, true, EXPV>(lds, md, bid); }
#endif
}
#define REP2(j, call) do { call; if (NREP(j) == 2) { __syncthreads(); call; } } while (0)

template <int layer>
__device__ __forceinline__ void run_layer(LAS unsigned char* lds, const Args& A, const XcdBarrier& bar, const int lo, const int hi) {
    const int bid = blockIdx.x, nb = gridDim.x;
    unsigned char* ws = A.ws;
    unsigned* ctl = (unsigned*)(ws + WS_CTL);
    constexpr int P = 1 + layer * 11;
    if (EN(0) && IN(P + 0)) {
        if (bid & 1) convert_experts(lds, A, layer, bid, nb, layer ? 8 : 0, layer ? 13 : 6);
        REP2(0, ph_proj<layer>(lds, ws, bid, nb));
        if (!(bid & 1)) convert_experts(lds, A, layer, bid, nb, layer ? 8 : 0, layer ? 13 : 6);
        SEAM(P + 0); }
    if (EN(1) && IN(P + 1)) { REP2(1, (ph_mixer<layer, false>(lds, A, bid, nb))); SEAM(P + 1); }
    if (EN(2) && IN(P + 2)) { REP2(2, (ph_mixer<layer, true>(lds, A, bid, nb)));
        if (layer == 0 && bid >= 128) { __syncthreads(); convert_experts(lds, A, 0, bid, nb, 13, 16); convert_experts(lds, A, 0, bid - 128, nb, 13, 16); }
        SEAM(P + 2); }
    if (EN(3) && IN(P + 3)) {
        if (layer == 0 && (bid & 1)) convert_experts(lds, A, 0, bid, nb, 6, 10);
        REP2(3, ph_outproj<layer>(lds, ws, bid, nb));
        if (layer == 0 && !(bid & 1)) convert_experts(lds, A, 0, bid, nb, 6, 10);
        SEAM(P + 3); }
    if (EN(4) && IN(P + 4)) { REP2(4, phase_ln((const bf16_t*)(ws + WS_Z), (bf16_t*)(ws + WS_H1), ws + WS_H1Q, A.in[I_LMG] + layer * DM, A.in[I_LMB] + layer * DM, bid, nb)); SEAM(P + 4); }
    if (EN(5) && IN(P + 5)) {
        if (bid & 1) { convert_experts(lds, A, layer, bid, nb, layer ? 13 : 10, layer ? 16 : 13); convert_experts(lds, A, layer, bid - 1, nb, layer ? 13 : 10, layer ? 16 : 13); }
        else ph_router<layer>(lds, ws, bid >> 1, nb >> 1);
        SEAM(P + 5); }
    if (EN(6) && IN(P + 6)) {
        phase_select<false>(lds, (const float*)(ws + WS_LOGITS), A.in[I_RB] + layer * NEXP, (int*)(ws + WS_TOKE), (int*)(ws + WS_TOKP), (float*)(ws + WS_TOKW), ctl + CW_CNT + layer * 256, bid, nb);
        if (NREP(6) == 2) phase_select<true>(lds, (const float*)(ws + WS_LOGITS), A.in[I_RB] + layer * NEXP, (int*)(ws + WS_TOKE), (int*)(ws + WS_TOKP), (float*)(ws + WS_TOKW), ctl + CW_CNT + layer * 256, bid, nb);
        SEAM(P + 6); }
    if (EN(7) && IN(P + 7)) { REP2(7, phase_dispatch(lds, ctl + CW_CNT + layer * 256, (const int*)(ws + WS_TOKE), (const int*)(ws + WS_TOKP), (int*)(ws + WS_STOK), (int*)(ws + WS_POSY), (int*)(ws + WS_MISC + 65536), (int*)(ws + WS_MISC + 65536 + 8192), bid, nb)); SEAM(P + 7); }
    if (EN(8) && IN(P + 8)) {
        if (layer == 0 && (bid & 1)) convert_experts(lds, A, 1, bid, nb, 0, 8);
        REP2(8, ph_gemm1<layer>(lds, ws, bid, nb));
        if (layer == 0 && !(bid & 1)) convert_experts(lds, A, 1, bid, nb, 0, 8);
        SEAM(P + 8); }
    if (EN(9) && IN(P + 9)) { REP2(9, ph_gemm2<layer>(lds, ws, bid, nb)); SEAM(P + 9); }
    if (EN(10) && IN(P + 10)) {
        if (layer == 0) REP2(10, (phase_combine<false>((const unsigned char*)(ws + WS_Y), (const int*)(ws + WS_POSY), (const float*)(ws + WS_TOKW), (const int*)(ws + WS_MISC + 65536 + 8192), (const bf16_t*)(ws + WS_H1), (bf16_t*)(ws + WS_H2), ws + WS_H2Q, nullptr, (float*)(ws + WS_GATES), (const float*)(ws + WS_MISC + 4096), A.in[I_LFG], A.in[I_LFB], bid, nb)));
        else REP2(10, (phase_combine<true>((const unsigned char*)(ws + WS_Y), (const int*)(ws + WS_POSY), (const float*)(ws + WS_TOKW), (const int*)(ws + WS_MISC + 65536 + 8192), (const bf16_t*)(ws + WS_H1), nullptr, nullptr, A.out, nullptr, nullptr, A.in[I_LFG] + DM, A.in[I_LFB] + DM, bid, nb)));
        SEAM(P + 10);
    }
}

__global__ void __launch_bounds__(512, 2) fwd_kernel(Args A) {
    extern __shared__ __attribute__((aligned(16))) unsigned char lds_raw[];
    LAS unsigned char* lds = (LAS unsigned char*)lds_raw;
    const int tid = threadIdx.x;
    unsigned* ctl = (unsigned*)(A.ws + WS_CTL);
    volatile LAS unsigned* misc = (volatile LAS unsigned*)(lds + LDS_MISC);
    if (tid < 64) misc[tid] = 0u;
    __syncthreads();
    const int lo = A.ph_lo, hi = A.ph_hi;
    XcdBarrier bar; bar.bar = ctl + CW_BAR; bar.x = 0; bar.st = misc;
    if (hi - lo > 1) bar = xcd_barrier_post(ctl + CW_BAR, misc);
    if (EN(11) && IN(0)) { for (int rep_ = 0; rep_ < 1 + (int)(((REPMASK) >> 11) & 1u); ++rep_) phase_prologue(lds, A, blockIdx.x, gridDim.x); SEAM(0); }
    run_layer<0>(lds, A, bar, lo, hi);
    run_layer<1>(lds, A, bar, lo, hi);
}
#undef IN
#undef SEAM

#ifdef DBG
__device__ __forceinline__ unsigned hash32(unsigned x) { x ^= x >> 16; x *= 0x7feb352dU; x ^= x >> 15; x *= 0x846ca68bU; x ^= x >> 16; return x; }
__device__ __forceinline__ void dbg_acc(float* w, int stage, float num, float den) { if (!(num == num) || num > 1e30f) num = 1e30f; atomicAdd(w + 2 * stage, num); atomicAdd(w + 2 * stage + 1, den); }
__device__ __forceinline__ float bfr(float x) { return bflo(pk2(x, 0.f)); }
__global__ void dbg_weights(Args A, float* w) {
    const unsigned i = blockIdx.x * 256 + threadIdx.x; unsigned char* ws = A.ws;
    float num = 0.f, den = 0.f;
    { const unsigned hsh = hash32(i * 4 + 0), col = hsh % 3584, k = (hsh >> 12) % 1024; const float r = A.in[I_WINAB][(size_t)k * 3600 + col], g = bf2f(((const bf16_t*)(ws + WS_WAB))[(size_t)col * 1024 + k]); num += (r - g) * (r - g); den += r * r; }
    { const unsigned hsh = hash32(i * 4 + 1), j = hsh % 256, k = (hsh >> 12) % 1024; float r = 0.f; for (int q = 0; q < 16; ++q) r += A.in[I_WINAB][(size_t)k * 3600 + 3584 + q] * A.in[I_WGKUP][q * 256 + j];
      const float g = bf2f(((const bf16_t*)(ws + WS_WAB))[(size_t)(3584 + j) * 1024 + k]); num += (r - g) * (r - g); den += r * r; }
    { const unsigned hsh = hash32(i * 4 + 2), le = hsh % 514, layer = le / 257, e = le % 257, n = (hsh >> 10) % 512, k = (hsh >> 20) % 1024;
      const float r = (e < 256) ? A.in[I_WEI][((size_t)(layer * 256 + e) * 1024 + k) * 512 + n] : A.in[I_WSI][((size_t)layer * 1024 + k) * 512 + n];
      const unsigned up = n >> 8, c = n & 255, drow = (c >> 7) * 256 + up * 128 + (c & 127);
      const float g = bf2f(((const bf16_t*)(ws + WS_W1T))[((size_t)(layer * 257 + e) * 512 + drow) * 1024 + k]); num += (r - g) * (r - g); den += r * r; }
    { const unsigned hsh = hash32(i * 4 + 3), le = hsh % 514, layer = le / 257, e = le % 257, n = (hsh >> 10) % 1024, k = (hsh >> 20) % 256;
      const float r = (e < 256) ? A.in[I_WED][((size_t)(layer * 256 + e) * 256 + k) * 1024 + n] : A.in[I_WSD][((size_t)layer * 256 + k) * 1024 + n];
      const float g = bf2f(((const bf16_t*)(ws + WS_W2T))[((size_t)(layer * 257 + e) * 1024 + n) * 256 + k]); num += (r - g) * (r - g); den += r * r; }
    dbg_acc(w, 1, num, den);
}
__global__ void dbg_gemm(const bf16_t* Am, int K, const bf16_t* Bt, const void* out, int ldo, int out_f32, int nrows, int ncols, float* w, int stage) {
    const unsigned i = blockIdx.x * 256 + threadIdx.x; const unsigned hsh = hash32(i + 77u * stage), row = hsh % nrows, col = (hsh >> 11) % ncols;
    float r = 0.f; for (int k = 0; k < K; ++k) r += bf2f(Am[(size_t)row * K + k]) * bf2f(Bt[(size_t)col * K + k]);
    const float g = out_f32 ? ((const float*)out)[(size_t)row * ldo + col] : bf2f(((const bf16_t*)out)[(size_t)row * ldo + col]);
    dbg_acc(w, stage, (r - g) * (r - g), r * r);
}
template <int MODE> __global__ void __launch_bounds__(256, 1) dbg_mixer(MixP mp, int b, int h, int T, float* w, int stage) {
    constexpr int DK = (MODE == 1) ? 64 : 128, DV = (MODE == 2) ? 256 : 128;
    __shared__ float sq[128], sk[128], sa[128], red[256], sh_i, sh_f;
    const int tid = threadIdx.x;
    const int ldp = mp.ldp; const bf16_t* proj = mp.proj;
    int cq, ck, cv, cg, cy, cu = 3584 + h * 64;
    if (MODE == 0) { cq = h * 128; ck = 512 + h * 128; cv = 1024 + h * 128; cg = 1536 + h * 128; cy = h * 128; }
    else if (MODE == 1) { cq = 2048 + h * 64; ck = 2304 + h * 64; cv = 2560 + h * 128; cg = 3072 + h * 128; cy = 512 + h * 128; }
    else { cq = h * 128; ck = 512 + h * 128; cv = 1024 + h * 256; cg = 2048 + h * 256; cy = h * 256; }
    float S[DK];
#pragma unroll
    for (int d = 0; d < DK; ++d) S[d] = 0.f;
    float nst = 0.f, num = 0.f, den = 0.f;
    for (int t = 0; t < T; ++t) {
        const size_t tok = (size_t)b * SEQ + t; const bf16_t* pr = proj + tok * ldp;
        if (tid < DK) {
            const int d = tid;
            if (MODE == 0) { const float z = bf2f(pr[ck + d]), sg = 1.f / (1.f + expf(-z)), lb = mp.lb0[h * 128 + d]; sa[d] = lb + (1.f - lb) * sg; sk[d] = (1.f - lb) * (1.f - sg); const float qq = bf2f(pr[cq + d]); sq[d] = qq / (1.f + expf(-qq)); }
            else if (MODE == 1) { const float u = bf2f(pr[cu + d]) + mp.bgk[h * 64 + d]; const float ls = fminf(u, 0.f) - log1pf(expf(-fabsf(u))); sa[d] = expf(ls / 16.f); sk[d] = bf2f(pr[ck + d]); sq[d] = bf2f(pr[cq + d]) * 0.125f; }
            else { float aq = 0.f, ak = 0.f; for (int j = 0; j < 4; ++j) { const int tt = t - 3 + j; if (tt >= 0) { const bf16_t* p2 = proj + ((size_t)b * SEQ + tt) * ldp; aq += mp.conv[j * 1024 + cq + d] * bf2f(p2[cq + d]); ak += mp.conv[j * 1024 + ck + d] * bf2f(p2[ck + d]); } }
                sq[d] = aq / (1.f + expf(-aq)); sk[d] = ak / (1.f + expf(-ak)) * 0.08838834764831845f; }
        }
        if (MODE == 2 && tid == 0) { const float* gp = mp.gates + tok * 8; sh_i = expf(gp[h] + mp.bif[h]); const float x = gp[4 + h] + mp.bif[4 + h]; sh_f = 1.f / (1.f + expf(-x)); }
        __syncthreads();
        const float vt = bf2f(pr[cv + tid]);
        float o = 0.f;
        if (MODE == 2) { const float f = sh_f, ii = sh_i;
#pragma unroll
            for (int d = 0; d < DK; ++d) { S[d] = f * S[d] + ii * sk[d] * vt; o += S[d] * sq[d]; }
            if (tid < 128) nst = f * nst + ii * sk[tid];
            red[tid] = (tid < 128) ? nst * sq[tid] : 0.f;
        } else {
#pragma unroll
            for (int d = 0; d < DK; ++d) { S[d] = sa[d] * S[d] + sk[d] * vt; o += S[d] * sq[d]; }
            red[tid] = o * o;
        }
        __syncthreads();
        for (int st = DV / 2; st > 0; st >>= 1) { if (tid < st) red[tid] += red[tid + st]; __syncthreads(); }
        const float tot = red[0];
        const float gt = bf2f(pr[cg + tid]);
        float y;
        if (MODE == 2) y = o / fmaxf(fabsf(tot), 1.f) * (1.f / (1.f + expf(-gt)));
        else y = o * rsqrtf(tot / 128.f + 1e-6f) * ((MODE == 0) ? mp.hg : mp.gg)[h * 128 + tid] * (gt / (1.f + expf(-gt)));
        const float g = bf2f(mp.ymix[tok * DM + cy + tid]);
        num += (y - g) * (y - g); den += y * y;
        __syncthreads();
    }
    dbg_acc(w, stage, num, den);
}
__global__ void dbg_h1(const bf16_t* HIN, const bf16_t* YM, const bf16_t* Wt, const bf16_t* H1, const float* g, const float* bb, float* w, int stage) {
    __shared__ float red[256]; __shared__ float zrow[1024];
    const int tid = threadIdx.x; const unsigned row = hash32(blockIdx.x + 1000u * stage) % NTOK;
    float z[4];
    for (int q = 0; q < 4; ++q) { const int c = tid + 256 * q; float a = 0.f; for (int k = 0; k < 1024; ++k) a += bf2f(YM[(size_t)row * 1024 + k]) * bf2f(Wt[(size_t)c * 1024 + k]); z[q] = bfr(ALPHA * bf2f(HIN[(size_t)row * 1024 + c]) + a); }
    red[tid] = z[0] + z[1] + z[2] + z[3]; __syncthreads();
    for (int st = 128; st > 0; st >>= 1) { if (tid < st) red[tid] += red[tid + st]; __syncthreads(); }
    const float mu = red[0] / 1024.f; __syncthreads();
    red[tid] = (z[0] - mu) * (z[0] - mu) + (z[1] - mu) * (z[1] - mu) + (z[2] - mu) * (z[2] - mu) + (z[3] - mu) * (z[3] - mu); __syncthreads();
    for (int st = 128; st > 0; st >>= 1) { if (tid < st) red[tid] += red[tid + st]; __syncthreads(); }
    const float rs = rsqrtf(red[0] / 1024.f + 1e-5f);
    float num = 0.f, den = 0.f;
    for (int q = 0; q < 4; ++q) { const int c = tid + 256 * q; const float y = (z[q] - mu) * rs * g[c] + bb[c], gg = bf2f(H1[(size_t)row * 1024 + c]); num += (y - gg) * (y - gg); den += y * y; }
    dbg_acc(w, stage, num, den); (void)zrow;
}
__global__ void dbg_select(const float* logits, const float* rb, const int* tok_e, const float* tok_w, float* w, int stage) {
    __shared__ float sc[256], bs[256]; __shared__ int ce[8]; __shared__ float cs[8];
    if (threadIdx.x != 0) return;
    const unsigned tok = hash32(blockIdx.x + 31u * stage) % NTOK;
    const float* lp = logits + (size_t)tok * 256;
    for (int e = 0; e < 256; ++e) { sc[e] = 1.f / (1.f + expf(-lp[e])); bs[e] = sc[e] + rb[e]; }
    float gs[8];
#pragma unroll
    for (int g = 0; g < 8; ++g) { float m1 = -1e30f, m2 = -1e30f; for (int j = 0; j < 32; ++j) { const float v = bs[g * 32 + j]; if (v > m1) { m2 = m1; m1 = v; } else if (v > m2) m2 = v; } gs[g] = m1 + m2; }
    unsigned selmask = 0;
#pragma unroll
    for (int g = 0; g < 8; ++g) { int rank = 0;
#pragma unroll
        for (int q = 0; q < 8; ++q) rank += (gs[q] > gs[g] || (gs[q] == gs[g] && q < g)) ? 1 : 0; if (rank < 4) selmask |= 1u << g; }
    float tot = 0.f;
    for (int k = 0; k < 8; ++k) { float bv = -1e30f; int be = 0; for (int e = 0; e < 256; ++e) { if (!((selmask >> (e >> 5)) & 1u)) continue; bool used = false; for (int q = 0; q < k; ++q) used |= (ce[q] == e); if (used) continue; if (bs[e] > bv) { bv = bs[e]; be = e; } } ce[k] = be; cs[k] = sc[be]; tot += sc[be]; }
    float num = 0.f, den = 0.f;
    for (int k = 0; k < 8; ++k) { const float wr_ = cs[k] / tot * 2.5f; const int ge = tok_e[(size_t)tok * 8 + k]; const float gw = tok_w[(size_t)tok * 8 + k];
        num += (ge == ce[k] ? 0.f : 1.f) + (wr_ - gw) * (wr_ - gw); den += wr_ * wr_; }
    dbg_acc(w, stage, num, den);
}
template <bool FINAL> __global__ void dbg_moe(Args A, int layer, const int* tok_e, const float* tok_w, const bf16_t* H1, const bf16_t* H2, const float* OUT, float* w, int stage) {
    __shared__ float hrow[1024], hid[256], red[256];
    const int tid = threadIdx.x; const unsigned tok = hash32(blockIdx.x + 555u * stage) % NTOK;
    for (int i = tid; i < 1024; i += 256) hrow[i] = bf2f(H1[(size_t)tok * 1024 + i]);
    float acc[4] = {0.f, 0.f, 0.f, 0.f};
    __syncthreads();
    for (int k = 0; k < 9; ++k) {
        const int e = (k < 8) ? tok_e[(size_t)tok * 8 + k] : 256; const float wk = (k < 8) ? tok_w[(size_t)tok * 8 + k] : 1.f;
        const float* W1 = (e < 256) ? A.in[I_WEI] + (size_t)(layer * 256 + e) * 1024 * 512 : A.in[I_WSI] + (size_t)layer * 1024 * 512;
        const float* W2 = (e < 256) ? A.in[I_WED] + (size_t)(layer * 256 + e) * 256 * 1024 : A.in[I_WSD] + (size_t)layer * 256 * 1024;
        float gsum = 0.f, usum = 0.f;
        for (int kk = 0; kk < 1024; ++kk) { gsum += hrow[kk] * W1[(size_t)kk * 512 + tid]; usum += hrow[kk] * W1[(size_t)kk * 512 + 256 + tid]; }
        hid[tid] = gsum / (1.f + expf(-gsum)) * usum;
        __syncthreads();
        for (int q = 0; q < 4; ++q) { const int c = tid + 256 * q; float a = 0.f; for (int j = 0; j < 256; ++j) a += hid[j] * W2[(size_t)j * 1024 + c]; acc[q] += wk * a; }
        __syncthreads();
    }
    float z[4]; for (int q = 0; q < 4; ++q) z[q] = ALPHA * hrow[tid + 256 * q] + acc[q];
    red[tid] = z[0] + z[1] + z[2] + z[3]; __syncthreads();
    for (int st = 128; st > 0; st >>= 1) { if (tid < st) red[tid] += red[tid + st]; __syncthreads(); }
    const float mu = red[0] / 1024.f; __syncthreads();
    red[tid] = (z[0] - mu) * (z[0] - mu) + (z[1] - mu) * (z[1] - mu) + (z[2] - mu) * (z[2] - mu) + (z[3] - mu) * (z[3] - mu); __syncthreads();
    for (int st = 128; st > 0; st >>= 1) { if (tid < st) red[tid] += red[tid + st]; __syncthreads(); }
    const float rs = rsqrtf(red[0] / 1024.f + 1e-5f);
    const float* g = A.in[I_LFG] + layer * DM; const float* bb = A.in[I_LFB] + layer * DM;
    float num = 0.f, den = 0.f;
    for (int q = 0; q < 4; ++q) { const int c = tid + 256 * q; const float y = (z[q] - mu) * rs * g[c] + bb[c]; const float gg = FINAL ? OUT[(size_t)tok * 1024 + c] : bf2f(H2[(size_t)tok * 1024 + c]); num += (y - gg) * (y - gg); den += y * y; }
    dbg_acc(w, stage, num, den);
}
#ifndef DBG_REPORT
#define DBG_REPORT 0
#endif
__global__ void dbg_fill(float* out, const float* w) {
    __shared__ float cval;
    if (threadIdx.x == 0) {
        float c = 0.f;
        if (DBG_REPORT == 0) { for (int st = 1; st <= 13; ++st) { const float rel = sqrtf(w[2 * st] / fmaxf(w[2 * st + 1], 1e-30f)); if (!(rel < 0.08f) || !(w[2 * st + 1] > 0.f)) { c = (float)st; break; } } }
        else { const float rel = sqrtf(w[2 * DBG_REPORT] / fmaxf(w[2 * DBG_REPORT + 1], 1e-30f)); float l = -log10f(fmaxf(rel, 1e-8f)); l = fminf(fmaxf(l, -2.f), 8.f); c = 3.f + l; }
        cval = c;
    }
    __syncthreads();
    const float c = cval;
    if (c != 0.f) for (size_t i = (size_t)blockIdx.x * 256 + threadIdx.x; i < (size_t)NTOK * DM; i += (size_t)gridDim.x * 256) out[i] = c;
}
#endif

extern "C" void kernel_launch(void* const* d_in, const int* in_sizes, int n_in, void* d_out, int out_size, void* d_ws, size_t ws_size, hipStream_t stream) {
    static int grid = 0;
    if (grid == 0) {
        if (n_in != 22 || out_size != NTOK * DM || ws_size < WS_END) { fprintf(stderr, "kernel_launch: unexpected shapes (n_in %d out %d ws %zu)\n", n_in, out_size, ws_size); grid = -1; return; }
        if (hipFuncSetAttribute((const void*)fwd_kernel, hipFuncAttributeMaxDynamicSharedMemorySize, LDS_BYTES) != hipSuccess) { fprintf(stderr, "kernel_launch: hipFuncSetAttribute failed\n"); grid = -1; return; }
        int per_cu = 0;
        if (hipOccupancyMaxActiveBlocksPerMultiprocessor(&per_cu, (const void*)fwd_kernel, 512, LDS_BYTES) != hipSuccess || per_cu < 1) fprintf(stderr, "kernel_launch: occupancy query says %d\n", per_cu);
        (void)hipGetLastError();
        grid = NWG;
    }
    if (grid < 0) return;
    (void)hipMemsetAsync((char*)d_ws + WS_CTL, 0, CTL_BYTES, stream);
    Args a{};
    for (int i = 0; i < 22; ++i) a.in[i] = (const float*)d_in[i];
    a.out = (float*)d_out; a.ws = (unsigned char*)d_ws;
#if MK_ONE_LAUNCH
    a.ph_lo = 0; a.ph_hi = 23;
    hipLaunchKernelGGL(fwd_kernel, dim3(grid), dim3(512), LDS_BYTES, stream, a);
#else
    for (int p = 0; p < 23; ++p) { a.ph_lo = p; a.ph_hi = p + 1; hipLaunchKernelGGL(fwd_kernel, dim3(grid), dim3(512), LDS_BYTES, stream, a);
#ifdef DBG
        unsigned char* ws = (unsigned char*)d_ws; float* dw = (float*)(ws + WS_CTL) + CW_DBG;
        const int layer = (p - 1) / 11, q = (p - 1) % 11;
        MixP mp{(const bf16_t*)(ws + WS_PROJ), layer ? CWID : ABW, 0, ws + WS_YMIX, (const float*)(ws + WS_GATES), (const float*)(ws + WS_MISC), a.in[I_BGK], a.in[I_HG], a.in[I_GG], a.in[I_CONV], a.in[I_BIF], (float*)(ws + WS_UST), (float*)(ws + WS_GSUM)};
        if (p == 0) hipLaunchKernelGGL(dbg_weights, dim3(256), dim3(256), 0, stream, a, dw);
        if (p >= 1 && q == 0) hipLaunchKernelGGL(dbg_gemm, dim3(64), dim3(256), 0, stream, (const bf16_t*)(ws + (layer ? WS_H2 : WS_HB)), 1024, (const bf16_t*)(ws + (layer ? WS_WC : WS_WAB)), (const void*)(ws + WS_PROJ), layer ? CWID : ABW, 0, NTOK, layer ? CWID : ABW, dw, layer ? 9 : 2);
        if (p >= 1 && q == 2 && layer == 0) { hipLaunchKernelGGL(dbg_mixer<0>, dim3(1), dim3(128), 0, stream, mp, 0, 1, 1100, dw, 3); hipLaunchKernelGGL(dbg_mixer<1>, dim3(1), dim3(128), 0, stream, mp, 1, 2, 1100, dw, 4); }
        if (p >= 1 && q == 2 && layer == 1) hipLaunchKernelGGL(dbg_mixer<2>, dim3(1), dim3(256), 0, stream, mp, 1, 1, 1100, dw, 10);
        if (p >= 1 && q == 4) hipLaunchKernelGGL(dbg_h1, dim3(32), dim3(256), 0, stream, (const bf16_t*)(ws + (layer ? WS_H2 : WS_HB)), (const bf16_t*)(ws + WS_YMIX), (const bf16_t*)(ws + (layer ? WS_WOC : WS_WOAB)), (const bf16_t*)(ws + WS_H1), a.in[I_LMG] + layer * DM, a.in[I_LMB] + layer * DM, dw, layer ? 11 : 5);
        if (p >= 1 && q == 5 && layer == 0) hipLaunchKernelGGL(dbg_gemm, dim3(64), dim3(256), 0, stream, (const bf16_t*)(ws + WS_H1), 1024, (const bf16_t*)(ws + WS_WR), (const void*)(ws + WS_LOGITS), 256, 1, NTOK, 256, dw, 6);
        if (p >= 1 && q == 6) hipLaunchKernelGGL(dbg_select, dim3(64), dim3(64), 0, stream, (const float*)(ws + WS_LOGITS), a.in[I_RB] + layer * NEXP, (const int*)(ws + WS_TOKE), (const float*)(ws + WS_TOKW), dw, layer ? 12 : 7);
        if (p >= 1 && q == 10 && layer == 0) hipLaunchKernelGGL(dbg_moe<false>, dim3(32), dim3(256), 0, stream, a, 0, (const int*)(ws + WS_TOKE), (const float*)(ws + WS_TOKW), (const bf16_t*)(ws + WS_H1), (const bf16_t*)(ws + WS_H2), (const float*)d_out, dw, 8);
        if (p >= 1 && q == 10 && layer == 1) { hipLaunchKernelGGL(dbg_moe<true>, dim3(32), dim3(256), 0, stream, a, 1, (const int*)(ws + WS_TOKE), (const float*)(ws + WS_TOKW), (const bf16_t*)(ws + WS_H1), (const bf16_t*)(ws + WS_H2), (const float*)d_out, dw, 13);
            hipLaunchKernelGGL(dbg_fill, dim3(1024), dim3(256), 0, stream, (float*)d_out, dw); }
#endif
    }
#endif
}
```

```cpp
#include <hip/hip_runtime.h>
#include <cstdio>
#include <cstdint>

#ifndef MK_ONE_LAUNCH
#define MK_ONE_LAUNCH 1
#endif

#define LAS __attribute__((address_space(3)))
typedef unsigned short bf16_t;
typedef short bf16x8 __attribute__((ext_vector_type(8)));
typedef float f32x4 __attribute__((ext_vector_type(4)));
typedef unsigned u32x4 __attribute__((ext_vector_type(4)));
typedef unsigned u32x2 __attribute__((ext_vector_type(2)));

constexpr int NTOK = 32768, SEQ = 16384, DM = 1024;
constexpr int ABW = 3840;
constexpr int CWID = 3072;
constexpr int NEXP = 256, NE1 = 257, TOPK = 8, NSLOT = 9;
constexpr float ALPHA = 1.41421356237f;
constexpr int NWG = 256;
constexpr int PRMAX = 262144 + 65536 + 32768;

constexpr size_t MiB = 1u << 20;
constexpr size_t WS_CTL = 0, CTL_BYTES = 1 * MiB;
constexpr size_t WS_MISC = 1 * MiB;
constexpr size_t WS_WAB = 2 * MiB, WS_WOAB = 10 * MiB, WS_WC = 12 * MiB, WS_WOC = 18 * MiB, WS_WR = 20 * MiB;
constexpr size_t WS_TOKE = 22 * MiB, WS_TOKP = 23 * MiB, WS_TOKW = 24 * MiB;
constexpr size_t WS_STOK = 26 * MiB, WS_POSY = 28 * MiB;
constexpr size_t WS_GATES = 32 * MiB;
constexpr size_t WS_UST = 34 * MiB, WS_GSUM = 54 * MiB;
constexpr size_t WS_LOGITS = 56 * MiB;
constexpr size_t WS_HB = 96 * MiB, WS_PROJ = 160 * MiB, WS_YMIX = 400 * MiB, WS_Z = 464 * MiB, WS_H1 = 528 * MiB, WS_H2 = 592 * MiB;
constexpr size_t WS_ACT = 656 * MiB, WS_Y = 832 * MiB, WS_W1T = 1540 * MiB, WS_W2T = 2056 * MiB;
constexpr size_t WS_XQ = 2320 * MiB, WS_H1Q = 2352 * MiB, WS_H2Q = 2384 * MiB, WS_END = 2416 * MiB;
constexpr float Q_SA = 127.f / 5.5f, Q_SW = 127.f * 32.f / 5.5f, Q_DEQ = 1.f / (Q_SA * Q_SW);
constexpr float Q_SY = 127.f / 8.f, Q_SWO = 127.f * 64.f / 5.5f, Q_DEQO = 1.f / (Q_SY * Q_SWO);
constexpr float Q_SACT = 127.f / 8.f, Q_DEQ2 = 16.f / (Q_SACT * Q_SW);
constexpr int CW_BAR = 4096;
constexpr int CW_CNT = 16384;

__device__ __forceinline__ unsigned pk2(float lo, float hi) { unsigned r; asm volatile("v_cvt_pk_bf16_f32 %0, %1, %2" : "=v"(r) : "v"(lo), "v"(hi)); return r; }
__device__ __forceinline__ float bflo(unsigned u) { return __uint_as_float(u << 16); }
__device__ __forceinline__ float bfhi(unsigned u) { return __uint_as_float(u & 0xffff0000u); }
__device__ __forceinline__ float bf2f(bf16_t b) { return __uint_as_float(((unsigned)b) << 16); }
__device__ __forceinline__ float sigm(float x) { return __builtin_amdgcn_rcpf(1.f + __expf(-x)); }
__device__ __forceinline__ float silu(float x) { return x * __builtin_amdgcn_rcpf(1.f + __expf(-x)); }
__device__ __forceinline__ int q8(float x, float sc) { return (int)rintf(fminf(fmaxf(x * sc, -127.f), 127.f)); }
__device__ __forceinline__ unsigned pk4(int a, int b, int c, int d) { return (unsigned)(a & 255) | ((unsigned)(b & 255) << 8) | ((unsigned)(c & 255) << 16) | ((unsigned)d << 24); }
__device__ __forceinline__ float logsig(float x) { return fminf(x, 0.f) - __logf(1.f + __expf(-fabsf(x))); }

#define XB_TMO      128
#define XB_XCNT(j)  (256  + 64 * (j))
#define XB_XSUB(j)  (1280 + 64 * (j))
#define XB_XGEN(j)  (2304 + 64 * (j))
#define XB_TOP      3328
#define XB_TOPGEN   3392
#define XCD_BAR_WORDS 3456
#define XB_SPIN_CAP (1u << 22)
__device__ __forceinline__ unsigned xb_ld(unsigned* p)              { return __hip_atomic_load(p, __ATOMIC_RELAXED, __HIP_MEMORY_SCOPE_AGENT); }
__device__ __forceinline__ unsigned xb_add(unsigned* p, unsigned v) { return __hip_atomic_fetch_add(p, v, __ATOMIC_RELAXED, __HIP_MEMORY_SCOPE_AGENT); }
__device__ __forceinline__ unsigned xb_xcc_id() { return (unsigned)__builtin_amdgcn_s_getreg((3 << 11) | 20) & 0xFu; }
#define XB_SPIN(cond, bar) do { unsigned _sp = 0; while (cond) { __builtin_amdgcn_s_sleep(1); \
    if ((++_sp & 255u) == 0u) { if (xb_ld(&(bar)[XB_TMO])) break; if (_sp > XB_SPIN_CAP) { atomicAdd(&(bar)[XB_TMO], 1u); break; } } } } while (0)
struct XcdBarrier { unsigned* bar; unsigned x; volatile LAS unsigned* st; };
__device__ __forceinline__ XcdBarrier xcd_barrier_post(unsigned* bar, volatile LAS unsigned* st) {
    XcdBarrier b; b.bar = bar; b.x = xb_xcc_id(); b.st = st;
    if (threadIdx.x == 0) (void)xb_add(&bar[XB_XCNT(b.x)], 1u);
    return b;
}
__device__ __forceinline__ void xcd_barrier_complete(unsigned* bar, unsigned x, unsigned& nloc, unsigned& nx) {
    const unsigned G = gridDim.x * gridDim.y * gridDim.z;
    unsigned sum, cnt, mine, sp = 0u;
    for (;;) {
        sum = 0u; cnt = 0u; mine = 0u;
#pragma unroll
        for (unsigned j = 0; j < 16; ++j) { const unsigned c = xb_ld(&bar[XB_XCNT(j)]); sum += c; cnt += (c > 0u) ? 1u : 0u; mine = (j == x) ? c : mine; }
        if (sum == G) break;
        __builtin_amdgcn_s_sleep(1);
        if ((++sp & 255u) == 0u) { if (xb_ld(&bar[XB_TMO])) break; if (sp > XB_SPIN_CAP) { atomicAdd(&bar[XB_TMO], 1u); break; } }
    }
    nloc = mine > 0u ? mine : 1u; nx = cnt > 0u ? cnt : 1u;
}
__device__ __forceinline__ void xcd_barrier(const XcdBarrier& b) {
    asm volatile("s_waitcnt vmcnt(0)" ::: "memory");
    __syncthreads();
    if (threadIdx.x == 0) {
        unsigned* bar = b.bar;
        __builtin_amdgcn_s_waitcnt(0);
        unsigned nloc = b.st[0], nx = b.st[1];
        if (nloc == 0u) { xcd_barrier_complete(bar, b.x, nloc, nx); b.st[0] = nloc; b.st[1] = nx; }
        const unsigned old = xb_add(&bar[XB_XSUB(b.x)], 1u);
        const unsigned gen = old / nloc;
        if (old + 1u == (gen + 1u) * nloc) {
            __builtin_amdgcn_fence(__ATOMIC_RELEASE, "agent");
            asm volatile("s_waitcnt vmcnt(0)" ::: "memory");
            const unsigned og = xb_add(&bar[XB_TOP], 1u);
            const unsigned tg = og / nx;
            if (og + 1u == (tg + 1u) * nx) xb_add(&bar[XB_TOPGEN], 1u);
            else XB_SPIN(xb_ld(&bar[XB_TOPGEN]) == tg, bar);
            __builtin_amdgcn_fence(__ATOMIC_ACQUIRE, "agent");
            xb_add(&bar[XB_XGEN(b.x)], 1u);
            asm volatile("s_waitcnt vmcnt(0)" ::: "memory");
        } else {
            XB_SPIN(xb_ld(&bar[XB_XGEN(b.x)]) == gen, bar);
            __builtin_amdgcn_fence(__ATOMIC_ACQUIRE, "agent");
            asm volatile("s_waitcnt vmcnt(0)" ::: "memory");
        }
    }
    __syncthreads();
}

namespace pg8 {
constexpr int BM = 256, BK = 64, HALF = 128, HTB = HALF * BK * 2, STAGE_BYTES = 8 * HTB, NXCD = 8, WGM = 8;
__device__ __forceinline__ int lds_byte(int r, int c) { const int st = (r >> 4) * 2 + (c >> 5), rr = r & 15, cc = c & 31, ob = rr * 64 + cc * 2; return st * 1024 + (ob ^ (((ob >> 9) & 1) << 5)); }
__device__ __forceinline__ void stage_rc(int b, int& R, int& C) { const int st = b / 1024, sb = b % 1024, swz = sb ^ (((sb >> 9) & 1) << 5); R = (st >> 1) * 16 + swz / 64; C = (st & 1) * 32 + (swz % 64) / 2; }
__device__ __forceinline__ int perm32(int rho) { const int n = rho >> 4, i = rho & 15; return 8 * (i >> 2) + 4 * n + (i & 3); }
struct Unit { int pm, pn; };
struct Gemm { const bf16_t* A; const bf16_t* Bt; int K; };

struct StaticOrder {
    int nM, nN, nwg, G, c;
    __device__ void init(int M, int N, int G_, int c_) { nM = M / BM; nN = N / BM; nwg = nM * nN; G = G_; c = c_; }
    __device__ bool next(int i, Unit& u) const {
        const long L = (long)i * G + c; if (L >= nwg) return false;
        int wgid = (int)L; { const int q = nwg / NXCD, r = nwg % NXCD, xcd = wgid % NXCD, off = wgid / NXCD; wgid = (xcd < r ? xcd * (q + 1) : r * (q + 1) + (xcd - r) * q) + off; }
        const int nig = WGM * nN, gid = wgid / nig, fm = gid * WGM, gsz = (nM - fm) < WGM ? (nM - fm) : WGM;
        u.pm = fm + ((wgid % nig) % gsz); u.pn = (wgid % nig) / gsz; return true;
    }
};
struct MoeOrder {
    const LAS int* tab; int n;
    __device__ bool next(int i, Unit& u) const {
        if (i >= n) return false;
        u.pm = __builtin_amdgcn_readfirstlane(tab[2 * i]); u.pn = __builtin_amdgcn_readfirstlane(tab[2 * i + 1]); return true;
    }
};
constexpr int LDS_UT = 131072, LDS_IDX = 131072 + 512, MOE_MAXU = 15;
__device__ __forceinline__ int moe_prep(LAS unsigned char* lds, const int* __restrict__ tile_exp, int nunits, int sh, int G, int c, const int* __restrict__ rowidx) {
    const int tid = threadIdx.x;
    LAS int* tab = (LAS int*)(lds + LDS_UT);
    int n = 0; { const long rem = (long)nunits - c; n = rem > 0 ? (int)((rem + G - 1) / G) : 0; if (n > 32) n = 32; }
    if (tid < n) { const long L = (long)tid * G + c; const int rt = (int)(L >> sh), j = (int)L & ((1 << sh) - 1); tab[2 * tid] = rt; tab[2 * tid + 1] = (tile_exp[rt] << sh) + j; }
    __syncthreads();
    if (rowidx) { LAS int* idx = (LAS int*)(lds + LDS_IDX); const int nn = n < MOE_MAXU ? n : MOE_MAXU;
        for (int x = tid; x < nn * 256; x += 512) idx[x] = rowidx[tab[2 * (x >> 8)] * 256 + (x & 255)];
        __syncthreads(); }
    return n;
}

typedef int i32x4 __attribute__((ext_vector_type(4)));
template <class Epi, class Sched, bool GATHER, bool I8 = false>
__device__ __forceinline__ void gemm_phase(LAS unsigned char* lds, const Gemm g, const LAS int* rowidx, const Sched& S, const Epi& E) {
    const int tid = threadIdx.x, wid = __builtin_amdgcn_readfirstlane(tid >> 6), lane = tid & 63, wr = wid >> 2, wc = wid & 3, fr = lane & 15, fq = lane >> 4;
    const int K = g.K, nt = K / BK;
    unsigned voffB[2], cofs[2]; int Rr[2];
#pragma unroll
    for (int i = 0; i < 2; ++i) { int R, C; stage_rc(tid * 16 + i * 8192, R, C); const int Rb = Epi::PERM ? ((R & ~31) + perm32(R & 31)) : R;
        Rr[i] = R; cofs[i] = (unsigned)C * 2u; voffB[i] = (unsigned)(Rb * K + C) * 2u; }
    const unsigned rowb = (unsigned)K * 2u;
    const size_t kstep = (size_t)(BK * 2);
    const size_t hstep = (size_t)HALF * K * 2;
    const size_t tstep = 2 * hstep;
    const unsigned ldsw = (unsigned)wid * 1024u;
    const int aoff = lds_byte(wr * 64 + fr, fq * 8), boff = lds_byte(wc * 32 + fr, fq * 8);
    const char* Abase = (const char*)g.A;
#define PG8_SA(b, h) (((b) * 2 + (h)) * HTB)
#define PG8_SB(b, h) ((4 + (b) * 2 + (h)) * HTB)
#define PG8_STAGE(bufoff, gbase, voff) do { _Pragma("unroll") for (int _i = 0; _i < 2; ++_i) \
        __builtin_amdgcn_global_load_lds((const unsigned*)((const char*)(gbase) + (voff)[_i]), (LAS unsigned*)(lds + (bufoff) + ldsw + _i * 8192), 16, 0, 0); } while (0)
#define PG8_STAGEA(bufoff, kb, offs) do { _Pragma("unroll") for (int _i = 0; _i < 2; ++_i) \
        __builtin_amdgcn_global_load_lds((const unsigned*)(Abase + (size_t)((kb) + (offs)[_i])), (LAS unsigned*)(lds + (bufoff) + ldsw + _i * 8192), 16, 0, 0); } while (0)
#define PG8_ROWOFF(u, uo, O) do { _Pragma("unroll") for (int _h = 0; _h < 2; ++_h) _Pragma("unroll") for (int _i = 0; _i < 2; ++_i) { \
        int _row = (u).pm * BM + _h * HALF + Rr[_i]; if (GATHER) _row = rowidx[(uo) * 256 + _h * HALF + Rr[_i]]; (O)[_h][_i] = (unsigned)_row * rowb + cofs[_i]; } } while (0)
#define PG8_LDA(dst, b, h) do { _Pragma("unroll") for (int m = 0; m < 4; ++m) _Pragma("unroll") for (int k = 0; k < 2; ++k) dst[m][k] = *(const LAS bf16x8*)(lds + PG8_SA(b, h) + aoff + m * 2048 + k * 1024); } while (0)
#define PG8_LDB(dst, b, h) do { _Pragma("unroll") for (int n = 0; n < 2; ++n) _Pragma("unroll") for (int k = 0; k < 2; ++k) dst[n][k] = *(const LAS bf16x8*)(lds + PG8_SB(b, h) + boff + n * 2048 + k * 1024); } while (0)
#define PG8_MMA(ai, bj, At, Bt) do { __builtin_amdgcn_s_setprio(1); _Pragma("unroll") for (int m = 0; m < 4; ++m) _Pragma("unroll") for (int n = 0; n < 2; ++n) _Pragma("unroll") for (int k = 0; k < 2; ++k) \
        { if (I8) acc[ai][bj][m][n] = __builtin_bit_cast(f32x4, __builtin_amdgcn_mfma_i32_16x16x64_i8(__builtin_bit_cast(i32x4, Bt[n][k]), __builtin_bit_cast(i32x4, At[m][k]), __builtin_bit_cast(i32x4, acc[ai][bj][m][n]), 0, 0, 0)); \
          else acc[ai][bj][m][n] = __builtin_amdgcn_mfma_f32_16x16x32_bf16(Bt[n][k], At[m][k], acc[ai][bj][m][n], 0, 0, 0); } __builtin_amdgcn_s_setprio(0); } while (0)
#define PG8_WAIT_V(n) asm volatile("s_waitcnt vmcnt(" #n ")" ::: "memory")
#define PG8_WAIT_L(n) asm volatile("s_waitcnt lgkmcnt(" #n ")" ::: "memory")
#define PG8_BAR __builtin_amdgcn_s_barrier()
#define PG8_SCHED __builtin_amdgcn_sched_barrier(0)
    Unit cur, nxt; int ui = 0;
    if (!S.next(0, cur)) return;
    f32x4 acc[2][2][4][2];
#pragma unroll
    for (int a = 0; a < 2; ++a)
#pragma unroll
        for (int b = 0; b < 2; ++b)
#pragma unroll
            for (int m = 0; m < 4; ++m)
#pragma unroll
                for (int n = 0; n < 2; ++n) acc[a][b][m][n] = (f32x4){0.f, 0.f, 0.f, 0.f};
    bf16x8 At[4][2], B0[2][2], B1[2][2];
    unsigned cO[2][2], nO[2][2];
    PG8_ROWOFF(cur, 0, cO);
    const char* cB = (const char*)g.Bt + (size_t)cur.pn * tstep;
    PG8_STAGE(PG8_SB(0, 0), cB, voffB); PG8_STAGE(PG8_SB(0, 1), cB + hstep, voffB); PG8_STAGEA(PG8_SA(0, 0), 0u, cO[0]); PG8_STAGEA(PG8_SA(0, 1), 0u, cO[1]);
    if (wr == 1) PG8_BAR;
    PG8_WAIT_V(2); PG8_BAR;
    PG8_STAGE(PG8_SB(1, 0), cB + kstep, voffB); PG8_STAGEA(PG8_SA(1, 0), (unsigned)kstep, cO[0]); PG8_STAGE(PG8_SB(1, 1), cB + hstep + kstep, voffB);
    PG8_WAIT_V(6); PG8_BAR;
    for (;;) {
        const bool has_next = S.next(ui + 1, nxt);
        const char* nB = has_next ? (const char*)g.Bt + (size_t)nxt.pn * tstep : cB;
#pragma unroll
        for (int h = 0; h < 2; ++h)
#pragma unroll
            for (int i = 0; i < 2; ++i) nO[h][i] = cO[h][i];
#pragma unroll 1
        for (int t = 0; t < nt; t += 2) {
            const bool last = (t == nt - 2);
            if (last && has_next) PG8_ROWOFF(nxt, ui + 1, nO);
            const unsigned k1 = (unsigned)(t + 1) * (unsigned)kstep;
            const unsigned k2 = last ? 0u : (unsigned)(t + 2) * (unsigned)kstep, k3 = k2 + (unsigned)kstep;
            const char* b2 = last ? nB : cB + (size_t)(t + 2) * kstep; const char* b3 = b2 + kstep;
            unsigned o2[2][2];
#pragma unroll
            for (int h = 0; h < 2; ++h)
#pragma unroll
                for (int i = 0; i < 2; ++i) o2[h][i] = last ? nO[h][i] : cO[h][i];
            PG8_LDB(B0, 0, 0); PG8_LDB(B1, 0, 1); PG8_SCHED; PG8_LDA(At, 0, 0); PG8_STAGEA(PG8_SA(1, 1), k1, cO[1]);
            PG8_WAIT_V(8); PG8_WAIT_L(0); PG8_BAR; PG8_MMA(0, 0, At, B0); PG8_MMA(0, 1, At, B1); PG8_BAR; PG8_SCHED;
            PG8_LDA(At, 0, 1); PG8_STAGE(PG8_SB(0, 0), b2, voffB); PG8_STAGE(PG8_SB(0, 1), b2 + hstep, voffB); PG8_STAGEA(PG8_SA(0, 0), k2, o2[0]);
            PG8_WAIT_V(8); PG8_WAIT_L(0); PG8_BAR; PG8_MMA(1, 0, At, B0); PG8_MMA(1, 1, At, B1); PG8_BAR; PG8_SCHED;
            PG8_LDB(B0, 1, 0); PG8_LDB(B1, 1, 1); PG8_SCHED; PG8_LDA(At, 1, 0); PG8_STAGEA(PG8_SA(0, 1), k2, o2[1]);
            PG8_WAIT_V(8); PG8_WAIT_L(0); PG8_BAR; PG8_MMA(0, 0, At, B0); PG8_MMA(0, 1, At, B1); PG8_BAR; PG8_SCHED;
            PG8_LDA(At, 1, 1); PG8_STAGE(PG8_SB(1, 0), b3, voffB); PG8_STAGE(PG8_SB(1, 1), b3 + hstep, voffB); PG8_STAGEA(PG8_SA(1, 0), k3, o2[0]);
            PG8_WAIT_V(8); PG8_WAIT_L(0); PG8_BAR; PG8_MMA(1, 0, At, B0); PG8_MMA(1, 1, At, B1); PG8_BAR; PG8_SCHED;
        }
        if (wr == 0) PG8_BAR;
        E(acc, cur, wr, wc, fr, fq);
        if (!has_next) break;
#pragma unroll
        for (int a = 0; a < 2; ++a)
#pragma unroll
            for (int b = 0; b < 2; ++b)
#pragma unroll
                for (int m = 0; m < 4; ++m)
#pragma unroll
                    for (int n = 0; n < 2; ++n) acc[a][b][m][n] = (f32x4){0.f, 0.f, 0.f, 0.f};
        cur = nxt; cB = nB; ++ui;
#pragma unroll
        for (int h = 0; h < 2; ++h)
#pragma unroll
            for (int i = 0; i < 2; ++i) cO[h][i] = nO[h][i];
        if (wr == 1) PG8_BAR;
    }
    PG8_WAIT_V(0);
    PG8_BAR;
#undef PG8_SA
#undef PG8_SB
#undef PG8_STAGE
#undef PG8_STAGEA
#undef PG8_ROWOFF
#undef PG8_LDA
#undef PG8_LDB
#undef PG8_MMA
#undef PG8_WAIT_V
#undef PG8_WAIT_L
#undef PG8_BAR
#undef PG8_SCHED
}

template <bool I8> struct EpiStoreBf16 {
    static constexpr bool PERM = true;
    bf16_t* O; int ldc;
    static __device__ __forceinline__ f32x4 dq(f32x4 v) { if (I8) { const i32x4 q = __builtin_bit_cast(i32x4, v); return (f32x4){(float)q[0] * Q_DEQ, (float)q[1] * Q_DEQ, (float)q[2] * Q_DEQ, (float)q[3] * Q_DEQ}; } return v; }
    __device__ __forceinline__ void operator()(const f32x4 (&acc)[2][2][4][2], const Unit& u, int wr, int wc, int fr, int fq) const {
        const int row0 = u.pm * BM + wr * 64 + fr, col0 = u.pn * BM + wc * 32 + 8 * fq;
#pragma unroll
        for (int ai = 0; ai < 2; ++ai)
#pragma unroll
            for (int m = 0; m < 4; ++m) { bf16_t* rowp = O + (size_t)(row0 + ai * HALF + m * 16) * ldc + col0;
#pragma unroll
                for (int bj = 0; bj < 2; ++bj) { const f32x4 v0 = dq(acc[ai][bj][m][0]), v1 = dq(acc[ai][bj][m][1]);
                    u32x4 w; w.x = pk2(v0[0], v0[1]); w.y = pk2(v0[2], v0[3]); w.z = pk2(v1[0], v1[1]); w.w = pk2(v1[2], v1[3]);
                    *(u32x4*)(rowp + bj * HALF) = w; } }
    }
};
struct EpiResid {
    static constexpr bool PERM = true;
    bf16_t* Z; const bf16_t* H;
    static __device__ __forceinline__ f32x4 dq(f32x4 v) { const i32x4 q = __builtin_bit_cast(i32x4, v); return (f32x4){(float)q[0] * Q_DEQO, (float)q[1] * Q_DEQO, (float)q[2] * Q_DEQO, (float)q[3] * Q_DEQO}; }
    __device__ __forceinline__ void operator()(const f32x4 (&acc)[2][2][4][2], const Unit& u, int wr, int wc, int fr, int fq) const {
        const int row0 = u.pm * BM + wr * 64 + fr, col0 = u.pn * BM + wc * 32 + 8 * fq;
#pragma unroll
        for (int ai = 0; ai < 2; ++ai)
#pragma unroll
            for (int m = 0; m < 4; ++m) { const size_t ro = (size_t)(row0 + ai * HALF + m * 16) * DM + col0;
#pragma unroll
                for (int bj = 0; bj < 2; ++bj) { const f32x4 v0 = dq(acc[ai][bj][m][0]), v1 = dq(acc[ai][bj][m][1]);
                    const u32x4 hh = *(const u32x4*)(H + ro + bj * HALF);
                    u32x4 w;
                    w.x = pk2(ALPHA * bflo(hh.x) + v0[0], ALPHA * bfhi(hh.x) + v0[1]); w.y = pk2(ALPHA * bflo(hh.y) + v0[2], ALPHA * bfhi(hh.y) + v0[3]);
                    w.z = pk2(ALPHA * bflo(hh.z) + v1[0], ALPHA * bfhi(hh.z) + v1[1]); w.w = pk2(ALPHA * bflo(hh.w) + v1[2], ALPHA * bfhi(hh.w) + v1[3]);
                    *(u32x4*)(Z + ro + bj * HALF) = w; } }
    }
};
struct EpiF32 {
    static constexpr bool PERM = false;
    float* C;
    __device__ __forceinline__ void operator()(const f32x4 (&acc)[2][2][4][2], const Unit& u, int wr, int wc, int fr, int fq) const {
        const int row0 = u.pm * BM + wr * 64 + fr, col0 = wc * 32 + 4 * fq;
#pragma unroll
        for (int ai = 0; ai < 2; ++ai)
#pragma unroll
            for (int m = 0; m < 4; ++m) { float* rowp = C + (size_t)(row0 + ai * HALF + m * 16) * 256 + col0;
#pragma unroll
                for (int bj = 0; bj < 2; ++bj)
#pragma unroll
                    for (int n = 0; n < 2; ++n) *(f32x4*)(rowp + bj * HALF + n * 16) = acc[ai][bj][m][n]; }
    }
};
template <bool I8> struct EpiSwiGLU {
    static constexpr bool PERM = true;
    unsigned char* ACT; LAS unsigned char* sbuf;
    static __device__ __forceinline__ f32x4 dq(f32x4 v) { if (I8) { const i32x4 q = __builtin_bit_cast(i32x4, v); return (f32x4){(float)q[0] * Q_DEQ, (float)q[1] * Q_DEQ, (float)q[2] * Q_DEQ, (float)q[3] * Q_DEQ}; } return v; }
    __device__ __forceinline__ void operator()(const f32x4 (&acc)[2][2][4][2], const Unit& u, int wr, int wc, int fr, int fq) const {
        const int tid = threadIdx.x, rrow = tid >> 3, rchunk = tid & 7;
        const int wrow = wr * 16 + fr;
        unsigned char* abase = ACT + (size_t)(u.pm * BM) * 256 + (u.pn & 1) * 128 + rchunk * 16;
#pragma unroll
        for (int st = 0; st < 8; ++st) {
            const int ai = st >> 2, m = st & 3;
            LAS unsigned char* buf = sbuf + (st & 1) * 4096;
            const f32x4 g0 = dq(acc[ai][0][m][0]), g1 = dq(acc[ai][0][m][1]), u0 = dq(acc[ai][1][m][0]), u1 = dq(acc[ai][1][m][1]);
            u32x2 w;
            w.x = pk4(q8(silu(g0[0]) * u0[0], Q_SACT), q8(silu(g0[1]) * u0[1], Q_SACT), q8(silu(g0[2]) * u0[2], Q_SACT), q8(silu(g0[3]) * u0[3], Q_SACT));
            w.y = pk4(q8(silu(g1[0]) * u1[0], Q_SACT), q8(silu(g1[1]) * u1[1], Q_SACT), q8(silu(g1[2]) * u1[2], Q_SACT), q8(silu(g1[3]) * u1[3], Q_SACT));
            const int c16 = wc * 2 + (fq >> 1);
            *(LAS u32x2*)(buf + wrow * 128 + ((c16 ^ (wrow & 7)) << 4) + (fq & 1) * 8) = w;
            asm volatile("s_waitcnt lgkmcnt(0)" ::: "memory"); __builtin_amdgcn_s_barrier(); asm volatile("" ::: "memory");
            if (tid < 256) {
                const u32x4 rv = *(const LAS u32x4*)(buf + rrow * 128 + ((rchunk ^ (rrow & 7)) << 4));
                const int grow = ai * HALF + (rrow >> 4) * 64 + m * 16 + (rrow & 15);
                *(u32x4*)(abase + (size_t)grow * 256) = rv;
            }
        }
        asm volatile("s_waitcnt lgkmcnt(0)" ::: "memory"); __builtin_amdgcn_s_barrier(); asm volatile("" ::: "memory");
    }
};
template <int EV = 0> struct EpiDownT {
    static constexpr bool PERM = true;
    unsigned char* Y; LAS unsigned char* sbuf;
    __device__ __forceinline__ void operator()(const f32x4 (&acc)[2][2][4][2], const Unit& u, int wr, int wc, int fr, int fq) const {
        const int tid = threadIdx.x, rrow = tid >> 4, rchunk = tid & 15;
        const int wrow = wr * 16 + fr;
        unsigned char* ybase = Y + (size_t)(u.pm * BM) * DM + (u.pn & 3) * 256 + rchunk * 16;
#pragma unroll
        for (int st = 0; st < 8; ++st) {
            const int ai = st >> 2, m = st & 3;
            LAS unsigned char* buf = sbuf + (st & 1) * 8192;
#pragma unroll
            for (int bj = 0; bj < 2; ++bj) { const i32x4 q0 = __builtin_bit_cast(i32x4, acc[ai][bj][m][0]), q1 = __builtin_bit_cast(i32x4, acc[ai][bj][m][1]);
                const f32x4 v0 = (f32x4){(float)q0[0] * Q_DEQ2, (float)q0[1] * Q_DEQ2, (float)q0[2] * Q_DEQ2, (float)q0[3] * Q_DEQ2}, v1 = (f32x4){(float)q1[0] * Q_DEQ2, (float)q1[1] * Q_DEQ2, (float)q1[2] * Q_DEQ2, (float)q1[3] * Q_DEQ2};
                int p0 = __builtin_amdgcn_cvt_pk_fp8_f32(v0[0], v0[1], 0, false); p0 = __builtin_amdgcn_cvt_pk_fp8_f32(v0[2], v0[3], p0, true);
                int p1 = __builtin_amdgcn_cvt_pk_fp8_f32(v1[0], v1[1], 0, false); p1 = __builtin_amdgcn_cvt_pk_fp8_f32(v1[2], v1[3], p1, true);
                u32x2 w; w.x = (unsigned)p0; w.y = (unsigned)p1;
                const int c16 = bj * 8 + wc * 2 + (fq >> 1);
                *(LAS u32x2*)(buf + wrow * 256 + ((c16 ^ (wrow & 15)) << 4) + (fq & 1) * 8) = w; }
            asm volatile("s_waitcnt lgkmcnt(0)" ::: "memory"); __builtin_amdgcn_s_barrier(); asm volatile("" ::: "memory");
            const u32x4 rv = *(const LAS u32x4*)(buf + rrow * 256 + ((rchunk ^ (rrow & 15)) << 4));
            const int grow = ai * HALF + (rrow >> 4) * 64 + m * 16 + (rrow & 15);
            if (EV == 1) { asm volatile("" :: "v"(rv.x), "v"(rv.y), "v"(rv.z), "v"(rv.w)); } else *(u32x4*)(ybase + (size_t)grow * DM) = rv;
        }
        asm volatile("s_waitcnt lgkmcnt(0)" ::: "memory"); __builtin_amdgcn_s_barrier(); asm volatile("" ::: "memory");
    }
};
typedef EpiDownT<0> EpiDown;
}

struct Args { const float* in[22]; float* out; unsigned char* ws; int ph_lo, ph_hi; };
enum { I_X = 0, I_WINAB, I_WGKUP, I_BGK, I_HG, I_GG, I_WOAB, I_LB, I_WINC, I_CONV, I_BIF, I_WOC, I_WR, I_RB, I_WEI, I_WED, I_WSI, I_WSD, I_LMG, I_LMB, I_LFG, I_LFB };

constexpr int LDS_MISC = 147200;
constexpr int LDS_BYTES = 147456;

__device__ __forceinline__ void cvt_tile(LAS unsigned char* lds, const float* __restrict__ src, size_t ldn, int k0, int n0, bf16_t* __restrict__ dst, int K, int drow0) {
    const int t = threadIdx.x;
    { const int c4 = (t & 15) * 4, r2 = t >> 4;
      const f32x4 a = *(const f32x4*)(src + (size_t)(k0 + 2 * r2) * ldn + n0 + c4);
      const f32x4 b = *(const f32x4*)(src + (size_t)(k0 + 2 * r2 + 1) * ldn + n0 + c4);
#pragma unroll
      for (int i = 0; i < 4; ++i) *(LAS unsigned*)(lds + ((c4 + i) * 72 + 2 * r2) * 2) = pk2(a[i], b[i]); }
    __syncthreads();
    { const int kk = (t & 7) * 8, n = t >> 3;
      const u32x4 v = *(const LAS u32x4*)(lds + (n * 72 + kk) * 2);
      *(u32x4*)(dst + (size_t)(drow0 + n) * K + k0 + kk) = v; }
    __syncthreads();
}
template <int NT>
__device__ __forceinline__ void cvt_multi(LAS unsigned char* lds, const float* __restrict__ src, size_t ldn, int k0, int n0, bf16_t* __restrict__ dst, int K, const int (&drow)[NT], float sc = 1.f) {
    const int t = threadIdx.x;
    { const int c4 = (t & 15) * 4, r2 = t >> 4;
      f32x4 a[NT], b[NT];
#pragma unroll
      for (int q = 0; q < NT; ++q) { a[q] = __builtin_nontemporal_load((const f32x4*)(src + (size_t)(k0 + 2 * r2) * ldn + n0 + 64 * q + c4)); b[q] = __builtin_nontemporal_load((const f32x4*)(src + (size_t)(k0 + 2 * r2 + 1) * ldn + n0 + 64 * q + c4)); }
#pragma unroll
      for (int q = 0; q < NT; ++q)
#pragma unroll
          for (int i = 0; i < 4; ++i) *(LAS unsigned*)(lds + q * 9216 + ((c4 + i) * 72 + 2 * r2) * 2) = pk2(a[q][i] * sc, b[q][i] * sc); }
    __syncthreads();
    { const int kk = (t & 7) * 8, n = t >> 3;
#pragma unroll
      for (int q = 0; q < NT; ++q) { const u32x4 v = *(const LAS u32x4*)(lds + q * 9216 + (n * 72 + kk) * 2); *(u32x4*)(dst + (size_t)(drow[q] + n) * K + k0 + kk) = v; } }
    __syncthreads();
}
template <int NT>
__device__ __forceinline__ void cvt8_multi(LAS unsigned char* lds, const float* __restrict__ src, size_t ldn, int k0, int n0, unsigned char* __restrict__ dst, int Kb, const int (&drow)[NT], float sc) {
    const int t = threadIdx.x;
    { const int c4 = (t & 15) * 4, r4 = t >> 4;
      f32x4 a[NT][4];
#pragma unroll
      for (int q = 0; q < NT; ++q)
#pragma unroll
          for (int j = 0; j < 4; ++j) a[q][j] = __builtin_nontemporal_load((const f32x4*)(src + (size_t)(k0 + 4 * r4 + j) * ldn + n0 + 64 * q + c4));
#pragma unroll
      for (int q = 0; q < NT; ++q)
#pragma unroll
          for (int i = 0; i < 4; ++i) *(LAS unsigned*)(lds + q * 9216 + (c4 + i) * 144 + 4 * r4) = pk4(q8(a[q][0][i], sc), q8(a[q][1][i], sc), q8(a[q][2][i], sc), q8(a[q][3][i], sc)); }
    __syncthreads();
    { const int kk = (t & 7) * 16, n = t >> 3;
#pragma unroll
      for (int q = 0; q < NT; ++q) { const u32x4 v = *(const LAS u32x4*)(lds + q * 9216 + n * 144 + kk); *(u32x4*)(dst + (size_t)(drow[q] + n) * Kb + k0 + kk) = v; } }
    __syncthreads();
}
template <int NT>
__device__ __forceinline__ void cvt8_matrix(LAS unsigned char* lds, const float* src, size_t ldn, int K, int n_lo, int ncols, unsigned char* dst, int drow_lo, float sc, int bid, int nb) {
    const int tk = K / 128, tn = ncols / (64 * NT);
    for (int j = bid; j < tk * tn; j += nb) { const int a = j / tn, b = j % tn; int dr[NT];
#pragma unroll
        for (int q = 0; q < NT; ++q) dr[q] = drow_lo + (b * NT + q) * 64;
        cvt8_multi<NT>(lds, src, ldn, a * 128, n_lo + b * 64 * NT, dst, K, dr, sc); }
}
template <int NT>
__device__ __forceinline__ void cvt_matrix(LAS unsigned char* lds, const float* src, size_t ldn, int K, int n_lo, int ncols, bf16_t* dst, int drow_lo, int bid, int nb) {
    const int tk = K / 64, tn = ncols / (64 * NT);
    for (int j = bid; j < tk * tn; j += nb) { const int a = j / tn, b = j % tn; int dr[NT];
#pragma unroll
        for (int q = 0; q < NT; ++q) dr[q] = drow_lo + (b * NT + q) * 64;
        cvt_multi<NT>(lds, src, ldn, a * 64, n_lo + b * 64 * NT, dst, K, dr); }
}
__device__ __forceinline__ void phase_prologue(LAS unsigned char* lds, const Args& A, int bid, int nb) {
    unsigned char* ws = A.ws; const int tid = threadIdx.x;
    if (bid == 0) {
        float* lb0 = (float*)(ws + WS_MISC);
        const float* l = A.in[I_LB];
        if (tid < 512) { const float a = l[tid], b = l[512 + tid], c = l[1024 + tid]; const float m = fmaxf(a, fmaxf(b, c));
            const float ea = __expf(a - m), eb = __expf(b - m), ec = __expf(c - m); lb0[tid] = ea / (ea + eb + ec); }
    }
    if (bid == 1 % nb) {
        float* wg = (float*)(ws + WS_MISC + 4096);
        for (int i = tid; i < 8 * 1024; i += 512) { const int g = i >> 10, k = i & 1023; wg[i] = A.in[I_WINC][(size_t)k * 3080 + 3072 + g]; }
    }
    { const float* x = A.in[I_X]; bf16_t* hb = (bf16_t*)(ws + WS_HB); unsigned char* xq = ws + WS_XQ;
      const size_t step = (size_t)nb * 512 * 8;
      for (size_t i0 = ((size_t)bid * 512 + tid) * 8; i0 < (size_t)NTOK * DM; i0 += 4 * step) {
          f32x4 a[4], b[4];
#pragma unroll
          for (int u = 0; u < 4; ++u) { const size_t i = i0 + u * step; if (i < (size_t)NTOK * DM) { a[u] = __builtin_nontemporal_load((const f32x4*)(x + i)); b[u] = __builtin_nontemporal_load((const f32x4*)(x + i + 4)); } }
#pragma unroll
          for (int u = 0; u < 4; ++u) { const size_t i = i0 + u * step; if (i < (size_t)NTOK * DM) {
              u32x4 w; w.x = pk2(a[u][0], a[u][1]); w.y = pk2(a[u][2], a[u][3]); w.z = pk2(b[u][0], b[u][1]); w.w = pk2(b[u][2], b[u][3]);
              *(u32x4*)(hb + i) = w;
              u32x2 qv; qv.x = pk4(q8(a[u][0], Q_SA), q8(a[u][1], Q_SA), q8(a[u][2], Q_SA), q8(a[u][3], Q_SA)); qv.y = pk4(q8(b[u][0], Q_SA), q8(b[u][1], Q_SA), q8(b[u][2], Q_SA), q8(b[u][3], Q_SA));
              *(u32x2*)(xq + i) = qv; } } } }
    { unsigned char* wab = ws + WS_WAB; const float* win = A.in[I_WINAB]; const float* wup = A.in[I_WGKUP];
      for (int o = bid * 512 + tid; o < 256 * 64; o += nb * 512) { const int j = o >> 6, k16 = (o & 63) * 16;
          float up[16];
#pragma unroll
          for (int r = 0; r < 16; ++r) up[r] = wup[r * 256 + j];
          int res[16];
#pragma unroll
          for (int q = 0; q < 16; ++q) { const float* wr_ = win + (size_t)(k16 + q) * 3600 + 3584; float sm = 0.f;
#pragma unroll
              for (int r = 0; r < 16; ++r) sm += wr_[r] * up[r];
              res[q] = q8(sm, Q_SW); }
          u32x4 w; w.x = pk4(res[0], res[1], res[2], res[3]); w.y = pk4(res[4], res[5], res[6], res[7]); w.z = pk4(res[8], res[9], res[10], res[11]); w.w = pk4(res[12], res[13], res[14], res[15]);
          *(u32x4*)(wab + (size_t)(3584 + j) * 1024 + k16) = w; } }
    cvt8_matrix<4>(lds, A.in[I_WINAB], 3600, 1024, 0, 3584, ws + WS_WAB, 0, Q_SW, bid, nb);
    cvt8_matrix<4>(lds, A.in[I_WOAB], 1024, 1024, 0, 1024, ws + WS_WOAB, 0, Q_SWO, bid, nb);
    cvt8_matrix<4>(lds, A.in[I_WINC], 3080, 1024, 0, 3072, ws + WS_WC, 0, Q_SW, bid, nb);
    cvt8_matrix<4>(lds, A.in[I_WOC], 1024, 1024, 0, 1024, ws + WS_WOC, 0, Q_SWO, bid, nb);
    cvt_matrix<4>(lds, A.in[I_WR], 256, 1024, 0, 256, (bf16_t*)(ws + WS_WR), 0, bid, nb);
    cvt_matrix<4>(lds, A.in[I_WR] + 1024 * 256, 256, 1024, 0, 256, (bf16_t*)(ws + WS_WR) + 256 * 1024, 0, bid, nb);
}
__device__ __forceinline__ void convert_experts(LAS unsigned char* lds, const Args& A, int layer, int bid, int nb, int lo16, int hi16) {
    unsigned char* ws = A.ws;
    int kk = 0;
    for (int j = bid; j < NE1 * 16; j += nb, ++kk) {
        { const int pk = kk % 16; if (pk < lo16 || pk >= hi16) continue; }
        const int e = j % NE1, t0 = j / NE1;
        const int t = (t0 < 8) ? 2 * t0 : 8 + t0;
        if (t < 16) {
            const float* src = (e < NEXP) ? A.in[I_WEI] + ((size_t)(layer * NEXP + e)) * 1024 * 512 : A.in[I_WSI] + (size_t)layer * 1024 * 512;
            unsigned char* dst = ws + WS_W1T + ((size_t)(layer * NE1 + e)) * 512 * 1024;
            const int tk = t >> 1;
            int dr[8];
#pragma unroll
            for (int q = 0; q < 8; ++q) { const int n0 = q * 64, gq = n0 >> 8, nn = n0 & 255; dr[q] = (nn >> 7) * 256 + gq * 128 + (nn & 127); }
            cvt8_multi<8>(lds, src, 512, tk * 128, 0, dst, 1024, dr, Q_SW);
        } else {
            const int t2 = t - 16, tk = t2 >> 2, g4 = t2 & 3;
            const float* src = (e < NEXP) ? A.in[I_WED] + ((size_t)(layer * NEXP + e)) * 256 * 1024 : A.in[I_WSD] + (size_t)layer * 256 * 1024;
            unsigned char* dst = ws + WS_W2T + ((size_t)(layer * NE1 + e)) * 1024 * 256;
            int dr[4];
#pragma unroll
            for (int q = 0; q < 4; ++q) dr[q] = g4 * 256 + q * 64;
            cvt8_multi<4>(lds, src, 1024, tk * 128, g4 * 256, dst, 256, dr, Q_SW);
        }
    }
}

__device__ __forceinline__ void phase_ln(const bf16_t* __restrict__ Z, bf16_t* __restrict__ H, unsigned char* __restrict__ HQ, const float* __restrict__ g, const float* __restrict__ b, int bid, int nb) {
    const int lane = threadIdx.x & 63, gw = bid * 8 + (threadIdx.x >> 6), nw = nb * 8;
    float gg[16], bb[16];
#pragma unroll
    for (int i = 0; i < 8; ++i) { gg[i] = g[lane * 8 + i]; gg[8 + i] = g[512 + lane * 8 + i]; bb[i] = b[lane * 8 + i]; bb[8 + i] = b[512 + lane * 8 + i]; }
    for (int row = gw; row < NTOK; row += nw) {
        const u32x4 a = *(const u32x4*)(Z + (size_t)row * DM + lane * 8), c = *(const u32x4*)(Z + (size_t)row * DM + 512 + lane * 8);
        float v[16];
        v[0] = bflo(a.x); v[1] = bfhi(a.x); v[2] = bflo(a.y); v[3] = bfhi(a.y); v[4] = bflo(a.z); v[5] = bfhi(a.z); v[6] = bflo(a.w); v[7] = bfhi(a.w);
        v[8] = bflo(c.x); v[9] = bfhi(c.x); v[10] = bflo(c.y); v[11] = bfhi(c.y); v[12] = bflo(c.z); v[13] = bfhi(c.z); v[14] = bflo(c.w); v[15] = bfhi(c.w);
        float s = 0.f;
#pragma unroll
        for (int i = 0; i < 16; ++i) s += v[i];
#pragma unroll
        for (int o = 32; o > 0; o >>= 1) s += __shfl_xor(s, o);
        const float mu = s * (1.f / 1024.f);
        float q = 0.f;
#pragma unroll
        for (int i = 0; i < 16; ++i) { const float d = v[i] - mu; q += d * d; }
#pragma unroll
        for (int o = 32; o > 0; o >>= 1) q += __shfl_xor(q, o);
        const float rs = rsqrtf(q * (1.f / 1024.f) + 1e-5f);
        float y[16];
#pragma unroll
        for (int i = 0; i < 16; ++i) y[i] = (v[i] - mu) * rs * gg[i] + bb[i];
        u32x4 w0, w1; w0.x = pk2(y[0], y[1]); w0.y = pk2(y[2], y[3]); w0.z = pk2(y[4], y[5]); w0.w = pk2(y[6], y[7]);
        w1.x = pk2(y[8], y[9]); w1.y = pk2(y[10], y[11]); w1.z = pk2(y[12], y[13]); w1.w = pk2(y[14], y[15]);
        *(u32x4*)(H + (size_t)row * DM + lane * 8) = w0; *(u32x4*)(H + (size_t)row * DM + 512 + lane * 8) = w1;
        u32x2 q0, q1;
        q0.x = pk4(q8(y[0], Q_SA), q8(y[1], Q_SA), q8(y[2], Q_SA), q8(y[3], Q_SA)); q0.y = pk4(q8(y[4], Q_SA), q8(y[5], Q_SA), q8(y[6], Q_SA), q8(y[7], Q_SA));
        q1.x = pk4(q8(y[8], Q_SA), q8(y[9], Q_SA), q8(y[10], Q_SA), q8(y[11], Q_SA)); q1.y = pk4(q8(y[12], Q_SA), q8(y[13], Q_SA), q8(y[14], Q_SA), q8(y[15], Q_SA));
        *(u32x2*)(HQ + (size_t)row * DM + lane * 8) = q0; *(u32x2*)(HQ + (size_t)row * DM + 512 + lane * 8) = q1;
    }
}

template <bool FINAL>
__device__ __forceinline__ void phase_combine(const unsigned char* __restrict__ Y, const int* __restrict__ posy, const float* __restrict__ tokw, const int* __restrict__ ntiles,
                                              const bf16_t* __restrict__ H1, bf16_t* __restrict__ H2, unsigned char* __restrict__ H2Q, float* __restrict__ OUT, float* __restrict__ GATES,
                                              const float* __restrict__ wgate, const float* __restrict__ g, const float* __restrict__ b, int bid, int nb) {
    const int shbase = (*ntiles - NTOK / 256) * 256;
    const int lane = threadIdx.x & 63, gw = bid * 8 + (threadIdx.x >> 6), nw = nb * 8;
    int npos = 0; float nwk = 0.f;
    if (gw < NTOK) { npos = (lane < 8) ? posy[(size_t)gw * 8 + lane] : shbase + gw; nwk = (lane < 8) ? tokw[(size_t)gw * 8 + lane] : 1.0f; }
    float gg[16], bb[16], wgt[FINAL ? 1 : 8][16];
#pragma unroll
    for (int i = 0; i < 8; ++i) { gg[i] = g[lane * 8 + i]; gg[8 + i] = g[512 + lane * 8 + i]; bb[i] = b[lane * 8 + i]; bb[8 + i] = b[512 + lane * 8 + i]; }
    if (!FINAL) {
#pragma unroll
        for (int gi = 0; gi < 8; ++gi)
#pragma unroll
            for (int i = 0; i < 8; ++i) { wgt[gi][i] = wgate[gi * 1024 + lane * 8 + i]; wgt[gi][8 + i] = wgate[gi * 1024 + 512 + lane * 8 + i]; }
    }
    for (int row = gw; row < NTOK; row += nw) {
        const int cpos = npos; const float cwk = nwk;
        { const int nr = row + nw; if (nr < NTOK) { npos = (lane < 8) ? posy[(size_t)nr * 8 + lane] : shbase + nr; nwk = (lane < 8) ? tokw[(size_t)nr * 8 + lane] : 1.0f; } }
        float v[16];
        { const u32x4 a = *(const u32x4*)(H1 + (size_t)row * DM + lane * 8), c = *(const u32x4*)(H1 + (size_t)row * DM + 512 + lane * 8);
          v[0] = bflo(a.x); v[1] = bfhi(a.x); v[2] = bflo(a.y); v[3] = bfhi(a.y); v[4] = bflo(a.z); v[5] = bfhi(a.z); v[6] = bflo(a.w); v[7] = bfhi(a.w);
          v[8] = bflo(c.x); v[9] = bfhi(c.x); v[10] = bflo(c.y); v[11] = bfhi(c.y); v[12] = bflo(c.z); v[13] = bfhi(c.z); v[14] = bflo(c.w); v[15] = bfhi(c.w); }
#pragma unroll
        for (int i = 0; i < 16; ++i) v[i] *= ALPHA;
        u32x2 ya[NSLOT], yc[NSLOT]; float wks[NSLOT];
#pragma unroll
        for (int k = 0; k < NSLOT; ++k) {
            const int pos = __builtin_amdgcn_readlane(cpos, k); wks[k] = __uint_as_float(__builtin_amdgcn_readlane(__float_as_uint(cwk), k)) * 0.0625f;
            const unsigned char* yr = Y + (size_t)pos * DM;
            ya[k] = *(const u32x2*)(yr + lane * 8); yc[k] = *(const u32x2*)(yr + 512 + lane * 8);
        }
        typedef float f32x2_ __attribute__((ext_vector_type(2)));
#pragma unroll
        for (int k = 0; k < NSLOT; ++k) {
            const float wk = wks[k];
            const f32x2_ a0 = __builtin_amdgcn_cvt_pk_f32_fp8((int)ya[k].x, false), a1 = __builtin_amdgcn_cvt_pk_f32_fp8((int)ya[k].x, true), a2 = __builtin_amdgcn_cvt_pk_f32_fp8((int)ya[k].y, false), a3 = __builtin_amdgcn_cvt_pk_f32_fp8((int)ya[k].y, true);
            const f32x2_ c0 = __builtin_amdgcn_cvt_pk_f32_fp8((int)yc[k].x, false), c1 = __builtin_amdgcn_cvt_pk_f32_fp8((int)yc[k].x, true), c2 = __builtin_amdgcn_cvt_pk_f32_fp8((int)yc[k].y, false), c3 = __builtin_amdgcn_cvt_pk_f32_fp8((int)yc[k].y, true);
            v[0] += wk * a0.x; v[1] += wk * a0.y; v[2] += wk * a1.x; v[3] += wk * a1.y; v[4] += wk * a2.x; v[5] += wk * a2.y; v[6] += wk * a3.x; v[7] += wk * a3.y;
            v[8] += wk * c0.x; v[9] += wk * c0.y; v[10] += wk * c1.x; v[11] += wk * c1.y; v[12] += wk * c2.x; v[13] += wk * c2.y; v[14] += wk * c3.x; v[15] += wk * c3.y;
        }
        float s = 0.f;
#pragma unroll
        for (int i = 0; i < 16; ++i) s += v[i];
#pragma unroll
        for (int o = 32; o > 0; o >>= 1) s += __shfl_xor(s, o);
        const float mu = s * (1.f / 1024.f);
        float q = 0.f;
#pragma unroll
        for (int i = 0; i < 16; ++i) { const float d = v[i] - mu; q += d * d; }
#pragma unroll
        for (int o = 32; o > 0; o >>= 1) q += __shfl_xor(q, o);
        const float rs = rsqrtf(q * (1.f / 1024.f) + 1e-5f);
        float y[16];
#pragma unroll
        for (int i = 0; i < 16; ++i) y[i] = (v[i] - mu) * rs * gg[i] + bb[i];
        if (FINAL) {
            float* o = OUT + (size_t)row * DM;
            *(f32x4*)(o + lane * 8) = (f32x4){y[0], y[1], y[2], y[3]}; *(f32x4*)(o + lane * 8 + 4) = (f32x4){y[4], y[5], y[6], y[7]};
            *(f32x4*)(o + 512 + lane * 8) = (f32x4){y[8], y[9], y[10], y[11]}; *(f32x4*)(o + 512 + lane * 8 + 4) = (f32x4){y[12], y[13], y[14], y[15]};
        } else {
            u32x4 w0, w1; w0.x = pk2(y[0], y[1]); w0.y = pk2(y[2], y[3]); w0.z = pk2(y[4], y[5]); w0.w = pk2(y[6], y[7]);
            w1.x = pk2(y[8], y[9]); w1.y = pk2(y[10], y[11]); w1.z = pk2(y[12], y[13]); w1.w = pk2(y[14], y[15]);
            *(u32x4*)(H2 + (size_t)row * DM + lane * 8) = w0; *(u32x4*)(H2 + (size_t)row * DM + 512 + lane * 8) = w1;
            { u32x2 q0, q1;
              q0.x = pk4(q8(y[0], Q_SA), q8(y[1], Q_SA), q8(y[2], Q_SA), q8(y[3], Q_SA)); q0.y = pk4(q8(y[4], Q_SA), q8(y[5], Q_SA), q8(y[6], Q_SA), q8(y[7], Q_SA));
              q1.x = pk4(q8(y[8], Q_SA), q8(y[9], Q_SA), q8(y[10], Q_SA), q8(y[11], Q_SA)); q1.y = pk4(q8(y[12], Q_SA), q8(y[13], Q_SA), q8(y[14], Q_SA), q8(y[15], Q_SA));
              *(u32x2*)(H2Q + (size_t)row * DM + lane * 8) = q0; *(u32x2*)(H2Q + (size_t)row * DM + 512 + lane * 8) = q1; }
            float yr[16];
            yr[0] = bflo(w0.x); yr[1] = bfhi(w0.x); yr[2] = bflo(w0.y); yr[3] = bfhi(w0.y); yr[4] = bflo(w0.z); yr[5] = bfhi(w0.z); yr[6] = bflo(w0.w); yr[7] = bfhi(w0.w);
            yr[8] = bflo(w1.x); yr[9] = bfhi(w1.x); yr[10] = bflo(w1.y); yr[11] = bfhi(w1.y); yr[12] = bflo(w1.z); yr[13] = bfhi(w1.z); yr[14] = bflo(w1.w); yr[15] = bfhi(w1.w);
            float d8[8];
#pragma unroll
            for (int gi = 0; gi < 8; ++gi) { float d = 0.f;
#pragma unroll
                for (int i = 0; i < 16; ++i) d += yr[i] * wgt[FINAL ? 0 : gi][i];
                d8[gi] = d; }
            float d4[4], d2[2], d1;
            { const bool hi = (lane & 32) != 0;
#pragma unroll
              for (int q = 0; q < 4; ++q) { const float keep = hi ? d8[4 + q] : d8[q], give = hi ? d8[q] : d8[4 + q]; d4[q] = keep + __shfl_xor(give, 32); } }
            { const bool hi = (lane & 16) != 0;
#pragma unroll
              for (int q = 0; q < 2; ++q) { const float keep = hi ? d4[2 + q] : d4[q], give = hi ? d4[q] : d4[2 + q]; d2[q] = keep + __shfl_xor(give, 16); } }
            { const bool hi = (lane & 8) != 0; const float keep = hi ? d2[1] : d2[0], give = hi ? d2[0] : d2[1]; d1 = keep + __shfl_xor(give, 8); }
            d1 += __shfl_xor(d1, 4); d1 += __shfl_xor(d1, 2); d1 += __shfl_xor(d1, 1);
            const int gidx = ((lane >> 5) & 1) * 4 + ((lane >> 4) & 1) * 2 + ((lane >> 3) & 1);
            const float gsum = d1;
            if ((lane & 7) == 0) GATES[(size_t)row * 8 + gidx] = gsum;
        }
    }
}

template <bool DRY>
__device__ __forceinline__ void phase_select(LAS unsigned char* lds, const float* __restrict__ logits, const float* __restrict__ rbias, int* __restrict__ tok_e, int* __restrict__ tok_p,
                                             float* __restrict__ tok_w, unsigned* __restrict__ cnt, int bid, int nb) {
    const int tid = threadIdx.x, it = tid & 63, g8 = tid >> 6;
    LAS unsigned* hist = (LAS unsigned*)lds;
    LAS unsigned* base = hist + 256;
    LAS int* selE = (LAS int*)(base + 256);
    LAS int* selR = selE + 1024;
    LAS float* gsl = (LAS float*)(lds + 10240);
    LAS float* lv = (LAS float*)(lds + 12288);
    LAS int* le = (LAS int*)(lds + 28672);
    LAS float* sb = (LAS float*)(lds + 45056);
    const int tpw = NTOK / nb;
    const int t0 = bid * tpw;
    const float NEG = -3.0e38f;
    if (tid < 256) hist[tid] = 0u;
    __syncthreads();
    for (int half = 0; half < tpw / 64; ++half) {
        const int tb = t0 + half * 64;
        {
            const int e = tid & 255, tk0 = tid >> 8; const float rb = rbias[e];
#pragma unroll
            for (int i0 = 0; i0 < 32; i0 += 8) { float lv8[8];
#pragma unroll
                for (int u = 0; u < 8; ++u) lv8[u] = logits[(size_t)(tb + tk0 + 2 * (i0 + u)) * 256 + e];
#pragma unroll
                for (int u = 0; u < 8; ++u) sb[e * 65 + tk0 + 2 * (i0 + u)] = sigm(lv8[u]) + rb; }
        }
        __syncthreads();
        {
            float m1 = NEG, m2 = NEG;
            for (int j = 0; j < 32; ++j) { const float v = sb[(g8 * 32 + j) * 65 + it]; if (v > m1) { m2 = m1; m1 = v; } else if (v > m2) m2 = v; }
            gsl[g8 * 64 + it] = m1 + m2;
        }
        __syncthreads();
        float G[8];
#pragma unroll
        for (int q = 0; q < 8; ++q) G[q] = gsl[q * 64 + it];
        unsigned selmask = 0u;
#pragma unroll
        for (int g = 0; g < 8; ++g) { int rank = 0;
#pragma unroll
            for (int q = 0; q < 8; ++q) rank += (G[q] > G[g] || (G[q] == G[g] && q < g)) ? 1 : 0;
            if (rank < 4) selmask |= 1u << g; }
        if ((selmask >> g8) & 1u) {
            float vv[32];
#pragma unroll
            for (int j = 0; j < 32; ++j) vv[j] = sb[(g8 * 32 + j) * 65 + it];
#pragma unroll
            for (int k = 0; k < 8; ++k) {
                float bv = vv[0]; int bj = 0;
#pragma unroll
                for (int j = 1; j < 32; ++j) { const bool gt = vv[j] > bv; bv = gt ? vv[j] : bv; bj = gt ? j : bj; }
#pragma unroll
                for (int j = 0; j < 32; ++j) vv[j] = (j == bj) ? NEG : vv[j];
                lv[(g8 * 8 + k) * 64 + it] = bv; le[(g8 * 8 + k) * 64 + it] = g8 * 32 + bj;
            }
        }
        __syncthreads();
        if (tid < 64) {
            int gid[4]; { int n = 0;
#pragma unroll
                for (int g = 0; g < 8; ++g) if ((selmask >> g) & 1u) { if (n == 0) gid[0] = g; else if (n == 1) gid[1] = g; else if (n == 2) gid[2] = g; else gid[3] = g; ++n; } }
            float hv[4]; int hp[4];
#pragma unroll
            for (int j = 0; j < 4; ++j) { hp[j] = 0; hv[j] = lv[(gid[j] * 8) * 64 + it]; }
            float sc8[8]; int te[8]; float tot = 0.f;
#pragma unroll
            for (int k = 0; k < 8; ++k) {
                int bj = 0; float bv = hv[0];
                if (hv[1] > bv) { bv = hv[1]; bj = 1; }
                if (hv[2] > bv) { bv = hv[2]; bj = 2; }
                if (hv[3] > bv) { bv = hv[3]; bj = 3; }
                const int gsel = (bj == 0) ? gid[0] : (bj == 1) ? gid[1] : (bj == 2) ? gid[2] : gid[3];
                const int psel = (bj == 0) ? hp[0] : (bj == 1) ? hp[1] : (bj == 2) ? hp[2] : hp[3];
                const int e = le[(gsel * 8 + psel) * 64 + it];
                te[k] = e; sc8[k] = bv - rbias[e]; tot += sc8[k];
                const float nv = (psel < 7) ? lv[(gsel * 8 + psel + 1) * 64 + it] : NEG;
                if (bj == 0) { hv[0] = nv; hp[0] = psel + 1; } else if (bj == 1) { hv[1] = nv; hp[1] = psel + 1; } else if (bj == 2) { hv[2] = nv; hp[2] = psel + 1; } else { hv[3] = nv; hp[3] = psel + 1; }
            }
            const float inv = 2.5f / tot;
            const int tok = tb + it, lt = half * 64 + it;
#pragma unroll
            for (int k = 0; k < 8; ++k) {
                tok_e[(size_t)tok * 8 + k] = te[k]; tok_w[(size_t)tok * 8 + k] = sc8[k] * inv;
                const unsigned r = atomicAdd((unsigned*)&hist[te[k]], 1u);
                selE[lt * 8 + k] = te[k]; selR[lt * 8 + k] = (int)r;
            }
        }
        __syncthreads();
    }
    if (DRY) return;
    if (tid < 256) { const unsigned c = hist[tid]; base[tid] = c ? __hip_atomic_fetch_add(cnt + tid, c, __ATOMIC_RELAXED, __HIP_MEMORY_SCOPE_AGENT) : 0u; }
    __syncthreads();
    for (int i = tid; i < tpw * 8; i += 512) tok_p[(size_t)t0 * 8 + i] = (int)base[selE[i]] + selR[i];
    __syncthreads();
}

__device__ __forceinline__ void phase_dispatch(LAS unsigned char* lds, const unsigned* __restrict__ cnt, const int* __restrict__ tok_e, const int* __restrict__ tok_p,
                                               int* __restrict__ s_tok, int* __restrict__ posy, int* __restrict__ tile_exp, int* __restrict__ ntiles, int bid, int nb) {
    const int tid = threadIdx.x;
    LAS int* tstart = (LAS int*)lds;
    LAS int* tcnt = tstart + 260;
    if (tid < 256) tcnt[tid] = (int)((__hip_atomic_load(cnt + tid, __ATOMIC_RELAXED, __HIP_MEMORY_SCOPE_AGENT) + 255u) >> 8);
    __syncthreads();
    if (tid < 256) { int a = 0;
#pragma unroll 16
        for (int j = 0; j < 256; ++j) { const int c = tcnt[j]; a += (j < tid) ? c : 0; }
        tstart[tid] = a; if (tid == 255) tstart[256] = a + tcnt[255]; }
    __syncthreads();
    const int TT = tstart[256];
    const int tpw = NTOK / nb, t0 = bid * tpw;
    for (int i = tid; i < tpw * 8; i += 512) {
        const size_t a = (size_t)t0 * 8 + i; const int e = tok_e[a], p = tok_p[a];
        const int pos = tstart[e] * 256 + p;
        s_tok[pos] = (int)(a >> 3); posy[a] = pos;
    }
    for (int i = tid; i < tpw; i += 512) { const int tok = t0 + i; s_tok[TT * 256 + tok] = tok; }
    for (int e = bid; e < 256; e += nb) {
        const int c = (int)__hip_atomic_load(cnt + e, __ATOMIC_RELAXED, __HIP_MEMORY_SCOPE_AGENT), ts = tstart[e], tc = tcnt[e];
        for (int i = c + tid; i < tc * 256; i += 512) s_tok[ts * 256 + i] = 0;
        for (int i = tid; i < tc; i += 512) tile_exp[ts + i] = e;
    }
    if (bid == 0) { for (int i = tid; i < NTOK / 256; i += 512) tile_exp[TT + i] = 256; if (tid == 0) *ntiles = TT + NTOK / 256; }
    __syncthreads();
}

constexpr int MX_QT = 0, MX_KT = 17408, MX_KHT = 34816, MX_VT = 53248, MX_P = 73984, MX_ST = 83200, MX_SEG = 122368, MX_GD = 126464, MX_ER = 126976, MX_RS = 127488, MX_DEN = 128000, MX_BC = 128256, MX_IP = 128512, MX_GT = 128768;
struct MixP {
    const bf16_t* proj; int ldp; int pad0; unsigned char* ymix; const float* gates;
    const float* lb0; const float* bgk; const float* hg; const float* gg; const float* conv; const float* bif;
    float* ust; float* gsum;
};
#define MFMA16(a, b, c) __builtin_amdgcn_mfma_f32_16x16x32_bf16((a), (b), (c), 0, 0, 0)

template <int MODE, bool FULL, int VAR = 0>
__device__ __forceinline__ void mixer_run(LAS unsigned char* lds, const MixP& mp, int bid) {
    constexpr int DK = (MODE == 1) ? 64 : 128, QP = DK + 8, CP = DK / 2, RG = 512 / CP, RPT = 64 / RG, KS = DK / 32;
    constexpr int NVT = (MODE == 2) ? 9 : 8;
    constexpr int NST = (DK == 128) ? NVT : 4;
    const int tid = threadIdx.x, lane = tid & 63, w = __builtin_amdgcn_readfirstlane(tid >> 6), l15 = lane & 15, l4 = lane >> 4;
    int b, h, vh = 0, seg;
    if (MODE == 0) { const int sq = bid >> 4; b = sq >> 2; h = sq & 3; seg = bid & 15; }
    else if (MODE == 1) { const int sq = (bid - 128) >> 4; b = sq >> 2; h = sq & 3; seg = bid & 15; }
    else { const int sq = bid >> 4; b = sq >> 3; h = (sq >> 1) & 3; vh = sq & 1; seg = bid & 15; }
    const int tok0 = b * SEQ + seg * 1024;
    const int ldp = mp.ldp; const bf16_t* proj = mp.proj;
    int cq, ck, cv, cg, cy;
    if (MODE == 0) { cq = h * 128; ck = 512 + h * 128; cv = 1024 + h * 128; cg = 1536 + h * 128; cy = h * 128; }
    else if (MODE == 1) { cq = 2048 + h * 64; ck = 2304 + h * 64; cv = 2560 + h * 128; cg = 3072 + h * 128; cy = 512 + h * 128; }
    else { cq = h * 128; ck = 512 + h * 128; cv = 1024 + h * 256 + vh * 128; cg = 2048 + h * 256 + vh * 128; cy = h * 256 + vh * 128; }
    const int cu = 3584 + h * 64;
    const int cp = tid % CP, rg = tid / CP, d0 = 2 * cp;
    float lbv[2] = {0.f, 0.f}, oml[2] = {0.f, 0.f}, bgk[2] = {0.f, 0.f}, cwq[4][2], cwk[4][2];
    if (MODE == 0) { lbv[0] = mp.lb0[h * 128 + d0]; lbv[1] = mp.lb0[h * 128 + d0 + 1]; oml[0] = 1.f - lbv[0]; oml[1] = 1.f - lbv[1]; }
    if (MODE == 1) { bgk[0] = mp.bgk[h * 64 + d0]; bgk[1] = mp.bgk[h * 64 + d0 + 1]; }
#pragma unroll
    for (int j = 0; j < 4; ++j) { cwq[j][0] = cwq[j][1] = cwk[j][0] = cwk[j][1] = 0.f; }
    if (MODE == 2) {
#pragma unroll
        for (int j = 0; j < 4; ++j) { cwq[j][0] = mp.conv[j * 1024 + cq + d0]; cwq[j][1] = mp.conv[j * 1024 + cq + d0 + 1]; cwk[j][0] = mp.conv[j * 1024 + ck + d0]; cwk[j][1] = mp.conv[j * 1024 + ck + d0 + 1]; }
    }
    const float bi = (MODE == 2) ? mp.bif[h] : 0.f, bfg = (MODE == 2) ? mp.bif[4 + h] : 0.f;
    const int sdt = (DK == 128) ? w : (w & 3), svt0 = (DK == 128) ? 0 : 4 * (w >> 2);
    f32x4 S[NST];
#pragma unroll
    for (int t = 0; t < NST; ++t) S[t] = (f32x4){0.f, 0.f, 0.f, 0.f};
    float gacc[2] = {(MODE == 2) ? 0.f : 1.f, (MODE == 2) ? 0.f : 1.f};
    if (MODE == 2) {
        for (int i = tid; i < 16 * 72; i += 512) { const int r = i / 72; *(LAS bf16_t*)(lds + MX_VT + ((128 + r) * 72 + (i % 72)) * 2) = (r == 0) ? (bf16_t)0x3F80 : (bf16_t)0; }
    }
    if (FULL) {
        const int bid0 = bid & ~15;
#pragma unroll 2
        for (int j = 0; j < seg; ++j) {
            const float* U = mp.ust + ((size_t)(bid0 + j) * 8 + w) * (9 * 4 * 64);
            float dec[4];
            if (MODE == 2) { const float gsv = mp.gsum[(size_t)(bid0 + j) * 128]; dec[0] = dec[1] = dec[2] = dec[3] = __expf(gsv); }
            else {
#pragma unroll
                for (int r = 0; r < 4; ++r) dec[r] = mp.gsum[(size_t)(bid0 + j) * 128 + sdt * 16 + 4 * l4 + r];
            }
            f32x4 uu[NST];
#pragma unroll
            for (int t = 0; t < NST; ++t)
#pragma unroll
                for (int r = 0; r < 4; ++r) uu[t][r] = U[(t * 4 + r) * 64 + lane];
#pragma unroll
            for (int t = 0; t < NST; ++t)
#pragma unroll
                for (int r = 0; r < 4; ++r) S[t][r] = dec[r] * S[t][r] + uu[t][r];
        }
    }
    const int sj = w & 3, ovh = w >> 2, srow = 16 * sj + l15;
    const int vp = tid & 63, r0v = (tid >> 6) * 8;
    unsigned ra[RPT + 3], rb[RPT + 3], rc[RPT], pv[8]; u32x2 gnx[4]; float sgi = 0.f, sgf = 0.f;
#pragma unroll
    for (int i = 0; i < RPT + 3; ++i) { ra[i] = 0u; rb[i] = 0u; }
#pragma unroll
    for (int i = 0; i < RPT; ++i) rc[i] = 0u;
#pragma unroll
    for (int t = 0; t < 4; ++t) gnx[t] = (u32x2){0u, 0u};
#define MX_LOAD(cn) do { const int tokn_ = tok0 + (cn) * 64; \
        if (VAR == 1 || VAR == 3 || VAR == 4) { _Pragma("unroll") for (int i = 0; i < RPT + 3; ++i) { ra[i] = 0x3c003c00u + (unsigned)(cn); rb[i] = 0x3c003c00u; } _Pragma("unroll") for (int i = 0; i < RPT; ++i) rc[i] = 0x3c003c00u; _Pragma("unroll") for (int i = 0; i < 8; ++i) pv[i] = 0x3c003c00u; _Pragma("unroll") for (int t = 0; t < 4; ++t) gnx[t] = (u32x2){0x3c003c00u, 0x3c003c00u}; sgi = 0.1f; sgf = 3.f; } else \
        if (MODE == 2) { const int tl0_ = seg * 1024 + (cn) * 64 + rg * RPT; \
            _Pragma("unroll") for (int i = 0; i < RPT + 3; ++i) { const int tl_ = tl0_ - 3 + i; \
                if (tl_ >= 0) { const bf16_t* pr_ = proj + (size_t)(b * SEQ + tl_) * ldp; if (FULL) ra[i] = *(const unsigned*)(pr_ + cq + d0); rb[i] = *(const unsigned*)(pr_ + ck + d0); } \
                else { ra[i] = 0u; rb[i] = 0u; } } \
            if (w == 0) { const float* gp_ = mp.gates + (size_t)(tokn_ + lane) * 8; sgi = gp_[h]; sgf = gp_[4 + h]; } \
        } else { \
            _Pragma("unroll") for (int i = 0; i < RPT; ++i) { const bf16_t* pr_ = proj + (size_t)(tokn_ + rg * RPT + i) * ldp; \
                if (MODE == 0) { ra[i] = *(const unsigned*)(pr_ + ck + d0); if (FULL) rb[i] = *(const unsigned*)(pr_ + cq + d0); } \
                else { ra[i] = *(const unsigned*)(pr_ + cu + d0); rb[i] = *(const unsigned*)(pr_ + ck + d0); if (FULL) rc[i] = *(const unsigned*)(pr_ + cq + d0); } } \
        } \
        _Pragma("unroll") for (int i = 0; i < 8; ++i) pv[i] = *(const unsigned*)(proj + (size_t)(tokn_ + r0v + i) * ldp + cv + 2 * vp); \
        if (FULL) { _Pragma("unroll") for (int t = 0; t < 4; ++t) gnx[t] = *(const u32x2*)(proj + (size_t)(tokn_ + srow) * ldp + cg + 16 * (4 * ovh + t) + 4 * l4); } \
    } while (0)
    float gnv[4][4];
#pragma unroll
    for (int t = 0; t < 4; ++t)
#pragma unroll
        for (int r = 0; r < 4; ++r) gnv[t][r] = (FULL && MODE != 2) ? ((MODE == 0) ? mp.hg : mp.gg)[h * 128 + 16 * (4 * ovh + t) + 4 * l4 + r] : 1.f;
    MX_LOAD(0);
    __syncthreads();
    for (int c = 0; c < 16; ++c) {
        const int tokc = tok0 + c * 64;
        float la[RPT][2], sp[RPT][2], qv[RPT][2], kv[RPT][2];
        u32x2 gcur[4];
        if (VAR == 4) {
#pragma unroll
            for (int t = 0; t < 4; ++t) gcur[t] = gnx[t];
            __syncthreads(); __syncthreads(); goto stepC; }
#pragma unroll
        for (int t = 0; t < 4; ++t) gcur[t] = gnx[t];
        if (MODE == 2) {
            if (w == 0) {
                const float ip = sgi + bi, lf = logsig(sgf + bfg);
                float cs = lf;
#pragma unroll
                for (int o = 1; o < 64; o <<= 1) { const float t = __shfl_up(cs, o); if (lane >= o) cs += t; }
                *(LAS float*)(lds + MX_BC + lane * 4) = cs; *(LAS float*)(lds + MX_IP + lane * 4) = ip - cs;
                if (lane == 63) *(LAS float*)(lds + MX_GT) = cs;
            }
#pragma unroll
            for (int i = 0; i < RPT; ++i)
#pragma unroll
                for (int e = 0; e < 2; ++e) {
                    float aq = 0.f, ak = 0.f;
#pragma unroll
                    for (int j = 0; j < 4; ++j) { aq += cwq[j][e] * (e ? bfhi(ra[i + j]) : bflo(ra[i + j])); ak += cwk[j][e] * (e ? bfhi(rb[i + j]) : bflo(rb[i + j])); }
                    qv[i][e] = silu(aq); kv[i][e] = silu(ak) * 0.08838834764831845f; la[i][e] = 0.f; sp[i][e] = 0.f;
                }
        } else {
#pragma unroll
            for (int i = 0; i < RPT; ++i) {
                if (MODE == 0) {
                    const unsigned uz = ra[i];
                    const float s0 = sigm(bflo(uz)), s1 = sigm(bfhi(uz));
                    la[i][0] = lbv[0] + oml[0] * s0; la[i][1] = lbv[1] + oml[1] * s1;
                    kv[i][0] = oml[0] - oml[0] * s0; kv[i][1] = oml[1] - oml[1] * s1;
                    if (FULL) { const unsigned uq = rb[i]; qv[i][0] = silu(bflo(uq)); qv[i][1] = silu(bfhi(uq)); } else { qv[i][0] = qv[i][1] = 0.f; }
                } else {
                    const unsigned uu = ra[i], uk = rb[i];
                    la[i][0] = __expf(logsig(bflo(uu) + bgk[0]) * 0.0625f); la[i][1] = __expf(logsig(bfhi(uu) + bgk[1]) * 0.0625f);
                    kv[i][0] = bflo(uk); kv[i][1] = bfhi(uk);
                    if (FULL) { const unsigned uq = rc[i]; qv[i][0] = bflo(uq) * 0.125f; qv[i][1] = bfhi(uq) * 0.125f; } else { qv[i][0] = qv[i][1] = 0.f; }
                }
            }
#pragma unroll
            for (int e = 0; e < 2; ++e) {
                float run = 1.f;
#pragma unroll
                for (int i = RPT - 1; i >= 0; --i) { sp[i][e] = run; run *= la[i][e]; }
                run = 1.f;
#pragma unroll
                for (int i = 0; i < RPT; ++i) { run *= la[i][e]; la[i][e] = run; }
            }
            *(LAS float*)(lds + MX_SEG + (rg * DK + d0) * 4) = la[RPT - 1][0]; *(LAS float*)(lds + MX_SEG + (rg * DK + d0 + 1) * 4) = la[RPT - 1][1];
        }
        {
            u32x4 lo, hi;
            lo.x = (pv[0] & 0xffffu) | (pv[1] << 16); lo.y = (pv[2] & 0xffffu) | (pv[3] << 16); lo.z = (pv[4] & 0xffffu) | (pv[5] << 16); lo.w = (pv[6] & 0xffffu) | (pv[7] << 16);
            hi.x = (pv[0] >> 16) | (pv[1] & 0xffff0000u); hi.y = (pv[2] >> 16) | (pv[3] & 0xffff0000u); hi.z = (pv[4] >> 16) | (pv[5] & 0xffff0000u); hi.w = (pv[6] >> 16) | (pv[7] & 0xffff0000u);
            *(LAS u32x4*)(lds + MX_VT + ((2 * vp) * 72 + r0v) * 2) = lo; *(LAS u32x4*)(lds + MX_VT + ((2 * vp + 1) * 72 + r0v) * 2) = hi;
        }
        if (c + 1 < 16) MX_LOAD(c + 1);
        if (VAR == 2) { unsigned xa = 0; _Pragma("unroll") for (int i = 0; i < RPT + 3; ++i) xa ^= ra[i] ^ rb[i]; _Pragma("unroll") for (int i = 0; i < RPT; ++i) xa ^= rc[i]; _Pragma("unroll") for (int i = 0; i < 8; ++i) xa ^= pv[i];
            _Pragma("unroll") for (int t = 0; t < 4; ++t) xa ^= gnx[t].x ^ gnx[t].y; gacc[0] += (float)(xa & 1u) + sgi + sgf; continue; }
        __syncthreads();
        {
            float pre[2], h2[2], gt[2];
            if (MODE == 2) {
                const float g = *(LAS float*)(lds + MX_GT);
                gt[0] = gt[1] = g; h2[0] = h2[1] = 0.f; pre[0] = pre[1] = 0.f;
                if (tid == 0) gacc[0] += g;
            } else {
#pragma unroll
                for (int e = 0; e < 2; ++e) { float p = 1.f, a1 = 1.f, a2 = 1.f;
#pragma unroll
                    for (int j = 0; j < RG; ++j) { const float v = *(LAS float*)(lds + MX_SEG + (j * DK + d0 + e) * 4);
                        if (j < RG / 2) a1 *= v; else a2 *= v;
                        const bool inb = (rg >= RG / 2) ? (j >= RG / 2 && j < rg) : (j > rg && j < RG / 2);
                        p *= inb ? v : 1.f; }
                    pre[e] = p; h2[e] = a2; gt[e] = a1 * a2;
                    if (rg == 0) { gacc[e] *= gt[e]; *(LAS float*)(lds + MX_GD + (d0 + e) * 4) = gt[e]; *(LAS float*)(lds + MX_ER + (d0 + e) * 4) = a1; } }
            }
            float kh[RPT][2];
#pragma unroll
            for (int i = 0; i < RPT; ++i) {
                const int s = rg * RPT + i;
                float qs[2], ks[2];
                if (MODE == 2) {
                    const float bc = *(LAS float*)(lds + MX_BC + s * 4), ipb = *(LAS float*)(lds + MX_IP + s * 4);
                    const float eq = __expf(bc), ek = __expf(ipb), eg = __expf(gt[0]);
                    qs[0] = qv[i][0] * eq; qs[1] = qv[i][1] * eq; ks[0] = kv[i][0] * ek; ks[1] = kv[i][1] * ek; kh[i][0] = ks[0] * eg; kh[i][1] = ks[1] * eg;
                } else {
#pragma unroll
                    for (int e = 0; e < 2; ++e) {
                        const float cd = pre[e] * ((rg >= RG / 2) ? la[i][e] : sp[i][e]);
                        const float rc_ = __builtin_amdgcn_rcpf(cd);
                        const float qm = (rg >= RG / 2) ? cd : rc_, km = (rg >= RG / 2) ? rc_ : cd;
                        qs[e] = qv[i][e] * qm; ks[e] = kv[i][e] * km; kh[i][e] = ks[e] * h2[e]; }
                }
                if (FULL) { *(LAS unsigned*)(lds + MX_QT + (s * QP + d0) * 2) = pk2(qs[0], qs[1]); *(LAS unsigned*)(lds + MX_KT + (s * QP + d0) * 2) = pk2(ks[0], ks[1]); }
            }
            if (RPT == 8) {
                u32x4 a, bq;
                a.x = pk2(kh[0][0], kh[1][0]); a.y = pk2(kh[2][0], kh[3][0]); a.z = pk2(kh[4 % RPT][0], kh[5 % RPT][0]); a.w = pk2(kh[6 % RPT][0], kh[7 % RPT][0]);
                bq.x = pk2(kh[0][1], kh[1][1]); bq.y = pk2(kh[2][1], kh[3][1]); bq.z = pk2(kh[4 % RPT][1], kh[5 % RPT][1]); bq.w = pk2(kh[6 % RPT][1], kh[7 % RPT][1]);
                *(LAS u32x4*)(lds + MX_KHT + (d0 * 72 + rg * 8) * 2) = a; *(LAS u32x4*)(lds + MX_KHT + ((d0 + 1) * 72 + rg * 8) * 2) = bq;
            } else {
                u32x2 a, bq;
                a.x = pk2(kh[0][0], kh[1][0]); a.y = pk2(kh[2][0], kh[3][0]); bq.x = pk2(kh[0][1], kh[1][1]); bq.y = pk2(kh[2][1], kh[3][1]);
                *(LAS u32x2*)(lds + MX_KHT + (d0 * 72 + rg * 4) * 2) = a; *(LAS u32x2*)(lds + MX_KHT + ((d0 + 1) * 72 + rg * 4) * 2) = bq;
            }
        }
        __syncthreads();
        stepC:
        if (FULL && VAR != 3) {
#pragma unroll
            for (int tt = 0; tt < 2; ++tt) {
                const int tile = 2 * w + tt, ti = tile >> 2, tj = tile & 3;
                f32x4 acc = (f32x4){0.f, 0.f, 0.f, 0.f};
                if (ti <= tj) {
#pragma unroll
                    for (int kk = 0; kk < KS; ++kk) {
                        const bf16x8 a = *(const LAS bf16x8*)(lds + MX_KT + ((16 * ti + l15) * QP + kk * 32 + 8 * l4) * 2);
                        const bf16x8 bq = *(const LAS bf16x8*)(lds + MX_QT + ((16 * tj + l15) * QP + kk * 32 + 8 * l4) * 2);
                        acc = MFMA16(a, bq, acc);
                    }
                }
                const int s = 16 * tj + l15, sp0 = 16 * ti + 4 * l4;
                float pvv[4];
#pragma unroll
                for (int r = 0; r < 4; ++r) pvv[r] = (sp0 + r <= s) ? acc[r] : 0.f;
                u32x2 pw; pw.x = pk2(pvv[0], pvv[1]); pw.y = pk2(pvv[2], pvv[3]);
                *(LAS u32x2*)(lds + MX_P + (s * 72 + sp0) * 2) = pw;
            }
            {
                float er[4];
#pragma unroll
                for (int r = 0; r < 4; ++r) er[r] = (MODE == 2) ? 1.f : *(LAS float*)(lds + MX_ER + (sdt * 16 + 4 * l4 + r) * 4);
#pragma unroll
                for (int t = 0; t < NST; ++t) {
                    const int v = 16 * (svt0 + t) + l15;
                    u32x2 sw; sw.x = pk2(S[t][0] * er[0], S[t][1] * er[1]); sw.y = pk2(S[t][2] * er[2], S[t][3] * er[3]);
                    *(LAS u32x2*)(lds + MX_ST + (v * QP + sdt * 16 + 4 * l4) * 2) = sw;
                }
            }
            {
                float dec[4];
                if (MODE == 2) { const float eg = __expf(*(LAS float*)(lds + MX_GT)); dec[0] = dec[1] = dec[2] = dec[3] = eg; }
                else {
    #pragma unroll
                    for (int r = 0; r < 4; ++r) dec[r] = *(LAS float*)(lds + MX_GD + (sdt * 16 + 4 * l4 + r) * 4);
                }
                bf16x8 ka[2];
    #pragma unroll
                for (int kk = 0; kk < 2; ++kk) ka[kk] = *(const LAS bf16x8*)(lds + MX_KHT + ((16 * sdt + l15) * 72 + kk * 32 + 8 * l4) * 2);
    #pragma unroll
                for (int t = 0; t < NST; ++t) {
    #pragma unroll
                    for (int r = 0; r < 4; ++r) S[t][r] *= dec[r];
    #pragma unroll
                    for (int kk = 0; kk < 2; ++kk) {
                        const bf16x8 vb = *(const LAS bf16x8*)(lds + MX_VT + ((16 * (svt0 + t) + l15) * 72 + kk * 32 + 8 * l4) * 2);
                        S[t] = MFMA16(ka[kk], vb, S[t]);
                    }
                }
            }
            __syncthreads();
            constexpr int NOT = (MODE == 2) ? 5 : 4;
            f32x4 O[NOT];
#pragma unroll
            for (int t = 0; t < NOT; ++t) O[t] = (f32x4){0.f, 0.f, 0.f, 0.f};
#pragma unroll
            for (int kk = 0; kk < 2; ++kk) {
                const bf16x8 bq = *(const LAS bf16x8*)(lds + MX_P + ((16 * sj + l15) * 72 + kk * 32 + 8 * l4) * 2);
#pragma unroll
                for (int t = 0; t < NOT; ++t) { const int vt = (t < 4) ? (4 * ovh + t) : 8;
                    if (t < 4 || ovh == 0) { const bf16x8 a = *(const LAS bf16x8*)(lds + MX_VT + ((16 * vt + l15) * 72 + kk * 32 + 8 * l4) * 2); O[t] = MFMA16(a, bq, O[t]); } }
            }
#pragma unroll
            for (int kk = 0; kk < KS; ++kk) {
                const bf16x8 bq = *(const LAS bf16x8*)(lds + MX_QT + ((16 * sj + l15) * QP + kk * 32 + 8 * l4) * 2);
#pragma unroll
                for (int t = 0; t < NOT; ++t) { const int vt = (t < 4) ? (4 * ovh + t) : 8;
                    if (t < 4 || ovh == 0) { const bf16x8 a = *(const LAS bf16x8*)(lds + MX_ST + ((16 * vt + l15) * QP + kk * 32 + 8 * l4) * 2); O[t] = MFMA16(a, bq, O[t]); } }
            }
            const int tokr = tokc + srow;
            float scale;
            if (MODE == 2) {
                if (ovh == 0 && l4 == 0) *(LAS float*)(lds + MX_DEN + srow * 4) = O[NOT - 1][0];
                __syncthreads();
                const float den = *(LAS float*)(lds + MX_DEN + srow * 4);
                scale = 1.f / fmaxf(fabsf(den), 1.f);
            } else {
                float ss = 0.f;
#pragma unroll
                for (int t = 0; t < 4; ++t)
#pragma unroll
                    for (int r = 0; r < 4; ++r) ss += O[t][r] * O[t][r];
                ss += __shfl_xor(ss, 16); ss += __shfl_xor(ss, 32);
                if (l4 == 0) *(LAS float*)(lds + MX_RS + (ovh * 64 + srow) * 4) = ss;
                __syncthreads();
                const float tot = *(LAS float*)(lds + MX_RS + srow * 4) + *(LAS float*)(lds + MX_RS + (64 + srow) * 4);
                scale = rsqrtf(tot * (1.f / 128.f) + 1e-6f);
            }
#pragma unroll
            for (int t = 0; t < 4; ++t) {
                const int v0 = 16 * (4 * ovh + t) + 4 * l4;
                const u32x2 gt = gcur[t];
                const float g0 = bflo(gt.x), g1 = bfhi(gt.x), g2 = bflo(gt.y), g3 = bfhi(gt.y);
                float y0, y1, y2, y3;
                if (MODE == 2) { y0 = O[t][0] * scale * sigm(g0); y1 = O[t][1] * scale * sigm(g1); y2 = O[t][2] * scale * sigm(g2); y3 = O[t][3] * scale * sigm(g3); }
                else { y0 = O[t][0] * scale * gnv[t][0] * silu(g0); y1 = O[t][1] * scale * gnv[t][1] * silu(g1); y2 = O[t][2] * scale * gnv[t][2] * silu(g2); y3 = O[t][3] * scale * gnv[t][3] * silu(g3); }
                *(LAS unsigned*)(lds + MX_P + srow * 128 + ((((v0 >> 4)) ^ (srow & 7)) << 4) + (v0 & 15)) = pk4(q8(y0, Q_SY), q8(y1, Q_SY), q8(y2, Q_SY), q8(y3, Q_SY));
            }
            __syncthreads();
            { const int yr = tid >> 3, yc = tid & 7;
              const u32x4 yv = *(const LAS u32x4*)(lds + MX_P + yr * 128 + ((yc ^ (yr & 7)) << 4));
              *(u32x4*)(mp.ymix + (size_t)(tokc + yr) * DM + cy + yc * 16) = yv; }
        }
        if (!FULL || VAR == 3) {
            {
                float dec[4];
                if (MODE == 2) { const float eg = __expf(*(LAS float*)(lds + MX_GT)); dec[0] = dec[1] = dec[2] = dec[3] = eg; }
                else {
    #pragma unroll
                    for (int r = 0; r < 4; ++r) dec[r] = *(LAS float*)(lds + MX_GD + (sdt * 16 + 4 * l4 + r) * 4);
                }
                bf16x8 ka[2];
    #pragma unroll
                for (int kk = 0; kk < 2; ++kk) ka[kk] = *(const LAS bf16x8*)(lds + MX_KHT + ((16 * sdt + l15) * 72 + kk * 32 + 8 * l4) * 2);
    #pragma unroll
                for (int t = 0; t < NST; ++t) {
    #pragma unroll
                    for (int r = 0; r < 4; ++r) S[t][r] *= dec[r];
    #pragma unroll
                    for (int kk = 0; kk < 2; ++kk) {
                        const bf16x8 vb = *(const LAS bf16x8*)(lds + MX_VT + ((16 * (svt0 + t) + l15) * 72 + kk * 32 + 8 * l4) * 2);
                        S[t] = MFMA16(ka[kk], vb, S[t]);
                    }
                }
            }
        __syncthreads();
        }
    }
#undef MX_LOAD
    if (VAR == 2) { mp.ust[(size_t)bid * 512 + tid] = gacc[0]; return; }
    if (!FULL) {
        float* U = mp.ust + ((size_t)bid * 8 + w) * (9 * 4 * 64);
#pragma unroll
        for (int t = 0; t < NST; ++t)
#pragma unroll
            for (int r = 0; r < 4; ++r) U[(t * 4 + r) * 64 + lane] = S[t][r];
        if (MODE == 2) { if (tid == 0) mp.gsum[(size_t)bid * 128] = gacc[0]; }
        else if (rg == 0) { mp.gsum[(size_t)bid * 128 + d0] = gacc[0]; mp.gsum[(size_t)bid * 128 + d0 + 1] = gacc[1]; }
    }
}

#ifndef PHMASK
#define PHMASK 0xFFFFu
#endif
#ifndef MIXSEL
#define MIXSEL 7
#endif
#ifndef REPMASK
#define REPMASK 0x0u
#endif
#define EN(j) (((PHMASK) >> (j)) & 1u)
#ifndef REPLAYER
#define REPLAYER 3
#endif
#define NREP(j) (1 + (int)((((REPMASK) >> (j)) & 1u) & (((REPLAYER) >> layer) & 1u)))
#define IN(k) (lo <= (k) && (k) < hi)
#define SEAM(k) do { if (IN((k) + 1)) xcd_barrier(bar); } while (0)

template <int layer> __device__ __forceinline__ void ph_proj(LAS unsigned char* lds, unsigned char* ws, int bid, int nb) {
    pg8::Gemm g{(const bf16_t*)(ws + (layer ? WS_H2Q : WS_XQ)), (const bf16_t*)(ws + (layer ? WS_WC : WS_WAB)), DM / 2};
    pg8::StaticOrder S; S.init(NTOK, layer ? CWID : ABW, nb, bid);
    pg8::EpiStoreBf16<true> E{(bf16_t*)(ws + WS_PROJ), layer ? CWID : ABW};
    pg8::gemm_phase<pg8::EpiStoreBf16<true>, pg8::StaticOrder, false, true>(lds, g, nullptr, S, E);
}
template <int layer> __device__ __forceinline__ void ph_outproj(LAS unsigned char* lds, unsigned char* ws, int bid, int nb) {
    pg8::Gemm g{(const bf16_t*)(ws + WS_YMIX), (const bf16_t*)(ws + (layer ? WS_WOC : WS_WOAB)), DM / 2};
    pg8::StaticOrder S; S.init(NTOK, DM, nb, bid);
    pg8::EpiResid E{(bf16_t*)(ws + WS_Z), (const bf16_t*)(ws + (layer ? WS_H2 : WS_HB))};
    pg8::gemm_phase<pg8::EpiResid, pg8::StaticOrder, false, true>(lds, g, nullptr, S, E);
}
template <int layer> __device__ __forceinline__ void ph_router(LAS unsigned char* lds, unsigned char* ws, int bid, int nb) {
    pg8::Gemm g{(const bf16_t*)(ws + WS_H1), (const bf16_t*)(ws + WS_WR) + (size_t)layer * 256 * 1024, DM};
    pg8::StaticOrder S; S.init(NTOK, 256, nb, bid);
    pg8::EpiF32 E{(float*)(ws + WS_LOGITS)};
    pg8::gemm_phase<pg8::EpiF32, pg8::StaticOrder, false>(lds, g, nullptr, S, E);
}
template <int layer> __device__ __forceinline__ void ph_gemm1(LAS unsigned char* lds, unsigned char* ws, int bid, int nb) {
    const int vcu = (nb % 8 == 0) ? (bid % 8) * (nb / 8) + bid / 8 : bid;
    const int nt = __builtin_amdgcn_readfirstlane(*(volatile int*)(ws + WS_MISC + 65536 + 8192));
    pg8::Gemm g{(const bf16_t*)(ws + WS_H1Q), (const bf16_t*)(ws + WS_W1T + (size_t)layer * NE1 * 512 * 1024), DM / 2};
    const int nu = pg8::moe_prep(lds, (const int*)(ws + WS_MISC + 65536), nt * 2, 1, nb, vcu, (const int*)(ws + WS_STOK));
    pg8::MoeOrder S{(const LAS int*)(lds + pg8::LDS_UT), nu < pg8::MOE_MAXU ? nu : pg8::MOE_MAXU};
    pg8::EpiSwiGLU<true> E{ws + WS_ACT, lds + 3 * pg8::HTB};
    pg8::gemm_phase<pg8::EpiSwiGLU<true>, pg8::MoeOrder, true, true>(lds, g, (const LAS int*)(lds + pg8::LDS_IDX), S, E);
}
template <int layer> __device__ __forceinline__ void ph_gemm2(LAS unsigned char* lds, unsigned char* ws, int bid, int nb) {
    const int vcu = (nb % 8 == 0) ? (bid % 8) * (nb / 8) + bid / 8 : bid;
    const int nt = __builtin_amdgcn_readfirstlane(*(volatile int*)(ws + WS_MISC + 65536 + 8192));
    int kq = 128; asm volatile("" : "+s"(kq));
    pg8::Gemm g{(const bf16_t*)(ws + WS_ACT), (const bf16_t*)(ws + WS_W2T + (size_t)layer * NE1 * 1024 * 256), kq};
    const int nu = pg8::moe_prep(lds, (const int*)(ws + WS_MISC + 65536), nt * 4, 2, nb, vcu, nullptr);
    pg8::MoeOrder S{(const LAS int*)(lds + pg8::LDS_UT), nu};
    pg8::EpiDown E{(unsigned char*)(ws + WS_Y), lds + 3 * pg8::HTB};
    pg8::gemm_phase<pg8::EpiDown, pg8::MoeOrder, false, true>(lds, g, nullptr, S, E);
}
template <int layer, bool FULLP> __device__ __forceinline__ void ph_mixer(LAS unsigned char* lds, const Args& A, int bid, int nb) {
    unsigned char* ws = A.ws;
    if (nb != NWG) return;
    MixP mp{(const bf16_t*)(ws + WS_PROJ), layer ? CWID : ABW, 0, ws + WS_YMIX, (const float*)(ws + WS_GATES), (const float*)(ws + WS_MISC), A.in[I_BGK], A.in[I_HG], A.in[I_GG], A.in[I_CONV], A.in[I_BIF], (float*)(ws + WS_UST), (float*)(ws + WS_GSUM)};
    if (layer == 0) { if (bid < 128) { if (MIXSEL & 1) mixer_run<0, FULLP>(lds, mp, bid); } else { if (MIXSEL & 2) mixer_run<1, FULLP>(lds, mp, bid); } }
    else { if (MIXSEL & 4) mixer_run<2, FULLP>(lds, mp, bid); }
}
#define REP2(j, call) do { call; if (NREP(j) == 2) { __syncthreads(); call; } } while (0)

template <int layer>
__device__ __forceinline__ void run_layer(LAS unsigned char* lds, const Args& A, const XcdBarrier& bar, const int lo, const int hi) {
    const int bid = blockIdx.x, nb = gridDim.x;
    unsigned char* ws = A.ws;
    unsigned* ctl = (unsigned*)(ws + WS_CTL);
    constexpr int P = 1 + layer * 11;
    if (EN(0) && IN(P + 0)) {
        if (bid & 1) convert_experts(lds, A, layer, bid, nb, layer ? 8 : 0, layer ? 13 : 6);
        REP2(0, ph_proj<layer>(lds, ws, bid, nb));
        if (!(bid & 1)) convert_experts(lds, A, layer, bid, nb, layer ? 8 : 0, layer ? 13 : 6);
        SEAM(P + 0); }
    if (EN(1) && IN(P + 1)) { REP2(1, (ph_mixer<layer, false>(lds, A, bid, nb))); SEAM(P + 1); }
    if (EN(2) && IN(P + 2)) { REP2(2, (ph_mixer<layer, true>(lds, A, bid, nb)));
        if (layer == 0 && bid >= 128) { __syncthreads(); convert_experts(lds, A, 0, bid, nb, 13, 16); convert_experts(lds, A, 0, bid - 128, nb, 13, 16); }
        SEAM(P + 2); }
    if (EN(3) && IN(P + 3)) {
        if (layer == 0 && (bid & 1)) convert_experts(lds, A, 0, bid, nb, 6, 10);
        REP2(3, ph_outproj<layer>(lds, ws, bid, nb));
        if (layer == 0 && !(bid & 1)) convert_experts(lds, A, 0, bid, nb, 6, 10);
        SEAM(P + 3); }
    if (EN(4) && IN(P + 4)) { REP2(4, phase_ln((const bf16_t*)(ws + WS_Z), (bf16_t*)(ws + WS_H1), ws + WS_H1Q, A.in[I_LMG] + layer * DM, A.in[I_LMB] + layer * DM, bid, nb)); SEAM(P + 4); }
    if (EN(5) && IN(P + 5)) {
        if (bid & 1) { convert_experts(lds, A, layer, bid, nb, layer ? 13 : 10, layer ? 16 : 13); convert_experts(lds, A, layer, bid - 1, nb, layer ? 13 : 10, layer ? 16 : 13); }
        else ph_router<layer>(lds, ws, bid >> 1, nb >> 1);
        SEAM(P + 5); }
    if (EN(6) && IN(P + 6)) {
        phase_select<false>(lds, (const float*)(ws + WS_LOGITS), A.in[I_RB] + layer * NEXP, (int*)(ws + WS_TOKE), (int*)(ws + WS_TOKP), (float*)(ws + WS_TOKW), ctl + CW_CNT + layer * 256, bid, nb);
        if (NREP(6) == 2) phase_select<true>(lds, (const float*)(ws + WS_LOGITS), A.in[I_RB] + layer * NEXP, (int*)(ws + WS_TOKE), (int*)(ws + WS_TOKP), (float*)(ws + WS_TOKW), ctl + CW_CNT + layer * 256, bid, nb);
        SEAM(P + 6); }
    if (EN(7) && IN(P + 7)) { REP2(7, phase_dispatch(lds, ctl + CW_CNT + layer * 256, (const int*)(ws + WS_TOKE), (const int*)(ws + WS_TOKP), (int*)(ws + WS_STOK), (int*)(ws + WS_POSY), (int*)(ws + WS_MISC + 65536), (int*)(ws + WS_MISC + 65536 + 8192), bid, nb)); SEAM(P + 7); }
    if (EN(8) && IN(P + 8)) {
        if (layer == 0 && (bid & 1)) convert_experts(lds, A, 1, bid, nb, 0, 8);
        REP2(8, ph_gemm1<layer>(lds, ws, bid, nb));
        if (layer == 0 && !(bid & 1)) convert_experts(lds, A, 1, bid, nb, 0, 8);
        SEAM(P + 8); }
    if (EN(9) && IN(P + 9)) { REP2(9, ph_gemm2<layer>(lds, ws, bid, nb)); SEAM(P + 9); }
    if (EN(10) && IN(P + 10)) {
        if (layer == 0) REP2(10, (phase_combine<false>((const unsigned char*)(ws + WS_Y), (const int*)(ws + WS_POSY), (const float*)(ws + WS_TOKW), (const int*)(ws + WS_MISC + 65536 + 8192), (const bf16_t*)(ws + WS_H1), (bf16_t*)(ws + WS_H2), ws + WS_H2Q, nullptr, (float*)(ws + WS_GATES), (const float*)(ws + WS_MISC + 4096), A.in[I_LFG], A.in[I_LFB], bid, nb)));
        else REP2(10, (phase_combine<true>((const unsigned char*)(ws + WS_Y), (const int*)(ws + WS_POSY), (const float*)(ws + WS_TOKW), (const int*)(ws + WS_MISC + 65536 + 8192), (const bf16_t*)(ws + WS_H1), nullptr, nullptr, A.out, nullptr, nullptr, A.in[I_LFG] + DM, A.in[I_LFB] + DM, bid, nb)));
        SEAM(P + 10);
    }
}

__global__ void __launch_bounds__(512, 2) fwd_kernel(Args A) {
    extern __shared__ __attribute__((aligned(16))) unsigned char lds_raw[];
    LAS unsigned char* lds = (LAS unsigned char*)lds_raw;
    const int tid = threadIdx.x;
    unsigned* ctl = (unsigned*)(A.ws + WS_CTL);
    volatile LAS unsigned* misc = (volatile LAS unsigned*)(lds + LDS_MISC);
    if (tid < 64) misc[tid] = 0u;
    __syncthreads();
    const int lo = A.ph_lo, hi = A.ph_hi;
    XcdBarrier bar; bar.bar = ctl + CW_BAR; bar.x = 0; bar.st = misc;
    if (hi - lo > 1) bar = xcd_barrier_post(ctl + CW_BAR, misc);
    if (EN(11) && IN(0)) { for (int rep_ = 0; rep_ < 1 + (int)(((REPMASK) >> 11) & 1u); ++rep_) phase_prologue(lds, A, blockIdx.x, gridDim.x); SEAM(0); }
    run_layer<0>(lds, A, bar, lo, hi);
    run_layer<1>(lds, A, bar, lo, hi);
}
#undef IN
#undef SEAM

extern "C" void kernel_launch(void* const* d_in, const int* in_sizes, int n_in, void* d_out, int out_size, void* d_ws, size_t ws_size, hipStream_t stream) {
    static int grid = 0;
    if (grid == 0) {
        if (n_in != 22 || out_size != NTOK * DM || ws_size < WS_END) { fprintf(stderr, "kernel_launch: unexpected shapes (n_in %d out %d ws %zu)\n", n_in, out_size, ws_size); grid = -1; return; }
        if (hipFuncSetAttribute((const void*)fwd_kernel, hipFuncAttributeMaxDynamicSharedMemorySize, LDS_BYTES) != hipSuccess) { fprintf(stderr, "kernel_launch: hipFuncSetAttribute failed\n"); grid = -1; return; }
        int per_cu = 0;
        if (hipOccupancyMaxActiveBlocksPerMultiprocessor(&per_cu, (const void*)fwd_kernel, 512, LDS_BYTES) != hipSuccess || per_cu < 1) fprintf(stderr, "kernel_launch: occupancy query says %d\n", per_cu);
        (void)hipGetLastError();
        grid = NWG;
    }
    if (grid < 0) return;
    (void)hipMemsetAsync((char*)d_ws + WS_CTL, 0, CTL_BYTES, stream);
    Args a{};
    for (int i = 0; i < 22; ++i) a.in[i] = (const float*)d_in[i];
    a.out = (float*)d_out; a.ws = (unsigned char*)d_ws;
#if MK_ONE_LAUNCH
    a.ph_lo = 0; a.ph_hi = 23;
    hipLaunchKernelGGL(fwd_kernel, dim3(grid), dim3(512), LDS_BYTES, stream, a);
#else
    for (int p = 0; p < 23; ++p) { a.ph_lo = p; a.ph_hi = p + 1; hipLaunchKernelGGL(fwd_kernel, dim3(grid), dim3(512), LDS_BYTES, stream, a);
    }
#endif
}
```

```cpp
#include <hip/hip_runtime.h>
#include <cstdio>
#include <cstdint>

#ifndef MK_ONE_LAUNCH
#define MK_ONE_LAUNCH 1
#endif

#define LAS __attribute__((address_space(3)))
typedef unsigned short bf16_t;
typedef short bf16x8 __attribute__((ext_vector_type(8)));
typedef float f32x4 __attribute__((ext_vector_type(4)));
typedef unsigned u32x4 __attribute__((ext_vector_type(4)));
typedef unsigned u32x2 __attribute__((ext_vector_type(2)));

constexpr int NTOK = 32768, SEQ = 16384, DM = 1024;
constexpr int ABW = 3840;
constexpr int CWID = 3072;
constexpr int NEXP = 256, NE1 = 257, TOPK = 8, NSLOT = 9;
constexpr float ALPHA = 1.41421356237f;
constexpr int NWG = 256;
constexpr int PRMAX = 262144 + 65536 + 32768;

constexpr size_t MiB = 1u << 20;
constexpr size_t WS_CTL = 0, CTL_BYTES = 1 * MiB;
constexpr size_t WS_MISC = 1 * MiB;
constexpr size_t WS_WAB = 2 * MiB, WS_WOAB = 10 * MiB, WS_WC = 12 * MiB, WS_WOC = 18 * MiB, WS_WR = 20 * MiB;
constexpr size_t WS_TOKE = 22 * MiB, WS_TOKP = 23 * MiB, WS_TOKW = 24 * MiB;
constexpr size_t WS_STOK = 26 * MiB, WS_SDST = 28 * MiB;
constexpr int YTRASH = NTOK * NSLOT;
constexpr size_t WS_GATES = 32 * MiB;
constexpr size_t WS_UST = 34 * MiB, WS_GSUM = 54 * MiB;
constexpr size_t WS_LOGITS = 56 * MiB;
constexpr size_t WS_HB = 96 * MiB, WS_PROJ = 160 * MiB, WS_YMIX = 400 * MiB, WS_Z = 464 * MiB, WS_H1 = 528 * MiB, WS_H2 = 592 * MiB;
constexpr size_t WS_ACT = 656 * MiB, WS_Y = 832 * MiB, WS_W1T = 1540 * MiB, WS_W2T = 2056 * MiB;
constexpr size_t WS_XQ = 2320 * MiB, WS_H1Q = 2352 * MiB, WS_H2Q = 2384 * MiB, WS_END = 2416 * MiB;
constexpr float Q_SA = 127.f / 5.5f, Q_SW = 127.f * 32.f / 5.5f, Q_DEQ = 1.f / (Q_SA * Q_SW);
constexpr float Q_SY = 127.f / 8.f, Q_SWO = 127.f * 64.f / 5.5f, Q_DEQO = 1.f / (Q_SY * Q_SWO);
constexpr float Q_SACT = 127.f / 8.f, Q_DEQ2 = 16.f / (Q_SACT * Q_SW);
constexpr int CW_BAR = 4096;
constexpr int CW_CNT = 16384;

__device__ __forceinline__ unsigned pk2(float lo, float hi) { unsigned r; asm volatile("v_cvt_pk_bf16_f32 %0, %1, %2" : "=v"(r) : "v"(lo), "v"(hi)); return r; }
__device__ __forceinline__ float bflo(unsigned u) { return __uint_as_float(u << 16); }
__device__ __forceinline__ float bfhi(unsigned u) { return __uint_as_float(u & 0xffff0000u); }
__device__ __forceinline__ float bf2f(bf16_t b) { return __uint_as_float(((unsigned)b) << 16); }
__device__ __forceinline__ float sigm(float x) { return __builtin_amdgcn_rcpf(1.f + __expf(-x)); }
__device__ __forceinline__ float silu(float x) { return x * __builtin_amdgcn_rcpf(1.f + __expf(-x)); }
__device__ __forceinline__ int q8(float x, float sc) { return (int)rintf(fminf(fmaxf(x * sc, -127.f), 127.f)); }
__device__ __forceinline__ unsigned pk4(int a, int b, int c, int d) { return (unsigned)(a & 255) | ((unsigned)(b & 255) << 8) | ((unsigned)(c & 255) << 16) | ((unsigned)d << 24); }
__device__ __forceinline__ float logsig(float x) { return fminf(x, 0.f) - __logf(1.f + __expf(-fabsf(x))); }

#define XB_TMO      128
#define XB_XCNT(j)  (256  + 64 * (j))
#define XB_XSUB(j)  (1280 + 64 * (j))
#define XB_XGEN(j)  (2304 + 64 * (j))
#define XB_TOP      3328
#define XB_TOPGEN   3392
#define XCD_BAR_WORDS 3456
#define XB_SPIN_CAP (1u << 22)
__device__ __forceinline__ unsigned xb_ld(unsigned* p)              { return __hip_atomic_load(p, __ATOMIC_RELAXED, __HIP_MEMORY_SCOPE_AGENT); }
__device__ __forceinline__ unsigned xb_add(unsigned* p, unsigned v) { return __hip_atomic_fetch_add(p, v, __ATOMIC_RELAXED, __HIP_MEMORY_SCOPE_AGENT); }
__device__ __forceinline__ unsigned xb_xcc_id() { return (unsigned)__builtin_amdgcn_s_getreg((3 << 11) | 20) & 0xFu; }
#define XB_SPIN(cond, bar) do { unsigned _sp = 0; while (cond) { __builtin_amdgcn_s_sleep(1); \
    if ((++_sp & 255u) == 0u) { if (xb_ld(&(bar)[XB_TMO])) break; if (_sp > XB_SPIN_CAP) { atomicAdd(&(bar)[XB_TMO], 1u); break; } } } } while (0)
struct XcdBarrier { unsigned* bar; unsigned x; volatile LAS unsigned* st; };
__device__ __forceinline__ XcdBarrier xcd_barrier_post(unsigned* bar, volatile LAS unsigned* st) {
    XcdBarrier b; b.bar = bar; b.x = xb_xcc_id(); b.st = st;
    if (threadIdx.x == 0) (void)xb_add(&bar[XB_XCNT(b.x)], 1u);
    return b;
}
__device__ __forceinline__ void xcd_barrier_complete(unsigned* bar, unsigned x, unsigned& nloc, unsigned& nx) {
    const unsigned G = gridDim.x * gridDim.y * gridDim.z;
    unsigned sum, cnt, mine, sp = 0u;
    for (;;) {
        sum = 0u; cnt = 0u; mine = 0u;
#pragma unroll
        for (unsigned j = 0; j < 16; ++j) { const unsigned c = xb_ld(&bar[XB_XCNT(j)]); sum += c; cnt += (c > 0u) ? 1u : 0u; mine = (j == x) ? c : mine; }
        if (sum == G) break;
        __builtin_amdgcn_s_sleep(1);
        if ((++sp & 255u) == 0u) { if (xb_ld(&bar[XB_TMO])) break; if (sp > XB_SPIN_CAP) { atomicAdd(&bar[XB_TMO], 1u); break; } }
    }
    nloc = mine > 0u ? mine : 1u; nx = cnt > 0u ? cnt : 1u;
}
__device__ __forceinline__ void xcd_barrier(const XcdBarrier& b) {
    asm volatile("s_waitcnt vmcnt(0)" ::: "memory");
    __syncthreads();
    if (threadIdx.x == 0) {
        unsigned* bar = b.bar;
        __builtin_amdgcn_s_waitcnt(0);
        unsigned nloc = b.st[0], nx = b.st[1];
        if (nloc == 0u) { xcd_barrier_complete(bar, b.x, nloc, nx); b.st[0] = nloc; b.st[1] = nx; }
        const unsigned old = xb_add(&bar[XB_XSUB(b.x)], 1u);
        const unsigned gen = old / nloc;
        if (old + 1u == (gen + 1u) * nloc) {
            __builtin_amdgcn_fence(__ATOMIC_RELEASE, "agent");
            asm volatile("s_waitcnt vmcnt(0)" ::: "memory");
            const unsigned og = xb_add(&bar[XB_TOP], 1u);
            const unsigned tg = og / nx;
            if (og + 1u == (tg + 1u) * nx) xb_add(&bar[XB_TOPGEN], 1u);
            else XB_SPIN(xb_ld(&bar[XB_TOPGEN]) == tg, bar);
            __builtin_amdgcn_fence(__ATOMIC_ACQUIRE, "agent");
            xb_add(&bar[XB_XGEN(b.x)], 1u);
            asm volatile("s_waitcnt vmcnt(0)" ::: "memory");
        } else {
            XB_SPIN(xb_ld(&bar[XB_XGEN(b.x)]) == gen, bar);
            __builtin_amdgcn_fence(__ATOMIC_ACQUIRE, "agent");
            asm volatile("s_waitcnt vmcnt(0)" ::: "memory");
        }
    }
    __syncthreads();
}

namespace pg8 {
constexpr int BM = 256, BK = 64, HALF = 128, HTB = HALF * BK * 2, STAGE_BYTES = 8 * HTB, NXCD = 8, WGM = 8;
__device__ __forceinline__ int lds_byte(int r, int c) { const int st = (r >> 4) * 2 + (c >> 5), rr = r & 15, cc = c & 31, ob = rr * 64 + cc * 2; return st * 1024 + (ob ^ (((ob >> 9) & 1) << 5)); }
__device__ __forceinline__ void stage_rc(int b, int& R, int& C) { const int st = b / 1024, sb = b % 1024, swz = sb ^ (((sb >> 9) & 1) << 5); R = (st >> 1) * 16 + swz / 64; C = (st & 1) * 32 + (swz % 64) / 2; }
__device__ __forceinline__ int perm32(int rho) { const int n = rho >> 4, i = rho & 15; return 8 * (i >> 2) + 4 * n + (i & 3); }
struct Unit { int pm, pn, slot; };
struct Gemm { const bf16_t* A; const bf16_t* Bt; int K; const int* dstrow = nullptr; };
constexpr int LDS_DST = 131072 + 512;

struct StaticOrder {
    int nM, nN, nwg, G, c;
    __device__ void init(int M, int N, int G_, int c_) { nM = M / BM; nN = N / BM; nwg = nM * nN; G = G_; c = c_; }
    __device__ bool next(int i, Unit& u) const {
        const long L = (long)i * G + c; if (L >= nwg) return false;
        int wgid = (int)L; { const int q = nwg / NXCD, r = nwg % NXCD, xcd = wgid % NXCD, off = wgid / NXCD; wgid = (xcd < r ? xcd * (q + 1) : r * (q + 1) + (xcd - r) * q) + off; }
        const int nig = WGM * nN, gid = wgid / nig, fm = gid * WGM, gsz = (nM - fm) < WGM ? (nM - fm) : WGM;
        u.pm = fm + ((wgid % nig) % gsz); u.pn = (wgid % nig) / gsz; return true;
    }
};
struct MoeOrder {
    const LAS int* tab; int n;
    __device__ bool next(int i, Unit& u) const {
        if (i >= n) return false;
        u.pm = __builtin_amdgcn_readfirstlane(tab[2 * i]); u.pn = __builtin_amdgcn_readfirstlane(tab[2 * i + 1]); return true;
    }
};
constexpr int LDS_UT = 131072, LDS_IDX = 131072 + 512, MOE_MAXU = 15;
__device__ __forceinline__ int moe_prep(LAS unsigned char* lds, const int* __restrict__ tile_exp, int nunits, int sh, int G, int c, const int* __restrict__ rowidx) {
    const int tid = threadIdx.x;
    LAS int* tab = (LAS int*)(lds + LDS_UT);
    int n = 0; { const long rem = (long)nunits - c; n = rem > 0 ? (int)((rem + G - 1) / G) : 0; if (n > 32) n = 32; }
    if (tid < n) { const long L = (long)tid * G + c; const int rt = (int)(L >> sh), j = (int)L & ((1 << sh) - 1); tab[2 * tid] = rt; tab[2 * tid + 1] = (tile_exp[rt] << sh) + j; }
    __syncthreads();
    if (rowidx) { LAS int* idx = (LAS int*)(lds + LDS_IDX); const int nn = n < MOE_MAXU ? n : MOE_MAXU;
        for (int x = tid; x < nn * 256; x += 512) idx[x] = rowidx[tab[2 * (x >> 8)] * 256 + (x & 255)];
        __syncthreads(); }
    return n;
}

typedef int i32x4 __attribute__((ext_vector_type(4)));
template <class Epi, class Sched, bool GATHER, bool I8 = false>
__device__ __forceinline__ void gemm_phase(LAS unsigned char* lds, const Gemm g, const LAS int* rowidx, const Sched& S, const Epi& E) {
    const int tid = threadIdx.x, wid = __builtin_amdgcn_readfirstlane(tid >> 6), lane = tid & 63, wr = wid >> 2, wc = wid & 3, fr = lane & 15, fq = lane >> 4;
    const int K = g.K, nt = K / BK;
    unsigned voffB[2], cofs[2]; int Rr[2];
#pragma unroll
    for (int i = 0; i < 2; ++i) { int R, C; stage_rc(tid * 16 + i * 8192, R, C); const int Rb = Epi::PERM ? ((R & ~31) + perm32(R & 31)) : R;
        Rr[i] = R; cofs[i] = (unsigned)C * 2u; voffB[i] = (unsigned)(Rb * K + C) * 2u; }
    const unsigned rowb = (unsigned)K * 2u;
    const size_t kstep = (size_t)(BK * 2);
    const size_t hstep = (size_t)HALF * K * 2;
    const size_t tstep = 2 * hstep;
    const unsigned ldsw = (unsigned)wid * 1024u;
    const int aoff = lds_byte(wr * 64 + fr, fq * 8), boff = lds_byte(wc * 32 + fr, fq * 8);
    const char* Abase = (const char*)g.A;
#define PG8_SA(b, h) (((b) * 2 + (h)) * HTB)
#define PG8_SB(b, h) ((4 + (b) * 2 + (h)) * HTB)
#define PG8_STAGE(bufoff, gbase, voff) do { _Pragma("unroll") for (int _i = 0; _i < 2; ++_i) \
        __builtin_amdgcn_global_load_lds((const unsigned*)((const char*)(gbase) + (voff)[_i]), (LAS unsigned*)(lds + (bufoff) + ldsw + _i * 8192), 16, 0, 0); } while (0)
#define PG8_STAGEA(bufoff, kb, offs) do { _Pragma("unroll") for (int _i = 0; _i < 2; ++_i) \
        __builtin_amdgcn_global_load_lds((const unsigned*)(Abase + (size_t)((kb) + (offs)[_i])), (LAS unsigned*)(lds + (bufoff) + ldsw + _i * 8192), 16, 0, 0); } while (0)
#define PG8_ROWOFF(u, uo, O) do { _Pragma("unroll") for (int _h = 0; _h < 2; ++_h) _Pragma("unroll") for (int _i = 0; _i < 2; ++_i) { \
        int _row = (u).pm * BM + _h * HALF + Rr[_i]; if (GATHER) _row = rowidx[(uo) * 256 + _h * HALF + Rr[_i]]; (O)[_h][_i] = (unsigned)_row * rowb + cofs[_i]; } } while (0)
#define PG8_LDA(dst, b, h) do { _Pragma("unroll") for (int m = 0; m < 4; ++m) _Pragma("unroll") for (int k = 0; k < 2; ++k) dst[m][k] = *(const LAS bf16x8*)(lds + PG8_SA(b, h) + aoff + m * 2048 + k * 1024); } while (0)
#define PG8_LDB(dst, b, h) do { _Pragma("unroll") for (int n = 0; n < 2; ++n) _Pragma("unroll") for (int k = 0; k < 2; ++k) dst[n][k] = *(const LAS bf16x8*)(lds + PG8_SB(b, h) + boff + n * 2048 + k * 1024); } while (0)
#define PG8_MMA(ai, bj, At, Bt) do { __builtin_amdgcn_s_setprio(1); _Pragma("unroll") for (int m = 0; m < 4; ++m) _Pragma("unroll") for (int n = 0; n < 2; ++n) _Pragma("unroll") for (int k = 0; k < 2; ++k) \
        { if (I8) acc[ai][bj][m][n] = __builtin_bit_cast(f32x4, __builtin_amdgcn_mfma_i32_16x16x64_i8(__builtin_bit_cast(i32x4, Bt[n][k]), __builtin_bit_cast(i32x4, At[m][k]), __builtin_bit_cast(i32x4, acc[ai][bj][m][n]), 0, 0, 0)); \
          else acc[ai][bj][m][n] = __builtin_amdgcn_mfma_f32_16x16x32_bf16(Bt[n][k], At[m][k], acc[ai][bj][m][n], 0, 0, 0); } __builtin_amdgcn_s_setprio(0); } while (0)
#define PG8_WAIT_V(n) asm volatile("s_waitcnt vmcnt(" #n ")" ::: "memory")
#define PG8_WAIT_L(n) asm volatile("s_waitcnt lgkmcnt(" #n ")" ::: "memory")
#define PG8_BAR __builtin_amdgcn_s_barrier()
#define PG8_SCHED __builtin_amdgcn_sched_barrier(0)
    Unit cur, nxt; int ui = 0;
    if (!S.next(0, cur)) return;
    cur.slot = 0;
#define PG8_DSTDMA(u, sl) do { if (g.dstrow && wid < 4) __builtin_amdgcn_global_load_lds((const unsigned*)(g.dstrow + (size_t)(u).pm * BM + wid * 64 + lane), (LAS unsigned*)(lds + LDS_DST + (sl) * 1024 + wid * 256), 4, 0, 0); } while (0)
    PG8_DSTDMA(cur, 0);
    f32x4 acc[2][2][4][2];
#pragma unroll
    for (int a = 0; a < 2; ++a)
#pragma unroll
        for (int b = 0; b < 2; ++b)
#pragma unroll
            for (int m = 0; m < 4; ++m)
#pragma unroll
                for (int n = 0; n < 2; ++n) acc[a][b][m][n] = (f32x4){0.f, 0.f, 0.f, 0.f};
    bf16x8 At[4][2], B0[2][2], B1[2][2];
    unsigned cO[2][2], nO[2][2];
    PG8_ROWOFF(cur, 0, cO);
    const char* cB = (const char*)g.Bt + (size_t)cur.pn * tstep;
    PG8_STAGE(PG8_SB(0, 0), cB, voffB); PG8_STAGE(PG8_SB(0, 1), cB + hstep, voffB); PG8_STAGEA(PG8_SA(0, 0), 0u, cO[0]); PG8_STAGEA(PG8_SA(0, 1), 0u, cO[1]);
    if (wr == 1) PG8_BAR;
    PG8_WAIT_V(2); PG8_BAR;
    PG8_STAGE(PG8_SB(1, 0), cB + kstep, voffB); PG8_STAGEA(PG8_SA(1, 0), (unsigned)kstep, cO[0]); PG8_STAGE(PG8_SB(1, 1), cB + hstep + kstep, voffB);
    PG8_WAIT_V(6); PG8_BAR;
    for (;;) {
        const bool has_next = S.next(ui + 1, nxt);
        nxt.slot = (ui + 1) & 1;
        if (has_next) PG8_DSTDMA(nxt, nxt.slot);
        const char* nB = has_next ? (const char*)g.Bt + (size_t)nxt.pn * tstep : cB;
#pragma unroll
        for (int h = 0; h < 2; ++h)
#pragma unroll
            for (int i = 0; i < 2; ++i) nO[h][i] = cO[h][i];
#pragma unroll 1
        for (int t = 0; t < nt; t += 2) {
            const bool last = (t == nt - 2);
            if (last && has_next) PG8_ROWOFF(nxt, ui + 1, nO);
            const unsigned k1 = (unsigned)(t + 1) * (unsigned)kstep;
            const unsigned k2 = last ? 0u : (unsigned)(t + 2) * (unsigned)kstep, k3 = k2 + (unsigned)kstep;
            const char* b2 = last ? nB : cB + (size_t)(t + 2) * kstep; const char* b3 = b2 + kstep;
            unsigned o2[2][2];
#pragma unroll
            for (int h = 0; h < 2; ++h)
#pragma unroll
                for (int i = 0; i < 2; ++i) o2[h][i] = last ? nO[h][i] : cO[h][i];
            PG8_LDB(B0, 0, 0); PG8_LDB(B1, 0, 1); PG8_SCHED; PG8_LDA(At, 0, 0); PG8_STAGEA(PG8_SA(1, 1), k1, cO[1]);
            PG8_WAIT_V(8); PG8_WAIT_L(0); PG8_BAR; PG8_MMA(0, 0, At, B0); PG8_MMA(0, 1, At, B1); PG8_BAR; PG8_SCHED;
            PG8_LDA(At, 0, 1); PG8_STAGE(PG8_SB(0, 0), b2, voffB); PG8_STAGE(PG8_SB(0, 1), b2 + hstep, voffB); PG8_STAGEA(PG8_SA(0, 0), k2, o2[0]);
            PG8_WAIT_V(8); PG8_WAIT_L(0); PG8_BAR; PG8_MMA(1, 0, At, B0); PG8_MMA(1, 1, At, B1); PG8_BAR; PG8_SCHED;
            PG8_LDB(B0, 1, 0); PG8_LDB(B1, 1, 1); PG8_SCHED; PG8_LDA(At, 1, 0); PG8_STAGEA(PG8_SA(0, 1), k2, o2[1]);
            PG8_WAIT_V(8); PG8_WAIT_L(0); PG8_BAR; PG8_MMA(0, 0, At, B0); PG8_MMA(0, 1, At, B1); PG8_BAR; PG8_SCHED;
            PG8_LDA(At, 1, 1); PG8_STAGE(PG8_SB(1, 0), b3, voffB); PG8_STAGE(PG8_SB(1, 1), b3 + hstep, voffB); PG8_STAGEA(PG8_SA(1, 0), k3, o2[0]);
            PG8_WAIT_V(8); PG8_WAIT_L(0); PG8_BAR; PG8_MMA(1, 0, At, B0); PG8_MMA(1, 1, At, B1); PG8_BAR; PG8_SCHED;
        }
        if (wr == 0) PG8_BAR;
        E(acc, cur, wr, wc, fr, fq);
        if (!has_next) break;
#pragma unroll
        for (int a = 0; a < 2; ++a)
#pragma unroll
            for (int b = 0; b < 2; ++b)
#pragma unroll
                for (int m = 0; m < 4; ++m)
#pragma unroll
                    for (int n = 0; n < 2; ++n) acc[a][b][m][n] = (f32x4){0.f, 0.f, 0.f, 0.f};
        cur = nxt; cB = nB; ++ui;
#pragma unroll
        for (int h = 0; h < 2; ++h)
#pragma unroll
            for (int i = 0; i < 2; ++i) cO[h][i] = nO[h][i];
        if (wr == 1) PG8_BAR;
    }
    PG8_WAIT_V(0);
    PG8_BAR;
#undef PG8_DSTDMA
#undef PG8_SA
#undef PG8_SB
#undef PG8_STAGE
#undef PG8_STAGEA
#undef PG8_ROWOFF
#undef PG8_LDA
#undef PG8_LDB
#undef PG8_MMA
#undef PG8_WAIT_V
#undef PG8_WAIT_L
#undef PG8_BAR
#undef PG8_SCHED
}

template <bool I8> struct EpiStoreBf16 {
    static constexpr bool PERM = true;
    bf16_t* O; int ldc;
    static __device__ __forceinline__ f32x4 dq(f32x4 v) { if (I8) { const i32x4 q = __builtin_bit_cast(i32x4, v); return (f32x4){(float)q[0] * Q_DEQ, (float)q[1] * Q_DEQ, (float)q[2] * Q_DEQ, (float)q[3] * Q_DEQ}; } return v; }
    __device__ __forceinline__ void operator()(const f32x4 (&acc)[2][2][4][2], const Unit& u, int wr, int wc, int fr, int fq) const {
        const int row0 = u.pm * BM + wr * 64 + fr, col0 = u.pn * BM + wc * 32 + 8 * fq;
#pragma unroll
        for (int ai = 0; ai < 2; ++ai)
#pragma unroll
            for (int m = 0; m < 4; ++m) { bf16_t* rowp = O + (size_t)(row0 + ai * HALF + m * 16) * ldc + col0;
#pragma unroll
                for (int bj = 0; bj < 2; ++bj) { const f32x4 v0 = dq(acc[ai][bj][m][0]), v1 = dq(acc[ai][bj][m][1]);
                    u32x4 w; w.x = pk2(v0[0], v0[1]); w.y = pk2(v0[2], v0[3]); w.z = pk2(v1[0], v1[1]); w.w = pk2(v1[2], v1[3]);
                    *(u32x4*)(rowp + bj * HALF) = w; } }
    }
};
struct EpiResid {
    static constexpr bool PERM = true;
    bf16_t* Z; const bf16_t* H;
    static __device__ __forceinline__ f32x4 dq(f32x4 v) { const i32x4 q = __builtin_bit_cast(i32x4, v); return (f32x4){(float)q[0] * Q_DEQO, (float)q[1] * Q_DEQO, (float)q[2] * Q_DEQO, (float)q[3] * Q_DEQO}; }
    __device__ __forceinline__ void operator()(const f32x4 (&acc)[2][2][4][2], const Unit& u, int wr, int wc, int fr, int fq) const {
        const int row0 = u.pm * BM + wr * 64 + fr, col0 = u.pn * BM + wc * 32 + 8 * fq;
#pragma unroll
        for (int ai = 0; ai < 2; ++ai)
#pragma unroll
            for (int m = 0; m < 4; ++m) { const size_t ro = (size_t)(row0 + ai * HALF + m * 16) * DM + col0;
#pragma unroll
                for (int bj = 0; bj < 2; ++bj) { const f32x4 v0 = dq(acc[ai][bj][m][0]), v1 = dq(acc[ai][bj][m][1]);
                    const u32x4 hh = *(const u32x4*)(H + ro + bj * HALF);
                    u32x4 w;
                    w.x = pk2(ALPHA * bflo(hh.x) + v0[0], ALPHA * bfhi(hh.x) + v0[1]); w.y = pk2(ALPHA * bflo(hh.y) + v0[2], ALPHA * bfhi(hh.y) + v0[3]);
                    w.z = pk2(ALPHA * bflo(hh.z) + v1[0], ALPHA * bfhi(hh.z) + v1[1]); w.w = pk2(ALPHA * bflo(hh.w) + v1[2], ALPHA * bfhi(hh.w) + v1[3]);
                    *(u32x4*)(Z + ro + bj * HALF) = w; } }
    }
};
struct EpiF32 {
    static constexpr bool PERM = false;
    float* C;
    __device__ __forceinline__ void operator()(const f32x4 (&acc)[2][2][4][2], const Unit& u, int wr, int wc, int fr, int fq) const {
        const int row0 = u.pm * BM + wr * 64 + fr, col0 = wc * 32 + 4 * fq;
#pragma unroll
        for (int ai = 0; ai < 2; ++ai)
#pragma unroll
            for (int m = 0; m < 4; ++m) { float* rowp = C + (size_t)(row0 + ai * HALF + m * 16) * 256 + col0;
#pragma unroll
                for (int bj = 0; bj < 2; ++bj)
#pragma unroll
                    for (int n = 0; n < 2; ++n) *(f32x4*)(rowp + bj * HALF + n * 16) = acc[ai][bj][m][n]; }
    }
};
template <bool I8> struct EpiSwiGLU {
    static constexpr bool PERM = true;
    unsigned char* ACT; LAS unsigned char* sbuf;
    static __device__ __forceinline__ f32x4 dq(f32x4 v) { if (I8) { const i32x4 q = __builtin_bit_cast(i32x4, v); return (f32x4){(float)q[0] * Q_DEQ, (float)q[1] * Q_DEQ, (float)q[2] * Q_DEQ, (float)q[3] * Q_DEQ}; } return v; }
    __device__ __forceinline__ void operator()(const f32x4 (&acc)[2][2][4][2], const Unit& u, int wr, int wc, int fr, int fq) const {
        const int tid = threadIdx.x, rrow = tid >> 3, rchunk = tid & 7;
        const int wrow = wr * 16 + fr;
        unsigned char* abase = ACT + (size_t)(u.pm * BM) * 256 + (u.pn & 1) * 128 + rchunk * 16;
#pragma unroll
        for (int st = 0; st < 8; ++st) {
            const int ai = st >> 2, m = st & 3;
            LAS unsigned char* buf = sbuf + (st & 1) * 4096;
            const f32x4 g0 = dq(acc[ai][0][m][0]), g1 = dq(acc[ai][0][m][1]), u0 = dq(acc[ai][1][m][0]), u1 = dq(acc[ai][1][m][1]);
            u32x2 w;
            w.x = pk4(q8(silu(g0[0]) * u0[0], Q_SACT), q8(silu(g0[1]) * u0[1], Q_SACT), q8(silu(g0[2]) * u0[2], Q_SACT), q8(silu(g0[3]) * u0[3], Q_SACT));
            w.y = pk4(q8(silu(g1[0]) * u1[0], Q_SACT), q8(silu(g1[1]) * u1[1], Q_SACT), q8(silu(g1[2]) * u1[2], Q_SACT), q8(silu(g1[3]) * u1[3], Q_SACT));
            const int c16 = wc * 2 + (fq >> 1);
            *(LAS u32x2*)(buf + wrow * 128 + ((c16 ^ (wrow & 7)) << 4) + (fq & 1) * 8) = w;
            asm volatile("s_waitcnt lgkmcnt(0)" ::: "memory"); __builtin_amdgcn_s_barrier(); asm volatile("" ::: "memory");
            if (tid < 256) {
                const u32x4 rv = *(const LAS u32x4*)(buf + rrow * 128 + ((rchunk ^ (rrow & 7)) << 4));
                const int grow = ai * HALF + (rrow >> 4) * 64 + m * 16 + (rrow & 15);
                *(u32x4*)(abase + (size_t)grow * 256) = rv;
            }
        }
        asm volatile("s_waitcnt lgkmcnt(0)" ::: "memory"); __builtin_amdgcn_s_barrier(); asm volatile("" ::: "memory");
    }
};
template <int EV = 0> struct EpiDownT {
    static constexpr bool PERM = true;
    unsigned char* Y; LAS unsigned char* sbuf;
    __device__ __forceinline__ void operator()(const f32x4 (&acc)[2][2][4][2], const Unit& u, int wr, int wc, int fr, int fq) const {
        const int tid = threadIdx.x, rrow = tid >> 4, rchunk = tid & 15;
        const int wrow = wr * 16 + fr;
        unsigned char* ybase = Y + (u.pn & 3) * 256 + rchunk * 16;
        const LAS int* dring = (const LAS int*)(sbuf - 3 * HTB + LDS_DST + u.slot * 1024);
#pragma unroll
        for (int st = 0; st < 8; ++st) {
            const int ai = st >> 2, m = st & 3;
            LAS unsigned char* buf = sbuf + (st & 1) * 8192;
#pragma unroll
            for (int bj = 0; bj < 2; ++bj) { const i32x4 q0 = __builtin_bit_cast(i32x4, acc[ai][bj][m][0]), q1 = __builtin_bit_cast(i32x4, acc[ai][bj][m][1]);
                const f32x4 v0 = (f32x4){(float)q0[0] * Q_DEQ2, (float)q0[1] * Q_DEQ2, (float)q0[2] * Q_DEQ2, (float)q0[3] * Q_DEQ2}, v1 = (f32x4){(float)q1[0] * Q_DEQ2, (float)q1[1] * Q_DEQ2, (float)q1[2] * Q_DEQ2, (float)q1[3] * Q_DEQ2};
                int p0 = __builtin_amdgcn_cvt_pk_fp8_f32(v0[0], v0[1], 0, false); p0 = __builtin_amdgcn_cvt_pk_fp8_f32(v0[2], v0[3], p0, true);
                int p1 = __builtin_amdgcn_cvt_pk_fp8_f32(v1[0], v1[1], 0, false); p1 = __builtin_amdgcn_cvt_pk_fp8_f32(v1[2], v1[3], p1, true);
                u32x2 w; w.x = (unsigned)p0; w.y = (unsigned)p1;
                const int c16 = bj * 8 + wc * 2 + (fq >> 1);
                *(LAS u32x2*)(buf + wrow * 256 + ((c16 ^ (wrow & 15)) << 4) + (fq & 1) * 8) = w; }
            asm volatile("s_waitcnt lgkmcnt(0)" ::: "memory"); __builtin_amdgcn_s_barrier(); asm volatile("" ::: "memory");
            const u32x4 rv = *(const LAS u32x4*)(buf + rrow * 256 + ((rchunk ^ (rrow & 15)) << 4));
            const int grow = ai * HALF + (rrow >> 4) * 64 + m * 16 + (rrow & 15);
            const int drow = dring[grow];
            if (EV == 1) { asm volatile("" :: "v"(rv.x), "v"(rv.y), "v"(rv.z), "v"(rv.w)); } else *(u32x4*)(ybase + (size_t)drow * DM) = rv;
        }
        asm volatile("s_waitcnt lgkmcnt(0)" ::: "memory"); __builtin_amdgcn_s_barrier(); asm volatile("" ::: "memory");
    }
};
typedef EpiDownT<0> EpiDown;
}

struct Args { const float* in[22]; float* out; unsigned char* ws; int ph_lo, ph_hi; };
enum { I_X = 0, I_WINAB, I_WGKUP, I_BGK, I_HG, I_GG, I_WOAB, I_LB, I_WINC, I_CONV, I_BIF, I_WOC, I_WR, I_RB, I_WEI, I_WED, I_WSI, I_WSD, I_LMG, I_LMB, I_LFG, I_LFB };

constexpr int LDS_MISC = 147200;
constexpr int LDS_BYTES = 147456;

__device__ __forceinline__ void cvt_tile(LAS unsigned char* lds, const float* __restrict__ src, size_t ldn, int k0, int n0, bf16_t* __restrict__ dst, int K, int drow0) {
    const int t = threadIdx.x;
    { const int c4 = (t & 15) * 4, r2 = t >> 4;
      const f32x4 a = *(const f32x4*)(src + (size_t)(k0 + 2 * r2) * ldn + n0 + c4);
      const f32x4 b = *(const f32x4*)(src + (size_t)(k0 + 2 * r2 + 1) * ldn + n0 + c4);
#pragma unroll
      for (int i = 0; i < 4; ++i) *(LAS unsigned*)(lds + ((c4 + i) * 72 + 2 * r2) * 2) = pk2(a[i], b[i]); }
    __syncthreads();
    { const int kk = (t & 7) * 8, n = t >> 3;
      const u32x4 v = *(const LAS u32x4*)(lds + (n * 72 + kk) * 2);
      *(u32x4*)(dst + (size_t)(drow0 + n) * K + k0 + kk) = v; }
    __syncthreads();
}
template <int NT>
__device__ __forceinline__ void cvt_multi(LAS unsigned char* lds, const float* __restrict__ src, size_t ldn, int k0, int n0, bf16_t* __restrict__ dst, int K, const int (&drow)[NT], float sc = 1.f) {
    const int t = threadIdx.x;
    { const int c4 = (t & 15) * 4, r2 = t >> 4;
      f32x4 a[NT], b[NT];
#pragma unroll
      for (int q = 0; q < NT; ++q) { a[q] = __builtin_nontemporal_load((const f32x4*)(src + (size_t)(k0 + 2 * r2) * ldn + n0 + 64 * q + c4)); b[q] = __builtin_nontemporal_load((const f32x4*)(src + (size_t)(k0 + 2 * r2 + 1) * ldn + n0 + 64 * q + c4)); }
#pragma unroll
      for (int q = 0; q < NT; ++q)
#pragma unroll
          for (int i = 0; i < 4; ++i) *(LAS unsigned*)(lds + q * 9216 + ((c4 + i) * 72 + 2 * r2) * 2) = pk2(a[q][i] * sc, b[q][i] * sc); }
    __syncthreads();
    { const int kk = (t & 7) * 8, n = t >> 3;
#pragma unroll
      for (int q = 0; q < NT; ++q) { const u32x4 v = *(const LAS u32x4*)(lds + q * 9216 + (n * 72 + kk) * 2); *(u32x4*)(dst + (size_t)(drow[q] + n) * K + k0 + kk) = v; } }
    __syncthreads();
}
template <int NT>
__device__ __forceinline__ void cvt8_multi(LAS unsigned char* lds, const float* __restrict__ src, size_t ldn, int k0, int n0, unsigned char* __restrict__ dst, int Kb, const int (&drow)[NT], float sc) {
    const int t = threadIdx.x;
    { const int c4 = (t & 15) * 4, r4 = t >> 4;
      f32x4 a[NT][4];
#pragma unroll
      for (int q = 0; q < NT; ++q)
#pragma unroll
          for (int j = 0; j < 4; ++j) a[q][j] = __builtin_nontemporal_load((const f32x4*)(src + (size_t)(k0 + 4 * r4 + j) * ldn + n0 + 64 * q + c4));
#pragma unroll
      for (int q = 0; q < NT; ++q)
#pragma unroll
          for (int i = 0; i < 4; ++i) *(LAS unsigned*)(lds + q * 9216 + (c4 + i) * 144 + 4 * r4) = pk4(q8(a[q][0][i], sc), q8(a[q][1][i], sc), q8(a[q][2][i], sc), q8(a[q][3][i], sc)); }
    __syncthreads();
    { const int kk = (t & 7) * 16, n = t >> 3;
#pragma unroll
      for (int q = 0; q < NT; ++q) { const u32x4 v = *(const LAS u32x4*)(lds + q * 9216 + n * 144 + kk); *(u32x4*)(dst + (size_t)(drow[q] + n) * Kb + k0 + kk) = v; } }
    __syncthreads();
}
template <int NT>
__device__ __forceinline__ void cvt8_matrix(LAS unsigned char* lds, const float* src, size_t ldn, int K, int n_lo, int ncols, unsigned char* dst, int drow_lo, float sc, int bid, int nb) {
    const int tk = K / 128, tn = ncols / (64 * NT);
    for (int j = bid; j < tk * tn; j += nb) { const int a = j / tn, b = j % tn; int dr[NT];
#pragma unroll
        for (int q = 0; q < NT; ++q) dr[q] = drow_lo + (b * NT + q) * 64;
        cvt8_multi<NT>(lds, src, ldn, a * 128, n_lo + b * 64 * NT, dst, K, dr, sc); }
}
template <int NT>
__device__ __forceinline__ void cvt_matrix(LAS unsigned char* lds, const float* src, size_t ldn, int K, int n_lo, int ncols, bf16_t* dst, int drow_lo, int bid, int nb) {
    const int tk = K / 64, tn = ncols / (64 * NT);
    for (int j = bid; j < tk * tn; j += nb) { const int a = j / tn, b = j % tn; int dr[NT];
#pragma unroll
        for (int q = 0; q < NT; ++q) dr[q] = drow_lo + (b * NT + q) * 64;
        cvt_multi<NT>(lds, src, ldn, a * 64, n_lo + b * 64 * NT, dst, K, dr); }
}
__device__ __forceinline__ void phase_prologue(LAS unsigned char* lds, const Args& A, int bid, int nb) {
    unsigned char* ws = A.ws; const int tid = threadIdx.x;
    if (bid == 0) {
        float* lb0 = (float*)(ws + WS_MISC);
        const float* l = A.in[I_LB];
        if (tid < 512) { const float a = l[tid], b = l[512 + tid], c = l[1024 + tid]; const float m = fmaxf(a, fmaxf(b, c));
            const float ea = __expf(a - m), eb = __expf(b - m), ec = __expf(c - m); lb0[tid] = ea / (ea + eb + ec); }
    }
    if (bid == 1 % nb) {
        float* wg = (float*)(ws + WS_MISC + 4096);
        for (int i = tid; i < 8 * 1024; i += 512) { const int g = i >> 10, k = i & 1023; wg[i] = A.in[I_WINC][(size_t)k * 3080 + 3072 + g]; }
    }
    { const float* x = A.in[I_X]; bf16_t* hb = (bf16_t*)(ws + WS_HB); unsigned char* xq = ws + WS_XQ;
      const size_t step = (size_t)nb * 512 * 8;
      for (size_t i0 = ((size_t)bid * 512 + tid) * 8; i0 < (size_t)NTOK * DM; i0 += 4 * step) {
          f32x4 a[4], b[4];
#pragma unroll
          for (int u = 0; u < 4; ++u) { const size_t i = i0 + u * step; if (i < (size_t)NTOK * DM) { a[u] = __builtin_nontemporal_load((const f32x4*)(x + i)); b[u] = __builtin_nontemporal_load((const f32x4*)(x + i + 4)); } }
#pragma unroll
          for (int u = 0; u < 4; ++u) { const size_t i = i0 + u * step; if (i < (size_t)NTOK * DM) {
              u32x4 w; w.x = pk2(a[u][0], a[u][1]); w.y = pk2(a[u][2], a[u][3]); w.z = pk2(b[u][0], b[u][1]); w.w = pk2(b[u][2], b[u][3]);
              *(u32x4*)(hb + i) = w;
              u32x2 qv; qv.x = pk4(q8(a[u][0], Q_SA), q8(a[u][1], Q_SA), q8(a[u][2], Q_SA), q8(a[u][3], Q_SA)); qv.y = pk4(q8(b[u][0], Q_SA), q8(b[u][1], Q_SA), q8(b[u][2], Q_SA), q8(b[u][3], Q_SA));
              *(u32x2*)(xq + i) = qv; } } } }
    { unsigned char* wab = ws + WS_WAB; const float* win = A.in[I_WINAB]; const float* wup = A.in[I_WGKUP];
      for (int o = bid * 512 + tid; o < 256 * 64; o += nb * 512) { const int j = o >> 6, k16 = (o & 63) * 16;
          float up[16];
#pragma unroll
          for (int r = 0; r < 16; ++r) up[r] = wup[r * 256 + j];
          int res[16];
#pragma unroll
          for (int q = 0; q < 16; ++q) { const float* wr_ = win + (size_t)(k16 + q) * 3600 + 3584; float sm = 0.f;
#pragma unroll
              for (int r = 0; r < 16; ++r) sm += wr_[r] * up[r];
              res[q] = q8(sm, Q_SW); }
          u32x4 w; w.x = pk4(res[0], res[1], res[2], res[3]); w.y = pk4(res[4], res[5], res[6], res[7]); w.z = pk4(res[8], res[9], res[10], res[11]); w.w = pk4(res[12], res[13], res[14], res[15]);
          *(u32x4*)(wab + (size_t)(3584 + j) * 1024 + k16) = w; } }
    cvt8_matrix<4>(lds, A.in[I_WINAB], 3600, 1024, 0, 3584, ws + WS_WAB, 0, Q_SW, bid, nb);
    cvt8_matrix<4>(lds, A.in[I_WOAB], 1024, 1024, 0, 1024, ws + WS_WOAB, 0, Q_SWO, bid, nb);
    cvt8_matrix<4>(lds, A.in[I_WINC], 3080, 1024, 0, 3072, ws + WS_WC, 0, Q_SW, bid, nb);
    cvt8_matrix<4>(lds, A.in[I_WOC], 1024, 1024, 0, 1024, ws + WS_WOC, 0, Q_SWO, bid, nb);
    cvt_matrix<4>(lds, A.in[I_WR], 256, 1024, 0, 256, (bf16_t*)(ws + WS_WR), 0, bid, nb);
    cvt_matrix<4>(lds, A.in[I_WR] + 1024 * 256, 256, 1024, 0, 256, (bf16_t*)(ws + WS_WR) + 256 * 1024, 0, bid, nb);
}
__device__ __forceinline__ void convert_experts(LAS unsigned char* lds, const Args& A, int layer, int bid, int nb, int lo16, int hi16) {
    unsigned char* ws = A.ws;
    int kk = 0;
    for (int j = bid; j < NE1 * 16; j += nb, ++kk) {
        { const int pk = kk % 16; if (pk < lo16 || pk >= hi16) continue; }
        const int e = j % NE1, t0 = j / NE1;
        const int t = (t0 < 8) ? 2 * t0 : 8 + t0;
        if (t < 16) {
            const float* src = (e < NEXP) ? A.in[I_WEI] + ((size_t)(layer * NEXP + e)) * 1024 * 512 : A.in[I_WSI] + (size_t)layer * 1024 * 512;
            unsigned char* dst = ws + WS_W1T + ((size_t)(layer * NE1 + e)) * 512 * 1024;
            const int tk = t >> 1;
            int dr[8];
#pragma unroll
            for (int q = 0; q < 8; ++q) { const int n0 = q * 64, gq = n0 >> 8, nn = n0 & 255; dr[q] = (nn >> 7) * 256 + gq * 128 + (nn & 127); }
            cvt8_multi<8>(lds, src, 512, tk * 128, 0, dst, 1024, dr, Q_SW);
        } else {
            const int t2 = t - 16, tk = t2 >> 2, g4 = t2 & 3;
            const float* src = (e < NEXP) ? A.in[I_WED] + ((size_t)(layer * NEXP + e)) * 256 * 1024 : A.in[I_WSD] + (size_t)layer * 256 * 1024;
            unsigned char* dst = ws + WS_W2T + ((size_t)(layer * NE1 + e)) * 1024 * 256;
            int dr[4];
#pragma unroll
            for (int q = 0; q < 4; ++q) dr[q] = g4 * 256 + q * 64;
            cvt8_multi<4>(lds, src, 1024, tk * 128, g4 * 256, dst, 256, dr, Q_SW);
        }
    }
}

__device__ __forceinline__ void phase_ln(const bf16_t* __restrict__ Z, bf16_t* __restrict__ H, unsigned char* __restrict__ HQ, const float* __restrict__ g, const float* __restrict__ b, int bid, int nb) {
    const int lane = threadIdx.x & 63, gw = bid * 8 + (threadIdx.x >> 6), nw = nb * 8;
    float gg[16], bb[16];
#pragma unroll
    for (int i = 0; i < 8; ++i) { gg[i] = g[lane * 8 + i]; gg[8 + i] = g[512 + lane * 8 + i]; bb[i] = b[lane * 8 + i]; bb[8 + i] = b[512 + lane * 8 + i]; }
    for (int row = gw; row < NTOK; row += nw) {
        const u32x4 a = *(const u32x4*)(Z + (size_t)row * DM + lane * 8), c = *(const u32x4*)(Z + (size_t)row * DM + 512 + lane * 8);
        float v[16];
        v[0] = bflo(a.x); v[1] = bfhi(a.x); v[2] = bflo(a.y); v[3] = bfhi(a.y); v[4] = bflo(a.z); v[5] = bfhi(a.z); v[6] = bflo(a.w); v[7] = bfhi(a.w);
        v[8] = bflo(c.x); v[9] = bfhi(c.x); v[10] = bflo(c.y); v[11] = bfhi(c.y); v[12] = bflo(c.z); v[13] = bfhi(c.z); v[14] = bflo(c.w); v[15] = bfhi(c.w);
        float s = 0.f;
#pragma unroll
        for (int i = 0; i < 16; ++i) s += v[i];
#pragma unroll
        for (int o = 32; o > 0; o >>= 1) s += __shfl_xor(s, o);
        const float mu = s * (1.f / 1024.f);
        float q = 0.f;
#pragma unroll
        for (int i = 0; i < 16; ++i) { const float d = v[i] - mu; q += d * d; }
#pragma unroll
        for (int o = 32; o > 0; o >>= 1) q += __shfl_xor(q, o);
        const float rs = rsqrtf(q * (1.f / 1024.f) + 1e-5f);
        float y[16];
#pragma unroll
        for (int i = 0; i < 16; ++i) y[i] = (v[i] - mu) * rs * gg[i] + bb[i];
        u32x4 w0, w1; w0.x = pk2(y[0], y[1]); w0.y = pk2(y[2], y[3]); w0.z = pk2(y[4], y[5]); w0.w = pk2(y[6], y[7]);
        w1.x = pk2(y[8], y[9]); w1.y = pk2(y[10], y[11]); w1.z = pk2(y[12], y[13]); w1.w = pk2(y[14], y[15]);
        *(u32x4*)(H + (size_t)row * DM + lane * 8) = w0; *(u32x4*)(H + (size_t)row * DM + 512 + lane * 8) = w1;
        u32x2 q0, q1;
        q0.x = pk4(q8(y[0], Q_SA), q8(y[1], Q_SA), q8(y[2], Q_SA), q8(y[3], Q_SA)); q0.y = pk4(q8(y[4], Q_SA), q8(y[5], Q_SA), q8(y[6], Q_SA), q8(y[7], Q_SA));
        q1.x = pk4(q8(y[8], Q_SA), q8(y[9], Q_SA), q8(y[10], Q_SA), q8(y[11], Q_SA)); q1.y = pk4(q8(y[12], Q_SA), q8(y[13], Q_SA), q8(y[14], Q_SA), q8(y[15], Q_SA));
        *(u32x2*)(HQ + (size_t)row * DM + lane * 8) = q0; *(u32x2*)(HQ + (size_t)row * DM + 512 + lane * 8) = q1;
    }
}

template <bool FINAL>
__device__ __forceinline__ void phase_combine(const unsigned char* __restrict__ Y, const float* __restrict__ tokw,
                                              const bf16_t* __restrict__ H1, bf16_t* __restrict__ H2, unsigned char* __restrict__ H2Q, float* __restrict__ OUT, float* __restrict__ GATES,
                                              const float* __restrict__ wgate, const float* __restrict__ g, const float* __restrict__ b, int bid, int nb) {
    const int lane = threadIdx.x & 63, gw = bid * 8 + (threadIdx.x >> 6), nw = nb * 8;
    float nwk = 0.f;
    if (gw < NTOK) nwk = (lane < 8) ? tokw[(size_t)gw * 8 + lane] : 1.0f;
    float gg[16], bb[16], wgt[FINAL ? 1 : 8][16];
#pragma unroll
    for (int i = 0; i < 8; ++i) { gg[i] = g[lane * 8 + i]; gg[8 + i] = g[512 + lane * 8 + i]; bb[i] = b[lane * 8 + i]; bb[8 + i] = b[512 + lane * 8 + i]; }
    if (!FINAL) {
#pragma unroll
        for (int gi = 0; gi < 8; ++gi)
#pragma unroll
            for (int i = 0; i < 8; ++i) { wgt[gi][i] = wgate[gi * 1024 + lane * 8 + i]; wgt[gi][8 + i] = wgate[gi * 1024 + 512 + lane * 8 + i]; }
    }
    for (int row = gw; row < NTOK; row += nw) {
        const float cwk = nwk;
        { const int nr = row + nw; if (nr < NTOK) nwk = (lane < 8) ? tokw[(size_t)nr * 8 + lane] : 1.0f; }
        float v[16];
        { const u32x4 a = *(const u32x4*)(H1 + (size_t)row * DM + lane * 8), c = *(const u32x4*)(H1 + (size_t)row * DM + 512 + lane * 8);
          v[0] = bflo(a.x); v[1] = bfhi(a.x); v[2] = bflo(a.y); v[3] = bfhi(a.y); v[4] = bflo(a.z); v[5] = bfhi(a.z); v[6] = bflo(a.w); v[7] = bfhi(a.w);
          v[8] = bflo(c.x); v[9] = bfhi(c.x); v[10] = bflo(c.y); v[11] = bfhi(c.y); v[12] = bflo(c.z); v[13] = bfhi(c.z); v[14] = bflo(c.w); v[15] = bfhi(c.w); }
#pragma unroll
        for (int i = 0; i < 16; ++i) v[i] *= ALPHA;
        u32x2 ya[NSLOT], yc[NSLOT]; float wks[NSLOT];
#pragma unroll
        for (int k = 0; k < NSLOT; ++k) {
            wks[k] = __uint_as_float(__builtin_amdgcn_readlane(__float_as_uint(cwk), k)) * 0.0625f;
            const unsigned char* yr = Y + ((size_t)row * NSLOT + k) * DM;
            ya[k] = *(const u32x2*)(yr + lane * 8); yc[k] = *(const u32x2*)(yr + 512 + lane * 8);
        }
        typedef float f32x2_ __attribute__((ext_vector_type(2)));
#pragma unroll
        for (int k = 0; k < NSLOT; ++k) {
            const float wk = wks[k];
            const f32x2_ a0 = __builtin_amdgcn_cvt_pk_f32_fp8((int)ya[k].x, false), a1 = __builtin_amdgcn_cvt_pk_f32_fp8((int)ya[k].x, true), a2 = __builtin_amdgcn_cvt_pk_f32_fp8((int)ya[k].y, false), a3 = __builtin_amdgcn_cvt_pk_f32_fp8((int)ya[k].y, true);
            const f32x2_ c0 = __builtin_amdgcn_cvt_pk_f32_fp8((int)yc[k].x, false), c1 = __builtin_amdgcn_cvt_pk_f32_fp8((int)yc[k].x, true), c2 = __builtin_amdgcn_cvt_pk_f32_fp8((int)yc[k].y, false), c3 = __builtin_amdgcn_cvt_pk_f32_fp8((int)yc[k].y, true);
            v[0] += wk * a0.x; v[1] += wk * a0.y; v[2] += wk * a1.x; v[3] += wk * a1.y; v[4] += wk * a2.x; v[5] += wk * a2.y; v[6] += wk * a3.x; v[7] += wk * a3.y;
            v[8] += wk * c0.x; v[9] += wk * c0.y; v[10] += wk * c1.x; v[11] += wk * c1.y; v[12] += wk * c2.x; v[13] += wk * c2.y; v[14] += wk * c3.x; v[15] += wk * c3.y;
        }
        float s = 0.f;
#pragma unroll
        for (int i = 0; i < 16; ++i) s += v[i];
#pragma unroll
        for (int o = 32; o > 0; o >>= 1) s += __shfl_xor(s, o);
        const float mu = s * (1.f / 1024.f);
        float q = 0.f;
#pragma unroll
        for (int i = 0; i < 16; ++i) { const float d = v[i] - mu; q += d * d; }
#pragma unroll
        for (int o = 32; o > 0; o >>= 1) q += __shfl_xor(q, o);
        const float rs = rsqrtf(q * (1.f / 1024.f) + 1e-5f);
        float y[16];
#pragma unroll
        for (int i = 0; i < 16; ++i) y[i] = (v[i] - mu) * rs * gg[i] + bb[i];
        if (FINAL) {
            float* o = OUT + (size_t)row * DM;
            *(f32x4*)(o + lane * 8) = (f32x4){y[0], y[1], y[2], y[3]}; *(f32x4*)(o + lane * 8 + 4) = (f32x4){y[4], y[5], y[6], y[7]};
            *(f32x4*)(o + 512 + lane * 8) = (f32x4){y[8], y[9], y[10], y[11]}; *(f32x4*)(o + 512 + lane * 8 + 4) = (f32x4){y[12], y[13], y[14], y[15]};
        } else {
            u32x4 w0, w1; w0.x = pk2(y[0], y[1]); w0.y = pk2(y[2], y[3]); w0.z = pk2(y[4], y[5]); w0.w = pk2(y[6], y[7]);
            w1.x = pk2(y[8], y[9]); w1.y = pk2(y[10], y[11]); w1.z = pk2(y[12], y[13]); w1.w = pk2(y[14], y[15]);
            *(u32x4*)(H2 + (size_t)row * DM + lane * 8) = w0; *(u32x4*)(H2 + (size_t)row * DM + 512 + lane * 8) = w1;
            { u32x2 q0, q1;
              q0.x = pk4(q8(y[0], Q_SA), q8(y[1], Q_SA), q8(y[2], Q_SA), q8(y[3], Q_SA)); q0.y = pk4(q8(y[4], Q_SA), q8(y[5], Q_SA), q8(y[6], Q_SA), q8(y[7], Q_SA));
              q1.x = pk4(q8(y[8], Q_SA), q8(y[9], Q_SA), q8(y[10], Q_SA), q8(y[11], Q_SA)); q1.y = pk4(q8(y[12], Q_SA), q8(y[13], Q_SA), q8(y[14], Q_SA), q8(y[15], Q_SA));
              *(u32x2*)(H2Q + (size_t)row * DM + lane * 8) = q0; *(u32x2*)(H2Q + (size_t)row * DM + 512 + lane * 8) = q1; }
            float yr[16];
            yr[0] = bflo(w0.x); yr[1] = bfhi(w0.x); yr[2] = bflo(w0.y); yr[3] = bfhi(w0.y); yr[4] = bflo(w0.z); yr[5] = bfhi(w0.z); yr[6] = bflo(w0.w); yr[7] = bfhi(w0.w);
            yr[8] = bflo(w1.x); yr[9] = bfhi(w1.x); yr[10] = bflo(w1.y); yr[11] = bfhi(w1.y); yr[12] = bflo(w1.z); yr[13] = bfhi(w1.z); yr[14] = bflo(w1.w); yr[15] = bfhi(w1.w);
            float d8[8];
#pragma unroll
            for (int gi = 0; gi < 8; ++gi) { float d = 0.f;
#pragma unroll
                for (int i = 0; i < 16; ++i) d += yr[i] * wgt[FINAL ? 0 : gi][i];
                d8[gi] = d; }
            float d4[4], d2[2], d1;
            { const bool hi = (lane & 32) != 0;
#pragma unroll
              for (int q = 0; q < 4; ++q) { const float keep = hi ? d8[4 + q] : d8[q], give = hi ? d8[q] : d8[4 + q]; d4[q] = keep + __shfl_xor(give, 32); } }
            { const bool hi = (lane & 16) != 0;
#pragma unroll
              for (int q = 0; q < 2; ++q) { const float keep = hi ? d4[2 + q] : d4[q], give = hi ? d4[q] : d4[2 + q]; d2[q] = keep + __shfl_xor(give, 16); } }
            { const bool hi = (lane & 8) != 0; const float keep = hi ? d2[1] : d2[0], give = hi ? d2[0] : d2[1]; d1 = keep + __shfl_xor(give, 8); }
            d1 += __shfl_xor(d1, 4); d1 += __shfl_xor(d1, 2); d1 += __shfl_xor(d1, 1);
            const int gidx = ((lane >> 5) & 1) * 4 + ((lane >> 4) & 1) * 2 + ((lane >> 3) & 1);
            const float gsum = d1;
            if ((lane & 7) == 0) GATES[(size_t)row * 8 + gidx] = gsum;
        }
    }
}

template <bool DRY>
__device__ __forceinline__ void phase_select(LAS unsigned char* lds, const float* __restrict__ logits, const float* __restrict__ rbias, int* __restrict__ tok_e, int* __restrict__ tok_p,
                                             float* __restrict__ tok_w, unsigned* __restrict__ cnt, int bid, int nb) {
    const int tid = threadIdx.x, it = tid & 63, g8 = tid >> 6;
    LAS unsigned* hist = (LAS unsigned*)lds;
    LAS unsigned* base = hist + 256;
    LAS int* selE = (LAS int*)(base + 256);
    LAS int* selR = selE + 1024;
    LAS float* gsl = (LAS float*)(lds + 10240);
    LAS float* lv = (LAS float*)(lds + 12288);
    LAS int* le = (LAS int*)(lds + 28672);
    LAS float* sb = (LAS float*)(lds + 45056);
    const int tpw = NTOK / nb;
    const int t0 = bid * tpw;
    const float NEG = -3.0e38f;
    if (tid < 256) hist[tid] = 0u;
    __syncthreads();
    for (int half = 0; half < tpw / 64; ++half) {
        const int tb = t0 + half * 64;
        {
            const int e = tid & 255, tk0 = tid >> 8; const float rb = rbias[e];
#pragma unroll
            for (int i0 = 0; i0 < 32; i0 += 8) { float lv8[8];
#pragma unroll
                for (int u = 0; u < 8; ++u) lv8[u] = logits[(size_t)(tb + tk0 + 2 * (i0 + u)) * 256 + e];
#pragma unroll
                for (int u = 0; u < 8; ++u) sb[e * 65 + tk0 + 2 * (i0 + u)] = sigm(lv8[u]) + rb; }
        }
        __syncthreads();
        {
            float m1 = NEG, m2 = NEG;
            for (int j = 0; j < 32; ++j) { const float v = sb[(g8 * 32 + j) * 65 + it]; if (v > m1) { m2 = m1; m1 = v; } else if (v > m2) m2 = v; }
            gsl[g8 * 64 + it] = m1 + m2;
        }
        __syncthreads();
        float G[8];
#pragma unroll
        for (int q = 0; q < 8; ++q) G[q] = gsl[q * 64 + it];
        unsigned selmask = 0u;
#pragma unroll
        for (int g = 0; g < 8; ++g) { int rank = 0;
#pragma unroll
            for (int q = 0; q < 8; ++q) rank += (G[q] > G[g] || (G[q] == G[g] && q < g)) ? 1 : 0;
            if (rank < 4) selmask |= 1u << g; }
        if ((selmask >> g8) & 1u) {
            float vv[32];
#pragma unroll
            for (int j = 0; j < 32; ++j) vv[j] = sb[(g8 * 32 + j) * 65 + it];
#pragma unroll
            for (int k = 0; k < 8; ++k) {
                float bv = vv[0]; int bj = 0;
#pragma unroll
                for (int j = 1; j < 32; ++j) { const bool gt = vv[j] > bv; bv = gt ? vv[j] : bv; bj = gt ? j : bj; }
#pragma unroll
                for (int j = 0; j < 32; ++j) vv[j] = (j == bj) ? NEG : vv[j];
                lv[(g8 * 8 + k) * 64 + it] = bv; le[(g8 * 8 + k) * 64 + it] = g8 * 32 + bj;
            }
        }
        __syncthreads();
        if (tid < 64) {
            int gid[4]; { int n = 0;
#pragma unroll
                for (int g = 0; g < 8; ++g) if ((selmask >> g) & 1u) { if (n == 0) gid[0] = g; else if (n == 1) gid[1] = g; else if (n == 2) gid[2] = g; else gid[3] = g; ++n; } }
            float hv[4]; int hp[4];
#pragma unroll
            for (int j = 0; j < 4; ++j) { hp[j] = 0; hv[j] = lv[(gid[j] * 8) * 64 + it]; }
            float sc8[8]; int te[8]; float tot = 0.f;
#pragma unroll
            for (int k = 0; k < 8; ++k) {
                int bj = 0; float bv = hv[0];
                if (hv[1] > bv) { bv = hv[1]; bj = 1; }
                if (hv[2] > bv) { bv = hv[2]; bj = 2; }
                if (hv[3] > bv) { bv = hv[3]; bj = 3; }
                const int gsel = (bj == 0) ? gid[0] : (bj == 1) ? gid[1] : (bj == 2) ? gid[2] : gid[3];
                const int psel = (bj == 0) ? hp[0] : (bj == 1) ? hp[1] : (bj == 2) ? hp[2] : hp[3];
                const int e = le[(gsel * 8 + psel) * 64 + it];
                te[k] = e; sc8[k] = bv - rbias[e]; tot += sc8[k];
                const float nv = (psel < 7) ? lv[(gsel * 8 + psel + 1) * 64 + it] : NEG;
                if (bj == 0) { hv[0] = nv; hp[0] = psel + 1; } else if (bj == 1) { hv[1] = nv; hp[1] = psel + 1; } else if (bj == 2) { hv[2] = nv; hp[2] = psel + 1; } else { hv[3] = nv; hp[3] = psel + 1; }
            }
            const float inv = 2.5f / tot;
            const int tok = tb + it, lt = half * 64 + it;
#pragma unroll
            for (int k = 0; k < 8; ++k) {
                tok_e[(size_t)tok * 8 + k] = te[k]; tok_w[(size_t)tok * 8 + k] = sc8[k] * inv;
                const unsigned r = atomicAdd((unsigned*)&hist[te[k]], 1u);
                selE[lt * 8 + k] = te[k]; selR[lt * 8 + k] = (int)r;
            }
        }
        __syncthreads();
    }
    if (DRY) return;
    if (tid < 256) { const unsigned c = hist[tid]; base[tid] = c ? __hip_atomic_fetch_add(cnt + tid, c, __ATOMIC_RELAXED, __HIP_MEMORY_SCOPE_AGENT) : 0u; }
    __syncthreads();
    for (int i = tid; i < tpw * 8; i += 512) tok_p[(size_t)t0 * 8 + i] = (int)base[selE[i]] + selR[i];
    __syncthreads();
}

__device__ __forceinline__ void phase_dispatch(LAS unsigned char* lds, const unsigned* __restrict__ cnt, const int* __restrict__ tok_e, const int* __restrict__ tok_p,
                                               int* __restrict__ s_tok, int* __restrict__ s_dst, int* __restrict__ tile_exp, int* __restrict__ ntiles, int bid, int nb) {
    const int tid = threadIdx.x;
    LAS int* tstart = (LAS int*)lds;
    LAS int* tcnt = tstart + 260;
    if (tid < 256) tcnt[tid] = (int)((__hip_atomic_load(cnt + tid, __ATOMIC_RELAXED, __HIP_MEMORY_SCOPE_AGENT) + 255u) >> 8);
    __syncthreads();
    if (tid < 256) { int a = 0;
#pragma unroll 16
        for (int j = 0; j < 256; ++j) { const int c = tcnt[j]; a += (j < tid) ? c : 0; }
        tstart[tid] = a; if (tid == 255) tstart[256] = a + tcnt[255]; }
    __syncthreads();
    const int TT = tstart[256];
    const int tpw = NTOK / nb, t0 = bid * tpw;
    for (int i = tid; i < tpw * 8; i += 512) {
        const size_t a = (size_t)t0 * 8 + i; const int e = tok_e[a], p = tok_p[a];
        const int pos = tstart[e] * 256 + p;
        s_tok[pos] = (int)(a >> 3); s_dst[pos] = (int)(a >> 3) * NSLOT + (int)(a & 7);
    }
    for (int i = tid; i < tpw; i += 512) { const int tok = t0 + i; s_tok[TT * 256 + tok] = tok; s_dst[TT * 256 + tok] = tok * NSLOT + 8; }
    for (int e = bid; e < 256; e += nb) {
        const int c = (int)__hip_atomic_load(cnt + e, __ATOMIC_RELAXED, __HIP_MEMORY_SCOPE_AGENT), ts = tstart[e], tc = tcnt[e];
        for (int i = c + tid; i < tc * 256; i += 512) { s_tok[ts * 256 + i] = 0; s_dst[ts * 256 + i] = YTRASH + (i & 255); }
        for (int i = tid; i < tc; i += 512) tile_exp[ts + i] = e;
    }
    if (bid == 0) { for (int i = tid; i < NTOK / 256; i += 512) tile_exp[TT + i] = 256; if (tid == 0) *ntiles = TT + NTOK / 256; }
    __syncthreads();
}

constexpr int MX_QT = 0, MX_KT = 17408, MX_KHT = 34816, MX_VT = 53248, MX_P = 73984, MX_ST = 83200, MX_SEG = 122368, MX_GD = 126464, MX_ER = 126976, MX_RS = 127488, MX_DEN = 128000, MX_BC = 128256, MX_IP = 128512, MX_GT = 128768;
struct MixP {
    const bf16_t* proj; int ldp; int pad0; unsigned char* ymix; const float* gates;
    const float* lb0; const float* bgk; const float* hg; const float* gg; const float* conv; const float* bif;
    float* ust; float* gsum;
};
#define MFMA16(a, b, c) __builtin_amdgcn_mfma_f32_16x16x32_bf16((a), (b), (c), 0, 0, 0)

template <int MODE, bool FULL, int VAR = 0>
__device__ __forceinline__ void mixer_run(LAS unsigned char* lds, const MixP& mp, int bid) {
    constexpr int DK = (MODE == 1) ? 64 : 128, QP = DK + 8, CP = DK / 2, RG = 512 / CP, RPT = 64 / RG, KS = DK / 32;
    constexpr int NVT = (MODE == 2) ? 9 : 8;
    constexpr int NST = (DK == 128) ? NVT : 4;
    const int tid = threadIdx.x, lane = tid & 63, w = __builtin_amdgcn_readfirstlane(tid >> 6), l15 = lane & 15, l4 = lane >> 4;
    int b, h, vh = 0, seg;
    if (MODE == 0) { const int sq = bid >> 4; b = sq >> 2; h = sq & 3; seg = bid & 15; }
    else if (MODE == 1) { const int sq = (bid - 128) >> 4; b = sq >> 2; h = sq & 3; seg = bid & 15; }
    else { const int sq = bid >> 4; b = sq >> 3; h = (sq >> 1) & 3; vh = sq & 1; seg = bid & 15; }
    const int tok0 = b * SEQ + seg * 1024;
    const int ldp = mp.ldp; const bf16_t* proj = mp.proj;
    int cq, ck, cv, cg, cy;
    if (MODE == 0) { cq = h * 128; ck = 512 + h * 128; cv = 1024 + h * 128; cg = 1536 + h * 128; cy = h * 128; }
    else if (MODE == 1) { cq = 2048 + h * 64; ck = 2304 + h * 64; cv = 2560 + h * 128; cg = 3072 + h * 128; cy = 512 + h * 128; }
    else { cq = h * 128; ck = 512 + h * 128; cv = 1024 + h * 256 + vh * 128; cg = 2048 + h * 256 + vh * 128; cy = h * 256 + vh * 128; }
    const int cu = 3584 + h * 64;
    const int cp = tid % CP, rg = tid / CP, d0 = 2 * cp;
    float lbv[2] = {0.f, 0.f}, oml[2] = {0.f, 0.f}, bgk[2] = {0.f, 0.f}, cwq[4][2], cwk[4][2];
    if (MODE == 0) { lbv[0] = mp.lb0[h * 128 + d0]; lbv[1] = mp.lb0[h * 128 + d0 + 1]; oml[0] = 1.f - lbv[0]; oml[1] = 1.f - lbv[1]; }
    if (MODE == 1) { bgk[0] = mp.bgk[h * 64 + d0]; bgk[1] = mp.bgk[h * 64 + d0 + 1]; }
#pragma unroll
    for (int j = 0; j < 4; ++j) { cwq[j][0] = cwq[j][1] = cwk[j][0] = cwk[j][1] = 0.f; }
    if (MODE == 2) {
#pragma unroll
        for (int j = 0; j < 4; ++j) { cwq[j][0] = mp.conv[j * 1024 + cq + d0]; cwq[j][1] = mp.conv[j * 1024 + cq + d0 + 1]; cwk[j][0] = mp.conv[j * 1024 + ck + d0]; cwk[j][1] = mp.conv[j * 1024 + ck + d0 + 1]; }
    }
    const float bi = (MODE == 2) ? mp.bif[h] : 0.f, bfg = (MODE == 2) ? mp.bif[4 + h] : 0.f;
    const int sdt = (DK == 128) ? w : (w & 3), svt0 = (DK == 128) ? 0 : 4 * (w >> 2);
    f32x4 S[NST];
#pragma unroll
    for (int t = 0; t < NST; ++t) S[t] = (f32x4){0.f, 0.f, 0.f, 0.f};
    float gacc[2] = {(MODE == 2) ? 0.f : 1.f, (MODE == 2) ? 0.f : 1.f};
    if (MODE == 2) {
        for (int i = tid; i < 16 * 72; i += 512) { const int r = i / 72; *(LAS bf16_t*)(lds + MX_VT + ((128 + r) * 72 + (i % 72)) * 2) = (r == 0) ? (bf16_t)0x3F80 : (bf16_t)0; }
    }
    if (FULL) {
        const int bid0 = bid & ~15;
#pragma unroll 2
        for (int j = 0; j < seg; ++j) {
            const float* U = mp.ust + ((size_t)(bid0 + j) * 8 + w) * (9 * 4 * 64);
            float dec[4];
            if (MODE == 2) { const float gsv = mp.gsum[(size_t)(bid0 + j) * 128]; dec[0] = dec[1] = dec[2] = dec[3] = __expf(gsv); }
            else {
#pragma unroll
                for (int r = 0; r < 4; ++r) dec[r] = mp.gsum[(size_t)(bid0 + j) * 128 + sdt * 16 + 4 * l4 + r];
            }
            f32x4 uu[NST];
#pragma unroll
            for (int t = 0; t < NST; ++t)
#pragma unroll
                for (int r = 0; r < 4; ++r) uu[t][r] = U[(t * 4 + r) * 64 + lane];
#pragma unroll
            for (int t = 0; t < NST; ++t)
#pragma unroll
                for (int r = 0; r < 4; ++r) S[t][r] = dec[r] * S[t][r] + uu[t][r];
        }
    }
    const int sj = w & 3, ovh = w >> 2, srow = 16 * sj + l15;
    const int vp = tid & 63, r0v = (tid >> 6) * 8;
    unsigned ra[RPT + 3], rb[RPT + 3], rc[RPT], pv[8]; u32x2 gnx[4]; float sgi = 0.f, sgf = 0.f;
#pragma unroll
    for (int i = 0; i < RPT + 3; ++i) { ra[i] = 0u; rb[i] = 0u; }
#pragma unroll
    for (int i = 0; i < RPT; ++i) rc[i] = 0u;
#pragma unroll
    for (int t = 0; t < 4; ++t) gnx[t] = (u32x2){0u, 0u};
#define MX_LOAD(cn) do { const int tokn_ = tok0 + (cn) * 64; \
        if (VAR == 1 || VAR == 3 || VAR == 4) { _Pragma("unroll") for (int i = 0; i < RPT + 3; ++i) { ra[i] = 0x3c003c00u + (unsigned)(cn); rb[i] = 0x3c003c00u; } _Pragma("unroll") for (int i = 0; i < RPT; ++i) rc[i] = 0x3c003c00u; _Pragma("unroll") for (int i = 0; i < 8; ++i) pv[i] = 0x3c003c00u; _Pragma("unroll") for (int t = 0; t < 4; ++t) gnx[t] = (u32x2){0x3c003c00u, 0x3c003c00u}; sgi = 0.1f; sgf = 3.f; } else \
        if (MODE == 2) { const int tl0_ = seg * 1024 + (cn) * 64 + rg * RPT; \
            _Pragma("unroll") for (int i = 0; i < RPT + 3; ++i) { const int tl_ = tl0_ - 3 + i; \
                if (tl_ >= 0) { const bf16_t* pr_ = proj + (size_t)(b * SEQ + tl_) * ldp; if (FULL) ra[i] = *(const unsigned*)(pr_ + cq + d0); rb[i] = *(const unsigned*)(pr_ + ck + d0); } \
                else { ra[i] = 0u; rb[i] = 0u; } } \
            if (w == 0) { const float* gp_ = mp.gates + (size_t)(tokn_ + lane) * 8; sgi = gp_[h]; sgf = gp_[4 + h]; } \
        } else { \
            _Pragma("unroll") for (int i = 0; i < RPT; ++i) { const bf16_t* pr_ = proj + (size_t)(tokn_ + rg * RPT + i) * ldp; \
                if (MODE == 0) { ra[i] = *(const unsigned*)(pr_ + ck + d0); if (FULL) rb[i] = *(const unsigned*)(pr_ + cq + d0); } \
                else { ra[i] = *(const unsigned*)(pr_ + cu + d0); rb[i] = *(const unsigned*)(pr_ + ck + d0); if (FULL) rc[i] = *(const unsigned*)(pr_ + cq + d0); } } \
        } \
        _Pragma("unroll") for (int i = 0; i < 8; ++i) pv[i] = *(const unsigned*)(proj + (size_t)(tokn_ + r0v + i) * ldp + cv + 2 * vp); \
        if (FULL) { _Pragma("unroll") for (int t = 0; t < 4; ++t) gnx[t] = *(const u32x2*)(proj + (size_t)(tokn_ + srow) * ldp + cg + 16 * (4 * ovh + t) + 4 * l4); } \
    } while (0)
    float gnv[4][4];
#pragma unroll
    for (int t = 0; t < 4; ++t)
#pragma unroll
        for (int r = 0; r < 4; ++r) gnv[t][r] = (FULL && MODE != 2) ? ((MODE == 0) ? mp.hg : mp.gg)[h * 128 + 16 * (4 * ovh + t) + 4 * l4 + r] : 1.f;
    MX_LOAD(0);
    __syncthreads();
    for (int c = 0; c < 16; ++c) {
        const int tokc = tok0 + c * 64;
        float la[RPT][2], sp[RPT][2], qv[RPT][2], kv[RPT][2];
        u32x2 gcur[4];
        if (VAR == 4) {
#pragma unroll
            for (int t = 0; t < 4; ++t) gcur[t] = gnx[t];
            __syncthreads(); __syncthreads(); goto stepC; }
#pragma unroll
        for (int t = 0; t < 4; ++t) gcur[t] = gnx[t];
        if (MODE == 2) {
            if (w == 0) {
                const float ip = sgi + bi, lf = logsig(sgf + bfg);
                float cs = lf;
#pragma unroll
                for (int o = 1; o < 64; o <<= 1) { const float t = __shfl_up(cs, o); if (lane >= o) cs += t; }
                *(LAS float*)(lds + MX_BC + lane * 4) = cs; *(LAS float*)(lds + MX_IP + lane * 4) = ip - cs;
                if (lane == 63) *(LAS float*)(lds + MX_GT) = cs;
            }
#pragma unroll
            for (int i = 0; i < RPT; ++i)
#pragma unroll
                for (int e = 0; e < 2; ++e) {
                    float aq = 0.f, ak = 0.f;
#pragma unroll
                    for (int j = 0; j < 4; ++j) { aq += cwq[j][e] * (e ? bfhi(ra[i + j]) : bflo(ra[i + j])); ak += cwk[j][e] * (e ? bfhi(rb[i + j]) : bflo(rb[i + j])); }
                    qv[i][e] = silu(aq); kv[i][e] = silu(ak) * 0.08838834764831845f; la[i][e] = 0.f; sp[i][e] = 0.f;
                }
        } else {
#pragma unroll
            for (int i = 0; i < RPT; ++i) {
                if (MODE == 0) {
                    const unsigned uz = ra[i];
                    const float s0 = sigm(bflo(uz)), s1 = sigm(bfhi(uz));
                    la[i][0] = lbv[0] + oml[0] * s0; la[i][1] = lbv[1] + oml[1] * s1;
                    kv[i][0] = oml[0] - oml[0] * s0; kv[i][1] = oml[1] - oml[1] * s1;
                    if (FULL) { const unsigned uq = rb[i]; qv[i][0] = silu(bflo(uq)); qv[i][1] = silu(bfhi(uq)); } else { qv[i][0] = qv[i][1] = 0.f; }
                } else {
                    const unsigned uu = ra[i], uk = rb[i];
                    la[i][0] = __expf(logsig(bflo(uu) + bgk[0]) * 0.0625f); la[i][1] = __expf(logsig(bfhi(uu) + bgk[1]) * 0.0625f);
                    kv[i][0] = bflo(uk); kv[i][1] = bfhi(uk);
                    if (FULL) { const unsigned uq = rc[i]; qv[i][0] = bflo(uq) * 0.125f; qv[i][1] = bfhi(uq) * 0.125f; } else { qv[i][0] = qv[i][1] = 0.f; }
                }
            }
#pragma unroll
            for (int e = 0; e < 2; ++e) {
                float run = 1.f;
#pragma unroll
                for (int i = RPT - 1; i >= 0; --i) { sp[i][e] = run; run *= la[i][e]; }
                run = 1.f;
#pragma unroll
                for (int i = 0; i < RPT; ++i) { run *= la[i][e]; la[i][e] = run; }
            }
            *(LAS float*)(lds + MX_SEG + (rg * DK + d0) * 4) = la[RPT - 1][0]; *(LAS float*)(lds + MX_SEG + (rg * DK + d0 + 1) * 4) = la[RPT - 1][1];
        }
        {
            u32x4 lo, hi;
            lo.x = (pv[0] & 0xffffu) | (pv[1] << 16); lo.y = (pv[2] & 0xffffu) | (pv[3] << 16); lo.z = (pv[4] & 0xffffu) | (pv[5] << 16); lo.w = (pv[6] & 0xffffu) | (pv[7] << 16);
            hi.x = (pv[0] >> 16) | (pv[1] & 0xffff0000u); hi.y = (pv[2] >> 16) | (pv[3] & 0xffff0000u); hi.z = (pv[4] >> 16) | (pv[5] & 0xffff0000u); hi.w = (pv[6] >> 16) | (pv[7] & 0xffff0000u);
            *(LAS u32x4*)(lds + MX_VT + ((2 * vp) * 72 + r0v) * 2) = lo; *(LAS u32x4*)(lds + MX_VT + ((2 * vp + 1) * 72 + r0v) * 2) = hi;
        }
        if (c + 1 < 16) MX_LOAD(c + 1);
        if (VAR == 2) { unsigned xa = 0; _Pragma("unroll") for (int i = 0; i < RPT + 3; ++i) xa ^= ra[i] ^ rb[i]; _Pragma("unroll") for (int i = 0; i < RPT; ++i) xa ^= rc[i]; _Pragma("unroll") for (int i = 0; i < 8; ++i) xa ^= pv[i];
            _Pragma("unroll") for (int t = 0; t < 4; ++t) xa ^= gnx[t].x ^ gnx[t].y; gacc[0] += (float)(xa & 1u) + sgi + sgf; continue; }
        __syncthreads();
        {
            float pre[2], h2[2], gt[2];
            if (MODE == 2) {
                const float g = *(LAS float*)(lds + MX_GT);
                gt[0] = gt[1] = g; h2[0] = h2[1] = 0.f; pre[0] = pre[1] = 0.f;
                if (tid == 0) gacc[0] += g;
            } else {
#pragma unroll
                for (int e = 0; e < 2; ++e) { float p = 1.f, a1 = 1.f, a2 = 1.f;
#pragma unroll
                    for (int j = 0; j < RG; ++j) { const float v = *(LAS float*)(lds + MX_SEG + (j * DK + d0 + e) * 4);
                        if (j < RG / 2) a1 *= v; else a2 *= v;
                        const bool inb = (rg >= RG / 2) ? (j >= RG / 2 && j < rg) : (j > rg && j < RG / 2);
                        p *= inb ? v : 1.f; }
                    pre[e] = p; h2[e] = a2; gt[e] = a1 * a2;
                    if (rg == 0) { gacc[e] *= gt[e]; *(LAS float*)(lds + MX_GD + (d0 + e) * 4) = gt[e]; *(LAS float*)(lds + MX_ER + (d0 + e) * 4) = a1; } }
            }
            float kh[RPT][2];
#pragma unroll
            for (int i = 0; i < RPT; ++i) {
                const int s = rg * RPT + i;
                float qs[2], ks[2];
                if (MODE == 2) {
                    const float bc = *(LAS float*)(lds + MX_BC + s * 4), ipb = *(LAS float*)(lds + MX_IP + s * 4);
                    const float eq = __expf(bc), ek = __expf(ipb), eg = __expf(gt[0]);
                    qs[0] = qv[i][0] * eq; qs[1] = qv[i][1] * eq; ks[0] = kv[i][0] * ek; ks[1] = kv[i][1] * ek; kh[i][0] = ks[0] * eg; kh[i][1] = ks[1] * eg;
                } else {
#pragma unroll
                    for (int e = 0; e < 2; ++e) {
                        const float cd = pre[e] * ((rg >= RG / 2) ? la[i][e] : sp[i][e]);
                        const float rc_ = __builtin_amdgcn_rcpf(cd);
                        const float qm = (rg >= RG / 2) ? cd : rc_, km = (rg >= RG / 2) ? rc_ : cd;
                        qs[e] = qv[i][e] * qm; ks[e] = kv[i][e] * km; kh[i][e] = ks[e] * h2[e]; }
                }
                if (FULL) { *(LAS unsigned*)(lds + MX_QT + (s * QP + d0) * 2) = pk2(qs[0], qs[1]); *(LAS unsigned*)(lds + MX_KT + (s * QP + d0) * 2) = pk2(ks[0], ks[1]); }
            }
            if (RPT == 8) {
                u32x4 a, bq;
                a.x = pk2(kh[0][0], kh[1][0]); a.y = pk2(kh[2][0], kh[3][0]); a.z = pk2(kh[4 % RPT][0], kh[5 % RPT][0]); a.w = pk2(kh[6 % RPT][0], kh[7 % RPT][0]);
                bq.x = pk2(kh[0][1], kh[1][1]); bq.y = pk2(kh[2][1], kh[3][1]); bq.z = pk2(kh[4 % RPT][1], kh[5 % RPT][1]); bq.w = pk2(kh[6 % RPT][1], kh[7 % RPT][1]);
                *(LAS u32x4*)(lds + MX_KHT + (d0 * 72 + rg * 8) * 2) = a; *(LAS u32x4*)(lds + MX_KHT + ((d0 + 1) * 72 + rg * 8) * 2) = bq;
            } else {
                u32x2 a, bq;
                a.x = pk2(kh[0][0], kh[1][0]); a.y = pk2(kh[2][0], kh[3][0]); bq.x = pk2(kh[0][1], kh[1][1]); bq.y = pk2(kh[2][1], kh[3][1]);
                *(LAS u32x2*)(lds + MX_KHT + (d0 * 72 + rg * 4) * 2) = a; *(LAS u32x2*)(lds + MX_KHT + ((d0 + 1) * 72 + rg * 4) * 2) = bq;
            }
        }
        __syncthreads();
        stepC:
        if (FULL && VAR != 3) {
#pragma unroll
            for (int tt = 0; tt < 2; ++tt) {
                const int tile = 2 * w + tt, ti = tile >> 2, tj = tile & 3;
                f32x4 acc = (f32x4){0.f, 0.f, 0.f, 0.f};
                if (ti <= tj) {
#pragma unroll
                    for (int kk = 0; kk < KS; ++kk) {
                        const bf16x8 a = *(const LAS bf16x8*)(lds + MX_KT + ((16 * ti + l15) * QP + kk * 32 + 8 * l4) * 2);
                        const bf16x8 bq = *(const LAS bf16x8*)(lds + MX_QT + ((16 * tj + l15) * QP + kk * 32 + 8 * l4) * 2);
                        acc = MFMA16(a, bq, acc);
                    }
                }
                const int s = 16 * tj + l15, sp0 = 16 * ti + 4 * l4;
                float pvv[4];
#pragma unroll
                for (int r = 0; r < 4; ++r) pvv[r] = (sp0 + r <= s) ? acc[r] : 0.f;
                u32x2 pw; pw.x = pk2(pvv[0], pvv[1]); pw.y = pk2(pvv[2], pvv[3]);
                *(LAS u32x2*)(lds + MX_P + (s * 72 + sp0) * 2) = pw;
            }
            {
                float er[4];
#pragma unroll
                for (int r = 0; r < 4; ++r) er[r] = (MODE == 2) ? 1.f : *(LAS float*)(lds + MX_ER + (sdt * 16 + 4 * l4 + r) * 4);
#pragma unroll
                for (int t = 0; t < NST; ++t) {
                    const int v = 16 * (svt0 + t) + l15;
                    u32x2 sw; sw.x = pk2(S[t][0] * er[0], S[t][1] * er[1]); sw.y = pk2(S[t][2] * er[2], S[t][3] * er[3]);
                    *(LAS u32x2*)(lds + MX_ST + (v * QP + sdt * 16 + 4 * l4) * 2) = sw;
                }
            }
            {
                float dec[4];
                if (MODE == 2) { const float eg = __expf(*(LAS float*)(lds + MX_GT)); dec[0] = dec[1] = dec[2] = dec[3] = eg; }
                else {
    #pragma unroll
                    for (int r = 0; r < 4; ++r) dec[r] = *(LAS float*)(lds + MX_GD + (sdt * 16 + 4 * l4 + r) * 4);
                }
                bf16x8 ka[2];
    #pragma unroll
                for (int kk = 0; kk < 2; ++kk) ka[kk] = *(const LAS bf16x8*)(lds + MX_KHT + ((16 * sdt + l15) * 72 + kk * 32 + 8 * l4) * 2);
    #pragma unroll
                for (int t = 0; t < NST; ++t) {
    #pragma unroll
                    for (int r = 0; r < 4; ++r) S[t][r] *= dec[r];
    #pragma unroll
                    for (int kk = 0; kk < 2; ++kk) {
                        const bf16x8 vb = *(const LAS bf16x8*)(lds + MX_VT + ((16 * (svt0 + t) + l15) * 72 + kk * 32 + 8 * l4) * 2);
                        S[t] = MFMA16(ka[kk], vb, S[t]);
                    }
                }
            }
            __syncthreads();
            constexpr int NOT = (MODE == 2) ? 5 : 4;
            f32x4 O[NOT];
#pragma unroll
            for (int t = 0; t < NOT; ++t) O[t] = (f32x4){0.f, 0.f, 0.f, 0.f};
#pragma unroll
            for (int kk = 0; kk < 2; ++kk) {
                const bf16x8 bq = *(const LAS bf16x8*)(lds + MX_P + ((16 * sj + l15) * 72 + kk * 32 + 8 * l4) * 2);
#pragma unroll
                for (int t = 0; t < NOT; ++t) { const int vt = (t < 4) ? (4 * ovh + t) : 8;
                    if (t < 4 || ovh == 0) { const bf16x8 a = *(const LAS bf16x8*)(lds + MX_VT + ((16 * vt + l15) * 72 + kk * 32 + 8 * l4) * 2); O[t] = MFMA16(a, bq, O[t]); } }
            }
#pragma unroll
            for (int kk = 0; kk < KS; ++kk) {
                const bf16x8 bq = *(const LAS bf16x8*)(lds + MX_QT + ((16 * sj + l15) * QP + kk * 32 + 8 * l4) * 2);
#pragma unroll
                for (int t = 0; t < NOT; ++t) { const int vt = (t < 4) ? (4 * ovh + t) : 8;
                    if (t < 4 || ovh == 0) { const bf16x8 a = *(const LAS bf16x8*)(lds + MX_ST + ((16 * vt + l15) * QP + kk * 32 + 8 * l4) * 2); O[t] = MFMA16(a, bq, O[t]); } }
            }
            const int tokr = tokc + srow;
            float scale;
            if (MODE == 2) {
                if (ovh == 0 && l4 == 0) *(LAS float*)(lds + MX_DEN + srow * 4) = O[NOT - 1][0];
                __syncthreads();
                const float den = *(LAS float*)(lds + MX_DEN + srow * 4);
                scale = 1.f / fmaxf(fabsf(den), 1.f);
            } else {
                float ss = 0.f;
#pragma unroll
                for (int t = 0; t < 4; ++t)
#pragma unroll
                    for (int r = 0; r < 4; ++r) ss += O[t][r] * O[t][r];
                ss += __shfl_xor(ss, 16); ss += __shfl_xor(ss, 32);
                if (l4 == 0) *(LAS float*)(lds + MX_RS + (ovh * 64 + srow) * 4) = ss;
                __syncthreads();
                const float tot = *(LAS float*)(lds + MX_RS + srow * 4) + *(LAS float*)(lds + MX_RS + (64 + srow) * 4);
                scale = rsqrtf(tot * (1.f / 128.f) + 1e-6f);
            }
#pragma unroll
            for (int t = 0; t < 4; ++t) {
                const int v0 = 16 * (4 * ovh + t) + 4 * l4;
                const u32x2 gt = gcur[t];
                const float g0 = bflo(gt.x), g1 = bfhi(gt.x), g2 = bflo(gt.y), g3 = bfhi(gt.y);
                float y0, y1, y2, y3;
                if (MODE == 2) { y0 = O[t][0] * scale * sigm(g0); y1 = O[t][1] * scale * sigm(g1); y2 = O[t][2] * scale * sigm(g2); y3 = O[t][3] * scale * sigm(g3); }
                else { y0 = O[t][0] * scale * gnv[t][0] * silu(g0); y1 = O[t][1] * scale * gnv[t][1] * silu(g1); y2 = O[t][2] * scale * gnv[t][2] * silu(g2); y3 = O[t][3] * scale * gnv[t][3] * silu(g3); }
                *(LAS unsigned*)(lds + MX_P + srow * 128 + ((((v0 >> 4)) ^ (srow & 7)) << 4) + (v0 & 15)) = pk4(q8(y0, Q_SY), q8(y1, Q_SY), q8(y2, Q_SY), q8(y3, Q_SY));
            }
            __syncthreads();
            { const int yr = tid >> 3, yc = tid & 7;
              const u32x4 yv = *(const LAS u32x4*)(lds + MX_P + yr * 128 + ((yc ^ (yr & 7)) << 4));
              *(u32x4*)(mp.ymix + (size_t)(tokc + yr) * DM + cy + yc * 16) = yv; }
        }
        if (!FULL || VAR == 3) {
            {
                float dec[4];
                if (MODE == 2) { const float eg = __expf(*(LAS float*)(lds + MX_GT)); dec[0] = dec[1] = dec[2] = dec[3] = eg; }
                else {
    #pragma unroll
                    for (int r = 0; r < 4; ++r) dec[r] = *(LAS float*)(lds + MX_GD + (sdt * 16 + 4 * l4 + r) * 4);
                }
                bf16x8 ka[2];
    #pragma unroll
                for (int kk = 0; kk < 2; ++kk) ka[kk] = *(const LAS bf16x8*)(lds + MX_KHT + ((16 * sdt + l15) * 72 + kk * 32 + 8 * l4) * 2);
    #pragma unroll
                for (int t = 0; t < NST; ++t) {
    #pragma unroll
                    for (int r = 0; r < 4; ++r) S[t][r] *= dec[r];
    #pragma unroll
                    for (int kk = 0; kk < 2; ++kk) {
                        const bf16x8 vb = *(const LAS bf16x8*)(lds + MX_VT + ((16 * (svt0 + t) + l15) * 72 + kk * 32 + 8 * l4) * 2);
                        S[t] = MFMA16(ka[kk], vb, S[t]);
                    }
                }
            }
        __syncthreads();
        }
    }
#undef MX_LOAD
    if (VAR == 2) { mp.ust[(size_t)bid * 512 + tid] = gacc[0]; return; }
    if (!FULL) {
        float* U = mp.ust + ((size_t)bid * 8 + w) * (9 * 4 * 64);
#pragma unroll
        for (int t = 0; t < NST; ++t)
#pragma unroll
            for (int r = 0; r < 4; ++r) U[(t * 4 + r) * 64 + lane] = S[t][r];
        if (MODE == 2) { if (tid == 0) mp.gsum[(size_t)bid * 128] = gacc[0]; }
        else if (rg == 0) { mp.gsum[(size_t)bid * 128 + d0] = gacc[0]; mp.gsum[(size_t)bid * 128 + d0 + 1] = gacc[1]; }
    }
}

#ifndef PHMASK
#define PHMASK 0xFFFFu
#endif
#ifndef MIXSEL
#define MIXSEL 7
#endif
#ifndef REPMASK
#define REPMASK 0x0u
#endif
#define EN(j) (((PHMASK) >> (j)) & 1u)
#ifndef REPLAYER
#define REPLAYER 3
#endif
#define NREP(j) (1 + (int)((((REPMASK) >> (j)) & 1u) & (((REPLAYER) >> layer) & 1u)))
#define IN(k) (lo <= (k) && (k) < hi)
#define SEAM(k) do { if (IN((k) + 1)) xcd_barrier(bar); } while (0)

template <int layer> __device__ __forceinline__ void ph_proj(LAS unsigned char* lds, unsigned char* ws, int bid, int nb) {
    pg8::Gemm g{(const bf16_t*)(ws + (layer ? WS_H2Q : WS_XQ)), (const bf16_t*)(ws + (layer ? WS_WC : WS_WAB)), DM / 2};
    pg8::StaticOrder S; S.init(NTOK, layer ? CWID : ABW, nb, bid);
    pg8::EpiStoreBf16<true> E{(bf16_t*)(ws + WS_PROJ), layer ? CWID : ABW};
    pg8::gemm_phase<pg8::EpiStoreBf16<true>, pg8::StaticOrder, false, true>(lds, g, nullptr, S, E);
}
template <int layer> __device__ __forceinline__ void ph_outproj(LAS unsigned char* lds, unsigned char* ws, int bid, int nb) {
    pg8::Gemm g{(const bf16_t*)(ws + WS_YMIX), (const bf16_t*)(ws + (layer ? WS_WOC : WS_WOAB)), DM / 2};
    pg8::StaticOrder S; S.init(NTOK, DM, nb, bid);
    pg8::EpiResid E{(bf16_t*)(ws + WS_Z), (const bf16_t*)(ws + (layer ? WS_H2 : WS_HB))};
    pg8::gemm_phase<pg8::EpiResid, pg8::StaticOrder, false, true>(lds, g, nullptr, S, E);
}
template <int layer> __device__ __forceinline__ void ph_router(LAS unsigned char* lds, unsigned char* ws, int bid, int nb) {
    pg8::Gemm g{(const bf16_t*)(ws + WS_H1), (const bf16_t*)(ws + WS_WR) + (size_t)layer * 256 * 1024, DM};
    pg8::StaticOrder S; S.init(NTOK, 256, nb, bid);
    pg8::EpiF32 E{(float*)(ws + WS_LOGITS)};
    pg8::gemm_phase<pg8::EpiF32, pg8::StaticOrder, false>(lds, g, nullptr, S, E);
}
template <int layer> __device__ __forceinline__ void ph_gemm1(LAS unsigned char* lds, unsigned char* ws, int bid, int nb) {
    const int vcu = (nb % 8 == 0) ? (bid % 8) * (nb / 8) + bid / 8 : bid;
    const int nt = __builtin_amdgcn_readfirstlane(*(volatile int*)(ws + WS_MISC + 65536 + 8192));
    pg8::Gemm g{(const bf16_t*)(ws + WS_H1Q), (const bf16_t*)(ws + WS_W1T + (size_t)layer * NE1 * 512 * 1024), DM / 2};
    const int nu = pg8::moe_prep(lds, (const int*)(ws + WS_MISC + 65536), nt * 2, 1, nb, vcu, (const int*)(ws + WS_STOK));
    pg8::MoeOrder S{(const LAS int*)(lds + pg8::LDS_UT), nu < pg8::MOE_MAXU ? nu : pg8::MOE_MAXU};
    pg8::EpiSwiGLU<true> E{ws + WS_ACT, lds + 3 * pg8::HTB};
    pg8::gemm_phase<pg8::EpiSwiGLU<true>, pg8::MoeOrder, true, true>(lds, g, (const LAS int*)(lds + pg8::LDS_IDX), S, E);
}
template <int layer> __device__ __forceinline__ void ph_gemm2(LAS unsigned char* lds, unsigned char* ws, int bid, int nb) {
    const int vcu = (nb % 8 == 0) ? (bid % 8) * (nb / 8) + bid / 8 : bid;
    const int nt = __builtin_amdgcn_readfirstlane(*(volatile int*)(ws + WS_MISC + 65536 + 8192));
    int kq = 128; asm volatile("" : "+s"(kq));
    pg8::Gemm g{(const bf16_t*)(ws + WS_ACT), (const bf16_t*)(ws + WS_W2T + (size_t)layer * NE1 * 1024 * 256), kq, (const int*)(ws + WS_SDST)};
    const int nu = pg8::moe_prep(lds, (const int*)(ws + WS_MISC + 65536), nt * 4, 2, nb, vcu, nullptr);
    pg8::MoeOrder S{(const LAS int*)(lds + pg8::LDS_UT), nu};
    pg8::EpiDown E{(unsigned char*)(ws + WS_Y), lds + 3 * pg8::HTB};
    pg8::gemm_phase<pg8::EpiDown, pg8::MoeOrder, false, true>(lds, g, nullptr, S, E);
}
template <int layer, bool FULLP> __device__ __forceinline__ void ph_mixer(LAS unsigned char* lds, const Args& A, int bid, int nb) {
    unsigned char* ws = A.ws;
    if (nb != NWG) return;
    MixP mp{(const bf16_t*)(ws + WS_PROJ), layer ? CWID : ABW, 0, ws + WS_YMIX, (const float*)(ws + WS_GATES), (const float*)(ws + WS_MISC), A.in[I_BGK], A.in[I_HG], A.in[I_GG], A.in[I_CONV], A.in[I_BIF], (float*)(ws + WS_UST), (float*)(ws + WS_GSUM)};
    if (layer == 0) { if (bid < 128) { if (MIXSEL & 1) mixer_run<0, FULLP>(lds, mp, bid); } else { if (MIXSEL & 2) mixer_run<1, FULLP>(lds, mp, bid); } }
    else { if (MIXSEL & 4) mixer_run<2, FULLP>(lds, mp, bid); }
}
#define REP2(j, call) do { call; if (NREP(j) == 2) { __syncthreads(); call; } } while (0)

template <int layer>
__device__ __forceinline__ void run_layer(LAS unsigned char* lds, const Args& A, const XcdBarrier& bar, const int lo, const int hi) {
    const int bid = blockIdx.x, nb = gridDim.x;
    unsigned char* ws = A.ws;
    unsigned* ctl = (unsigned*)(ws + WS_CTL);
    constexpr int P = 1 + layer * 11;
    if (EN(0) && IN(P + 0)) {
        if (bid & 1) convert_experts(lds, A, layer, bid, nb, layer ? 8 : 0, layer ? 13 : 6);
        REP2(0, ph_proj<layer>(lds, ws, bid, nb));
        if (!(bid & 1)) convert_experts(lds, A, layer, bid, nb, layer ? 8 : 0, layer ? 13 : 6);
        SEAM(P + 0); }
    if (EN(1) && IN(P + 1)) { REP2(1, (ph_mixer<layer, false>(lds, A, bid, nb))); SEAM(P + 1); }
    if (EN(2) && IN(P + 2)) { REP2(2, (ph_mixer<layer, true>(lds, A, bid, nb)));
        if (layer == 0 && bid >= 128) { __syncthreads(); convert_experts(lds, A, 0, bid, nb, 13, 16); convert_experts(lds, A, 0, bid - 128, nb, 13, 16); }
        SEAM(P + 2); }
    if (EN(3) && IN(P + 3)) {
        if (layer == 0 && (bid & 1)) convert_experts(lds, A, 0, bid, nb, 6, 10);
        REP2(3, ph_outproj<layer>(lds, ws, bid, nb));
        if (layer == 0 && !(bid & 1)) convert_experts(lds, A, 0, bid, nb, 6, 10);
        SEAM(P + 3); }
    if (EN(4) && IN(P + 4)) { REP2(4, phase_ln((const bf16_t*)(ws + WS_Z), (bf16_t*)(ws + WS_H1), ws + WS_H1Q, A.in[I_LMG] + layer * DM, A.in[I_LMB] + layer * DM, bid, nb)); SEAM(P + 4); }
    if (EN(5) && IN(P + 5)) {
        if (bid & 1) { convert_experts(lds, A, layer, bid, nb, layer ? 13 : 10, layer ? 16 : 13); convert_experts(lds, A, layer, bid - 1, nb, layer ? 13 : 10, layer ? 16 : 13); }
        else ph_router<layer>(lds, ws, bid >> 1, nb >> 1);
        SEAM(P + 5); }
    if (EN(6) && IN(P + 6)) {
        phase_select<false>(lds, (const float*)(ws + WS_LOGITS), A.in[I_RB] + layer * NEXP, (int*)(ws + WS_TOKE), (int*)(ws + WS_TOKP), (float*)(ws + WS_TOKW), ctl + CW_CNT + layer * 256, bid, nb);
        if (NREP(6) == 2) phase_select<true>(lds, (const float*)(ws + WS_LOGITS), A.in[I_RB] + layer * NEXP, (int*)(ws + WS_TOKE), (int*)(ws + WS_TOKP), (float*)(ws + WS_TOKW), ctl + CW_CNT + layer * 256, bid, nb);
        SEAM(P + 6); }
    if (EN(7) && IN(P + 7)) { REP2(7, phase_dispatch(lds, ctl + CW_CNT + layer * 256, (const int*)(ws + WS_TOKE), (const int*)(ws + WS_TOKP), (int*)(ws + WS_STOK), (int*)(ws + WS_SDST), (int*)(ws + WS_MISC + 65536), (int*)(ws + WS_MISC + 65536 + 8192), bid, nb)); SEAM(P + 7); }
    if (EN(8) && IN(P + 8)) {
        if (layer == 0 && (bid & 1)) convert_experts(lds, A, 1, bid, nb, 0, 8);
        REP2(8, ph_gemm1<layer>(lds, ws, bid, nb));
        if (layer == 0 && !(bid & 1)) convert_experts(lds, A, 1, bid, nb, 0, 8);
        SEAM(P + 8); }
    if (EN(9) && IN(P + 9)) { REP2(9, ph_gemm2<layer>(lds, ws, bid, nb)); SEAM(P + 9); }
    if (EN(10) && IN(P + 10)) {
        if (layer == 0) REP2(10, (phase_combine<false>((const unsigned char*)(ws + WS_Y), (const float*)(ws + WS_TOKW), (const bf16_t*)(ws + WS_H1), (bf16_t*)(ws + WS_H2), ws + WS_H2Q, nullptr, (float*)(ws + WS_GATES), (const float*)(ws + WS_MISC + 4096), A.in[I_LFG], A.in[I_LFB], bid, nb)));
        else REP2(10, (phase_combine<true>((const unsigned char*)(ws + WS_Y), (const float*)(ws + WS_TOKW), (const bf16_t*)(ws + WS_H1), nullptr, nullptr, A.out, nullptr, nullptr, A.in[I_LFG] + DM, A.in[I_LFB] + DM, bid, nb)));
        SEAM(P + 10);
    }
}

__global__ void __launch_bounds__(512, 2) fwd_kernel(Args A) {
    extern __shared__ __attribute__((aligned(16))) unsigned char lds_raw[];
    LAS unsigned char* lds = (LAS unsigned char*)lds_raw;
    const int tid = threadIdx.x;
    unsigned* ctl = (unsigned*)(A.ws + WS_CTL);
    volatile LAS unsigned* misc = (volatile LAS unsigned*)(lds + LDS_MISC);
    if (tid < 64) misc[tid] = 0u;
    __syncthreads();
    const int lo = A.ph_lo, hi = A.ph_hi;
    XcdBarrier bar; bar.bar = ctl + CW_BAR; bar.x = 0; bar.st = misc;
    if (hi - lo > 1) bar = xcd_barrier_post(ctl + CW_BAR, misc);
    if (EN(11) && IN(0)) { for (int rep_ = 0; rep_ < 1 + (int)(((REPMASK) >> 11) & 1u); ++rep_) phase_prologue(lds, A, blockIdx.x, gridDim.x); SEAM(0); }
    run_layer<0>(lds, A, bar, lo, hi);
    run_layer<1>(lds, A, bar, lo, hi);
}
#undef IN
#undef SEAM

extern "C" void kernel_launch(void* const* d_in, const int* in_sizes, int n_in, void* d_out, int out_size, void* d_ws, size_t ws_size, hipStream_t stream) {
    static int grid = 0;
    if (grid == 0) {
        if (n_in != 22 || out_size != NTOK * DM || ws_size < WS_END) { fprintf(stderr, "kernel_launch: unexpected shapes (n_in %d out %d ws %zu)\n", n_in, out_size, ws_size); grid = -1; return; }
        if (hipFuncSetAttribute((const void*)fwd_kernel, hipFuncAttributeMaxDynamicSharedMemorySize, LDS_BYTES) != hipSuccess) { fprintf(stderr, "kernel_launch: hipFuncSetAttribute failed\n"); grid = -1; return; }
        int per_cu = 0;
        if (hipOccupancyMaxActiveBlocksPerMultiprocessor(&per_cu, (const void*)fwd_kernel, 512, LDS_BYTES) != hipSuccess || per_cu < 1) fprintf(stderr, "kernel_launch: occupancy query says %d\n", per_cu);
        (void)hipGetLastError();
        grid = NWG;
    }
    if (grid < 0) return;
    (void)hipMemsetAsync((char*)d_ws + WS_CTL, 0, CTL_BYTES, stream);
    Args a{};
    for (int i = 0; i < 22; ++i) a.in[i] = (const float*)d_in[i];
    a.out = (float*)d_out; a.ws = (unsigned char*)d_ws;
#if MK_ONE_LAUNCH
    a.ph_lo = 0; a.ph_hi = 23;
    hipLaunchKernelGGL(fwd_kernel, dim3(grid), dim3(512), LDS_BYTES, stream, a);
#else
    for (int p = 0; p < 23; ++p) { a.ph_lo = p; a.ph_hi = p + 1; hipLaunchKernelGGL(fwd_kernel, dim3(grid), dim3(512), LDS_BYTES, stream, a);
    }
#endif
}
```
